# Optimizing an MI355X kernel written in HIP

```python
import math
import jax, jax.numpy as jnp
from jax import lax
import numpy as np

D_MODEL = 1024
BATCH = 16
SEQ = 256
DEPTH = 2
DEC_BATCH = 4
DEC_SEQ = 2048
PAST_LEN = 256

GRID_W = 64
HEAD_DIM = 64
GQA_Q_HEADS = 8
GQA_KV_HEADS = 2
MLA_HEADS = 8
MLA_Q_RANK = 384
MLA_KV_RANK = 256
MLA_NOPE = 64
MLA_ROPE = 32
MLA_V = 64
HY_CH = 512
HY_ORDER = 2
HY_BANDS = 8
HY_EMB = 1 + 2 * HY_BANDS
HY_FFN = 64
HY_TARGET = 1e-2
HY_FAST_DECAY_PCT = 0.3
HY_SLOW_DECAY_PCT = 1.5
N_BRANCH = 3
BRANCH_W = 512
FFN_DIM = 2816
ROPE_THETA = 10000.0
Q_BLOCK = 128
EPS = 1e-6
MOD_CHUNKS = 6
SPLIT_SIZES = (GQA_Q_HEADS * HEAD_DIM, GQA_KV_HEADS * HEAD_DIM, GQA_KV_HEADS * HEAD_DIM,
               MLA_Q_RANK, MLA_KV_RANK, MLA_ROPE, 3 * HY_CH, N_BRANCH * D_MODEL)
IN_COLS = sum(SPLIT_SIZES)

kernel_name = "hybrid_gqa_mla_hyena_prefix_diffusion_step"


def _split_points():
    pts, acc = [], 0
    for s in SPLIT_SIZES[:-1]:
        acc += s
        pts.append(acc)
    return pts


def rms_norm(x, g):
    xf = x.astype(jnp.float32)
    y = xf * lax.rsqrt(jnp.mean(xf * xf, axis=-1, keepdims=True) + EPS)
    return (y * g.astype(jnp.float32)).astype(x.dtype)


def grid_rope(L, rot_dim):
    rows = L // GRID_W
    row = jnp.repeat(jnp.arange(rows, dtype=jnp.float32), GRID_W)
    col = jnp.tile(jnp.arange(GRID_W, dtype=jnp.float32), rows)
    axis_dim = rot_dim // 2
    inv = ROPE_THETA ** (-jnp.arange(0, axis_dim, 2, dtype=jnp.float32) / axis_dim)
    ang = jnp.concatenate([row[:, None] * inv, col[:, None] * inv], axis=-1)
    return jnp.cos(ang), jnp.sin(ang)


def apply_rope(x, rope):
    cos, sin = rope
    shp = x.shape
    xr = x.astype(jnp.float32).reshape(shp[:-1] + (shp[-1] // 2, 2))
    x0, x1 = xr[..., 0], xr[..., 1]
    c = cos[:, None, :]
    s = sin[:, None, :]
    out = jnp.stack([x0 * c - x1 * s, x0 * s + x1 * c], axis=-1).reshape(shp)
    return out.astype(x.dtype)


def blocked_attention(q, k, v, scale):
    B, Lq, H, Dk = q.shape
    Hkv = k.shape[2]
    G = H // Hkv
    Dv = v.shape[-1]
    nb = Lq // Q_BLOCK
    qb = jnp.moveaxis(q.reshape(B, nb, Q_BLOCK, Hkv, G, Dk), 1, 0)

    def one_block(qblk):
        s = jnp.einsum("bqhgd,bkhd->bhgqk", qblk, k, preferred_element_type=jnp.float32) * scale
        p = jax.nn.softmax(s, axis=-1).astype(v.dtype)
        return jnp.einsum("bhgqk,bkhd->bqhgd", p, v)

    o = lax.map(one_block, qb)
    return jnp.moveaxis(o, 0, 1).reshape(B, Lq, H, Dv)


def dwconv3(x, w, b):
    xp = jnp.pad(x, ((0, 0), (1, 1), (0, 0)))
    return xp[:, :-2] * w[0] + xp[:, 1:-1] * w[1] + xp[:, 2:] * w[2] + b


def hyena_filters(L, w1, b1, w2, b2, w3, freq):
    f32 = jnp.float32
    t = jnp.arange(L, dtype=f32)
    tn = t / max(L - 1, 1)
    bands = jnp.linspace(1e-4, HY_BANDS - 1, HY_BANDS, dtype=f32)
    ang = (2.0 * math.pi / L) * t[:, None] * bands[None, :]
    z = jnp.concatenate([tn[:, None], jnp.cos(ang), -jnp.sin(ang)], axis=-1)
    freq = freq.astype(f32)
    h = jnp.sin(freq[0] * (z @ w1.astype(f32) + b1.astype(f32)))
    h = jnp.sin(freq[1] * (h @ w2.astype(f32) + b2.astype(f32)))
    h = (h @ w3.astype(f32)).reshape(L, 2, HY_ORDER, HY_CH)
    min_decay = math.log(HY_TARGET) / HY_FAST_DECAY_PCT
    max_decay = math.log(HY_TARGET) / HY_SLOW_DECAY_PCT
    deltas = jnp.abs(jnp.linspace(min_decay, max_decay, HY_CH, dtype=f32))
    window = jnp.exp(-tn[:, None] * deltas[None, :])
    h = h * window[:, None, None, :]
    fwd = h[:, 0]
    bwd = h[1:, 1]
    l1 = jnp.sum(jnp.abs(fwd), axis=0) + jnp.sum(jnp.abs(bwd), axis=0) + EPS
    fwd = fwd / l1
    bwd = bwd / l1
    kern = jnp.concatenate([fwd, jnp.zeros((1, HY_ORDER, HY_CH), f32), bwd[::-1]], axis=0)
    return jnp.fft.rfft(kern, axis=0)


def long_conv(u, kf):
    L = u.shape[1]
    uf = jnp.fft.rfft(u.astype(jnp.float32), n=2 * L, axis=1)
    return jnp.fft.irfft(uf * kf[None], n=2 * L, axis=1)[:, :L].astype(u.dtype)


def hyena_branch(hy_in, lp):
    L = hy_in.shape[1]
    u = dwconv3(hy_in, lp["hy_short_w"], lp["hy_short_b"])
    v, x1, x2 = jnp.split(u, 3, axis=-1)
    kf = hyena_filters(L, lp["hy_w1"], lp["hy_b1"], lp["hy_w2"], lp["hy_b2"], lp["hy_w3"], lp["hy_freq"])
    z = v
    for n, gate in enumerate((x1, x2)):
        z = gate * (long_conv(z, kf[:, n]) + lp["hy_bias"][n] * z)
    return z


def token_mixers(h, lp, ctx_cache, rope_a, rope_b):
    B, L, _ = h.shape
    proj = h @ lp["w_in"]
    q_a, k_a, v_a, cq, ckv, kpe, hy_in, gates = jnp.split(proj, _split_points(), axis=-1)
    q_a = rms_norm(q_a.reshape(B, L, GQA_Q_HEADS, HEAD_DIM), lp["gqa_q_norm"])
    k_a = rms_norm(k_a.reshape(B, L, GQA_KV_HEADS, HEAD_DIM), lp["gqa_k_norm"])
    v_a = v_a.reshape(B, L, GQA_KV_HEADS, HEAD_DIM)
    cq = rms_norm(cq, lp["mla_q_norm"])
    q_b = (cq @ lp["mla_w_uq"]).reshape(B, L, MLA_HEADS, MLA_NOPE + MLA_ROPE)
    q_nope, q_pe = q_b[..., :MLA_NOPE], q_b[..., MLA_NOPE:]
    ckv = rms_norm(ckv, lp["mla_kv_norm"])
    kpe = kpe[:, :, None, :]
    if ctx_cache is None:
        new_ctx = (k_a, v_a, ckv, kpe[:, :, 0])
        keys_a, vals_a, ckv_all, kpe_all = k_a, v_a, ckv, kpe
    else:
        new_ctx = None
        q_a = apply_rope(q_a, rope_a)
        q_pe = apply_rope(q_pe, rope_b)
        c_k, c_v, c_ckv, c_kpe = ctx_cache
        keys_a = jnp.concatenate([c_k, apply_rope(k_a, rope_a)], axis=1)
        vals_a = jnp.concatenate([c_v, v_a], axis=1)
        ckv_all = jnp.concatenate([c_ckv, ckv], axis=1)
        kpe_all = jnp.concatenate([c_kpe[:, :, None, :], apply_rope(kpe, rope_b)], axis=1)
    o_a = blocked_attention(q_a, keys_a, vals_a, HEAD_DIM ** -0.5).reshape(B, L, BRANCH_W)
    kv = (ckv_all @ lp["mla_w_ukv"]).reshape(B, -1, MLA_HEADS, MLA_NOPE + MLA_V)
    k_b = jnp.concatenate([kv[..., :MLA_NOPE], jnp.broadcast_to(kpe_all, kv.shape[:-1] + (MLA_ROPE,))], axis=-1)
    q_b = jnp.concatenate([q_nope, q_pe], axis=-1)
    o_b = blocked_attention(q_b, k_b, kv[..., MLA_NOPE:], (MLA_NOPE + MLA_ROPE) ** -0.5).reshape(B, L, BRANCH_W)
    o_c = hyena_branch(hy_in, lp)
    branches = jnp.einsum("nblc,ncd->nbld", jnp.stack([o_a, o_b, o_c]), lp["w_branch"])
    g = jax.nn.sigmoid(gates.reshape(B, L, N_BRANCH, D_MODEL))
    merged = jnp.einsum("blnd,nbld->bld", g, branches)
    return merged @ lp["w_out"], new_ctx


def conv_ffn(h, lp):
    u = dwconv3(h @ lp["ffn_up"], lp["ffn_conv_w"], lp["ffn_conv_b"])
    a, g = jnp.split(u, 2, axis=-1)
    return (jax.nn.silu(g) * a) @ lp["ffn_down"]


def trunk_layer(x, cond, lp, ctx_cache, rope_a, rope_b):
    mod = (jax.nn.silu(cond) @ lp["w_mod"] + lp["b_mod"])[:, None, :]
    sh1, sc1, g1, sh2, sc2, g2 = jnp.split(mod, MOD_CHUNKS, axis=-1)
    h = rms_norm(x, lp["norm1"]) * (1 + sc1) + sh1
    o, new_ctx = token_mixers(h, lp, ctx_cache, rope_a, rope_b)
    x = x + g1 * o
    h = rms_norm(x, lp["norm2"]) * (1 + sc2) + sh2
    x = x + g2 * conv_ffn(h, lp)
    return x, new_ctx


def setup_inputs(seed: int = 0) -> dict:
    key = jax.random.key(seed)
    keys = iter(jax.random.split(key, 48))
    f32 = jnp.float32
    D = D_MODEL

    def nrm(shape, scale):
        return jax.random.normal(next(keys), shape, f32) * scale

    def gain(shape):
        return 1.0 + nrm(shape, 0.05)

    return {
        "x_prompt": nrm((BATCH, SEQ, D), 1.0),
        "x_sample": nrm((DEC_BATCH, DEC_SEQ, D), 1.0),
        "cache_gqa_k": nrm((DEC_BATCH, DEPTH, PAST_LEN, GQA_KV_HEADS, HEAD_DIM), 1.0),
        "cache_gqa_v": nrm((DEC_BATCH, DEPTH, PAST_LEN, GQA_KV_HEADS, HEAD_DIM), 1.0),
        "cache_mla_ckv": nrm((DEC_BATCH, DEPTH, PAST_LEN, MLA_KV_RANK), 1.0),
        "cache_mla_kpe": nrm((DEC_BATCH, DEPTH, PAST_LEN, MLA_ROPE), 1.0),
        "c": nrm((DEC_BATCH, D), 1.0),
        "c_ctx": nrm((D,), 1.0),
        "w_mod": nrm((DEPTH, D, MOD_CHUNKS * D), 0.5 * D ** -0.5),
        "b_mod": nrm((DEPTH, MOD_CHUNKS * D), 0.01),
        "norm1": gain((DEPTH, D)),
        "norm2": gain((DEPTH, D)),
        "w_in": nrm((DEPTH, D, IN_COLS), D ** -0.5),
        "gqa_q_norm": gain((DEPTH, HEAD_DIM)),
        "gqa_k_norm": gain((DEPTH, HEAD_DIM)),
        "mla_q_norm": gain((DEPTH, MLA_Q_RANK)),
        "mla_kv_norm": gain((DEPTH, MLA_KV_RANK)),
        "mla_w_uq": nrm((DEPTH, MLA_Q_RANK, MLA_HEADS * (MLA_NOPE + MLA_ROPE)), MLA_Q_RANK ** -0.5),
        "mla_w_ukv": nrm((DEPTH, MLA_KV_RANK, MLA_HEADS * (MLA_NOPE + MLA_V)), MLA_KV_RANK ** -0.5),
        "hy_short_w": nrm((DEPTH, 3, 3 * HY_CH), 3 ** -0.5),
        "hy_short_b": nrm((DEPTH, 3 * HY_CH), 0.02),
        "hy_w1": nrm((DEPTH, HY_EMB, HY_FFN), HY_EMB ** -0.5),
        "hy_b1": nrm((DEPTH, HY_FFN), 0.1),
        "hy_w2": nrm((DEPTH, HY_FFN, HY_FFN), HY_FFN ** -0.5),
        "hy_b2": nrm((DEPTH, HY_FFN), 0.1),
        "hy_w3": nrm((DEPTH, HY_FFN, 2 * HY_ORDER * HY_CH), HY_FFN ** -0.5),
        "hy_freq": gain((DEPTH, 2, HY_FFN)),
        "hy_bias": nrm((DEPTH, HY_ORDER, HY_CH), 0.5),
        "w_branch": nrm((DEPTH, N_BRANCH, BRANCH_W, D), BRANCH_W ** -0.5),
        "w_out": nrm((DEPTH, D, D), D ** -0.5),
        "ffn_up": nrm((DEPTH, D, 2 * FFN_DIM), D ** -0.5),
        "ffn_conv_w": nrm((DEPTH, 3, 2 * FFN_DIM), 3 ** -0.5),
        "ffn_conv_b": nrm((DEPTH, 2 * FFN_DIM), 0.02),
        "ffn_down": nrm((DEPTH, FFN_DIM, D), FFN_DIM ** -0.5),
        "final_norm": gain((D,)),
    }


def reference(x_prompt, x_sample, cache_gqa_k, cache_gqa_v, cache_mla_ckv, cache_mla_kpe, c, c_ctx,
              w_mod, b_mod, norm1, norm2, w_in, gqa_q_norm, gqa_k_norm, mla_q_norm, mla_kv_norm,
              mla_w_uq, mla_w_ukv, hy_short_w, hy_short_b, hy_w1, hy_b1, hy_w2, hy_b2, hy_w3, hy_freq,
              hy_bias, w_branch, w_out, ffn_up, ffn_conv_w, ffn_conv_b, ffn_down, final_norm):
    L_lat = x_sample.shape[1]
    rope_a = grid_rope(L_lat, HEAD_DIM)
    rope_b = grid_rope(L_lat, MLA_ROPE)
    xp = x_prompt
    xs = x_sample
    ctx_cond = c_ctx[None, :]
    ks, vs, ckvs, kpes = [], [], [], []
    for l in range(DEPTH):
        lp = dict(w_mod=w_mod[l], b_mod=b_mod[l], norm1=norm1[l], norm2=norm2[l], w_in=w_in[l],
                  gqa_q_norm=gqa_q_norm[l], gqa_k_norm=gqa_k_norm[l], mla_q_norm=mla_q_norm[l],
                  mla_kv_norm=mla_kv_norm[l], mla_w_uq=mla_w_uq[l], mla_w_ukv=mla_w_ukv[l],
                  hy_short_w=hy_short_w[l], hy_short_b=hy_short_b[l], hy_w1=hy_w1[l], hy_b1=hy_b1[l],
                  hy_w2=hy_w2[l], hy_b2=hy_b2[l], hy_w3=hy_w3[l], hy_freq=hy_freq[l], hy_bias=hy_bias[l],
                  w_branch=w_branch[l], w_out=w_out[l], ffn_up=ffn_up[l], ffn_conv_w=ffn_conv_w[l],
                  ffn_conv_b=ffn_conv_b[l], ffn_down=ffn_down[l])
        xp, (k_l, v_l, ckv_l, kpe_l) = trunk_layer(xp, ctx_cond, lp, None, None, None)
        ks.append(k_l)
        vs.append(v_l)
        ckvs.append(ckv_l)
        kpes.append(kpe_l)
        cache_l = (cache_gqa_k[:, l], cache_gqa_v[:, l], cache_mla_ckv[:, l], cache_mla_kpe[:, l])
        xs, _ = trunk_layer(xs, c, lp, cache_l, rope_a, rope_b)
    y_prompt = rms_norm(xp, final_norm)
    y_sample = rms_norm(xs, final_norm)
    new_gqa_k = jnp.stack(ks, axis=1)
    new_gqa_v = jnp.stack(vs, axis=1)
    new_mla_ckv = jnp.stack(ckvs, axis=1)
    new_mla_kpe = jnp.stack(kpes, axis=1)
    return (y_prompt, y_sample, new_gqa_k, new_gqa_v, new_mla_ckv, new_mla_kpe)
```

```cpp
#include <hip/hip_runtime.h>
#include <hip/hip_cooperative_groups.h>
#include <cstdio>
#include <cstdint>
namespace cg = cooperative_groups;
namespace pg8 {
#define PG8_LAS __attribute__((address_space(3)))
typedef unsigned short bf16_t;
typedef short bf16x8 __attribute__((ext_vector_type(8)));
typedef float f32x4 __attribute__((ext_vector_type(4)));
typedef unsigned u32x4 __attribute__((ext_vector_type(4)));
constexpr int BM = 256, BK = 64, HALF = 128, HTB = HALF * BK * 2  , STAGE_BYTES = 8 * HTB, NXCD = 8, WGM = 8;

__host__ __device__ __forceinline__ int lds_byte(int r, int c) { const int st = (r >> 4) * 2 + (c >> 5), rr = r & 15, cc = c & 31, ob = rr * 64 + cc * 2; return st * 1024 + (ob ^ (((ob >> 9) & 1) << 5)); }
__host__ __device__ __forceinline__ void stage_rc(int b, int& R, int& C) { const int st = b / 1024, sb = b % 1024, swz = sb ^ (((sb >> 9) & 1) << 5); R = (st >> 1) * 16 + swz / 64; C = (st & 1) * 32 + (swz % 64) / 2; }
__host__ __device__ __forceinline__ int perm32(int rho) { const int n = rho >> 4, i = rho & 15; return 8 * (i >> 2) + 4 * n + (i & 3); }

struct Unit { int pm, pn; };
struct Gemm { const bf16_t* A; const bf16_t* Bt; int M, N, K, lda, ldb; };

struct StaticOrder {
    int nM, nN, nwg, G, c;
    __host__ __device__ void init(int M, int N, int G_, int c_) { nM = M / BM; nN = N / BM; nwg = nM * nN; G = G_; c = c_; }
    __host__ __device__ bool next(int i, Unit& u) const {
        const long L = (long)i * G + c; if (L >= nwg) return false;
        int wgid = (int)L; { const int q = nwg / NXCD, r = nwg % NXCD, xcd = wgid % NXCD, off = wgid / NXCD; wgid = (xcd < r ? xcd * (q + 1) : r * (q + 1) + (xcd - r) * q) + off; }
        const int nig = WGM * nN, gid = wgid / nig, fm = gid * WGM, gsz = (nM - fm) < WGM ? (nM - fm) : WGM;
        u.pm = fm + ((wgid % nig) % gsz); u.pn = (wgid % nig) / gsz; return true;
    }
    __device__ __forceinline__ void a_ready(const Unit&) const {}
    __device__ __forceinline__ void done(const Unit&) const {}
};

__device__ __forceinline__ unsigned cvt_pk_bf16(float lo, float hi) { unsigned r; asm volatile("v_cvt_pk_bf16_f32 %0, %1, %2" : "=v"(r) : "v"(lo), "v"(hi)); return r; }
__device__ __forceinline__ float sigm(float x) { return 1.f / (1.f + __expf(-x)); }
#define EPI_FOR _Pragma("unroll") for (int ai = 0; ai < 2; ++ai) _Pragma("unroll") for (int m = 0; m < 4; ++m) _Pragma("unroll") for (int bj = 0; bj < 2; ++bj)

template <int ACT  > struct EpiStore {
    static constexpr bool PERM = true, AFTER_DRAIN = false;
    bf16_t* O; int ld;
    __device__ __forceinline__ void operator()(const f32x4 (&acc)[2][2][4][2], const Unit& u, int wr, int wc, int fr, int fq) const {
        const int row0 = u.pm * BM + wr * 64 + fr, col0 = u.pn * BM + wc * 32 + 8 * fq;
        EPI_FOR { f32x4 v0 = acc[ai][bj][m][0], v1 = acc[ai][bj][m][1];
            if (ACT == 1) { v0 = (f32x4){sigm(v0[0]), sigm(v0[1]), sigm(v0[2]), sigm(v0[3])}; v1 = (f32x4){sigm(v1[0]), sigm(v1[1]), sigm(v1[2]), sigm(v1[3])}; }
            u32x4 w; w.x = cvt_pk_bf16(v0[0], v0[1]); w.y = cvt_pk_bf16(v0[2], v0[3]); w.z = cvt_pk_bf16(v1[0], v1[1]); w.w = cvt_pk_bf16(v1[2], v1[3]);
            *(u32x4*)(O + (size_t)(row0 + ai * HALF + m * 16) * ld + col0 + bj * HALF) = w; }
    }
};
struct EpiSeg {
    static constexpr bool PERM = true, AFTER_DRAIN = false;
    bf16_t *QA, *KV, *CQ, *CKV, *HY;
    __device__ __forceinline__ void operator()(const f32x4 (&acc)[2][2][4][2], const Unit& u, int wr, int wc, int fr, int fq) const {
        bf16_t* base; int ld, coff; const int pn = u.pn;
        if (pn < 2) { base = QA; ld = 512; coff = 256 * pn; } else if (pn == 2) { base = KV; ld = 256; coff = 0; } else if (pn < 5) { base = CQ; ld = 512; coff = 256 * (pn - 3); }
        else if (pn == 5) { base = CKV; ld = 256; coff = 0; } else { base = HY; ld = 1536; coff = 256 * (pn - 6); }
        const int row0 = u.pm * BM + wr * 64 + fr, col0 = coff + wc * 32 + 8 * fq;
        EPI_FOR { const f32x4 v0 = acc[ai][bj][m][0], v1 = acc[ai][bj][m][1];
            u32x4 w; w.x = cvt_pk_bf16(v0[0], v0[1]); w.y = cvt_pk_bf16(v0[2], v0[3]); w.z = cvt_pk_bf16(v1[0], v1[1]); w.w = cvt_pk_bf16(v1[2], v1[3]);
            *(u32x4*)(base + (size_t)(row0 + ai * HALF + m * 16) * ld + col0 + bj * HALF) = w; }
    }
};
template <int MODE  > struct EpiMerge {
    static constexpr bool PERM = true, AFTER_DRAIN = false;
    const bf16_t* S; float* Macc; bf16_t* Mbf;
    __device__ __forceinline__ void operator()(const f32x4 (&acc)[2][2][4][2], const Unit& u, int wr, int wc, int fr, int fq) const {
        const int row0 = u.pm * BM + wr * 64 + fr, col0 = u.pn * BM + wc * 32 + 8 * fq;
        EPI_FOR { const size_t off = (size_t)(row0 + ai * HALF + m * 16) * 1024 + col0 + bj * HALF;
            const u32x4 sw = *(const u32x4*)(S + off);
            f32x4 s0 = (f32x4){__uint_as_float(sw.x << 16), __uint_as_float(sw.x & 0xffff0000u), __uint_as_float(sw.y << 16), __uint_as_float(sw.y & 0xffff0000u)};
            f32x4 s1 = (f32x4){__uint_as_float(sw.z << 16), __uint_as_float(sw.z & 0xffff0000u), __uint_as_float(sw.w << 16), __uint_as_float(sw.w & 0xffff0000u)};
            f32x4 v0 = acc[ai][bj][m][0] * s0, v1 = acc[ai][bj][m][1] * s1;
            if (MODE >= 1) { v0 = v0 + *(const f32x4*)(Macc + off); v1 = v1 + *(const f32x4*)(Macc + off + 4); }
            if (MODE <= 1) { *(f32x4*)(Macc + off) = v0; *(f32x4*)(Macc + off + 4) = v1; }
            else { u32x4 w; w.x = cvt_pk_bf16(v0[0], v0[1]); w.y = cvt_pk_bf16(v0[2], v0[3]); w.z = cvt_pk_bf16(v1[0], v1[1]); w.w = cvt_pk_bf16(v1[2], v1[3]); *(u32x4*)(Mbf + off) = w; } }
    }
};
struct EpiResid {
    static constexpr bool PERM = true, AFTER_DRAIN = false;
    float* X; const float* gate;
    __device__ __forceinline__ void operator()(const f32x4 (&acc)[2][2][4][2], const Unit& u, int wr, int wc, int fr, int fq) const {
        const int row0 = u.pm * BM + wr * 64 + fr, col0 = u.pn * BM + wc * 32 + 8 * fq;
        const int mrow = (u.pm < 16) ? 0 : 1 + ((u.pm - 16) >> 3);
        const float* gp = gate + (size_t)mrow * 6144 + col0;
        f32x4 g[2][2];
#pragma unroll
        for (int bj = 0; bj < 2; ++bj) { g[bj][0] = *(const f32x4*)(gp + bj * HALF); g[bj][1] = *(const f32x4*)(gp + bj * HALF + 4); }
        EPI_FOR { float* xp = X + (size_t)(row0 + ai * HALF + m * 16) * 1024 + col0 + bj * HALF;
            const f32x4 x0 = *(const f32x4*)xp, x1 = *(const f32x4*)(xp + 4);
            *(f32x4*)xp = x0 + g[bj][0] * acc[ai][bj][m][0]; *(f32x4*)(xp + 4) = x1 + g[bj][1] * acc[ai][bj][m][1]; }
    }
};

template <class Epi, class Sched, bool ALIGN_EPI = false, bool SP2 = false>
__device__ __forceinline__ void gemm_phase(PG8_LAS unsigned char* lds, const Gemm g, const Sched& S, const Epi& E) {
    int tid_l = threadIdx.x; asm volatile("" : "+v"(tid_l));
    const int tid = tid_l, wid = __builtin_amdgcn_readfirstlane(tid >> 6), lane = tid & 63, wr = wid >> 2, wc = wid & 3, fr = lane & 15, fq = lane >> 4;
    const int K = g.K, nt = K / BK;
    unsigned voffA[2], voffB[2];
#pragma unroll
    for (int i = 0; i < 2; ++i) { int R, C; stage_rc(tid * 16 + i * 8192, R, C); const int Rb = Epi::PERM ? ((R & ~31) + perm32(R & 31)) : R;
        voffA[i] = (unsigned)(R * g.lda + C) * 2u; voffB[i] = (unsigned)(Rb * g.ldb + C) * 2u; }
    const size_t kstep = (size_t)(BK * 2);
    const size_t hstepA = (size_t)HALF * g.lda * 2, hstepB = (size_t)HALF * g.ldb * 2;
    const size_t tstepA = 2 * hstepA, tstepB = 2 * hstepB;
    const unsigned ldsw = (unsigned)wid * 1024u;
    const int aoff = lds_byte(wr * 64 + fr, fq * 8), boff = lds_byte(wc * 32 + fr, fq * 8);
#define PG8_SA(b, h) (((b) * 2 + (h)) * HTB)
#define PG8_SB(b, h) ((4 + (b) * 2 + (h)) * HTB)
#define PG8_STAGE(bufoff, gbase, voff) do { _Pragma("unroll") for (int _i = 0; _i < 2; ++_i) \
        __builtin_amdgcn_global_load_lds((const unsigned*)((const char*)(gbase) + (voff)[_i]), (PG8_LAS unsigned*)(lds + (bufoff) + ldsw + _i * 8192), 16, 0, 0); } while (0)
#define PG8_LDA(dst, b, h) do { _Pragma("unroll") for (int m = 0; m < 4; ++m) _Pragma("unroll") for (int k = 0; k < 2; ++k) dst[m][k] = *(const PG8_LAS bf16x8*)(lds + PG8_SA(b, h) + aoff + m * 2048 + k * 1024); } while (0)
#define PG8_LDB(dst, b, h) do { _Pragma("unroll") for (int n = 0; n < 2; ++n) _Pragma("unroll") for (int k = 0; k < 2; ++k) dst[n][k] = *(const PG8_LAS bf16x8*)(lds + PG8_SB(b, h) + boff + n * 2048 + k * 1024); } while (0)
#define PG8_MMA(ai, bj, At, Bt) do { __builtin_amdgcn_s_setprio(1); _Pragma("unroll") for (int m = 0; m < 4; ++m) _Pragma("unroll") for (int n = 0; n < 2; ++n) _Pragma("unroll") for (int k = 0; k < 2; ++k) \
        acc[ai][bj][m][n] = __builtin_amdgcn_mfma_f32_16x16x32_bf16(Bt[n][k], At[m][k], acc[ai][bj][m][n], 0, 0, 0); __builtin_amdgcn_s_setprio(0); } while (0)
#define PG8_WAIT_V(n) asm volatile("s_waitcnt vmcnt(" #n ")" ::: "memory")
#define PG8_WAIT_L(n) asm volatile("s_waitcnt lgkmcnt(" #n ")" ::: "memory")
#define PG8_BAR __builtin_amdgcn_s_barrier()
#define PG8_SCHED __builtin_amdgcn_sched_barrier(0)
    Unit cur, nxt; int ui = 0;
    if (!S.next(0, cur)) return;
    f32x4 acc[2][2][4][2];
#pragma unroll
    for (int a = 0; a < 2; ++a)
#pragma unroll
        for (int b = 0; b < 2; ++b)
#pragma unroll
            for (int m = 0; m < 4; ++m)
#pragma unroll
                for (int n = 0; n < 2; ++n) acc[a][b][m][n] = (f32x4){0.f, 0.f, 0.f, 0.f};
    bf16x8 At[4][2], B0[2][2], B1[2][2];
    const char* cA = (const char*)g.A + (size_t)cur.pm * tstepA; const char* cB = (const char*)g.Bt + (size_t)cur.pn * tstepB;
    S.a_ready(cur);
    if constexpr (SP2) {
        PG8_STAGE(PG8_SB(0, 0), cB, voffB); PG8_STAGE(PG8_SB(0, 1), cB + hstepB, voffB); PG8_STAGE(PG8_SA(0, 0), cA, voffA); PG8_STAGE(PG8_SA(0, 1), cA + hstepA, voffA);
        if (wr == 1) PG8_BAR;
        PG8_WAIT_V(2); PG8_BAR;
        PG8_STAGE(PG8_SB(1, 0), cB + kstep, voffB); PG8_STAGE(PG8_SA(1, 0), cA + kstep, voffA); PG8_STAGE(PG8_SB(1, 1), cB + hstepB + kstep, voffB);
        PG8_WAIT_V(6); PG8_BAR;
    } else {
        PG8_STAGE(PG8_SB(0, 0), cB, voffB); PG8_STAGE(PG8_SA(0, 0), cA, voffA); PG8_STAGE(PG8_SB(0, 1), cB + hstepB, voffB); PG8_STAGE(PG8_SA(0, 1), cA + hstepA, voffA);
        if (wr == 1) PG8_BAR;
        PG8_WAIT_V(4); PG8_BAR;
        PG8_STAGE(PG8_SB(1, 0), cB + kstep, voffB); PG8_STAGE(PG8_SA(1, 0), cA + kstep, voffA); PG8_STAGE(PG8_SB(1, 1), cB + hstepB + kstep, voffB);
        PG8_WAIT_V(6); PG8_BAR;
    }
    for (;;) {
        const bool has_next = S.next(ui + 1, nxt);
        const char* nA = has_next ? (const char*)g.A + (size_t)nxt.pm * tstepA : cA; const char* nB = has_next ? (const char*)g.Bt + (size_t)nxt.pn * tstepB : cB;
        for (int t = 0; t < nt; t += 2) {
            const bool last = (t == nt - 2);
            const char* a1 = cA + (size_t)(t + 1) * kstep;
            const char* a2 = last ? nA : cA + (size_t)(t + 2) * kstep; const char* b2 = last ? nB : cB + (size_t)(t + 2) * kstep;
            const char* a3 = a2 + kstep; const char* b3 = b2 + kstep;
            if (last && has_next) S.a_ready(nxt);
            if constexpr (SP2) {
            PG8_LDB(B0, 0, 0); PG8_LDB(B1, 0, 1); PG8_SCHED; PG8_LDA(At, 0, 0); PG8_STAGE(PG8_SA(1, 1), a1 + hstepA, voffA);
            PG8_WAIT_V(8); PG8_WAIT_L(0); PG8_BAR; PG8_MMA(0, 0, At, B0); PG8_MMA(0, 1, At, B1); PG8_BAR; PG8_SCHED;
            PG8_LDA(At, 0, 1); PG8_STAGE(PG8_SB(0, 0), b2, voffB); PG8_STAGE(PG8_SB(0, 1), b2 + hstepB, voffB); PG8_STAGE(PG8_SA(0, 0), a2, voffA);
            PG8_WAIT_V(8); PG8_WAIT_L(0); PG8_BAR; PG8_MMA(1, 0, At, B0); PG8_MMA(1, 1, At, B1); PG8_BAR; PG8_SCHED;
            PG8_LDB(B0, 1, 0); PG8_LDB(B1, 1, 1); PG8_SCHED; PG8_LDA(At, 1, 0); PG8_STAGE(PG8_SA(0, 1), a2 + hstepA, voffA);
            PG8_WAIT_V(8); PG8_WAIT_L(0); PG8_BAR; PG8_MMA(0, 0, At, B0); PG8_MMA(0, 1, At, B1); PG8_BAR; PG8_SCHED;
            PG8_LDA(At, 1, 1); PG8_STAGE(PG8_SB(1, 0), b3, voffB); PG8_STAGE(PG8_SB(1, 1), b3 + hstepB, voffB); PG8_STAGE(PG8_SA(1, 0), a3, voffA);
            PG8_WAIT_V(8); PG8_WAIT_L(0); PG8_BAR; PG8_MMA(1, 0, At, B0); PG8_MMA(1, 1, At, B1); PG8_BAR; PG8_SCHED;
            } else {
            PG8_LDB(B0, 0, 0); PG8_SCHED; PG8_LDA(At, 0, 0); PG8_STAGE(PG8_SA(1, 1), a1 + hstepA, voffA);
            PG8_WAIT_L(8); PG8_BAR; PG8_WAIT_L(0); PG8_MMA(0, 0, At, B0); PG8_BAR; PG8_SCHED;
            PG8_LDB(B1, 0, 1); PG8_STAGE(PG8_SB(0, 0), b2, voffB);
            PG8_BAR; PG8_WAIT_L(0); PG8_MMA(0, 1, At, B1); PG8_BAR;
            PG8_LDA(At, 0, 1); PG8_STAGE(PG8_SA(0, 0), a2, voffA);
            PG8_BAR; PG8_WAIT_L(0); PG8_MMA(1, 0, At, B0); PG8_BAR; PG8_SCHED;
            PG8_STAGE(PG8_SB(0, 1), b2 + hstepB, voffB);
            PG8_WAIT_V(6); PG8_BAR; PG8_MMA(1, 1, At, B1); PG8_BAR;
            PG8_LDB(B0, 1, 0); PG8_SCHED; PG8_LDA(At, 1, 0); PG8_STAGE(PG8_SA(0, 1), a2 + hstepA, voffA);
            PG8_WAIT_L(8); PG8_BAR; PG8_WAIT_L(0); PG8_MMA(0, 0, At, B0); PG8_BAR; PG8_SCHED;
            PG8_LDB(B1, 1, 1); PG8_STAGE(PG8_SB(1, 0), b3, voffB);
            PG8_BAR; PG8_WAIT_L(0); PG8_MMA(0, 1, At, B1); PG8_BAR;
            PG8_LDA(At, 1, 1); PG8_STAGE(PG8_SA(1, 0), a3, voffA);
            PG8_BAR; PG8_WAIT_L(0); PG8_MMA(1, 0, At, B0); PG8_BAR; PG8_SCHED;
            PG8_STAGE(PG8_SB(1, 1), b3 + hstepB, voffB);
            PG8_WAIT_V(6); PG8_BAR; PG8_MMA(1, 1, At, B1); PG8_BAR;
            }
        }
        if constexpr (ALIGN_EPI) { if (wr == 0) PG8_BAR; }
        if constexpr (!Epi::AFTER_DRAIN) { E(acc, cur, wr, wc, fr, fq); S.done(cur); }
        if (!has_next) break;
#pragma unroll
        for (int a = 0; a < 2; ++a)
#pragma unroll
            for (int b = 0; b < 2; ++b)
#pragma unroll
                for (int m = 0; m < 4; ++m)
#pragma unroll
                    for (int n = 0; n < 2; ++n) acc[a][b][m][n] = (f32x4){0.f, 0.f, 0.f, 0.f};
        cur = nxt; cA = nA; cB = nB; ++ui;
        if constexpr (ALIGN_EPI) { if (wr == 1) PG8_BAR; }
    }
    PG8_WAIT_V(0);
    if constexpr (!ALIGN_EPI) { if (wr == 0) PG8_BAR; }
    PG8_BAR;
    if constexpr (Epi::AFTER_DRAIN) { E.fused(acc, cur, wr, wc, fr, fq, lds, wid, lane); S.done(cur); }
#undef PG8_SA
#undef PG8_SB
#undef PG8_STAGE
#undef PG8_LDA
#undef PG8_LDB
#undef PG8_MMA
#undef PG8_WAIT_V
#undef PG8_WAIT_L
#undef PG8_BAR
#undef PG8_SCHED
}
}

constexpr int TCTX = 4096, TLAT = 8192, TT = 12288, DM = 1024, NKEYROWS = 13312;
constexpr float EPSN = 1e-6f;
constexpr size_t MiB = 1u << 20;
constexpr size_t WS_MOD = 0, MOD_BYTES = 2 * 5 * 6144 * 4;
constexpr size_t WS_HID = 1 * MiB;
constexpr size_t WS_WIN = 3 * MiB, WS_WG = 9 * MiB, WS_WUQ = 15 * MiB, WS_WKN = 16 * MiB, WS_WVV = 16 * MiB + 262144, WS_WB = 17 * MiB, WS_WO = 20 * MiB, WS_WUP = 22 * MiB, WS_WDN = 33 * MiB;
constexpr size_t WS_U = 39 * MiB, WS_ACT = 171 * MiB, WS_HBF = 171 * MiB;
constexpr size_t WS_QA = 39 * MiB, WS_KVR = 51 * MiB, WS_CQ = 57 * MiB, WS_CKVR = 69 * MiB, WS_HYR = 75 * MiB, WS_OA = 75 * MiB, WS_OB = 87 * MiB, WS_OC = 99 * MiB;
constexpr size_t WS_UT = 111 * MiB, WS_QB = 147 * MiB, WS_CKVALL = 195 * MiB, WS_KPEALL = 202 * MiB, WS_KNB = 203 * MiB, WS_VTB = 216 * MiB, WS_KA = 229 * MiB, WS_VTA = 233 * MiB;
constexpr size_t WS_S = 111 * MiB, WS_MBF = 135 * MiB, WS_MACC = 195 * MiB, WS_END = 256 * MiB;
constexpr int KA_LAT = 16 * 2 * 256 * 64;
constexpr int UT_LAT = 16 * 1536 * 256;
constexpr int OUT_K = 12582912, OUT_V = 13631488, OUT_CKV = 14680064, OUT_KPE = 16777216;
constexpr int LDS_BYTES = 147456;
constexpr int NPHASE = 24;

#define GAS __attribute__((address_space(1)))
#define LAS __attribute__((address_space(3)))
typedef unsigned short bf16;
typedef unsigned v4u __attribute__((ext_vector_type(4)));
typedef unsigned v2u __attribute__((ext_vector_type(2)));
typedef float f32x4 __attribute__((ext_vector_type(4)));
typedef float f32x16 __attribute__((ext_vector_type(16)));
typedef short bf16x8 __attribute__((ext_vector_type(8)));
typedef short bf16x4 __attribute__((ext_vector_type(4)));
#define LDS_WAIT() asm volatile("s_waitcnt lgkmcnt(0)" ::: "memory")
__device__ __forceinline__ unsigned f2bf(float f) { unsigned u = __builtin_bit_cast(unsigned, f); return (u + 0x7fffu + ((u >> 16) & 1u)) >> 16; }
__device__ __forceinline__ unsigned pk2(float lo, float hi) { return f2bf(lo) | (f2bf(hi) << 16); }
__device__ __forceinline__ float bflo(unsigned w) { return __uint_as_float(w << 16); }
__device__ __forceinline__ float bfhi(unsigned w) { return __uint_as_float(w & 0xffff0000u); }
__device__ __forceinline__ float bf1(bf16 b) { return __uint_as_float(((unsigned)b) << 16); }
__device__ __forceinline__ void fsincos(float x, float& s, float& c) { float rev = x * 0.15915494309189535f; rev = rev - rintf(rev); s = __builtin_amdgcn_sinf(rev); c = __builtin_amdgcn_cosf(rev); }
__device__ __forceinline__ float fsin(float x) { float rev = x * 0.15915494309189535f; rev = rev - rintf(rev); return __builtin_amdgcn_sinf(rev); }
__device__ __forceinline__ float wave_sum(float v) {
#pragma unroll
    for (int o = 1; o < 64; o <<= 1) v += __shfl_xor(v, o);
    return v;
}
__device__ __forceinline__ void rope2(float& x0, float& x1, float ang) { float s, c; fsincos(ang, s, c); const float a = x0 * c - x1 * s, b = x0 * s + x1 * c; x0 = a; x1 = b; }
#define L2_10000 13.287712379549449f

__device__ __forceinline__ void transpose_item(const float* W, size_t ldw, int k0, int n0, bf16* WT, size_t ldt, int drow0, LAS float* scr, int lane) {
#pragma unroll 8
    for (int i = 0; i < 32; ++i) { const int kk = 2 * i + (lane >> 5); scr[kk * 33 + (lane & 31)] = W[(size_t)(k0 + kk) * ldw + n0 + (lane & 31)]; }
    LDS_WAIT(); asm volatile("" ::: "memory");
    const int c = lane & 7;
#pragma unroll
    for (int j = 0; j < 4; ++j) { const int n = (lane >> 3) + 8 * j; const LAS float* s = scr + (8 * c) * 33 + n;
        v4u o; o.x = pk2(s[0 * 33], s[1 * 33]); o.y = pk2(s[2 * 33], s[3 * 33]); o.z = pk2(s[4 * 33], s[5 * 33]); o.w = pk2(s[6 * 33], s[7 * 33]);
        *(v4u*)(WT + (size_t)(drow0 + n) * ldt + k0 + 8 * c) = o; }
    LDS_WAIT(); asm volatile("" ::: "memory");
}

struct Args { const float* in[35]; float* out; unsigned char* ws; int ph_lo, ph_hi; };

__device__ __forceinline__ void wconv_phase(const Args& a, int l, LAS unsigned char* lds, int gw, int NGW, int gt, int NGT, int wave, int lane) {
    LAS float* scr = (LAS float*)(lds + wave * 16384);
    unsigned char* ws = a.ws;
    bf16 *WIN = (bf16*)(ws + WS_WIN), *WG = (bf16*)(ws + WS_WG), *WUQ = (bf16*)(ws + WS_WUQ), *WKN = (bf16*)(ws + WS_WKN), *WVV = (bf16*)(ws + WS_WVV), *WB = (bf16*)(ws + WS_WB), *WO = (bf16*)(ws + WS_WO), *WUP = (bf16*)(ws + WS_WUP), *WDN = (bf16*)(ws + WS_WDN);
    constexpr int I1 = 16 * 189, I2 = 6 * 24, I3 = 4 * 32, I4 = 3 * 8 * 32, I5 = 16 * 32, I6 = 16 * 176, I7 = 44 * 32, NIT = I1 + I2 + I3 + I4 + I5 + I6 + I7;
    for (int it = gw; it < NIT; it += NGW) {
        int r = it;
        if (r < I1) { const int kb = r / 189, n0 = 32 * (r % 189); bf16* dst = WIN; int drow;
            if (n0 < 1152) drow = n0; else if (n0 < 1408) drow = n0 + 128; else if (n0 < 1440) drow = 1152 + (n0 - 1408); else if (n0 < 2976) drow = 1536 + (n0 - 1440); else { dst = WG; drow = n0 - 2976; }
            transpose_item(a.in[12] + (size_t)l * 1024 * 6048, 6048, 64 * kb, n0, dst, 1024, drow, scr, lane); continue; } r -= I1;
        if (r < I2) { const int kb = r / 24, n0 = 32 * (r % 24); transpose_item(a.in[17] + (size_t)l * 384 * 768, 768, 64 * kb, n0, WUQ, 384, n0, scr, lane); continue; } r -= I2;
        if (r < I3) { const int kb = r / 32, n0 = 32 * (r % 32); const int h = n0 >> 7, c0 = n0 & 127;
            transpose_item(a.in[18] + (size_t)l * 256 * 1024, 1024, 64 * kb, n0, (c0 < 64) ? WKN : WVV, 256, h * 64 + (c0 & 63), scr, lane); continue; } r -= I3;
        if (r < I4) { const int n = r / 256, q = r % 256, kb = q / 32, n0 = 32 * (q % 32);
            transpose_item(a.in[28] + ((size_t)l * 3 + n) * 512 * 1024, 1024, 64 * kb, n0, WB + (size_t)n * 1024 * 512, 512, n0, scr, lane); continue; } r -= I4;
        if (r < I5) { const int kb = r / 32, n0 = 32 * (r % 32); transpose_item(a.in[29] + (size_t)l * 1024 * 1024, 1024, 64 * kb, n0, WO, 1024, n0, scr, lane); continue; } r -= I5;
        if (r < I6) { const int kb = r / 176, n0 = 32 * (r % 176); transpose_item(a.in[30] + (size_t)l * 1024 * 5632, 5632, 64 * kb, n0, WUP, 1024, n0, scr, lane); continue; } r -= I6;
        { const int kb = r / 32, n0 = 32 * (r % 32); transpose_item(a.in[33] + (size_t)l * 2816 * 1024, 1024, 64 * kb, n0, WDN, 2816, n0, scr, lane); }
    }
    for (int i = gt; i < 96 * 1024 / 8; i += NGT) *(v4u*)(WIN + (size_t)1184 * 1024 + (size_t)i * 8) = (v4u){0u, 0u, 0u, 0u};
}

__device__ __forceinline__ void norm_phase(const Args& a, int l, int which, bool first, int gw, int NGW, int lane) {
    const float* mod = (const float*)(a.ws + WS_MOD) + (size_t)l * 5 * 6144;
    bf16* HBF = (bf16*)(a.ws + WS_HBF);
    const float* gv = (which == 0) ? a.in[10] + l * 1024 : (which == 1) ? a.in[11] + l * 1024 : a.in[34];
    const int shoff = (which == 0) ? 0 : 3072, scoff = shoff + 1024;
    for (int row = gw; row < TT; row += NGW) {
        const float* src = first ? (row < TCTX ? a.in[0] + (size_t)row * DM : a.in[1] + (size_t)(row - TCTX) * DM) : a.out + (size_t)row * DM;
        f32x4 v[4]; float ss = 0.f;
#pragma unroll
        for (int j = 0; j < 4; ++j) { v[j] = *(const f32x4*)(src + 4 * lane + 256 * j); ss += (v[j].x * v[j].x + v[j].y * v[j].y) + (v[j].z * v[j].z + v[j].w * v[j].w); }
        if (first) {
#pragma unroll
            for (int j = 0; j < 4; ++j) *(f32x4*)(a.out + (size_t)row * DM + 4 * lane + 256 * j) = v[j]; }
        const float rs = rsqrtf(wave_sum(ss) * (1.f / DM) + EPSN);
        const int mrow = row < TCTX ? 0 : 1 + ((row - TCTX) >> 11);
        const float* mp = mod + (size_t)mrow * 6144;
#pragma unroll
        for (int j = 0; j < 4; ++j) { const int col = 4 * lane + 256 * j; const f32x4 g = *(const f32x4*)(gv + col);
            if (which == 2) { *(f32x4*)(a.out + (size_t)row * DM + col) = v[j] * rs * g; }
            else { const f32x4 sc = *(const f32x4*)(mp + scoff + col), sh = *(const f32x4*)(mp + shoff + col);
                const f32x4 y = v[j] * rs * g * (sc + 1.f) + sh;
                *(v2u*)(HBF + (size_t)row * DM + col) = (v2u){pk2(y.x, y.y), pk2(y.z, y.w)}; } }
    }
}
__device__ __forceinline__ void p0_mod_hid(const Args& a, LAS unsigned char* lds, int bid, int G, int tid, int gw, int NGW, int lane) {
    float* mod = (float*)(a.ws + WS_MOD);
    LAS float* sc = (LAS float*)lds;
    for (int it = bid; it < 384; it += G) {
        const int l = it / 192, rem = it % 192, kc = rem / 12, jb = rem % 12;
        if (tid < 320) { const int r = tid >> 6, kk = tid & 63, k = kc * 64 + kk; const float cv = (r == 0) ? a.in[7][k] : a.in[6][(r - 1) * 1024 + k]; sc[tid] = cv / (1.f + __expf(-cv)); }
        __syncthreads();
        const int j = jb * 512 + tid;
        const float* wp = a.in[8] + ((size_t)l * 1024 + kc * 64) * 6144 + j;
        float acc[5] = {0.f, 0.f, 0.f, 0.f, 0.f};
#pragma unroll 8
        for (int kk = 0; kk < 64; ++kk) { const float w = wp[(size_t)kk * 6144];
#pragma unroll
            for (int r = 0; r < 5; ++r) acc[r] += sc[r * 64 + kk] * w; }
        const float bias = (kc == 0) ? a.in[9][l * 6144 + j] : 0.f;
#pragma unroll
        for (int r = 0; r < 5; ++r) atomicAdd(mod + (size_t)(l * 5 + r) * 6144 + j, acc[r] + bias);
        __syncthreads();
    }
    float* HID = (float*)(a.ws + WS_HID);
    for (int it = gw; it < 2 * 2304; it += NGW) {
        const int l = it / 2304, q = it % 2304; const int L = q < 256 ? 256 : 2048, t = q < 256 ? q : q - 256;
        const float tn = (float)t / (float)(L - 1);
        float zi = 0.f;
        if (lane == 0) zi = tn;
        else if (lane <= 16) { const int bi = (lane - 1) & 7; const float band = 1e-4f + (float)bi * ((7.f - 1e-4f) / 7.f); const float ang = (6.283185307179586f / (float)L) * (float)t * band; float s, c; fsincos(ang, s, c); zi = (lane <= 8) ? c : -s; }
        float s1 = a.in[22][l * 64 + lane];
#pragma unroll
        for (int i = 0; i < 17; ++i) s1 += __shfl(zi, i) * a.in[21][(l * 17 + i) * 64 + lane];
        const float h1 = fsin(a.in[26][(l * 2 + 0) * 64 + lane] * s1);
        float s2 = a.in[24][l * 64 + lane];
#pragma unroll 8
        for (int i = 0; i < 64; ++i) s2 += __shfl(h1, i) * a.in[23][(l * 64 + i) * 64 + lane];
        HID[(size_t)it * 64 + lane] = fsin(a.in[26][(l * 2 + 1) * 64 + lane] * s2);
    }
}

__device__ __forceinline__ void post_phase(const Args& a, int l, LAS unsigned char* lds, int bid, int G, int tid, int gw, int NGW, int gt, int NGT, int lane) {
    unsigned char* ws = a.ws;
    bf16 *QA = (bf16*)(ws + WS_QA), *KVR = (bf16*)(ws + WS_KVR), *CQ = (bf16*)(ws + WS_CQ), *CKVR = (bf16*)(ws + WS_CKVR), *HYR = (bf16*)(ws + WS_HYR);
    bf16 *UT = (bf16*)(ws + WS_UT), *CKVALL = (bf16*)(ws + WS_CKVALL), *KPEALL = (bf16*)(ws + WS_KPEALL), *KA = (bf16*)(ws + WS_KA), *VTA = (bf16*)(ws + WS_VTA);
    for (int i = gt; i < 4 * 256 * 128; i += NGT) { const int b = i >> 15, p = (i >> 7) & 255, kvh = (i >> 6) & 1, d = i & 63;
        const size_t s = ((size_t)(b * 2 + l) * 256 + p) * 128 + kvh * 64 + d;
        KA[KA_LAT + ((b * 2 + kvh) * 2304 + p) * 64 + d] = (bf16)f2bf(a.in[2][s]);
        VTA[KA_LAT + ((b * 2 + kvh) * 64 + d) * 2304 + p] = (bf16)f2bf(a.in[3][s]); }
    for (int i = gt; i < 4 * 256 * 256; i += NGT) { const int b = i >> 16, p = (i >> 8) & 255, j = i & 255;
        CKVALL[(size_t)(TCTX + b * 2304 + p) * 256 + j] = (bf16)f2bf(a.in[4][((size_t)(b * 2 + l) * 256 + p) * 256 + j]); }
    for (int i = gt; i < 4 * 256 * 32; i += NGT) { const int b = i >> 13, p = (i >> 5) & 255, j = i & 31;
        KPEALL[(size_t)(TCTX + b * 2304 + p) * 32 + j] = (bf16)f2bf(a.in[5][((size_t)(b * 2 + l) * 256 + p) * 32 + j]); }
    const float *gq = a.in[13] + l * 64, *gk = a.in[14] + l * 64, *gcq = a.in[15] + l * 384, *gkv = a.in[16] + l * 256;
    for (int row = gw; row < TT; row += NGW) {
        const bool lat = row >= TCTX;
        const int b = lat ? (row - TCTX) >> 11 : row >> 8, t = lat ? (row - TCTX) & 2047 : row & 255;
        const float grow = (float)(t >> 6), gcol = (float)(t & 63);
        const int keyrow = lat ? TCTX + b * 2304 + 256 + t : row;
        { v4u w = *(const v4u*)(QA + (size_t)row * 512 + 8 * lane);
          float x[8] = {bflo(w.x), bfhi(w.x), bflo(w.y), bfhi(w.y), bflo(w.z), bfhi(w.z), bflo(w.w), bfhi(w.w)};
          float ss = 0.f;
#pragma unroll
          for (int j = 0; j < 8; ++j) ss += x[j] * x[j];
          ss += __shfl_xor(ss, 1); ss += __shfl_xor(ss, 2); ss += __shfl_xor(ss, 4);
          const float rs = rsqrtf(ss * (1.f / 64.f) + EPSN); const int d0 = 8 * (lane & 7);
#pragma unroll
          for (int j = 0; j < 8; ++j) x[j] = x[j] * rs * gq[d0 + j];
          if (lat) {
#pragma unroll
              for (int k = 0; k < 4; ++k) { const int i = 4 * (lane & 7) + k; const float inv = __builtin_amdgcn_exp2f(-(float)(i & 15) * (L2_10000 / 16.f)); rope2(x[2 * k], x[2 * k + 1], (i < 16 ? grow : gcol) * inv); } }
          *(v4u*)(QA + (size_t)row * 512 + 8 * lane) = (v4u){pk2(x[0], x[1]), pk2(x[2], x[3]), pk2(x[4], x[5]), pk2(x[6], x[7])}; }
        { const v2u w = *(const v2u*)(KVR + (size_t)row * 256 + 4 * lane);
          float x[4] = {bflo(w.x), bfhi(w.x), bflo(w.y), bfhi(w.y)};
          float ss = (x[0] * x[0] + x[1] * x[1]) + (x[2] * x[2] + x[3] * x[3]);
          ss += __shfl_xor(ss, 1); ss += __shfl_xor(ss, 2); ss += __shfl_xor(ss, 4); ss += __shfl_xor(ss, 8);
          const int kvh = (lane >> 4) & 1, d0 = 4 * (lane & 15);
          if (lane < 32) {
              const float rs = rsqrtf(ss * (1.f / 64.f) + EPSN);
#pragma unroll
              for (int j = 0; j < 4; ++j) x[j] = x[j] * rs * gk[d0 + j];
              if (!lat) { *(f32x4*)(a.out + OUT_K + ((size_t)(b * 2 + l) * 256 + t) * 128 + kvh * 64 + d0) = (f32x4){x[0], x[1], x[2], x[3]};
                  *(v2u*)(KA + ((size_t)(b * 2 + kvh) * 256 + t) * 64 + d0) = (v2u){pk2(x[0], x[1]), pk2(x[2], x[3])}; }
              else {
#pragma unroll
                  for (int k = 0; k < 2; ++k) { const int i = 2 * (lane & 15) + k; const float inv = __builtin_amdgcn_exp2f(-(float)(i & 15) * (L2_10000 / 16.f)); rope2(x[2 * k], x[2 * k + 1], (i < 16 ? grow : gcol) * inv); }
                  *(v2u*)(KA + KA_LAT + ((size_t)(b * 2 + kvh) * 2304 + 256 + t) * 64 + d0) = (v2u){pk2(x[0], x[1]), pk2(x[2], x[3])}; }
          } else {
              if (!lat) { *(f32x4*)(a.out + OUT_V + ((size_t)(b * 2 + l) * 256 + t) * 128 + kvh * 64 + d0) = (f32x4){x[0], x[1], x[2], x[3]};
#pragma unroll
                  for (int j = 0; j < 4; ++j) VTA[((size_t)(b * 2 + kvh) * 64 + d0 + j) * 256 + t] = (bf16)f2bf(x[j]); }
              else {
#pragma unroll
                  for (int j = 0; j < 4; ++j) VTA[KA_LAT + ((size_t)(b * 2 + kvh) * 64 + d0 + j) * 2304 + 256 + t] = (bf16)f2bf(x[j]); }
          } }
        { unsigned* p = (unsigned*)(CQ + (size_t)row * 512 + 6 * lane);
          const unsigned w0 = p[0], w1 = p[1], w2 = p[2];
          float x[6] = {bflo(w0), bfhi(w0), bflo(w1), bfhi(w1), bflo(w2), bfhi(w2)};
          float ss = 0.f;
#pragma unroll
          for (int j = 0; j < 6; ++j) ss += x[j] * x[j];
          const float rs = rsqrtf(wave_sum(ss) * (1.f / 384.f) + EPSN);
#pragma unroll
          for (int j = 0; j < 6; ++j) x[j] = x[j] * rs * gcq[6 * lane + j];
          p[0] = pk2(x[0], x[1]); p[1] = pk2(x[2], x[3]); p[2] = pk2(x[4], x[5]);
          if (lane < 16) { const unsigned w = *(const unsigned*)(CQ + (size_t)row * 512 + 384 + 2 * lane); float y0 = bflo(w), y1 = bfhi(w);
              if (!lat) { a.out[OUT_KPE + ((size_t)(b * 2 + l) * 256 + t) * 32 + 2 * lane] = y0; a.out[OUT_KPE + ((size_t)(b * 2 + l) * 256 + t) * 32 + 2 * lane + 1] = y1; }
              else { const float inv = __builtin_amdgcn_exp2f(-(float)(lane & 7) * (L2_10000 / 8.f)); rope2(y0, y1, (lane < 8 ? grow : gcol) * inv); }
              *(unsigned*)(KPEALL + (size_t)keyrow * 32 + 2 * lane) = pk2(y0, y1); } }
        { const v2u w = *(const v2u*)(CKVR + (size_t)row * 256 + 4 * lane);
          float x[4] = {bflo(w.x), bfhi(w.x), bflo(w.y), bfhi(w.y)};
          const float ss = (x[0] * x[0] + x[1] * x[1]) + (x[2] * x[2] + x[3] * x[3]);
          const float rs = rsqrtf(wave_sum(ss) * (1.f / 256.f) + EPSN);
#pragma unroll
          for (int j = 0; j < 4; ++j) x[j] = x[j] * rs * gkv[4 * lane + j];
          if (!lat) *(f32x4*)(a.out + OUT_CKV + ((size_t)(b * 2 + l) * 256 + t) * 256 + 4 * lane) = (f32x4){x[0], x[1], x[2], x[3]};
          *(v2u*)(CKVALL + (size_t)keyrow * 256 + 4 * lane) = (v2u){pk2(x[0], x[1]), pk2(x[2], x[3])}; }
    }
    LAS float* tile = (LAS float*)lds;
    const float *sw = a.in[19] + (size_t)l * 3 * 1536, *sb = a.in[20] + (size_t)l * 1536;
    for (int it = bid; it < 192 * 24; it += G) {
        const int tb = it / 24, cb = it % 24, row0 = tb * 64;
        const bool lat = row0 >= TCTX; const int L = lat ? 2048 : 256;
        const int b = lat ? (row0 - TCTX) >> 11 : row0 >> 8, t0 = lat ? (row0 - TCTX) & 2047 : row0 & 255;
        { const int rr = tid >> 3, c8 = tid & 7; const v4u w = *(const v4u*)(HYR + (size_t)(row0 + rr) * 1536 + cb * 64 + 8 * c8);
          LAS float* tp = tile + (rr + 1) * 65 + 8 * c8;
          tp[0] = bflo(w.x); tp[1] = bfhi(w.x); tp[2] = bflo(w.y); tp[3] = bfhi(w.y); tp[4] = bflo(w.z); tp[5] = bfhi(w.z); tp[6] = bflo(w.w); tp[7] = bfhi(w.w); }
        if (tid < 16) { const int which = tid >> 3, c8 = tid & 7; const bool ok = which ? (t0 + 64 < L) : (t0 > 0); const int rsrc = which ? row0 + 64 : row0 - 1;
          v4u w = (v4u){0u, 0u, 0u, 0u}; if (ok) w = *(const v4u*)(HYR + (size_t)rsrc * 1536 + cb * 64 + 8 * c8);
          LAS float* tp = tile + (which ? 65 : 0) * 65 + 8 * c8;
          tp[0] = bflo(w.x); tp[1] = bfhi(w.x); tp[2] = bflo(w.y); tp[3] = bfhi(w.y); tp[4] = bflo(w.z); tp[5] = bfhi(w.z); tp[6] = bflo(w.w); tp[7] = bfhi(w.w); }
        __syncthreads();
        { const int c = tid >> 3, tc = tid & 7, cg_ = cb * 64 + c; const float w0 = sw[cg_], w1 = sw[1536 + cg_], w2 = sw[3072 + cg_], bb = sb[cg_];
          float u[8];
#pragma unroll
          for (int k = 0; k < 8; ++k) { const int tr = 8 * tc + k; u[k] = w0 * tile[tr * 65 + c] + w1 * tile[(tr + 1) * 65 + c] + w2 * tile[(tr + 2) * 65 + c] + bb; }
          const size_t base = lat ? (size_t)UT_LAT + ((size_t)b * 1536 + cg_) * 2048 : ((size_t)b * 1536 + cg_) * 256;
          *(v4u*)(UT + base + t0 + 8 * tc) = (v4u){pk2(u[0], u[1]), pk2(u[2], u[3]), pk2(u[4], u[5]), pk2(u[6], u[7])}; }
        __syncthreads();
    }
}

__device__ __forceinline__ void ffnconv_phase(const Args& a, int l, int gt, int NGT) {
    const bf16* U = (const bf16*)(a.ws + WS_U); bf16* ACT = (bf16*)(a.ws + WS_ACT);
    const float *cw = a.in[31] + (size_t)l * 3 * 5632, *cb = a.in[32] + (size_t)l * 5632;
    for (int idx = gt; idx < 768 * 352; idx += NGT) {
        const int tb = idx / 352, ch = idx % 352, row0 = tb * 16, c0 = ch * 8;
        const bool lat = row0 >= TCTX; const int t0 = lat ? (row0 - TCTX) & 2047 : row0 & 255, L = lat ? 2048 : 256;
        float pa[8], ca[8], pg[8], cg2[8];
        { v4u w = (v4u){0u, 0u, 0u, 0u}, w2 = w;
          if (t0 > 0) { w = *(const v4u*)(U + (size_t)(row0 - 1) * 5632 + c0); w2 = *(const v4u*)(U + (size_t)(row0 - 1) * 5632 + 2816 + c0); }
          pa[0] = bflo(w.x); pa[1] = bfhi(w.x); pa[2] = bflo(w.y); pa[3] = bfhi(w.y); pa[4] = bflo(w.z); pa[5] = bfhi(w.z); pa[6] = bflo(w.w); pa[7] = bfhi(w.w);
          pg[0] = bflo(w2.x); pg[1] = bfhi(w2.x); pg[2] = bflo(w2.y); pg[3] = bfhi(w2.y); pg[4] = bflo(w2.z); pg[5] = bfhi(w2.z); pg[6] = bflo(w2.w); pg[7] = bfhi(w2.w);
          w = *(const v4u*)(U + (size_t)row0 * 5632 + c0); w2 = *(const v4u*)(U + (size_t)row0 * 5632 + 2816 + c0);
          ca[0] = bflo(w.x); ca[1] = bfhi(w.x); ca[2] = bflo(w.y); ca[3] = bfhi(w.y); ca[4] = bflo(w.z); ca[5] = bfhi(w.z); ca[6] = bflo(w.w); ca[7] = bfhi(w.w);
          cg2[0] = bflo(w2.x); cg2[1] = bfhi(w2.x); cg2[2] = bflo(w2.y); cg2[3] = bfhi(w2.y); cg2[4] = bflo(w2.z); cg2[5] = bfhi(w2.z); cg2[6] = bflo(w2.w); cg2[7] = bfhi(w2.w); }
        for (int i = 0; i < 16; ++i) {
            float na[8], ng[8];
            v4u w = (v4u){0u, 0u, 0u, 0u}, w2 = w;
            if (t0 + i + 1 < L) { w = *(const v4u*)(U + (size_t)(row0 + i + 1) * 5632 + c0); w2 = *(const v4u*)(U + (size_t)(row0 + i + 1) * 5632 + 2816 + c0); }
            na[0] = bflo(w.x); na[1] = bfhi(w.x); na[2] = bflo(w.y); na[3] = bfhi(w.y); na[4] = bflo(w.z); na[5] = bfhi(w.z); na[6] = bflo(w.w); na[7] = bfhi(w.w);
            ng[0] = bflo(w2.x); ng[1] = bfhi(w2.x); ng[2] = bflo(w2.y); ng[3] = bfhi(w2.y); ng[4] = bflo(w2.z); ng[5] = bfhi(w2.z); ng[6] = bflo(w2.w); ng[7] = bfhi(w2.w);
            float o[8];
#pragma unroll
            for (int j = 0; j < 8; ++j) {
                const float av = cw[c0 + j] * pa[j] + cw[5632 + c0 + j] * ca[j] + cw[2 * 5632 + c0 + j] * na[j] + cb[c0 + j];
                const float gv = cw[2816 + c0 + j] * pg[j] + cw[5632 + 2816 + c0 + j] * cg2[j] + cw[2 * 5632 + 2816 + c0 + j] * ng[j] + cb[2816 + c0 + j];
                o[j] = gv / (1.f + __expf(-gv)) * av; pa[j] = ca[j]; ca[j] = na[j]; pg[j] = cg2[j]; cg2[j] = ng[j]; }
            *(v4u*)(ACT + (size_t)(row0 + i) * 2816 + c0) = (v4u){pk2(o[0], o[1]), pk2(o[2], o[3]), pk2(o[4], o[5]), pk2(o[6], o[7])};
        }
    }
}
template <int DK>
__device__ __forceinline__ void attn_unit(LAS unsigned char* lds, int tid, const bf16* Qp, int qpitch, const bf16* Kp, int kpitch, const bf16* Kpe, const bf16* Vt, size_t vpitch,
                                          int nkeys, bf16* Op, int opitch, float sl2, bool rope, int pos0) {
    constexpr int NS = DK / 16;
    asm volatile("" : "+v"(tid));
    const int lane = tid & 63, wave = tid >> 6, r = lane & 31, h = lane >> 5;
    bf16x8 qf[NS];
    { const bf16* qrow = Qp + (size_t)(wave * 32 + r) * qpitch;
#pragma unroll
      for (int s = 0; s < NS; ++s) qf[s] = *(const bf16x8*)(qrow + 16 * s + 8 * h);
      if (DK == 96 && rope) { const int t = pos0 + wave * 32 + r; const float grow = (float)(t >> 6), gcol = (float)(t & 63);
#pragma unroll
          for (int sp = 0; sp < 2; ++sp) { bf16x8 v = qf[NS - 2 + sp];
#pragma unroll
              for (int k = 0; k < 4; ++k) { float x0 = bf1((bf16)v[2 * k]), x1 = bf1((bf16)v[2 * k + 1]);
                  const float inv = __builtin_amdgcn_exp2f(-(float)(4 * h + k) * (L2_10000 / 8.f)); rope2(x0, x1, (sp == 0 ? grow : gcol) * inv);
                  v[2 * k] = (short)f2bf(x0); v[2 * k + 1] = (short)f2bf(x1); }
              qf[NS - 2 + sp] = v; } } }
    const int kkey = tid >> 3, kch = tid & 7, pkey = tid >> 2, pch = tid & 3;
    f32x16 o0, o1;
#pragma unroll
    for (int i = 0; i < 16; ++i) { o0[i] = 0.f; o1[i] = 0.f; }
    float mrun = -__builtin_inff(), lrun = 0.f;
    v4u rk, rv, rp = (v4u){0u, 0u, 0u, 0u};
    const int ntile = nkeys >> 6;
#define ATT_LOAD(kt) do { const int key0 = (kt) * 64; rk = *(const v4u*)(Kp + (size_t)(key0 + kkey) * kpitch + 8 * kch); rv = *(const v4u*)(Vt + (size_t)kkey * vpitch + key0 + 8 * kch); \
        if (DK == 96 && tid < 256) rp = *(const v4u*)(Kpe + (size_t)(key0 + pkey) * 32 + 8 * pch); } while (0)
#define ATT_WRITE(buf) do { *(LAS v4u*)(lds + (buf) * 13312 + kkey * 208 + kch * 16) = rk; *(LAS v4u*)(lds + 26624 + (buf) * 9216 + kkey * 144 + kch * 16) = rv; \
        if (DK == 96 && tid < 256) *(LAS v4u*)(lds + (buf) * 13312 + pkey * 208 + 128 + pch * 16) = rp; } while (0)
    ATT_LOAD(0); ATT_WRITE(0); __syncthreads();
    for (int kt = 0; kt < ntile; ++kt) {
        const int buf = kt & 1;
        if (kt + 1 < ntile) ATT_LOAD(kt + 1);
        const LAS unsigned char* kb = lds + buf * 13312; const LAS unsigned char* vb = lds + 26624 + buf * 9216;
        f32x16 s0, s1;
#pragma unroll
        for (int i = 0; i < 16; ++i) { s0[i] = 0.f; s1[i] = 0.f; }
#pragma unroll
        for (int s = 0; s < NS; ++s) {
            const bf16x8 a0 = *(const LAS bf16x8*)(kb + r * 208 + (16 * s + 8 * h) * 2), a1 = *(const LAS bf16x8*)(kb + (32 + r) * 208 + (16 * s + 8 * h) * 2);
            s0 = __builtin_amdgcn_mfma_f32_32x32x16_bf16(a0, qf[s], s0, 0, 0, 0); s1 = __builtin_amdgcn_mfma_f32_32x32x16_bf16(a1, qf[s], s1, 0, 0, 0); }
        float mx = s0[0];
#pragma unroll
        for (int i = 1; i < 16; ++i) mx = fmaxf(mx, s0[i]);
#pragma unroll
        for (int i = 0; i < 16; ++i) mx = fmaxf(mx, s1[i]);
        mx = fmaxf(mx, __shfl_xor(mx, 32));
        const float mnew = fmaxf(mrun, mx), alpha = __builtin_amdgcn_exp2f((mrun - mnew) * sl2), nm = mnew * sl2;
        float sum = 0.f;
#pragma unroll
        for (int i = 0; i < 16; ++i) { s0[i] = __builtin_amdgcn_exp2f(s0[i] * sl2 - nm); s1[i] = __builtin_amdgcn_exp2f(s1[i] * sl2 - nm); sum += s0[i] + s1[i]; }
        lrun = lrun * alpha + sum; mrun = mnew;
#pragma unroll
        for (int i = 0; i < 16; ++i) { o0[i] *= alpha; o1[i] *= alpha; }
#pragma unroll
        for (int sub = 0; sub < 2; ++sub) {
#pragma unroll
            for (int s2 = 0; s2 < 2; ++s2) {
                bf16x8 pb;
#pragma unroll
                for (int e = 0; e < 8; ++e) pb[e] = (short)f2bf(sub == 0 ? s0[8 * s2 + e] : s1[8 * s2 + e]);
                const int kofs = (32 * sub + 16 * s2 + 4 * h) * 2;
#pragma unroll
                for (int slab = 0; slab < 2; ++slab) {
                    const LAS unsigned char* vp = vb + (32 * slab + r) * 144 + kofs;
                    const bf16x4 lo = *(const LAS bf16x4*)vp, hi = *(const LAS bf16x4*)(vp + 16);
                    const bf16x8 va = (bf16x8){lo[0], lo[1], lo[2], lo[3], hi[0], hi[1], hi[2], hi[3]};
                    if (slab == 0) o0 = __builtin_amdgcn_mfma_f32_32x32x16_bf16(va, pb, o0, 0, 0, 0); else o1 = __builtin_amdgcn_mfma_f32_32x32x16_bf16(va, pb, o1, 0, 0, 0); } } }
        if (kt + 1 < ntile) ATT_WRITE(buf ^ 1);
        __syncthreads();
    }
#undef ATT_LOAD
#undef ATT_WRITE
    const float ltot = lrun + __shfl_xor(lrun, 32), inv = 1.f / ltot;
    bf16* orow = Op + (size_t)(wave * 32 + r) * opitch;
#pragma unroll
    for (int g4 = 0; g4 < 4; ++g4) {
        *(v2u*)(orow + 8 * g4 + 4 * h) = (v2u){pk2(o0[4 * g4] * inv, o0[4 * g4 + 1] * inv), pk2(o0[4 * g4 + 2] * inv, o0[4 * g4 + 3] * inv)};
        *(v2u*)(orow + 32 + 8 * g4 + 4 * h) = (v2u){pk2(o1[4 * g4] * inv, o1[4 * g4 + 1] * inv), pk2(o1[4 * g4 + 2] * inv, o1[4 * g4 + 3] * inv)}; }
}

template <bool LAT>
__device__ __forceinline__ void hyena_unit(const Args& a, int l, int c, LAS unsigned char* lds, int tid) {
    constexpr int L = LAT ? 2048 : 256, NB = LAT ? 4 : 16, NE = L / 16, NCH = L / 4, NW = LAT ? 8 : 4, ASH = LAT ? 2 : 4;
    asm volatile("" : "+v"(tid));
    const int lane = tid & 63, wave = tid >> 6, r = lane & 31, h = lane >> 5;
    const bf16* UT = (const bf16*)(a.ws + WS_UT) + (LAT ? UT_LAT : 0);
    bf16* OC = (bf16*)(a.ws + WS_OC);
    const float* HID = (const float*)(a.ws + WS_HID) + ((size_t)l * 2304 + (LAT ? 256 : 0)) * 64;
    LAS bf16* U = (LAS bf16*)lds; LAS bf16* X = (LAS bf16*)(lds + 16384); LAS float* FT = (LAS float*)(lds + 32768); LAS unsigned char* GC = lds + 65536;
    LAS float* W3 = (LAS float*)(lds + 131200); LAS float* RED = (LAS float*)(lds + 132224);
    for (int q = tid; q < NB * L / 8; q += 512) { const int b = q / (L / 8), off = (q % (L / 8)) * 8;
        *(LAS v4u*)(U + b * L + off) = *(const v4u*)(UT + ((size_t)b * 1536 + c) * L + off);
        *(LAS v4u*)(X + b * L + off) = *(const v4u*)(UT + ((size_t)b * 1536 + 512 + c) * L + off); }
    if (tid < 256) { const int j = tid >> 2, k = tid & 3; W3[k * 64 + j] = a.in[25][((size_t)l * 64 + j) * 2048 + (k >> 1) * 1024 + (k & 1) * 512 + c]; }
    __syncthreads();
    { const float dmin = -15.350567286626973f, dmax = -3.0701134573253945f;
      const float delta = fabsf(dmin + (float)c * ((dmax - dmin) / 511.f));
      float p0 = 0.f, p1 = 0.f;
      for (int t = tid; t < L; t += 512) {
          float s[4] = {0.f, 0.f, 0.f, 0.f};
#pragma unroll 4
          for (int j4 = 0; j4 < 16; ++j4) { const f32x4 hv = *(const f32x4*)(HID + (size_t)t * 64 + 4 * j4);
#pragma unroll
              for (int k = 0; k < 4; ++k) s[k] += hv.x * W3[k * 64 + 4 * j4] + hv.y * W3[k * 64 + 4 * j4 + 1] + hv.z * W3[k * 64 + 4 * j4 + 2] + hv.w * W3[k * 64 + 4 * j4 + 3]; }
          const float win = __expf(-((float)t / (float)(L - 1)) * delta);
#pragma unroll
          for (int k = 0; k < 4; ++k) { s[k] *= win; FT[k * L + t] = s[k]; }
          p0 += fabsf(s[0]) + (t >= 1 ? fabsf(s[2]) : 0.f); p1 += fabsf(s[1]) + (t >= 1 ? fabsf(s[3]) : 0.f); }
      p0 = wave_sum(p0); p1 = wave_sum(p1);
      if (lane == 0) { RED[2 * wave] = p0; RED[2 * wave + 1] = p1; } }
    __syncthreads();
    const int col = 32 * wave + r, ca = col >> ASH, cbat = col & (NB - 1);
    const int a_lo = (32 * wave) >> ASH, a_hi = (32 * wave + 31) >> ASH;
    const int rowbase = LAT ? TCTX + cbat * 2048 : cbat * 256;
#pragma unroll 1
    for (int n = 0; n < 2; ++n) {
        float l1s = 0.f;
#pragma unroll
        for (int w = 0; w < 8; ++w) l1s += RED[2 * w + n];
        const float invl1 = 1.f / (l1s + EPSN);
        for (int e = tid; e < 8 * NCH * 8; e += 512) { const int k = e / (NCH * 8), y = (e >> 3) % NCH, j = e & 7; const int m = L - (8 * y + k + j);
            float v = 0.f; if (m >= 0 && m < L) v = FT[n * L + m]; else if (m < 0 && m > -L) v = FT[(2 + n) * L - m];
            *(LAS bf16*)(GC + (k * 513 + y) * 16 + 2 * j) = (bf16)f2bf(v * invl1); }
        __syncthreads();
        f32x16 acc;
#pragma unroll
        for (int i = 0; i < 16; ++i) acc[i] = 0.f;
        if (wave < NW) {
            const int lam_lo = 2 * a_lo - (NE - 1), lam_hi = 2 * a_hi;
            for (int lam = lam_lo; lam <= lam_hi; ++lam) {
                const int xs = 8 * h - r - 16 * lam + L;
                const bf16x8 af = *(const LAS bf16x8*)(GC + ((xs & 7) * 513 + (xs >> 3)) * 16);
                const int e = 2 * ca - lam;
                bf16x8 bfr = (bf16x8){0, 0, 0, 0, 0, 0, 0, 0};
                if (e >= 0 && e < NE) bfr = *(const LAS bf16x8*)(U + cbat * L + 16 * e + 8 * h);
                acc = __builtin_amdgcn_mfma_f32_32x32x16_bf16(af, bfr, acc, 0, 0, 0);
            }
        }
        const float bias = a.in[27][((size_t)l * 2 + n) * 512 + c];
        float z[16];
        if (wave < NW) {
#pragma unroll
            for (int g4 = 0; g4 < 4; ++g4) { const int t0 = 32 * ca + 8 * g4 + 4 * h;
                const v2u uw = *(const LAS v2u*)(U + cbat * L + t0), xw = *(const LAS v2u*)(X + cbat * L + t0);
                const float uv[4] = {bflo(uw.x), bfhi(uw.x), bflo(uw.y), bfhi(uw.y)}, xv[4] = {bflo(xw.x), bfhi(xw.x), bflo(xw.y), bfhi(xw.y)};
#pragma unroll
                for (int k = 0; k < 4; ++k) z[4 * g4 + k] = xv[k] * (acc[4 * g4 + k] + bias * uv[k]); }
        }
        __syncthreads();
        if (n == 0) {
            if (wave < NW) {
#pragma unroll
                for (int g4 = 0; g4 < 4; ++g4) *(LAS v2u*)(U + cbat * L + 32 * ca + 8 * g4 + 4 * h) = (v2u){pk2(z[4 * g4], z[4 * g4 + 1]), pk2(z[4 * g4 + 2], z[4 * g4 + 3])}; }
            for (int q = tid; q < NB * L / 8; q += 512) { const int b = q / (L / 8), off = (q % (L / 8)) * 8;
                *(LAS v4u*)(X + b * L + off) = *(const v4u*)(UT + ((size_t)b * 1536 + 1024 + c) * L + off); }
        } else if (wave < NW) {
#pragma unroll
            for (int g4 = 0; g4 < 4; ++g4)
#pragma unroll
                for (int k = 0; k < 4; ++k) OC[(size_t)(rowbase + 32 * ca + 8 * g4 + 4 * h + k) * 512 + c] = (bf16)f2bf(z[4 * g4 + k]);
        }
    }
    __syncthreads();
}
#ifndef PHMASK
#define PHMASK 0x1fff
#endif
#define PH_ON(k) (((PHMASK) >> (k)) & 1)
__global__ void __launch_bounds__(512, 2) mega_fwd(Args a) {
    extern __shared__ __attribute__((aligned(16))) unsigned char lds_raw[];
    LAS unsigned char* lds = (LAS unsigned char*)lds_raw;
    cg::grid_group grid = cg::this_grid();
    const int G = gridDim.x, bid = blockIdx.x, NGW = G * 8, NGT = G * 512;
    using pg8::Gemm; using pg8::StaticOrder;
#pragma unroll 1
    for (int ph = a.ph_lo; ph < a.ph_hi; ++ph) {
        int tid = threadIdx.x; asm volatile("" : "+v"(tid));
        unsigned char* ws = a.ws; asm volatile("" : "+s"(ws));
        const int lane = tid & 63, wave = __builtin_amdgcn_readfirstlane(tid >> 6), gw = bid * 8 + wave, gt = bid * 512 + tid;
        const int l = (ph >= 1 && ph < 23) ? (ph - 1) / 11 : 0, sub = (ph >= 1 && ph < 23) ? (ph - 1) % 11 : -1;
        float* mod = (float*)(ws + WS_MOD) + (size_t)l * 5 * 6144;
        if (PH_ON(11) && ph == 0) { p0_mod_hid(a, lds, bid, G, tid, gw, NGW, lane); wconv_phase(a, 0, lds, gw, NGW, gt, NGT, wave, lane); }
        else if (PH_ON(12) && ph == 23) { norm_phase(a, 0, 2, false, gw, NGW, lane); }
        else if (PH_ON(0) && sub == 0) { if (l == 1) wconv_phase(a, 1, lds, gw, NGW, gt, NGT, wave, lane); norm_phase(a, l, 0, l == 0, gw, NGW, lane); }
        else if (PH_ON(1) && sub == 1) {
            Gemm g{(const bf16*)(ws + WS_HBF), (const bf16*)(ws + WS_WIN), TT, 3072, 1024, 1024, 1024}; StaticOrder S; S.init(TT, 3072, G, bid);
            pg8::EpiSeg E{(bf16*)(ws + WS_QA), (bf16*)(ws + WS_KVR), (bf16*)(ws + WS_CQ), (bf16*)(ws + WS_CKVR), (bf16*)(ws + WS_HYR)};
            pg8::gemm_phase<pg8::EpiSeg, StaticOrder, true, true>(lds, g, S, E);
        }
        else if (PH_ON(2) && sub == 2) { post_phase(a, l, lds, bid, G, tid, gw, NGW, gt, NGT, lane); }
        else if (PH_ON(3) && sub == 3) {
#pragma unroll 1
            for (int q = 0; q < 3; ++q) {
                Gemm g; StaticOrder S; pg8::EpiStore<0> E;
                if (q == 0) { g = Gemm{(const bf16*)(ws + WS_CQ), (const bf16*)(ws + WS_WUQ), TT, 768, 384, 512, 384}; S.init(TT, 768, G, bid); E = pg8::EpiStore<0>{(bf16*)(ws + WS_QB), 768}; }
                else if (q == 1) { g = Gemm{(const bf16*)(ws + WS_CKVALL), (const bf16*)(ws + WS_WKN), NKEYROWS, 512, 256, 256, 256}; S.init(NKEYROWS, 512, G, (bid + G - 144 % G) % G); E = pg8::EpiStore<0>{(bf16*)(ws + WS_KNB), 512}; }
                else { g = Gemm{(const bf16*)(ws + WS_WVV), (const bf16*)(ws + WS_CKVALL), 512, NKEYROWS, 256, 256, 256}; S.init(512, NKEYROWS, G, (bid + G - 248 % G) % G); E = pg8::EpiStore<0>{(bf16*)(ws + WS_VTB), NKEYROWS}; }
                pg8::gemm_phase<pg8::EpiStore<0>, StaticOrder, true, true>(lds, g, S, E);
            }
        }
        else if (PH_ON(4) && sub == 4) {
            const bf16 *QA = (const bf16*)(ws + WS_QA), *QB = (const bf16*)(ws + WS_QB), *KA = (const bf16*)(ws + WS_KA), *VTA = (const bf16*)(ws + WS_VTA);
            const bf16 *KNB = (const bf16*)(ws + WS_KNB), *VTB = (const bf16*)(ws + WS_VTB), *KPE = (const bf16*)(ws + WS_KPEALL);
            bf16 *OA = (bf16*)(ws + WS_OA), *OB = (bf16*)(ws + WS_OB);
            const float slA = 0.125f * 1.4426950408889634f, slB = 0.10206207261596575f * 1.4426950408889634f;
            for (int it = bid; it < 1792; it += G) {
                if (it < 256 || (it >= 1024 && it < 1152)) {
                    const bool lat = it < 256; const int u = lat ? it : it - 1024;
                    const int b = lat ? u >> 6 : u >> 3, hh = lat ? (u >> 3) & 7 : u & 7, qb = lat ? u & 7 : 0;
                    const int row0 = lat ? TCTX + b * 2048 + qb * 256 : b * 256, key0 = lat ? TCTX + b * 2304 : b * 256;
                    attn_unit<96>(lds, tid, QB + (size_t)row0 * 768 + hh * 96, 768, KNB + (size_t)key0 * 512 + hh * 64, 512, KPE + (size_t)key0 * 32, VTB + (size_t)(hh * 64) * NKEYROWS + key0, NKEYROWS,
                                  lat ? 2304 : 256, OB + (size_t)row0 * 512 + hh * 64, 512, slB, lat, qb * 256);
                } else if (it < 512 || (it >= 1152 && it < 1280)) {
                    const bool lat = it < 512; const int u = lat ? it - 256 : it - 1152;
                    const int b = lat ? u >> 6 : u >> 3, hh = lat ? (u >> 3) & 7 : u & 7, qb = lat ? u & 7 : 0, kvh = hh >> 2;
                    const int row0 = lat ? TCTX + b * 2048 + qb * 256 : b * 256, nk = lat ? 2304 : 256;
                    const size_t kbase = lat ? (size_t)KA_LAT + (size_t)(b * 2 + kvh) * 2304 * 64 : (size_t)(b * 2 + kvh) * 256 * 64;
                    attn_unit<64>(lds, tid, QA + (size_t)row0 * 512 + hh * 64, 512, KA + kbase, 64, nullptr, VTA + kbase, nk, nk, OA + (size_t)row0 * 512 + hh * 64, 512, slA, false, 0);
                } else if (it < 1024) { hyena_unit<true>(a, l, it - 512, lds, tid); }
                else { hyena_unit<false>(a, l, it - 1280, lds, tid); }
            }
        }
        else if (PH_ON(5) && sub == 5) {
            const bf16* HBF = (const bf16*)(ws + WS_HBF); bf16* Sg = (bf16*)(ws + WS_S); float* MACC = (float*)(ws + WS_MACC); bf16* MBF = (bf16*)(ws + WS_MBF);
#pragma unroll 1
            for (int n = 0; n < 3; ++n) {
                { Gemm g{HBF, (const bf16*)(ws + WS_WG) + (size_t)n * 1024 * 1024, TT, 1024, 1024, 1024, 1024}; StaticOrder S; S.init(TT, 1024, G, bid);
                  pg8::EpiStore<1> E{Sg, 1024}; pg8::gemm_phase<pg8::EpiStore<1>, StaticOrder, true, true>(lds, g, S, E); }
                Gemm g{(const bf16*)(ws + WS_OA) + (size_t)n * TT * 512, (const bf16*)(ws + WS_WB) + (size_t)n * 1024 * 512, TT, 1024, 512, 512, 512}; StaticOrder S; S.init(TT, 1024, G, bid);
                if (n == 0) { pg8::EpiMerge<0> E{Sg, MACC, MBF}; pg8::gemm_phase<pg8::EpiMerge<0>, StaticOrder, true, true>(lds, g, S, E); }
                else if (n == 1) { pg8::EpiMerge<1> E{Sg, MACC, MBF}; pg8::gemm_phase<pg8::EpiMerge<1>, StaticOrder, true, true>(lds, g, S, E); }
                else { pg8::EpiMerge<2> E{Sg, MACC, MBF}; pg8::gemm_phase<pg8::EpiMerge<2>, StaticOrder, true, true>(lds, g, S, E); }
            }
        }
        else if (PH_ON(6) && sub == 6) {
            Gemm g{(const bf16*)(ws + WS_MBF), (const bf16*)(ws + WS_WO), TT, 1024, 1024, 1024, 1024}; StaticOrder S; S.init(TT, 1024, G, bid);
            pg8::EpiResid E{a.out, mod + 2048}; pg8::gemm_phase<pg8::EpiResid, StaticOrder, true, true>(lds, g, S, E);
        }
        else if (PH_ON(7) && sub == 7) { norm_phase(a, l, 1, false, gw, NGW, lane); }
        else if (PH_ON(8) && sub == 8) {
            Gemm g{(const bf16*)(ws + WS_HBF), (const bf16*)(ws + WS_WUP), TT, 5632, 1024, 1024, 1024}; StaticOrder S; S.init(TT, 5632, G, bid);
            pg8::EpiStore<0> E{(bf16*)(ws + WS_U), 5632}; pg8::gemm_phase<pg8::EpiStore<0>, StaticOrder, true, true>(lds, g, S, E);
        }
        else if (PH_ON(9) && sub == 9) { ffnconv_phase(a, l, gt, NGT); }
        else if (PH_ON(10) && sub == 10) {
            Gemm g{(const bf16*)(ws + WS_ACT), (const bf16*)(ws + WS_WDN), TT, 1024, 2816, 2816, 2816}; StaticOrder S; S.init(TT, 1024, G, bid);
            pg8::EpiResid E{a.out, mod + 5120}; pg8::gemm_phase<pg8::EpiResid, StaticOrder, true, true>(lds, g, S, E);
        }
        if (ph + 1 < a.ph_hi) { __syncthreads(); grid.sync(); }
    }
}

extern "C" void kernel_launch(void* const* d_in, const int* in_sizes, int n_in, void* d_out, int out_size, void* d_ws, size_t ws_size, hipStream_t stream) {
    static int grid = 0;
    if (grid == 0) {
        if (n_in != 35 || ws_size < WS_END) { fprintf(stderr, "kernel_launch: unexpected n_in %d / ws %zu\n", n_in, ws_size); grid = -1; return; }
        int dev = 0, cus = 0, per_cu = 0;
        if (hipGetDevice(&dev) != hipSuccess || hipDeviceGetAttribute(&cus, hipDeviceAttributeMultiprocessorCount, dev) != hipSuccess) { grid = -1; return; }
        if (hipFuncSetAttribute((const void*)mega_fwd, hipFuncAttributeMaxDynamicSharedMemorySize, LDS_BYTES) != hipSuccess) { fprintf(stderr, "kernel_launch: hipFuncSetAttribute failed\n"); grid = -1; return; }
        if (hipOccupancyMaxActiveBlocksPerMultiprocessor(&per_cu, (const void*)mega_fwd, 512, LDS_BYTES) != hipSuccess || per_cu < 1) { fprintf(stderr, "kernel_launch: occupancy query says %d\n", per_cu); per_cu = 1; }
        (void)hipGetLastError();
        grid = cus;
    }
    if (grid < 0) return;
    if (hipMemsetAsync((char*)d_ws + WS_MOD, 0, MOD_BYTES, stream) != hipSuccess) { fprintf(stderr, "kernel_launch: memset failed\n"); return; }
    Args a{};
    for (int i = 0; i < 35; ++i) a.in[i] = (const float*)d_in[i];
    a.out = (float*)d_out; a.ws = (unsigned char*)d_ws;
#if defined(MK_PER_PHASE)
    for (int p = 0; p < NPHASE; ++p) { a.ph_lo = p; a.ph_hi = p + 1; void* args[] = {&a};
        hipError_t e = hipLaunchCooperativeKernel((const void*)mega_fwd, dim3(grid), dim3(512), args, LDS_BYTES, stream);
        if (e != hipSuccess) { fprintf(stderr, "launch %d failed: %s\n", p, hipGetErrorString(e)); break; } }
#else
    a.ph_lo = 0; a.ph_hi = NPHASE; void* args[] = {&a};
    hipError_t e = hipLaunchCooperativeKernel((const void*)mega_fwd, dim3(grid), dim3(512), args, LDS_BYTES, stream);
    if (e != hipSuccess) fprintf(stderr, "cooperative launch failed: %s (grid %d)\n", hipGetErrorString(e), grid);
#endif
}
```

```cpp
#include <hip/hip_runtime.h>
#include <hip/hip_cooperative_groups.h>
#include <cstdio>
#include <cstdint>
namespace cg = cooperative_groups;
namespace pg8 {
#define PG8_LAS __attribute__((address_space(3)))
typedef unsigned short bf16_t;
typedef short bf16x8 __attribute__((ext_vector_type(8)));
typedef float f32x4 __attribute__((ext_vector_type(4)));
typedef unsigned u32x4 __attribute__((ext_vector_type(4)));
constexpr int BM = 256, BK = 64, HALF = 128, HTB = HALF * BK * 2  , STAGE_BYTES = 8 * HTB, NXCD = 8, WGM = 8;

__host__ __device__ __forceinline__ int lds_byte(int r, int c) { const int st = (r >> 4) * 2 + (c >> 5), rr = r & 15, cc = c & 31, ob = rr * 64 + cc * 2; return st * 1024 + (ob ^ (((ob >> 9) & 1) << 5)); }
__host__ __device__ __forceinline__ void stage_rc(int b, int& R, int& C) { const int st = b / 1024, sb = b % 1024, swz = sb ^ (((sb >> 9) & 1) << 5); R = (st >> 1) * 16 + swz / 64; C = (st & 1) * 32 + (swz % 64) / 2; }
__host__ __device__ __forceinline__ int perm32(int rho) { const int n = rho >> 4, i = rho & 15; return 8 * (i >> 2) + 4 * n + (i & 3); }

struct Unit { int pm, pn; };
struct Gemm { const bf16_t* A; const bf16_t* Bt; int M, N, K, lda, ldb; };

struct StaticOrder {
    int nM, nN, nwg, G, c;
    __host__ __device__ void init(int M, int N, int G_, int c_) { nM = M / BM; nN = N / BM; nwg = nM * nN; G = G_; c = c_; }
    __host__ __device__ bool next(int i, Unit& u) const {
        const long L = (long)i * G + c; if (L >= nwg) return false;
        int wgid = (int)L; { const int q = nwg / NXCD, r = nwg % NXCD, xcd = wgid % NXCD, off = wgid / NXCD; wgid = (xcd < r ? xcd * (q + 1) : r * (q + 1) + (xcd - r) * q) + off; }
        const int nig = WGM * nN, gid = wgid / nig, fm = gid * WGM, gsz = (nM - fm) < WGM ? (nM - fm) : WGM;
        u.pm = fm + ((wgid % nig) % gsz); u.pn = (wgid % nig) / gsz; return true;
    }
    __device__ __forceinline__ void a_ready(const Unit&) const {}
    __device__ __forceinline__ void done(const Unit&) const {}
};

__device__ __forceinline__ unsigned cvt_pk_bf16(float lo, float hi) { unsigned r; asm volatile("v_cvt_pk_bf16_f32 %0, %1, %2" : "=v"(r) : "v"(lo), "v"(hi)); return r; }
__device__ __forceinline__ float sigm(float x) { return 1.f / (1.f + __expf(-x)); }
#define EPI_FOR _Pragma("unroll") for (int ai = 0; ai < 2; ++ai) _Pragma("unroll") for (int m = 0; m < 4; ++m) _Pragma("unroll") for (int bj = 0; bj < 2; ++bj)

template <int ACT  > struct EpiStore {
    static constexpr bool PERM = true, AFTER_DRAIN = false;
    bf16_t* O; int ld;
    __device__ __forceinline__ void operator()(const f32x4 (&acc)[2][2][4][2], const Unit& u, int wr, int wc, int fr, int fq) const {
        const int row0 = u.pm * BM + wr * 64 + fr, col0 = u.pn * BM + wc * 32 + 8 * fq;
        EPI_FOR { f32x4 v0 = acc[ai][bj][m][0], v1 = acc[ai][bj][m][1];
            if (ACT == 1) { v0 = (f32x4){sigm(v0[0]), sigm(v0[1]), sigm(v0[2]), sigm(v0[3])}; v1 = (f32x4){sigm(v1[0]), sigm(v1[1]), sigm(v1[2]), sigm(v1[3])}; }
            u32x4 w; w.x = cvt_pk_bf16(v0[0], v0[1]); w.y = cvt_pk_bf16(v0[2], v0[3]); w.z = cvt_pk_bf16(v1[0], v1[1]); w.w = cvt_pk_bf16(v1[2], v1[3]);
            *(u32x4*)(O + (size_t)(row0 + ai * HALF + m * 16) * ld + col0 + bj * HALF) = w; }
    }
};
struct EpiSeg {
    static constexpr bool PERM = true, AFTER_DRAIN = false;
    bf16_t *QA, *KV, *CQ, *CKV, *HY;
    __device__ __forceinline__ void operator()(const f32x4 (&acc)[2][2][4][2], const Unit& u, int wr, int wc, int fr, int fq) const {
        bf16_t* base; int ld, coff; const int pn = u.pn;
        if (pn < 2) { base = QA; ld = 512; coff = 256 * pn; } else if (pn == 2) { base = KV; ld = 256; coff = 0; } else if (pn < 5) { base = CQ; ld = 512; coff = 256 * (pn - 3); }
        else if (pn == 5) { base = CKV; ld = 256; coff = 0; } else { base = HY; ld = 1536; coff = 256 * (pn - 6); }
        const int row0 = u.pm * BM + wr * 64 + fr, col0 = coff + wc * 32 + 8 * fq;
        EPI_FOR { const f32x4 v0 = acc[ai][bj][m][0], v1 = acc[ai][bj][m][1];
            u32x4 w; w.x = cvt_pk_bf16(v0[0], v0[1]); w.y = cvt_pk_bf16(v0[2], v0[3]); w.z = cvt_pk_bf16(v1[0], v1[1]); w.w = cvt_pk_bf16(v1[2], v1[3]);
            *(u32x4*)(base + (size_t)(row0 + ai * HALF + m * 16) * ld + col0 + bj * HALF) = w; }
    }
};
template <int MODE  > struct EpiMerge {
    static constexpr bool PERM = true, AFTER_DRAIN = false;
    const bf16_t* S; float* Macc; bf16_t* Mbf;
    __device__ __forceinline__ void operator()(const f32x4 (&acc)[2][2][4][2], const Unit& u, int wr, int wc, int fr, int fq) const {
        const int row0 = u.pm * BM + wr * 64 + fr, col0 = u.pn * BM + wc * 32 + 8 * fq;
        EPI_FOR { const size_t off = (size_t)(row0 + ai * HALF + m * 16) * 1024 + col0 + bj * HALF;
            const u32x4 sw = *(const u32x4*)(S + off);
            f32x4 s0 = (f32x4){__uint_as_float(sw.x << 16), __uint_as_float(sw.x & 0xffff0000u), __uint_as_float(sw.y << 16), __uint_as_float(sw.y & 0xffff0000u)};
            f32x4 s1 = (f32x4){__uint_as_float(sw.z << 16), __uint_as_float(sw.z & 0xffff0000u), __uint_as_float(sw.w << 16), __uint_as_float(sw.w & 0xffff0000u)};
            f32x4 v0 = acc[ai][bj][m][0] * s0, v1 = acc[ai][bj][m][1] * s1;
            if (MODE >= 1) { v0 = v0 + *(const f32x4*)(Macc + off); v1 = v1 + *(const f32x4*)(Macc + off + 4); }
            if (MODE <= 1) { *(f32x4*)(Macc + off) = v0; *(f32x4*)(Macc + off + 4) = v1; }
            else { u32x4 w; w.x = cvt_pk_bf16(v0[0], v0[1]); w.y = cvt_pk_bf16(v0[2], v0[3]); w.z = cvt_pk_bf16(v1[0], v1[1]); w.w = cvt_pk_bf16(v1[2], v1[3]); *(u32x4*)(Mbf + off) = w; } }
    }
};
struct EpiResid {
    static constexpr bool PERM = true, AFTER_DRAIN = false;
    float* X; const float* gate;
    __device__ __forceinline__ void operator()(const f32x4 (&acc)[2][2][4][2], const Unit& u, int wr, int wc, int fr, int fq) const {
        const int row0 = u.pm * BM + wr * 64 + fr, col0 = u.pn * BM + wc * 32 + 8 * fq;
        const int mrow = (u.pm < 16) ? 0 : 1 + ((u.pm - 16) >> 3);
        const float* gp = gate + (size_t)mrow * 6144 + col0;
        f32x4 g[2][2];
#pragma unroll
        for (int bj = 0; bj < 2; ++bj) { g[bj][0] = *(const f32x4*)(gp + bj * HALF); g[bj][1] = *(const f32x4*)(gp + bj * HALF + 4); }
        EPI_FOR { float* xp = X + (size_t)(row0 + ai * HALF + m * 16) * 1024 + col0 + bj * HALF;
            const f32x4 x0 = *(const f32x4*)xp, x1 = *(const f32x4*)(xp + 4);
            *(f32x4*)xp = x0 + g[bj][0] * acc[ai][bj][m][0]; *(f32x4*)(xp + 4) = x1 + g[bj][1] * acc[ai][bj][m][1]; }
    }
};

template <class Epi, class Sched, bool ALIGN_EPI = false, bool SP2 = false>
__device__ __forceinline__ void gemm_phase(PG8_LAS unsigned char* lds, const Gemm g, const Sched& S, const Epi& E) {
    int tid_l = threadIdx.x; asm volatile("" : "+v"(tid_l));
    const int tid = tid_l, wid = __builtin_amdgcn_readfirstlane(tid >> 6), lane = tid & 63, wr = wid >> 2, wc = wid & 3, fr = lane & 15, fq = lane >> 4;
    const int K = g.K, nt = K / BK;
    unsigned voffA[2], voffB[2];
#pragma unroll
    for (int i = 0; i < 2; ++i) { int R, C; stage_rc(tid * 16 + i * 8192, R, C); const int Rb = Epi::PERM ? ((R & ~31) + perm32(R & 31)) : R;
        voffA[i] = (unsigned)(R * g.lda + C) * 2u; voffB[i] = (unsigned)(Rb * g.ldb + C) * 2u; }
    const size_t kstep = (size_t)(BK * 2);
    const size_t hstepA = (size_t)HALF * g.lda * 2, hstepB = (size_t)HALF * g.ldb * 2;
    const size_t tstepA = 2 * hstepA, tstepB = 2 * hstepB;
    const unsigned ldsw = (unsigned)wid * 1024u;
    const int aoff = lds_byte(wr * 64 + fr, fq * 8), boff = lds_byte(wc * 32 + fr, fq * 8);
#define PG8_SA(b, h) (((b) * 2 + (h)) * HTB)
#define PG8_SB(b, h) ((4 + (b) * 2 + (h)) * HTB)
#define PG8_STAGE(bufoff, gbase, voff) do { _Pragma("unroll") for (int _i = 0; _i < 2; ++_i) \
        __builtin_amdgcn_global_load_lds((const unsigned*)((const char*)(gbase) + (voff)[_i]), (PG8_LAS unsigned*)(lds + (bufoff) + ldsw + _i * 8192), 16, 0, 0); } while (0)
#define PG8_LDA(dst, b, h) do { _Pragma("unroll") for (int m = 0; m < 4; ++m) _Pragma("unroll") for (int k = 0; k < 2; ++k) dst[m][k] = *(const PG8_LAS bf16x8*)(lds + PG8_SA(b, h) + aoff + m * 2048 + k * 1024); } while (0)
#define PG8_LDB(dst, b, h) do { _Pragma("unroll") for (int n = 0; n < 2; ++n) _Pragma("unroll") for (int k = 0; k < 2; ++k) dst[n][k] = *(const PG8_LAS bf16x8*)(lds + PG8_SB(b, h) + boff + n * 2048 + k * 1024); } while (0)
#define PG8_MMA(ai, bj, At, Bt) do { __builtin_amdgcn_s_setprio(1); _Pragma("unroll") for (int m = 0; m < 4; ++m) _Pragma("unroll") for (int n = 0; n < 2; ++n) _Pragma("unroll") for (int k = 0; k < 2; ++k) \
        acc[ai][bj][m][n] = __builtin_amdgcn_mfma_f32_16x16x32_bf16(Bt[n][k], At[m][k], acc[ai][bj][m][n], 0, 0, 0); __builtin_amdgcn_s_setprio(0); } while (0)
#define PG8_WAIT_V(n) asm volatile("s_waitcnt vmcnt(" #n ")" ::: "memory")
#define PG8_WAIT_L(n) asm volatile("s_waitcnt lgkmcnt(" #n ")" ::: "memory")
#define PG8_BAR __builtin_amdgcn_s_barrier()
#define PG8_SCHED __builtin_amdgcn_sched_barrier(0)
    Unit cur, nxt; int ui = 0;
    if (!S.next(0, cur)) return;
    f32x4 acc[2][2][4][2];
#pragma unroll
    for (int a = 0; a < 2; ++a)
#pragma unroll
        for (int b = 0; b < 2; ++b)
#pragma unroll
            for (int m = 0; m < 4; ++m)
#pragma unroll
                for (int n = 0; n < 2; ++n) acc[a][b][m][n] = (f32x4){0.f, 0.f, 0.f, 0.f};
    bf16x8 At[4][2], B0[2][2], B1[2][2];
    const char* cA = (const char*)g.A + (size_t)cur.pm * tstepA; const char* cB = (const char*)g.Bt + (size_t)cur.pn * tstepB;
    S.a_ready(cur);
    if constexpr (SP2) {
        PG8_STAGE(PG8_SB(0, 0), cB, voffB); PG8_STAGE(PG8_SB(0, 1), cB + hstepB, voffB); PG8_STAGE(PG8_SA(0, 0), cA, voffA); PG8_STAGE(PG8_SA(0, 1), cA + hstepA, voffA);
        if (wr == 1) PG8_BAR;
        PG8_WAIT_V(2); PG8_BAR;
        PG8_STAGE(PG8_SB(1, 0), cB + kstep, voffB); PG8_STAGE(PG8_SA(1, 0), cA + kstep, voffA); PG8_STAGE(PG8_SB(1, 1), cB + hstepB + kstep, voffB);
        PG8_WAIT_V(6); PG8_BAR;
    } else {
        PG8_STAGE(PG8_SB(0, 0), cB, voffB); PG8_STAGE(PG8_SA(0, 0), cA, voffA); PG8_STAGE(PG8_SB(0, 1), cB + hstepB, voffB); PG8_STAGE(PG8_SA(0, 1), cA + hstepA, voffA);
        if (wr == 1) PG8_BAR;
        PG8_WAIT_V(4); PG8_BAR;
        PG8_STAGE(PG8_SB(1, 0), cB + kstep, voffB); PG8_STAGE(PG8_SA(1, 0), cA + kstep, voffA); PG8_STAGE(PG8_SB(1, 1), cB + hstepB + kstep, voffB);
        PG8_WAIT_V(6); PG8_BAR;
    }
    for (;;) {
        const bool has_next = S.next(ui + 1, nxt);
        const char* nA = has_next ? (const char*)g.A + (size_t)nxt.pm * tstepA : cA; const char* nB = has_next ? (const char*)g.Bt + (size_t)nxt.pn * tstepB : cB;
        for (int t = 0; t < nt; t += 2) {
            const bool last = (t == nt - 2);
            const char* a1 = cA + (size_t)(t + 1) * kstep;
            const char* a2 = last ? nA : cA + (size_t)(t + 2) * kstep; const char* b2 = last ? nB : cB + (size_t)(t + 2) * kstep;
            const char* a3 = a2 + kstep; const char* b3 = b2 + kstep;
            if (last && has_next) S.a_ready(nxt);
            if constexpr (SP2) {
            PG8_LDB(B0, 0, 0); PG8_LDB(B1, 0, 1); PG8_SCHED; PG8_LDA(At, 0, 0); PG8_STAGE(PG8_SA(1, 1), a1 + hstepA, voffA);
            PG8_WAIT_V(8); PG8_WAIT_L(0); PG8_BAR; PG8_MMA(0, 0, At, B0); PG8_MMA(0, 1, At, B1); PG8_BAR; PG8_SCHED;
            PG8_LDA(At, 0, 1); PG8_STAGE(PG8_SB(0, 0), b2, voffB); PG8_STAGE(PG8_SB(0, 1), b2 + hstepB, voffB); PG8_STAGE(PG8_SA(0, 0), a2, voffA);
            PG8_WAIT_V(8); PG8_WAIT_L(0); PG8_BAR; PG8_MMA(1, 0, At, B0); PG8_MMA(1, 1, At, B1); PG8_BAR; PG8_SCHED;
            PG8_LDB(B0, 1, 0); PG8_LDB(B1, 1, 1); PG8_SCHED; PG8_LDA(At, 1, 0); PG8_STAGE(PG8_SA(0, 1), a2 + hstepA, voffA);
            PG8_WAIT_V(8); PG8_WAIT_L(0); PG8_BAR; PG8_MMA(0, 0, At, B0); PG8_MMA(0, 1, At, B1); PG8_BAR; PG8_SCHED;
            PG8_LDA(At, 1, 1); PG8_STAGE(PG8_SB(1, 0), b3, voffB); PG8_STAGE(PG8_SB(1, 1), b3 + hstepB, voffB); PG8_STAGE(PG8_SA(1, 0), a3, voffA);
            PG8_WAIT_V(8); PG8_WAIT_L(0); PG8_BAR; PG8_MMA(1, 0, At, B0); PG8_MMA(1, 1, At, B1); PG8_BAR; PG8_SCHED;
            } else {
            PG8_LDB(B0, 0, 0); PG8_SCHED; PG8_LDA(At, 0, 0); PG8_STAGE(PG8_SA(1, 1), a1 + hstepA, voffA);
            PG8_WAIT_L(8); PG8_BAR; PG8_WAIT_L(0); PG8_MMA(0, 0, At, B0); PG8_BAR; PG8_SCHED;
            PG8_LDB(B1, 0, 1); PG8_STAGE(PG8_SB(0, 0), b2, voffB);
            PG8_BAR; PG8_WAIT_L(0); PG8_MMA(0, 1, At, B1); PG8_BAR;
            PG8_LDA(At, 0, 1); PG8_STAGE(PG8_SA(0, 0), a2, voffA);
            PG8_BAR; PG8_WAIT_L(0); PG8_MMA(1, 0, At, B0); PG8_BAR; PG8_SCHED;
            PG8_STAGE(PG8_SB(0, 1), b2 + hstepB, voffB);
            PG8_WAIT_V(6); PG8_BAR; PG8_MMA(1, 1, At, B1); PG8_BAR;
            PG8_LDB(B0, 1, 0); PG8_SCHED; PG8_LDA(At, 1, 0); PG8_STAGE(PG8_SA(0, 1), a2 + hstepA, voffA);
            PG8_WAIT_L(8); PG8_BAR; PG8_WAIT_L(0); PG8_MMA(0, 0, At, B0); PG8_BAR; PG8_SCHED;
            PG8_LDB(B1, 1, 1); PG8_STAGE(PG8_SB(1, 0), b3, voffB);
            PG8_BAR; PG8_WAIT_L(0); PG8_MMA(0, 1, At, B1); PG8_BAR;
            PG8_LDA(At, 1, 1); PG8_STAGE(PG8_SA(1, 0), a3, voffA);
            PG8_BAR; PG8_WAIT_L(0); PG8_MMA(1, 0, At, B0); PG8_BAR; PG8_SCHED;
            PG8_STAGE(PG8_SB(1, 1), b3 + hstepB, voffB);
            PG8_WAIT_V(6); PG8_BAR; PG8_MMA(1, 1, At, B1); PG8_BAR;
            }
        }
        if constexpr (ALIGN_EPI) { if (wr == 0) PG8_BAR; }
        if constexpr (!Epi::AFTER_DRAIN) { E(acc, cur, wr, wc, fr, fq); S.done(cur); }
        if (!has_next) break;
#pragma unroll
        for (int a = 0; a < 2; ++a)
#pragma unroll
            for (int b = 0; b < 2; ++b)
#pragma unroll
                for (int m = 0; m < 4; ++m)
#pragma unroll
                    for (int n = 0; n < 2; ++n) acc[a][b][m][n] = (f32x4){0.f, 0.f, 0.f, 0.f};
        cur = nxt; cA = nA; cB = nB; ++ui;
        if constexpr (ALIGN_EPI) { if (wr == 1) PG8_BAR; }
    }
    PG8_WAIT_V(0);
    if constexpr (!ALIGN_EPI) { if (wr == 0) PG8_BAR; }
    PG8_BAR;
    if constexpr (Epi::AFTER_DRAIN) { E.fused(acc, cur, wr, wc, fr, fq, lds, wid, lane); S.done(cur); }
#undef PG8_SA
#undef PG8_SB
#undef PG8_STAGE
#undef PG8_LDA
#undef PG8_LDB
#undef PG8_MMA
#undef PG8_WAIT_V
#undef PG8_WAIT_L
#undef PG8_BAR
#undef PG8_SCHED
}
}

constexpr int TCTX = 4096, TLAT = 8192, TT = 12288, DM = 1024, NKEYROWS = 13312;
constexpr float EPSN = 1e-6f;
constexpr size_t MiB = 1u << 20;
constexpr size_t WS_MOD = 0, MOD_BYTES = 2 * 5 * 6144 * 4, WS_BAR = 262144, BAR_REGION = 16384, ZERO_BYTES = WS_BAR + 5 * BAR_REGION;
constexpr size_t WS_HID = 1 * MiB;
constexpr size_t WS_WIN = 3 * MiB, WS_WG = 9 * MiB, WS_WUQ = 15 * MiB, WS_WKN = 16 * MiB, WS_WVV = 16 * MiB + 262144, WS_WB = 17 * MiB, WS_WO = 20 * MiB, WS_WUP = 22 * MiB, WS_WDN = 33 * MiB;
constexpr size_t WS_U = 39 * MiB, WS_ACT = 171 * MiB, WS_HBF = 171 * MiB;
constexpr size_t WS_QA = 39 * MiB, WS_KVR = 51 * MiB, WS_CQ = 57 * MiB, WS_CKVR = 69 * MiB, WS_HYR = 75 * MiB, WS_OA = 75 * MiB, WS_OB = 87 * MiB, WS_OC = 99 * MiB;
constexpr size_t WS_UT = 111 * MiB, WS_QB = 147 * MiB, WS_CKVALL = 195 * MiB, WS_KPEALL = 202 * MiB, WS_KNB = 203 * MiB, WS_VTB = 216 * MiB, WS_KA = 229 * MiB, WS_VTA = 233 * MiB;
constexpr size_t WS_S = 111 * MiB, WS_MBF = 135 * MiB, WS_MACC = 195 * MiB, WS_END = 256 * MiB;
constexpr int KA_LAT = 16 * 2 * 256 * 64;
constexpr int UT_LAT = 16 * 1536 * 256;
constexpr int OUT_K = 12582912, OUT_V = 13631488, OUT_CKV = 14680064, OUT_KPE = 16777216;
constexpr int LDS_BYTES = 147456;
constexpr int NPHASE = 24;

#define GAS __attribute__((address_space(1)))
#define LAS __attribute__((address_space(3)))
typedef unsigned short bf16;
typedef unsigned v4u __attribute__((ext_vector_type(4)));
typedef unsigned v2u __attribute__((ext_vector_type(2)));
typedef float f32x4 __attribute__((ext_vector_type(4)));
typedef float f32x16 __attribute__((ext_vector_type(16)));
typedef short bf16x8 __attribute__((ext_vector_type(8)));
typedef short bf16x4 __attribute__((ext_vector_type(4)));
#define LDS_WAIT() asm volatile("s_waitcnt lgkmcnt(0)" ::: "memory")
__device__ __forceinline__ unsigned f2bf(float f) { unsigned u = __builtin_bit_cast(unsigned, f); return (u + 0x7fffu + ((u >> 16) & 1u)) >> 16; }
__device__ __forceinline__ unsigned pk2(float lo, float hi) { return f2bf(lo) | (f2bf(hi) << 16); }
__device__ __forceinline__ float bflo(unsigned w) { return __uint_as_float(w << 16); }
__device__ __forceinline__ float bfhi(unsigned w) { return __uint_as_float(w & 0xffff0000u); }
__device__ __forceinline__ float bf1(bf16 b) { return __uint_as_float(((unsigned)b) << 16); }
__device__ __forceinline__ void fsincos(float x, float& s, float& c) { float rev = x * 0.15915494309189535f; rev = rev - rintf(rev); s = __builtin_amdgcn_sinf(rev); c = __builtin_amdgcn_cosf(rev); }
__device__ __forceinline__ float fsin(float x) { float rev = x * 0.15915494309189535f; rev = rev - rintf(rev); return __builtin_amdgcn_sinf(rev); }
__device__ __forceinline__ float wave_sum(float v) {
#pragma unroll
    for (int o = 1; o < 64; o <<= 1) v += __shfl_xor(v, o);
    return v;
}
__device__ __forceinline__ void rope2(float& x0, float& x1, float ang) { float s, c; fsincos(ang, s, c); const float a = x0 * c - x1 * s, b = x0 * s + x1 * c; x0 = a; x1 = b; }
#define L2_10000 13.287712379549449f

__device__ __forceinline__ void transpose_item(const float* W, size_t ldw, int k0, int n0, bf16* WT, size_t ldt, int drow0, LAS float* scr, int lane) {
#pragma unroll 8
    for (int i = 0; i < 32; ++i) { const int kk = 2 * i + (lane >> 5); scr[kk * 33 + (lane & 31)] = W[(size_t)(k0 + kk) * ldw + n0 + (lane & 31)]; }
    LDS_WAIT(); asm volatile("" ::: "memory");
    const int c = lane & 7;
#pragma unroll
    for (int j = 0; j < 4; ++j) { const int n = (lane >> 3) + 8 * j; const LAS float* s = scr + (8 * c) * 33 + n;
        v4u o; o.x = pk2(s[0 * 33], s[1 * 33]); o.y = pk2(s[2 * 33], s[3 * 33]); o.z = pk2(s[4 * 33], s[5 * 33]); o.w = pk2(s[6 * 33], s[7 * 33]);
        *(v4u*)(WT + (size_t)(drow0 + n) * ldt + k0 + 8 * c) = o; }
    LDS_WAIT(); asm volatile("" ::: "memory");
}

#define XB_TMO      128
#define XB_XCNT(j)  (256  + 64 * (j))
#define XB_XSUB(j)  (1280 + 64 * (j))
#define XB_XGEN(j)  (2304 + 64 * (j))
#define XB_TOP      3328
#define XB_TOPGEN   3392
#define XCD_BAR_WORDS 3456
#define XB_SPIN_CAP (1u << 18)

__device__ __forceinline__ unsigned xb_ld(unsigned* p)              { return __hip_atomic_load(p, __ATOMIC_RELAXED, __HIP_MEMORY_SCOPE_AGENT); }
__device__ __forceinline__ unsigned xb_add(unsigned* p, unsigned v) { return __hip_atomic_fetch_add(p, v, __ATOMIC_RELAXED, __HIP_MEMORY_SCOPE_AGENT); }
__device__ __forceinline__ unsigned xb_xcc_id() { return (unsigned)__builtin_amdgcn_s_getreg((3 << 11) | 20) & 0xFu; }
#define XB_SPIN(cond, bar) do { unsigned _sp = 0; while (cond) { __builtin_amdgcn_s_sleep(1); \
    if ((++_sp & 255u) == 0u) { if (xb_ld(&(bar)[XB_TMO])) break; if (_sp > XB_SPIN_CAP) { atomicAdd(&(bar)[XB_TMO], 1u); break; } } } } while (0)

struct XcdBarrier {
    unsigned* bar; unsigned x;
    volatile LAS unsigned* st;
};

__device__ __forceinline__ XcdBarrier xcd_barrier_post(unsigned* bar, volatile LAS unsigned* st) {
    XcdBarrier b; b.bar = bar; b.x = xb_xcc_id(); b.st = st;
    if (threadIdx.x == 0) (void)xb_add(&bar[XB_XCNT(b.x)], 1u);
    return b;
}
__device__ __forceinline__ void xcd_barrier_complete(unsigned* bar, unsigned x, unsigned& nloc, unsigned& nx) {
    const unsigned G = gridDim.x * gridDim.y * gridDim.z;
    unsigned sum, cnt, mine, sp = 0u;
    for (;;) {
        sum = 0u; cnt = 0u; mine = 0u;
#pragma unroll
        for (unsigned j = 0; j < 16; ++j) { const unsigned c = xb_ld(&bar[XB_XCNT(j)]); sum += c; cnt += (c > 0u) ? 1u : 0u; mine = (j == x) ? c : mine; }
        if (sum == G) break;
        __builtin_amdgcn_s_sleep(1);
        if ((++sp & 255u) == 0u) { if (xb_ld(&bar[XB_TMO])) break; if (sp > XB_SPIN_CAP) { atomicAdd(&bar[XB_TMO], 1u); break; } }
    }
    nloc = mine > 0u ? mine : 1u; nx = cnt > 0u ? cnt : 1u;
}

__device__ __forceinline__ void xcd_barrier(const XcdBarrier& b) {
    asm volatile("s_waitcnt vmcnt(0)" ::: "memory");
    __syncthreads();
    if (threadIdx.x == 0) {
        unsigned* bar = b.bar;
        __builtin_amdgcn_s_waitcnt(0);
        unsigned nloc = b.st[0], nx = b.st[1];
        if (nloc == 0u) { xcd_barrier_complete(bar, b.x, nloc, nx); b.st[0] = nloc; b.st[1] = nx; }
        const unsigned old = xb_add(&bar[XB_XSUB(b.x)], 1u);
        const unsigned gen = old / nloc;
        if (old + 1u == (gen + 1u) * nloc) {
            __builtin_amdgcn_fence(__ATOMIC_RELEASE, "agent");
            asm volatile("s_waitcnt vmcnt(0)" ::: "memory");
            const unsigned og = xb_add(&bar[XB_TOP], 1u);
            const unsigned tg = og / nx;
            if (og + 1u == (tg + 1u) * nx) xb_add(&bar[XB_TOPGEN], 1u);
            else XB_SPIN(xb_ld(&bar[XB_TOPGEN]) == tg, bar);
            __builtin_amdgcn_fence(__ATOMIC_ACQUIRE, "agent");
            xb_add(&bar[XB_XGEN(b.x)], 1u);
            asm volatile("s_waitcnt vmcnt(0)" ::: "memory");
        } else {
            XB_SPIN(xb_ld(&bar[XB_XGEN(b.x)]) == gen, bar);
            __builtin_amdgcn_fence(__ATOMIC_ACQUIRE, "agent");
            asm volatile("s_waitcnt vmcnt(0)" ::: "memory");
        }
    }
    __syncthreads();
}


struct Args { const float* in[35]; float* out; unsigned char* ws; int ph_lo, ph_hi, li, pad; };

__device__ __forceinline__ void wconv_phase(const Args& a, int l, LAS unsigned char* lds, int gw, int NGW, int gt, int NGT, int wave, int lane) {
    LAS float* scr = (LAS float*)(lds + wave * 16384);
    unsigned char* ws = a.ws;
    bf16 *WIN = (bf16*)(ws + WS_WIN), *WG = (bf16*)(ws + WS_WG), *WUQ = (bf16*)(ws + WS_WUQ), *WKN = (bf16*)(ws + WS_WKN), *WVV = (bf16*)(ws + WS_WVV), *WB = (bf16*)(ws + WS_WB), *WO = (bf16*)(ws + WS_WO), *WUP = (bf16*)(ws + WS_WUP), *WDN = (bf16*)(ws + WS_WDN);
    constexpr int I1 = 16 * 189, I2 = 6 * 24, I3 = 4 * 32, I4 = 3 * 8 * 32, I5 = 16 * 32, I6 = 16 * 176, I7 = 44 * 32, NIT = I1 + I2 + I3 + I4 + I5 + I6 + I7;
    for (int it = gw; it < NIT; it += NGW) {
        int r = it;
        if (r < I1) { const int kb = r / 189, n0 = 32 * (r % 189); bf16* dst = WIN; int drow;
            if (n0 < 1152) drow = n0; else if (n0 < 1408) drow = n0 + 128; else if (n0 < 1440) drow = 1152 + (n0 - 1408); else if (n0 < 2976) drow = 1536 + (n0 - 1440); else { dst = WG; drow = n0 - 2976; }
            transpose_item(a.in[12] + (size_t)l * 1024 * 6048, 6048, 64 * kb, n0, dst, 1024, drow, scr, lane); continue; } r -= I1;
        if (r < I2) { const int kb = r / 24, n0 = 32 * (r % 24); transpose_item(a.in[17] + (size_t)l * 384 * 768, 768, 64 * kb, n0, WUQ, 384, n0, scr, lane); continue; } r -= I2;
        if (r < I3) { const int kb = r / 32, n0 = 32 * (r % 32); const int h = n0 >> 7, c0 = n0 & 127;
            transpose_item(a.in[18] + (size_t)l * 256 * 1024, 1024, 64 * kb, n0, (c0 < 64) ? WKN : WVV, 256, h * 64 + (c0 & 63), scr, lane); continue; } r -= I3;
        if (r < I4) { const int n = r / 256, q = r % 256, kb = q / 32, n0 = 32 * (q % 32);
            transpose_item(a.in[28] + ((size_t)l * 3 + n) * 512 * 1024, 1024, 64 * kb, n0, WB + (size_t)n * 1024 * 512, 512, n0, scr, lane); continue; } r -= I4;
        if (r < I5) { const int kb = r / 32, n0 = 32 * (r % 32); transpose_item(a.in[29] + (size_t)l * 1024 * 1024, 1024, 64 * kb, n0, WO, 1024, n0, scr, lane); continue; } r -= I5;
        if (r < I6) { const int kb = r / 176, n0 = 32 * (r % 176); transpose_item(a.in[30] + (size_t)l * 1024 * 5632, 5632, 64 * kb, n0, WUP, 1024, n0, scr, lane); continue; } r -= I6;
        { const int kb = r / 32, n0 = 32 * (r % 32); transpose_item(a.in[33] + (size_t)l * 2816 * 1024, 1024, 64 * kb, n0, WDN, 2816, n0, scr, lane); }
    }
    for (int i = gt; i < 96 * 1024 / 8; i += NGT) *(v4u*)(WIN + (size_t)1184 * 1024 + (size_t)i * 8) = (v4u){0u, 0u, 0u, 0u};
}

__device__ __forceinline__ void norm_phase(const Args& a, int l, int which, bool first, int gw, int NGW, int lane) {
    const float* mod = (const float*)(a.ws + WS_MOD) + (size_t)l * 5 * 6144;
    bf16* HBF = (bf16*)(a.ws + WS_HBF);
    const float* gv = (which == 0) ? a.in[10] + l * 1024 : (which == 1) ? a.in[11] + l * 1024 : a.in[34];
    const int shoff = (which == 0) ? 0 : 3072, scoff = shoff + 1024;
    for (int row = gw; row < TT; row += NGW) {
        const float* src = first ? (row < TCTX ? a.in[0] + (size_t)row * DM : a.in[1] + (size_t)(row - TCTX) * DM) : a.out + (size_t)row * DM;
        f32x4 v[4]; float ss = 0.f;
#pragma unroll
        for (int j = 0; j < 4; ++j) { v[j] = *(const f32x4*)(src + 4 * lane + 256 * j); ss += (v[j].x * v[j].x + v[j].y * v[j].y) + (v[j].z * v[j].z + v[j].w * v[j].w); }
        if (first) {
#pragma unroll
            for (int j = 0; j < 4; ++j) *(f32x4*)(a.out + (size_t)row * DM + 4 * lane + 256 * j) = v[j]; }
        const float rs = rsqrtf(wave_sum(ss) * (1.f / DM) + EPSN);
        const int mrow = row < TCTX ? 0 : 1 + ((row - TCTX) >> 11);
        const float* mp = mod + (size_t)mrow * 6144;
#pragma unroll
        for (int j = 0; j < 4; ++j) { const int col = 4 * lane + 256 * j; const f32x4 g = *(const f32x4*)(gv + col);
            if (which == 2) { *(f32x4*)(a.out + (size_t)row * DM + col) = v[j] * rs * g; }
            else { const f32x4 sc = *(const f32x4*)(mp + scoff + col), sh = *(const f32x4*)(mp + shoff + col);
                const f32x4 y = v[j] * rs * g * (sc + 1.f) + sh;
                *(v2u*)(HBF + (size_t)row * DM + col) = (v2u){pk2(y.x, y.y), pk2(y.z, y.w)}; } }
    }
}
__device__ __forceinline__ void p0_mod_hid(const Args& a, LAS unsigned char* lds, int bid, int G, int tid, int gw, int NGW, int lane) {
    float* mod = (float*)(a.ws + WS_MOD);
    LAS float* sc = (LAS float*)lds;
    for (int it = bid; it < 384; it += G) {
        const int l = it / 192, rem = it % 192, kc = rem / 12, jb = rem % 12;
        if (tid < 320) { const int r = tid >> 6, kk = tid & 63, k = kc * 64 + kk; const float cv = (r == 0) ? a.in[7][k] : a.in[6][(r - 1) * 1024 + k]; sc[tid] = cv / (1.f + __expf(-cv)); }
        __syncthreads();
        const int j = jb * 512 + tid;
        const float* wp = a.in[8] + ((size_t)l * 1024 + kc * 64) * 6144 + j;
        float acc[5] = {0.f, 0.f, 0.f, 0.f, 0.f};
#pragma unroll 8
        for (int kk = 0; kk < 64; ++kk) { const float w = wp[(size_t)kk * 6144];
#pragma unroll
            for (int r = 0; r < 5; ++r) acc[r] += sc[r * 64 + kk] * w; }
        const float bias = (kc == 0) ? a.in[9][l * 6144 + j] : 0.f;
#pragma unroll
        for (int r = 0; r < 5; ++r) atomicAdd(mod + (size_t)(l * 5 + r) * 6144 + j, acc[r] + bias);
        __syncthreads();
    }
    float* HID = (float*)(a.ws + WS_HID);
    for (int it = gw; it < 2 * 2304; it += NGW) {
        const int l = it / 2304, q = it % 2304; const int L = q < 256 ? 256 : 2048, t = q < 256 ? q : q - 256;
        const float tn = (float)t / (float)(L - 1);
        float zi = 0.f;
        if (lane == 0) zi = tn;
        else if (lane <= 16) { const int bi = (lane - 1) & 7; const float band = 1e-4f + (float)bi * ((7.f - 1e-4f) / 7.f); const float ang = (6.283185307179586f / (float)L) * (float)t * band; float s, c; fsincos(ang, s, c); zi = (lane <= 8) ? c : -s; }
        float s1 = a.in[22][l * 64 + lane];
#pragma unroll
        for (int i = 0; i < 17; ++i) s1 += __shfl(zi, i) * a.in[21][(l * 17 + i) * 64 + lane];
        const float h1 = fsin(a.in[26][(l * 2 + 0) * 64 + lane] * s1);
        float s2 = a.in[24][l * 64 + lane];
#pragma unroll 8
        for (int i = 0; i < 64; ++i) s2 += __shfl(h1, i) * a.in[23][(l * 64 + i) * 64 + lane];
        HID[(size_t)it * 64 + lane] = fsin(a.in[26][(l * 2 + 1) * 64 + lane] * s2);
    }
}

__device__ __forceinline__ void post_phase(const Args& a, int l, LAS unsigned char* lds, int bid, int G, int tid, int gw, int NGW, int gt, int NGT, int lane) {
    unsigned char* ws = a.ws;
    bf16 *QA = (bf16*)(ws + WS_QA), *KVR = (bf16*)(ws + WS_KVR), *CQ = (bf16*)(ws + WS_CQ), *CKVR = (bf16*)(ws + WS_CKVR), *HYR = (bf16*)(ws + WS_HYR);
    bf16 *UT = (bf16*)(ws + WS_UT), *CKVALL = (bf16*)(ws + WS_CKVALL), *KPEALL = (bf16*)(ws + WS_KPEALL), *KA = (bf16*)(ws + WS_KA), *VTA = (bf16*)(ws + WS_VTA);
    for (int i = gt; i < 4 * 256 * 128; i += NGT) { const int b = i >> 15, p = (i >> 7) & 255, kvh = (i >> 6) & 1, d = i & 63;
        const size_t s = ((size_t)(b * 2 + l) * 256 + p) * 128 + kvh * 64 + d;
        KA[KA_LAT + ((b * 2 + kvh) * 2304 + p) * 64 + d] = (bf16)f2bf(a.in[2][s]);
        VTA[KA_LAT + ((b * 2 + kvh) * 64 + d) * 2304 + p] = (bf16)f2bf(a.in[3][s]); }
    for (int i = gt; i < 4 * 256 * 256; i += NGT) { const int b = i >> 16, p = (i >> 8) & 255, j = i & 255;
        CKVALL[(size_t)(TCTX + b * 2304 + p) * 256 + j] = (bf16)f2bf(a.in[4][((size_t)(b * 2 + l) * 256 + p) * 256 + j]); }
    for (int i = gt; i < 4 * 256 * 32; i += NGT) { const int b = i >> 13, p = (i >> 5) & 255, j = i & 31;
        KPEALL[(size_t)(TCTX + b * 2304 + p) * 32 + j] = (bf16)f2bf(a.in[5][((size_t)(b * 2 + l) * 256 + p) * 32 + j]); }
    const float *gq = a.in[13] + l * 64, *gk = a.in[14] + l * 64, *gcq = a.in[15] + l * 384, *gkv = a.in[16] + l * 256;
    for (int row = gw; row < TT; row += NGW) {
        const bool lat = row >= TCTX;
        const int b = lat ? (row - TCTX) >> 11 : row >> 8, t = lat ? (row - TCTX) & 2047 : row & 255;
        const float grow = (float)(t >> 6), gcol = (float)(t & 63);
        const int keyrow = lat ? TCTX + b * 2304 + 256 + t : row;
        { v4u w = *(const v4u*)(QA + (size_t)row * 512 + 8 * lane);
          float x[8] = {bflo(w.x), bfhi(w.x), bflo(w.y), bfhi(w.y), bflo(w.z), bfhi(w.z), bflo(w.w), bfhi(w.w)};
          float ss = 0.f;
#pragma unroll
          for (int j = 0; j < 8; ++j) ss += x[j] * x[j];
          ss += __shfl_xor(ss, 1); ss += __shfl_xor(ss, 2); ss += __shfl_xor(ss, 4);
          const float rs = rsqrtf(ss * (1.f / 64.f) + EPSN); const int d0 = 8 * (lane & 7);
#pragma unroll
          for (int j = 0; j < 8; ++j) x[j] = x[j] * rs * gq[d0 + j];
          if (lat) {
#pragma unroll
              for (int k = 0; k < 4; ++k) { const int i = 4 * (lane & 7) + k; const float inv = __builtin_amdgcn_exp2f(-(float)(i & 15) * (L2_10000 / 16.f)); rope2(x[2 * k], x[2 * k + 1], (i < 16 ? grow : gcol) * inv); } }
          *(v4u*)(QA + (size_t)row * 512 + 8 * lane) = (v4u){pk2(x[0], x[1]), pk2(x[2], x[3]), pk2(x[4], x[5]), pk2(x[6], x[7])}; }
        { const v2u w = *(const v2u*)(KVR + (size_t)row * 256 + 4 * lane);
          float x[4] = {bflo(w.x), bfhi(w.x), bflo(w.y), bfhi(w.y)};
          float ss = (x[0] * x[0] + x[1] * x[1]) + (x[2] * x[2] + x[3] * x[3]);
          ss += __shfl_xor(ss, 1); ss += __shfl_xor(ss, 2); ss += __shfl_xor(ss, 4); ss += __shfl_xor(ss, 8);
          const int kvh = (lane >> 4) & 1, d0 = 4 * (lane & 15);
          if (lane < 32) {
              const float rs = rsqrtf(ss * (1.f / 64.f) + EPSN);
#pragma unroll
              for (int j = 0; j < 4; ++j) x[j] = x[j] * rs * gk[d0 + j];
              if (!lat) { *(f32x4*)(a.out + OUT_K + ((size_t)(b * 2 + l) * 256 + t) * 128 + kvh * 64 + d0) = (f32x4){x[0], x[1], x[2], x[3]};
                  *(v2u*)(KA + ((size_t)(b * 2 + kvh) * 256 + t) * 64 + d0) = (v2u){pk2(x[0], x[1]), pk2(x[2], x[3])}; }
              else {
#pragma unroll
                  for (int k = 0; k < 2; ++k) { const int i = 2 * (lane & 15) + k; const float inv = __builtin_amdgcn_exp2f(-(float)(i & 15) * (L2_10000 / 16.f)); rope2(x[2 * k], x[2 * k + 1], (i < 16 ? grow : gcol) * inv); }
                  *(v2u*)(KA + KA_LAT + ((size_t)(b * 2 + kvh) * 2304 + 256 + t) * 64 + d0) = (v2u){pk2(x[0], x[1]), pk2(x[2], x[3])}; }
          } else {
              if (!lat) { *(f32x4*)(a.out + OUT_V + ((size_t)(b * 2 + l) * 256 + t) * 128 + kvh * 64 + d0) = (f32x4){x[0], x[1], x[2], x[3]};
#pragma unroll
                  for (int j = 0; j < 4; ++j) VTA[((size_t)(b * 2 + kvh) * 64 + d0 + j) * 256 + t] = (bf16)f2bf(x[j]); }
              else {
#pragma unroll
                  for (int j = 0; j < 4; ++j) VTA[KA_LAT + ((size_t)(b * 2 + kvh) * 64 + d0 + j) * 2304 + 256 + t] = (bf16)f2bf(x[j]); }
          } }
        { unsigned* p = (unsigned*)(CQ + (size_t)row * 512 + 6 * lane);
          const unsigned w0 = p[0], w1 = p[1], w2 = p[2];
          float x[6] = {bflo(w0), bfhi(w0), bflo(w1), bfhi(w1), bflo(w2), bfhi(w2)};
          float ss = 0.f;
#pragma unroll
          for (int j = 0; j < 6; ++j) ss += x[j] * x[j];
          const float rs = rsqrtf(wave_sum(ss) * (1.f / 384.f) + EPSN);
#pragma unroll
          for (int j = 0; j < 6; ++j) x[j] = x[j] * rs * gcq[6 * lane + j];
          p[0] = pk2(x[0], x[1]); p[1] = pk2(x[2], x[3]); p[2] = pk2(x[4], x[5]);
          if (lane < 16) { const unsigned w = *(const unsigned*)(CQ + (size_t)row * 512 + 384 + 2 * lane); float y0 = bflo(w), y1 = bfhi(w);
              if (!lat) { a.out[OUT_KPE + ((size_t)(b * 2 + l) * 256 + t) * 32 + 2 * lane] = y0; a.out[OUT_KPE + ((size_t)(b * 2 + l) * 256 + t) * 32 + 2 * lane + 1] = y1; }
              else { const float inv = __builtin_amdgcn_exp2f(-(float)(lane & 7) * (L2_10000 / 8.f)); rope2(y0, y1, (lane < 8 ? grow : gcol) * inv); }
              *(unsigned*)(KPEALL + (size_t)keyrow * 32 + 2 * lane) = pk2(y0, y1); } }
        { const v2u w = *(const v2u*)(CKVR + (size_t)row * 256 + 4 * lane);
          float x[4] = {bflo(w.x), bfhi(w.x), bflo(w.y), bfhi(w.y)};
          const float ss = (x[0] * x[0] + x[1] * x[1]) + (x[2] * x[2] + x[3] * x[3]);
          const float rs = rsqrtf(wave_sum(ss) * (1.f / 256.f) + EPSN);
#pragma unroll
          for (int j = 0; j < 4; ++j) x[j] = x[j] * rs * gkv[4 * lane + j];
          if (!lat) *(f32x4*)(a.out + OUT_CKV + ((size_t)(b * 2 + l) * 256 + t) * 256 + 4 * lane) = (f32x4){x[0], x[1], x[2], x[3]};
          *(v2u*)(CKVALL + (size_t)keyrow * 256 + 4 * lane) = (v2u){pk2(x[0], x[1]), pk2(x[2], x[3])}; }
    }
    LAS float* tile = (LAS float*)lds;
    const float *sw = a.in[19] + (size_t)l * 3 * 1536, *sb = a.in[20] + (size_t)l * 1536;
    for (int it = bid; it < 192 * 24; it += G) {
        const int tb = it / 24, cb = it % 24, row0 = tb * 64;
        const bool lat = row0 >= TCTX; const int L = lat ? 2048 : 256;
        const int b = lat ? (row0 - TCTX) >> 11 : row0 >> 8, t0 = lat ? (row0 - TCTX) & 2047 : row0 & 255;
        { const int rr = tid >> 3, c8 = tid & 7; const v4u w = *(const v4u*)(HYR + (size_t)(row0 + rr) * 1536 + cb * 64 + 8 * c8);
          LAS float* tp = tile + (rr + 1) * 65 + 8 * c8;
          tp[0] = bflo(w.x); tp[1] = bfhi(w.x); tp[2] = bflo(w.y); tp[3] = bfhi(w.y); tp[4] = bflo(w.z); tp[5] = bfhi(w.z); tp[6] = bflo(w.w); tp[7] = bfhi(w.w); }
        if (tid < 16) { const int which = tid >> 3, c8 = tid & 7; const bool ok = which ? (t0 + 64 < L) : (t0 > 0); const int rsrc = which ? row0 + 64 : row0 - 1;
          v4u w = (v4u){0u, 0u, 0u, 0u}; if (ok) w = *(const v4u*)(HYR + (size_t)rsrc * 1536 + cb * 64 + 8 * c8);
          LAS float* tp = tile + (which ? 65 : 0) * 65 + 8 * c8;
          tp[0] = bflo(w.x); tp[1] = bfhi(w.x); tp[2] = bflo(w.y); tp[3] = bfhi(w.y); tp[4] = bflo(w.z); tp[5] = bfhi(w.z); tp[6] = bflo(w.w); tp[7] = bfhi(w.w); }
        __syncthreads();
        { const int c = tid >> 3, tc = tid & 7, cg_ = cb * 64 + c; const float w0 = sw[cg_], w1 = sw[1536 + cg_], w2 = sw[3072 + cg_], bb = sb[cg_];
          float u[8];
#pragma unroll
          for (int k = 0; k < 8; ++k) { const int tr = 8 * tc + k; u[k] = w0 * tile[tr * 65 + c] + w1 * tile[(tr + 1) * 65 + c] + w2 * tile[(tr + 2) * 65 + c] + bb; }
          const size_t base = lat ? (size_t)UT_LAT + ((size_t)b * 1536 + cg_) * 2048 : ((size_t)b * 1536 + cg_) * 256;
          *(v4u*)(UT + base + t0 + 8 * tc) = (v4u){pk2(u[0], u[1]), pk2(u[2], u[3]), pk2(u[4], u[5]), pk2(u[6], u[7])}; }
        __syncthreads();
    }
}

__device__ __forceinline__ void ffnconv_phase(const Args& a, int l, int gt, int NGT) {
    const bf16* U = (const bf16*)(a.ws + WS_U); bf16* ACT = (bf16*)(a.ws + WS_ACT);
    const float *cw = a.in[31] + (size_t)l * 3 * 5632, *cb = a.in[32] + (size_t)l * 5632;
    for (int idx = gt; idx < 768 * 352; idx += NGT) {
        const int tb = idx / 352, ch = idx % 352, row0 = tb * 16, c0 = ch * 8;
        const bool lat = row0 >= TCTX; const int t0 = lat ? (row0 - TCTX) & 2047 : row0 & 255, L = lat ? 2048 : 256;
        float pa[8], ca[8], pg[8], cg2[8];
        { v4u w = (v4u){0u, 0u, 0u, 0u}, w2 = w;
          if (t0 > 0) { w = *(const v4u*)(U + (size_t)(row0 - 1) * 5632 + c0); w2 = *(const v4u*)(U + (size_t)(row0 - 1) * 5632 + 2816 + c0); }
          pa[0] = bflo(w.x); pa[1] = bfhi(w.x); pa[2] = bflo(w.y); pa[3] = bfhi(w.y); pa[4] = bflo(w.z); pa[5] = bfhi(w.z); pa[6] = bflo(w.w); pa[7] = bfhi(w.w);
          pg[0] = bflo(w2.x); pg[1] = bfhi(w2.x); pg[2] = bflo(w2.y); pg[3] = bfhi(w2.y); pg[4] = bflo(w2.z); pg[5] = bfhi(w2.z); pg[6] = bflo(w2.w); pg[7] = bfhi(w2.w);
          w = *(const v4u*)(U + (size_t)row0 * 5632 + c0); w2 = *(const v4u*)(U + (size_t)row0 * 5632 + 2816 + c0);
          ca[0] = bflo(w.x); ca[1] = bfhi(w.x); ca[2] = bflo(w.y); ca[3] = bfhi(w.y); ca[4] = bflo(w.z); ca[5] = bfhi(w.z); ca[6] = bflo(w.w); ca[7] = bfhi(w.w);
          cg2[0] = bflo(w2.x); cg2[1] = bfhi(w2.x); cg2[2] = bflo(w2.y); cg2[3] = bfhi(w2.y); cg2[4] = bflo(w2.z); cg2[5] = bfhi(w2.z); cg2[6] = bflo(w2.w); cg2[7] = bfhi(w2.w); }
        for (int i = 0; i < 16; ++i) {
            float na[8], ng[8];
            v4u w = (v4u){0u, 0u, 0u, 0u}, w2 = w;
            if (t0 + i + 1 < L) { w = *(const v4u*)(U + (size_t)(row0 + i + 1) * 5632 + c0); w2 = *(const v4u*)(U + (size_t)(row0 + i + 1) * 5632 + 2816 + c0); }
            na[0] = bflo(w.x); na[1] = bfhi(w.x); na[2] = bflo(w.y); na[3] = bfhi(w.y); na[4] = bflo(w.z); na[5] = bfhi(w.z); na[6] = bflo(w.w); na[7] = bfhi(w.w);
            ng[0] = bflo(w2.x); ng[1] = bfhi(w2.x); ng[2] = bflo(w2.y); ng[3] = bfhi(w2.y); ng[4] = bflo(w2.z); ng[5] = bfhi(w2.z); ng[6] = bflo(w2.w); ng[7] = bfhi(w2.w);
            float o[8];
#pragma unroll
            for (int j = 0; j < 8; ++j) {
                const float av = cw[c0 + j] * pa[j] + cw[5632 + c0 + j] * ca[j] + cw[2 * 5632 + c0 + j] * na[j] + cb[c0 + j];
                const float gv = cw[2816 + c0 + j] * pg[j] + cw[5632 + 2816 + c0 + j] * cg2[j] + cw[2 * 5632 + 2816 + c0 + j] * ng[j] + cb[2816 + c0 + j];
                o[j] = gv / (1.f + __expf(-gv)) * av; pa[j] = ca[j]; ca[j] = na[j]; pg[j] = cg2[j]; cg2[j] = ng[j]; }
            *(v4u*)(ACT + (size_t)(row0 + i) * 2816 + c0) = (v4u){pk2(o[0], o[1]), pk2(o[2], o[3]), pk2(o[4], o[5]), pk2(o[6], o[7])};
        }
    }
}
template <int DK>
__device__ __forceinline__ void attn_unit(LAS unsigned char* lds, int tid, const bf16* Qp, int qpitch, const bf16* Kp, int kpitch, const bf16* Kpe, const bf16* Vt, size_t vpitch,
                                          int nkeys, bf16* Op, int opitch, float sl2, bool rope, int pos0) {
    constexpr int NS = DK / 16;
    asm volatile("" : "+v"(tid));
    const int lane = tid & 63, wave = tid >> 6, r = lane & 31, h = lane >> 5;
    bf16x8 qf[NS];
    { const bf16* qrow = Qp + (size_t)(wave * 32 + r) * qpitch;
#pragma unroll
      for (int s = 0; s < NS; ++s) qf[s] = *(const bf16x8*)(qrow + 16 * s + 8 * h);
      if (DK == 96 && rope) { const int t = pos0 + wave * 32 + r; const float grow = (float)(t >> 6), gcol = (float)(t & 63);
#pragma unroll
          for (int sp = 0; sp < 2; ++sp) { bf16x8 v = qf[NS - 2 + sp];
#pragma unroll
              for (int k = 0; k < 4; ++k) { float x0 = bf1((bf16)v[2 * k]), x1 = bf1((bf16)v[2 * k + 1]);
                  const float inv = __builtin_amdgcn_exp2f(-(float)(4 * h + k) * (L2_10000 / 8.f)); rope2(x0, x1, (sp == 0 ? grow : gcol) * inv);
                  v[2 * k] = (short)f2bf(x0); v[2 * k + 1] = (short)f2bf(x1); }
              qf[NS - 2 + sp] = v; } } }
    const int kkey = tid >> 3, kch = tid & 7, pkey = tid >> 2, pch = tid & 3;
    f32x16 o0, o1;
#pragma unroll
    for (int i = 0; i < 16; ++i) { o0[i] = 0.f; o1[i] = 0.f; }
    float mrun = -__builtin_inff(), lrun = 0.f;
    v4u rk, rv, rp = (v4u){0u, 0u, 0u, 0u};
    const int ntile = nkeys >> 6;
#define ATT_LOAD(kt) do { const int key0 = (kt) * 64; rk = *(const v4u*)(Kp + (size_t)(key0 + kkey) * kpitch + 8 * kch); rv = *(const v4u*)(Vt + (size_t)kkey * vpitch + key0 + 8 * kch); \
        if (DK == 96 && tid < 256) rp = *(const v4u*)(Kpe + (size_t)(key0 + pkey) * 32 + 8 * pch); } while (0)
#define ATT_WRITE(buf) do { *(LAS v4u*)(lds + (buf) * 13312 + kkey * 208 + kch * 16) = rk; *(LAS v4u*)(lds + 26624 + (buf) * 9216 + kkey * 144 + kch * 16) = rv; \
        if (DK == 96 && tid < 256) *(LAS v4u*)(lds + (buf) * 13312 + pkey * 208 + 128 + pch * 16) = rp; } while (0)
    ATT_LOAD(0); ATT_WRITE(0); __syncthreads();
    for (int kt = 0; kt < ntile; ++kt) {
        const int buf = kt & 1;
        if (kt + 1 < ntile) ATT_LOAD(kt + 1);
        const LAS unsigned char* kb = lds + buf * 13312; const LAS unsigned char* vb = lds + 26624 + buf * 9216;
        f32x16 s0, s1;
#pragma unroll
        for (int i = 0; i < 16; ++i) { s0[i] = 0.f; s1[i] = 0.f; }
#pragma unroll
        for (int s = 0; s < NS; ++s) {
            const bf16x8 a0 = *(const LAS bf16x8*)(kb + r * 208 + (16 * s + 8 * h) * 2), a1 = *(const LAS bf16x8*)(kb + (32 + r) * 208 + (16 * s + 8 * h) * 2);
            s0 = __builtin_amdgcn_mfma_f32_32x32x16_bf16(a0, qf[s], s0, 0, 0, 0); s1 = __builtin_amdgcn_mfma_f32_32x32x16_bf16(a1, qf[s], s1, 0, 0, 0); }
        float mx = s0[0];
#pragma unroll
        for (int i = 1; i < 16; ++i) mx = fmaxf(mx, s0[i]);
#pragma unroll
        for (int i = 0; i < 16; ++i) mx = fmaxf(mx, s1[i]);
        mx = fmaxf(mx, __shfl_xor(mx, 32));
        const float mnew = fmaxf(mrun, mx), alpha = __builtin_amdgcn_exp2f((mrun - mnew) * sl2), nm = mnew * sl2;
        float sum = 0.f;
#pragma unroll
        for (int i = 0; i < 16; ++i) { s0[i] = __builtin_amdgcn_exp2f(s0[i] * sl2 - nm); s1[i] = __builtin_amdgcn_exp2f(s1[i] * sl2 - nm); sum += s0[i] + s1[i]; }
        lrun = lrun * alpha + sum; mrun = mnew;
#pragma unroll
        for (int i = 0; i < 16; ++i) { o0[i] *= alpha; o1[i] *= alpha; }
#pragma unroll
        for (int sub = 0; sub < 2; ++sub) {
#pragma unroll
            for (int s2 = 0; s2 < 2; ++s2) {
                bf16x8 pb;
#pragma unroll
                for (int e = 0; e < 8; ++e) pb[e] = (short)f2bf(sub == 0 ? s0[8 * s2 + e] : s1[8 * s2 + e]);
                const int kofs = (32 * sub + 16 * s2 + 4 * h) * 2;
#pragma unroll
                for (int slab = 0; slab < 2; ++slab) {
                    const LAS unsigned char* vp = vb + (32 * slab + r) * 144 + kofs;
                    const bf16x4 lo = *(const LAS bf16x4*)vp, hi = *(const LAS bf16x4*)(vp + 16);
                    const bf16x8 va = (bf16x8){lo[0], lo[1], lo[2], lo[3], hi[0], hi[1], hi[2], hi[3]};
                    if (slab == 0) o0 = __builtin_amdgcn_mfma_f32_32x32x16_bf16(va, pb, o0, 0, 0, 0); else o1 = __builtin_amdgcn_mfma_f32_32x32x16_bf16(va, pb, o1, 0, 0, 0); } } }
        if (kt + 1 < ntile) ATT_WRITE(buf ^ 1);
        __syncthreads();
    }
#undef ATT_LOAD
#undef ATT_WRITE
    const float ltot = lrun + __shfl_xor(lrun, 32), inv = 1.f / ltot;
    bf16* orow = Op + (size_t)(wave * 32 + r) * opitch;
#pragma unroll
    for (int g4 = 0; g4 < 4; ++g4) {
        *(v2u*)(orow + 8 * g4 + 4 * h) = (v2u){pk2(o0[4 * g4] * inv, o0[4 * g4 + 1] * inv), pk2(o0[4 * g4 + 2] * inv, o0[4 * g4 + 3] * inv)};
        *(v2u*)(orow + 32 + 8 * g4 + 4 * h) = (v2u){pk2(o1[4 * g4] * inv, o1[4 * g4 + 1] * inv), pk2(o1[4 * g4 + 2] * inv, o1[4 * g4 + 3] * inv)}; }
}

template <bool LAT>
__device__ __forceinline__ void hyena_unit(const Args& a, int l, int c, LAS unsigned char* lds, int tid) {
    constexpr int L = LAT ? 2048 : 256, NB = LAT ? 4 : 16, NE = L / 16, NCH = L / 4, NW = LAT ? 8 : 4, ASH = LAT ? 2 : 4;
    asm volatile("" : "+v"(tid));
    const int lane = tid & 63, wave = tid >> 6, r = lane & 31, h = lane >> 5;
    const bf16* UT = (const bf16*)(a.ws + WS_UT) + (LAT ? UT_LAT : 0);
    bf16* OC = (bf16*)(a.ws + WS_OC);
    const float* HID = (const float*)(a.ws + WS_HID) + ((size_t)l * 2304 + (LAT ? 256 : 0)) * 64;
    LAS bf16* U = (LAS bf16*)lds; LAS bf16* X = (LAS bf16*)(lds + 16384); LAS float* FT = (LAS float*)(lds + 32768); LAS unsigned char* GC = lds + 65536;
    LAS float* W3 = (LAS float*)(lds + 131200); LAS float* RED = (LAS float*)(lds + 132224);
    for (int q = tid; q < NB * L / 8; q += 512) { const int b = q / (L / 8), off = (q % (L / 8)) * 8;
        *(LAS v4u*)(U + b * L + off) = *(const v4u*)(UT + ((size_t)b * 1536 + c) * L + off);
        *(LAS v4u*)(X + b * L + off) = *(const v4u*)(UT + ((size_t)b * 1536 + 512 + c) * L + off); }
    if (tid < 256) { const int j = tid >> 2, k = tid & 3; W3[k * 64 + j] = a.in[25][((size_t)l * 64 + j) * 2048 + (k >> 1) * 1024 + (k & 1) * 512 + c]; }
    __syncthreads();
    { const float dmin = -15.350567286626973f, dmax = -3.0701134573253945f;
      const float delta = fabsf(dmin + (float)c * ((dmax - dmin) / 511.f));
      float p0 = 0.f, p1 = 0.f;
      for (int t = tid; t < L; t += 512) {
          float s[4] = {0.f, 0.f, 0.f, 0.f};
#pragma unroll 4
          for (int j4 = 0; j4 < 16; ++j4) { const f32x4 hv = *(const f32x4*)(HID + (size_t)t * 64 + 4 * j4);
#pragma unroll
              for (int k = 0; k < 4; ++k) s[k] += hv.x * W3[k * 64 + 4 * j4] + hv.y * W3[k * 64 + 4 * j4 + 1] + hv.z * W3[k * 64 + 4 * j4 + 2] + hv.w * W3[k * 64 + 4 * j4 + 3]; }
          const float win = __expf(-((float)t / (float)(L - 1)) * delta);
#pragma unroll
          for (int k = 0; k < 4; ++k) { s[k] *= win; FT[k * L + t] = s[k]; }
          p0 += fabsf(s[0]) + (t >= 1 ? fabsf(s[2]) : 0.f); p1 += fabsf(s[1]) + (t >= 1 ? fabsf(s[3]) : 0.f); }
      p0 = wave_sum(p0); p1 = wave_sum(p1);
      if (lane == 0) { RED[2 * wave] = p0; RED[2 * wave + 1] = p1; } }
    __syncthreads();
    const int col = 32 * wave + r, ca = col >> ASH, cbat = col & (NB - 1);
    const int a_lo = (32 * wave) >> ASH, a_hi = (32 * wave + 31) >> ASH;
    const int rowbase = LAT ? TCTX + cbat * 2048 : cbat * 256;
#pragma unroll 1
    for (int n = 0; n < 2; ++n) {
        float l1s = 0.f;
#pragma unroll
        for (int w = 0; w < 8; ++w) l1s += RED[2 * w + n];
        const float invl1 = 1.f / (l1s + EPSN);
        for (int e = tid; e < 8 * NCH * 8; e += 512) { const int k = e / (NCH * 8), y = (e >> 3) % NCH, j = e & 7; const int m = L - (8 * y + k + j);
            float v = 0.f; if (m >= 0 && m < L) v = FT[n * L + m]; else if (m < 0 && m > -L) v = FT[(2 + n) * L - m];
            *(LAS bf16*)(GC + (k * 513 + y) * 16 + 2 * j) = (bf16)f2bf(v * invl1); }
        __syncthreads();
        f32x16 acc;
#pragma unroll
        for (int i = 0; i < 16; ++i) acc[i] = 0.f;
        if (wave < NW) {
            const int lam_lo = 2 * a_lo - (NE - 1), lam_hi = 2 * a_hi;
            for (int lam = lam_lo; lam <= lam_hi; ++lam) {
                const int xs = 8 * h - r - 16 * lam + L;
                const bf16x8 af = *(const LAS bf16x8*)(GC + ((xs & 7) * 513 + (xs >> 3)) * 16);
                const int e = 2 * ca - lam;
                bf16x8 bfr = (bf16x8){0, 0, 0, 0, 0, 0, 0, 0};
                if (e >= 0 && e < NE) bfr = *(const LAS bf16x8*)(U + cbat * L + 16 * e + 8 * h);
                acc = __builtin_amdgcn_mfma_f32_32x32x16_bf16(af, bfr, acc, 0, 0, 0);
            }
        }
        const float bias = a.in[27][((size_t)l * 2 + n) * 512 + c];
        float z[16];
        if (wave < NW) {
#pragma unroll
            for (int g4 = 0; g4 < 4; ++g4) { const int t0 = 32 * ca + 8 * g4 + 4 * h;
                const v2u uw = *(const LAS v2u*)(U + cbat * L + t0), xw = *(const LAS v2u*)(X + cbat * L + t0);
                const float uv[4] = {bflo(uw.x), bfhi(uw.x), bflo(uw.y), bfhi(uw.y)}, xv[4] = {bflo(xw.x), bfhi(xw.x), bflo(xw.y), bfhi(xw.y)};
#pragma unroll
                for (int k = 0; k < 4; ++k) z[4 * g4 + k] = xv[k] * (acc[4 * g4 + k] + bias * uv[k]); }
        }
        __syncthreads();
        if (n == 0) {
            if (wave < NW) {
#pragma unroll
                for (int g4 = 0; g4 < 4; ++g4) *(LAS v2u*)(U + cbat * L + 32 * ca + 8 * g4 + 4 * h) = (v2u){pk2(z[4 * g4], z[4 * g4 + 1]), pk2(z[4 * g4 + 2], z[4 * g4 + 3])}; }
            for (int q = tid; q < NB * L / 8; q += 512) { const int b = q / (L / 8), off = (q % (L / 8)) * 8;
                *(LAS v4u*)(X + b * L + off) = *(const v4u*)(UT + ((size_t)b * 1536 + 1024 + c) * L + off); }
        } else if (wave < NW) {
#pragma unroll
            for (int g4 = 0; g4 < 4; ++g4)
#pragma unroll
                for (int k = 0; k < 4; ++k) OC[(size_t)(rowbase + 32 * ca + 8 * g4 + 4 * h + k) * 512 + c] = (bf16)f2bf(z[4 * g4 + k]);
        }
    }
    __syncthreads();
}
#ifndef PHMASK
#define PHMASK 0x1fff
#endif
#define PH_ON(k) (((PHMASK) >> (k)) & 1)
template <class T> __device__ __forceinline__ T* asglobal(T* p) { return (T*)(GAS T*)p; }
__global__ void __launch_bounds__(512, 2) mega_fwd(Args a) {
    extern __shared__ __attribute__((aligned(16))) unsigned char lds_raw[];
    LAS unsigned char* lds = (LAS unsigned char*)lds_raw;
    cg::grid_group grid = cg::this_grid();
    const int G = gridDim.x, bid = blockIdx.x, NGW = G * 8, NGT = G * 512;
    using pg8::Gemm; using pg8::StaticOrder;
    const int ph_lo = a.ph_lo, ph_hi = a.ph_hi;
    volatile LAS unsigned* MISC = (volatile LAS unsigned*)(lds + LDS_BYTES - 64);
    if (threadIdx.x < 16) MISC[threadIdx.x] = 0u;
    __syncthreads();
    XcdBarrier bar = xcd_barrier_post((unsigned*)(a.ws + WS_BAR + (size_t)a.li * BAR_REGION), MISC);
#pragma unroll 1
    for (int ph = ph_lo; ph < ph_hi; ++ph) {
        int tid = threadIdx.x; asm volatile("" : "+v"(tid));
        unsigned char* ws = a.ws; asm volatile("" : "+s"(ws));
        const int lane = tid & 63, wave = __builtin_amdgcn_readfirstlane(tid >> 6), gw = bid * 8 + wave, gt = bid * 512 + tid;
        const int l = (ph >= 1 && ph < 23) ? (ph - 1) / 11 : 0, sub = (ph >= 1 && ph < 23) ? (ph - 1) % 11 : -1;
        float* mod = (float*)(ws + WS_MOD) + (size_t)l * 5 * 6144;
        if (PH_ON(11) && ph == 0) { p0_mod_hid(a, lds, bid, G, tid, gw, NGW, lane); wconv_phase(a, 0, lds, gw, NGW, gt, NGT, wave, lane); }
        else if (PH_ON(12) && ph == 23) { norm_phase(a, 0, 2, false, gw, NGW, lane); }
        else if (PH_ON(0) && sub == 0) { if (l == 1) wconv_phase(a, 1, lds, gw, NGW, gt, NGT, wave, lane); norm_phase(a, l, 0, l == 0, gw, NGW, lane); }
        else if (PH_ON(1) && sub == 1) {
            Gemm g{(const bf16*)(ws + WS_HBF), (const bf16*)(ws + WS_WIN), TT, 3072, 1024, 1024, 1024}; StaticOrder S; S.init(TT, 3072, G, bid);
            pg8::EpiSeg E{(bf16*)(ws + WS_QA), (bf16*)(ws + WS_KVR), (bf16*)(ws + WS_CQ), (bf16*)(ws + WS_CKVR), (bf16*)(ws + WS_HYR)};
            pg8::gemm_phase<pg8::EpiSeg, StaticOrder, true, true>(lds, g, S, E);
        }
        else if (PH_ON(2) && sub == 2) { post_phase(a, l, lds, bid, G, tid, gw, NGW, gt, NGT, lane); }
        else if (PH_ON(3) && sub == 3) {
#pragma unroll 1
            for (int q = 0; q < 3; ++q) {
                Gemm g; StaticOrder S; pg8::EpiStore<0> E;
                if (q == 0) { g = Gemm{(const bf16*)(ws + WS_CQ), (const bf16*)(ws + WS_WUQ), TT, 768, 384, 512, 384}; S.init(TT, 768, G, bid); E = pg8::EpiStore<0>{(bf16*)(ws + WS_QB), 768}; }
                else if (q == 1) { g = Gemm{(const bf16*)(ws + WS_CKVALL), (const bf16*)(ws + WS_WKN), NKEYROWS, 512, 256, 256, 256}; S.init(NKEYROWS, 512, G, (bid + G - 144 % G) % G); E = pg8::EpiStore<0>{(bf16*)(ws + WS_KNB), 512}; }
                else { g = Gemm{(const bf16*)(ws + WS_WVV), (const bf16*)(ws + WS_CKVALL), 512, NKEYROWS, 256, 256, 256}; S.init(512, NKEYROWS, G, (bid + G - 248 % G) % G); E = pg8::EpiStore<0>{(bf16*)(ws + WS_VTB), NKEYROWS}; }
                pg8::gemm_phase<pg8::EpiStore<0>, StaticOrder, true, true>(lds, g, S, E);
            }
        }
        else if (PH_ON(4) && sub == 4) {
            const bf16 *QA = (const bf16*)(ws + WS_QA), *QB = (const bf16*)(ws + WS_QB), *KA = (const bf16*)(ws + WS_KA), *VTA = (const bf16*)(ws + WS_VTA);
            const bf16 *KNB = (const bf16*)(ws + WS_KNB), *VTB = (const bf16*)(ws + WS_VTB), *KPE = (const bf16*)(ws + WS_KPEALL);
            bf16 *OA = (bf16*)(ws + WS_OA), *OB = (bf16*)(ws + WS_OB);
            const float slA = 0.125f * 1.4426950408889634f, slB = 0.10206207261596575f * 1.4426950408889634f;
            for (int it = bid; it < 1792; it += G) {
                if (it < 256 || (it >= 1024 && it < 1152)) {
                    const bool lat = it < 256; const int u = lat ? it : it - 1024;
                    const int b = lat ? u >> 6 : u >> 3, hh = lat ? (u >> 3) & 7 : u & 7, qb = lat ? u & 7 : 0;
                    const int row0 = lat ? TCTX + b * 2048 + qb * 256 : b * 256, key0 = lat ? TCTX + b * 2304 : b * 256;
                    attn_unit<96>(lds, tid, QB + (size_t)row0 * 768 + hh * 96, 768, KNB + (size_t)key0 * 512 + hh * 64, 512, KPE + (size_t)key0 * 32, VTB + (size_t)(hh * 64) * NKEYROWS + key0, NKEYROWS,
                                  lat ? 2304 : 256, OB + (size_t)row0 * 512 + hh * 64, 512, slB, lat, qb * 256);
                } else if (it < 512 || (it >= 1152 && it < 1280)) {
                    const bool lat = it < 512; const int u = lat ? it - 256 : it - 1152;
                    const int b = lat ? u >> 6 : u >> 3, hh = lat ? (u >> 3) & 7 : u & 7, qb = lat ? u & 7 : 0, kvh = hh >> 2;
                    const int row0 = lat ? TCTX + b * 2048 + qb * 256 : b * 256, nk = lat ? 2304 : 256;
                    const size_t kbase = lat ? (size_t)KA_LAT + (size_t)(b * 2 + kvh) * 2304 * 64 : (size_t)(b * 2 + kvh) * 256 * 64;
                    attn_unit<64>(lds, tid, QA + (size_t)row0 * 512 + hh * 64, 512, KA + kbase, 64, nullptr, VTA + kbase, nk, nk, OA + (size_t)row0 * 512 + hh * 64, 512, slA, false, 0);
                } else if (it < 1024) { hyena_unit<true>(a, l, it - 512, lds, tid); }
                else { hyena_unit<false>(a, l, it - 1280, lds, tid); }
            }
        }
        else if (PH_ON(5) && sub == 5) {
            const bf16* HBF = (const bf16*)(ws + WS_HBF); bf16* Sg = (bf16*)(ws + WS_S); float* MACC = (float*)(ws + WS_MACC); bf16* MBF = (bf16*)(ws + WS_MBF);
#pragma unroll 1
            for (int n = 0; n < 3; ++n) {
                { Gemm g{HBF, (const bf16*)(ws + WS_WG) + (size_t)n * 1024 * 1024, TT, 1024, 1024, 1024, 1024}; StaticOrder S; S.init(TT, 1024, G, bid);
                  pg8::EpiStore<1> E{Sg, 1024}; pg8::gemm_phase<pg8::EpiStore<1>, StaticOrder, true, true>(lds, g, S, E); }
                Gemm g{(const bf16*)(ws + WS_OA) + (size_t)n * TT * 512, (const bf16*)(ws + WS_WB) + (size_t)n * 1024 * 512, TT, 1024, 512, 512, 512}; StaticOrder S; S.init(TT, 1024, G, bid);
                if (n == 0) { pg8::EpiMerge<0> E{Sg, MACC, MBF}; pg8::gemm_phase<pg8::EpiMerge<0>, StaticOrder, true, true>(lds, g, S, E); }
                else if (n == 1) { pg8::EpiMerge<1> E{Sg, MACC, MBF}; pg8::gemm_phase<pg8::EpiMerge<1>, StaticOrder, true, true>(lds, g, S, E); }
                else { pg8::EpiMerge<2> E{Sg, MACC, MBF}; pg8::gemm_phase<pg8::EpiMerge<2>, StaticOrder, true, true>(lds, g, S, E); }
            }
        }
        else if (PH_ON(6) && sub == 6) {
            Gemm g{(const bf16*)(ws + WS_MBF), (const bf16*)(ws + WS_WO), TT, 1024, 1024, 1024, 1024}; StaticOrder S; S.init(TT, 1024, G, bid);
            pg8::EpiResid E{a.out, mod + 2048}; pg8::gemm_phase<pg8::EpiResid, StaticOrder, true, true>(lds, g, S, E);
        }
        else if (PH_ON(7) && sub == 7) { norm_phase(a, l, 1, false, gw, NGW, lane); }
        else if (PH_ON(8) && sub == 8) {
            Gemm g{(const bf16*)(ws + WS_HBF), (const bf16*)(ws + WS_WUP), TT, 5632, 1024, 1024, 1024}; StaticOrder S; S.init(TT, 5632, G, bid);
            pg8::EpiStore<0> E{(bf16*)(ws + WS_U), 5632}; pg8::gemm_phase<pg8::EpiStore<0>, StaticOrder, true, true>(lds, g, S, E);
        }
        else if (PH_ON(9) && sub == 9) { ffnconv_phase(a, l, gt, NGT); }
        else if (PH_ON(10) && sub == 10) {
            Gemm g{(const bf16*)(ws + WS_ACT), (const bf16*)(ws + WS_WDN), TT, 1024, 2816, 2816, 2816}; StaticOrder S; S.init(TT, 1024, G, bid);
            pg8::EpiResid E{a.out, mod + 5120}; pg8::gemm_phase<pg8::EpiResid, StaticOrder, true, true>(lds, g, S, E);
        }
#ifdef EXTRA_SYNCS
        for (int q = 0; q < EXTRA_SYNCS; ++q) { __syncthreads(); grid.sync(); }
#endif
        if (ph + 1 < ph_hi) { if (ph == ph_lo) { __syncthreads(); grid.sync(); } else xcd_barrier(bar); }
    }
}

extern "C" void kernel_launch(void* const* d_in, const int* in_sizes, int n_in, void* d_out, int out_size, void* d_ws, size_t ws_size, hipStream_t stream) {
    static int grid = 0;
    if (grid == 0) {
        if (n_in != 35 || ws_size < WS_END) { fprintf(stderr, "kernel_launch: unexpected n_in %d / ws %zu\n", n_in, ws_size); grid = -1; return; }
        int dev = 0, cus = 0, per_cu = 0;
        if (hipGetDevice(&dev) != hipSuccess || hipDeviceGetAttribute(&cus, hipDeviceAttributeMultiprocessorCount, dev) != hipSuccess) { grid = -1; return; }
        if (hipFuncSetAttribute((const void*)mega_fwd, hipFuncAttributeMaxDynamicSharedMemorySize, LDS_BYTES) != hipSuccess) { fprintf(stderr, "kernel_launch: hipFuncSetAttribute failed\n"); grid = -1; return; }
        if (hipOccupancyMaxActiveBlocksPerMultiprocessor(&per_cu, (const void*)mega_fwd, 512, LDS_BYTES) != hipSuccess || per_cu < 1) { fprintf(stderr, "kernel_launch: occupancy query says %d\n", per_cu); per_cu = 1; }
        (void)hipGetLastError();
        grid = cus;
    }
    if (grid < 0) return;
    if (hipMemsetAsync((char*)d_ws + WS_MOD, 0, ZERO_BYTES, stream) != hipSuccess) { fprintf(stderr, "kernel_launch: memset failed\n"); return; }
    Args a{};
    for (int i = 0; i < 35; ++i) a.in[i] = (const float*)d_in[i];
    a.out = (float*)d_out; a.ws = (unsigned char*)d_ws;
#if defined(MK_PER_PHASE)
    for (int p = 0; p < NPHASE; ++p) { a.ph_lo = p; a.ph_hi = p + 1; a.li = 0; void* args[] = {&a};
        hipError_t e = hipLaunchCooperativeKernel((const void*)mega_fwd, dim3(grid), dim3(512), args, LDS_BYTES, stream);
        if (e != hipSuccess) { fprintf(stderr, "launch %d failed: %s\n", p, hipGetErrorString(e)); break; } }
#else
#if defined(PROBE_SUB)
    { const int k0 = 1 + PROBE_SUB, k1 = 12 + PROBE_SUB; const int cuts[6][2] = {{0, k0 + 1}, {k0, k0 + 1}, {k0 + 1, k1 + 1}, {k1, k1 + 1}, {k1 + 1, NPHASE}, {0, 0}};
      for (int c = 0; c < 5; ++c) { a.ph_lo = cuts[c][0]; a.ph_hi = cuts[c][1]; a.li = c; if (a.ph_lo >= a.ph_hi) continue; void* args[] = {&a};
          hipError_t e = hipLaunchCooperativeKernel((const void*)mega_fwd, dim3(grid), dim3(512), args, LDS_BYTES, stream);
          if (e != hipSuccess) { fprintf(stderr, "cooperative launch failed: %s\n", hipGetErrorString(e)); break; } } }
#elif defined(PROBE_CUTS)
    { const int k0 = 1 + PROBE_CUTS, k1 = 12 + PROBE_CUTS; const int cuts[4][2] = {{0, k0 + 1}, {k0 + 1, k1 + 1}, {k1 + 1, NPHASE}, {0, 0}};
      for (int c = 0; c < 3; ++c) { a.ph_lo = cuts[c][0]; a.ph_hi = cuts[c][1]; a.li = c; if (a.ph_lo >= a.ph_hi) continue; void* args[] = {&a};
          hipError_t e = hipLaunchCooperativeKernel((const void*)mega_fwd, dim3(grid), dim3(512), args, LDS_BYTES, stream);
          if (e != hipSuccess) { fprintf(stderr, "cooperative launch failed: %s\n", hipGetErrorString(e)); break; } } }
#else
    a.ph_lo = 0; a.ph_hi = NPHASE; void* args[] = {&a};
    hipError_t e = hipLaunchCooperativeKernel((const void*)mega_fwd, dim3(grid), dim3(512), args, LDS_BYTES, stream);
    if (e != hipSuccess) fprintf(stderr, "cooperative launch failed: %s (grid %d)\n", hipGetErrorString(e), grid);
#endif
#endif
}
```

```cpp
#include <hip/hip_runtime.h>
#include <hip/hip_cooperative_groups.h>
#include <cstdio>
#include <cstdint>
namespace cg = cooperative_groups;
namespace pg8 {
#define PG8_LAS __attribute__((address_space(3)))
typedef unsigned short bf16_t;
typedef short bf16x8 __attribute__((ext_vector_type(8)));
typedef float f32x4 __attribute__((ext_vector_type(4)));
typedef unsigned u32x4 __attribute__((ext_vector_type(4)));
constexpr int BM = 256, BK = 64, HALF = 128, HTB = HALF * BK * 2  , STAGE_BYTES = 8 * HTB, NXCD = 8, WGM = 8;

__host__ __device__ __forceinline__ int lds_byte(int r, int c) { const int st = (r >> 4) * 2 + (c >> 5), rr = r & 15, cc = c & 31, ob = rr * 64 + cc * 2; return st * 1024 + (ob ^ (((ob >> 9) & 1) << 5)); }
__host__ __device__ __forceinline__ void stage_rc(int b, int& R, int& C) { const int st = b / 1024, sb = b % 1024, swz = sb ^ (((sb >> 9) & 1) << 5); R = (st >> 1) * 16 + swz / 64; C = (st & 1) * 32 + (swz % 64) / 2; }
__host__ __device__ __forceinline__ int perm32(int rho) { const int n = rho >> 4, i = rho & 15; return 8 * (i >> 2) + 4 * n + (i & 3); }

struct Unit { int pm, pn; };
struct Gemm { const bf16_t* A; const bf16_t* Bt; int M, N, K, lda, ldb; };

struct StaticOrder {
    int nM, nN, nwg, G, c;
    __host__ __device__ void init(int M, int N, int G_, int c_) { nM = M / BM; nN = N / BM; nwg = nM * nN; G = G_; c = c_; }
    __host__ __device__ bool next(int i, Unit& u) const {
        const long L = (long)i * G + c; if (L >= nwg) return false;
        int wgid = (int)L; { const int q = nwg / NXCD, r = nwg % NXCD, xcd = wgid % NXCD, off = wgid / NXCD; wgid = (xcd < r ? xcd * (q + 1) : r * (q + 1) + (xcd - r) * q) + off; }
        const int nig = WGM * nN, gid = wgid / nig, fm = gid * WGM, gsz = (nM - fm) < WGM ? (nM - fm) : WGM;
        u.pm = fm + ((wgid % nig) % gsz); u.pn = (wgid % nig) / gsz; return true;
    }
    __device__ __forceinline__ void a_ready(const Unit&) const {}
    __device__ __forceinline__ void done(const Unit&) const {}
};

#ifndef GAS
#define GAS __attribute__((address_space(1)))
#endif
__device__ __forceinline__ unsigned cvt_pk_bf16(float lo, float hi) { unsigned r; asm volatile("v_cvt_pk_bf16_f32 %0, %1, %2" : "=v"(r) : "v"(lo), "v"(hi)); return r; }
__device__ __forceinline__ float sigm(float x) { return 1.f / (1.f + __expf(-x)); }
#define EPI_FOR _Pragma("unroll") for (int ai = 0; ai < 2; ++ai) _Pragma("unroll") for (int m = 0; m < 4; ++m) _Pragma("unroll") for (int bj = 0; bj < 2; ++bj)

template <int ACT  > struct EpiStore {
    static constexpr bool PERM = true, AFTER_DRAIN = false;
    bf16_t* O; int ld;
    __device__ __forceinline__ void operator()(const f32x4 (&acc)[2][2][4][2], const Unit& u, int wr, int wc, int fr, int fq) const {
        const int row0 = u.pm * BM + wr * 64 + fr, col0 = u.pn * BM + wc * 32 + 8 * fq;
        EPI_FOR { f32x4 v0 = acc[ai][bj][m][0], v1 = acc[ai][bj][m][1];
            if (ACT == 1) { v0 = (f32x4){sigm(v0[0]), sigm(v0[1]), sigm(v0[2]), sigm(v0[3])}; v1 = (f32x4){sigm(v1[0]), sigm(v1[1]), sigm(v1[2]), sigm(v1[3])}; }
            u32x4 w; w.x = cvt_pk_bf16(v0[0], v0[1]); w.y = cvt_pk_bf16(v0[2], v0[3]); w.z = cvt_pk_bf16(v1[0], v1[1]); w.w = cvt_pk_bf16(v1[2], v1[3]);
            *(GAS u32x4*)(O + (size_t)(row0 + ai * HALF + m * 16) * ld + col0 + bj * HALF) = w; }
    }
};
struct EpiSeg {
    static constexpr bool PERM = true, AFTER_DRAIN = false;
    bf16_t *QA, *KV, *CQ, *CKV, *HY;
    __device__ __forceinline__ void operator()(const f32x4 (&acc)[2][2][4][2], const Unit& u, int wr, int wc, int fr, int fq) const {
        bf16_t* base; int ld, coff; const int pn = u.pn;
        if (pn < 2) { base = QA; ld = 512; coff = 256 * pn; } else if (pn == 2) { base = KV; ld = 256; coff = 0; } else if (pn < 5) { base = CQ; ld = 512; coff = 256 * (pn - 3); }
        else if (pn == 5) { base = CKV; ld = 256; coff = 0; } else { base = HY; ld = 1536; coff = 256 * (pn - 6); }
        const int row0 = u.pm * BM + wr * 64 + fr, col0 = coff + wc * 32 + 8 * fq;
        EPI_FOR { const f32x4 v0 = acc[ai][bj][m][0], v1 = acc[ai][bj][m][1];
            u32x4 w; w.x = cvt_pk_bf16(v0[0], v0[1]); w.y = cvt_pk_bf16(v0[2], v0[3]); w.z = cvt_pk_bf16(v1[0], v1[1]); w.w = cvt_pk_bf16(v1[2], v1[3]);
            *(GAS u32x4*)(base + (size_t)(row0 + ai * HALF + m * 16) * ld + col0 + bj * HALF) = w; }
    }
};
template <int MODE  > struct EpiMerge {
    static constexpr bool PERM = true, AFTER_DRAIN = false;
    const bf16_t* S; float* Macc; bf16_t* Mbf;
    __device__ __forceinline__ void operator()(const f32x4 (&acc)[2][2][4][2], const Unit& u, int wr, int wc, int fr, int fq) const {
        const int row0 = u.pm * BM + wr * 64 + fr, col0 = u.pn * BM + wc * 32 + 8 * fq;
        EPI_FOR { const size_t off = (size_t)(row0 + ai * HALF + m * 16) * 1024 + col0 + bj * HALF;
            const u32x4 sw = *(const GAS u32x4*)(S + off);
            f32x4 s0 = (f32x4){__uint_as_float(sw.x << 16), __uint_as_float(sw.x & 0xffff0000u), __uint_as_float(sw.y << 16), __uint_as_float(sw.y & 0xffff0000u)};
            f32x4 s1 = (f32x4){__uint_as_float(sw.z << 16), __uint_as_float(sw.z & 0xffff0000u), __uint_as_float(sw.w << 16), __uint_as_float(sw.w & 0xffff0000u)};
            f32x4 v0 = acc[ai][bj][m][0] * s0, v1 = acc[ai][bj][m][1] * s1;
            if (MODE >= 1) { v0 = v0 + *(const GAS f32x4*)(Macc + off); v1 = v1 + *(const GAS f32x4*)(Macc + off + 4); }
            if (MODE <= 1) { *(GAS f32x4*)(Macc + off) = v0; *(GAS f32x4*)(Macc + off + 4) = v1; }
            else { u32x4 w; w.x = cvt_pk_bf16(v0[0], v0[1]); w.y = cvt_pk_bf16(v0[2], v0[3]); w.z = cvt_pk_bf16(v1[0], v1[1]); w.w = cvt_pk_bf16(v1[2], v1[3]); *(GAS u32x4*)(Mbf + off) = w; } }
    }
};
struct EpiResid {
    static constexpr bool PERM = true, AFTER_DRAIN = false;
    float* X; const float* gate;
    __device__ __forceinline__ void operator()(const f32x4 (&acc)[2][2][4][2], const Unit& u, int wr, int wc, int fr, int fq) const {
        const int row0 = u.pm * BM + wr * 64 + fr, col0 = u.pn * BM + wc * 32 + 8 * fq;
        const int mrow = (u.pm < 16) ? 0 : 1 + ((u.pm - 16) >> 3);
        const float* gp = gate + (size_t)mrow * 6144 + col0;
        f32x4 g[2][2];
#pragma unroll
        for (int bj = 0; bj < 2; ++bj) { g[bj][0] = *(const GAS f32x4*)(gp + bj * HALF); g[bj][1] = *(const GAS f32x4*)(gp + bj * HALF + 4); }
        EPI_FOR { float* xp = X + (size_t)(row0 + ai * HALF + m * 16) * 1024 + col0 + bj * HALF;
            const f32x4 x0 = *(const GAS f32x4*)xp, x1 = *(const GAS f32x4*)(xp + 4);
            *(GAS f32x4*)xp = x0 + g[bj][0] * acc[ai][bj][m][0]; *(GAS f32x4*)(xp + 4) = x1 + g[bj][1] * acc[ai][bj][m][1]; }
    }
};

template <class Epi, class Sched, bool ALIGN_EPI = false, bool SP2 = false>
__device__ __forceinline__ void gemm_phase(PG8_LAS unsigned char* lds, const Gemm g, const Sched& S, const Epi& E) {
    int tid_l = threadIdx.x; asm volatile("" : "+v"(tid_l));
    const int tid = tid_l, wid = __builtin_amdgcn_readfirstlane(tid >> 6), lane = tid & 63, wr = wid >> 2, wc = wid & 3, fr = lane & 15, fq = lane >> 4;
    const int K = g.K, nt = K / BK;
    unsigned voffA[2], voffB[2];
#pragma unroll
    for (int i = 0; i < 2; ++i) { int R, C; stage_rc(tid * 16 + i * 8192, R, C); const int Rb = Epi::PERM ? ((R & ~31) + perm32(R & 31)) : R;
        voffA[i] = (unsigned)(R * g.lda + C) * 2u; voffB[i] = (unsigned)(Rb * g.ldb + C) * 2u; }
    const size_t kstep = (size_t)(BK * 2);
    const size_t hstepA = (size_t)HALF * g.lda * 2, hstepB = (size_t)HALF * g.ldb * 2;
    const size_t tstepA = 2 * hstepA, tstepB = 2 * hstepB;
    const unsigned ldsw = (unsigned)wid * 1024u;
    const int aoff = lds_byte(wr * 64 + fr, fq * 8), boff = lds_byte(wc * 32 + fr, fq * 8);
#define PG8_SA(b, h) (((b) * 2 + (h)) * HTB)
#define PG8_SB(b, h) ((4 + (b) * 2 + (h)) * HTB)
#define PG8_STAGE(bufoff, gbase, voff) do { _Pragma("unroll") for (int _i = 0; _i < 2; ++_i) \
        __builtin_amdgcn_global_load_lds((const unsigned*)((const char*)(gbase) + (voff)[_i]), (PG8_LAS unsigned*)(lds + (bufoff) + ldsw + _i * 8192), 16, 0, 0); } while (0)
#define PG8_LDA(dst, b, h) do { _Pragma("unroll") for (int m = 0; m < 4; ++m) _Pragma("unroll") for (int k = 0; k < 2; ++k) dst[m][k] = *(const PG8_LAS bf16x8*)(lds + PG8_SA(b, h) + aoff + m * 2048 + k * 1024); } while (0)
#define PG8_LDB(dst, b, h) do { _Pragma("unroll") for (int n = 0; n < 2; ++n) _Pragma("unroll") for (int k = 0; k < 2; ++k) dst[n][k] = *(const PG8_LAS bf16x8*)(lds + PG8_SB(b, h) + boff + n * 2048 + k * 1024); } while (0)
#define PG8_MMA(ai, bj, At, Bt) do { __builtin_amdgcn_s_setprio(1); _Pragma("unroll") for (int m = 0; m < 4; ++m) _Pragma("unroll") for (int n = 0; n < 2; ++n) _Pragma("unroll") for (int k = 0; k < 2; ++k) \
        acc[ai][bj][m][n] = __builtin_amdgcn_mfma_f32_16x16x32_bf16(Bt[n][k], At[m][k], acc[ai][bj][m][n], 0, 0, 0); __builtin_amdgcn_s_setprio(0); } while (0)
#define PG8_WAIT_V(n) asm volatile("s_waitcnt vmcnt(" #n ")" ::: "memory")
#define PG8_WAIT_L(n) asm volatile("s_waitcnt lgkmcnt(" #n ")" ::: "memory")
#define PG8_BAR __builtin_amdgcn_s_barrier()
#define PG8_SCHED __builtin_amdgcn_sched_barrier(0)
    Unit cur, nxt; int ui = 0;
    if (!S.next(0, cur)) return;
    f32x4 acc[2][2][4][2];
#pragma unroll
    for (int a = 0; a < 2; ++a)
#pragma unroll
        for (int b = 0; b < 2; ++b)
#pragma unroll
            for (int m = 0; m < 4; ++m)
#pragma unroll
                for (int n = 0; n < 2; ++n) acc[a][b][m][n] = (f32x4){0.f, 0.f, 0.f, 0.f};
    bf16x8 At[4][2], B0[2][2], B1[2][2];
    const char* cA = (const char*)g.A + (size_t)cur.pm * tstepA; const char* cB = (const char*)g.Bt + (size_t)cur.pn * tstepB;
    S.a_ready(cur);
    if constexpr (SP2) {
        PG8_STAGE(PG8_SB(0, 0), cB, voffB); PG8_STAGE(PG8_SB(0, 1), cB + hstepB, voffB); PG8_STAGE(PG8_SA(0, 0), cA, voffA); PG8_STAGE(PG8_SA(0, 1), cA + hstepA, voffA);
        if (wr == 1) PG8_BAR;
        PG8_WAIT_V(2); PG8_BAR;
        PG8_STAGE(PG8_SB(1, 0), cB + kstep, voffB); PG8_STAGE(PG8_SA(1, 0), cA + kstep, voffA); PG8_STAGE(PG8_SB(1, 1), cB + hstepB + kstep, voffB);
        PG8_WAIT_V(6); PG8_BAR;
    } else {
        PG8_STAGE(PG8_SB(0, 0), cB, voffB); PG8_STAGE(PG8_SA(0, 0), cA, voffA); PG8_STAGE(PG8_SB(0, 1), cB + hstepB, voffB); PG8_STAGE(PG8_SA(0, 1), cA + hstepA, voffA);
        if (wr == 1) PG8_BAR;
        PG8_WAIT_V(4); PG8_BAR;
        PG8_STAGE(PG8_SB(1, 0), cB + kstep, voffB); PG8_STAGE(PG8_SA(1, 0), cA + kstep, voffA); PG8_STAGE(PG8_SB(1, 1), cB + hstepB + kstep, voffB);
        PG8_WAIT_V(6); PG8_BAR;
    }
    for (;;) {
        const bool has_next = S.next(ui + 1, nxt);
        const char* nA = has_next ? (const char*)g.A + (size_t)nxt.pm * tstepA : cA; const char* nB = has_next ? (const char*)g.Bt + (size_t)nxt.pn * tstepB : cB;
        for (int t = 0; t < nt; t += 2) {
            const bool last = (t == nt - 2);
            const char* a1 = cA + (size_t)(t + 1) * kstep;
            const char* a2 = last ? nA : cA + (size_t)(t + 2) * kstep; const char* b2 = last ? nB : cB + (size_t)(t + 2) * kstep;
            const char* a3 = a2 + kstep; const char* b3 = b2 + kstep;
            if (last && has_next) S.a_ready(nxt);
            if constexpr (SP2) {
            PG8_LDB(B0, 0, 0); PG8_LDB(B1, 0, 1); PG8_SCHED; PG8_LDA(At, 0, 0); PG8_STAGE(PG8_SA(1, 1), a1 + hstepA, voffA);
            PG8_WAIT_V(8); PG8_WAIT_L(0); PG8_BAR; PG8_MMA(0, 0, At, B0); PG8_MMA(0, 1, At, B1); PG8_BAR; PG8_SCHED;
            PG8_LDA(At, 0, 1); PG8_STAGE(PG8_SB(0, 0), b2, voffB); PG8_STAGE(PG8_SB(0, 1), b2 + hstepB, voffB); PG8_STAGE(PG8_SA(0, 0), a2, voffA);
            PG8_WAIT_V(8); PG8_WAIT_L(0); PG8_BAR; PG8_MMA(1, 0, At, B0); PG8_MMA(1, 1, At, B1); PG8_BAR; PG8_SCHED;
            PG8_LDB(B0, 1, 0); PG8_LDB(B1, 1, 1); PG8_SCHED; PG8_LDA(At, 1, 0); PG8_STAGE(PG8_SA(0, 1), a2 + hstepA, voffA);
            PG8_WAIT_V(8); PG8_WAIT_L(0); PG8_BAR; PG8_MMA(0, 0, At, B0); PG8_MMA(0, 1, At, B1); PG8_BAR; PG8_SCHED;
            PG8_LDA(At, 1, 1); PG8_STAGE(PG8_SB(1, 0), b3, voffB); PG8_STAGE(PG8_SB(1, 1), b3 + hstepB, voffB); PG8_STAGE(PG8_SA(1, 0), a3, voffA);
            PG8_WAIT_V(8); PG8_WAIT_L(0); PG8_BAR; PG8_MMA(1, 0, At, B0); PG8_MMA(1, 1, At, B1); PG8_BAR; PG8_SCHED;
            } else {
            PG8_LDB(B0, 0, 0); PG8_SCHED; PG8_LDA(At, 0, 0); PG8_STAGE(PG8_SA(1, 1), a1 + hstepA, voffA);
            PG8_WAIT_L(8); PG8_BAR; PG8_WAIT_L(0); PG8_MMA(0, 0, At, B0); PG8_BAR; PG8_SCHED;
            PG8_LDB(B1, 0, 1); PG8_STAGE(PG8_SB(0, 0), b2, voffB);
            PG8_BAR; PG8_WAIT_L(0); PG8_MMA(0, 1, At, B1); PG8_BAR;
            PG8_LDA(At, 0, 1); PG8_STAGE(PG8_SA(0, 0), a2, voffA);
            PG8_BAR; PG8_WAIT_L(0); PG8_MMA(1, 0, At, B0); PG8_BAR; PG8_SCHED;
            PG8_STAGE(PG8_SB(0, 1), b2 + hstepB, voffB);
            PG8_WAIT_V(6); PG8_BAR; PG8_MMA(1, 1, At, B1); PG8_BAR;
            PG8_LDB(B0, 1, 0); PG8_SCHED; PG8_LDA(At, 1, 0); PG8_STAGE(PG8_SA(0, 1), a2 + hstepA, voffA);
            PG8_WAIT_L(8); PG8_BAR; PG8_WAIT_L(0); PG8_MMA(0, 0, At, B0); PG8_BAR; PG8_SCHED;
            PG8_LDB(B1, 1, 1); PG8_STAGE(PG8_SB(1, 0), b3, voffB);
            PG8_BAR; PG8_WAIT_L(0); PG8_MMA(0, 1, At, B1); PG8_BAR;
            PG8_LDA(At, 1, 1); PG8_STAGE(PG8_SA(1, 0), a3, voffA);
            PG8_BAR; PG8_WAIT_L(0); PG8_MMA(1, 0, At, B0); PG8_BAR; PG8_SCHED;
            PG8_STAGE(PG8_SB(1, 1), b3 + hstepB, voffB);
            PG8_WAIT_V(6); PG8_BAR; PG8_MMA(1, 1, At, B1); PG8_BAR;
            }
        }
        if constexpr (ALIGN_EPI) { if (wr == 0) PG8_BAR; }
        if constexpr (!Epi::AFTER_DRAIN) { E(acc, cur, wr, wc, fr, fq); S.done(cur); }
        if (!has_next) break;
#pragma unroll
        for (int a = 0; a < 2; ++a)
#pragma unroll
            for (int b = 0; b < 2; ++b)
#pragma unroll
                for (int m = 0; m < 4; ++m)
#pragma unroll
                    for (int n = 0; n < 2; ++n) acc[a][b][m][n] = (f32x4){0.f, 0.f, 0.f, 0.f};
        cur = nxt; cA = nA; cB = nB; ++ui;
        if constexpr (ALIGN_EPI) { if (wr == 1) PG8_BAR; }
    }
    PG8_WAIT_V(0);
    if constexpr (!ALIGN_EPI) { if (wr == 0) PG8_BAR; }
    PG8_BAR;
    if constexpr (Epi::AFTER_DRAIN) { E.fused(acc, cur, wr, wc, fr, fq, lds, wid, lane); S.done(cur); }
#undef PG8_SA
#undef PG8_SB
#undef PG8_STAGE
#undef PG8_LDA
#undef PG8_LDB
#undef PG8_MMA
#undef PG8_WAIT_V
#undef PG8_WAIT_L
#undef PG8_BAR
#undef PG8_SCHED
}
}

constexpr int TCTX = 4096, TLAT = 8192, TT = 12288, DM = 1024, NKEYROWS = 13312;
constexpr float EPSN = 1e-6f;
constexpr size_t MiB = 1u << 20;
constexpr size_t WS_MOD = 0, MOD_BYTES = 2 * 5 * 6144 * 4, WS_BAR = 262144, BAR_REGION = 16384, ZERO_BYTES = WS_BAR + 5 * BAR_REGION;
constexpr size_t WS_HID = 1 * MiB;
constexpr size_t WS_WIN = 3 * MiB, WS_WG = 9 * MiB, WS_WUQ = 15 * MiB, WS_WKN = 16 * MiB, WS_WVV = 16 * MiB + 262144, WS_WB = 17 * MiB, WS_WO = 20 * MiB, WS_WUP = 22 * MiB, WS_WDN = 33 * MiB;
constexpr size_t WS_U = 39 * MiB, WS_ACT = 171 * MiB, WS_HBF = 171 * MiB;
constexpr size_t WS_QA = 39 * MiB, WS_KVR = 51 * MiB, WS_CQ = 57 * MiB, WS_CKVR = 69 * MiB, WS_HYR = 75 * MiB, WS_OA = 75 * MiB, WS_OB = 87 * MiB, WS_OC = 99 * MiB;
constexpr size_t WS_UT = 111 * MiB, WS_QB = 147 * MiB, WS_CKVALL = 195 * MiB, WS_KPEALL = 202 * MiB, WS_KNB = 203 * MiB, WS_VTB = 216 * MiB, WS_KA = 229 * MiB, WS_VTA = 233 * MiB;
constexpr size_t WS_S = 111 * MiB, WS_MBF = 135 * MiB, WS_MACC = 195 * MiB, WS_END = 256 * MiB;
constexpr int KA_LAT = 16 * 2 * 256 * 64;
constexpr int UT_LAT = 16 * 1536 * 256;
constexpr int OUT_K = 12582912, OUT_V = 13631488, OUT_CKV = 14680064, OUT_KPE = 16777216;
constexpr int LDS_BYTES = 147456;
constexpr int NPHASE = 24;

#ifndef GAS
#define GAS __attribute__((address_space(1)))
#endif
#define LAS __attribute__((address_space(3)))
typedef unsigned short bf16;
typedef unsigned v4u __attribute__((ext_vector_type(4)));
typedef unsigned v2u __attribute__((ext_vector_type(2)));
typedef float f32x4 __attribute__((ext_vector_type(4)));
typedef float f32x16 __attribute__((ext_vector_type(16)));
typedef short bf16x8 __attribute__((ext_vector_type(8)));
typedef short bf16x4 __attribute__((ext_vector_type(4)));
#define LDS_WAIT() asm volatile("s_waitcnt lgkmcnt(0)" ::: "memory")
__device__ __forceinline__ unsigned f2bf(float f) { unsigned u = __builtin_bit_cast(unsigned, f); return (u + 0x7fffu + ((u >> 16) & 1u)) >> 16; }
__device__ __forceinline__ unsigned pk2(float lo, float hi) { return f2bf(lo) | (f2bf(hi) << 16); }
__device__ __forceinline__ float bflo(unsigned w) { return __uint_as_float(w << 16); }
__device__ __forceinline__ float bfhi(unsigned w) { return __uint_as_float(w & 0xffff0000u); }
__device__ __forceinline__ float bf1(bf16 b) { return __uint_as_float(((unsigned)b) << 16); }
__device__ __forceinline__ void fsincos(float x, float& s, float& c) { float rev = x * 0.15915494309189535f; rev = rev - rintf(rev); s = __builtin_amdgcn_sinf(rev); c = __builtin_amdgcn_cosf(rev); }
__device__ __forceinline__ float fsin(float x) { float rev = x * 0.15915494309189535f; rev = rev - rintf(rev); return __builtin_amdgcn_sinf(rev); }
__device__ __forceinline__ float wave_sum(float v) {
#pragma unroll
    for (int o = 1; o < 64; o <<= 1) v += __shfl_xor(v, o);
    return v;
}
__device__ __forceinline__ void rope2(float& x0, float& x1, float ang) { float s, c; fsincos(ang, s, c); const float a = x0 * c - x1 * s, b = x0 * s + x1 * c; x0 = a; x1 = b; }
#define L2_10000 13.287712379549449f

__device__ __forceinline__ void transpose_item(const float* W, size_t ldw, int k0, int n0, bf16* WT, size_t ldt, int drow0, LAS float* scr, int lane) {
#pragma unroll 8
    for (int i = 0; i < 32; ++i) { const int kk = 2 * i + (lane >> 5); scr[kk * 33 + (lane & 31)] = W[(size_t)(k0 + kk) * ldw + n0 + (lane & 31)]; }
    LDS_WAIT(); asm volatile("" ::: "memory");
    const int c = lane & 7;
#pragma unroll
    for (int j = 0; j < 4; ++j) { const int n = (lane >> 3) + 8 * j; const LAS float* s = scr + (8 * c) * 33 + n;
        v4u o; o.x = pk2(s[0 * 33], s[1 * 33]); o.y = pk2(s[2 * 33], s[3 * 33]); o.z = pk2(s[4 * 33], s[5 * 33]); o.w = pk2(s[6 * 33], s[7 * 33]);
        *(GAS v4u*)(WT + (size_t)(drow0 + n) * ldt + k0 + 8 * c) = o; }
    LDS_WAIT(); asm volatile("" ::: "memory");
}

#define XB_TMO      128
#define XB_XCNT(j)  (256  + 64 * (j))
#define XB_XSUB(j)  (1280 + 64 * (j))
#define XB_XGEN(j)  (2304 + 64 * (j))
#define XB_TOP      3328
#define XB_TOPGEN   3392
#define XCD_BAR_WORDS 3456
#define XB_SPIN_CAP (1u << 18)

__device__ __forceinline__ unsigned xb_ld(unsigned* p)              { return __hip_atomic_load(p, __ATOMIC_RELAXED, __HIP_MEMORY_SCOPE_AGENT); }
__device__ __forceinline__ unsigned xb_add(unsigned* p, unsigned v) { return __hip_atomic_fetch_add(p, v, __ATOMIC_RELAXED, __HIP_MEMORY_SCOPE_AGENT); }
__device__ __forceinline__ unsigned xb_xcc_id() { return (unsigned)__builtin_amdgcn_s_getreg((3 << 11) | 20) & 0xFu; }
#define XB_SPIN(cond, bar) do { unsigned _sp = 0; while (cond) { __builtin_amdgcn_s_sleep(1); \
    if ((++_sp & 255u) == 0u) { if (xb_ld(&(bar)[XB_TMO])) break; if (_sp > XB_SPIN_CAP) { atomicAdd(&(bar)[XB_TMO], 1u); break; } } } } while (0)

struct XcdBarrier {
    unsigned* bar; unsigned x;
    volatile LAS unsigned* st;
};

__device__ __forceinline__ XcdBarrier xcd_barrier_post(unsigned* bar, volatile LAS unsigned* st) {
    XcdBarrier b; b.bar = bar; b.x = xb_xcc_id(); b.st = st;
    if (threadIdx.x == 0) (void)xb_add(&bar[XB_XCNT(b.x)], 1u);
    return b;
}
__device__ __forceinline__ void xcd_barrier_complete(unsigned* bar, unsigned x, unsigned& nloc, unsigned& nx) {
    const unsigned G = gridDim.x * gridDim.y * gridDim.z;
    unsigned sum, cnt, mine, sp = 0u;
    for (;;) {
        sum = 0u; cnt = 0u; mine = 0u;
#pragma unroll
        for (unsigned j = 0; j < 16; ++j) { const unsigned c = xb_ld(&bar[XB_XCNT(j)]); sum += c; cnt += (c > 0u) ? 1u : 0u; mine = (j == x) ? c : mine; }
        if (sum == G) break;
        __builtin_amdgcn_s_sleep(1);
        if ((++sp & 255u) == 0u) { if (xb_ld(&bar[XB_TMO])) break; if (sp > XB_SPIN_CAP) { atomicAdd(&bar[XB_TMO], 1u); break; } }
    }
    nloc = mine > 0u ? mine : 1u; nx = cnt > 0u ? cnt : 1u;
}

__device__ __forceinline__ void xcd_barrier(const XcdBarrier& b) {
    asm volatile("s_waitcnt vmcnt(0)" ::: "memory");
    __syncthreads();
    if (threadIdx.x == 0) {
        unsigned* bar = b.bar;
        __builtin_amdgcn_s_waitcnt(0);
        unsigned nloc = b.st[0], nx = b.st[1];
        if (nloc == 0u) { xcd_barrier_complete(bar, b.x, nloc, nx); b.st[0] = nloc; b.st[1] = nx; }
        const unsigned old = xb_add(&bar[XB_XSUB(b.x)], 1u);
        const unsigned gen = old / nloc;
        if (old + 1u == (gen + 1u) * nloc) {
            __builtin_amdgcn_fence(__ATOMIC_RELEASE, "agent");
            asm volatile("s_waitcnt vmcnt(0)" ::: "memory");
            const unsigned og = xb_add(&bar[XB_TOP], 1u);
            const unsigned tg = og / nx;
            if (og + 1u == (tg + 1u) * nx) xb_add(&bar[XB_TOPGEN], 1u);
            else XB_SPIN(xb_ld(&bar[XB_TOPGEN]) == tg, bar);
            __builtin_amdgcn_fence(__ATOMIC_ACQUIRE, "agent");
            xb_add(&bar[XB_XGEN(b.x)], 1u);
            asm volatile("s_waitcnt vmcnt(0)" ::: "memory");
        } else {
            XB_SPIN(xb_ld(&bar[XB_XGEN(b.x)]) == gen, bar);
            __builtin_amdgcn_fence(__ATOMIC_ACQUIRE, "agent");
            asm volatile("s_waitcnt vmcnt(0)" ::: "memory");
        }
    }
    __syncthreads();
}


struct Args { const float* in[35]; float* out; unsigned char* ws; int ph_lo, ph_hi, li, pad; };

__device__ __forceinline__ void wconv_phase(const Args& a, int l, LAS unsigned char* lds, int gw, int NGW, int gt, int NGT, int wave, int lane) {
    LAS float* scr = (LAS float*)(lds + wave * 16384);
    unsigned char* ws = a.ws;
    bf16 *WIN = (bf16*)(ws + WS_WIN), *WG = (bf16*)(ws + WS_WG), *WUQ = (bf16*)(ws + WS_WUQ), *WKN = (bf16*)(ws + WS_WKN), *WVV = (bf16*)(ws + WS_WVV), *WB = (bf16*)(ws + WS_WB), *WO = (bf16*)(ws + WS_WO), *WUP = (bf16*)(ws + WS_WUP), *WDN = (bf16*)(ws + WS_WDN);
    constexpr int I1 = 16 * 189, I2 = 6 * 24, I3 = 4 * 32, I4 = 3 * 8 * 32, I5 = 16 * 32, I6 = 16 * 176, I7 = 44 * 32, NIT = I1 + I2 + I3 + I4 + I5 + I6 + I7;
    for (int it = gw; it < NIT; it += NGW) {
        int r = it;
        if (r < I1) { const int kb = r / 189, n0 = 32 * (r % 189); bf16* dst = WIN; int drow;
            if (n0 < 1152) drow = n0; else if (n0 < 1408) drow = n0 + 128; else if (n0 < 1440) drow = 1152 + (n0 - 1408); else if (n0 < 2976) drow = 1536 + (n0 - 1440); else { dst = WG; drow = n0 - 2976; }
            transpose_item(a.in[12] + (size_t)l * 1024 * 6048, 6048, 64 * kb, n0, dst, 1024, drow, scr, lane); continue; } r -= I1;
        if (r < I2) { const int kb = r / 24, n0 = 32 * (r % 24); transpose_item(a.in[17] + (size_t)l * 384 * 768, 768, 64 * kb, n0, WUQ, 384, n0, scr, lane); continue; } r -= I2;
        if (r < I3) { const int kb = r / 32, n0 = 32 * (r % 32); const int h = n0 >> 7, c0 = n0 & 127;
            transpose_item(a.in[18] + (size_t)l * 256 * 1024, 1024, 64 * kb, n0, (c0 < 64) ? WKN : WVV, 256, h * 64 + (c0 & 63), scr, lane); continue; } r -= I3;
        if (r < I4) { const int n = r / 256, q = r % 256, kb = q / 32, n0 = 32 * (q % 32);
            transpose_item(a.in[28] + ((size_t)l * 3 + n) * 512 * 1024, 1024, 64 * kb, n0, WB + (size_t)n * 1024 * 512, 512, n0, scr, lane); continue; } r -= I4;
        if (r < I5) { const int kb = r / 32, n0 = 32 * (r % 32); transpose_item(a.in[29] + (size_t)l * 1024 * 1024, 1024, 64 * kb, n0, WO, 1024, n0, scr, lane); continue; } r -= I5;
        if (r < I6) { const int kb = r / 176, n0 = 32 * (r % 176); transpose_item(a.in[30] + (size_t)l * 1024 * 5632, 5632, 64 * kb, n0, WUP, 1024, n0, scr, lane); continue; } r -= I6;
        { const int kb = r / 32, n0 = 32 * (r % 32); transpose_item(a.in[33] + (size_t)l * 2816 * 1024, 1024, 64 * kb, n0, WDN, 2816, n0, scr, lane); }
    }
    for (int i = gt; i < 96 * 1024 / 8; i += NGT) *(GAS v4u*)(WIN + (size_t)1184 * 1024 + (size_t)i * 8) = (v4u){0u, 0u, 0u, 0u};
}

__device__ __forceinline__ void norm_phase(const Args& a, int l, int which, bool first, int gw, int NGW, int lane) {
    const GAS float* mod = (const GAS float*)(a.ws + WS_MOD) + (size_t)l * 5 * 6144;
    GAS bf16* HBF = (GAS bf16*)(a.ws + WS_HBF);
    const GAS float* gv = (const GAS float*)((which == 0) ? a.in[10] + l * 1024 : (which == 1) ? a.in[11] + l * 1024 : a.in[34]);
    GAS float* outp = (GAS float*)a.out;
    const int shoff = (which == 0) ? 0 : 3072, scoff = shoff + 1024;
    #pragma unroll 1
    for (int row0 = gw; row0 < TT; row0 += 4 * NGW) {
        f32x4 v[4][4];
#pragma unroll
        for (int q = 0; q < 4; ++q) { const int row = row0 + q * NGW; const int rr = row < TT ? row : row0;
            const GAS float* src = first ? (const GAS float*)(rr < TCTX ? a.in[0] + (size_t)rr * DM : a.in[1] + (size_t)(rr - TCTX) * DM) : (const GAS float*)(outp + (size_t)rr * DM);
#pragma unroll
            for (int j = 0; j < 4; ++j) v[q][j] = *(const GAS f32x4*)(src + 4 * lane + 256 * j); }
#pragma unroll
        for (int q = 0; q < 4; ++q) { const int row = row0 + q * NGW; if (row >= TT) continue;
            float ss = 0.f;
#pragma unroll
            for (int j = 0; j < 4; ++j) ss += (v[q][j].x * v[q][j].x + v[q][j].y * v[q][j].y) + (v[q][j].z * v[q][j].z + v[q][j].w * v[q][j].w);
            if (first) {
#pragma unroll
                for (int j = 0; j < 4; ++j) *(GAS f32x4*)(outp + (size_t)row * DM + 4 * lane + 256 * j) = v[q][j]; }
            const float rs = rsqrtf(wave_sum(ss) * (1.f / DM) + EPSN);
            const int mrow = row < TCTX ? 0 : 1 + ((row - TCTX) >> 11);
            const GAS float* mp = mod + (size_t)mrow * 6144;
#pragma unroll
            for (int j = 0; j < 4; ++j) { const int col = 4 * lane + 256 * j; const f32x4 g = *(const GAS f32x4*)(gv + col);
                if (which == 2) { *(GAS f32x4*)(outp + (size_t)row * DM + col) = v[q][j] * rs * g; }
                else { const f32x4 sc = *(const GAS f32x4*)(mp + scoff + col), sh = *(const GAS f32x4*)(mp + shoff + col);
                    const f32x4 y = v[q][j] * rs * g * (sc + 1.f) + sh;
                    *(GAS v2u*)(HBF + (size_t)row * DM + col) = (v2u){pk2(y.x, y.y), pk2(y.z, y.w)}; } } }
    }
}
__device__ __forceinline__ void p0_mod_hid(const Args& a, LAS unsigned char* lds, int bid, int G, int tid, int gw, int NGW, int lane) {
    float* mod = (float*)(a.ws + WS_MOD);
    LAS float* sc = (LAS float*)lds;
    for (int it = bid; it < 384; it += G) {
        const int l = it / 192, rem = it % 192, kc = rem / 12, jb = rem % 12;
        if (tid < 320) { const int r = tid >> 6, kk = tid & 63, k = kc * 64 + kk; const float cv = (r == 0) ? a.in[7][k] : a.in[6][(r - 1) * 1024 + k]; sc[tid] = cv / (1.f + __expf(-cv)); }
        __syncthreads();
        const int j = jb * 512 + tid;
        const GAS float* wp = (const GAS float*)(a.in[8] + ((size_t)l * 1024 + kc * 64) * 6144 + j);
        float acc[5] = {0.f, 0.f, 0.f, 0.f, 0.f};
#pragma unroll 8
        for (int kk = 0; kk < 64; ++kk) { const float w = wp[(size_t)kk * 6144];
#pragma unroll
            for (int r = 0; r < 5; ++r) acc[r] += sc[r * 64 + kk] * w; }
        const float bias = (kc == 0) ? a.in[9][l * 6144 + j] : 0.f;
#pragma unroll
        for (int r = 0; r < 5; ++r) atomicAdd(mod + (size_t)(l * 5 + r) * 6144 + j, acc[r] + bias);
        __syncthreads();
    }
    float* HID = (float*)(a.ws + WS_HID);
    for (int it = gw; it < 2 * 2304; it += NGW) {
        const int l = it / 2304, q = it % 2304; const int L = q < 256 ? 256 : 2048, t = q < 256 ? q : q - 256;
        const float tn = (float)t / (float)(L - 1);
        float zi = 0.f;
        if (lane == 0) zi = tn;
        else if (lane <= 16) { const int bi = (lane - 1) & 7; const float band = 1e-4f + (float)bi * ((7.f - 1e-4f) / 7.f); const float ang = (6.283185307179586f / (float)L) * (float)t * band; float s, c; fsincos(ang, s, c); zi = (lane <= 8) ? c : -s; }
        float s1 = a.in[22][l * 64 + lane];
#pragma unroll
        for (int i = 0; i < 17; ++i) s1 += __shfl(zi, i) * a.in[21][(l * 17 + i) * 64 + lane];
        const float h1 = fsin(a.in[26][(l * 2 + 0) * 64 + lane] * s1);
        float s2 = a.in[24][l * 64 + lane];
#pragma unroll 8
        for (int i = 0; i < 64; ++i) s2 += __shfl(h1, i) * a.in[23][(l * 64 + i) * 64 + lane];
        HID[(size_t)it * 64 + lane] = fsin(a.in[26][(l * 2 + 1) * 64 + lane] * s2);
    }
}

__device__ __forceinline__ void post_phase(const Args& a, int l, LAS unsigned char* lds, int bid, int G, int tid, int gw, int NGW, int gt, int NGT, int lane) {
    unsigned char* ws = a.ws;
    GAS bf16 *QA = (GAS bf16*)(ws + WS_QA), *KVR = (GAS bf16*)(ws + WS_KVR), *CQ = (GAS bf16*)(ws + WS_CQ), *CKVR = (GAS bf16*)(ws + WS_CKVR), *HYR = (GAS bf16*)(ws + WS_HYR);
    GAS bf16 *UT = (GAS bf16*)(ws + WS_UT), *CKVALL = (GAS bf16*)(ws + WS_CKVALL), *KPEALL = (GAS bf16*)(ws + WS_KPEALL), *KA = (GAS bf16*)(ws + WS_KA), *VTA = (GAS bf16*)(ws + WS_VTA);
    GAS float* outp = (GAS float*)a.out;
    for (int i = gt; i < 4 * 256 * 128; i += NGT) { const int b = i >> 15, p = (i >> 7) & 255, kvh = (i >> 6) & 1, d = i & 63;
        const size_t s = ((size_t)(b * 2 + l) * 256 + p) * 128 + kvh * 64 + d;
        KA[KA_LAT + ((b * 2 + kvh) * 2304 + p) * 64 + d] = (bf16)f2bf(a.in[2][s]);
        VTA[KA_LAT + ((b * 2 + kvh) * 64 + d) * 2304 + p] = (bf16)f2bf(a.in[3][s]); }
    for (int i = gt; i < 4 * 256 * 256; i += NGT) { const int b = i >> 16, p = (i >> 8) & 255, j = i & 255;
        CKVALL[(size_t)(TCTX + b * 2304 + p) * 256 + j] = (bf16)f2bf(a.in[4][((size_t)(b * 2 + l) * 256 + p) * 256 + j]); }
    for (int i = gt; i < 4 * 256 * 32; i += NGT) { const int b = i >> 13, p = (i >> 5) & 255, j = i & 31;
        KPEALL[(size_t)(TCTX + b * 2304 + p) * 32 + j] = (bf16)f2bf(a.in[5][((size_t)(b * 2 + l) * 256 + p) * 32 + j]); }
    const GAS float *gq = (const GAS float*)(a.in[13] + l * 64), *gk = (const GAS float*)(a.in[14] + l * 64), *gcq = (const GAS float*)(a.in[15] + l * 384), *gkv = (const GAS float*)(a.in[16] + l * 256);
    for (int row = gw; row < TT; row += NGW) {
        const bool lat = row >= TCTX;
        const int b = lat ? (row - TCTX) >> 11 : row >> 8, t = lat ? (row - TCTX) & 2047 : row & 255;
        const float grow = (float)(t >> 6), gcol = (float)(t & 63);
        const int keyrow = lat ? TCTX + b * 2304 + 256 + t : row;
        { v4u w = *(const GAS v4u*)(QA + (size_t)row * 512 + 8 * lane);
          float x[8] = {bflo(w.x), bfhi(w.x), bflo(w.y), bfhi(w.y), bflo(w.z), bfhi(w.z), bflo(w.w), bfhi(w.w)};
          float ss = 0.f;
#pragma unroll
          for (int j = 0; j < 8; ++j) ss += x[j] * x[j];
          ss += __shfl_xor(ss, 1); ss += __shfl_xor(ss, 2); ss += __shfl_xor(ss, 4);
          const float rs = rsqrtf(ss * (1.f / 64.f) + EPSN); const int d0 = 8 * (lane & 7);
#pragma unroll
          for (int j = 0; j < 8; ++j) x[j] = x[j] * rs * gq[d0 + j];
          if (lat) {
#pragma unroll
              for (int k = 0; k < 4; ++k) { const int i = 4 * (lane & 7) + k; const float inv = __builtin_amdgcn_exp2f(-(float)(i & 15) * (L2_10000 / 16.f)); rope2(x[2 * k], x[2 * k + 1], (i < 16 ? grow : gcol) * inv); } }
          *(GAS v4u*)(QA + (size_t)row * 512 + 8 * lane) = (v4u){pk2(x[0], x[1]), pk2(x[2], x[3]), pk2(x[4], x[5]), pk2(x[6], x[7])}; }
        { const v2u w = *(const GAS v2u*)(KVR + (size_t)row * 256 + 4 * lane);
          float x[4] = {bflo(w.x), bfhi(w.x), bflo(w.y), bfhi(w.y)};
          float ss = (x[0] * x[0] + x[1] * x[1]) + (x[2] * x[2] + x[3] * x[3]);
          ss += __shfl_xor(ss, 1); ss += __shfl_xor(ss, 2); ss += __shfl_xor(ss, 4); ss += __shfl_xor(ss, 8);
          const int kvh = (lane >> 4) & 1, d0 = 4 * (lane & 15);
          if (lane < 32) {
              const float rs = rsqrtf(ss * (1.f / 64.f) + EPSN);
#pragma unroll
              for (int j = 0; j < 4; ++j) x[j] = x[j] * rs * gk[d0 + j];
              if (!lat) { *(GAS f32x4*)(outp + OUT_K + ((size_t)(b * 2 + l) * 256 + t) * 128 + kvh * 64 + d0) = (f32x4){x[0], x[1], x[2], x[3]};
                  *(GAS v2u*)(KA + ((size_t)(b * 2 + kvh) * 256 + t) * 64 + d0) = (v2u){pk2(x[0], x[1]), pk2(x[2], x[3])}; }
              else {
#pragma unroll
                  for (int k = 0; k < 2; ++k) { const int i = 2 * (lane & 15) + k; const float inv = __builtin_amdgcn_exp2f(-(float)(i & 15) * (L2_10000 / 16.f)); rope2(x[2 * k], x[2 * k + 1], (i < 16 ? grow : gcol) * inv); }
                  *(GAS v2u*)(KA + KA_LAT + ((size_t)(b * 2 + kvh) * 2304 + 256 + t) * 64 + d0) = (v2u){pk2(x[0], x[1]), pk2(x[2], x[3])}; }
          } else {
              if (!lat) { *(GAS f32x4*)(outp + OUT_V + ((size_t)(b * 2 + l) * 256 + t) * 128 + kvh * 64 + d0) = (f32x4){x[0], x[1], x[2], x[3]};
#pragma unroll
                  for (int j = 0; j < 4; ++j) VTA[((size_t)(b * 2 + kvh) * 64 + d0 + j) * 256 + t] = (bf16)f2bf(x[j]); }
              else {
#pragma unroll
                  for (int j = 0; j < 4; ++j) VTA[KA_LAT + ((size_t)(b * 2 + kvh) * 64 + d0 + j) * 2304 + 256 + t] = (bf16)f2bf(x[j]); }
          } }
        { GAS unsigned* p = (GAS unsigned*)(CQ + (size_t)row * 512 + 6 * lane);
          const unsigned w0 = p[0], w1 = p[1], w2 = p[2];
          float x[6] = {bflo(w0), bfhi(w0), bflo(w1), bfhi(w1), bflo(w2), bfhi(w2)};
          float ss = 0.f;
#pragma unroll
          for (int j = 0; j < 6; ++j) ss += x[j] * x[j];
          const float rs = rsqrtf(wave_sum(ss) * (1.f / 384.f) + EPSN);
#pragma unroll
          for (int j = 0; j < 6; ++j) x[j] = x[j] * rs * gcq[6 * lane + j];
          p[0] = pk2(x[0], x[1]); p[1] = pk2(x[2], x[3]); p[2] = pk2(x[4], x[5]);
          if (lane < 16) { const unsigned w = *(const GAS unsigned*)(CQ + (size_t)row * 512 + 384 + 2 * lane); float y0 = bflo(w), y1 = bfhi(w);
              if (!lat) { outp[OUT_KPE + ((size_t)(b * 2 + l) * 256 + t) * 32 + 2 * lane] = y0; outp[OUT_KPE + ((size_t)(b * 2 + l) * 256 + t) * 32 + 2 * lane + 1] = y1; }
              else { const float inv = __builtin_amdgcn_exp2f(-(float)(lane & 7) * (L2_10000 / 8.f)); rope2(y0, y1, (lane < 8 ? grow : gcol) * inv); }
              *(GAS unsigned*)(KPEALL + (size_t)keyrow * 32 + 2 * lane) = pk2(y0, y1); } }
        { const v2u w = *(const GAS v2u*)(CKVR + (size_t)row * 256 + 4 * lane);
          float x[4] = {bflo(w.x), bfhi(w.x), bflo(w.y), bfhi(w.y)};
          const float ss = (x[0] * x[0] + x[1] * x[1]) + (x[2] * x[2] + x[3] * x[3]);
          const float rs = rsqrtf(wave_sum(ss) * (1.f / 256.f) + EPSN);
#pragma unroll
          for (int j = 0; j < 4; ++j) x[j] = x[j] * rs * gkv[4 * lane + j];
          if (!lat) *(GAS f32x4*)(outp + OUT_CKV + ((size_t)(b * 2 + l) * 256 + t) * 256 + 4 * lane) = (f32x4){x[0], x[1], x[2], x[3]};
          *(GAS v2u*)(CKVALL + (size_t)keyrow * 256 + 4 * lane) = (v2u){pk2(x[0], x[1]), pk2(x[2], x[3])}; }
    }
    LAS float* tile = (LAS float*)lds;
    const GAS float *sw = (const GAS float*)(a.in[19] + (size_t)l * 3 * 1536), *sb = (const GAS float*)(a.in[20] + (size_t)l * 1536);
    for (int it = bid; it < 192 * 24; it += G) {
        const int tb = it / 24, cb = it % 24, row0 = tb * 64;
        const bool lat = row0 >= TCTX; const int L = lat ? 2048 : 256;
        const int b = lat ? (row0 - TCTX) >> 11 : row0 >> 8, t0 = lat ? (row0 - TCTX) & 2047 : row0 & 255;
        { const int rr = tid >> 3, c8 = tid & 7; const v4u w = *(const GAS v4u*)(HYR + (size_t)(row0 + rr) * 1536 + cb * 64 + 8 * c8);
          LAS float* tp = tile + (rr + 1) * 65 + 8 * c8;
          tp[0] = bflo(w.x); tp[1] = bfhi(w.x); tp[2] = bflo(w.y); tp[3] = bfhi(w.y); tp[4] = bflo(w.z); tp[5] = bfhi(w.z); tp[6] = bflo(w.w); tp[7] = bfhi(w.w); }
        if (tid < 16) { const int which = tid >> 3, c8 = tid & 7; const bool ok = which ? (t0 + 64 < L) : (t0 > 0); const int rsrc = which ? row0 + 64 : row0 - 1;
          v4u w = (v4u){0u, 0u, 0u, 0u}; if (ok) w = *(const GAS v4u*)(HYR + (size_t)rsrc * 1536 + cb * 64 + 8 * c8);
          LAS float* tp = tile + (which ? 65 : 0) * 65 + 8 * c8;
          tp[0] = bflo(w.x); tp[1] = bfhi(w.x); tp[2] = bflo(w.y); tp[3] = bfhi(w.y); tp[4] = bflo(w.z); tp[5] = bfhi(w.z); tp[6] = bflo(w.w); tp[7] = bfhi(w.w); }
        __syncthreads();
        { const int c = tid >> 3, tc = tid & 7, cg_ = cb * 64 + c; const float w0 = sw[cg_], w1 = sw[1536 + cg_], w2 = sw[3072 + cg_], bb = sb[cg_];
          float u[8];
#pragma unroll
          for (int k = 0; k < 8; ++k) { const int tr = 8 * tc + k; u[k] = w0 * tile[tr * 65 + c] + w1 * tile[(tr + 1) * 65 + c] + w2 * tile[(tr + 2) * 65 + c] + bb; }
          const size_t base = lat ? (size_t)UT_LAT + ((size_t)b * 1536 + cg_) * 2048 : ((size_t)b * 1536 + cg_) * 256;
          *(GAS v4u*)(UT + base + t0 + 8 * tc) = (v4u){pk2(u[0], u[1]), pk2(u[2], u[3]), pk2(u[4], u[5]), pk2(u[6], u[7])}; }
        __syncthreads();
    }
}

__device__ __forceinline__ void ffnconv_phase(const Args& a, int l, int gt, int NGT) {
    const GAS bf16* U = (const GAS bf16*)(a.ws + WS_U); GAS bf16* ACT = (GAS bf16*)(a.ws + WS_ACT);
    const GAS float *cw = (const GAS float*)(a.in[31] + (size_t)l * 3 * 5632), *cb = (const GAS float*)(a.in[32] + (size_t)l * 5632);
#pragma unroll 1
    for (int idx = gt; idx < 1536 * 352; idx += NGT) {
        const int tb = idx / 352, ch = idx % 352, row0 = tb * 8, c0 = ch * 8;
        const bool lat = row0 >= TCTX; const int t0 = lat ? (row0 - TCTX) & 2047 : row0 & 255, L = lat ? 2048 : 256;
        v4u ra[10], rg[10];
#pragma unroll
        for (int i = 0; i < 10; ++i) { const int t = t0 + i - 1; const bool ok = (t >= 0) && (t < L); const size_t rr = (size_t)(row0 + (ok ? i - 1 : 0)) * 5632 + c0;
            ra[i] = *(const GAS v4u*)(U + rr); rg[i] = *(const GAS v4u*)(U + rr + 2816);
            if (!ok) { ra[i] = (v4u){0u, 0u, 0u, 0u}; rg[i] = (v4u){0u, 0u, 0u, 0u}; } }
        float wa[3][8], wg[3][8], ba[8], bg[8];
#pragma unroll
        for (int j = 0; j < 8; ++j) { ba[j] = cb[c0 + j]; bg[j] = cb[2816 + c0 + j];
#pragma unroll
            for (int k = 0; k < 3; ++k) { wa[k][j] = cw[k * 5632 + c0 + j]; wg[k][j] = cw[k * 5632 + 2816 + c0 + j]; } }
#pragma unroll
        for (int i = 0; i < 8; ++i) {
            float o[8];
#pragma unroll
            for (int j2 = 0; j2 < 4; ++j2) {
                const unsigned a0 = ra[i][j2], a1 = ra[i + 1][j2], a2 = ra[i + 2][j2], g0 = rg[i][j2], g1 = rg[i + 1][j2], g2 = rg[i + 2][j2];
                { const int j = 2 * j2; const float av = wa[0][j] * bflo(a0) + wa[1][j] * bflo(a1) + wa[2][j] * bflo(a2) + ba[j], gv = wg[0][j] * bflo(g0) + wg[1][j] * bflo(g1) + wg[2][j] * bflo(g2) + bg[j]; o[j] = gv / (1.f + __expf(-gv)) * av; }
                { const int j = 2 * j2 + 1; const float av = wa[0][j] * bfhi(a0) + wa[1][j] * bfhi(a1) + wa[2][j] * bfhi(a2) + ba[j], gv = wg[0][j] * bfhi(g0) + wg[1][j] * bfhi(g1) + wg[2][j] * bfhi(g2) + bg[j]; o[j] = gv / (1.f + __expf(-gv)) * av; } }
            *(GAS v4u*)(ACT + (size_t)(row0 + i) * 2816 + c0) = (v4u){pk2(o[0], o[1]), pk2(o[2], o[3]), pk2(o[4], o[5]), pk2(o[6], o[7])};
        }
    }
}
__device__ __forceinline__ unsigned cvtpk(float lo, float hi) { unsigned r; asm("v_cvt_pk_bf16_f32 %0, %1, %2" : "=v"(r) : "v"(lo), "v"(hi)); return r; }
template <int DK>
__device__ __forceinline__ void attn_unit(LAS unsigned char* lds, int tid, const bf16* Qp, int qpitch, const bf16* Kp, int kpitch, const bf16* Kpe, const bf16* Vt, size_t vpitch,
                                          int nkeys, bf16* Op, int opitch, float sl2, bool rope, int pos0) {
    constexpr int NS = DK / 16;
    asm volatile("" : "+v"(tid));
    const int lane = tid & 63, wave = tid >> 6, r = lane & 31, h = lane >> 5;
    bf16x8 qf[NS];
    { const bf16* qrow = Qp + (size_t)(wave * 32 + r) * qpitch;
#pragma unroll
      for (int s = 0; s < NS; ++s) qf[s] = *(const GAS bf16x8*)(qrow + 16 * s + 8 * h);
      if (DK == 96 && rope) { const int t = pos0 + wave * 32 + r; const float grow = (float)(t >> 6), gcol = (float)(t & 63);
#pragma unroll
          for (int sp = 0; sp < 2; ++sp) { bf16x8 v = qf[NS - 2 + sp];
#pragma unroll
              for (int k = 0; k < 4; ++k) { float x0 = bf1((bf16)v[2 * k]), x1 = bf1((bf16)v[2 * k + 1]);
                  const float inv = __builtin_amdgcn_exp2f(-(float)(4 * h + k) * (L2_10000 / 8.f)); rope2(x0, x1, (sp == 0 ? grow : gcol) * inv);
                  v[2 * k] = (short)f2bf(x0); v[2 * k + 1] = (short)f2bf(x1); }
              qf[NS - 2 + sp] = v; } } }
    const int kkey = tid >> 3, kch = tid & 7, pkey = tid >> 2, pch = tid & 3;
    f32x16 o0, o1;
#pragma unroll
    for (int i = 0; i < 16; ++i) { o0[i] = 0.f; o1[i] = 0.f; }
    float mrun = -__builtin_inff(), lrun = 0.f;
    v4u rk, rv, rp = (v4u){0u, 0u, 0u, 0u};
    const int ntile = nkeys >> 6;
#define ATT_LOAD(kt) do { const int key0 = (kt) * 64; rk = *(const GAS v4u*)(Kp + (size_t)(key0 + kkey) * kpitch + 8 * kch); rv = *(const GAS v4u*)(Vt + (size_t)kkey * vpitch + key0 + 8 * kch); \
        if (DK == 96 && tid < 256) rp = *(const GAS v4u*)(Kpe + (size_t)(key0 + pkey) * 32 + 8 * pch); } while (0)
#define ATT_WRITE(buf) do { *(LAS v4u*)(lds + (buf) * 13312 + kkey * 208 + kch * 16) = rk; *(LAS v4u*)(lds + 26624 + (buf) * 9216 + kkey * 144 + kch * 16) = rv; \
        if (DK == 96 && tid < 256) *(LAS v4u*)(lds + (buf) * 13312 + pkey * 208 + 128 + pch * 16) = rp; } while (0)
    ATT_LOAD(0); ATT_WRITE(0); __syncthreads();
    for (int kt = 0; kt < ntile; ++kt) {
        const int buf = kt & 1;
        if (kt + 1 < ntile) ATT_LOAD(kt + 1);
        const LAS unsigned char* kb = lds + buf * 13312; const LAS unsigned char* vb = lds + 26624 + buf * 9216;
        f32x16 s0, s1;
#pragma unroll
        for (int i = 0; i < 16; ++i) { s0[i] = 0.f; s1[i] = 0.f; }
#pragma unroll
        for (int s = 0; s < NS; ++s) {
            const bf16x8 a0 = *(const LAS bf16x8*)(kb + r * 208 + (16 * s + 8 * h) * 2), a1 = *(const LAS bf16x8*)(kb + (32 + r) * 208 + (16 * s + 8 * h) * 2);
            s0 = __builtin_amdgcn_mfma_f32_32x32x16_bf16(a0, qf[s], s0, 0, 0, 0); s1 = __builtin_amdgcn_mfma_f32_32x32x16_bf16(a1, qf[s], s1, 0, 0, 0); }
        float mx = s0[0];
#pragma unroll
        for (int i = 1; i < 16; ++i) mx = fmaxf(mx, s0[i]);
#pragma unroll
        for (int i = 0; i < 16; ++i) mx = fmaxf(mx, s1[i]);
        mx = fmaxf(mx, __shfl_xor(mx, 32));
        const float mnew = fmaxf(mrun, mx), alpha = __builtin_amdgcn_exp2f((mrun - mnew) * sl2), nm = mnew * sl2;
        float sum = 0.f;
#pragma unroll
        for (int i = 0; i < 16; ++i) { s0[i] = __builtin_amdgcn_exp2f(s0[i] * sl2 - nm); s1[i] = __builtin_amdgcn_exp2f(s1[i] * sl2 - nm); sum += s0[i] + s1[i]; }
        lrun = lrun * alpha + sum; mrun = mnew;
#pragma unroll
        for (int i = 0; i < 16; ++i) { o0[i] *= alpha; o1[i] *= alpha; }
#pragma unroll
        for (int sub = 0; sub < 2; ++sub) {
#pragma unroll
            for (int s2 = 0; s2 < 2; ++s2) {
                const v4u pw = (sub == 0) ? (v4u){cvtpk(s0[8 * s2], s0[8 * s2 + 1]), cvtpk(s0[8 * s2 + 2], s0[8 * s2 + 3]), cvtpk(s0[8 * s2 + 4], s0[8 * s2 + 5]), cvtpk(s0[8 * s2 + 6], s0[8 * s2 + 7])}
                                          : (v4u){cvtpk(s1[8 * s2], s1[8 * s2 + 1]), cvtpk(s1[8 * s2 + 2], s1[8 * s2 + 3]), cvtpk(s1[8 * s2 + 4], s1[8 * s2 + 5]), cvtpk(s1[8 * s2 + 6], s1[8 * s2 + 7])};
                const bf16x8 pb = __builtin_bit_cast(bf16x8, pw);
                const int kofs = (32 * sub + 16 * s2 + 4 * h) * 2;
#pragma unroll
                for (int slab = 0; slab < 2; ++slab) {
                    const LAS unsigned char* vp = vb + (32 * slab + r) * 144 + kofs;
                    const bf16x4 lo = *(const LAS bf16x4*)vp, hi = *(const LAS bf16x4*)(vp + 16);
                    const bf16x8 va = (bf16x8){lo[0], lo[1], lo[2], lo[3], hi[0], hi[1], hi[2], hi[3]};
                    if (slab == 0) o0 = __builtin_amdgcn_mfma_f32_32x32x16_bf16(va, pb, o0, 0, 0, 0); else o1 = __builtin_amdgcn_mfma_f32_32x32x16_bf16(va, pb, o1, 0, 0, 0); } } }
        if (kt + 1 < ntile) ATT_WRITE(buf ^ 1);
        __syncthreads();
    }
#undef ATT_LOAD
#undef ATT_WRITE
    const float ltot = lrun + __shfl_xor(lrun, 32), inv = 1.f / ltot;
    bf16* orow = Op + (size_t)(wave * 32 + r) * opitch;
#pragma unroll
    for (int g4 = 0; g4 < 4; ++g4) {
        *(GAS v2u*)(orow + 8 * g4 + 4 * h) = (v2u){pk2(o0[4 * g4] * inv, o0[4 * g4 + 1] * inv), pk2(o0[4 * g4 + 2] * inv, o0[4 * g4 + 3] * inv)};
        *(GAS v2u*)(orow + 32 + 8 * g4 + 4 * h) = (v2u){pk2(o1[4 * g4] * inv, o1[4 * g4 + 1] * inv), pk2(o1[4 * g4 + 2] * inv, o1[4 * g4 + 3] * inv)}; }
}

template <bool LAT>
__device__ __forceinline__ void hyena_unit(const Args& a, int l, int c, LAS unsigned char* lds, int tid) {
    constexpr int L = LAT ? 2048 : 256, NB = LAT ? 4 : 16, NE = L / 16, NCH = L / 4, NW = LAT ? 8 : 4, ASH = LAT ? 2 : 4;
    asm volatile("" : "+v"(tid));
    const int lane = tid & 63, wave = tid >> 6, r = lane & 31, h = lane >> 5;
    const bf16* UT = (const bf16*)(a.ws + WS_UT) + (LAT ? UT_LAT : 0);
    GAS bf16* OC = (GAS bf16*)(a.ws + WS_OC);
    const float* HID = (const float*)(a.ws + WS_HID) + ((size_t)l * 2304 + (LAT ? 256 : 0)) * 64;
    LAS bf16* U = (LAS bf16*)lds; LAS bf16* X = (LAS bf16*)(lds + 16384); LAS float* FT = (LAS float*)(lds + 32768); LAS unsigned char* GC = lds + 65536;
    LAS float* W3 = (LAS float*)(lds + 131200); LAS float* RED = (LAS float*)(lds + 132224);
    for (int q = tid; q < NB * L / 8; q += 512) { const int b = q / (L / 8), off = (q % (L / 8)) * 8;
        *(LAS v4u*)(U + b * L + off) = *(const GAS v4u*)(UT + ((size_t)b * 1536 + c) * L + off);
        *(LAS v4u*)(X + b * L + off) = *(const GAS v4u*)(UT + ((size_t)b * 1536 + 512 + c) * L + off); }
    if (tid < 256) { const int j = tid >> 2, k = tid & 3; W3[k * 64 + j] = a.in[25][((size_t)l * 64 + j) * 2048 + (k >> 1) * 1024 + (k & 1) * 512 + c]; }
    __syncthreads();
#if defined(PROBE_HY) && PROBE_HY == 1
    for (int rep = 0; rep < 2; ++rep)
#endif
    { const float dmin = -15.350567286626973f, dmax = -3.0701134573253945f;
      const float delta = fabsf(dmin + (float)c * ((dmax - dmin) / 511.f));
      float p0 = 0.f, p1 = 0.f;
      for (int t = tid; t < L; t += 512) {
          float s[4] = {0.f, 0.f, 0.f, 0.f};
#pragma unroll 4
          for (int j4 = 0; j4 < 16; ++j4) { const f32x4 hv = *(const GAS f32x4*)(HID + (size_t)t * 64 + 4 * j4);
#pragma unroll
              for (int k = 0; k < 4; ++k) s[k] += hv.x * W3[k * 64 + 4 * j4] + hv.y * W3[k * 64 + 4 * j4 + 1] + hv.z * W3[k * 64 + 4 * j4 + 2] + hv.w * W3[k * 64 + 4 * j4 + 3]; }
          const float win = __expf(-((float)t / (float)(L - 1)) * delta);
#pragma unroll
          for (int k = 0; k < 4; ++k) { s[k] *= win; FT[k * L + t] = s[k]; }
          p0 += fabsf(s[0]) + (t >= 1 ? fabsf(s[2]) : 0.f); p1 += fabsf(s[1]) + (t >= 1 ? fabsf(s[3]) : 0.f); }
      p0 = wave_sum(p0); p1 = wave_sum(p1);
      if (lane == 0) { RED[2 * wave] = p0; RED[2 * wave + 1] = p1; } }
    __syncthreads();
    const int col = 32 * wave + r, ca = col >> ASH, cbat = col & (NB - 1);
    const int a_lo = (32 * wave) >> ASH, a_hi = (32 * wave + 31) >> ASH;
    const int rowbase = LAT ? TCTX + cbat * 2048 : cbat * 256;
#pragma unroll 1
    for (int n = 0; n < 2; ++n) {
        float l1s = 0.f;
#pragma unroll
        for (int w = 0; w < 8; ++w) l1s += RED[2 * w + n];
        const float invl1 = 1.f / (l1s + EPSN);
#if defined(PROBE_HY) && PROBE_HY == 4
        for (int rep = 0; rep < 2; ++rep)
#endif
        for (int q = tid; q < 8 * NCH; q += 512) { const int k = q & 7, y = q >> 3, m0 = L - (8 * y + k);
            float v[8];
#pragma unroll
            for (int j = 0; j < 8; ++j) { const int m = m0 - j; float t = 0.f; if (m >= 0 && m < L) t = FT[n * L + m]; else if (m < 0 && m > -L) t = FT[(2 + n) * L - m]; v[j] = t * invl1; }
            *(LAS v4u*)(GC + (k * 513 + y) * 16) = (v4u){cvtpk(v[0], v[1]), cvtpk(v[2], v[3]), cvtpk(v[4], v[5]), cvtpk(v[6], v[7])}; }
        __syncthreads();
        f32x16 acc, acc1;
#if defined(PROBE_HY) && PROBE_HY == 3
        for (int rep = 0; rep < 2; ++rep) {
#endif
#pragma unroll
        for (int i = 0; i < 16; ++i) { acc[i] = 0.f; acc1[i] = 0.f; }
        if (wave < NW) {
            const int lam_lo = 2 * a_lo - (NE - 1), lam_hi = 2 * a_hi;
            const int xs0 = 8 * h - r + L;
            const LAS unsigned char* ap = GC + ((xs0 & 7) * 513 + (xs0 >> 3) - 2 * lam_lo) * 16;
            const LAS unsigned char* bp = (const LAS unsigned char*)(U + cbat * L + 8 * h);
            int e = 2 * ca - lam_lo;
            const bf16x8 zero8 = (bf16x8){0, 0, 0, 0, 0, 0, 0, 0};
            bf16x8 a0 = *(const LAS bf16x8*)ap, b0 = (e >= 0 && e < NE) ? *(const LAS bf16x8*)(bp + 32 * e) : zero8;
            bf16x8 a1 = *(const LAS bf16x8*)(ap - 32), b1 = (e - 1 >= 0 && e - 1 < NE) ? *(const LAS bf16x8*)(bp + 32 * (e - 1)) : zero8;
            for (int lam = lam_lo; lam <= lam_hi; lam += 2) {
                ap -= 64; e -= 2;
                const bool more = lam + 2 <= lam_hi;
                const LAS unsigned char* apn = more ? ap : ap + 64;
                const bf16x8 na0 = *(const LAS bf16x8*)apn, na1 = *(const LAS bf16x8*)(apn - 32);
                const bf16x8 nb0 = (more && e >= 0 && e < NE) ? *(const LAS bf16x8*)(bp + 32 * e) : zero8;
                const bf16x8 nb1 = (more && e - 1 >= 0 && e - 1 < NE) ? *(const LAS bf16x8*)(bp + 32 * (e - 1)) : zero8;
                acc = __builtin_amdgcn_mfma_f32_32x32x16_bf16(a0, b0, acc, 0, 0, 0);
                acc1 = __builtin_amdgcn_mfma_f32_32x32x16_bf16(a1, b1, acc1, 0, 0, 0);
                a0 = na0; a1 = na1; b0 = nb0; b1 = nb1;
            }
#pragma unroll
            for (int i = 0; i < 16; ++i) acc[i] += acc1[i];
        }
#if defined(PROBE_HY) && PROBE_HY == 3
        asm volatile("" :: "v"(acc[0]), "v"(acc[5]));
        }
#endif
        const float bias = a.in[27][((size_t)l * 2 + n) * 512 + c];
        float z[16];
        if (wave < NW) {
#pragma unroll
            for (int g4 = 0; g4 < 4; ++g4) { const int t0 = 32 * ca + 8 * g4 + 4 * h;
                const v2u uw = *(const LAS v2u*)(U + cbat * L + t0), xw = *(const LAS v2u*)(X + cbat * L + t0);
                const float uv[4] = {bflo(uw.x), bfhi(uw.x), bflo(uw.y), bfhi(uw.y)}, xv[4] = {bflo(xw.x), bfhi(xw.x), bflo(xw.y), bfhi(xw.y)};
#pragma unroll
                for (int k = 0; k < 4; ++k) z[4 * g4 + k] = xv[k] * (acc[4 * g4 + k] + bias * uv[k]); }
        }
        __syncthreads();
        if (n == 0) {
            if (wave < NW) {
#pragma unroll
                for (int g4 = 0; g4 < 4; ++g4) *(LAS v2u*)(U + cbat * L + 32 * ca + 8 * g4 + 4 * h) = (v2u){pk2(z[4 * g4], z[4 * g4 + 1]), pk2(z[4 * g4 + 2], z[4 * g4 + 3])}; }
            for (int q = tid; q < NB * L / 8; q += 512) { const int b = q / (L / 8), off = (q % (L / 8)) * 8;
                *(LAS v4u*)(X + b * L + off) = *(const GAS v4u*)(UT + ((size_t)b * 1536 + 1024 + c) * L + off); }
        } else if (wave < NW) {
#if defined(PROBE_HY) && PROBE_HY == 2
            for (int rep = 0; rep < 2; ++rep)
#endif
#pragma unroll
            for (int g4 = 0; g4 < 4; ++g4)
#pragma unroll
                for (int k = 0; k < 4; ++k) OC[(size_t)(rowbase + 32 * ca + 8 * g4 + 4 * h + k) * 512 + c] = (bf16)f2bf(z[4 * g4 + k]);
        }
    }
    __syncthreads();
}
#ifndef PHMASK
#define PHMASK 0x1fff
#endif
#define PH_ON(k) (((PHMASK) >> (k)) & 1)
template <class T> __device__ __forceinline__ T* asglobal(T* p) { return (T*)(GAS T*)p; }
__global__ void __launch_bounds__(512, 2) mega_fwd(Args a) {
    extern __shared__ __attribute__((aligned(16))) unsigned char lds_raw[];
    LAS unsigned char* lds = (LAS unsigned char*)lds_raw;
    cg::grid_group grid = cg::this_grid();
    const int bid = blockIdx.x;
    using pg8::Gemm; using pg8::StaticOrder;
    const int ph_lo = a.ph_lo, ph_hi = a.ph_hi;
    volatile LAS unsigned* MISC = (volatile LAS unsigned*)(lds + LDS_BYTES - 64);
    if (threadIdx.x < 16) MISC[threadIdx.x] = 0u;
    __syncthreads();
    if (ph_hi > NPHASE) { __syncthreads(); grid.sync(); }
    XcdBarrier bar = xcd_barrier_post((unsigned*)(a.ws + WS_BAR + (size_t)a.li * BAR_REGION), MISC);
#pragma unroll 1
    for (int ph = ph_lo; ph < ph_hi; ++ph) {
        int tid = threadIdx.x; asm volatile("" : "+v"(tid));
        int G = gridDim.x; asm volatile("" : "+s"(G)); const int NGW = G * 8, NGT = G * 512;
        unsigned char* ws = a.ws; asm volatile("" : "+s"(ws));
#if defined(__HIP_DEVICE_COMPILE__)
#define ASSUME_GLOBAL(p) __builtin_assume(!__builtin_amdgcn_is_shared((const void*)(p)) && !__builtin_amdgcn_is_private((const void*)(p)))
#else
#define ASSUME_GLOBAL(p) ((void)0)
#endif
        ASSUME_GLOBAL(ws); ASSUME_GLOBAL(a.ws); ASSUME_GLOBAL(a.out);
#pragma unroll
        for (int i = 0; i < 35; ++i) ASSUME_GLOBAL(a.in[i]);
        const int lane = tid & 63, wave = __builtin_amdgcn_readfirstlane(tid >> 6), gw = bid * 8 + wave, gt = bid * 512 + tid;
        const int l = (ph >= 1 && ph < 23) ? (ph - 1) / 11 : 0, sub = (ph >= 1 && ph < 23) ? (ph - 1) % 11 : -1;
        float* mod = (float*)(ws + WS_MOD) + (size_t)l * 5 * 6144;
        if (PH_ON(11) && ph == 0) { p0_mod_hid(a, lds, bid, G, tid, gw, NGW, lane); wconv_phase(a, 0, lds, gw, NGW, gt, NGT, wave, lane); }
        else if (PH_ON(12) && ph == 23) { norm_phase(a, 0, 2, false, gw, NGW, lane); }
        else if (PH_ON(0) && sub == 0) { if (l == 1) wconv_phase(a, 1, lds, gw, NGW, gt, NGT, wave, lane); norm_phase(a, l, 0, l == 0, gw, NGW, lane); }
        else if (PH_ON(1) && sub == 1) {
            Gemm g{(const bf16*)(ws + WS_HBF), (const bf16*)(ws + WS_WIN), TT, 3072, 1024, 1024, 1024}; StaticOrder S; S.init(TT, 3072, G, bid);
            pg8::EpiSeg E{(bf16*)(ws + WS_QA), (bf16*)(ws + WS_KVR), (bf16*)(ws + WS_CQ), (bf16*)(ws + WS_CKVR), (bf16*)(ws + WS_HYR)};
            pg8::gemm_phase<pg8::EpiSeg, StaticOrder, true, true>(lds, g, S, E);
        }
        else if (PH_ON(2) && sub == 2) { post_phase(a, l, lds, bid, G, tid, gw, NGW, gt, NGT, lane); }
        else if (PH_ON(3) && sub == 3) {
#pragma unroll 1
            for (int q = 0; q < 3; ++q) {
                Gemm g; StaticOrder S; pg8::EpiStore<0> E;
                if (q == 0) { g = Gemm{(const bf16*)(ws + WS_CQ), (const bf16*)(ws + WS_WUQ), TT, 768, 384, 512, 384}; S.init(TT, 768, G, bid); E = pg8::EpiStore<0>{(bf16*)(ws + WS_QB), 768}; }
                else if (q == 1) { g = Gemm{(const bf16*)(ws + WS_CKVALL), (const bf16*)(ws + WS_WKN), NKEYROWS, 512, 256, 256, 256}; S.init(NKEYROWS, 512, G, (bid + G - 144 % G) % G); E = pg8::EpiStore<0>{(bf16*)(ws + WS_KNB), 512}; }
                else { g = Gemm{(const bf16*)(ws + WS_WVV), (const bf16*)(ws + WS_CKVALL), 512, NKEYROWS, 256, 256, 256}; S.init(512, NKEYROWS, G, (bid + G - 248 % G) % G); E = pg8::EpiStore<0>{(bf16*)(ws + WS_VTB), NKEYROWS}; }
                pg8::gemm_phase<pg8::EpiStore<0>, StaticOrder, true, true>(lds, g, S, E);
            }
        }
        else if (PH_ON(4) && sub == 4) {
            const bf16 *QA = (const bf16*)(ws + WS_QA), *QB = (const bf16*)(ws + WS_QB), *KA = (const bf16*)(ws + WS_KA), *VTA = (const bf16*)(ws + WS_VTA);
            const bf16 *KNB = (const bf16*)(ws + WS_KNB), *VTB = (const bf16*)(ws + WS_VTB), *KPE = (const bf16*)(ws + WS_KPEALL);
            bf16 *OA = (bf16*)(ws + WS_OA), *OB = (bf16*)(ws + WS_OB);
            const float slA = 0.125f * 1.4426950408889634f, slB = 0.10206207261596575f * 1.4426950408889634f;
            const int sel = a.pad;
            for (int it = bid; it < 1792; it += G) {
                { const bool is_hy = (it >= 512 && it < 1024) || it >= 1280; if ((sel == 1 && is_hy) || (sel == 2 && !is_hy)) continue; }
                if (it < 256 || (it >= 1024 && it < 1152)) {
                    const bool lat = it < 256; const int u = lat ? (G == 256 ? ((bid & 7) * 4 + (bid >> 6)) * 8 + ((bid >> 3) & 7) : it) : it - 1024;
                    const int b = lat ? u >> 6 : u >> 3, hh = lat ? (u >> 3) & 7 : u & 7, qb = lat ? u & 7 : 0;
                    const int row0 = lat ? TCTX + b * 2048 + qb * 256 : b * 256, key0 = lat ? TCTX + b * 2304 : b * 256;
                    attn_unit<96>(lds, tid, QB + (size_t)row0 * 768 + hh * 96, 768, KNB + (size_t)key0 * 512 + hh * 64, 512, KPE + (size_t)key0 * 32, VTB + (size_t)(hh * 64) * NKEYROWS + key0, NKEYROWS,
                                  lat ? 2304 : 256, OB + (size_t)row0 * 512 + hh * 64, 512, slB, lat, qb * 256);
                } else if (it < 512 || (it >= 1152 && it < 1280)) {
                    const bool lat = it < 512; const int u = lat ? (G == 256 ? ((bid & 7) * 4 + (bid >> 6)) * 8 + ((bid >> 3) & 7) : it - 256) : it - 1152;
                    const int b = lat ? u >> 6 : u >> 3, hh = lat ? (u >> 3) & 7 : u & 7, qb = lat ? u & 7 : 0, kvh = hh >> 2;
                    const int row0 = lat ? TCTX + b * 2048 + qb * 256 : b * 256, nk = lat ? 2304 : 256;
                    const size_t kbase = lat ? (size_t)KA_LAT + (size_t)(b * 2 + kvh) * 2304 * 64 : (size_t)(b * 2 + kvh) * 256 * 64;
                    attn_unit<64>(lds, tid, QA + (size_t)row0 * 512 + hh * 64, 512, KA + kbase, 64, nullptr, VTA + kbase, nk, nk, OA + (size_t)row0 * 512 + hh * 64, 512, slA, false, 0);
                } else if (it < 1024) { hyena_unit<true>(a, l, it - 512, lds, tid); }
                else { hyena_unit<false>(a, l, it - 1280, lds, tid); }
            }
        }
        else if (PH_ON(5) && sub == 5) {
            const bf16* HBF = (const bf16*)(ws + WS_HBF); bf16* Sg = (bf16*)(ws + WS_S); float* MACC = (float*)(ws + WS_MACC); bf16* MBF = (bf16*)(ws + WS_MBF);
#pragma unroll 1
            for (int n = 0; n < 3; ++n) {
                { Gemm g{HBF, (const bf16*)(ws + WS_WG) + (size_t)n * 1024 * 1024, TT, 1024, 1024, 1024, 1024}; StaticOrder S; S.init(TT, 1024, G, bid);
                  pg8::EpiStore<1> E{Sg, 1024}; pg8::gemm_phase<pg8::EpiStore<1>, StaticOrder, true, true>(lds, g, S, E); }
                Gemm g{(const bf16*)(ws + WS_OA) + (size_t)n * TT * 512, (const bf16*)(ws + WS_WB) + (size_t)n * 1024 * 512, TT, 1024, 512, 512, 512}; StaticOrder S; S.init(TT, 1024, G, bid);
                if (n == 0) { pg8::EpiMerge<0> E{Sg, MACC, MBF}; pg8::gemm_phase<pg8::EpiMerge<0>, StaticOrder, true, true>(lds, g, S, E); }
                else if (n == 1) { pg8::EpiMerge<1> E{Sg, MACC, MBF}; pg8::gemm_phase<pg8::EpiMerge<1>, StaticOrder, true, true>(lds, g, S, E); }
                else { pg8::EpiMerge<2> E{Sg, MACC, MBF}; pg8::gemm_phase<pg8::EpiMerge<2>, StaticOrder, true, true>(lds, g, S, E); }
            }
        }
        else if (PH_ON(6) && sub == 6) {
            Gemm g{(const bf16*)(ws + WS_MBF), (const bf16*)(ws + WS_WO), TT, 1024, 1024, 1024, 1024}; StaticOrder S; S.init(TT, 1024, G, bid);
            pg8::EpiResid E{a.out, mod + 2048}; pg8::gemm_phase<pg8::EpiResid, StaticOrder, true, true>(lds, g, S, E);
        }
        else if (PH_ON(7) && sub == 7) { norm_phase(a, l, 1, false, gw, NGW, lane); }
        else if (PH_ON(8) && sub == 8) {
            Gemm g{(const bf16*)(ws + WS_HBF), (const bf16*)(ws + WS_WUP), TT, 5632, 1024, 1024, 1024}; StaticOrder S; S.init(TT, 5632, G, bid);
            pg8::EpiStore<0> E{(bf16*)(ws + WS_U), 5632}; pg8::gemm_phase<pg8::EpiStore<0>, StaticOrder, true, true>(lds, g, S, E);
        }
        else if (PH_ON(9) && sub == 9) { ffnconv_phase(a, l, gt, NGT); }
        else if (PH_ON(10) && sub == 10) {
            Gemm g{(const bf16*)(ws + WS_ACT), (const bf16*)(ws + WS_WDN), TT, 1024, 2816, 2816, 2816}; StaticOrder S; S.init(TT, 1024, G, bid);
            pg8::EpiResid E{a.out, mod + 5120}; pg8::gemm_phase<pg8::EpiResid, StaticOrder, true, true>(lds, g, S, E);
        }
#ifdef EXTRA_SYNCS
        for (int q = 0; q < EXTRA_SYNCS; ++q) { __syncthreads(); grid.sync(); }
#endif
        if (ph + 1 < ph_hi) xcd_barrier(bar);
    }
}

extern "C" void kernel_launch(void* const* d_in, const int* in_sizes, int n_in, void* d_out, int out_size, void* d_ws, size_t ws_size, hipStream_t stream) {
    static int grid = 0;
    if (grid == 0) {
        if (n_in != 35 || ws_size < WS_END) { fprintf(stderr, "kernel_launch: unexpected n_in %d / ws %zu\n", n_in, ws_size); grid = -1; return; }
        int dev = 0, cus = 0, per_cu = 0;
        if (hipGetDevice(&dev) != hipSuccess || hipDeviceGetAttribute(&cus, hipDeviceAttributeMultiprocessorCount, dev) != hipSuccess) { grid = -1; return; }
        if (hipFuncSetAttribute((const void*)mega_fwd, hipFuncAttributeMaxDynamicSharedMemorySize, LDS_BYTES) != hipSuccess) { fprintf(stderr, "kernel_launch: hipFuncSetAttribute failed\n"); grid = -1; return; }
        if (hipOccupancyMaxActiveBlocksPerMultiprocessor(&per_cu, (const void*)mega_fwd, 512, LDS_BYTES) != hipSuccess || per_cu < 1) { fprintf(stderr, "kernel_launch: occupancy query says %d\n", per_cu); per_cu = 1; }
        (void)hipGetLastError();
        grid = cus;
    }
    if (grid < 0) return;
    if (hipMemsetAsync((char*)d_ws + WS_MOD, 0, ZERO_BYTES, stream) != hipSuccess) { fprintf(stderr, "kernel_launch: memset failed\n"); return; }
    Args a{};
    for (int i = 0; i < 35; ++i) a.in[i] = (const float*)d_in[i];
    a.out = (float*)d_out; a.ws = (unsigned char*)d_ws;
#if defined(MK_PER_PHASE)
    for (int p = 0; p < NPHASE; ++p) { a.ph_lo = p; a.ph_hi = p + 1; a.li = 0; void* args[] = {&a};
        hipError_t e = hipLaunchCooperativeKernel((const void*)mega_fwd, dim3(grid), dim3(512), args, LDS_BYTES, stream);
        if (e != hipSuccess) { fprintf(stderr, "launch %d failed: %s\n", p, hipGetErrorString(e)); break; } }
#else
#if defined(PROBE_SUB)
#ifndef PROBE_SEL
#define PROBE_SEL 0
#endif
    { const int k0 = 1 + PROBE_SUB, k1 = 12 + PROBE_SUB; const int cuts[6][2] = {{0, k0 + 1}, {k0, k0 + 1}, {k0 + 1, k1 + 1}, {k1, k1 + 1}, {k1 + 1, NPHASE}, {0, 0}};
      for (int c = 0; c < 5; ++c) { a.ph_lo = cuts[c][0]; a.ph_hi = cuts[c][1]; a.li = c; a.pad = (c == 1 || c == 3) ? PROBE_SEL : 0; if (a.ph_lo >= a.ph_hi) continue; void* args[] = {&a};
          hipError_t e = hipLaunchCooperativeKernel((const void*)mega_fwd, dim3(grid), dim3(512), args, LDS_BYTES, stream);
          if (e != hipSuccess) { fprintf(stderr, "cooperative launch failed: %s\n", hipGetErrorString(e)); break; } } }
#elif defined(PROBE_CUTS)
    { const int k0 = 1 + PROBE_CUTS, k1 = 12 + PROBE_CUTS; const int cuts[4][2] = {{0, k0 + 1}, {k0 + 1, k1 + 1}, {k1 + 1, NPHASE}, {0, 0}};
      for (int c = 0; c < 3; ++c) { a.ph_lo = cuts[c][0]; a.ph_hi = cuts[c][1]; a.li = c; if (a.ph_lo >= a.ph_hi) continue; void* args[] = {&a};
          hipError_t e = hipLaunchCooperativeKernel((const void*)mega_fwd, dim3(grid), dim3(512), args, LDS_BYTES, stream);
          if (e != hipSuccess) { fprintf(stderr, "cooperative launch failed: %s\n", hipGetErrorString(e)); break; } } }
#else
    a.ph_lo = 0; a.ph_hi = NPHASE; void* args[] = {&a};
    hipError_t e = hipLaunchCooperativeKernel((const void*)mega_fwd, dim3(grid), dim3(512), args, LDS_BYTES, stream);
    if (e != hipSuccess) fprintf(stderr, "cooperative launch failed: %s (grid %d)\n", hipGetErrorString(e), grid);
#endif
#endif
}
```

```cpp
#include <hip/hip_runtime.h>
#include <hip/hip_cooperative_groups.h>
#include <cstdio>
#include <cstdint>
namespace cg = cooperative_groups;
namespace pg8 {
#define PG8_LAS __attribute__((address_space(3)))
typedef unsigned short bf16_t;
typedef short bf16x8 __attribute__((ext_vector_type(8)));
typedef float f32x4 __attribute__((ext_vector_type(4)));
typedef unsigned u32x4 __attribute__((ext_vector_type(4)));
constexpr int BM = 256, BK = 64, HALF = 128, HTB = HALF * BK * 2  , STAGE_BYTES = 8 * HTB, NXCD = 8, WGM = 8;

__host__ __device__ __forceinline__ int lds_byte(int r, int c) { const int st = (r >> 4) * 2 + (c >> 5), rr = r & 15, cc = c & 31, ob = rr * 64 + cc * 2; return st * 1024 + (ob ^ (((ob >> 9) & 1) << 5)); }
__host__ __device__ __forceinline__ void stage_rc(int b, int& R, int& C) { const int st = b / 1024, sb = b % 1024, swz = sb ^ (((sb >> 9) & 1) << 5); R = (st >> 1) * 16 + swz / 64; C = (st & 1) * 32 + (swz % 64) / 2; }
__host__ __device__ __forceinline__ int perm32(int rho) { const int n = rho >> 4, i = rho & 15; return 8 * (i >> 2) + 4 * n + (i & 3); }

struct Unit { int pm, pn; };
struct Gemm { const bf16_t* A; const bf16_t* Bt; int M, N, K, lda, ldb; };

struct StaticOrder {
    int nM, nN, nwg, G, c;
    __host__ __device__ void init(int M, int N, int G_, int c_) { nM = M / BM; nN = N / BM; nwg = nM * nN; G = G_; c = c_; }
    __host__ __device__ bool next(int i, Unit& u) const {
        const long L = (long)i * G + c; if (L >= nwg) return false;
        int wgid = (int)L; { const int q = nwg / NXCD, r = nwg % NXCD, xcd = wgid % NXCD, off = wgid / NXCD; wgid = (xcd < r ? xcd * (q + 1) : r * (q + 1) + (xcd - r) * q) + off; }
        const int nig = WGM * nN, gid = wgid / nig, fm = gid * WGM, gsz = (nM - fm) < WGM ? (nM - fm) : WGM;
        u.pm = fm + ((wgid % nig) % gsz); u.pn = (wgid % nig) / gsz; return true;
    }
    __device__ __forceinline__ void a_ready(const Unit&) const {}
    __device__ __forceinline__ void done(const Unit&) const {}
};

#ifndef GAS
#define GAS __attribute__((address_space(1)))
#endif
__device__ __forceinline__ unsigned cvt_pk_bf16(float lo, float hi) { unsigned r; asm volatile("v_cvt_pk_bf16_f32 %0, %1, %2" : "=v"(r) : "v"(lo), "v"(hi)); return r; }
__device__ __forceinline__ float sigm(float x) { return 1.f / (1.f + __expf(-x)); }
#define EPI_FOR _Pragma("unroll") for (int ai = 0; ai < 2; ++ai) _Pragma("unroll") for (int m = 0; m < 4; ++m) _Pragma("unroll") for (int bj = 0; bj < 2; ++bj)

template <int ACT  > struct EpiStore {
    static constexpr bool PERM = true, AFTER_DRAIN = false;
    bf16_t* O; int ld;
    __device__ __forceinline__ void operator()(const f32x4 (&acc)[2][2][4][2], const Unit& u, int wr, int wc, int fr, int fq) const {
        const int row0 = u.pm * BM + wr * 64 + fr, col0 = u.pn * BM + wc * 32 + 8 * fq;
        EPI_FOR { f32x4 v0 = acc[ai][bj][m][0], v1 = acc[ai][bj][m][1];
            if (ACT == 1) { v0 = (f32x4){sigm(v0[0]), sigm(v0[1]), sigm(v0[2]), sigm(v0[3])}; v1 = (f32x4){sigm(v1[0]), sigm(v1[1]), sigm(v1[2]), sigm(v1[3])}; }
            u32x4 w; w.x = cvt_pk_bf16(v0[0], v0[1]); w.y = cvt_pk_bf16(v0[2], v0[3]); w.z = cvt_pk_bf16(v1[0], v1[1]); w.w = cvt_pk_bf16(v1[2], v1[3]);
            *(GAS u32x4*)(O + (size_t)(row0 + ai * HALF + m * 16) * ld + col0 + bj * HALF) = w; }
    }
};
struct EpiSeg {
    static constexpr bool PERM = true, AFTER_DRAIN = false;
    bf16_t *QA, *KV, *CQ, *CKV, *HY;
    __device__ __forceinline__ void operator()(const f32x4 (&acc)[2][2][4][2], const Unit& u, int wr, int wc, int fr, int fq) const {
        bf16_t* base; int ld, coff; const int pn = u.pn;
        if (pn < 2) { base = QA; ld = 512; coff = 256 * pn; } else if (pn == 2) { base = KV; ld = 256; coff = 0; } else if (pn < 5) { base = CQ; ld = 512; coff = 256 * (pn - 3); }
        else if (pn == 5) { base = CKV; ld = 256; coff = 0; } else { base = HY; ld = 1536; coff = 256 * (pn - 6); }
        const int row0 = u.pm * BM + wr * 64 + fr, col0 = coff + wc * 32 + 8 * fq;
        EPI_FOR { const f32x4 v0 = acc[ai][bj][m][0], v1 = acc[ai][bj][m][1];
            u32x4 w; w.x = cvt_pk_bf16(v0[0], v0[1]); w.y = cvt_pk_bf16(v0[2], v0[3]); w.z = cvt_pk_bf16(v1[0], v1[1]); w.w = cvt_pk_bf16(v1[2], v1[3]);
            *(GAS u32x4*)(base + (size_t)(row0 + ai * HALF + m * 16) * ld + col0 + bj * HALF) = w; }
    }
};
template <int MODE  > struct EpiMerge {
    static constexpr bool PERM = true, AFTER_DRAIN = false;
    const bf16_t* S; float* Macc; bf16_t* Mbf;
    __device__ __forceinline__ void operator()(const f32x4 (&acc)[2][2][4][2], const Unit& u, int wr, int wc, int fr, int fq) const {
        const int row0 = u.pm * BM + wr * 64 + fr, col0 = u.pn * BM + wc * 32 + 8 * fq;
        EPI_FOR { const size_t off = (size_t)(row0 + ai * HALF + m * 16) * 1024 + col0 + bj * HALF;
            const u32x4 sw = *(const GAS u32x4*)(S + off);
            f32x4 s0 = (f32x4){__uint_as_float(sw.x << 16), __uint_as_float(sw.x & 0xffff0000u), __uint_as_float(sw.y << 16), __uint_as_float(sw.y & 0xffff0000u)};
            f32x4 s1 = (f32x4){__uint_as_float(sw.z << 16), __uint_as_float(sw.z & 0xffff0000u), __uint_as_float(sw.w << 16), __uint_as_float(sw.w & 0xffff0000u)};
            f32x4 v0 = acc[ai][bj][m][0] * s0, v1 = acc[ai][bj][m][1] * s1;
            if (MODE >= 1) { v0 = v0 + *(const GAS f32x4*)(Macc + off); v1 = v1 + *(const GAS f32x4*)(Macc + off + 4); }
            if (MODE <= 1) { *(GAS f32x4*)(Macc + off) = v0; *(GAS f32x4*)(Macc + off + 4) = v1; }
            else { u32x4 w; w.x = cvt_pk_bf16(v0[0], v0[1]); w.y = cvt_pk_bf16(v0[2], v0[3]); w.z = cvt_pk_bf16(v1[0], v1[1]); w.w = cvt_pk_bf16(v1[2], v1[3]); *(GAS u32x4*)(Mbf + off) = w; } }
    }
};
struct EpiResid {
    static constexpr bool PERM = true, AFTER_DRAIN = false;
    float* X; const float* gate;
    __device__ __forceinline__ void operator()(const f32x4 (&acc)[2][2][4][2], const Unit& u, int wr, int wc, int fr, int fq) const {
        const int row0 = u.pm * BM + wr * 64 + fr, col0 = u.pn * BM + wc * 32 + 8 * fq;
        const int mrow = (u.pm < 16) ? 0 : 1 + ((u.pm - 16) >> 3);
        const float* gp = gate + (size_t)mrow * 6144 + col0;
        f32x4 g[2][2];
#pragma unroll
        for (int bj = 0; bj < 2; ++bj) { g[bj][0] = *(const GAS f32x4*)(gp + bj * HALF); g[bj][1] = *(const GAS f32x4*)(gp + bj * HALF + 4); }
        EPI_FOR { float* xp = X + (size_t)(row0 + ai * HALF + m * 16) * 1024 + col0 + bj * HALF;
            const f32x4 x0 = *(const GAS f32x4*)xp, x1 = *(const GAS f32x4*)(xp + 4);
            *(GAS f32x4*)xp = x0 + g[bj][0] * acc[ai][bj][m][0]; *(GAS f32x4*)(xp + 4) = x1 + g[bj][1] * acc[ai][bj][m][1]; }
    }
};

template <class Epi, class Sched, bool ALIGN_EPI = false, bool SP2 = false>
__device__ __forceinline__ void gemm_phase(PG8_LAS unsigned char* lds, const Gemm g, const Sched& S, const Epi& E) {
    int tid_l = threadIdx.x; asm volatile("" : "+v"(tid_l));
    const int tid = tid_l, wid = __builtin_amdgcn_readfirstlane(tid >> 6), lane = tid & 63, wr = wid >> 2, wc = wid & 3, fr = lane & 15, fq = lane >> 4;
    const int K = g.K, nt = K / BK;
    unsigned voffA[2], voffB[2];
#pragma unroll
    for (int i = 0; i < 2; ++i) { int R, C; stage_rc(tid * 16 + i * 8192, R, C); const int Rb = Epi::PERM ? ((R & ~31) + perm32(R & 31)) : R;
        voffA[i] = (unsigned)(R * g.lda + C) * 2u; voffB[i] = (unsigned)(Rb * g.ldb + C) * 2u; }
    const size_t kstep = (size_t)(BK * 2);
    const size_t hstepA = (size_t)HALF * g.lda * 2, hstepB = (size_t)HALF * g.ldb * 2;
    const size_t tstepA = 2 * hstepA, tstepB = 2 * hstepB;
    const unsigned ldsw = (unsigned)wid * 1024u;
    const int aoff = lds_byte(wr * 64 + fr, fq * 8), boff = lds_byte(wc * 32 + fr, fq * 8);
#define PG8_SA(b, h) (((b) * 2 + (h)) * HTB)
#define PG8_SB(b, h) ((4 + (b) * 2 + (h)) * HTB)
#define PG8_STAGE(bufoff, gbase, voff) do { _Pragma("unroll") for (int _i = 0; _i < 2; ++_i) \
        __builtin_amdgcn_global_load_lds((const unsigned*)((const char*)(gbase) + (voff)[_i]), (PG8_LAS unsigned*)(lds + (bufoff) + ldsw + _i * 8192), 16, 0, 0); } while (0)
#define PG8_LDA(dst, b, h) do { _Pragma("unroll") for (int m = 0; m < 4; ++m) _Pragma("unroll") for (int k = 0; k < 2; ++k) dst[m][k] = *(const PG8_LAS bf16x8*)(lds + PG8_SA(b, h) + aoff + m * 2048 + k * 1024); } while (0)
#define PG8_LDB(dst, b, h) do { _Pragma("unroll") for (int n = 0; n < 2; ++n) _Pragma("unroll") for (int k = 0; k < 2; ++k) dst[n][k] = *(const PG8_LAS bf16x8*)(lds + PG8_SB(b, h) + boff + n * 2048 + k * 1024); } while (0)
#define PG8_MMA(ai, bj, At, Bt) do { __builtin_amdgcn_s_setprio(1); _Pragma("unroll") for (int m = 0; m < 4; ++m) _Pragma("unroll") for (int n = 0; n < 2; ++n) _Pragma("unroll") for (int k = 0; k < 2; ++k) \
        acc[ai][bj][m][n] = __builtin_amdgcn_mfma_f32_16x16x32_bf16(Bt[n][k], At[m][k], acc[ai][bj][m][n], 0, 0, 0); __builtin_amdgcn_s_setprio(0); } while (0)
#define PG8_WAIT_V(n) asm volatile("s_waitcnt vmcnt(" #n ")" ::: "memory")
#define PG8_WAIT_L(n) asm volatile("s_waitcnt lgkmcnt(" #n ")" ::: "memory")
#define PG8_BAR __builtin_amdgcn_s_barrier()
#define PG8_SCHED __builtin_amdgcn_sched_barrier(0)
    Unit cur, nxt; int ui = 0;
    if (!S.next(0, cur)) return;
    f32x4 acc[2][2][4][2];
#pragma unroll
    for (int a = 0; a < 2; ++a)
#pragma unroll
        for (int b = 0; b < 2; ++b)
#pragma unroll
            for (int m = 0; m < 4; ++m)
#pragma unroll
                for (int n = 0; n < 2; ++n) acc[a][b][m][n] = (f32x4){0.f, 0.f, 0.f, 0.f};
    bf16x8 At[4][2], B0[2][2], B1[2][2];
    const char* cA = (const char*)g.A + (size_t)cur.pm * tstepA; const char* cB = (const char*)g.Bt + (size_t)cur.pn * tstepB;
    S.a_ready(cur);
    if constexpr (SP2) {
        PG8_STAGE(PG8_SB(0, 0), cB, voffB); PG8_STAGE(PG8_SB(0, 1), cB + hstepB, voffB); PG8_STAGE(PG8_SA(0, 0), cA, voffA); PG8_STAGE(PG8_SA(0, 1), cA + hstepA, voffA);
        if (wr == 1) PG8_BAR;
        PG8_WAIT_V(2); PG8_BAR;
        PG8_STAGE(PG8_SB(1, 0), cB + kstep, voffB); PG8_STAGE(PG8_SA(1, 0), cA + kstep, voffA); PG8_STAGE(PG8_SB(1, 1), cB + hstepB + kstep, voffB);
        PG8_WAIT_V(6); PG8_BAR;
    } else {
        PG8_STAGE(PG8_SB(0, 0), cB, voffB); PG8_STAGE(PG8_SA(0, 0), cA, voffA); PG8_STAGE(PG8_SB(0, 1), cB + hstepB, voffB); PG8_STAGE(PG8_SA(0, 1), cA + hstepA, voffA);
        if (wr == 1) PG8_BAR;
        PG8_WAIT_V(4); PG8_BAR;
        PG8_STAGE(PG8_SB(1, 0), cB + kstep, voffB); PG8_STAGE(PG8_SA(1, 0), cA + kstep, voffA); PG8_STAGE(PG8_SB(1, 1), cB + hstepB + kstep, voffB);
        PG8_WAIT_V(6); PG8_BAR;
    }
    for (;;) {
        const bool has_next = S.next(ui + 1, nxt);
        const char* nA = has_next ? (const char*)g.A + (size_t)nxt.pm * tstepA : cA; const char* nB = has_next ? (const char*)g.Bt + (size_t)nxt.pn * tstepB : cB;
        for (int t = 0; t < nt; t += 2) {
            const bool last = (t == nt - 2);
            const char* a1 = cA + (size_t)(t + 1) * kstep;
            const char* a2 = last ? nA : cA + (size_t)(t + 2) * kstep; const char* b2 = last ? nB : cB + (size_t)(t + 2) * kstep;
            const char* a3 = a2 + kstep; const char* b3 = b2 + kstep;
            if (last && has_next) S.a_ready(nxt);
            if constexpr (SP2) {
            PG8_LDB(B0, 0, 0); PG8_LDB(B1, 0, 1); PG8_SCHED; PG8_LDA(At, 0, 0); PG8_STAGE(PG8_SA(1, 1), a1 + hstepA, voffA);
            PG8_WAIT_V(8); PG8_WAIT_L(0); PG8_BAR; PG8_MMA(0, 0, At, B0); PG8_MMA(0, 1, At, B1); PG8_BAR; PG8_SCHED;
            PG8_LDA(At, 0, 1); PG8_STAGE(PG8_SB(0, 0), b2, voffB); PG8_STAGE(PG8_SB(0, 1), b2 + hstepB, voffB); PG8_STAGE(PG8_SA(0, 0), a2, voffA);
            PG8_WAIT_V(8); PG8_WAIT_L(0); PG8_BAR; PG8_MMA(1, 0, At, B0); PG8_MMA(1, 1, At, B1); PG8_BAR; PG8_SCHED;
            PG8_LDB(B0, 1, 0); PG8_LDB(B1, 1, 1); PG8_SCHED; PG8_LDA(At, 1, 0); PG8_STAGE(PG8_SA(0, 1), a2 + hstepA, voffA);
            PG8_WAIT_V(8); PG8_WAIT_L(0); PG8_BAR; PG8_MMA(0, 0, At, B0); PG8_MMA(0, 1, At, B1); PG8_BAR; PG8_SCHED;
            PG8_LDA(At, 1, 1); PG8_STAGE(PG8_SB(1, 0), b3, voffB); PG8_STAGE(PG8_SB(1, 1), b3 + hstepB, voffB); PG8_STAGE(PG8_SA(1, 0), a3, voffA);
            PG8_WAIT_V(8); PG8_WAIT_L(0); PG8_BAR; PG8_MMA(1, 0, At, B0); PG8_MMA(1, 1, At, B1); PG8_BAR; PG8_SCHED;
            } else {
            PG8_LDB(B0, 0, 0); PG8_SCHED; PG8_LDA(At, 0, 0); PG8_STAGE(PG8_SA(1, 1), a1 + hstepA, voffA);
            PG8_WAIT_L(8); PG8_BAR; PG8_WAIT_L(0); PG8_MMA(0, 0, At, B0); PG8_BAR; PG8_SCHED;
            PG8_LDB(B1, 0, 1); PG8_STAGE(PG8_SB(0, 0), b2, voffB);
            PG8_BAR; PG8_WAIT_L(0); PG8_MMA(0, 1, At, B1); PG8_BAR;
            PG8_LDA(At, 0, 1); PG8_STAGE(PG8_SA(0, 0), a2, voffA);
            PG8_BAR; PG8_WAIT_L(0); PG8_MMA(1, 0, At, B0); PG8_BAR; PG8_SCHED;
            PG8_STAGE(PG8_SB(0, 1), b2 + hstepB, voffB);
            PG8_WAIT_V(6); PG8_BAR; PG8_MMA(1, 1, At, B1); PG8_BAR;
            PG8_LDB(B0, 1, 0); PG8_SCHED; PG8_LDA(At, 1, 0); PG8_STAGE(PG8_SA(0, 1), a2 + hstepA, voffA);
            PG8_WAIT_L(8); PG8_BAR; PG8_WAIT_L(0); PG8_MMA(0, 0, At, B0); PG8_BAR; PG8_SCHED;
            PG8_LDB(B1, 1, 1); PG8_STAGE(PG8_SB(1, 0), b3, voffB);
            PG8_BAR; PG8_WAIT_L(0); PG8_MMA(0, 1, At, B1); PG8_BAR;
            PG8_LDA(At, 1, 1); PG8_STAGE(PG8_SA(1, 0), a3, voffA);
            PG8_BAR; PG8_WAIT_L(0); PG8_MMA(1, 0, At, B0); PG8_BAR; PG8_SCHED;
            PG8_STAGE(PG8_SB(1, 1), b3 + hstepB, voffB);
            PG8_WAIT_V(6); PG8_BAR; PG8_MMA(1, 1, At, B1); PG8_BAR;
            }
        }
        if constexpr (ALIGN_EPI) { if (wr == 0) PG8_BAR; }
        if constexpr (!Epi::AFTER_DRAIN) { E(acc, cur, wr, wc, fr, fq); S.done(cur); }
        if (!has_next) break;
#pragma unroll
        for (int a = 0; a < 2; ++a)
#pragma unroll
            for (int b = 0; b < 2; ++b)
#pragma unroll
                for (int m = 0; m < 4; ++m)
#pragma unroll
                    for (int n = 0; n < 2; ++n) acc[a][b][m][n] = (f32x4){0.f, 0.f, 0.f, 0.f};
        cur = nxt; cA = nA; cB = nB; ++ui;
        if constexpr (ALIGN_EPI) { if (wr == 1) PG8_BAR; }
    }
    PG8_WAIT_V(0);
    if constexpr (!ALIGN_EPI) { if (wr == 0) PG8_BAR; }
    PG8_BAR;
    if constexpr (Epi::AFTER_DRAIN) { E.fused(acc, cur, wr, wc, fr, fq, lds, wid, lane); S.done(cur); }
#undef PG8_SA
#undef PG8_SB
#undef PG8_STAGE
#undef PG8_LDA
#undef PG8_LDB
#undef PG8_MMA
#undef PG8_WAIT_V
#undef PG8_WAIT_L
#undef PG8_BAR
#undef PG8_SCHED
}
}

constexpr int TCTX = 4096, TLAT = 8192, TT = 12288, DM = 1024, NKEYROWS = 13312;
constexpr float EPSN = 1e-6f;
constexpr size_t MiB = 1u << 20;
constexpr size_t WS_MOD = 0, MOD_BYTES = 2 * 5 * 6144 * 4, WS_BAR = 262144, BAR_REGION = 16384, ZERO_BYTES = WS_BAR + 5 * BAR_REGION;
constexpr size_t WS_HID = 1 * MiB;
constexpr size_t WS_WIN = 3 * MiB, WS_WG = 9 * MiB, WS_WUQ = 15 * MiB, WS_WKN = 16 * MiB, WS_WVV = 16 * MiB + 262144, WS_WB = 17 * MiB, WS_WO = 20 * MiB, WS_WUP = 22 * MiB, WS_WDN = 33 * MiB;
constexpr size_t WS_U = 39 * MiB, WS_ACT = 171 * MiB, WS_HBF = 171 * MiB;
constexpr size_t WS_QA = 39 * MiB, WS_KVR = 51 * MiB, WS_CQ = 57 * MiB, WS_CKVR = 69 * MiB, WS_HYR = 75 * MiB, WS_OA = 75 * MiB, WS_OB = 87 * MiB, WS_OC = 99 * MiB;
constexpr size_t WS_UT = 111 * MiB, WS_QB = 147 * MiB, WS_CKVALL = 195 * MiB, WS_KPEALL = 202 * MiB, WS_KNB = 203 * MiB, WS_VTB = 216 * MiB, WS_KA = 229 * MiB, WS_VTA = 233 * MiB;
constexpr size_t WS_S = 111 * MiB, WS_MBF = 135 * MiB, WS_MACC = 195 * MiB, WS_END = 256 * MiB;
constexpr int KA_LAT = 16 * 2 * 256 * 64;
constexpr int UT_LAT = 16 * 1536 * 256;
constexpr int OUT_K = 12582912, OUT_V = 13631488, OUT_CKV = 14680064, OUT_KPE = 16777216;
constexpr int LDS_BYTES = 147456;
constexpr int NPHASE = 24;

#ifndef GAS
#define GAS __attribute__((address_space(1)))
#endif
#define LAS __attribute__((address_space(3)))
typedef unsigned short bf16;
typedef unsigned v4u __attribute__((ext_vector_type(4)));
typedef unsigned v2u __attribute__((ext_vector_type(2)));
typedef float f32x4 __attribute__((ext_vector_type(4)));
typedef float f32x16 __attribute__((ext_vector_type(16)));
typedef short bf16x8 __attribute__((ext_vector_type(8)));
typedef short bf16x4 __attribute__((ext_vector_type(4)));
#define LDS_WAIT() asm volatile("s_waitcnt lgkmcnt(0)" ::: "memory")
__device__ __forceinline__ unsigned f2bf(float f) { unsigned u = __builtin_bit_cast(unsigned, f); return (u + 0x7fffu + ((u >> 16) & 1u)) >> 16; }
__device__ __forceinline__ unsigned pk2(float lo, float hi) { return f2bf(lo) | (f2bf(hi) << 16); }
__device__ __forceinline__ float bflo(unsigned w) { return __uint_as_float(w << 16); }
__device__ __forceinline__ float bfhi(unsigned w) { return __uint_as_float(w & 0xffff0000u); }
__device__ __forceinline__ float bf1(bf16 b) { return __uint_as_float(((unsigned)b) << 16); }
__device__ __forceinline__ void fsincos(float x, float& s, float& c) { float rev = x * 0.15915494309189535f; rev = rev - rintf(rev); s = __builtin_amdgcn_sinf(rev); c = __builtin_amdgcn_cosf(rev); }
__device__ __forceinline__ float fsin(float x) { float rev = x * 0.15915494309189535f; rev = rev - rintf(rev); return __builtin_amdgcn_sinf(rev); }
__device__ __forceinline__ float wave_sum(float v) {
#pragma unroll
    for (int o = 1; o < 64; o <<= 1) v += __shfl_xor(v, o);
    return v;
}
__device__ __forceinline__ void rope2(float& x0, float& x1, float ang) { float s, c; fsincos(ang, s, c); const float a = x0 * c - x1 * s, b = x0 * s + x1 * c; x0 = a; x1 = b; }
#define L2_10000 13.287712379549449f

__device__ __forceinline__ void transpose_item(const float* W, size_t ldw, int k0, int n0, bf16* WT, size_t ldt, int drow0, LAS float* scr, int lane) {
    float wv[32];
#pragma unroll
    for (int i = 0; i < 32; ++i) wv[i] = ((const GAS float*)W)[(size_t)(k0 + 2 * i + (lane >> 5)) * ldw + n0 + (lane & 31)];
#pragma unroll
    for (int i = 0; i < 32; ++i) scr[(2 * i + (lane >> 5)) * 33 + (lane & 31)] = wv[i];
    LDS_WAIT(); asm volatile("" ::: "memory");
    const int c = lane & 7;
#pragma unroll
    for (int j = 0; j < 4; ++j) { const int n = (lane >> 3) + 8 * j; const LAS float* s = scr + (8 * c) * 33 + n;
        v4u o; o.x = pk2(s[0 * 33], s[1 * 33]); o.y = pk2(s[2 * 33], s[3 * 33]); o.z = pk2(s[4 * 33], s[5 * 33]); o.w = pk2(s[6 * 33], s[7 * 33]);
        *(GAS v4u*)(WT + (size_t)(drow0 + n) * ldt + k0 + 8 * c) = o; }
    LDS_WAIT(); asm volatile("" ::: "memory");
}

#define XB_TMO      128
#define XB_XCNT(j)  (256  + 64 * (j))
#define XB_XSUB(j)  (1280 + 64 * (j))
#define XB_XGEN(j)  (2304 + 64 * (j))
#define XB_TOP      3328
#define XB_TOPGEN   3392
#define XCD_BAR_WORDS 3456
#define XB_SPIN_CAP (1u << 18)

__device__ __forceinline__ unsigned xb_ld(unsigned* p)              { return __hip_atomic_load(p, __ATOMIC_RELAXED, __HIP_MEMORY_SCOPE_AGENT); }
__device__ __forceinline__ unsigned xb_add(unsigned* p, unsigned v) { return __hip_atomic_fetch_add(p, v, __ATOMIC_RELAXED, __HIP_MEMORY_SCOPE_AGENT); }
__device__ __forceinline__ unsigned xb_xcc_id() { return (unsigned)__builtin_amdgcn_s_getreg((3 << 11) | 20) & 0xFu; }
#define XB_SPIN(cond, bar) do { unsigned _sp = 0; while (cond) { __builtin_amdgcn_s_sleep(1); \
    if ((++_sp & 255u) == 0u) { if (xb_ld(&(bar)[XB_TMO])) break; if (_sp > XB_SPIN_CAP) { atomicAdd(&(bar)[XB_TMO], 1u); break; } } } } while (0)

struct XcdBarrier {
    unsigned* bar; unsigned x;
    volatile LAS unsigned* st;
};

__device__ __forceinline__ XcdBarrier xcd_barrier_post(unsigned* bar, volatile LAS unsigned* st) {
    XcdBarrier b; b.bar = bar; b.x = xb_xcc_id(); b.st = st;
    if (threadIdx.x == 0) (void)xb_add(&bar[XB_XCNT(b.x)], 1u);
    return b;
}
__device__ __forceinline__ void xcd_barrier_complete(unsigned* bar, unsigned x, unsigned& nloc, unsigned& nx) {
    const unsigned G = gridDim.x * gridDim.y * gridDim.z;
    unsigned sum, cnt, mine, sp = 0u;
    for (;;) {
        sum = 0u; cnt = 0u; mine = 0u;
#pragma unroll
        for (unsigned j = 0; j < 16; ++j) { const unsigned c = xb_ld(&bar[XB_XCNT(j)]); sum += c; cnt += (c > 0u) ? 1u : 0u; mine = (j == x) ? c : mine; }
        if (sum == G) break;
        __builtin_amdgcn_s_sleep(1);
        if ((++sp & 255u) == 0u) { if (xb_ld(&bar[XB_TMO])) break; if (sp > XB_SPIN_CAP) { atomicAdd(&bar[XB_TMO], 1u); break; } }
    }
    nloc = mine > 0u ? mine : 1u; nx = cnt > 0u ? cnt : 1u;
}

__device__ __forceinline__ void xcd_barrier(const XcdBarrier& b) {
    asm volatile("s_waitcnt vmcnt(0)" ::: "memory");
    __syncthreads();
    if (threadIdx.x == 0) {
        unsigned* bar = b.bar;
        __builtin_amdgcn_s_waitcnt(0);
        unsigned nloc = b.st[0], nx = b.st[1];
        if (nloc == 0u) { xcd_barrier_complete(bar, b.x, nloc, nx); b.st[0] = nloc; b.st[1] = nx; }
        const unsigned old = xb_add(&bar[XB_XSUB(b.x)], 1u);
        const unsigned gen = old / nloc;
        if (old + 1u == (gen + 1u) * nloc) {
            __builtin_amdgcn_fence(__ATOMIC_RELEASE, "agent");
            asm volatile("s_waitcnt vmcnt(0)" ::: "memory");
            const unsigned og = xb_add(&bar[XB_TOP], 1u);
            const unsigned tg = og / nx;
            if (og + 1u == (tg + 1u) * nx) xb_add(&bar[XB_TOPGEN], 1u);
            else XB_SPIN(xb_ld(&bar[XB_TOPGEN]) == tg, bar);
            __builtin_amdgcn_fence(__ATOMIC_ACQUIRE, "agent");
            xb_add(&bar[XB_XGEN(b.x)], 1u);
            asm volatile("s_waitcnt vmcnt(0)" ::: "memory");
        } else {
            XB_SPIN(xb_ld(&bar[XB_XGEN(b.x)]) == gen, bar);
            __builtin_amdgcn_fence(__ATOMIC_ACQUIRE, "agent");
            asm volatile("s_waitcnt vmcnt(0)" ::: "memory");
        }
    }
    __syncthreads();
}


struct Args { const float* in[35]; float* out; unsigned char* ws; int ph_lo, ph_hi, li, pad; };

__device__ __forceinline__ void wconv_phase(const Args& a, int l, LAS unsigned char* lds, int gw, int NGW, int gt, int NGT, int wave, int lane) {
    LAS float* scr = (LAS float*)(lds + wave * 16384);
    unsigned char* ws = a.ws;
    bf16 *WIN = (bf16*)(ws + WS_WIN), *WG = (bf16*)(ws + WS_WG), *WUQ = (bf16*)(ws + WS_WUQ), *WKN = (bf16*)(ws + WS_WKN), *WVV = (bf16*)(ws + WS_WVV), *WB = (bf16*)(ws + WS_WB), *WO = (bf16*)(ws + WS_WO), *WUP = (bf16*)(ws + WS_WUP), *WDN = (bf16*)(ws + WS_WDN);
    constexpr int I1 = 16 * 189, I2 = 6 * 24, I3 = 4 * 32, I4 = 3 * 8 * 32, I5 = 16 * 32, I6 = 16 * 176, I7 = 44 * 32, NIT = I1 + I2 + I3 + I4 + I5 + I6 + I7;
    for (int it = gw; it < NIT; it += NGW) {
        int r = it;
        if (r < I1) { const int kb = r / 189, n0 = 32 * (r % 189); bf16* dst = WIN; int drow;
            if (n0 < 1152) drow = n0; else if (n0 < 1408) drow = n0 + 128; else if (n0 < 1440) drow = 1152 + (n0 - 1408); else if (n0 < 2976) drow = 1536 + (n0 - 1440); else { dst = WG; drow = n0 - 2976; }
            transpose_item(a.in[12] + (size_t)l * 1024 * 6048, 6048, 64 * kb, n0, dst, 1024, drow, scr, lane); continue; } r -= I1;
        if (r < I2) { const int kb = r / 24, n0 = 32 * (r % 24); transpose_item(a.in[17] + (size_t)l * 384 * 768, 768, 64 * kb, n0, WUQ, 384, n0, scr, lane); continue; } r -= I2;
        if (r < I3) { const int kb = r / 32, n0 = 32 * (r % 32); const int h = n0 >> 7, c0 = n0 & 127;
            transpose_item(a.in[18] + (size_t)l * 256 * 1024, 1024, 64 * kb, n0, (c0 < 64) ? WKN : WVV, 256, h * 64 + (c0 & 63), scr, lane); continue; } r -= I3;
        if (r < I4) { const int n = r / 256, q = r % 256, kb = q / 32, n0 = 32 * (q % 32);
            transpose_item(a.in[28] + ((size_t)l * 3 + n) * 512 * 1024, 1024, 64 * kb, n0, WB + (size_t)n * 1024 * 512, 512, n0, scr, lane); continue; } r -= I4;
        if (r < I5) { const int kb = r / 32, n0 = 32 * (r % 32); transpose_item(a.in[29] + (size_t)l * 1024 * 1024, 1024, 64 * kb, n0, WO, 1024, n0, scr, lane); continue; } r -= I5;
        if (r < I6) { const int kb = r / 176, n0 = 32 * (r % 176); transpose_item(a.in[30] + (size_t)l * 1024 * 5632, 5632, 64 * kb, n0, WUP, 1024, n0, scr, lane); continue; } r -= I6;
        { const int kb = r / 32, n0 = 32 * (r % 32); transpose_item(a.in[33] + (size_t)l * 2816 * 1024, 1024, 64 * kb, n0, WDN, 2816, n0, scr, lane); }
    }
    for (int i = gt; i < 96 * 1024 / 8; i += NGT) *(GAS v4u*)(WIN + (size_t)1184 * 1024 + (size_t)i * 8) = (v4u){0u, 0u, 0u, 0u};
}

__device__ __forceinline__ void norm_phase(const Args& a, int l, int which, bool first, int gw, int NGW, int lane) {
    const GAS float* mod = (const GAS float*)(a.ws + WS_MOD) + (size_t)l * 5 * 6144;
    GAS bf16* HBF = (GAS bf16*)(a.ws + WS_HBF);
    const GAS float* gv = (const GAS float*)((which == 0) ? a.in[10] + l * 1024 : (which == 1) ? a.in[11] + l * 1024 : a.in[34]);
    GAS float* outp = (GAS float*)a.out;
    const int shoff = (which == 0) ? 0 : 3072, scoff = shoff + 1024;
    #pragma unroll 1
    for (int row0 = gw; row0 < TT; row0 += 4 * NGW) {
        f32x4 v[4][4];
#pragma unroll
        for (int q = 0; q < 4; ++q) { const int row = row0 + q * NGW; const int rr = row < TT ? row : row0;
            const GAS float* src = first ? (const GAS float*)(rr < TCTX ? a.in[0] + (size_t)rr * DM : a.in[1] + (size_t)(rr - TCTX) * DM) : (const GAS float*)(outp + (size_t)rr * DM);
#pragma unroll
            for (int j = 0; j < 4; ++j) v[q][j] = *(const GAS f32x4*)(src + 4 * lane + 256 * j); }
#pragma unroll
        for (int q = 0; q < 4; ++q) { const int row = row0 + q * NGW; if (row >= TT) continue;
            float ss = 0.f;
#pragma unroll
            for (int j = 0; j < 4; ++j) ss += (v[q][j].x * v[q][j].x + v[q][j].y * v[q][j].y) + (v[q][j].z * v[q][j].z + v[q][j].w * v[q][j].w);
            if (first) {
#pragma unroll
                for (int j = 0; j < 4; ++j) *(GAS f32x4*)(outp + (size_t)row * DM + 4 * lane + 256 * j) = v[q][j]; }
            const float rs = rsqrtf(wave_sum(ss) * (1.f / DM) + EPSN);
            const int mrow = row < TCTX ? 0 : 1 + ((row - TCTX) >> 11);
            const GAS float* mp = mod + (size_t)mrow * 6144;
#pragma unroll
            for (int j = 0; j < 4; ++j) { const int col = 4 * lane + 256 * j; const f32x4 g = *(const GAS f32x4*)(gv + col);
                if (which == 2) { *(GAS f32x4*)(outp + (size_t)row * DM + col) = v[q][j] * rs * g; }
                else { const f32x4 sc = *(const GAS f32x4*)(mp + scoff + col), sh = *(const GAS f32x4*)(mp + shoff + col);
                    const f32x4 y = v[q][j] * rs * g * (sc + 1.f) + sh;
                    *(GAS v2u*)(HBF + (size_t)row * DM + col) = (v2u){pk2(y.x, y.y), pk2(y.z, y.w)}; } } }
    }
}
__device__ __forceinline__ void p0_mod_hid(const Args& a, LAS unsigned char* lds, int bid, int G, int tid, int gw, int NGW, int lane) {
    float* mod = (float*)(a.ws + WS_MOD);
    LAS float* sc = (LAS float*)lds;
    for (int it = bid; it < 384; it += G) {
        const int l = it / 192, rem = it % 192, kc = rem / 12, jb = rem % 12;
        if (tid < 320) { const int r = tid >> 6, kk = tid & 63, k = kc * 64 + kk; const float cv = (r == 0) ? a.in[7][k] : a.in[6][(r - 1) * 1024 + k]; sc[tid] = cv / (1.f + __expf(-cv)); }
        __syncthreads();
        const int j = jb * 512 + tid;
        const GAS float* wp = (const GAS float*)(a.in[8] + ((size_t)l * 1024 + kc * 64) * 6144 + j);
        float acc[5] = {0.f, 0.f, 0.f, 0.f, 0.f};
#pragma unroll 8
        for (int kk = 0; kk < 64; ++kk) { const float w = wp[(size_t)kk * 6144];
#pragma unroll
            for (int r = 0; r < 5; ++r) acc[r] += sc[r * 64 + kk] * w; }
        const float bias = (kc == 0) ? a.in[9][l * 6144 + j] : 0.f;
#pragma unroll
        for (int r = 0; r < 5; ++r) atomicAdd(mod + (size_t)(l * 5 + r) * 6144 + j, acc[r] + bias);
        __syncthreads();
    }
    float* HID = (float*)(a.ws + WS_HID);
    for (int it = gw; it < 2 * 2304; it += NGW) {
        const int l = it / 2304, q = it % 2304; const int L = q < 256 ? 256 : 2048, t = q < 256 ? q : q - 256;
        const float tn = (float)t / (float)(L - 1);
        float zi = 0.f;
        if (lane == 0) zi = tn;
        else if (lane <= 16) { const int bi = (lane - 1) & 7; const float band = 1e-4f + (float)bi * ((7.f - 1e-4f) / 7.f); const float ang = (6.283185307179586f / (float)L) * (float)t * band; float s, c; fsincos(ang, s, c); zi = (lane <= 8) ? c : -s; }
        float s1 = a.in[22][l * 64 + lane];
#pragma unroll
        for (int i = 0; i < 17; ++i) s1 += __shfl(zi, i) * a.in[21][(l * 17 + i) * 64 + lane];
        const float h1 = fsin(a.in[26][(l * 2 + 0) * 64 + lane] * s1);
        float s2 = a.in[24][l * 64 + lane];
#pragma unroll 8
        for (int i = 0; i < 64; ++i) s2 += __shfl(h1, i) * a.in[23][(l * 64 + i) * 64 + lane];
        HID[(size_t)it * 64 + lane] = fsin(a.in[26][(l * 2 + 1) * 64 + lane] * s2);
    }
}

__device__ __forceinline__ void post_phase(const Args& a, int l, LAS unsigned char* lds, int bid, int G, int tid, int gw, int NGW, int gt, int NGT, int lane) {
    unsigned char* ws = a.ws;
    GAS bf16 *QA = (GAS bf16*)(ws + WS_QA), *KVR = (GAS bf16*)(ws + WS_KVR), *CQ = (GAS bf16*)(ws + WS_CQ), *CKVR = (GAS bf16*)(ws + WS_CKVR), *HYR = (GAS bf16*)(ws + WS_HYR);
    GAS bf16 *UT = (GAS bf16*)(ws + WS_UT), *CKVALL = (GAS bf16*)(ws + WS_CKVALL), *KPEALL = (GAS bf16*)(ws + WS_KPEALL), *KA = (GAS bf16*)(ws + WS_KA), *VTA = (GAS bf16*)(ws + WS_VTA);
    GAS float* outp = (GAS float*)a.out;
    for (int i = gt; i < 4 * 256 * 128; i += NGT) { const int b = i >> 15, p = (i >> 7) & 255, kvh = (i >> 6) & 1, d = i & 63;
        const size_t s = ((size_t)(b * 2 + l) * 256 + p) * 128 + kvh * 64 + d;
        KA[KA_LAT + ((b * 2 + kvh) * 2304 + p) * 64 + d] = (bf16)f2bf(a.in[2][s]);
        VTA[KA_LAT + ((b * 2 + kvh) * 64 + d) * 2304 + p] = (bf16)f2bf(a.in[3][s]); }
    for (int i = gt; i < 4 * 256 * 256; i += NGT) { const int b = i >> 16, p = (i >> 8) & 255, j = i & 255;
        CKVALL[(size_t)(TCTX + b * 2304 + p) * 256 + j] = (bf16)f2bf(a.in[4][((size_t)(b * 2 + l) * 256 + p) * 256 + j]); }
    for (int i = gt; i < 4 * 256 * 32; i += NGT) { const int b = i >> 13, p = (i >> 5) & 255, j = i & 31;
        KPEALL[(size_t)(TCTX + b * 2304 + p) * 32 + j] = (bf16)f2bf(a.in[5][((size_t)(b * 2 + l) * 256 + p) * 32 + j]); }
    const GAS float *gq = (const GAS float*)(a.in[13] + l * 64), *gk = (const GAS float*)(a.in[14] + l * 64), *gcq = (const GAS float*)(a.in[15] + l * 384), *gkv = (const GAS float*)(a.in[16] + l * 256);
    for (int row = gw; row < TT; row += NGW) {
        const bool lat = row >= TCTX;
        const int b = lat ? (row - TCTX) >> 11 : row >> 8, t = lat ? (row - TCTX) & 2047 : row & 255;
        const float grow = (float)(t >> 6), gcol = (float)(t & 63);
        const int keyrow = lat ? TCTX + b * 2304 + 256 + t : row;
        { v4u w = *(const GAS v4u*)(QA + (size_t)row * 512 + 8 * lane);
          float x[8] = {bflo(w.x), bfhi(w.x), bflo(w.y), bfhi(w.y), bflo(w.z), bfhi(w.z), bflo(w.w), bfhi(w.w)};
          float ss = 0.f;
#pragma unroll
          for (int j = 0; j < 8; ++j) ss += x[j] * x[j];
          ss += __shfl_xor(ss, 1); ss += __shfl_xor(ss, 2); ss += __shfl_xor(ss, 4);
          const float rs = rsqrtf(ss * (1.f / 64.f) + EPSN); const int d0 = 8 * (lane & 7);
#pragma unroll
          for (int j = 0; j < 8; ++j) x[j] = x[j] * rs * gq[d0 + j];
          if (lat) {
#pragma unroll
              for (int k = 0; k < 4; ++k) { const int i = 4 * (lane & 7) + k; const float inv = __builtin_amdgcn_exp2f(-(float)(i & 15) * (L2_10000 / 16.f)); rope2(x[2 * k], x[2 * k + 1], (i < 16 ? grow : gcol) * inv); } }
          *(GAS v4u*)(QA + (size_t)row * 512 + 8 * lane) = (v4u){pk2(x[0], x[1]), pk2(x[2], x[3]), pk2(x[4], x[5]), pk2(x[6], x[7])}; }
        { const v2u w = *(const GAS v2u*)(KVR + (size_t)row * 256 + 4 * lane);
          float x[4] = {bflo(w.x), bfhi(w.x), bflo(w.y), bfhi(w.y)};
          float ss = (x[0] * x[0] + x[1] * x[1]) + (x[2] * x[2] + x[3] * x[3]);
          ss += __shfl_xor(ss, 1); ss += __shfl_xor(ss, 2); ss += __shfl_xor(ss, 4); ss += __shfl_xor(ss, 8);
          const int kvh = (lane >> 4) & 1, d0 = 4 * (lane & 15);
          if (lane < 32) {
              const float rs = rsqrtf(ss * (1.f / 64.f) + EPSN);
#pragma unroll
              for (int j = 0; j < 4; ++j) x[j] = x[j] * rs * gk[d0 + j];
              if (!lat) { *(GAS f32x4*)(outp + OUT_K + ((size_t)(b * 2 + l) * 256 + t) * 128 + kvh * 64 + d0) = (f32x4){x[0], x[1], x[2], x[3]};
                  *(GAS v2u*)(KA + ((size_t)(b * 2 + kvh) * 256 + t) * 64 + d0) = (v2u){pk2(x[0], x[1]), pk2(x[2], x[3])}; }
              else {
#pragma unroll
                  for (int k = 0; k < 2; ++k) { const int i = 2 * (lane & 15) + k; const float inv = __builtin_amdgcn_exp2f(-(float)(i & 15) * (L2_10000 / 16.f)); rope2(x[2 * k], x[2 * k + 1], (i < 16 ? grow : gcol) * inv); }
                  *(GAS v2u*)(KA + KA_LAT + ((size_t)(b * 2 + kvh) * 2304 + 256 + t) * 64 + d0) = (v2u){pk2(x[0], x[1]), pk2(x[2], x[3])}; }
          } else {
              if (!lat) { *(GAS f32x4*)(outp + OUT_V + ((size_t)(b * 2 + l) * 256 + t) * 128 + kvh * 64 + d0) = (f32x4){x[0], x[1], x[2], x[3]};
#pragma unroll
                  for (int j = 0; j < 4; ++j) VTA[((size_t)(b * 2 + kvh) * 64 + d0 + j) * 256 + t] = (bf16)f2bf(x[j]); }
              else {
#pragma unroll
                  for (int j = 0; j < 4; ++j) VTA[KA_LAT + ((size_t)(b * 2 + kvh) * 64 + d0 + j) * 2304 + 256 + t] = (bf16)f2bf(x[j]); }
          } }
        { GAS unsigned* p = (GAS unsigned*)(CQ + (size_t)row * 512 + 6 * lane);
          const unsigned w0 = p[0], w1 = p[1], w2 = p[2];
          float x[6] = {bflo(w0), bfhi(w0), bflo(w1), bfhi(w1), bflo(w2), bfhi(w2)};
          float ss = 0.f;
#pragma unroll
          for (int j = 0; j < 6; ++j) ss += x[j] * x[j];
          const float rs = rsqrtf(wave_sum(ss) * (1.f / 384.f) + EPSN);
#pragma unroll
          for (int j = 0; j < 6; ++j) x[j] = x[j] * rs * gcq[6 * lane + j];
          p[0] = pk2(x[0], x[1]); p[1] = pk2(x[2], x[3]); p[2] = pk2(x[4], x[5]);
          if (lane < 16) { const unsigned w = *(const GAS unsigned*)(CQ + (size_t)row * 512 + 384 + 2 * lane); float y0 = bflo(w), y1 = bfhi(w);
              if (!lat) { outp[OUT_KPE + ((size_t)(b * 2 + l) * 256 + t) * 32 + 2 * lane] = y0; outp[OUT_KPE + ((size_t)(b * 2 + l) * 256 + t) * 32 + 2 * lane + 1] = y1; }
              else { const float inv = __builtin_amdgcn_exp2f(-(float)(lane & 7) * (L2_10000 / 8.f)); rope2(y0, y1, (lane < 8 ? grow : gcol) * inv); }
              *(GAS unsigned*)(KPEALL + (size_t)keyrow * 32 + 2 * lane) = pk2(y0, y1); } }
        { const v2u w = *(const GAS v2u*)(CKVR + (size_t)row * 256 + 4 * lane);
          float x[4] = {bflo(w.x), bfhi(w.x), bflo(w.y), bfhi(w.y)};
          const float ss = (x[0] * x[0] + x[1] * x[1]) + (x[2] * x[2] + x[3] * x[3]);
          const float rs = rsqrtf(wave_sum(ss) * (1.f / 256.f) + EPSN);
#pragma unroll
          for (int j = 0; j < 4; ++j) x[j] = x[j] * rs * gkv[4 * lane + j];
          if (!lat) *(GAS f32x4*)(outp + OUT_CKV + ((size_t)(b * 2 + l) * 256 + t) * 256 + 4 * lane) = (f32x4){x[0], x[1], x[2], x[3]};
          *(GAS v2u*)(CKVALL + (size_t)keyrow * 256 + 4 * lane) = (v2u){pk2(x[0], x[1]), pk2(x[2], x[3])}; }
    }
    LAS float* tile = (LAS float*)lds;
    const GAS float *sw = (const GAS float*)(a.in[19] + (size_t)l * 3 * 1536), *sb = (const GAS float*)(a.in[20] + (size_t)l * 1536);
    for (int it = bid; it < 96 * 12; it += G) {
        const int tb = it / 12, cb = it % 12, row0 = tb * 128;
        const bool lat = row0 >= TCTX; const int L = lat ? 2048 : 256;
        const int b = lat ? (row0 - TCTX) >> 11 : row0 >> 8, t0 = lat ? (row0 - TCTX) & 2047 : row0 & 255;
        v4u w[4], wh = (v4u){0u, 0u, 0u, 0u};
        { const int rr = tid >> 4, c8 = tid & 15;
#pragma unroll
          for (int q = 0; q < 4; ++q) w[q] = *(const GAS v4u*)(HYR + (size_t)(row0 + rr + 32 * q) * 1536 + cb * 128 + 8 * c8);
          if (tid < 32) { const int which = tid >> 4; const bool ok = which ? (t0 + 128 < L) : (t0 > 0); const int rsrc = which ? row0 + 128 : row0 - 1;
              if (ok) wh = *(const GAS v4u*)(HYR + (size_t)rsrc * 1536 + cb * 128 + 8 * c8); }
#pragma unroll
          for (int q = 0; q < 4; ++q) { LAS float* tp = tile + (rr + 32 * q + 1) * 129 + 8 * c8;
              tp[0] = bflo(w[q].x); tp[1] = bfhi(w[q].x); tp[2] = bflo(w[q].y); tp[3] = bfhi(w[q].y); tp[4] = bflo(w[q].z); tp[5] = bfhi(w[q].z); tp[6] = bflo(w[q].w); tp[7] = bfhi(w[q].w); }
          if (tid < 32) { LAS float* tp = tile + ((tid >> 4) ? 129 : 0) * 129 + 8 * c8;
              tp[0] = bflo(wh.x); tp[1] = bfhi(wh.x); tp[2] = bflo(wh.y); tp[3] = bfhi(wh.y); tp[4] = bflo(wh.z); tp[5] = bfhi(wh.z); tp[6] = bflo(wh.w); tp[7] = bfhi(wh.w); } }
        __syncthreads();
        { const int c = tid >> 2, tc = tid & 3, cg_ = cb * 128 + c; const float w0 = sw[cg_], w1 = sw[1536 + cg_], w2 = sw[3072 + cg_], bb = sb[cg_];
          const size_t base = lat ? (size_t)UT_LAT + ((size_t)b * 1536 + cg_) * 2048 : ((size_t)b * 1536 + cg_) * 256;
#pragma unroll
          for (int q = 0; q < 4; ++q) { float u[8];
#pragma unroll
              for (int k = 0; k < 8; ++k) { const int tr = 32 * tc + 8 * q + k; u[k] = w0 * tile[tr * 129 + c] + w1 * tile[(tr + 1) * 129 + c] + w2 * tile[(tr + 2) * 129 + c] + bb; }
              *(GAS v4u*)(UT + base + t0 + 32 * tc + 8 * q) = (v4u){pk2(u[0], u[1]), pk2(u[2], u[3]), pk2(u[4], u[5]), pk2(u[6], u[7])}; } }
        __syncthreads();
    }
}

__device__ __forceinline__ void ffnconv_phase(const Args& a, int l, int gt, int NGT) {
    const GAS bf16* U = (const GAS bf16*)(a.ws + WS_U); GAS bf16* ACT = (GAS bf16*)(a.ws + WS_ACT);
    const GAS float *cw = (const GAS float*)(a.in[31] + (size_t)l * 3 * 5632), *cb = (const GAS float*)(a.in[32] + (size_t)l * 5632);
#pragma unroll 1
    for (int idx = gt; idx < 1536 * 352; idx += NGT) {
        const int tb = idx / 352, ch = idx % 352, row0 = tb * 8, c0 = ch * 8;
        const bool lat = row0 >= TCTX; const int t0 = lat ? (row0 - TCTX) & 2047 : row0 & 255, L = lat ? 2048 : 256;
        v4u ra[10], rg[10];
#pragma unroll
        for (int i = 0; i < 10; ++i) { const int t = t0 + i - 1; const bool ok = (t >= 0) && (t < L); const size_t rr = (size_t)(row0 + (ok ? i - 1 : 0)) * 5632 + c0;
            ra[i] = *(const GAS v4u*)(U + rr); rg[i] = *(const GAS v4u*)(U + rr + 2816);
            if (!ok) { ra[i] = (v4u){0u, 0u, 0u, 0u}; rg[i] = (v4u){0u, 0u, 0u, 0u}; } }
        float wa[3][8], wg[3][8], ba[8], bg[8];
#pragma unroll
        for (int j = 0; j < 8; ++j) { ba[j] = cb[c0 + j]; bg[j] = cb[2816 + c0 + j];
#pragma unroll
            for (int k = 0; k < 3; ++k) { wa[k][j] = cw[k * 5632 + c0 + j]; wg[k][j] = cw[k * 5632 + 2816 + c0 + j]; } }
#pragma unroll
        for (int i = 0; i < 8; ++i) {
            float o[8];
#pragma unroll
            for (int j2 = 0; j2 < 4; ++j2) {
                const unsigned a0 = ra[i][j2], a1 = ra[i + 1][j2], a2 = ra[i + 2][j2], g0 = rg[i][j2], g1 = rg[i + 1][j2], g2 = rg[i + 2][j2];
                { const int j = 2 * j2; const float av = wa[0][j] * bflo(a0) + wa[1][j] * bflo(a1) + wa[2][j] * bflo(a2) + ba[j], gv = wg[0][j] * bflo(g0) + wg[1][j] * bflo(g1) + wg[2][j] * bflo(g2) + bg[j]; o[j] = gv / (1.f + __expf(-gv)) * av; }
                { const int j = 2 * j2 + 1; const float av = wa[0][j] * bfhi(a0) + wa[1][j] * bfhi(a1) + wa[2][j] * bfhi(a2) + ba[j], gv = wg[0][j] * bfhi(g0) + wg[1][j] * bfhi(g1) + wg[2][j] * bfhi(g2) + bg[j]; o[j] = gv / (1.f + __expf(-gv)) * av; } }
            *(GAS v4u*)(ACT + (size_t)(row0 + i) * 2816 + c0) = (v4u){pk2(o[0], o[1]), pk2(o[2], o[3]), pk2(o[4], o[5]), pk2(o[6], o[7])};
        }
    }
}
__device__ __forceinline__ unsigned cvtpk(float lo, float hi) { unsigned r; asm("v_cvt_pk_bf16_f32 %0, %1, %2" : "=v"(r) : "v"(lo), "v"(hi)); return r; }
template <int DK>
__device__ __forceinline__ void attn_unit(LAS unsigned char* lds, int tid, const bf16* Qp, int qpitch, const bf16* Kp, int kpitch, const bf16* Kpe, const bf16* Vt, size_t vpitch,
                                          int nkeys, bf16* Op, int opitch, float sl2, bool rope, int pos0) {
    constexpr int NS = DK / 16;
    asm volatile("" : "+v"(tid));
    const int lane = tid & 63, wave = tid >> 6, r = lane & 31, h = lane >> 5;
    bf16x8 qf[NS];
    { const bf16* qrow = Qp + (size_t)(wave * 32 + r) * qpitch;
#pragma unroll
      for (int s = 0; s < NS; ++s) qf[s] = *(const GAS bf16x8*)(qrow + 16 * s + 8 * h);
      if (DK == 96 && rope) { const int t = pos0 + wave * 32 + r; const float grow = (float)(t >> 6), gcol = (float)(t & 63);
#pragma unroll
          for (int sp = 0; sp < 2; ++sp) { bf16x8 v = qf[NS - 2 + sp];
#pragma unroll
              for (int k = 0; k < 4; ++k) { float x0 = bf1((bf16)v[2 * k]), x1 = bf1((bf16)v[2 * k + 1]);
                  const float inv = __builtin_amdgcn_exp2f(-(float)(4 * h + k) * (L2_10000 / 8.f)); rope2(x0, x1, (sp == 0 ? grow : gcol) * inv);
                  v[2 * k] = (short)f2bf(x0); v[2 * k + 1] = (short)f2bf(x1); }
              qf[NS - 2 + sp] = v; } } }
    const int kkey = tid >> 3, kch = tid & 7, pkey = tid >> 2, pch = tid & 3;
    f32x16 o0, o1;
#pragma unroll
    for (int i = 0; i < 16; ++i) { o0[i] = 0.f; o1[i] = 0.f; }
    float mrun = -__builtin_inff(), lrun = 0.f;
    v4u rk, rv, rp = (v4u){0u, 0u, 0u, 0u};
    const int ntile = nkeys >> 6;
#define ATT_LOAD(kt) do { const int key0 = (kt) * 64; rk = *(const GAS v4u*)(Kp + (size_t)(key0 + kkey) * kpitch + 8 * kch); rv = *(const GAS v4u*)(Vt + (size_t)kkey * vpitch + key0 + 8 * kch); \
        if (DK == 96 && tid < 256) rp = *(const GAS v4u*)(Kpe + (size_t)(key0 + pkey) * 32 + 8 * pch); } while (0)
#define ATT_WRITE(buf) do { *(LAS v4u*)(lds + (buf) * 13312 + kkey * 208 + kch * 16) = rk; *(LAS v4u*)(lds + 26624 + (buf) * 9216 + kkey * 144 + kch * 16) = rv; \
        if (DK == 96 && tid < 256) *(LAS v4u*)(lds + (buf) * 13312 + pkey * 208 + 128 + pch * 16) = rp; } while (0)
    ATT_LOAD(0); ATT_WRITE(0); __syncthreads();
    for (int kt = 0; kt < ntile; ++kt) {
        const int buf = kt & 1;
        if (kt + 1 < ntile) ATT_LOAD(kt + 1);
        const LAS unsigned char* kb = lds + buf * 13312; const LAS unsigned char* vb = lds + 26624 + buf * 9216;
        f32x16 s0, s1;
#pragma unroll
        for (int i = 0; i < 16; ++i) { s0[i] = 0.f; s1[i] = 0.f; }
#pragma unroll
        for (int s = 0; s < NS; ++s) {
            const bf16x8 a0 = *(const LAS bf16x8*)(kb + r * 208 + (16 * s + 8 * h) * 2), a1 = *(const LAS bf16x8*)(kb + (32 + r) * 208 + (16 * s + 8 * h) * 2);
            s0 = __builtin_amdgcn_mfma_f32_32x32x16_bf16(a0, qf[s], s0, 0, 0, 0); s1 = __builtin_amdgcn_mfma_f32_32x32x16_bf16(a1, qf[s], s1, 0, 0, 0); }
        float mx = s0[0];
#pragma unroll
        for (int i = 1; i < 16; ++i) mx = fmaxf(mx, s0[i]);
#pragma unroll
        for (int i = 0; i < 16; ++i) mx = fmaxf(mx, s1[i]);
        mx = fmaxf(mx, __shfl_xor(mx, 32));
        const float mnew = fmaxf(mrun, mx), alpha = __builtin_amdgcn_exp2f((mrun - mnew) * sl2), nm = mnew * sl2;
        float sum = 0.f;
#pragma unroll
        for (int i = 0; i < 16; ++i) { s0[i] = __builtin_amdgcn_exp2f(s0[i] * sl2 - nm); s1[i] = __builtin_amdgcn_exp2f(s1[i] * sl2 - nm); sum += s0[i] + s1[i]; }
        lrun = lrun * alpha + sum; mrun = mnew;
#pragma unroll
        for (int i = 0; i < 16; ++i) { o0[i] *= alpha; o1[i] *= alpha; }
#pragma unroll
        for (int sub = 0; sub < 2; ++sub) {
#pragma unroll
            for (int s2 = 0; s2 < 2; ++s2) {
                const v4u pw = (sub == 0) ? (v4u){cvtpk(s0[8 * s2], s0[8 * s2 + 1]), cvtpk(s0[8 * s2 + 2], s0[8 * s2 + 3]), cvtpk(s0[8 * s2 + 4], s0[8 * s2 + 5]), cvtpk(s0[8 * s2 + 6], s0[8 * s2 + 7])}
                                          : (v4u){cvtpk(s1[8 * s2], s1[8 * s2 + 1]), cvtpk(s1[8 * s2 + 2], s1[8 * s2 + 3]), cvtpk(s1[8 * s2 + 4], s1[8 * s2 + 5]), cvtpk(s1[8 * s2 + 6], s1[8 * s2 + 7])};
                const bf16x8 pb = __builtin_bit_cast(bf16x8, pw);
                const int kofs = (32 * sub + 16 * s2 + 4 * h) * 2;
#pragma unroll
                for (int slab = 0; slab < 2; ++slab) {
                    const LAS unsigned char* vp = vb + (32 * slab + r) * 144 + kofs;
                    const bf16x4 lo = *(const LAS bf16x4*)vp, hi = *(const LAS bf16x4*)(vp + 16);
                    const bf16x8 va = (bf16x8){lo[0], lo[1], lo[2], lo[3], hi[0], hi[1], hi[2], hi[3]};
                    if (slab == 0) o0 = __builtin_amdgcn_mfma_f32_32x32x16_bf16(va, pb, o0, 0, 0, 0); else o1 = __builtin_amdgcn_mfma_f32_32x32x16_bf16(va, pb, o1, 0, 0, 0); } } }
        if (kt + 1 < ntile) ATT_WRITE(buf ^ 1);
        __syncthreads();
    }
#undef ATT_LOAD
#undef ATT_WRITE
    const float ltot = lrun + __shfl_xor(lrun, 32), inv = 1.f / ltot;
    bf16* orow = Op + (size_t)(wave * 32 + r) * opitch;
#pragma unroll
    for (int g4 = 0; g4 < 4; ++g4) {
        *(GAS v2u*)(orow + 8 * g4 + 4 * h) = (v2u){pk2(o0[4 * g4] * inv, o0[4 * g4 + 1] * inv), pk2(o0[4 * g4 + 2] * inv, o0[4 * g4 + 3] * inv)};
        *(GAS v2u*)(orow + 32 + 8 * g4 + 4 * h) = (v2u){pk2(o1[4 * g4] * inv, o1[4 * g4 + 1] * inv), pk2(o1[4 * g4 + 2] * inv, o1[4 * g4 + 3] * inv)}; }
}

template <bool LAT>
__device__ __forceinline__ void hyena_unit(const Args& a, int l, int c, LAS unsigned char* lds, int tid) {
    constexpr int L = LAT ? 2048 : 256, NB = LAT ? 4 : 16, NE = L / 16, NCH = L / 4, NW = LAT ? 8 : 4, ASH = LAT ? 2 : 4, MG = LAT ? 224 : 32  , UP = L + 2 * MG + 8  , GS = 514  ;
    asm volatile("" : "+v"(tid));
    const int lane = tid & 63, wave = tid >> 6, r = lane & 31, h = lane >> 5;
    const bf16* UT = (const bf16*)(a.ws + WS_UT) + (LAT ? UT_LAT : 0);
    GAS bf16* OC = (GAS bf16*)(a.ws + WS_OC);
    const float* HID = (const float*)(a.ws + WS_HID) + ((size_t)l * 2304 + (LAT ? 256 : 0)) * 64;
    LAS bf16* U = (LAS bf16*)lds; LAS bf16* X = (LAS bf16*)(lds + 20096); LAS float* FT = (LAS float*)(lds + 36480); LAS unsigned char* GC = lds + 69248;
    LAS float* W3 = (LAS float*)(lds + 135040); LAS float* RED = (LAS float*)(lds + 136064);
    for (int q = tid; q < NB * L / 8; q += 512) { const int b = q / (L / 8), off = (q % (L / 8)) * 8;
        *(LAS v4u*)(U + b * UP + MG + off) = *(const GAS v4u*)(UT + ((size_t)b * 1536 + c) * L + off);
        *(LAS v4u*)(X + b * L + off) = *(const GAS v4u*)(UT + ((size_t)b * 1536 + 512 + c) * L + off); }
    for (int q = tid; q < NB * 2 * MG / 8; q += 512) { const int b = q / (2 * MG / 8), o = q % (2 * MG / 8); const int off = (o < MG / 8) ? 8 * o : MG + L + 8 * (o - MG / 8);
        *(LAS v4u*)(U + b * UP + off) = (v4u){0u, 0u, 0u, 0u}; }
    if (tid < 256) { const int j = tid >> 2, k = tid & 3; W3[k * 64 + j] = a.in[25][((size_t)l * 64 + j) * 2048 + (k >> 1) * 1024 + (k & 1) * 512 + c]; }
    __syncthreads();
#if defined(PROBE_HY) && PROBE_HY == 1
    for (int rep = 0; rep < 2; ++rep)
#endif
    { const float dmin = -15.350567286626973f, dmax = -3.0701134573253945f;
      const float delta = fabsf(dmin + (float)c * ((dmax - dmin) / 511.f));
      float p0 = 0.f, p1 = 0.f;
      for (int t = tid; t < L; t += 512) {
          float s[4] = {0.f, 0.f, 0.f, 0.f};
#pragma unroll 4
          for (int j4 = 0; j4 < 16; ++j4) { const f32x4 hv = *(const GAS f32x4*)(HID + (size_t)t * 64 + 4 * j4);
#pragma unroll
              for (int k = 0; k < 4; ++k) s[k] += hv.x * W3[k * 64 + 4 * j4] + hv.y * W3[k * 64 + 4 * j4 + 1] + hv.z * W3[k * 64 + 4 * j4 + 2] + hv.w * W3[k * 64 + 4 * j4 + 3]; }
          const float win = __expf(-((float)t / (float)(L - 1)) * delta);
#pragma unroll
          for (int k = 0; k < 4; ++k) { s[k] *= win; FT[k * L + t] = s[k]; }
          p0 += fabsf(s[0]) + (t >= 1 ? fabsf(s[2]) : 0.f); p1 += fabsf(s[1]) + (t >= 1 ? fabsf(s[3]) : 0.f); }
      p0 = wave_sum(p0); p1 = wave_sum(p1);
      if (lane == 0) { RED[2 * wave] = p0; RED[2 * wave + 1] = p1; } }
    __syncthreads();
    const int col = 32 * wave + r, ca = col >> ASH, cbat = col & (NB - 1);
    const int a_lo = (32 * wave) >> ASH, a_hi = (32 * wave + 31) >> ASH;
    const int rowbase = LAT ? TCTX + cbat * 2048 : cbat * 256;
#pragma unroll 1
    for (int n = 0; n < 2; ++n) {
        float l1s = 0.f;
#pragma unroll
        for (int w = 0; w < 8; ++w) l1s += RED[2 * w + n];
        const float invl1 = 1.f / (l1s + EPSN);
#if defined(PROBE_HY) && PROBE_HY == 4
        for (int rep = 0; rep < 2; ++rep)
#endif
        for (int q = tid; q < 8 * NCH; q += 512) { const int k = q & 7, y = q >> 3, m0 = L - (8 * y + k);
            float v[8];
#pragma unroll
            for (int j = 0; j < 8; ++j) { const int m = m0 - j; float t = 0.f; if (m >= 0 && m < L) t = FT[n * L + m]; else if (m < 0 && m > -L) t = FT[(2 + n) * L - m]; v[j] = t * invl1; }
            *(LAS v4u*)(GC + (k * GS + y) * 16) = (v4u){cvtpk(v[0], v[1]), cvtpk(v[2], v[3]), cvtpk(v[4], v[5]), cvtpk(v[6], v[7])}; }
        __syncthreads();
        f32x16 acc, acc1;
#if defined(PROBE_HY) && PROBE_HY == 3
        for (int rep = 0; rep < 2; ++rep) {
#endif
#pragma unroll
        for (int i = 0; i < 16; ++i) { acc[i] = 0.f; acc1[i] = 0.f; }
        if (wave < NW) {
            const int lam_lo = 2 * a_lo - (NE - 1), lam_hi = 2 * a_hi;
            const int xs0 = 8 * h - r + L;
            const LAS unsigned char* ap = GC + ((xs0 & 7) * GS + (xs0 >> 3) - 2 * lam_lo) * 16;
            const LAS unsigned char* bp = (const LAS unsigned char*)(U + cbat * UP + MG + 8 * h) + 32 * (2 * ca - lam_lo);
            bf16x8 a0 = *(const LAS bf16x8*)ap, b0 = *(const LAS bf16x8*)bp, a1 = *(const LAS bf16x8*)(ap - 32), b1 = *(const LAS bf16x8*)(bp - 32);
            for (int lam = lam_lo; lam <= lam_hi; lam += 2) {
                const bool more = lam + 2 <= lam_hi;
                if (more) { ap -= 64; bp -= 64; }
                const bf16x8 na0 = *(const LAS bf16x8*)ap, na1 = *(const LAS bf16x8*)(ap - 32), nb0 = *(const LAS bf16x8*)bp, nb1 = *(const LAS bf16x8*)(bp - 32);
                acc = __builtin_amdgcn_mfma_f32_32x32x16_bf16(a0, b0, acc, 0, 0, 0);
                acc1 = __builtin_amdgcn_mfma_f32_32x32x16_bf16(a1, b1, acc1, 0, 0, 0);
                a0 = na0; a1 = na1; b0 = nb0; b1 = nb1;
            }
#pragma unroll
            for (int i = 0; i < 16; ++i) acc[i] += acc1[i];
        }
#if defined(PROBE_HY) && PROBE_HY == 3
        asm volatile("" :: "v"(acc[0]), "v"(acc[5]));
        }
#endif
        const float bias = a.in[27][((size_t)l * 2 + n) * 512 + c];
        float z[16];
        if (wave < NW) {
#pragma unroll
            for (int g4 = 0; g4 < 4; ++g4) { const int t0 = 32 * ca + 8 * g4 + 4 * h;
                const v2u uw = *(const LAS v2u*)(U + cbat * UP + MG + t0), xw = *(const LAS v2u*)(X + cbat * L + t0);
                const float uv[4] = {bflo(uw.x), bfhi(uw.x), bflo(uw.y), bfhi(uw.y)}, xv[4] = {bflo(xw.x), bfhi(xw.x), bflo(xw.y), bfhi(xw.y)};
#pragma unroll
                for (int k = 0; k < 4; ++k) z[4 * g4 + k] = xv[k] * (acc[4 * g4 + k] + bias * uv[k]); }
        }
        __syncthreads();
        if (n == 0) {
            if (wave < NW) {
#pragma unroll
                for (int g4 = 0; g4 < 4; ++g4) *(LAS v2u*)(U + cbat * UP + MG + 32 * ca + 8 * g4 + 4 * h) = (v2u){pk2(z[4 * g4], z[4 * g4 + 1]), pk2(z[4 * g4 + 2], z[4 * g4 + 3])}; }
            for (int q = tid; q < NB * L / 8; q += 512) { const int b = q / (L / 8), off = (q % (L / 8)) * 8;
                *(LAS v4u*)(X + b * L + off) = *(const GAS v4u*)(UT + ((size_t)b * 1536 + 1024 + c) * L + off); }
        } else if (wave < NW) {
#if defined(PROBE_HY) && PROBE_HY == 2
            for (int rep = 0; rep < 2; ++rep)
#endif
#pragma unroll
            for (int g4 = 0; g4 < 4; ++g4)
#pragma unroll
                for (int k = 0; k < 4; ++k) OC[(size_t)(rowbase + 32 * ca + 8 * g4 + 4 * h + k) * 512 + c] = (bf16)f2bf(z[4 * g4 + k]);
        }
    }
    __syncthreads();
}
#ifndef PHMASK
#define PHMASK 0x1fff
#endif
#define PH_ON(k) (((PHMASK) >> (k)) & 1)
template <class T> __device__ __forceinline__ T* asglobal(T* p) { return (T*)(GAS T*)p; }
__global__ void __launch_bounds__(512, 2) mega_fwd(Args a) {
    extern __shared__ __attribute__((aligned(16))) unsigned char lds_raw[];
    LAS unsigned char* lds = (LAS unsigned char*)lds_raw;
    cg::grid_group grid = cg::this_grid();
    const int bid = blockIdx.x;
    using pg8::Gemm; using pg8::StaticOrder;
    const int ph_lo = a.ph_lo, ph_hi = a.ph_hi;
    volatile LAS unsigned* MISC = (volatile LAS unsigned*)(lds + LDS_BYTES - 64);
    if (threadIdx.x < 16) MISC[threadIdx.x] = 0u;
    __syncthreads();
    if (ph_hi > NPHASE) { __syncthreads(); grid.sync(); }
    XcdBarrier bar = xcd_barrier_post((unsigned*)(a.ws + WS_BAR + (size_t)a.li * BAR_REGION), MISC);
#pragma unroll 1
    for (int ph = ph_lo; ph < ph_hi; ++ph) {
        int tid = threadIdx.x; asm volatile("" : "+v"(tid));
        int G = gridDim.x; asm volatile("" : "+s"(G)); const int NGW = G * 8, NGT = G * 512;
        unsigned char* ws = a.ws; asm volatile("" : "+s"(ws));
#if defined(__HIP_DEVICE_COMPILE__)
#define ASSUME_GLOBAL(p) __builtin_assume(!__builtin_amdgcn_is_shared((const void*)(p)) && !__builtin_amdgcn_is_private((const void*)(p)))
#else
#define ASSUME_GLOBAL(p) ((void)0)
#endif
        ASSUME_GLOBAL(ws); ASSUME_GLOBAL(a.ws); ASSUME_GLOBAL(a.out);
#pragma unroll
        for (int i = 0; i < 35; ++i) ASSUME_GLOBAL(a.in[i]);
        const int lane = tid & 63, wave = __builtin_amdgcn_readfirstlane(tid >> 6), gw = bid * 8 + wave, gt = bid * 512 + tid;
        const int l = (ph >= 1 && ph < 23) ? (ph - 1) / 11 : 0, sub = (ph >= 1 && ph < 23) ? (ph - 1) % 11 : -1;
        float* mod = (float*)(ws + WS_MOD) + (size_t)l * 5 * 6144;
        if (PH_ON(11) && ph == 0) { p0_mod_hid(a, lds, bid, G, tid, gw, NGW, lane); wconv_phase(a, 0, lds, gw, NGW, gt, NGT, wave, lane); }
        else if (PH_ON(12) && ph == 23) { norm_phase(a, 0, 2, false, gw, NGW, lane); }
        else if (PH_ON(0) && sub == 0) { if (l == 1) wconv_phase(a, 1, lds, gw, NGW, gt, NGT, wave, lane); norm_phase(a, l, 0, l == 0, gw, NGW, lane); }
        else if (PH_ON(1) && sub == 1) {
            Gemm g{(const bf16*)(ws + WS_HBF), (const bf16*)(ws + WS_WIN), TT, 3072, 1024, 1024, 1024}; StaticOrder S; S.init(TT, 3072, G, bid);
            pg8::EpiSeg E{(bf16*)(ws + WS_QA), (bf16*)(ws + WS_KVR), (bf16*)(ws + WS_CQ), (bf16*)(ws + WS_CKVR), (bf16*)(ws + WS_HYR)};
            pg8::gemm_phase<pg8::EpiSeg, StaticOrder, true, true>(lds, g, S, E);
        }
        else if (PH_ON(2) && sub == 2) { post_phase(a, l, lds, bid, G, tid, gw, NGW, gt, NGT, lane); }
        else if (PH_ON(3) && sub == 3) {
#pragma unroll 1
            for (int q = 0; q < 3; ++q) {
                Gemm g; StaticOrder S; pg8::EpiStore<0> E;
                if (q == 0) { g = Gemm{(const bf16*)(ws + WS_CQ), (const bf16*)(ws + WS_WUQ), TT, 768, 384, 512, 384}; S.init(TT, 768, G, bid); E = pg8::EpiStore<0>{(bf16*)(ws + WS_QB), 768}; }
                else if (q == 1) { g = Gemm{(const bf16*)(ws + WS_CKVALL), (const bf16*)(ws + WS_WKN), NKEYROWS, 512, 256, 256, 256}; S.init(NKEYROWS, 512, G, (bid + G - 144 % G) % G); E = pg8::EpiStore<0>{(bf16*)(ws + WS_KNB), 512}; }
                else { g = Gemm{(const bf16*)(ws + WS_WVV), (const bf16*)(ws + WS_CKVALL), 512, NKEYROWS, 256, 256, 256}; S.init(512, NKEYROWS, G, (bid + G - 248 % G) % G); E = pg8::EpiStore<0>{(bf16*)(ws + WS_VTB), NKEYROWS}; }
                pg8::gemm_phase<pg8::EpiStore<0>, StaticOrder, true, true>(lds, g, S, E);
            }
        }
        else if (PH_ON(4) && sub == 4) {
            const bf16 *QA = (const bf16*)(ws + WS_QA), *QB = (const bf16*)(ws + WS_QB), *KA = (const bf16*)(ws + WS_KA), *VTA = (const bf16*)(ws + WS_VTA);
            const bf16 *KNB = (const bf16*)(ws + WS_KNB), *VTB = (const bf16*)(ws + WS_VTB), *KPE = (const bf16*)(ws + WS_KPEALL);
            bf16 *OA = (bf16*)(ws + WS_OA), *OB = (bf16*)(ws + WS_OB);
            const float slA = 0.125f * 1.4426950408889634f, slB = 0.10206207261596575f * 1.4426950408889634f;
            const int sel = a.pad;
            for (int it = bid; it < 1792; it += G) {
                { const bool is_hy = (it >= 512 && it < 1024) || it >= 1280; if ((sel == 1 && is_hy) || (sel == 2 && !is_hy)) continue; }
                if (it < 256 || (it >= 1024 && it < 1152)) {
                    const bool lat = it < 256; const int u = lat ? (G == 256 ? ((bid & 7) * 4 + (bid >> 6)) * 8 + ((bid >> 3) & 7) : it) : it - 1024;
                    const int b = lat ? u >> 6 : u >> 3, hh = lat ? (u >> 3) & 7 : u & 7, qb = lat ? u & 7 : 0;
                    const int row0 = lat ? TCTX + b * 2048 + qb * 256 : b * 256, key0 = lat ? TCTX + b * 2304 : b * 256;
                    attn_unit<96>(lds, tid, QB + (size_t)row0 * 768 + hh * 96, 768, KNB + (size_t)key0 * 512 + hh * 64, 512, KPE + (size_t)key0 * 32, VTB + (size_t)(hh * 64) * NKEYROWS + key0, NKEYROWS,
                                  lat ? 2304 : 256, OB + (size_t)row0 * 512 + hh * 64, 512, slB, lat, qb * 256);
                } else if (it < 512 || (it >= 1152 && it < 1280)) {
                    const bool lat = it < 512; const int u = lat ? (G == 256 ? ((bid & 7) * 4 + (bid >> 6)) * 8 + ((bid >> 3) & 7) : it - 256) : it - 1152;
                    const int b = lat ? u >> 6 : u >> 3, hh = lat ? (u >> 3) & 7 : u & 7, qb = lat ? u & 7 : 0, kvh = hh >> 2;
                    const int row0 = lat ? TCTX + b * 2048 + qb * 256 : b * 256, nk = lat ? 2304 : 256;
                    const size_t kbase = lat ? (size_t)KA_LAT + (size_t)(b * 2 + kvh) * 2304 * 64 : (size_t)(b * 2 + kvh) * 256 * 64;
                    attn_unit<64>(lds, tid, QA + (size_t)row0 * 512 + hh * 64, 512, KA + kbase, 64, nullptr, VTA + kbase, nk, nk, OA + (size_t)row0 * 512 + hh * 64, 512, slA, false, 0);
                } else if (it < 1024) { hyena_unit<true>(a, l, it - 512, lds, tid); }
                else { hyena_unit<false>(a, l, it - 1280, lds, tid); }
            }
        }
        else if (PH_ON(5) && sub == 5) {
            const bf16* HBF = (const bf16*)(ws + WS_HBF); bf16* Sg = (bf16*)(ws + WS_S); float* MACC = (float*)(ws + WS_MACC); bf16* MBF = (bf16*)(ws + WS_MBF);
#pragma unroll 1
            for (int n = 0; n < 3; ++n) {
                { Gemm g{HBF, (const bf16*)(ws + WS_WG) + (size_t)n * 1024 * 1024, TT, 1024, 1024, 1024, 1024}; StaticOrder S; S.init(TT, 1024, G, bid);
                  pg8::EpiStore<1> E{Sg, 1024}; pg8::gemm_phase<pg8::EpiStore<1>, StaticOrder, true, true>(lds, g, S, E); }
                Gemm g{(const bf16*)(ws + WS_OA) + (size_t)n * TT * 512, (const bf16*)(ws + WS_WB) + (size_t)n * 1024 * 512, TT, 1024, 512, 512, 512}; StaticOrder S; S.init(TT, 1024, G, bid);
                if (n == 0) { pg8::EpiMerge<0> E{Sg, MACC, MBF}; pg8::gemm_phase<pg8::EpiMerge<0>, StaticOrder, true, true>(lds, g, S, E); }
                else if (n == 1) { pg8::EpiMerge<1> E{Sg, MACC, MBF}; pg8::gemm_phase<pg8::EpiMerge<1>, StaticOrder, true, true>(lds, g, S, E); }
                else { pg8::EpiMerge<2> E{Sg, MACC, MBF}; pg8::gemm_phase<pg8::EpiMerge<2>, StaticOrder, true, true>(lds, g, S, E); }
            }
        }
        else if (PH_ON(6) && sub == 6) {
            Gemm g{(const bf16*)(ws + WS_MBF), (const bf16*)(ws + WS_WO), TT, 1024, 1024, 1024, 1024}; StaticOrder S; S.init(TT, 1024, G, bid);
            pg8::EpiResid E{a.out, mod + 2048}; pg8::gemm_phase<pg8::EpiResid, StaticOrder, true, true>(lds, g, S, E);
        }
        else if (PH_ON(7) && sub == 7) { norm_phase(a, l, 1, false, gw, NGW, lane); }
        else if (PH_ON(8) && sub == 8) {
            Gemm g{(const bf16*)(ws + WS_HBF), (const bf16*)(ws + WS_WUP), TT, 5632, 1024, 1024, 1024}; StaticOrder S; S.init(TT, 5632, G, bid);
            pg8::EpiStore<0> E{(bf16*)(ws + WS_U), 5632}; pg8::gemm_phase<pg8::EpiStore<0>, StaticOrder, true, true>(lds, g, S, E);
        }
        else if (PH_ON(9) && sub == 9) { ffnconv_phase(a, l, gt, NGT); }
        else if (PH_ON(10) && sub == 10) {
            Gemm g{(const bf16*)(ws + WS_ACT), (const bf16*)(ws + WS_WDN), TT, 1024, 2816, 2816, 2816}; StaticOrder S; S.init(TT, 1024, G, bid);
            pg8::EpiResid E{a.out, mod + 5120}; pg8::gemm_phase<pg8::EpiResid, StaticOrder, true, true>(lds, g, S, E);
        }
#ifdef EXTRA_SYNCS
        for (int q = 0; q < EXTRA_SYNCS; ++q) { __syncthreads(); grid.sync(); }
#endif
        if (ph + 1 < ph_hi) xcd_barrier(bar);
    }
}

extern "C" void kernel_launch(void* const* d_in, const int* in_sizes, int n_in, void* d_out, int out_size, void* d_ws, size_t ws_size, hipStream_t stream) {
    static int grid = 0;
    if (grid == 0) {
        if (n_in != 35 || ws_size < WS_END) { fprintf(stderr, "kernel_launch: unexpected n_in %d / ws %zu\n", n_in, ws_size); grid = -1; return; }
        int dev = 0, cus = 0, per_cu = 0;
        if (hipGetDevice(&dev) != hipSuccess || hipDeviceGetAttribute(&cus, hipDeviceAttributeMultiprocessorCount, dev) != hipSuccess) { grid = -1; return; }
        if (hipFuncSetAttribute((const void*)mega_fwd, hipFuncAttributeMaxDynamicSharedMemorySize, LDS_BYTES) != hipSuccess) { fprintf(stderr, "kernel_launch: hipFuncSetAttribute failed\n"); grid = -1; return; }
        if (hipOccupancyMaxActiveBlocksPerMultiprocessor(&per_cu, (const void*)mega_fwd, 512, LDS_BYTES) != hipSuccess || per_cu < 1) { fprintf(stderr, "kernel_launch: occupancy query says %d\n", per_cu); per_cu = 1; }
        (void)hipGetLastError();
        grid = cus;
    }
    if (grid < 0) return;
    if (hipMemsetAsync((char*)d_ws + WS_MOD, 0, ZERO_BYTES, stream) != hipSuccess) { fprintf(stderr, "kernel_launch: memset failed\n"); return; }
    Args a{};
    for (int i = 0; i < 35; ++i) a.in[i] = (const float*)d_in[i];
    a.out = (float*)d_out; a.ws = (unsigned char*)d_ws;
#if defined(MK_PER_PHASE)
    for (int p = 0; p < NPHASE; ++p) { a.ph_lo = p; a.ph_hi = p + 1; a.li = 0; void* args[] = {&a};
        hipError_t e = hipLaunchCooperativeKernel((const void*)mega_fwd, dim3(grid), dim3(512), args, LDS_BYTES, stream);
        if (e != hipSuccess) { fprintf(stderr, "launch %d failed: %s\n", p, hipGetErrorString(e)); break; } }
#else
#if defined(PROBE_SUB)
#ifndef PROBE_SEL
#define PROBE_SEL 0
#endif
    { const int k0 = 1 + PROBE_SUB, k1 = 12 + PROBE_SUB; const int cuts[6][2] = {{0, k0 + 1}, {k0, k0 + 1}, {k0 + 1, k1 + 1}, {k1, k1 + 1}, {k1 + 1, NPHASE}, {0, 0}};
      for (int c = 0; c < 5; ++c) { a.ph_lo = cuts[c][0]; a.ph_hi = cuts[c][1]; a.li = c; a.pad = (c == 1 || c == 3) ? PROBE_SEL : 0; if (a.ph_lo >= a.ph_hi) continue; void* args[] = {&a};
          hipError_t e = hipLaunchCooperativeKernel((const void*)mega_fwd, dim3(grid), dim3(512), args, LDS_BYTES, stream);
          if (e != hipSuccess) { fprintf(stderr, "cooperative launch failed: %s\n", hipGetErrorString(e)); break; } } }
#elif defined(PROBE_CUTS)
    { const int k0 = 1 + PROBE_CUTS, k1 = 12 + PROBE_CUTS; const int cuts[4][2] = {{0, k0 + 1}, {k0 + 1, k1 + 1}, {k1 + 1, NPHASE}, {0, 0}};
      for (int c = 0; c < 3; ++c) { a.ph_lo = cuts[c][0]; a.ph_hi = cuts[c][1]; a.li = c; if (a.ph_lo >= a.ph_hi) continue; void* args[] = {&a};
          hipError_t e = hipLaunchCooperativeKernel((const void*)mega_fwd, dim3(grid), dim3(512), args, LDS_BYTES, stream);
          if (e != hipSuccess) { fprintf(stderr, "cooperative launch failed: %s\n", hipGetErrorString(e)); break; } } }
#else
    a.ph_lo = 0; a.ph_hi = NPHASE; void* args[] = {&a};
    hipError_t e = hipLaunchCooperativeKernel((const void*)mega_fwd, dim3(grid), dim3(512), args, LDS_BYTES, stream);
    if (e != hipSuccess) fprintf(stderr, "cooperative launch failed: %s (grid %d)\n", hipGetErrorString(e), grid);
#endif
#endif
}
```

```cpp
#include <hip/hip_runtime.h>
#include <hip/hip_cooperative_groups.h>
#include <cstdio>
#include <cstdint>
namespace cg = cooperative_groups;
namespace pg8 {
#define PG8_LAS __attribute__((address_space(3)))
typedef unsigned short bf16_t;
typedef short bf16x8 __attribute__((ext_vector_type(8)));
typedef float f32x4 __attribute__((ext_vector_type(4)));
typedef unsigned u32x4 __attribute__((ext_vector_type(4)));
constexpr int BM = 256, BK = 64, HALF = 128, HTB = HALF * BK * 2  , STAGE_BYTES = 8 * HTB, NXCD = 8, WGM = 8;

__host__ __device__ __forceinline__ int lds_byte(int r, int c) { const int st = (r >> 4) * 2 + (c >> 5), rr = r & 15, cc = c & 31, ob = rr * 64 + cc * 2; return st * 1024 + (ob ^ (((ob >> 9) & 1) << 5)); }
__host__ __device__ __forceinline__ void stage_rc(int b, int& R, int& C) { const int st = b / 1024, sb = b % 1024, swz = sb ^ (((sb >> 9) & 1) << 5); R = (st >> 1) * 16 + swz / 64; C = (st & 1) * 32 + (swz % 64) / 2; }
__host__ __device__ __forceinline__ int perm32(int rho) { const int n = rho >> 4, i = rho & 15; return 8 * (i >> 2) + 4 * n + (i & 3); }

struct Unit { int pm, pn; };
struct Gemm { const bf16_t* A; const bf16_t* Bt; int M, N, K, lda, ldb; };

struct StaticOrder {
    int nM, nN, nwg, G, c;
    __host__ __device__ void init(int M, int N, int G_, int c_) { nM = M / BM; nN = N / BM; nwg = nM * nN; G = G_; c = c_; }
    __host__ __device__ bool next(int i, Unit& u) const {
        const long L = (long)i * G + c; if (L >= nwg) return false;
        int wgid = (int)L; { const int q = nwg / NXCD, r = nwg % NXCD, xcd = wgid % NXCD, off = wgid / NXCD; wgid = (xcd < r ? xcd * (q + 1) : r * (q + 1) + (xcd - r) * q) + off; }
        const int nig = WGM * nN, gid = wgid / nig, fm = gid * WGM, gsz = (nM - fm) < WGM ? (nM - fm) : WGM;
        u.pm = fm + ((wgid % nig) % gsz); u.pn = (wgid % nig) / gsz; return true;
    }
    __device__ __forceinline__ void a_ready(const Unit&) const {}
    __device__ __forceinline__ void done(const Unit&) const {}
};

#ifndef GAS
#define GAS __attribute__((address_space(1)))
#endif
typedef float f32x2v __attribute__((ext_vector_type(2)));
typedef __bf16 bf16x2v __attribute__((ext_vector_type(2)));
__device__ __forceinline__ unsigned cvt_pk_bf16(float lo, float hi) { const f32x2v v = {lo, hi}; const bf16x2v b = __builtin_convertvector(v, bf16x2v); return __builtin_bit_cast(unsigned, b); }
__device__ __forceinline__ float sigm(float x) { return __builtin_amdgcn_rcpf(1.f + __expf(-x)); }
#define EPI_FOR _Pragma("unroll") for (int ai = 0; ai < 2; ++ai) _Pragma("unroll") for (int m = 0; m < 4; ++m) _Pragma("unroll") for (int bj = 0; bj < 2; ++bj)

template <int ACT  > struct EpiStore {
    static constexpr bool PERM = true, AFTER_DRAIN = false;
    bf16_t* O; int ld;
    __device__ __forceinline__ void operator()(const f32x4 (&acc)[2][2][4][2], const Unit& u, int wr, int wc, int fr, int fq) const {
        const int row0 = u.pm * BM + wr * 64 + fr, col0 = u.pn * BM + wc * 32 + 8 * fq;
        EPI_FOR { f32x4 v0 = acc[ai][bj][m][0], v1 = acc[ai][bj][m][1];
            if (ACT == 1) { v0 = (f32x4){sigm(v0[0]), sigm(v0[1]), sigm(v0[2]), sigm(v0[3])}; v1 = (f32x4){sigm(v1[0]), sigm(v1[1]), sigm(v1[2]), sigm(v1[3])}; }
            u32x4 w; w.x = cvt_pk_bf16(v0[0], v0[1]); w.y = cvt_pk_bf16(v0[2], v0[3]); w.z = cvt_pk_bf16(v1[0], v1[1]); w.w = cvt_pk_bf16(v1[2], v1[3]);
            *(GAS u32x4*)(O + (size_t)(row0 + ai * HALF + m * 16) * ld + col0 + bj * HALF) = w; }
    }
};
struct EpiSeg {
    static constexpr bool PERM = true, AFTER_DRAIN = false;
    bf16_t *QA, *KV, *CQ, *CKV, *HY;
    __device__ __forceinline__ void operator()(const f32x4 (&acc)[2][2][4][2], const Unit& u, int wr, int wc, int fr, int fq) const {
        bf16_t* base; int ld, coff; const int pn = u.pn;
        if (pn < 2) { base = QA; ld = 512; coff = 256 * pn; } else if (pn == 2) { base = KV; ld = 256; coff = 0; } else if (pn < 5) { base = CQ; ld = 512; coff = 256 * (pn - 3); }
        else if (pn == 5) { base = CKV; ld = 256; coff = 0; } else { base = HY; ld = 1536; coff = 256 * (pn - 6); }
        const int row0 = u.pm * BM + wr * 64 + fr, col0 = coff + wc * 32 + 8 * fq;
        EPI_FOR { const f32x4 v0 = acc[ai][bj][m][0], v1 = acc[ai][bj][m][1];
            u32x4 w; w.x = cvt_pk_bf16(v0[0], v0[1]); w.y = cvt_pk_bf16(v0[2], v0[3]); w.z = cvt_pk_bf16(v1[0], v1[1]); w.w = cvt_pk_bf16(v1[2], v1[3]);
            *(GAS u32x4*)(base + (size_t)(row0 + ai * HALF + m * 16) * ld + col0 + bj * HALF) = w; }
    }
};
template <int MODE  > struct EpiMerge {
    static constexpr bool PERM = true, AFTER_DRAIN = false;
    const bf16_t* S; float* Macc; bf16_t* Mbf;
    __device__ __forceinline__ void operator()(const f32x4 (&acc)[2][2][4][2], const Unit& u, int wr, int wc, int fr, int fq) const {
        const int row0 = u.pm * BM + wr * 64 + fr, col0 = u.pn * BM + wc * 32 + 8 * fq;
        EPI_FOR { const size_t off = (size_t)(row0 + ai * HALF + m * 16) * 1024 + col0 + bj * HALF;
            const u32x4 sw = *(const GAS u32x4*)(S + off);
            f32x4 s0 = (f32x4){__uint_as_float(sw.x << 16), __uint_as_float(sw.x & 0xffff0000u), __uint_as_float(sw.y << 16), __uint_as_float(sw.y & 0xffff0000u)};
            f32x4 s1 = (f32x4){__uint_as_float(sw.z << 16), __uint_as_float(sw.z & 0xffff0000u), __uint_as_float(sw.w << 16), __uint_as_float(sw.w & 0xffff0000u)};
            f32x4 v0 = acc[ai][bj][m][0] * s0, v1 = acc[ai][bj][m][1] * s1;
            if (MODE >= 1) { v0 = v0 + *(const GAS f32x4*)(Macc + off); v1 = v1 + *(const GAS f32x4*)(Macc + off + 4); }
            if (MODE <= 1) { *(GAS f32x4*)(Macc + off) = v0; *(GAS f32x4*)(Macc + off + 4) = v1; }
            else { u32x4 w; w.x = cvt_pk_bf16(v0[0], v0[1]); w.y = cvt_pk_bf16(v0[2], v0[3]); w.z = cvt_pk_bf16(v1[0], v1[1]); w.w = cvt_pk_bf16(v1[2], v1[3]); *(GAS u32x4*)(Mbf + off) = w; } }
    }
};
struct EpiResid {
    static constexpr bool PERM = true, AFTER_DRAIN = false;
    float* X; const float* gate;
    __device__ __forceinline__ void operator()(const f32x4 (&acc)[2][2][4][2], const Unit& u, int wr, int wc, int fr, int fq) const {
        const int row0 = u.pm * BM + wr * 64 + fr, col0 = u.pn * BM + wc * 32 + 8 * fq;
        const int mrow = (u.pm < 16) ? 0 : 1 + ((u.pm - 16) >> 3);
        const float* gp = gate + (size_t)mrow * 6144 + col0;
        f32x4 g[2][2];
#pragma unroll
        for (int bj = 0; bj < 2; ++bj) { g[bj][0] = *(const GAS f32x4*)(gp + bj * HALF); g[bj][1] = *(const GAS f32x4*)(gp + bj * HALF + 4); }
        EPI_FOR { float* xp = X + (size_t)(row0 + ai * HALF + m * 16) * 1024 + col0 + bj * HALF;
            const f32x4 x0 = *(const GAS f32x4*)xp, x1 = *(const GAS f32x4*)(xp + 4);
            *(GAS f32x4*)xp = x0 + g[bj][0] * acc[ai][bj][m][0]; *(GAS f32x4*)(xp + 4) = x1 + g[bj][1] * acc[ai][bj][m][1]; }
    }
};

template <class Epi, class Sched, bool ALIGN_EPI = false, bool SP2 = false>
__device__ __forceinline__ void gemm_phase(PG8_LAS unsigned char* lds, const Gemm g, const Sched& S, const Epi& E) {
    int tid_l = threadIdx.x; asm volatile("" : "+v"(tid_l));
    const int tid = tid_l, wid = __builtin_amdgcn_readfirstlane(tid >> 6), lane = tid & 63, wr = wid >> 2, wc = wid & 3, fr = lane & 15, fq = lane >> 4;
    const int K = g.K, nt = K / BK;
    unsigned voffA[2], voffB[2];
#pragma unroll
    for (int i = 0; i < 2; ++i) { int R, C; stage_rc(tid * 16 + i * 8192, R, C); const int Rb = Epi::PERM ? ((R & ~31) + perm32(R & 31)) : R;
        voffA[i] = (unsigned)(R * g.lda + C) * 2u; voffB[i] = (unsigned)(Rb * g.ldb + C) * 2u; }
    const size_t kstep = (size_t)(BK * 2);
    const size_t hstepA = (size_t)HALF * g.lda * 2, hstepB = (size_t)HALF * g.ldb * 2;
    const size_t tstepA = 2 * hstepA, tstepB = 2 * hstepB;
    const unsigned ldsw = (unsigned)wid * 1024u;
    const int aoff = lds_byte(wr * 64 + fr, fq * 8), boff = lds_byte(wc * 32 + fr, fq * 8);
#define PG8_SA(b, h) (((b) * 2 + (h)) * HTB)
#define PG8_SB(b, h) ((4 + (b) * 2 + (h)) * HTB)
#define PG8_STAGE(bufoff, gbase, voff) do { _Pragma("unroll") for (int _i = 0; _i < 2; ++_i) \
        __builtin_amdgcn_global_load_lds((const unsigned*)((const char*)(gbase) + (voff)[_i]), (PG8_LAS unsigned*)(lds + (bufoff) + ldsw + _i * 8192), 16, 0, 0); } while (0)
#define PG8_LDA(dst, b, h) do { _Pragma("unroll") for (int m = 0; m < 4; ++m) _Pragma("unroll") for (int k = 0; k < 2; ++k) dst[m][k] = *(const PG8_LAS bf16x8*)(lds + PG8_SA(b, h) + aoff + m * 2048 + k * 1024); } while (0)
#define PG8_LDB(dst, b, h) do { _Pragma("unroll") for (int n = 0; n < 2; ++n) _Pragma("unroll") for (int k = 0; k < 2; ++k) dst[n][k] = *(const PG8_LAS bf16x8*)(lds + PG8_SB(b, h) + boff + n * 2048 + k * 1024); } while (0)
#define PG8_MMA(ai, bj, At, Bt) do { __builtin_amdgcn_s_setprio(1); _Pragma("unroll") for (int m = 0; m < 4; ++m) _Pragma("unroll") for (int n = 0; n < 2; ++n) _Pragma("unroll") for (int k = 0; k < 2; ++k) \
        acc[ai][bj][m][n] = __builtin_amdgcn_mfma_f32_16x16x32_bf16(Bt[n][k], At[m][k], acc[ai][bj][m][n], 0, 0, 0); __builtin_amdgcn_s_setprio(0); } while (0)
#define PG8_WAIT_V(n) asm volatile("s_waitcnt vmcnt(" #n ")" ::: "memory")
#define PG8_WAIT_L(n) asm volatile("s_waitcnt lgkmcnt(" #n ")" ::: "memory")
#define PG8_BAR __builtin_amdgcn_s_barrier()
#define PG8_SCHED __builtin_amdgcn_sched_barrier(0)
    Unit cur, nxt; int ui = 0;
    if (!S.next(0, cur)) return;
    f32x4 acc[2][2][4][2];
#pragma unroll
    for (int a = 0; a < 2; ++a)
#pragma unroll
        for (int b = 0; b < 2; ++b)
#pragma unroll
            for (int m = 0; m < 4; ++m)
#pragma unroll
                for (int n = 0; n < 2; ++n) acc[a][b][m][n] = (f32x4){0.f, 0.f, 0.f, 0.f};
    bf16x8 At[4][2], B0[2][2], B1[2][2];
    const char* cA = (const char*)g.A + (size_t)cur.pm * tstepA; const char* cB = (const char*)g.Bt + (size_t)cur.pn * tstepB;
    S.a_ready(cur);
    if constexpr (SP2) {
        PG8_STAGE(PG8_SB(0, 0), cB, voffB); PG8_STAGE(PG8_SB(0, 1), cB + hstepB, voffB); PG8_STAGE(PG8_SA(0, 0), cA, voffA); PG8_STAGE(PG8_SA(0, 1), cA + hstepA, voffA);
        if (wr == 1) PG8_BAR;
        PG8_WAIT_V(2); PG8_BAR;
        PG8_STAGE(PG8_SB(1, 0), cB + kstep, voffB); PG8_STAGE(PG8_SA(1, 0), cA + kstep, voffA); PG8_STAGE(PG8_SB(1, 1), cB + hstepB + kstep, voffB);
        PG8_WAIT_V(6); PG8_BAR;
    } else {
        PG8_STAGE(PG8_SB(0, 0), cB, voffB); PG8_STAGE(PG8_SA(0, 0), cA, voffA); PG8_STAGE(PG8_SB(0, 1), cB + hstepB, voffB); PG8_STAGE(PG8_SA(0, 1), cA + hstepA, voffA);
        if (wr == 1) PG8_BAR;
        PG8_WAIT_V(4); PG8_BAR;
        PG8_STAGE(PG8_SB(1, 0), cB + kstep, voffB); PG8_STAGE(PG8_SA(1, 0), cA + kstep, voffA); PG8_STAGE(PG8_SB(1, 1), cB + hstepB + kstep, voffB);
        PG8_WAIT_V(6); PG8_BAR;
    }
    for (;;) {
        const bool has_next = S.next(ui + 1, nxt);
        const char* nA = has_next ? (const char*)g.A + (size_t)nxt.pm * tstepA : cA; const char* nB = has_next ? (const char*)g.Bt + (size_t)nxt.pn * tstepB : cB;
        for (int t = 0; t < nt; t += 2) {
            const bool last = (t == nt - 2);
            const char* a1 = cA + (size_t)(t + 1) * kstep;
            const char* a2 = last ? nA : cA + (size_t)(t + 2) * kstep; const char* b2 = last ? nB : cB + (size_t)(t + 2) * kstep;
            const char* a3 = a2 + kstep; const char* b3 = b2 + kstep;
            if (last && has_next) S.a_ready(nxt);
            if constexpr (SP2) {
            PG8_LDB(B0, 0, 0); PG8_LDB(B1, 0, 1); PG8_SCHED; PG8_LDA(At, 0, 0); PG8_STAGE(PG8_SA(1, 1), a1 + hstepA, voffA);
            PG8_WAIT_V(8); PG8_WAIT_L(0); PG8_BAR; PG8_MMA(0, 0, At, B0); PG8_MMA(0, 1, At, B1); PG8_BAR; PG8_SCHED;
            PG8_LDA(At, 0, 1); PG8_STAGE(PG8_SB(0, 0), b2, voffB); PG8_STAGE(PG8_SB(0, 1), b2 + hstepB, voffB); PG8_STAGE(PG8_SA(0, 0), a2, voffA);
            PG8_WAIT_V(8); PG8_WAIT_L(0); PG8_BAR; PG8_MMA(1, 0, At, B0); PG8_MMA(1, 1, At, B1); PG8_BAR; PG8_SCHED;
            PG8_LDB(B0, 1, 0); PG8_LDB(B1, 1, 1); PG8_SCHED; PG8_LDA(At, 1, 0); PG8_STAGE(PG8_SA(0, 1), a2 + hstepA, voffA);
            PG8_WAIT_V(8); PG8_WAIT_L(0); PG8_BAR; PG8_MMA(0, 0, At, B0); PG8_MMA(0, 1, At, B1); PG8_BAR; PG8_SCHED;
            PG8_LDA(At, 1, 1); PG8_STAGE(PG8_SB(1, 0), b3, voffB); PG8_STAGE(PG8_SB(1, 1), b3 + hstepB, voffB); PG8_STAGE(PG8_SA(1, 0), a3, voffA);
            PG8_WAIT_V(8); PG8_WAIT_L(0); PG8_BAR; PG8_MMA(1, 0, At, B0); PG8_MMA(1, 1, At, B1); PG8_BAR; PG8_SCHED;
            } else {
            PG8_LDB(B0, 0, 0); PG8_SCHED; PG8_LDA(At, 0, 0); PG8_STAGE(PG8_SA(1, 1), a1 + hstepA, voffA);
            PG8_WAIT_L(8); PG8_BAR; PG8_WAIT_L(0); PG8_MMA(0, 0, At, B0); PG8_BAR; PG8_SCHED;
            PG8_LDB(B1, 0, 1); PG8_STAGE(PG8_SB(0, 0), b2, voffB);
            PG8_BAR; PG8_WAIT_L(0); PG8_MMA(0, 1, At, B1); PG8_BAR;
            PG8_LDA(At, 0, 1); PG8_STAGE(PG8_SA(0, 0), a2, voffA);
            PG8_BAR; PG8_WAIT_L(0); PG8_MMA(1, 0, At, B0); PG8_BAR; PG8_SCHED;
            PG8_STAGE(PG8_SB(0, 1), b2 + hstepB, voffB);
            PG8_WAIT_V(6); PG8_BAR; PG8_MMA(1, 1, At, B1); PG8_BAR;
            PG8_LDB(B0, 1, 0); PG8_SCHED; PG8_LDA(At, 1, 0); PG8_STAGE(PG8_SA(0, 1), a2 + hstepA, voffA);
            PG8_WAIT_L(8); PG8_BAR; PG8_WAIT_L(0); PG8_MMA(0, 0, At, B0); PG8_BAR; PG8_SCHED;
            PG8_LDB(B1, 1, 1); PG8_STAGE(PG8_SB(1, 0), b3, voffB);
            PG8_BAR; PG8_WAIT_L(0); PG8_MMA(0, 1, At, B1); PG8_BAR;
            PG8_LDA(At, 1, 1); PG8_STAGE(PG8_SA(1, 0), a3, voffA);
            PG8_BAR; PG8_WAIT_L(0); PG8_MMA(1, 0, At, B0); PG8_BAR; PG8_SCHED;
            PG8_STAGE(PG8_SB(1, 1), b3 + hstepB, voffB);
            PG8_WAIT_V(6); PG8_BAR; PG8_MMA(1, 1, At, B1); PG8_BAR;
            }
        }
        if constexpr (ALIGN_EPI) { if (wr == 0) PG8_BAR; }
        if constexpr (!Epi::AFTER_DRAIN) { E(acc, cur, wr, wc, fr, fq); S.done(cur); }
        if (!has_next) break;
#pragma unroll
        for (int a = 0; a < 2; ++a)
#pragma unroll
            for (int b = 0; b < 2; ++b)
#pragma unroll
                for (int m = 0; m < 4; ++m)
#pragma unroll
                    for (int n = 0; n < 2; ++n) acc[a][b][m][n] = (f32x4){0.f, 0.f, 0.f, 0.f};
        cur = nxt; cA = nA; cB = nB; ++ui;
        if constexpr (ALIGN_EPI) { if (wr == 1) PG8_BAR; }
    }
    PG8_WAIT_V(0);
    if constexpr (!ALIGN_EPI) { if (wr == 0) PG8_BAR; }
    PG8_BAR;
    if constexpr (Epi::AFTER_DRAIN) { E.fused(acc, cur, wr, wc, fr, fq, lds, wid, lane); S.done(cur); }
#undef PG8_SA
#undef PG8_SB
#undef PG8_STAGE
#undef PG8_LDA
#undef PG8_LDB
#undef PG8_MMA
#undef PG8_WAIT_V
#undef PG8_WAIT_L
#undef PG8_BAR
#undef PG8_SCHED
}
}

constexpr int TCTX = 4096, TLAT = 8192, TT = 12288, DM = 1024, NKEYROWS = 13312;
constexpr float EPSN = 1e-6f;
constexpr size_t MiB = 1u << 20;
constexpr size_t WS_MOD = 0, MOD_BYTES = 2 * 5 * 6144 * 4, WS_BAR = 262144, BAR_REGION = 16384, ZERO_BYTES = WS_BAR + 5 * BAR_REGION;
constexpr size_t WS_HID = 1 * MiB;
constexpr size_t WS_WIN = 3 * MiB, WS_WG = 9 * MiB, WS_WUQ = 15 * MiB, WS_WKN = 16 * MiB, WS_WVV = 16 * MiB + 262144, WS_WB = 17 * MiB, WS_WO = 20 * MiB, WS_WUP = 22 * MiB, WS_WDN = 33 * MiB;
constexpr size_t WS_U = 39 * MiB, WS_ACT = 171 * MiB, WS_HBF = 171 * MiB;
constexpr size_t WS_QA = 39 * MiB, WS_KVR = 51 * MiB, WS_CQ = 57 * MiB, WS_CKVR = 69 * MiB, WS_HYR = 75 * MiB, WS_OA = 75 * MiB, WS_OB = 87 * MiB, WS_OC = 99 * MiB;
constexpr size_t WS_UT = 111 * MiB, WS_QB = 147 * MiB, WS_CKVALL = 195 * MiB, WS_KPEALL = 202 * MiB, WS_KNB = 203 * MiB, WS_VTB = 216 * MiB, WS_KA = 229 * MiB, WS_VTA = 233 * MiB;
constexpr size_t WS_S = 111 * MiB, WS_MBF = 135 * MiB, WS_MACC = 195 * MiB, WS_END = 256 * MiB;
constexpr int KA_LAT = 16 * 2 * 256 * 64;
constexpr int UT_LAT = 16 * 1536 * 256;
constexpr int OUT_K = 12582912, OUT_V = 13631488, OUT_CKV = 14680064, OUT_KPE = 16777216;
constexpr int LDS_BYTES = 147456;
constexpr int NPHASE = 24;

#ifndef GAS
#define GAS __attribute__((address_space(1)))
#endif
#define LAS __attribute__((address_space(3)))
typedef unsigned short bf16;
typedef unsigned v4u __attribute__((ext_vector_type(4)));
typedef unsigned v2u __attribute__((ext_vector_type(2)));
typedef float f32x4 __attribute__((ext_vector_type(4)));
typedef float f32x16 __attribute__((ext_vector_type(16)));
typedef short bf16x8 __attribute__((ext_vector_type(8)));
typedef short bf16x4 __attribute__((ext_vector_type(4)));
#define LDS_WAIT() asm volatile("s_waitcnt lgkmcnt(0)" ::: "memory")
__device__ __forceinline__ unsigned f2bf(float f) { unsigned u = __builtin_bit_cast(unsigned, f); return (u + 0x7fffu + ((u >> 16) & 1u)) >> 16; }
__device__ __forceinline__ unsigned pk2(float lo, float hi) { return f2bf(lo) | (f2bf(hi) << 16); }
__device__ __forceinline__ float bflo(unsigned w) { return __uint_as_float(w << 16); }
__device__ __forceinline__ float bfhi(unsigned w) { return __uint_as_float(w & 0xffff0000u); }
__device__ __forceinline__ float bf1(bf16 b) { return __uint_as_float(((unsigned)b) << 16); }
__device__ __forceinline__ void fsincos(float x, float& s, float& c) { float rev = x * 0.15915494309189535f; rev = rev - rintf(rev); s = __builtin_amdgcn_sinf(rev); c = __builtin_amdgcn_cosf(rev); }
__device__ __forceinline__ float fsin(float x) { float rev = x * 0.15915494309189535f; rev = rev - rintf(rev); return __builtin_amdgcn_sinf(rev); }
__device__ __forceinline__ float wave_sum(float v) {
#pragma unroll
    for (int o = 1; o < 64; o <<= 1) v += __shfl_xor(v, o);
    return v;
}
__device__ __forceinline__ void rope2(float& x0, float& x1, float ang) { float s, c; fsincos(ang, s, c); const float a = x0 * c - x1 * s, b = x0 * s + x1 * c; x0 = a; x1 = b; }
#define L2_10000 13.287712379549449f

__device__ __forceinline__ void transpose_item(const float* W, size_t ldw, int k0, int n0, bf16* WT, size_t ldt, int drow0, LAS float* scr, int lane) {
    float wv[32];
#pragma unroll
    for (int i = 0; i < 32; ++i) wv[i] = ((const GAS float*)W)[(size_t)(k0 + 2 * i + (lane >> 5)) * ldw + n0 + (lane & 31)];
#pragma unroll
    for (int i = 0; i < 32; ++i) scr[(2 * i + (lane >> 5)) * 33 + (lane & 31)] = wv[i];
    LDS_WAIT(); asm volatile("" ::: "memory");
    const int c = lane & 7;
#pragma unroll
    for (int j = 0; j < 4; ++j) { const int n = (lane >> 3) + 8 * j; const LAS float* s = scr + (8 * c) * 33 + n;
        v4u o; o.x = pk2(s[0 * 33], s[1 * 33]); o.y = pk2(s[2 * 33], s[3 * 33]); o.z = pk2(s[4 * 33], s[5 * 33]); o.w = pk2(s[6 * 33], s[7 * 33]);
        *(GAS v4u*)(WT + (size_t)(drow0 + n) * ldt + k0 + 8 * c) = o; }
    LDS_WAIT(); asm volatile("" ::: "memory");
}

#define XB_TMO      128
#define XB_XCNT(j)  (256  + 64 * (j))
#define XB_XSUB(j)  (1280 + 64 * (j))
#define XB_XGEN(j)  (2304 + 64 * (j))
#define XB_TOP      3328
#define XB_TOPGEN   3392
#define XCD_BAR_WORDS 3456
#define XB_SPIN_CAP (1u << 18)

__device__ __forceinline__ unsigned xb_ld(unsigned* p)              { return __hip_atomic_load(p, __ATOMIC_RELAXED, __HIP_MEMORY_SCOPE_AGENT); }
__device__ __forceinline__ unsigned xb_add(unsigned* p, unsigned v) { return __hip_atomic_fetch_add(p, v, __ATOMIC_RELAXED, __HIP_MEMORY_SCOPE_AGENT); }
__device__ __forceinline__ unsigned xb_xcc_id() { return (unsigned)__builtin_amdgcn_s_getreg((3 << 11) | 20) & 0xFu; }
#define XB_SPIN(cond, bar) do { unsigned _sp = 0; while (cond) { __builtin_amdgcn_s_sleep(1); \
    if ((++_sp & 255u) == 0u) { if (xb_ld(&(bar)[XB_TMO])) break; if (_sp > XB_SPIN_CAP) { atomicAdd(&(bar)[XB_TMO], 1u); break; } } } } while (0)

struct XcdBarrier {
    unsigned* bar; unsigned x;
    volatile LAS unsigned* st;
};

__device__ __forceinline__ XcdBarrier xcd_barrier_post(unsigned* bar, volatile LAS unsigned* st) {
    XcdBarrier b; b.bar = bar; b.x = xb_xcc_id(); b.st = st;
    if (threadIdx.x == 0) (void)xb_add(&bar[XB_XCNT(b.x)], 1u);
    return b;
}
__device__ __forceinline__ void xcd_barrier_complete(unsigned* bar, unsigned x, unsigned& nloc, unsigned& nx) {
    const unsigned G = gridDim.x * gridDim.y * gridDim.z;
    unsigned sum, cnt, mine, sp = 0u;
    for (;;) {
        sum = 0u; cnt = 0u; mine = 0u;
#pragma unroll
        for (unsigned j = 0; j < 16; ++j) { const unsigned c = xb_ld(&bar[XB_XCNT(j)]); sum += c; cnt += (c > 0u) ? 1u : 0u; mine = (j == x) ? c : mine; }
        if (sum == G) break;
        __builtin_amdgcn_s_sleep(1);
        if ((++sp & 255u) == 0u) { if (xb_ld(&bar[XB_TMO])) break; if (sp > XB_SPIN_CAP) { atomicAdd(&bar[XB_TMO], 1u); break; } }
    }
    nloc = mine > 0u ? mine : 1u; nx = cnt > 0u ? cnt : 1u;
}

__device__ __forceinline__ void xcd_barrier(const XcdBarrier& b) {
    asm volatile("s_waitcnt vmcnt(0)" ::: "memory");
    __syncthreads();
    if (threadIdx.x == 0) {
        unsigned* bar = b.bar;
        __builtin_amdgcn_s_waitcnt(0);
        unsigned nloc = b.st[0], nx = b.st[1];
        if (nloc == 0u) { xcd_barrier_complete(bar, b.x, nloc, nx); b.st[0] = nloc; b.st[1] = nx; }
        const unsigned old = xb_add(&bar[XB_XSUB(b.x)], 1u);
        const unsigned gen = old / nloc;
        if (old + 1u == (gen + 1u) * nloc) {
            __builtin_amdgcn_fence(__ATOMIC_RELEASE, "agent");
            asm volatile("s_waitcnt vmcnt(0)" ::: "memory");
            const unsigned og = xb_add(&bar[XB_TOP], 1u);
            const unsigned tg = og / nx;
            if (og + 1u == (tg + 1u) * nx) xb_add(&bar[XB_TOPGEN], 1u);
            else XB_SPIN(xb_ld(&bar[XB_TOPGEN]) == tg, bar);
            __builtin_amdgcn_fence(__ATOMIC_ACQUIRE, "agent");
            xb_add(&bar[XB_XGEN(b.x)], 1u);
            asm volatile("s_waitcnt vmcnt(0)" ::: "memory");
        } else {
            XB_SPIN(xb_ld(&bar[XB_XGEN(b.x)]) == gen, bar);
            __builtin_amdgcn_fence(__ATOMIC_ACQUIRE, "agent");
            asm volatile("s_waitcnt vmcnt(0)" ::: "memory");
        }
    }
    __syncthreads();
}


struct Args { const float* in[35]; float* out; unsigned char* ws; int ph_lo, ph_hi, li, pad; };

__device__ __forceinline__ void wconv_phase(const Args& a, int l, LAS unsigned char* lds, int gw, int NGW, int gt, int NGT, int wave, int lane) {
    LAS float* scr = (LAS float*)(lds + wave * 16384);
    unsigned char* ws = a.ws;
    bf16 *WIN = (bf16*)(ws + WS_WIN), *WG = (bf16*)(ws + WS_WG), *WUQ = (bf16*)(ws + WS_WUQ), *WKN = (bf16*)(ws + WS_WKN), *WVV = (bf16*)(ws + WS_WVV), *WB = (bf16*)(ws + WS_WB), *WO = (bf16*)(ws + WS_WO), *WUP = (bf16*)(ws + WS_WUP), *WDN = (bf16*)(ws + WS_WDN);
    constexpr int I1 = 16 * 189, I2 = 6 * 24, I3 = 4 * 32, I4 = 3 * 8 * 32, I5 = 16 * 32, I6 = 16 * 176, I7 = 44 * 32, NIT = I1 + I2 + I3 + I4 + I5 + I6 + I7;
    for (int it = gw; it < NIT; it += NGW) {
        int r = it;
        if (r < I1) { const int kb = r / 189, n0 = 32 * (r % 189); bf16* dst = WIN; int drow;
            if (n0 < 1152) drow = n0; else if (n0 < 1408) drow = n0 + 128; else if (n0 < 1440) drow = 1152 + (n0 - 1408); else if (n0 < 2976) drow = 1536 + (n0 - 1440); else { dst = WG; drow = n0 - 2976; }
            transpose_item(a.in[12] + (size_t)l * 1024 * 6048, 6048, 64 * kb, n0, dst, 1024, drow, scr, lane); continue; } r -= I1;
        if (r < I2) { const int kb = r / 24, n0 = 32 * (r % 24); transpose_item(a.in[17] + (size_t)l * 384 * 768, 768, 64 * kb, n0, WUQ, 384, n0, scr, lane); continue; } r -= I2;
        if (r < I3) { const int kb = r / 32, n0 = 32 * (r % 32); const int h = n0 >> 7, c0 = n0 & 127;
            transpose_item(a.in[18] + (size_t)l * 256 * 1024, 1024, 64 * kb, n0, (c0 < 64) ? WKN : WVV, 256, h * 64 + (c0 & 63), scr, lane); continue; } r -= I3;
        if (r < I4) { const int n = r / 256, q = r % 256, kb = q / 32, n0 = 32 * (q % 32);
            transpose_item(a.in[28] + ((size_t)l * 3 + n) * 512 * 1024, 1024, 64 * kb, n0, WB + (size_t)n * 1024 * 512, 512, n0, scr, lane); continue; } r -= I4;
        if (r < I5) { const int kb = r / 32, n0 = 32 * (r % 32); transpose_item(a.in[29] + (size_t)l * 1024 * 1024, 1024, 64 * kb, n0, WO, 1024, n0, scr, lane); continue; } r -= I5;
        if (r < I6) { const int kb = r / 176, n0 = 32 * (r % 176); transpose_item(a.in[30] + (size_t)l * 1024 * 5632, 5632, 64 * kb, n0, WUP, 1024, n0, scr, lane); continue; } r -= I6;
        { const int kb = r / 32, n0 = 32 * (r % 32); transpose_item(a.in[33] + (size_t)l * 2816 * 1024, 1024, 64 * kb, n0, WDN, 2816, n0, scr, lane); }
    }
    for (int i = gt; i < 96 * 1024 / 8; i += NGT) *(GAS v4u*)(WIN + (size_t)1184 * 1024 + (size_t)i * 8) = (v4u){0u, 0u, 0u, 0u};
}

__device__ __forceinline__ void norm_phase(const Args& a, int l, int which, bool first, int gw, int NGW, int lane) {
    const GAS float* mod = (const GAS float*)(a.ws + WS_MOD) + (size_t)l * 5 * 6144;
    GAS bf16* HBF = (GAS bf16*)(a.ws + WS_HBF);
    const GAS float* gv = (const GAS float*)((which == 0) ? a.in[10] + l * 1024 : (which == 1) ? a.in[11] + l * 1024 : a.in[34]);
    GAS float* outp = (GAS float*)a.out;
    const int shoff = (which == 0) ? 0 : 3072, scoff = shoff + 1024;
    #pragma unroll 1
    for (int row0 = gw; row0 < TT; row0 += 4 * NGW) {
        f32x4 v[4][4];
#pragma unroll
        for (int q = 0; q < 4; ++q) { const int row = row0 + q * NGW; const int rr = row < TT ? row : row0;
            const GAS float* src = first ? (const GAS float*)(rr < TCTX ? a.in[0] + (size_t)rr * DM : a.in[1] + (size_t)(rr - TCTX) * DM) : (const GAS float*)(outp + (size_t)rr * DM);
#pragma unroll
            for (int j = 0; j < 4; ++j) v[q][j] = *(const GAS f32x4*)(src + 4 * lane + 256 * j); }
#pragma unroll
        for (int q = 0; q < 4; ++q) { const int row = row0 + q * NGW; if (row >= TT) continue;
            float ss = 0.f;
#pragma unroll
            for (int j = 0; j < 4; ++j) ss += (v[q][j].x * v[q][j].x + v[q][j].y * v[q][j].y) + (v[q][j].z * v[q][j].z + v[q][j].w * v[q][j].w);
            if (first) {
#pragma unroll
                for (int j = 0; j < 4; ++j) *(GAS f32x4*)(outp + (size_t)row * DM + 4 * lane + 256 * j) = v[q][j]; }
            const float rs = rsqrtf(wave_sum(ss) * (1.f / DM) + EPSN);
            const int mrow = row < TCTX ? 0 : 1 + ((row - TCTX) >> 11);
            const GAS float* mp = mod + (size_t)mrow * 6144;
#pragma unroll
            for (int j = 0; j < 4; ++j) { const int col = 4 * lane + 256 * j; const f32x4 g = *(const GAS f32x4*)(gv + col);
                if (which == 2) { *(GAS f32x4*)(outp + (size_t)row * DM + col) = v[q][j] * rs * g; }
                else { const f32x4 sc = *(const GAS f32x4*)(mp + scoff + col), sh = *(const GAS f32x4*)(mp + shoff + col);
                    const f32x4 y = v[q][j] * rs * g * (sc + 1.f) + sh;
                    *(GAS v2u*)(HBF + (size_t)row * DM + col) = (v2u){pk2(y.x, y.y), pk2(y.z, y.w)}; } } }
    }
}
__device__ __forceinline__ void p0_mod_hid(const Args& a, LAS unsigned char* lds, int bid, int G, int tid, int gw, int NGW, int lane) {
    float* mod = (float*)(a.ws + WS_MOD);
    LAS float* sc = (LAS float*)lds;
    for (int it = bid; it < 384; it += G) {
        const int l = it / 192, rem = it % 192, kc = rem / 12, jb = rem % 12;
        if (tid < 320) { const int r = tid >> 6, kk = tid & 63, k = kc * 64 + kk; const float cv = (r == 0) ? a.in[7][k] : a.in[6][(r - 1) * 1024 + k]; sc[tid] = cv / (1.f + __expf(-cv)); }
        __syncthreads();
        const int j = jb * 512 + tid;
        const GAS float* wp = (const GAS float*)(a.in[8] + ((size_t)l * 1024 + kc * 64) * 6144 + j);
        float acc[5] = {0.f, 0.f, 0.f, 0.f, 0.f};
#pragma unroll 8
        for (int kk = 0; kk < 64; ++kk) { const float w = wp[(size_t)kk * 6144];
#pragma unroll
            for (int r = 0; r < 5; ++r) acc[r] += sc[r * 64 + kk] * w; }
        const float bias = (kc == 0) ? a.in[9][l * 6144 + j] : 0.f;
#pragma unroll
        for (int r = 0; r < 5; ++r) atomicAdd(mod + (size_t)(l * 5 + r) * 6144 + j, acc[r] + bias);
        __syncthreads();
    }
    float* HID = (float*)(a.ws + WS_HID);
    for (int it = gw; it < 2 * 2304; it += NGW) {
        const int l = it / 2304, q = it % 2304; const int L = q < 256 ? 256 : 2048, t = q < 256 ? q : q - 256;
        const float tn = (float)t / (float)(L - 1);
        float zi = 0.f;
        if (lane == 0) zi = tn;
        else if (lane <= 16) { const int bi = (lane - 1) & 7; const float band = 1e-4f + (float)bi * ((7.f - 1e-4f) / 7.f); const float ang = (6.283185307179586f / (float)L) * (float)t * band; float s, c; fsincos(ang, s, c); zi = (lane <= 8) ? c : -s; }
        float s1 = a.in[22][l * 64 + lane];
#pragma unroll
        for (int i = 0; i < 17; ++i) s1 += __shfl(zi, i) * a.in[21][(l * 17 + i) * 64 + lane];
        const float h1 = fsin(a.in[26][(l * 2 + 0) * 64 + lane] * s1);
        float s2 = a.in[24][l * 64 + lane];
#pragma unroll 8
        for (int i = 0; i < 64; ++i) s2 += __shfl(h1, i) * a.in[23][(l * 64 + i) * 64 + lane];
        HID[(size_t)it * 64 + lane] = fsin(a.in[26][(l * 2 + 1) * 64 + lane] * s2);
    }
}

__device__ __forceinline__ void post_phase(const Args& a, int l, LAS unsigned char* lds, int bid, int G, int tid, int gw, int NGW, int gt, int NGT, int lane) {
    unsigned char* ws = a.ws;
    GAS bf16 *QA = (GAS bf16*)(ws + WS_QA), *KVR = (GAS bf16*)(ws + WS_KVR), *CQ = (GAS bf16*)(ws + WS_CQ), *CKVR = (GAS bf16*)(ws + WS_CKVR), *HYR = (GAS bf16*)(ws + WS_HYR);
    GAS bf16 *UT = (GAS bf16*)(ws + WS_UT), *CKVALL = (GAS bf16*)(ws + WS_CKVALL), *KPEALL = (GAS bf16*)(ws + WS_KPEALL), *KA = (GAS bf16*)(ws + WS_KA), *VTA = (GAS bf16*)(ws + WS_VTA);
    GAS float* outp = (GAS float*)a.out;
    for (int i = gt; i < 4 * 256 * 128; i += NGT) { const int b = i >> 15, p = (i >> 7) & 255, kvh = (i >> 6) & 1, d = i & 63;
        const size_t s = ((size_t)(b * 2 + l) * 256 + p) * 128 + kvh * 64 + d;
        KA[KA_LAT + ((b * 2 + kvh) * 2304 + p) * 64 + d] = (bf16)f2bf(a.in[2][s]);
        VTA[KA_LAT + ((b * 2 + kvh) * 64 + d) * 2304 + p] = (bf16)f2bf(a.in[3][s]); }
    for (int i = gt; i < 4 * 256 * 256; i += NGT) { const int b = i >> 16, p = (i >> 8) & 255, j = i & 255;
        CKVALL[(size_t)(TCTX + b * 2304 + p) * 256 + j] = (bf16)f2bf(a.in[4][((size_t)(b * 2 + l) * 256 + p) * 256 + j]); }
    for (int i = gt; i < 4 * 256 * 32; i += NGT) { const int b = i >> 13, p = (i >> 5) & 255, j = i & 31;
        KPEALL[(size_t)(TCTX + b * 2304 + p) * 32 + j] = (bf16)f2bf(a.in[5][((size_t)(b * 2 + l) * 256 + p) * 32 + j]); }
    const GAS float *gq = (const GAS float*)(a.in[13] + l * 64), *gk = (const GAS float*)(a.in[14] + l * 64), *gcq = (const GAS float*)(a.in[15] + l * 384), *gkv = (const GAS float*)(a.in[16] + l * 256);
    for (int row = gw; row < TT; row += NGW) {
        const bool lat = row >= TCTX;
        const int b = lat ? (row - TCTX) >> 11 : row >> 8, t = lat ? (row - TCTX) & 2047 : row & 255;
        const float grow = (float)(t >> 6), gcol = (float)(t & 63);
        const int keyrow = lat ? TCTX + b * 2304 + 256 + t : row;
        { v4u w = *(const GAS v4u*)(QA + (size_t)row * 512 + 8 * lane);
          float x[8] = {bflo(w.x), bfhi(w.x), bflo(w.y), bfhi(w.y), bflo(w.z), bfhi(w.z), bflo(w.w), bfhi(w.w)};
          float ss = 0.f;
#pragma unroll
          for (int j = 0; j < 8; ++j) ss += x[j] * x[j];
          ss += __shfl_xor(ss, 1); ss += __shfl_xor(ss, 2); ss += __shfl_xor(ss, 4);
          const float rs = rsqrtf(ss * (1.f / 64.f) + EPSN); const int d0 = 8 * (lane & 7);
#pragma unroll
          for (int j = 0; j < 8; ++j) x[j] = x[j] * rs * gq[d0 + j];
          if (lat) {
#pragma unroll
              for (int k = 0; k < 4; ++k) { const int i = 4 * (lane & 7) + k; const float inv = __builtin_amdgcn_exp2f(-(float)(i & 15) * (L2_10000 / 16.f)); rope2(x[2 * k], x[2 * k + 1], (i < 16 ? grow : gcol) * inv); } }
          *(GAS v4u*)(QA + (size_t)row * 512 + 8 * lane) = (v4u){pk2(x[0], x[1]), pk2(x[2], x[3]), pk2(x[4], x[5]), pk2(x[6], x[7])}; }
        { const v2u w = *(const GAS v2u*)(KVR + (size_t)row * 256 + 4 * lane);
          float x[4] = {bflo(w.x), bfhi(w.x), bflo(w.y), bfhi(w.y)};
          float ss = (x[0] * x[0] + x[1] * x[1]) + (x[2] * x[2] + x[3] * x[3]);
          ss += __shfl_xor(ss, 1); ss += __shfl_xor(ss, 2); ss += __shfl_xor(ss, 4); ss += __shfl_xor(ss, 8);
          const int kvh = (lane >> 4) & 1, d0 = 4 * (lane & 15);
          if (lane < 32) {
              const float rs = rsqrtf(ss * (1.f / 64.f) + EPSN);
#pragma unroll
              for (int j = 0; j < 4; ++j) x[j] = x[j] * rs * gk[d0 + j];
              if (!lat) { *(GAS f32x4*)(outp + OUT_K + ((size_t)(b * 2 + l) * 256 + t) * 128 + kvh * 64 + d0) = (f32x4){x[0], x[1], x[2], x[3]};
                  *(GAS v2u*)(KA + ((size_t)(b * 2 + kvh) * 256 + t) * 64 + d0) = (v2u){pk2(x[0], x[1]), pk2(x[2], x[3])}; }
              else {
#pragma unroll
                  for (int k = 0; k < 2; ++k) { const int i = 2 * (lane & 15) + k; const float inv = __builtin_amdgcn_exp2f(-(float)(i & 15) * (L2_10000 / 16.f)); rope2(x[2 * k], x[2 * k + 1], (i < 16 ? grow : gcol) * inv); }
                  *(GAS v2u*)(KA + KA_LAT + ((size_t)(b * 2 + kvh) * 2304 + 256 + t) * 64 + d0) = (v2u){pk2(x[0], x[1]), pk2(x[2], x[3])}; }
          } else {
              if (!lat) { *(GAS f32x4*)(outp + OUT_V + ((size_t)(b * 2 + l) * 256 + t) * 128 + kvh * 64 + d0) = (f32x4){x[0], x[1], x[2], x[3]};
#pragma unroll
                  for (int j = 0; j < 4; ++j) VTA[((size_t)(b * 2 + kvh) * 64 + d0 + j) * 256 + t] = (bf16)f2bf(x[j]); }
              else {
#pragma unroll
                  for (int j = 0; j < 4; ++j) VTA[KA_LAT + ((size_t)(b * 2 + kvh) * 64 + d0 + j) * 2304 + 256 + t] = (bf16)f2bf(x[j]); }
          } }
        { GAS unsigned* p = (GAS unsigned*)(CQ + (size_t)row * 512 + 6 * lane);
          const unsigned w0 = p[0], w1 = p[1], w2 = p[2];
          float x[6] = {bflo(w0), bfhi(w0), bflo(w1), bfhi(w1), bflo(w2), bfhi(w2)};
          float ss = 0.f;
#pragma unroll
          for (int j = 0; j < 6; ++j) ss += x[j] * x[j];
          const float rs = rsqrtf(wave_sum(ss) * (1.f / 384.f) + EPSN);
#pragma unroll
          for (int j = 0; j < 6; ++j) x[j] = x[j] * rs * gcq[6 * lane + j];
          p[0] = pk2(x[0], x[1]); p[1] = pk2(x[2], x[3]); p[2] = pk2(x[4], x[5]);
          if (lane < 16) { const unsigned w = *(const GAS unsigned*)(CQ + (size_t)row * 512 + 384 + 2 * lane); float y0 = bflo(w), y1 = bfhi(w);
              if (!lat) { outp[OUT_KPE + ((size_t)(b * 2 + l) * 256 + t) * 32 + 2 * lane] = y0; outp[OUT_KPE + ((size_t)(b * 2 + l) * 256 + t) * 32 + 2 * lane + 1] = y1; }
              else { const float inv = __builtin_amdgcn_exp2f(-(float)(lane & 7) * (L2_10000 / 8.f)); rope2(y0, y1, (lane < 8 ? grow : gcol) * inv); }
              *(GAS unsigned*)(KPEALL + (size_t)keyrow * 32 + 2 * lane) = pk2(y0, y1); } }
        { const v2u w = *(const GAS v2u*)(CKVR + (size_t)row * 256 + 4 * lane);
          float x[4] = {bflo(w.x), bfhi(w.x), bflo(w.y), bfhi(w.y)};
          const float ss = (x[0] * x[0] + x[1] * x[1]) + (x[2] * x[2] + x[3] * x[3]);
          const float rs = rsqrtf(wave_sum(ss) * (1.f / 256.f) + EPSN);
#pragma unroll
          for (int j = 0; j < 4; ++j) x[j] = x[j] * rs * gkv[4 * lane + j];
          if (!lat) *(GAS f32x4*)(outp + OUT_CKV + ((size_t)(b * 2 + l) * 256 + t) * 256 + 4 * lane) = (f32x4){x[0], x[1], x[2], x[3]};
          *(GAS v2u*)(CKVALL + (size_t)keyrow * 256 + 4 * lane) = (v2u){pk2(x[0], x[1]), pk2(x[2], x[3])}; }
    }
    LAS float* tile = (LAS float*)lds;
    const GAS float *sw = (const GAS float*)(a.in[19] + (size_t)l * 3 * 1536), *sb = (const GAS float*)(a.in[20] + (size_t)l * 1536);
    for (int it = bid; it < 96 * 12; it += G) {
        const int tb = it / 12, cb = it % 12, row0 = tb * 128;
        const bool lat = row0 >= TCTX; const int L = lat ? 2048 : 256;
        const int b = lat ? (row0 - TCTX) >> 11 : row0 >> 8, t0 = lat ? (row0 - TCTX) & 2047 : row0 & 255;
        v4u w[4], wh = (v4u){0u, 0u, 0u, 0u};
        { const int rr = tid >> 4, c8 = tid & 15;
#pragma unroll
          for (int q = 0; q < 4; ++q) w[q] = *(const GAS v4u*)(HYR + (size_t)(row0 + rr + 32 * q) * 1536 + cb * 128 + 8 * c8);
          if (tid < 32) { const int which = tid >> 4; const bool ok = which ? (t0 + 128 < L) : (t0 > 0); const int rsrc = which ? row0 + 128 : row0 - 1;
              if (ok) wh = *(const GAS v4u*)(HYR + (size_t)rsrc * 1536 + cb * 128 + 8 * c8); }
#pragma unroll
          for (int q = 0; q < 4; ++q) { LAS float* tp = tile + (rr + 32 * q + 1) * 129 + 8 * c8;
              tp[0] = bflo(w[q].x); tp[1] = bfhi(w[q].x); tp[2] = bflo(w[q].y); tp[3] = bfhi(w[q].y); tp[4] = bflo(w[q].z); tp[5] = bfhi(w[q].z); tp[6] = bflo(w[q].w); tp[7] = bfhi(w[q].w); }
          if (tid < 32) { LAS float* tp = tile + ((tid >> 4) ? 129 : 0) * 129 + 8 * c8;
              tp[0] = bflo(wh.x); tp[1] = bfhi(wh.x); tp[2] = bflo(wh.y); tp[3] = bfhi(wh.y); tp[4] = bflo(wh.z); tp[5] = bfhi(wh.z); tp[6] = bflo(wh.w); tp[7] = bfhi(wh.w); } }
        __syncthreads();
        { const int c = tid >> 2, tc = tid & 3, cg_ = cb * 128 + c; const float w0 = sw[cg_], w1 = sw[1536 + cg_], w2 = sw[3072 + cg_], bb = sb[cg_];
          const size_t base = lat ? (size_t)UT_LAT + ((size_t)b * 1536 + cg_) * 2048 : ((size_t)b * 1536 + cg_) * 256;
#pragma unroll
          for (int q = 0; q < 4; ++q) { float u[8];
#pragma unroll
              for (int k = 0; k < 8; ++k) { const int tr = 32 * tc + 8 * q + k; u[k] = w0 * tile[tr * 129 + c] + w1 * tile[(tr + 1) * 129 + c] + w2 * tile[(tr + 2) * 129 + c] + bb; }
              *(GAS v4u*)(UT + base + t0 + 32 * tc + 8 * q) = (v4u){pk2(u[0], u[1]), pk2(u[2], u[3]), pk2(u[4], u[5]), pk2(u[6], u[7])}; } }
        __syncthreads();
    }
}

__device__ __forceinline__ void ffnconv_phase(const Args& a, int l, int gt, int NGT) {
    const GAS bf16* U = (const GAS bf16*)(a.ws + WS_U); GAS bf16* ACT = (GAS bf16*)(a.ws + WS_ACT);
    const GAS float *cw = (const GAS float*)(a.in[31] + (size_t)l * 3 * 5632), *cb = (const GAS float*)(a.in[32] + (size_t)l * 5632);
#pragma unroll 1
    for (int idx = gt; idx < 1536 * 352; idx += NGT) {
        const int tb = idx / 352, ch = idx % 352, row0 = tb * 8, c0 = ch * 8;
        const bool lat = row0 >= TCTX; const int t0 = lat ? (row0 - TCTX) & 2047 : row0 & 255, L = lat ? 2048 : 256;
        v4u ra[10], rg[10];
#pragma unroll
        for (int i = 0; i < 10; ++i) { const int t = t0 + i - 1; const bool ok = (t >= 0) && (t < L); const size_t rr = (size_t)(row0 + (ok ? i - 1 : 0)) * 5632 + c0;
            ra[i] = *(const GAS v4u*)(U + rr); rg[i] = *(const GAS v4u*)(U + rr + 2816);
            if (!ok) { ra[i] = (v4u){0u, 0u, 0u, 0u}; rg[i] = (v4u){0u, 0u, 0u, 0u}; } }
        float wa[3][8], wg[3][8], ba[8], bg[8];
#pragma unroll
        for (int j = 0; j < 8; ++j) { ba[j] = cb[c0 + j]; bg[j] = cb[2816 + c0 + j];
#pragma unroll
            for (int k = 0; k < 3; ++k) { wa[k][j] = cw[k * 5632 + c0 + j]; wg[k][j] = cw[k * 5632 + 2816 + c0 + j]; } }
#pragma unroll
        for (int i = 0; i < 8; ++i) {
            float o[8];
#pragma unroll
            for (int j2 = 0; j2 < 4; ++j2) {
                const unsigned a0 = ra[i][j2], a1 = ra[i + 1][j2], a2 = ra[i + 2][j2], g0 = rg[i][j2], g1 = rg[i + 1][j2], g2 = rg[i + 2][j2];
                { const int j = 2 * j2; const float av = wa[0][j] * bflo(a0) + wa[1][j] * bflo(a1) + wa[2][j] * bflo(a2) + ba[j], gv = wg[0][j] * bflo(g0) + wg[1][j] * bflo(g1) + wg[2][j] * bflo(g2) + bg[j]; o[j] = gv * __builtin_amdgcn_rcpf(1.f + __expf(-gv)) * av; }
                { const int j = 2 * j2 + 1; const float av = wa[0][j] * bfhi(a0) + wa[1][j] * bfhi(a1) + wa[2][j] * bfhi(a2) + ba[j], gv = wg[0][j] * bfhi(g0) + wg[1][j] * bfhi(g1) + wg[2][j] * bfhi(g2) + bg[j]; o[j] = gv * __builtin_amdgcn_rcpf(1.f + __expf(-gv)) * av; } }
            *(GAS v4u*)(ACT + (size_t)(row0 + i) * 2816 + c0) = (v4u){pk2(o[0], o[1]), pk2(o[2], o[3]), pk2(o[4], o[5]), pk2(o[6], o[7])};
        }
    }
}
typedef float f32x2_t __attribute__((ext_vector_type(2)));
typedef __bf16 bf16x2_t __attribute__((ext_vector_type(2)));
__device__ __forceinline__ unsigned cvtpk(float lo, float hi) { const f32x2_t v = {lo, hi}; const bf16x2_t b = __builtin_convertvector(v, bf16x2_t); return __builtin_bit_cast(unsigned, b); }
template <int DK>
__device__ __forceinline__ void attn_unit(LAS unsigned char* lds, int tid, const bf16* Qp, int qpitch, const bf16* Kp, int kpitch, const bf16* Kpe, const bf16* Vt, size_t vpitch,
                                          int nkeys, bf16* Op, int opitch, float sl2, bool rope, int pos0) {
    constexpr int NS = DK / 16;
    asm volatile("" : "+v"(tid));
    const int lane = tid & 63, wave = tid >> 6, r = lane & 31, h = lane >> 5;
    bf16x8 qf[NS];
    { const bf16* qrow = Qp + (size_t)(wave * 32 + r) * qpitch;
#pragma unroll
      for (int s = 0; s < NS; ++s) qf[s] = *(const GAS bf16x8*)(qrow + 16 * s + 8 * h);
      if (DK == 96 && rope) { const int t = pos0 + wave * 32 + r; const float grow = (float)(t >> 6), gcol = (float)(t & 63);
#pragma unroll
          for (int sp = 0; sp < 2; ++sp) { bf16x8 v = qf[NS - 2 + sp];
#pragma unroll
              for (int k = 0; k < 4; ++k) { float x0 = bf1((bf16)v[2 * k]), x1 = bf1((bf16)v[2 * k + 1]);
                  const float inv = __builtin_amdgcn_exp2f(-(float)(4 * h + k) * (L2_10000 / 8.f)); rope2(x0, x1, (sp == 0 ? grow : gcol) * inv);
                  v[2 * k] = (short)f2bf(x0); v[2 * k + 1] = (short)f2bf(x1); }
              qf[NS - 2 + sp] = v; } } }
    const int kkey = tid >> 3, kch = tid & 7, pkey = tid >> 2, pch = tid & 3;
    f32x16 o0, o1;
#pragma unroll
    for (int i = 0; i < 16; ++i) { o0[i] = 0.f; o1[i] = 0.f; }
    float mrun = -__builtin_inff(), lrun = 0.f;
    v4u rk, rv, rp = (v4u){0u, 0u, 0u, 0u};
    const int ntile = nkeys >> 6;
#define ATT_LOAD(kt) do { const int key0 = (kt) * 64; rk = *(const GAS v4u*)(Kp + (size_t)(key0 + kkey) * kpitch + 8 * kch); rv = *(const GAS v4u*)(Vt + (size_t)kkey * vpitch + key0 + 8 * kch); \
        if (DK == 96 && tid < 256) rp = *(const GAS v4u*)(Kpe + (size_t)(key0 + pkey) * 32 + 8 * pch); } while (0)
#define ATT_WRITE(buf) do { *(LAS v4u*)(lds + (buf) * 13312 + kkey * 208 + kch * 16) = rk; \
        { LAS unsigned char* vw = lds + 26624 + (buf) * 9216 + kkey * 144 + (kch >> 1) * 32 + (kch & 1) * 8; *(LAS v2u*)vw = (v2u){rv.x, rv.y}; *(LAS v2u*)(vw + 16) = (v2u){rv.z, rv.w}; } \
        if (DK == 96 && tid < 256) *(LAS v4u*)(lds + (buf) * 13312 + pkey * 208 + 128 + pch * 16) = rp; } while (0)
    ATT_LOAD(0); ATT_WRITE(0); __syncthreads();
    for (int kt = 0; kt < ntile; ++kt) {
        const int buf = kt & 1;
        if (kt + 1 < ntile) ATT_LOAD(kt + 1);
        const LAS unsigned char* kb = lds + buf * 13312; const LAS unsigned char* vb = lds + 26624 + buf * 9216;
        f32x16 s0, s1;
#pragma unroll
        for (int i = 0; i < 16; ++i) { s0[i] = 0.f; s1[i] = 0.f; }
#pragma unroll
        for (int s = 0; s < NS; ++s) {
            const bf16x8 a0 = *(const LAS bf16x8*)(kb + r * 208 + (16 * s + 8 * h) * 2), a1 = *(const LAS bf16x8*)(kb + (32 + r) * 208 + (16 * s + 8 * h) * 2);
            s0 = __builtin_amdgcn_mfma_f32_32x32x16_bf16(a0, qf[s], s0, 0, 0, 0); s1 = __builtin_amdgcn_mfma_f32_32x32x16_bf16(a1, qf[s], s1, 0, 0, 0); }
        float mx = s0[0];
#pragma unroll
        for (int i = 1; i < 16; ++i) mx = fmaxf(mx, s0[i]);
#pragma unroll
        for (int i = 0; i < 16; ++i) mx = fmaxf(mx, s1[i]);
        mx = fmaxf(mx, __shfl_xor(mx, 32));
        const float mnew = fmaxf(mrun, mx), alpha = __builtin_amdgcn_exp2f((mrun - mnew) * sl2), nm = mnew * sl2;
        float sum = 0.f;
#pragma unroll
        for (int i = 0; i < 16; ++i) { s0[i] = __builtin_amdgcn_exp2f(s0[i] * sl2 - nm); s1[i] = __builtin_amdgcn_exp2f(s1[i] * sl2 - nm); sum += s0[i] + s1[i]; }
        lrun = lrun * alpha + sum; mrun = mnew;
#pragma unroll
        for (int i = 0; i < 16; ++i) { o0[i] *= alpha; o1[i] *= alpha; }
#pragma unroll
        for (int sub = 0; sub < 2; ++sub) {
#pragma unroll
            for (int s2 = 0; s2 < 2; ++s2) {
                const v4u pw = (sub == 0) ? (v4u){cvtpk(s0[8 * s2], s0[8 * s2 + 1]), cvtpk(s0[8 * s2 + 2], s0[8 * s2 + 3]), cvtpk(s0[8 * s2 + 4], s0[8 * s2 + 5]), cvtpk(s0[8 * s2 + 6], s0[8 * s2 + 7])}
                                          : (v4u){cvtpk(s1[8 * s2], s1[8 * s2 + 1]), cvtpk(s1[8 * s2 + 2], s1[8 * s2 + 3]), cvtpk(s1[8 * s2 + 4], s1[8 * s2 + 5]), cvtpk(s1[8 * s2 + 6], s1[8 * s2 + 7])};
                const bf16x8 pb = __builtin_bit_cast(bf16x8, pw);
                const int kofs = (32 * sub + 16 * s2 + 8 * h) * 2;
#pragma unroll
                for (int slab = 0; slab < 2; ++slab) {
                    const bf16x8 va = *(const LAS bf16x8*)(vb + (32 * slab + r) * 144 + kofs);
                    if (slab == 0) o0 = __builtin_amdgcn_mfma_f32_32x32x16_bf16(va, pb, o0, 0, 0, 0); else o1 = __builtin_amdgcn_mfma_f32_32x32x16_bf16(va, pb, o1, 0, 0, 0); } } }
        if (kt + 1 < ntile) ATT_WRITE(buf ^ 1);
        __syncthreads();
    }
#undef ATT_LOAD
#undef ATT_WRITE
    const float ltot = lrun + __shfl_xor(lrun, 32), inv = 1.f / ltot;
    bf16* orow = Op + (size_t)(wave * 32 + r) * opitch;
#pragma unroll
    for (int g4 = 0; g4 < 4; ++g4) {
        *(GAS v2u*)(orow + 8 * g4 + 4 * h) = (v2u){pk2(o0[4 * g4] * inv, o0[4 * g4 + 1] * inv), pk2(o0[4 * g4 + 2] * inv, o0[4 * g4 + 3] * inv)};
        *(GAS v2u*)(orow + 32 + 8 * g4 + 4 * h) = (v2u){pk2(o1[4 * g4] * inv, o1[4 * g4 + 1] * inv), pk2(o1[4 * g4 + 2] * inv, o1[4 * g4 + 3] * inv)}; }
}

template <bool LAT>
__device__ __forceinline__ void hyena_unit(const Args& a, int l, int c, LAS unsigned char* lds, int tid) {
    constexpr int L = LAT ? 2048 : 256, NB = LAT ? 4 : 16, NE = L / 16, NCH = L / 4, NW = LAT ? 8 : 4, ASH = LAT ? 2 : 4, MG = LAT ? 224 : 32  , UP = L + 2 * MG + 8  , GS = 514  ;
    asm volatile("" : "+v"(tid));
    const int lane = tid & 63, wave = tid >> 6, r = lane & 31, h = lane >> 5;
    const bf16* UT = (const bf16*)(a.ws + WS_UT) + (LAT ? UT_LAT : 0);
    GAS bf16* OC = (GAS bf16*)(a.ws + WS_OC);
    const float* HID = (const float*)(a.ws + WS_HID) + ((size_t)l * 2304 + (LAT ? 256 : 0)) * 64;
    LAS bf16* U = (LAS bf16*)lds; LAS bf16* X = (LAS bf16*)(lds + 20096); LAS float* FT = (LAS float*)(lds + 36480); LAS unsigned char* GC = lds + 69248;
    LAS float* W3 = (LAS float*)(lds + 135040); LAS float* RED = (LAS float*)(lds + 136064);
    for (int q = tid; q < NB * L / 8; q += 512) { const int b = q / (L / 8), off = (q % (L / 8)) * 8;
        *(LAS v4u*)(U + b * UP + MG + off) = *(const GAS v4u*)(UT + ((size_t)b * 1536 + c) * L + off);
        *(LAS v4u*)(X + b * L + off) = *(const GAS v4u*)(UT + ((size_t)b * 1536 + 512 + c) * L + off); }
    for (int q = tid; q < NB * 2 * MG / 8; q += 512) { const int b = q / (2 * MG / 8), o = q % (2 * MG / 8); const int off = (o < MG / 8) ? 8 * o : MG + L + 8 * (o - MG / 8);
        *(LAS v4u*)(U + b * UP + off) = (v4u){0u, 0u, 0u, 0u}; }
    if (tid < 256) { const int j = tid >> 2, k = tid & 3; W3[k * 64 + j] = a.in[25][((size_t)l * 64 + j) * 2048 + (k >> 1) * 1024 + (k & 1) * 512 + c]; }
    __syncthreads();
#if defined(PROBE_HY) && PROBE_HY == 1
    for (int rep = 0; rep < 2; ++rep)
#endif
    { const float dmin = -15.350567286626973f, dmax = -3.0701134573253945f;
      const float delta = fabsf(dmin + (float)c * ((dmax - dmin) / 511.f));
      float p0 = 0.f, p1 = 0.f;
      for (int t = tid; t < L; t += 512) {
          float s[4] = {0.f, 0.f, 0.f, 0.f};
#pragma unroll 4
          for (int j4 = 0; j4 < 16; ++j4) { const f32x4 hv = *(const GAS f32x4*)(HID + (size_t)t * 64 + 4 * j4);
#pragma unroll
              for (int k = 0; k < 4; ++k) s[k] += hv.x * W3[k * 64 + 4 * j4] + hv.y * W3[k * 64 + 4 * j4 + 1] + hv.z * W3[k * 64 + 4 * j4 + 2] + hv.w * W3[k * 64 + 4 * j4 + 3]; }
          const float win = __expf(-((float)t / (float)(L - 1)) * delta);
#pragma unroll
          for (int k = 0; k < 4; ++k) { s[k] *= win; FT[k * L + t] = s[k]; }
          p0 += fabsf(s[0]) + (t >= 1 ? fabsf(s[2]) : 0.f); p1 += fabsf(s[1]) + (t >= 1 ? fabsf(s[3]) : 0.f); }
      p0 = wave_sum(p0); p1 = wave_sum(p1);
      if (lane == 0) { RED[2 * wave] = p0; RED[2 * wave + 1] = p1; } }
    __syncthreads();
    const int col = 32 * wave + r, ca = col >> ASH, cbat = col & (NB - 1);
    const int a_lo = (32 * wave) >> ASH, a_hi = (32 * wave + 31) >> ASH;
    const int rowbase = LAT ? TCTX + cbat * 2048 : cbat * 256;
#pragma unroll 1
    for (int n = 0; n < 2; ++n) {
        float l1s = 0.f;
#pragma unroll
        for (int w = 0; w < 8; ++w) l1s += RED[2 * w + n];
        const float invl1 = 1.f / (l1s + EPSN);
#if defined(PROBE_HY) && PROBE_HY == 4
        for (int rep = 0; rep < 2; ++rep)
#endif
        for (int q = tid; q < 8 * NCH; q += 512) { const int k = q & 7, y = q >> 3, m0 = L - (8 * y + k);
            float v[8];
#pragma unroll
            for (int j = 0; j < 8; ++j) { const int m = m0 - j; float t = 0.f; if (m >= 0 && m < L) t = FT[n * L + m]; else if (m < 0 && m > -L) t = FT[(2 + n) * L - m]; v[j] = t * invl1; }
            *(LAS v4u*)(GC + (k * GS + y) * 16) = (v4u){cvtpk(v[0], v[1]), cvtpk(v[2], v[3]), cvtpk(v[4], v[5]), cvtpk(v[6], v[7])}; }
        __syncthreads();
        f32x16 acc, acc1;
#if defined(PROBE_HY) && PROBE_HY == 3
        for (int rep = 0; rep < 2; ++rep) {
#endif
#pragma unroll
        for (int i = 0; i < 16; ++i) { acc[i] = 0.f; acc1[i] = 0.f; }
        if (wave < NW) {
            const int lam_lo = 2 * a_lo - (NE - 1), lam_hi = 2 * a_hi;
            const int xs0 = 8 * h - r + L;
            const LAS unsigned char* ap = GC + ((xs0 & 7) * GS + (xs0 >> 3) - 2 * lam_lo) * 16;
            const LAS unsigned char* bp = (const LAS unsigned char*)(U + cbat * UP + MG + 8 * h) + 32 * (2 * ca - lam_lo);
            bf16x8 a0 = *(const LAS bf16x8*)ap, b0 = *(const LAS bf16x8*)bp, a1 = *(const LAS bf16x8*)(ap - 32), b1 = *(const LAS bf16x8*)(bp - 32);
            for (int lam = lam_lo; lam <= lam_hi; lam += 2) {
                const bool more = lam + 2 <= lam_hi;
                if (more) { ap -= 64; bp -= 64; }
                const bf16x8 na0 = *(const LAS bf16x8*)ap, na1 = *(const LAS bf16x8*)(ap - 32), nb0 = *(const LAS bf16x8*)bp, nb1 = *(const LAS bf16x8*)(bp - 32);
                acc = __builtin_amdgcn_mfma_f32_32x32x16_bf16(a0, b0, acc, 0, 0, 0);
                acc1 = __builtin_amdgcn_mfma_f32_32x32x16_bf16(a1, b1, acc1, 0, 0, 0);
                a0 = na0; a1 = na1; b0 = nb0; b1 = nb1;
            }
#pragma unroll
            for (int i = 0; i < 16; ++i) acc[i] += acc1[i];
        }
#if defined(PROBE_HY) && PROBE_HY == 3
        asm volatile("" :: "v"(acc[0]), "v"(acc[5]));
        }
#endif
        const float bias = a.in[27][((size_t)l * 2 + n) * 512 + c];
        float z[16];
        if (wave < NW) {
#pragma unroll
            for (int g4 = 0; g4 < 4; ++g4) { const int t0 = 32 * ca + 8 * g4 + 4 * h;
                const v2u uw = *(const LAS v2u*)(U + cbat * UP + MG + t0), xw = *(const LAS v2u*)(X + cbat * L + t0);
                const float uv[4] = {bflo(uw.x), bfhi(uw.x), bflo(uw.y), bfhi(uw.y)}, xv[4] = {bflo(xw.x), bfhi(xw.x), bflo(xw.y), bfhi(xw.y)};
#pragma unroll
                for (int k = 0; k < 4; ++k) z[4 * g4 + k] = xv[k] * (acc[4 * g4 + k] + bias * uv[k]); }
        }
        __syncthreads();
        if (n == 0) {
            if (wave < NW) {
#pragma unroll
                for (int g4 = 0; g4 < 4; ++g4) *(LAS v2u*)(U + cbat * UP + MG + 32 * ca + 8 * g4 + 4 * h) = (v2u){pk2(z[4 * g4], z[4 * g4 + 1]), pk2(z[4 * g4 + 2], z[4 * g4 + 3])}; }
            for (int q = tid; q < NB * L / 8; q += 512) { const int b = q / (L / 8), off = (q % (L / 8)) * 8;
                *(LAS v4u*)(X + b * L + off) = *(const GAS v4u*)(UT + ((size_t)b * 1536 + 1024 + c) * L + off); }
        } else if (wave < NW) {
#if defined(PROBE_HY) && PROBE_HY == 2
            for (int rep = 0; rep < 2; ++rep)
#endif
#pragma unroll
            for (int g4 = 0; g4 < 4; ++g4)
#pragma unroll
                for (int k = 0; k < 4; ++k) OC[(size_t)(rowbase + 32 * ca + 8 * g4 + 4 * h + k) * 512 + c] = (bf16)f2bf(z[4 * g4 + k]);
        }
    }
    __syncthreads();
}
#ifndef PHMASK
#define PHMASK 0x1fff
#endif
#define PH_ON(k) (((PHMASK) >> (k)) & 1)
#define L1_INV() do { asm volatile("s_waitcnt vmcnt(0)" ::: "memory"); __builtin_amdgcn_fence(__ATOMIC_ACQUIRE, "agent"); asm volatile("s_waitcnt vmcnt(0)" ::: "memory"); __syncthreads(); } while (0)
template <class T> __device__ __forceinline__ T* asglobal(T* p) { return (T*)(GAS T*)p; }
__global__ void __launch_bounds__(512, 2) mega_fwd(Args a) {
    extern __shared__ __attribute__((aligned(16))) unsigned char lds_raw[];
    LAS unsigned char* lds = (LAS unsigned char*)lds_raw;
    cg::grid_group grid = cg::this_grid();
    const int bid = blockIdx.x;
    using pg8::Gemm; using pg8::StaticOrder;
    const int ph_lo = a.ph_lo, ph_hi = a.ph_hi;
    volatile LAS unsigned* MISC = (volatile LAS unsigned*)(lds + LDS_BYTES - 64);
    if (threadIdx.x < 16) MISC[threadIdx.x] = 0u;
    __syncthreads();
    if (ph_hi > NPHASE) { __syncthreads(); grid.sync(); }
    XcdBarrier bar = xcd_barrier_post((unsigned*)(a.ws + WS_BAR + (size_t)a.li * BAR_REGION), MISC);
#pragma unroll 1
    for (int ph = ph_lo; ph < ph_hi; ++ph) {
        int tid = threadIdx.x; asm volatile("" : "+v"(tid));
        int G = gridDim.x; asm volatile("" : "+s"(G)); const int NGW = G * 8, NGT = G * 512;
        unsigned char* ws = a.ws; asm volatile("" : "+s"(ws));
#if defined(__HIP_DEVICE_COMPILE__)
#define ASSUME_GLOBAL(p) __builtin_assume(!__builtin_amdgcn_is_shared((const void*)(p)) && !__builtin_amdgcn_is_private((const void*)(p)))
#else
#define ASSUME_GLOBAL(p) ((void)0)
#endif
        ASSUME_GLOBAL(ws); ASSUME_GLOBAL(a.ws); ASSUME_GLOBAL(a.out);
#pragma unroll
        for (int i = 0; i < 35; ++i) ASSUME_GLOBAL(a.in[i]);
        const int lane = tid & 63, wave = __builtin_amdgcn_readfirstlane(tid >> 6), gw = bid * 8 + wave, gt = bid * 512 + tid;
        const int l = (ph >= 1 && ph < 23) ? (ph - 1) / 11 : 0, sub = (ph >= 1 && ph < 23) ? (ph - 1) % 11 : -1;
        float* mod = (float*)(ws + WS_MOD) + (size_t)l * 5 * 6144;
        if (PH_ON(11) && ph == 0) { p0_mod_hid(a, lds, bid, G, tid, gw, NGW, lane); wconv_phase(a, 0, lds, gw, NGW, gt, NGT, wave, lane); }
        else if (PH_ON(12) && ph == 23) { norm_phase(a, 0, 2, false, gw, NGW, lane); }
        else if (PH_ON(0) && sub == 0) { if (l == 1) wconv_phase(a, 1, lds, gw, NGW, gt, NGT, wave, lane); norm_phase(a, l, 0, l == 0, gw, NGW, lane); }
        else if (PH_ON(1) && sub == 1) {
            Gemm g{(const bf16*)(ws + WS_HBF), (const bf16*)(ws + WS_WIN), TT, 3072, 1024, 1024, 1024}; StaticOrder S; S.init(TT, 3072, G, bid);
            pg8::EpiSeg E{(bf16*)(ws + WS_QA), (bf16*)(ws + WS_KVR), (bf16*)(ws + WS_CQ), (bf16*)(ws + WS_CKVR), (bf16*)(ws + WS_HYR)};
            pg8::gemm_phase<pg8::EpiSeg, StaticOrder, true, true>(lds, g, S, E);
        }
        else if (PH_ON(2) && sub == 2) { post_phase(a, l, lds, bid, G, tid, gw, NGW, gt, NGT, lane); }
        else if (PH_ON(3) && sub == 3) {
#pragma unroll 1
            for (int q = 0; q < 3; ++q) {
                Gemm g; StaticOrder S; pg8::EpiStore<0> E;
                if (q == 0) { g = Gemm{(const bf16*)(ws + WS_CQ), (const bf16*)(ws + WS_WUQ), TT, 768, 384, 512, 384}; S.init(TT, 768, G, bid); E = pg8::EpiStore<0>{(bf16*)(ws + WS_QB), 768}; }
                else if (q == 1) { g = Gemm{(const bf16*)(ws + WS_CKVALL), (const bf16*)(ws + WS_WKN), NKEYROWS, 512, 256, 256, 256}; S.init(NKEYROWS, 512, G, (bid + G - 144 % G) % G); E = pg8::EpiStore<0>{(bf16*)(ws + WS_KNB), 512}; }
                else { g = Gemm{(const bf16*)(ws + WS_WVV), (const bf16*)(ws + WS_CKVALL), 512, NKEYROWS, 256, 256, 256}; S.init(512, NKEYROWS, G, (bid + G - 248 % G) % G); E = pg8::EpiStore<0>{(bf16*)(ws + WS_VTB), NKEYROWS}; }
                pg8::gemm_phase<pg8::EpiStore<0>, StaticOrder, true, true>(lds, g, S, E);
            }
        }
        else if (PH_ON(4) && sub == 4) {
            const bf16 *QA = (const bf16*)(ws + WS_QA), *QB = (const bf16*)(ws + WS_QB), *KA = (const bf16*)(ws + WS_KA), *VTA = (const bf16*)(ws + WS_VTA);
            const bf16 *KNB = (const bf16*)(ws + WS_KNB), *VTB = (const bf16*)(ws + WS_VTB), *KPE = (const bf16*)(ws + WS_KPEALL);
            bf16 *OA = (bf16*)(ws + WS_OA), *OB = (bf16*)(ws + WS_OB);
            const float slA = 0.125f * 1.4426950408889634f, slB = 0.10206207261596575f * 1.4426950408889634f;
            const int sel = a.pad;
            for (int it = bid; it < 1792; it += G) {
                { const bool is_hy = (it >= 512 && it < 1024) || it >= 1280; if ((sel == 1 && is_hy) || (sel == 2 && !is_hy)) continue; }
                if (it < 256 || (it >= 1024 && it < 1152)) {
                    const bool lat = it < 256; const int u = lat ? (G == 256 ? ((bid & 7) * 4 + (bid >> 6)) * 8 + ((bid >> 3) & 7) : it) : it - 1024;
                    const int b = lat ? u >> 6 : u >> 3, hh = lat ? (u >> 3) & 7 : u & 7, qb = lat ? u & 7 : 0;
                    const int row0 = lat ? TCTX + b * 2048 + qb * 256 : b * 256, key0 = lat ? TCTX + b * 2304 : b * 256;
                    attn_unit<96>(lds, tid, QB + (size_t)row0 * 768 + hh * 96, 768, KNB + (size_t)key0 * 512 + hh * 64, 512, KPE + (size_t)key0 * 32, VTB + (size_t)(hh * 64) * NKEYROWS + key0, NKEYROWS,
                                  lat ? 2304 : 256, OB + (size_t)row0 * 512 + hh * 64, 512, slB, lat, qb * 256);
                } else if (it < 512 || (it >= 1152 && it < 1280)) {
                    const bool lat = it < 512; const int u = lat ? (G == 256 ? ((bid & 7) * 4 + (bid >> 6)) * 8 + ((bid >> 3) & 7) : it - 256) : it - 1152;
                    const int b = lat ? u >> 6 : u >> 3, hh = lat ? (u >> 3) & 7 : u & 7, qb = lat ? u & 7 : 0, kvh = hh >> 2;
                    const int row0 = lat ? TCTX + b * 2048 + qb * 256 : b * 256, nk = lat ? 2304 : 256;
                    const size_t kbase = lat ? (size_t)KA_LAT + (size_t)(b * 2 + kvh) * 2304 * 64 : (size_t)(b * 2 + kvh) * 256 * 64;
                    attn_unit<64>(lds, tid, QA + (size_t)row0 * 512 + hh * 64, 512, KA + kbase, 64, nullptr, VTA + kbase, nk, nk, OA + (size_t)row0 * 512 + hh * 64, 512, slA, false, 0);
                } else if (it < 1024) { hyena_unit<true>(a, l, it - 512, lds, tid); }
                else { hyena_unit<false>(a, l, it - 1280, lds, tid); }
            }
        }
        else if (PH_ON(5) && sub == 5) {
            const bf16* HBF = (const bf16*)(ws + WS_HBF); bf16* Sg = (bf16*)(ws + WS_S); float* MACC = (float*)(ws + WS_MACC); bf16* MBF = (bf16*)(ws + WS_MBF);
#pragma unroll 1
            for (int n = 0; n < 3; ++n) {
                { Gemm g{HBF, (const bf16*)(ws + WS_WG) + (size_t)n * 1024 * 1024, TT, 1024, 1024, 1024, 1024}; StaticOrder S; S.init(TT, 1024, G, bid);
                  pg8::EpiStore<1> E{Sg, 1024}; pg8::gemm_phase<pg8::EpiStore<1>, StaticOrder, true, true>(lds, g, S, E); }
                Gemm g{(const bf16*)(ws + WS_OA) + (size_t)n * TT * 512, (const bf16*)(ws + WS_WB) + (size_t)n * 1024 * 512, TT, 1024, 512, 512, 512}; StaticOrder S; S.init(TT, 1024, G, bid);
                if (n == 0) { pg8::EpiMerge<0> E{Sg, MACC, MBF}; pg8::gemm_phase<pg8::EpiMerge<0>, StaticOrder, true, true>(lds, g, S, E); }
                else if (n == 1) { pg8::EpiMerge<1> E{Sg, MACC, MBF}; pg8::gemm_phase<pg8::EpiMerge<1>, StaticOrder, true, true>(lds, g, S, E); }
                else { pg8::EpiMerge<2> E{Sg, MACC, MBF}; pg8::gemm_phase<pg8::EpiMerge<2>, StaticOrder, true, true>(lds, g, S, E); }
            }
        }
        else if (PH_ON(6) && sub == 6) {
            Gemm g{(const bf16*)(ws + WS_MBF), (const bf16*)(ws + WS_WO), TT, 1024, 1024, 1024, 1024}; StaticOrder S; S.init(TT, 1024, G, bid);
            pg8::EpiResid E{a.out, mod + 2048}; pg8::gemm_phase<pg8::EpiResid, StaticOrder, true, true>(lds, g, S, E);
        }
        else if (PH_ON(7) && sub == 7) { norm_phase(a, l, 1, false, gw, NGW, lane); }
        else if (PH_ON(8) && sub == 8) {
            Gemm g{(const bf16*)(ws + WS_HBF), (const bf16*)(ws + WS_WUP), TT, 5632, 1024, 1024, 1024}; StaticOrder S; S.init(TT, 5632, G, bid);
            pg8::EpiStore<0> E{(bf16*)(ws + WS_U), 5632}; pg8::gemm_phase<pg8::EpiStore<0>, StaticOrder, true, true>(lds, g, S, E);
        }
        else if (PH_ON(9) && sub == 9) { ffnconv_phase(a, l, gt, NGT); }
        else if (PH_ON(10) && sub == 10) {
            Gemm g{(const bf16*)(ws + WS_ACT), (const bf16*)(ws + WS_WDN), TT, 1024, 2816, 2816, 2816}; StaticOrder S; S.init(TT, 1024, G, bid);
            pg8::EpiResid E{a.out, mod + 5120}; pg8::gemm_phase<pg8::EpiResid, StaticOrder, true, true>(lds, g, S, E);
        }
#ifdef EXTRA_SYNCS
        for (int q = 0; q < EXTRA_SYNCS; ++q) { __syncthreads(); grid.sync(); }
#endif
        if (ph + 1 < ph_hi) xcd_barrier(bar);
    }
}

extern "C" void kernel_launch(void* const* d_in, const int* in_sizes, int n_in, void* d_out, int out_size, void* d_ws, size_t ws_size, hipStream_t stream) {
    static int grid = 0;
    if (grid == 0) {
        if (n_in != 35 || ws_size < WS_END) { fprintf(stderr, "kernel_launch: unexpected n_in %d / ws %zu\n", n_in, ws_size); grid = -1; return; }
        int dev = 0, cus = 0, per_cu = 0;
        if (hipGetDevice(&dev) != hipSuccess || hipDeviceGetAttribute(&cus, hipDeviceAttributeMultiprocessorCount, dev) != hipSuccess) { grid = -1; return; }
        if (hipFuncSetAttribute((const void*)mega_fwd, hipFuncAttributeMaxDynamicSharedMemorySize, LDS_BYTES) != hipSuccess) { fprintf(stderr, "kernel_launch: hipFuncSetAttribute failed\n"); grid = -1; return; }
        if (hipOccupancyMaxActiveBlocksPerMultiprocessor(&per_cu, (const void*)mega_fwd, 512, LDS_BYTES) != hipSuccess || per_cu < 1) { fprintf(stderr, "kernel_launch: occupancy query says %d\n", per_cu); per_cu = 1; }
        (void)hipGetLastError();
        grid = cus;
    }
    if (grid < 0) return;
    if (hipMemsetAsync((char*)d_ws + WS_MOD, 0, ZERO_BYTES, stream) != hipSuccess) { fprintf(stderr, "kernel_launch: memset failed\n"); return; }
    Args a{};
    for (int i = 0; i < 35; ++i) a.in[i] = (const float*)d_in[i];
    a.out = (float*)d_out; a.ws = (unsigned char*)d_ws;
#if defined(MK_PER_PHASE)
    for (int p = 0; p < NPHASE; ++p) { a.ph_lo = p; a.ph_hi = p + 1; a.li = 0; void* args[] = {&a};
        hipError_t e = hipLaunchCooperativeKernel((const void*)mega_fwd, dim3(grid), dim3(512), args, LDS_BYTES, stream);
        if (e != hipSuccess) { fprintf(stderr, "launch %d failed: %s\n", p, hipGetErrorString(e)); break; } }
#else
#if defined(PROBE_SUB)
#ifndef PROBE_SEL
#define PROBE_SEL 0
#endif
    { const int k0 = 1 + PROBE_SUB, k1 = 12 + PROBE_SUB; const int cuts[6][2] = {{0, k0 + 1}, {k0, k0 + 1}, {k0 + 1, k1 + 1}, {k1, k1 + 1}, {k1 + 1, NPHASE}, {0, 0}};
      for (int c = 0; c < 5; ++c) { a.ph_lo = cuts[c][0]; a.ph_hi = cuts[c][1]; a.li = c; a.pad = (c == 1 || c == 3) ? PROBE_SEL : 0; if (a.ph_lo >= a.ph_hi) continue; void* args[] = {&a};
          hipError_t e = hipLaunchCooperativeKernel((const void*)mega_fwd, dim3(grid), dim3(512), args, LDS_BYTES, stream);
          if (e != hipSuccess) { fprintf(stderr, "cooperative launch failed: %s\n", hipGetErrorString(e)); break; } } }
#elif defined(PROBE_CUTS)
    { const int k0 = 1 + PROBE_CUTS, k1 = 12 + PROBE_CUTS; const int cuts[4][2] = {{0, k0 + 1}, {k0 + 1, k1 + 1}, {k1 + 1, NPHASE}, {0, 0}};
      for (int c = 0; c < 3; ++c) { a.ph_lo = cuts[c][0]; a.ph_hi = cuts[c][1]; a.li = c; if (a.ph_lo >= a.ph_hi) continue; void* args[] = {&a};
          hipError_t e = hipLaunchCooperativeKernel((const void*)mega_fwd, dim3(grid), dim3(512), args, LDS_BYTES, stream);
          if (e != hipSuccess) { fprintf(stderr, "cooperative launch failed: %s\n", hipGetErrorString(e)); break; } } }
#else
    a.ph_lo = 0; a.ph_hi = NPHASE; void* args[] = {&a};
    hipError_t e = hipLaunchCooperativeKernel((const void*)mega_fwd, dim3(grid), dim3(512), args, LDS_BYTES, stream);
    if (e != hipSuccess) fprintf(stderr, "cooperative launch failed: %s (grid %d)\n", hipGetErrorString(e), grid);
#endif
#endif
}
```

```cpp
#include <hip/hip_runtime.h>
#include <hip/hip_cooperative_groups.h>
#include <cstdio>
#include <cstdint>
namespace cg = cooperative_groups;
namespace pg8 {
#define PG8_LAS __attribute__((address_space(3)))
typedef unsigned short bf16_t;
typedef short bf16x8 __attribute__((ext_vector_type(8)));
typedef float f32x4 __attribute__((ext_vector_type(4)));
typedef unsigned u32x4 __attribute__((ext_vector_type(4)));
constexpr int BM = 256, BK = 64, HALF = 128, HTB = HALF * BK * 2  , STAGE_BYTES = 8 * HTB, NXCD = 8, WGM = 8;

__host__ __device__ __forceinline__ int lds_byte(int r, int c) { const int st = (r >> 4) * 2 + (c >> 5), rr = r & 15, cc = c & 31, ob = rr * 64 + cc * 2; return st * 1024 + (ob ^ (((ob >> 9) & 1) << 5)); }
__host__ __device__ __forceinline__ void stage_rc(int b, int& R, int& C) { const int st = b / 1024, sb = b % 1024, swz = sb ^ (((sb >> 9) & 1) << 5); R = (st >> 1) * 16 + swz / 64; C = (st & 1) * 32 + (swz % 64) / 2; }
__host__ __device__ __forceinline__ int perm32(int rho) { const int n = rho >> 4, i = rho & 15; return 8 * (i >> 2) + 4 * n + (i & 3); }

struct Unit { int pm, pn; };
struct Gemm { const bf16_t* A; const bf16_t* Bt; int M, N, K, lda, ldb; };

struct StaticOrder {
    int nM, nN, nwg, G, c;
    __host__ __device__ void init(int M, int N, int G_, int c_) { nM = M / BM; nN = N / BM; nwg = nM * nN; G = G_; c = c_; }
    __host__ __device__ bool next(int i, Unit& u) const {
        const long L = (long)i * G + c; if (L >= nwg) return false;
        int wgid = (int)L; { const int q = nwg / NXCD, r = nwg % NXCD, xcd = wgid % NXCD, off = wgid / NXCD; wgid = (xcd < r ? xcd * (q + 1) : r * (q + 1) + (xcd - r) * q) + off; }
        const int nig = WGM * nN, gid = wgid / nig, fm = gid * WGM, gsz = (nM - fm) < WGM ? (nM - fm) : WGM;
        u.pm = fm + ((wgid % nig) % gsz); u.pn = (wgid % nig) / gsz; return true;
    }
    __device__ __forceinline__ void a_ready(const Unit&) const {}
    __device__ __forceinline__ void done(const Unit&) const {}
};

#ifndef GAS
#define GAS __attribute__((address_space(1)))
#endif
typedef float f32x2v __attribute__((ext_vector_type(2)));
typedef __bf16 bf16x2v __attribute__((ext_vector_type(2)));
__device__ __forceinline__ unsigned cvt_pk_bf16(float lo, float hi) { const f32x2v v = {lo, hi}; const bf16x2v b = __builtin_convertvector(v, bf16x2v); return __builtin_bit_cast(unsigned, b); }
__device__ __forceinline__ float sigm(float x) { return __builtin_amdgcn_rcpf(1.f + __expf(-x)); }
#define EPI_FOR _Pragma("unroll") for (int ai = 0; ai < 2; ++ai) _Pragma("unroll") for (int m = 0; m < 4; ++m) _Pragma("unroll") for (int bj = 0; bj < 2; ++bj)

template <int ACT  > struct EpiStore {
    static constexpr bool PERM = true, AFTER_DRAIN = false;
    bf16_t* O; int ld;
    __device__ __forceinline__ void operator()(const f32x4 (&acc)[2][2][4][2], const Unit& u, int wr, int wc, int fr, int fq) const {
        const int row0 = u.pm * BM + wr * 64 + fr, col0 = u.pn * BM + wc * 32 + 8 * fq;
        EPI_FOR { f32x4 v0 = acc[ai][bj][m][0], v1 = acc[ai][bj][m][1];
            if (ACT == 1) { v0 = (f32x4){sigm(v0[0]), sigm(v0[1]), sigm(v0[2]), sigm(v0[3])}; v1 = (f32x4){sigm(v1[0]), sigm(v1[1]), sigm(v1[2]), sigm(v1[3])}; }
            u32x4 w; w.x = cvt_pk_bf16(v0[0], v0[1]); w.y = cvt_pk_bf16(v0[2], v0[3]); w.z = cvt_pk_bf16(v1[0], v1[1]); w.w = cvt_pk_bf16(v1[2], v1[3]);
            *(GAS u32x4*)(O + (size_t)(row0 + ai * HALF + m * 16) * ld + col0 + bj * HALF) = w; }
    }
};
struct EpiSeg {
    static constexpr bool PERM = true, AFTER_DRAIN = false;
    bf16_t *QA, *KV, *CQ, *CKV, *HY;
    __device__ __forceinline__ void operator()(const f32x4 (&acc)[2][2][4][2], const Unit& u, int wr, int wc, int fr, int fq) const {
        bf16_t* base; int ld, coff; const int pn = u.pn;
        if (pn < 2) { base = QA; ld = 512; coff = 256 * pn; } else if (pn == 2) { base = KV; ld = 256; coff = 0; } else if (pn < 5) { base = CQ; ld = 512; coff = 256 * (pn - 3); }
        else if (pn == 5) { base = CKV; ld = 256; coff = 0; } else { base = HY; ld = 1536; coff = 256 * (pn - 6); }
        const int row0 = u.pm * BM + wr * 64 + fr, col0 = coff + wc * 32 + 8 * fq;
        EPI_FOR { const f32x4 v0 = acc[ai][bj][m][0], v1 = acc[ai][bj][m][1];
            u32x4 w; w.x = cvt_pk_bf16(v0[0], v0[1]); w.y = cvt_pk_bf16(v0[2], v0[3]); w.z = cvt_pk_bf16(v1[0], v1[1]); w.w = cvt_pk_bf16(v1[2], v1[3]);
            *(GAS u32x4*)(base + (size_t)(row0 + ai * HALF + m * 16) * ld + col0 + bj * HALF) = w; }
    }
};
struct EpiGate {
    static constexpr bool PERM = true, AFTER_DRAIN = false;
    bf16_t* S0;
    __device__ __forceinline__ void operator()(const f32x4 (&acc)[2][2][4][2], const Unit& u, int wr, int wc, int fr, int fq) const {
        const int n = u.pn >> 2; bf16_t* base = (bf16_t*)((unsigned char*)S0 + (size_t)n * (72u << 20) - (size_t)(n >> 1) * (48u << 20));
        const int row0 = u.pm * BM + wr * 64 + fr, col0 = (u.pn & 3) * BM + wc * 32 + 8 * fq;
        EPI_FOR { f32x4 v0 = acc[ai][bj][m][0], v1 = acc[ai][bj][m][1];
            v0 = (f32x4){sigm(v0[0]), sigm(v0[1]), sigm(v0[2]), sigm(v0[3])}; v1 = (f32x4){sigm(v1[0]), sigm(v1[1]), sigm(v1[2]), sigm(v1[3])};
            u32x4 w; w.x = cvt_pk_bf16(v0[0], v0[1]); w.y = cvt_pk_bf16(v0[2], v0[3]); w.z = cvt_pk_bf16(v1[0], v1[1]); w.w = cvt_pk_bf16(v1[2], v1[3]);
            *(GAS u32x4*)(base + (size_t)(row0 + ai * HALF + m * 16) * 1024 + col0 + bj * HALF) = w; }
    }
};
struct EpiMerge {
    static constexpr bool PERM = true, AFTER_DRAIN = false;
    const bf16_t* S; bf16_t* M; int MODE;
    __device__ __forceinline__ void operator()(const f32x4 (&acc)[2][2][4][2], const Unit& u, int wr, int wc, int fr, int fq) const {
        const int row0 = u.pm * BM + wr * 64 + fr, col0 = u.pn * BM + wc * 32 + 8 * fq;
        EPI_FOR { const size_t off = (size_t)(row0 + ai * HALF + m * 16) * 1024 + col0 + bj * HALF;
            const u32x4 sw = *(const GAS u32x4*)(S + off);
            f32x4 s0 = (f32x4){__uint_as_float(sw.x << 16), __uint_as_float(sw.x & 0xffff0000u), __uint_as_float(sw.y << 16), __uint_as_float(sw.y & 0xffff0000u)};
            f32x4 s1 = (f32x4){__uint_as_float(sw.z << 16), __uint_as_float(sw.z & 0xffff0000u), __uint_as_float(sw.w << 16), __uint_as_float(sw.w & 0xffff0000u)};
            f32x4 v0 = acc[ai][bj][m][0] * s0, v1 = acc[ai][bj][m][1] * s1;
            if (MODE >= 1) { const u32x4 mw = *(const GAS u32x4*)(M + off);
                v0 = v0 + (f32x4){__uint_as_float(mw.x << 16), __uint_as_float(mw.x & 0xffff0000u), __uint_as_float(mw.y << 16), __uint_as_float(mw.y & 0xffff0000u)};
                v1 = v1 + (f32x4){__uint_as_float(mw.z << 16), __uint_as_float(mw.z & 0xffff0000u), __uint_as_float(mw.w << 16), __uint_as_float(mw.w & 0xffff0000u)}; }
            u32x4 w; w.x = cvt_pk_bf16(v0[0], v0[1]); w.y = cvt_pk_bf16(v0[2], v0[3]); w.z = cvt_pk_bf16(v1[0], v1[1]); w.w = cvt_pk_bf16(v1[2], v1[3]); *(GAS u32x4*)(M + off) = w; }
    }
};
struct EpiResid {
    static constexpr bool PERM = true, AFTER_DRAIN = false;
    float* X; const float* gate;
    __device__ __forceinline__ void operator()(const f32x4 (&acc)[2][2][4][2], const Unit& u, int wr, int wc, int fr, int fq) const {
        const int row0 = u.pm * BM + wr * 64 + fr, col0 = u.pn * BM + wc * 32 + 8 * fq;
        const int mrow = (u.pm < 16) ? 0 : 1 + ((u.pm - 16) >> 3);
        const float* gp = gate + (size_t)mrow * 6144 + col0;
        f32x4 g[2][2];
#pragma unroll
        for (int bj = 0; bj < 2; ++bj) { g[bj][0] = *(const GAS f32x4*)(gp + bj * HALF); g[bj][1] = *(const GAS f32x4*)(gp + bj * HALF + 4); }
        EPI_FOR { float* xp = X + (size_t)(row0 + ai * HALF + m * 16) * 1024 + col0 + bj * HALF;
            const f32x4 x0 = *(const GAS f32x4*)xp, x1 = *(const GAS f32x4*)(xp + 4);
            *(GAS f32x4*)xp = x0 + g[bj][0] * acc[ai][bj][m][0]; *(GAS f32x4*)(xp + 4) = x1 + g[bj][1] * acc[ai][bj][m][1]; }
    }
};

template <class Epi, class Sched, bool ALIGN_EPI = false, bool SP2 = false>
__device__ __forceinline__ void gemm_phase(PG8_LAS unsigned char* lds, const Gemm g, const Sched& S, const Epi& E) {
    int tid_l = threadIdx.x; asm volatile("" : "+v"(tid_l));
    const int tid = tid_l, wid = __builtin_amdgcn_readfirstlane(tid >> 6), lane = tid & 63, wr = wid >> 2, wc = wid & 3, fr = lane & 15, fq = lane >> 4;
    const int K = g.K, nt = K / BK;
    unsigned voffA[2], voffB[2];
#pragma unroll
    for (int i = 0; i < 2; ++i) { int R, C; stage_rc(tid * 16 + i * 8192, R, C); const int Rb = Epi::PERM ? ((R & ~31) + perm32(R & 31)) : R;
        voffA[i] = (unsigned)(R * g.lda + C) * 2u; voffB[i] = (unsigned)(Rb * g.ldb + C) * 2u; }
    const size_t kstep = (size_t)(BK * 2);
    const size_t hstepA = (size_t)HALF * g.lda * 2, hstepB = (size_t)HALF * g.ldb * 2;
    const size_t tstepA = 2 * hstepA, tstepB = 2 * hstepB;
    const unsigned ldsw = (unsigned)wid * 1024u;
    const int aoff = lds_byte(wr * 64 + fr, fq * 8), boff = lds_byte(wc * 32 + fr, fq * 8);
#define PG8_SA(b, h) (((b) * 2 + (h)) * HTB)
#define PG8_SB(b, h) ((4 + (b) * 2 + (h)) * HTB)
#define PG8_STAGE(bufoff, gbase, voff) do { _Pragma("unroll") for (int _i = 0; _i < 2; ++_i) \
        __builtin_amdgcn_global_load_lds((const unsigned*)((const char*)(gbase) + (voff)[_i]), (PG8_LAS unsigned*)(lds + (bufoff) + ldsw + _i * 8192), 16, 0, 0); } while (0)
#define PG8_LDA(dst, b, h) do { _Pragma("unroll") for (int m = 0; m < 4; ++m) _Pragma("unroll") for (int k = 0; k < 2; ++k) dst[m][k] = *(const PG8_LAS bf16x8*)(lds + PG8_SA(b, h) + aoff + m * 2048 + k * 1024); } while (0)
#define PG8_LDB(dst, b, h) do { _Pragma("unroll") for (int n = 0; n < 2; ++n) _Pragma("unroll") for (int k = 0; k < 2; ++k) dst[n][k] = *(const PG8_LAS bf16x8*)(lds + PG8_SB(b, h) + boff + n * 2048 + k * 1024); } while (0)
#define PG8_MMA(ai, bj, At, Bt) do { __builtin_amdgcn_s_setprio(1); _Pragma("unroll") for (int m = 0; m < 4; ++m) _Pragma("unroll") for (int n = 0; n < 2; ++n) _Pragma("unroll") for (int k = 0; k < 2; ++k) \
        acc[ai][bj][m][n] = __builtin_amdgcn_mfma_f32_16x16x32_bf16(Bt[n][k], At[m][k], acc[ai][bj][m][n], 0, 0, 0); __builtin_amdgcn_s_setprio(0); } while (0)
#define PG8_WAIT_V(n) asm volatile("s_waitcnt vmcnt(" #n ")" ::: "memory")
#define PG8_WAIT_L(n) asm volatile("s_waitcnt lgkmcnt(" #n ")" ::: "memory")
#define PG8_BAR __builtin_amdgcn_s_barrier()
#define PG8_SCHED __builtin_amdgcn_sched_barrier(0)
    Unit cur, nxt; int ui = 0;
    if (!S.next(0, cur)) return;
    f32x4 acc[2][2][4][2];
#pragma unroll
    for (int a = 0; a < 2; ++a)
#pragma unroll
        for (int b = 0; b < 2; ++b)
#pragma unroll
            for (int m = 0; m < 4; ++m)
#pragma unroll
                for (int n = 0; n < 2; ++n) acc[a][b][m][n] = (f32x4){0.f, 0.f, 0.f, 0.f};
    bf16x8 At[4][2], B0[2][2], B1[2][2];
    const char* cA = (const char*)g.A + (size_t)cur.pm * tstepA; const char* cB = (const char*)g.Bt + (size_t)cur.pn * tstepB;
    S.a_ready(cur);
    if constexpr (SP2) {
        PG8_STAGE(PG8_SB(0, 0), cB, voffB); PG8_STAGE(PG8_SB(0, 1), cB + hstepB, voffB); PG8_STAGE(PG8_SA(0, 0), cA, voffA); PG8_STAGE(PG8_SA(0, 1), cA + hstepA, voffA);
        if (wr == 1) PG8_BAR;
        PG8_WAIT_V(2); PG8_BAR;
        PG8_STAGE(PG8_SB(1, 0), cB + kstep, voffB); PG8_STAGE(PG8_SA(1, 0), cA + kstep, voffA); PG8_STAGE(PG8_SB(1, 1), cB + hstepB + kstep, voffB);
        PG8_WAIT_V(6); PG8_BAR;
    } else {
        PG8_STAGE(PG8_SB(0, 0), cB, voffB); PG8_STAGE(PG8_SA(0, 0), cA, voffA); PG8_STAGE(PG8_SB(0, 1), cB + hstepB, voffB); PG8_STAGE(PG8_SA(0, 1), cA + hstepA, voffA);
        if (wr == 1) PG8_BAR;
        PG8_WAIT_V(4); PG8_BAR;
        PG8_STAGE(PG8_SB(1, 0), cB + kstep, voffB); PG8_STAGE(PG8_SA(1, 0), cA + kstep, voffA); PG8_STAGE(PG8_SB(1, 1), cB + hstepB + kstep, voffB);
        PG8_WAIT_V(6); PG8_BAR;
    }
    for (;;) {
        const bool has_next = S.next(ui + 1, nxt);
        const char* nA = has_next ? (const char*)g.A + (size_t)nxt.pm * tstepA : cA; const char* nB = has_next ? (const char*)g.Bt + (size_t)nxt.pn * tstepB : cB;
        for (int t = 0; t < nt; t += 2) {
            const bool last = (t == nt - 2);
            const char* a1 = cA + (size_t)(t + 1) * kstep;
            const char* a2 = last ? nA : cA + (size_t)(t + 2) * kstep; const char* b2 = last ? nB : cB + (size_t)(t + 2) * kstep;
            const char* a3 = a2 + kstep; const char* b3 = b2 + kstep;
            if (last && has_next) S.a_ready(nxt);
            if constexpr (SP2) {
            PG8_LDB(B0, 0, 0); PG8_LDB(B1, 0, 1); PG8_SCHED; PG8_LDA(At, 0, 0); PG8_STAGE(PG8_SA(1, 1), a1 + hstepA, voffA);
            PG8_WAIT_V(8); PG8_WAIT_L(0); PG8_BAR; PG8_MMA(0, 0, At, B0); PG8_MMA(0, 1, At, B1); PG8_BAR; PG8_SCHED;
            PG8_LDA(At, 0, 1); PG8_STAGE(PG8_SB(0, 0), b2, voffB); PG8_STAGE(PG8_SB(0, 1), b2 + hstepB, voffB); PG8_STAGE(PG8_SA(0, 0), a2, voffA);
            PG8_WAIT_V(8); PG8_WAIT_L(0); PG8_BAR; PG8_MMA(1, 0, At, B0); PG8_MMA(1, 1, At, B1); PG8_BAR; PG8_SCHED;
            PG8_LDB(B0, 1, 0); PG8_LDB(B1, 1, 1); PG8_SCHED; PG8_LDA(At, 1, 0); PG8_STAGE(PG8_SA(0, 1), a2 + hstepA, voffA);
            PG8_WAIT_V(8); PG8_WAIT_L(0); PG8_BAR; PG8_MMA(0, 0, At, B0); PG8_MMA(0, 1, At, B1); PG8_BAR; PG8_SCHED;
            PG8_LDA(At, 1, 1); PG8_STAGE(PG8_SB(1, 0), b3, voffB); PG8_STAGE(PG8_SB(1, 1), b3 + hstepB, voffB); PG8_STAGE(PG8_SA(1, 0), a3, voffA);
            PG8_WAIT_V(8); PG8_WAIT_L(0); PG8_BAR; PG8_MMA(1, 0, At, B0); PG8_MMA(1, 1, At, B1); PG8_BAR; PG8_SCHED;
            } else {
            PG8_LDB(B0, 0, 0); PG8_SCHED; PG8_LDA(At, 0, 0); PG8_STAGE(PG8_SA(1, 1), a1 + hstepA, voffA);
            PG8_WAIT_L(8); PG8_BAR; PG8_WAIT_L(0); PG8_MMA(0, 0, At, B0); PG8_BAR; PG8_SCHED;
            PG8_LDB(B1, 0, 1); PG8_STAGE(PG8_SB(0, 0), b2, voffB);
            PG8_BAR; PG8_WAIT_L(0); PG8_MMA(0, 1, At, B1); PG8_BAR;
            PG8_LDA(At, 0, 1); PG8_STAGE(PG8_SA(0, 0), a2, voffA);
            PG8_BAR; PG8_WAIT_L(0); PG8_MMA(1, 0, At, B0); PG8_BAR; PG8_SCHED;
            PG8_STAGE(PG8_SB(0, 1), b2 + hstepB, voffB);
            PG8_WAIT_V(6); PG8_BAR; PG8_MMA(1, 1, At, B1); PG8_BAR;
            PG8_LDB(B0, 1, 0); PG8_SCHED; PG8_LDA(At, 1, 0); PG8_STAGE(PG8_SA(0, 1), a2 + hstepA, voffA);
            PG8_WAIT_L(8); PG8_BAR; PG8_WAIT_L(0); PG8_MMA(0, 0, At, B0); PG8_BAR; PG8_SCHED;
            PG8_LDB(B1, 1, 1); PG8_STAGE(PG8_SB(1, 0), b3, voffB);
            PG8_BAR; PG8_WAIT_L(0); PG8_MMA(0, 1, At, B1); PG8_BAR;
            PG8_LDA(At, 1, 1); PG8_STAGE(PG8_SA(1, 0), a3, voffA);
            PG8_BAR; PG8_WAIT_L(0); PG8_MMA(1, 0, At, B0); PG8_BAR; PG8_SCHED;
            PG8_STAGE(PG8_SB(1, 1), b3 + hstepB, voffB);
            PG8_WAIT_V(6); PG8_BAR; PG8_MMA(1, 1, At, B1); PG8_BAR;
            }
        }
        if constexpr (ALIGN_EPI) { if (wr == 0) PG8_BAR; }
        if constexpr (!Epi::AFTER_DRAIN) { E(acc, cur, wr, wc, fr, fq); S.done(cur); }
        if (!has_next) break;
#pragma unroll
        for (int a = 0; a < 2; ++a)
#pragma unroll
            for (int b = 0; b < 2; ++b)
#pragma unroll
                for (int m = 0; m < 4; ++m)
#pragma unroll
                    for (int n = 0; n < 2; ++n) acc[a][b][m][n] = (f32x4){0.f, 0.f, 0.f, 0.f};
        cur = nxt; cA = nA; cB = nB; ++ui;
        if constexpr (ALIGN_EPI) { if (wr == 1) PG8_BAR; }
    }
    PG8_WAIT_V(0);
    if constexpr (!ALIGN_EPI) { if (wr == 0) PG8_BAR; }
    PG8_BAR;
    if constexpr (Epi::AFTER_DRAIN) { E.fused(acc, cur, wr, wc, fr, fq, lds, wid, lane); S.done(cur); }
#undef PG8_SA
#undef PG8_SB
#undef PG8_STAGE
#undef PG8_LDA
#undef PG8_LDB
#undef PG8_MMA
#undef PG8_WAIT_V
#undef PG8_WAIT_L
#undef PG8_BAR
#undef PG8_SCHED
}
}

constexpr int TCTX = 4096, TLAT = 8192, TT = 12288, DM = 1024, NKEYROWS = 13312;
constexpr float EPSN = 1e-6f;
constexpr size_t MiB = 1u << 20;
constexpr size_t WS_MOD = 0, MOD_BYTES = 2 * 5 * 6144 * 4, WS_BAR = 262144, BAR_REGION = 16384, ZERO_BYTES = WS_BAR + 5 * BAR_REGION;
constexpr size_t WS_HID = 1 * MiB;
constexpr size_t WS_WIN = 3 * MiB, WS_WG = 9 * MiB, WS_WUQ = 15 * MiB, WS_WKN = 16 * MiB, WS_WVV = 16 * MiB + 262144, WS_WB = 17 * MiB, WS_WO = 20 * MiB, WS_WUP = 22 * MiB, WS_WDN = 33 * MiB;
constexpr size_t WS_U = 39 * MiB, WS_ACT = 171 * MiB, WS_HBF = 171 * MiB;
constexpr size_t WS_QA = 39 * MiB, WS_KVR = 51 * MiB, WS_CQ = 57 * MiB, WS_CKVR = 69 * MiB, WS_HYR = 75 * MiB, WS_OA = 75 * MiB, WS_OB = 87 * MiB, WS_OC = 99 * MiB;
constexpr size_t WS_UT = 111 * MiB, WS_QB = 147 * MiB, WS_CKVALL = 195 * MiB, WS_KPEALL = 202 * MiB, WS_KNB = 203 * MiB, WS_VTB = 216 * MiB, WS_KA = 229 * MiB, WS_VTA = 233 * MiB;
constexpr size_t WS_S0 = 39 * MiB, WS_S1 = 111 * MiB, WS_S2 = 135 * MiB, WS_MBF = 195 * MiB, WS_END = 256 * MiB;
constexpr int KA_LAT = 16 * 2 * 256 * 64;
constexpr int UT_LAT = 16 * 1536 * 256;
constexpr int OUT_K = 12582912, OUT_V = 13631488, OUT_CKV = 14680064, OUT_KPE = 16777216;
constexpr int LDS_BYTES = 147456;
constexpr int NPHASE = 24;

#ifndef GAS
#define GAS __attribute__((address_space(1)))
#endif
#define LAS __attribute__((address_space(3)))
typedef unsigned short bf16;
typedef unsigned v4u __attribute__((ext_vector_type(4)));
typedef unsigned v2u __attribute__((ext_vector_type(2)));
typedef float f32x4 __attribute__((ext_vector_type(4)));
typedef float f32x16 __attribute__((ext_vector_type(16)));
typedef short bf16x8 __attribute__((ext_vector_type(8)));
typedef short bf16x4 __attribute__((ext_vector_type(4)));
#define LDS_WAIT() asm volatile("s_waitcnt lgkmcnt(0)" ::: "memory")
__device__ __forceinline__ unsigned f2bf(float f) { unsigned u = __builtin_bit_cast(unsigned, f); return (u + 0x7fffu + ((u >> 16) & 1u)) >> 16; }
__device__ __forceinline__ unsigned pk2(float lo, float hi) { return f2bf(lo) | (f2bf(hi) << 16); }
__device__ __forceinline__ float bflo(unsigned w) { return __uint_as_float(w << 16); }
__device__ __forceinline__ float bfhi(unsigned w) { return __uint_as_float(w & 0xffff0000u); }
__device__ __forceinline__ float bf1(bf16 b) { return __uint_as_float(((unsigned)b) << 16); }
__device__ __forceinline__ void fsincos(float x, float& s, float& c) { float rev = x * 0.15915494309189535f; rev = rev - rintf(rev); s = __builtin_amdgcn_sinf(rev); c = __builtin_amdgcn_cosf(rev); }
__device__ __forceinline__ float fsin(float x) { float rev = x * 0.15915494309189535f; rev = rev - rintf(rev); return __builtin_amdgcn_sinf(rev); }
__device__ __forceinline__ float wave_sum(float v) {
#pragma unroll
    for (int o = 1; o < 64; o <<= 1) v += __shfl_xor(v, o);
    return v;
}
__device__ __forceinline__ void rope2(float& x0, float& x1, float ang) { float s, c; fsincos(ang, s, c); const float a = x0 * c - x1 * s, b = x0 * s + x1 * c; x0 = a; x1 = b; }
#define L2_10000 13.287712379549449f

__device__ __forceinline__ void transpose_item(const float* W, size_t ldw, int k0, int n0, bf16* WT, size_t ldt, int drow0, LAS float* scr, int lane) {
    float wv[32];
#pragma unroll
    for (int i = 0; i < 32; ++i) wv[i] = ((const GAS float*)W)[(size_t)(k0 + 2 * i + (lane >> 5)) * ldw + n0 + (lane & 31)];
#pragma unroll
    for (int i = 0; i < 32; ++i) scr[(2 * i + (lane >> 5)) * 33 + (lane & 31)] = wv[i];
    LDS_WAIT(); asm volatile("" ::: "memory");
    const int c = lane & 7;
#pragma unroll
    for (int j = 0; j < 4; ++j) { const int n = (lane >> 3) + 8 * j; const LAS float* s = scr + (8 * c) * 33 + n;
        v4u o; o.x = pk2(s[0 * 33], s[1 * 33]); o.y = pk2(s[2 * 33], s[3 * 33]); o.z = pk2(s[4 * 33], s[5 * 33]); o.w = pk2(s[6 * 33], s[7 * 33]);
        *(GAS v4u*)(WT + (size_t)(drow0 + n) * ldt + k0 + 8 * c) = o; }
    LDS_WAIT(); asm volatile("" ::: "memory");
}

#define XB_TMO      128
#define XB_XCNT(j)  (256  + 64 * (j))
#define XB_XSUB(j)  (1280 + 64 * (j))
#define XB_XGEN(j)  (2304 + 64 * (j))
#define XB_TOP      3328
#define XB_TOPGEN   3392
#define XCD_BAR_WORDS 3456
#define XB_SPIN_CAP (1u << 18)

__device__ __forceinline__ unsigned xb_ld(unsigned* p)              { return __hip_atomic_load(p, __ATOMIC_RELAXED, __HIP_MEMORY_SCOPE_AGENT); }
__device__ __forceinline__ unsigned xb_add(unsigned* p, unsigned v) { return __hip_atomic_fetch_add(p, v, __ATOMIC_RELAXED, __HIP_MEMORY_SCOPE_AGENT); }
__device__ __forceinline__ unsigned xb_xcc_id() { return (unsigned)__builtin_amdgcn_s_getreg((3 << 11) | 20) & 0xFu; }
#define XB_SPIN(cond, bar) do { unsigned _sp = 0; while (cond) { __builtin_amdgcn_s_sleep(1); \
    if ((++_sp & 255u) == 0u) { if (xb_ld(&(bar)[XB_TMO])) break; if (_sp > XB_SPIN_CAP) { atomicAdd(&(bar)[XB_TMO], 1u); break; } } } } while (0)

struct XcdBarrier {
    unsigned* bar; unsigned x;
    volatile LAS unsigned* st;
};

__device__ __forceinline__ XcdBarrier xcd_barrier_post(unsigned* bar, volatile LAS unsigned* st) {
    XcdBarrier b; b.bar = bar; b.x = xb_xcc_id(); b.st = st;
    if (threadIdx.x == 0) (void)xb_add(&bar[XB_XCNT(b.x)], 1u);
    return b;
}
__device__ __forceinline__ void xcd_barrier_complete(unsigned* bar, unsigned x, unsigned& nloc, unsigned& nx) {
    const unsigned G = gridDim.x * gridDim.y * gridDim.z;
    unsigned sum, cnt, mine, sp = 0u;
    for (;;) {
        sum = 0u; cnt = 0u; mine = 0u;
#pragma unroll
        for (unsigned j = 0; j < 16; ++j) { const unsigned c = xb_ld(&bar[XB_XCNT(j)]); sum += c; cnt += (c > 0u) ? 1u : 0u; mine = (j == x) ? c : mine; }
        if (sum == G) break;
        __builtin_amdgcn_s_sleep(1);
        if ((++sp & 255u) == 0u) { if (xb_ld(&bar[XB_TMO])) break; if (sp > XB_SPIN_CAP) { atomicAdd(&bar[XB_TMO], 1u); break; } }
    }
    nloc = mine > 0u ? mine : 1u; nx = cnt > 0u ? cnt : 1u;
}

__device__ __forceinline__ void xcd_barrier(const XcdBarrier& b) {
    asm volatile("s_waitcnt vmcnt(0)" ::: "memory");
    __syncthreads();
    if (threadIdx.x == 0) {
        unsigned* bar = b.bar;
        __builtin_amdgcn_s_waitcnt(0);
        unsigned nloc = b.st[0], nx = b.st[1];
        if (nloc == 0u) { xcd_barrier_complete(bar, b.x, nloc, nx); b.st[0] = nloc; b.st[1] = nx; }
        const unsigned old = xb_add(&bar[XB_XSUB(b.x)], 1u);
        const unsigned gen = old / nloc;
        if (old + 1u == (gen + 1u) * nloc) {
            __builtin_amdgcn_fence(__ATOMIC_RELEASE, "agent");
            asm volatile("s_waitcnt vmcnt(0)" ::: "memory");
            const unsigned og = xb_add(&bar[XB_TOP], 1u);
            const unsigned tg = og / nx;
            if (og + 1u == (tg + 1u) * nx) xb_add(&bar[XB_TOPGEN], 1u);
            else XB_SPIN(xb_ld(&bar[XB_TOPGEN]) == tg, bar);
            __builtin_amdgcn_fence(__ATOMIC_ACQUIRE, "agent");
            xb_add(&bar[XB_XGEN(b.x)], 1u);
            asm volatile("s_waitcnt vmcnt(0)" ::: "memory");
        } else {
            XB_SPIN(xb_ld(&bar[XB_XGEN(b.x)]) == gen, bar);
            __builtin_amdgcn_fence(__ATOMIC_ACQUIRE, "agent");
            asm volatile("s_waitcnt vmcnt(0)" ::: "memory");
        }
    }
    __syncthreads();
}


struct Args { const float* in[35]; float* out; unsigned char* ws; int ph_lo, ph_hi, li, pad; };

__device__ __forceinline__ void wconv_phase(const Args& a, int l, LAS unsigned char* lds, int gw, int NGW, int gt, int NGT, int wave, int lane) {
    LAS float* scr = (LAS float*)(lds + wave * 16384);
    unsigned char* ws = a.ws;
    bf16 *WIN = (bf16*)(ws + WS_WIN), *WG = (bf16*)(ws + WS_WG), *WUQ = (bf16*)(ws + WS_WUQ), *WKN = (bf16*)(ws + WS_WKN), *WVV = (bf16*)(ws + WS_WVV), *WB = (bf16*)(ws + WS_WB), *WO = (bf16*)(ws + WS_WO), *WUP = (bf16*)(ws + WS_WUP), *WDN = (bf16*)(ws + WS_WDN);
    constexpr int I1 = 16 * 189, I2 = 6 * 24, I3 = 4 * 32, I4 = 3 * 8 * 32, I5 = 16 * 32, I6 = 16 * 176, I7 = 44 * 32, NIT = I1 + I2 + I3 + I4 + I5 + I6 + I7;
    for (int it = gw; it < NIT; it += NGW) {
        int r = it;
        if (r < I1) { const int kb = r / 189, n0 = 32 * (r % 189); bf16* dst = WIN; int drow;
            if (n0 < 1152) drow = n0; else if (n0 < 1408) drow = n0 + 128; else if (n0 < 1440) drow = 1152 + (n0 - 1408); else if (n0 < 2976) drow = 1536 + (n0 - 1440); else { dst = WG; drow = n0 - 2976; }
            transpose_item(a.in[12] + (size_t)l * 1024 * 6048, 6048, 64 * kb, n0, dst, 1024, drow, scr, lane); continue; } r -= I1;
        if (r < I2) { const int kb = r / 24, n0 = 32 * (r % 24); transpose_item(a.in[17] + (size_t)l * 384 * 768, 768, 64 * kb, n0, WUQ, 384, n0, scr, lane); continue; } r -= I2;
        if (r < I3) { const int kb = r / 32, n0 = 32 * (r % 32); const int h = n0 >> 7, c0 = n0 & 127;
            transpose_item(a.in[18] + (size_t)l * 256 * 1024, 1024, 64 * kb, n0, (c0 < 64) ? WKN : WVV, 256, h * 64 + (c0 & 63), scr, lane); continue; } r -= I3;
        if (r < I4) { const int n = r / 256, q = r % 256, kb = q / 32, n0 = 32 * (q % 32);
            transpose_item(a.in[28] + ((size_t)l * 3 + n) * 512 * 1024, 1024, 64 * kb, n0, WB + (size_t)n * 1024 * 512, 512, n0, scr, lane); continue; } r -= I4;
        if (r < I5) { const int kb = r / 32, n0 = 32 * (r % 32); transpose_item(a.in[29] + (size_t)l * 1024 * 1024, 1024, 64 * kb, n0, WO, 1024, n0, scr, lane); continue; } r -= I5;
        if (r < I6) { const int kb = r / 176, n0 = 32 * (r % 176); transpose_item(a.in[30] + (size_t)l * 1024 * 5632, 5632, 64 * kb, n0, WUP, 1024, n0, scr, lane); continue; } r -= I6;
        { const int kb = r / 32, n0 = 32 * (r % 32); transpose_item(a.in[33] + (size_t)l * 2816 * 1024, 1024, 64 * kb, n0, WDN, 2816, n0, scr, lane); }
    }
    for (int i = gt; i < 96 * 1024 / 8; i += NGT) *(GAS v4u*)(WIN + (size_t)1184 * 1024 + (size_t)i * 8) = (v4u){0u, 0u, 0u, 0u};
}

__device__ __forceinline__ void norm_phase(const Args& a, int l, int which, bool first, int gw, int NGW, int lane) {
    const GAS float* mod = (const GAS float*)(a.ws + WS_MOD) + (size_t)l * 5 * 6144;
    GAS bf16* HBF = (GAS bf16*)(a.ws + WS_HBF);
    const GAS float* gv = (const GAS float*)((which == 0) ? a.in[10] + l * 1024 : (which == 1) ? a.in[11] + l * 1024 : a.in[34]);
    GAS float* outp = (GAS float*)a.out;
    const int shoff = (which == 0) ? 0 : 3072, scoff = shoff + 1024;
    #pragma unroll 1
    for (int row0 = gw; row0 < TT; row0 += 4 * NGW) {
        f32x4 v[4][4];
#pragma unroll
        for (int q = 0; q < 4; ++q) { const int row = row0 + q * NGW; const int rr = row < TT ? row : row0;
            const GAS float* src = first ? (const GAS float*)(rr < TCTX ? a.in[0] + (size_t)rr * DM : a.in[1] + (size_t)(rr - TCTX) * DM) : (const GAS float*)(outp + (size_t)rr * DM);
#pragma unroll
            for (int j = 0; j < 4; ++j) v[q][j] = *(const GAS f32x4*)(src + 4 * lane + 256 * j); }
#pragma unroll
        for (int q = 0; q < 4; ++q) { const int row = row0 + q * NGW; if (row >= TT) continue;
            float ss = 0.f;
#pragma unroll
            for (int j = 0; j < 4; ++j) ss += (v[q][j].x * v[q][j].x + v[q][j].y * v[q][j].y) + (v[q][j].z * v[q][j].z + v[q][j].w * v[q][j].w);
            if (first) {
#pragma unroll
                for (int j = 0; j < 4; ++j) *(GAS f32x4*)(outp + (size_t)row * DM + 4 * lane + 256 * j) = v[q][j]; }
            const float rs = rsqrtf(wave_sum(ss) * (1.f / DM) + EPSN);
            const int mrow = row < TCTX ? 0 : 1 + ((row - TCTX) >> 11);
            const GAS float* mp = mod + (size_t)mrow * 6144;
#pragma unroll
            for (int j = 0; j < 4; ++j) { const int col = 4 * lane + 256 * j; const f32x4 g = *(const GAS f32x4*)(gv + col);
                if (which == 2) { *(GAS f32x4*)(outp + (size_t)row * DM + col) = v[q][j] * rs * g; }
                else { const f32x4 sc = *(const GAS f32x4*)(mp + scoff + col), sh = *(const GAS f32x4*)(mp + shoff + col);
                    const f32x4 y = v[q][j] * rs * g * (sc + 1.f) + sh;
                    *(GAS v2u*)(HBF + (size_t)row * DM + col) = (v2u){pk2(y.x, y.y), pk2(y.z, y.w)}; } } }
    }
}
__device__ __forceinline__ void p0_mod_hid(const Args& a, LAS unsigned char* lds, int bid, int G, int tid, int gw, int NGW, int lane) {
    float* mod = (float*)(a.ws + WS_MOD);
    LAS float* sc = (LAS float*)lds;
    for (int it = bid; it < 384; it += G) {
        const int l = it / 192, rem = it % 192, kc = rem / 12, jb = rem % 12;
        if (tid < 320) { const int r = tid >> 6, kk = tid & 63, k = kc * 64 + kk; const float cv = (r == 0) ? a.in[7][k] : a.in[6][(r - 1) * 1024 + k]; sc[tid] = cv / (1.f + __expf(-cv)); }
        __syncthreads();
        const int j = jb * 512 + tid;
        const GAS float* wp = (const GAS float*)(a.in[8] + ((size_t)l * 1024 + kc * 64) * 6144 + j);
        float acc[5] = {0.f, 0.f, 0.f, 0.f, 0.f};
#pragma unroll 8
        for (int kk = 0; kk < 64; ++kk) { const float w = wp[(size_t)kk * 6144];
#pragma unroll
            for (int r = 0; r < 5; ++r) acc[r] += sc[r * 64 + kk] * w; }
        const float bias = (kc == 0) ? a.in[9][l * 6144 + j] : 0.f;
#pragma unroll
        for (int r = 0; r < 5; ++r) atomicAdd(mod + (size_t)(l * 5 + r) * 6144 + j, acc[r] + bias);
        __syncthreads();
    }
    float* HID = (float*)(a.ws + WS_HID);
    for (int it = gw; it < 2 * 2304; it += NGW) {
        const int l = it / 2304, q = it % 2304; const int L = q < 256 ? 256 : 2048, t = q < 256 ? q : q - 256;
        const float tn = (float)t / (float)(L - 1);
        float zi = 0.f;
        if (lane == 0) zi = tn;
        else if (lane <= 16) { const int bi = (lane - 1) & 7; const float band = 1e-4f + (float)bi * ((7.f - 1e-4f) / 7.f); const float ang = (6.283185307179586f / (float)L) * (float)t * band; float s, c; fsincos(ang, s, c); zi = (lane <= 8) ? c : -s; }
        float s1 = a.in[22][l * 64 + lane];
#pragma unroll
        for (int i = 0; i < 17; ++i) s1 += __shfl(zi, i) * a.in[21][(l * 17 + i) * 64 + lane];
        const float h1 = fsin(a.in[26][(l * 2 + 0) * 64 + lane] * s1);
        float s2 = a.in[24][l * 64 + lane];
#pragma unroll 8
        for (int i = 0; i < 64; ++i) s2 += __shfl(h1, i) * a.in[23][(l * 64 + i) * 64 + lane];
        HID[(size_t)it * 64 + lane] = fsin(a.in[26][(l * 2 + 1) * 64 + lane] * s2);
    }
}

__device__ __forceinline__ void post_phase(const Args& a, int l, LAS unsigned char* lds, int bid, int G, int tid, int gw, int NGW, int gt, int NGT, int lane) {
    unsigned char* ws = a.ws;
    GAS bf16 *QA = (GAS bf16*)(ws + WS_QA), *KVR = (GAS bf16*)(ws + WS_KVR), *CQ = (GAS bf16*)(ws + WS_CQ), *CKVR = (GAS bf16*)(ws + WS_CKVR), *HYR = (GAS bf16*)(ws + WS_HYR);
    GAS bf16 *UT = (GAS bf16*)(ws + WS_UT), *CKVALL = (GAS bf16*)(ws + WS_CKVALL), *KPEALL = (GAS bf16*)(ws + WS_KPEALL), *KA = (GAS bf16*)(ws + WS_KA), *VTA = (GAS bf16*)(ws + WS_VTA);
    GAS float* outp = (GAS float*)a.out;
    for (int i = gt; i < 4 * 256 * 128; i += NGT) { const int b = i >> 15, p = (i >> 7) & 255, kvh = (i >> 6) & 1, d = i & 63;
        const size_t s = ((size_t)(b * 2 + l) * 256 + p) * 128 + kvh * 64 + d;
        KA[KA_LAT + ((b * 2 + kvh) * 2304 + p) * 64 + d] = (bf16)f2bf(a.in[2][s]);
        VTA[KA_LAT + ((b * 2 + kvh) * 64 + d) * 2304 + p] = (bf16)f2bf(a.in[3][s]); }
    for (int i = gt; i < 4 * 256 * 256; i += NGT) { const int b = i >> 16, p = (i >> 8) & 255, j = i & 255;
        CKVALL[(size_t)(TCTX + b * 2304 + p) * 256 + j] = (bf16)f2bf(a.in[4][((size_t)(b * 2 + l) * 256 + p) * 256 + j]); }
    for (int i = gt; i < 4 * 256 * 32; i += NGT) { const int b = i >> 13, p = (i >> 5) & 255, j = i & 31;
        KPEALL[(size_t)(TCTX + b * 2304 + p) * 32 + j] = (bf16)f2bf(a.in[5][((size_t)(b * 2 + l) * 256 + p) * 32 + j]); }
    const GAS float *gq = (const GAS float*)(a.in[13] + l * 64), *gk = (const GAS float*)(a.in[14] + l * 64), *gcq = (const GAS float*)(a.in[15] + l * 384), *gkv = (const GAS float*)(a.in[16] + l * 256);
    for (int row = gw; row < TT; row += NGW) {
        const bool lat = row >= TCTX;
        const int b = lat ? (row - TCTX) >> 11 : row >> 8, t = lat ? (row - TCTX) & 2047 : row & 255;
        const float grow = (float)(t >> 6), gcol = (float)(t & 63);
        const int keyrow = lat ? TCTX + b * 2304 + 256 + t : row;
        { v4u w = *(const GAS v4u*)(QA + (size_t)row * 512 + 8 * lane);
          float x[8] = {bflo(w.x), bfhi(w.x), bflo(w.y), bfhi(w.y), bflo(w.z), bfhi(w.z), bflo(w.w), bfhi(w.w)};
          float ss = 0.f;
#pragma unroll
          for (int j = 0; j < 8; ++j) ss += x[j] * x[j];
          ss += __shfl_xor(ss, 1); ss += __shfl_xor(ss, 2); ss += __shfl_xor(ss, 4);
          const float rs = rsqrtf(ss * (1.f / 64.f) + EPSN); const int d0 = 8 * (lane & 7);
#pragma unroll
          for (int j = 0; j < 8; ++j) x[j] = x[j] * rs * gq[d0 + j];
          if (lat) {
#pragma unroll
              for (int k = 0; k < 4; ++k) { const int i = 4 * (lane & 7) + k; const float inv = __builtin_amdgcn_exp2f(-(float)(i & 15) * (L2_10000 / 16.f)); rope2(x[2 * k], x[2 * k + 1], (i < 16 ? grow : gcol) * inv); } }
          *(GAS v4u*)(QA + (size_t)row * 512 + 8 * lane) = (v4u){pk2(x[0], x[1]), pk2(x[2], x[3]), pk2(x[4], x[5]), pk2(x[6], x[7])}; }
        { const v2u w = *(const GAS v2u*)(KVR + (size_t)row * 256 + 4 * lane);
          float x[4] = {bflo(w.x), bfhi(w.x), bflo(w.y), bfhi(w.y)};
          float ss = (x[0] * x[0] + x[1] * x[1]) + (x[2] * x[2] + x[3] * x[3]);
          ss += __shfl_xor(ss, 1); ss += __shfl_xor(ss, 2); ss += __shfl_xor(ss, 4); ss += __shfl_xor(ss, 8);
          const int kvh = (lane >> 4) & 1, d0 = 4 * (lane & 15);
          if (lane < 32) {
              const float rs = rsqrtf(ss * (1.f / 64.f) + EPSN);
#pragma unroll
              for (int j = 0; j < 4; ++j) x[j] = x[j] * rs * gk[d0 + j];
              if (!lat) { *(GAS f32x4*)(outp + OUT_K + ((size_t)(b * 2 + l) * 256 + t) * 128 + kvh * 64 + d0) = (f32x4){x[0], x[1], x[2], x[3]};
                  *(GAS v2u*)(KA + ((size_t)(b * 2 + kvh) * 256 + t) * 64 + d0) = (v2u){pk2(x[0], x[1]), pk2(x[2], x[3])}; }
              else {
#pragma unroll
                  for (int k = 0; k < 2; ++k) { const int i = 2 * (lane & 15) + k; const float inv = __builtin_amdgcn_exp2f(-(float)(i & 15) * (L2_10000 / 16.f)); rope2(x[2 * k], x[2 * k + 1], (i < 16 ? grow : gcol) * inv); }
                  *(GAS v2u*)(KA + KA_LAT + ((size_t)(b * 2 + kvh) * 2304 + 256 + t) * 64 + d0) = (v2u){pk2(x[0], x[1]), pk2(x[2], x[3])}; }
          } else {
              if (!lat) { *(GAS f32x4*)(outp + OUT_V + ((size_t)(b * 2 + l) * 256 + t) * 128 + kvh * 64 + d0) = (f32x4){x[0], x[1], x[2], x[3]};
#pragma unroll
                  for (int j = 0; j < 4; ++j) VTA[((size_t)(b * 2 + kvh) * 64 + d0 + j) * 256 + t] = (bf16)f2bf(x[j]); }
              else {
#pragma unroll
                  for (int j = 0; j < 4; ++j) VTA[KA_LAT + ((size_t)(b * 2 + kvh) * 64 + d0 + j) * 2304 + 256 + t] = (bf16)f2bf(x[j]); }
          } }
        { GAS unsigned* p = (GAS unsigned*)(CQ + (size_t)row * 512 + 6 * lane);
          const unsigned w0 = p[0], w1 = p[1], w2 = p[2];
          float x[6] = {bflo(w0), bfhi(w0), bflo(w1), bfhi(w1), bflo(w2), bfhi(w2)};
          float ss = 0.f;
#pragma unroll
          for (int j = 0; j < 6; ++j) ss += x[j] * x[j];
          const float rs = rsqrtf(wave_sum(ss) * (1.f / 384.f) + EPSN);
#pragma unroll
          for (int j = 0; j < 6; ++j) x[j] = x[j] * rs * gcq[6 * lane + j];
          p[0] = pk2(x[0], x[1]); p[1] = pk2(x[2], x[3]); p[2] = pk2(x[4], x[5]);
          if (lane < 16) { const unsigned w = *(const GAS unsigned*)(CQ + (size_t)row * 512 + 384 + 2 * lane); float y0 = bflo(w), y1 = bfhi(w);
              if (!lat) { outp[OUT_KPE + ((size_t)(b * 2 + l) * 256 + t) * 32 + 2 * lane] = y0; outp[OUT_KPE + ((size_t)(b * 2 + l) * 256 + t) * 32 + 2 * lane + 1] = y1; }
              else { const float inv = __builtin_amdgcn_exp2f(-(float)(lane & 7) * (L2_10000 / 8.f)); rope2(y0, y1, (lane < 8 ? grow : gcol) * inv); }
              *(GAS unsigned*)(KPEALL + (size_t)keyrow * 32 + 2 * lane) = pk2(y0, y1); } }
        { const v2u w = *(const GAS v2u*)(CKVR + (size_t)row * 256 + 4 * lane);
          float x[4] = {bflo(w.x), bfhi(w.x), bflo(w.y), bfhi(w.y)};
          const float ss = (x[0] * x[0] + x[1] * x[1]) + (x[2] * x[2] + x[3] * x[3]);
          const float rs = rsqrtf(wave_sum(ss) * (1.f / 256.f) + EPSN);
#pragma unroll
          for (int j = 0; j < 4; ++j) x[j] = x[j] * rs * gkv[4 * lane + j];
          if (!lat) *(GAS f32x4*)(outp + OUT_CKV + ((size_t)(b * 2 + l) * 256 + t) * 256 + 4 * lane) = (f32x4){x[0], x[1], x[2], x[3]};
          *(GAS v2u*)(CKVALL + (size_t)keyrow * 256 + 4 * lane) = (v2u){pk2(x[0], x[1]), pk2(x[2], x[3])}; }
    }
    LAS float* tile = (LAS float*)lds;
    const GAS float *sw = (const GAS float*)(a.in[19] + (size_t)l * 3 * 1536), *sb = (const GAS float*)(a.in[20] + (size_t)l * 1536);
    for (int it = bid; it < 96 * 12; it += G) {
        const int tb = it / 12, cb = it % 12, row0 = tb * 128;
        const bool lat = row0 >= TCTX; const int L = lat ? 2048 : 256;
        const int b = lat ? (row0 - TCTX) >> 11 : row0 >> 8, t0 = lat ? (row0 - TCTX) & 2047 : row0 & 255;
        v4u w[4], wh = (v4u){0u, 0u, 0u, 0u};
        { const int rr = tid >> 4, c8 = tid & 15;
#pragma unroll
          for (int q = 0; q < 4; ++q) w[q] = *(const GAS v4u*)(HYR + (size_t)(row0 + rr + 32 * q) * 1536 + cb * 128 + 8 * c8);
          if (tid < 32) { const int which = tid >> 4; const bool ok = which ? (t0 + 128 < L) : (t0 > 0); const int rsrc = which ? row0 + 128 : row0 - 1;
              if (ok) wh = *(const GAS v4u*)(HYR + (size_t)rsrc * 1536 + cb * 128 + 8 * c8); }
#pragma unroll
          for (int q = 0; q < 4; ++q) { LAS float* tp = tile + (rr + 32 * q + 1) * 129 + 8 * c8;
              tp[0] = bflo(w[q].x); tp[1] = bfhi(w[q].x); tp[2] = bflo(w[q].y); tp[3] = bfhi(w[q].y); tp[4] = bflo(w[q].z); tp[5] = bfhi(w[q].z); tp[6] = bflo(w[q].w); tp[7] = bfhi(w[q].w); }
          if (tid < 32) { LAS float* tp = tile + ((tid >> 4) ? 129 : 0) * 129 + 8 * c8;
              tp[0] = bflo(wh.x); tp[1] = bfhi(wh.x); tp[2] = bflo(wh.y); tp[3] = bfhi(wh.y); tp[4] = bflo(wh.z); tp[5] = bfhi(wh.z); tp[6] = bflo(wh.w); tp[7] = bfhi(wh.w); } }
        __syncthreads();
        { const int c = tid >> 2, tc = tid & 3, cg_ = cb * 128 + c; const float w0 = sw[cg_], w1 = sw[1536 + cg_], w2 = sw[3072 + cg_], bb = sb[cg_];
          const size_t base = lat ? (size_t)UT_LAT + ((size_t)b * 1536 + cg_) * 2048 : ((size_t)b * 1536 + cg_) * 256;
#pragma unroll
          for (int q = 0; q < 4; ++q) { float u[8];
#pragma unroll
              for (int k = 0; k < 8; ++k) { const int tr = 32 * tc + 8 * q + k; u[k] = w0 * tile[tr * 129 + c] + w1 * tile[(tr + 1) * 129 + c] + w2 * tile[(tr + 2) * 129 + c] + bb; }
              *(GAS v4u*)(UT + base + t0 + 32 * tc + 8 * q) = (v4u){pk2(u[0], u[1]), pk2(u[2], u[3]), pk2(u[4], u[5]), pk2(u[6], u[7])}; } }
        __syncthreads();
    }
}

__device__ __forceinline__ void ffnconv_phase(const Args& a, int l, int gt, int NGT) {
    const GAS bf16* U = (const GAS bf16*)(a.ws + WS_U); GAS bf16* ACT = (GAS bf16*)(a.ws + WS_ACT);
    const GAS float *cw = (const GAS float*)(a.in[31] + (size_t)l * 3 * 5632), *cb = (const GAS float*)(a.in[32] + (size_t)l * 5632);
#pragma unroll 1
    for (int idx = gt; idx < 1536 * 352; idx += NGT) {
        const int tb = idx / 352, ch = idx % 352, row0 = tb * 8, c0 = ch * 8;
        const bool lat = row0 >= TCTX; const int t0 = lat ? (row0 - TCTX) & 2047 : row0 & 255, L = lat ? 2048 : 256;
        v4u ra[10], rg[10];
#pragma unroll
        for (int i = 0; i < 10; ++i) { const int t = t0 + i - 1; const bool ok = (t >= 0) && (t < L); const size_t rr = (size_t)(row0 + (ok ? i - 1 : 0)) * 5632 + c0;
            ra[i] = *(const GAS v4u*)(U + rr); rg[i] = *(const GAS v4u*)(U + rr + 2816);
            if (!ok) { ra[i] = (v4u){0u, 0u, 0u, 0u}; rg[i] = (v4u){0u, 0u, 0u, 0u}; } }
        float wa[3][8], wg[3][8], ba[8], bg[8];
#pragma unroll
        for (int j = 0; j < 8; ++j) { ba[j] = cb[c0 + j]; bg[j] = cb[2816 + c0 + j];
#pragma unroll
            for (int k = 0; k < 3; ++k) { wa[k][j] = cw[k * 5632 + c0 + j]; wg[k][j] = cw[k * 5632 + 2816 + c0 + j]; } }
#pragma unroll
        for (int i = 0; i < 8; ++i) {
            float o[8];
#pragma unroll
            for (int j2 = 0; j2 < 4; ++j2) {
                const unsigned a0 = ra[i][j2], a1 = ra[i + 1][j2], a2 = ra[i + 2][j2], g0 = rg[i][j2], g1 = rg[i + 1][j2], g2 = rg[i + 2][j2];
                { const int j = 2 * j2; const float av = wa[0][j] * bflo(a0) + wa[1][j] * bflo(a1) + wa[2][j] * bflo(a2) + ba[j], gv = wg[0][j] * bflo(g0) + wg[1][j] * bflo(g1) + wg[2][j] * bflo(g2) + bg[j]; o[j] = gv * __builtin_amdgcn_rcpf(1.f + __expf(-gv)) * av; }
                { const int j = 2 * j2 + 1; const float av = wa[0][j] * bfhi(a0) + wa[1][j] * bfhi(a1) + wa[2][j] * bfhi(a2) + ba[j], gv = wg[0][j] * bfhi(g0) + wg[1][j] * bfhi(g1) + wg[2][j] * bfhi(g2) + bg[j]; o[j] = gv * __builtin_amdgcn_rcpf(1.f + __expf(-gv)) * av; } }
            *(GAS v4u*)(ACT + (size_t)(row0 + i) * 2816 + c0) = (v4u){pk2(o[0], o[1]), pk2(o[2], o[3]), pk2(o[4], o[5]), pk2(o[6], o[7])};
        }
    }
}
typedef float f32x2_t __attribute__((ext_vector_type(2)));
typedef __bf16 bf16x2_t __attribute__((ext_vector_type(2)));
__device__ __forceinline__ unsigned cvtpk(float lo, float hi) { const f32x2_t v = {lo, hi}; const bf16x2_t b = __builtin_convertvector(v, bf16x2_t); return __builtin_bit_cast(unsigned, b); }
template <int DK>
__device__ __forceinline__ void attn_unit(LAS unsigned char* lds, int tid, const bf16* Qp, int qpitch, const bf16* Kp, int kpitch, const bf16* Kpe, const bf16* Vt, size_t vpitch,
                                          int nkeys, bf16* Op, int opitch, float sl2, bool rope, int pos0) {
    constexpr int NS = DK / 16;
    asm volatile("" : "+v"(tid));
    const int lane = tid & 63, wave = tid >> 6, r = lane & 31, h = lane >> 5;
    bf16x8 qf[NS];
    { const bf16* qrow = Qp + (size_t)(wave * 32 + r) * qpitch;
#pragma unroll
      for (int s = 0; s < NS; ++s) qf[s] = *(const GAS bf16x8*)(qrow + 16 * s + 8 * h);
      if (DK == 96 && rope) { const int t = pos0 + wave * 32 + r; const float grow = (float)(t >> 6), gcol = (float)(t & 63);
#pragma unroll
          for (int sp = 0; sp < 2; ++sp) { bf16x8 v = qf[NS - 2 + sp];
#pragma unroll
              for (int k = 0; k < 4; ++k) { float x0 = bf1((bf16)v[2 * k]), x1 = bf1((bf16)v[2 * k + 1]);
                  const float inv = __builtin_amdgcn_exp2f(-(float)(4 * h + k) * (L2_10000 / 8.f)); rope2(x0, x1, (sp == 0 ? grow : gcol) * inv);
                  v[2 * k] = (short)f2bf(x0); v[2 * k + 1] = (short)f2bf(x1); }
              qf[NS - 2 + sp] = v; } } }
    const int kkey = tid >> 3, kch = tid & 7, pkey = tid >> 2, pch = tid & 3;
    f32x16 o0, o1;
#pragma unroll
    for (int i = 0; i < 16; ++i) { o0[i] = 0.f; o1[i] = 0.f; }
    float mrun = -__builtin_inff(), lrun = 0.f;
    v4u rk, rv, rp = (v4u){0u, 0u, 0u, 0u};
    const int ntile = nkeys >> 6;
#define ATT_LOAD(kt) do { const int key0 = (kt) * 64; rk = *(const GAS v4u*)(Kp + (size_t)(key0 + kkey) * kpitch + 8 * kch); rv = *(const GAS v4u*)(Vt + (size_t)kkey * vpitch + key0 + 8 * kch); \
        if (DK == 96 && tid < 256) rp = *(const GAS v4u*)(Kpe + (size_t)(key0 + pkey) * 32 + 8 * pch); } while (0)
#define ATT_WRITE(buf) do { *(LAS v4u*)(lds + (buf) * 13312 + kkey * 208 + kch * 16) = rk; \
        { LAS unsigned char* vw = lds + 26624 + (buf) * 9216 + kkey * 144 + (kch >> 1) * 32 + (kch & 1) * 8; *(LAS v2u*)vw = (v2u){rv.x, rv.y}; *(LAS v2u*)(vw + 16) = (v2u){rv.z, rv.w}; } \
        if (DK == 96 && tid < 256) *(LAS v4u*)(lds + (buf) * 13312 + pkey * 208 + 128 + pch * 16) = rp; } while (0)
    ATT_LOAD(0); ATT_WRITE(0); __syncthreads();
    for (int kt = 0; kt < ntile; ++kt) {
        const int buf = kt & 1;
        if (kt + 1 < ntile) ATT_LOAD(kt + 1);
        const LAS unsigned char* kb = lds + buf * 13312; const LAS unsigned char* vb = lds + 26624 + buf * 9216;
        f32x16 s0, s1;
#pragma unroll
        for (int i = 0; i < 16; ++i) { s0[i] = 0.f; s1[i] = 0.f; }
#pragma unroll
        for (int s = 0; s < NS; ++s) {
            const bf16x8 a0 = *(const LAS bf16x8*)(kb + r * 208 + (16 * s + 8 * h) * 2), a1 = *(const LAS bf16x8*)(kb + (32 + r) * 208 + (16 * s + 8 * h) * 2);
            s0 = __builtin_amdgcn_mfma_f32_32x32x16_bf16(a0, qf[s], s0, 0, 0, 0); s1 = __builtin_amdgcn_mfma_f32_32x32x16_bf16(a1, qf[s], s1, 0, 0, 0); }
        float mx = s0[0];
#pragma unroll
        for (int i = 1; i < 16; ++i) mx = fmaxf(mx, s0[i]);
#pragma unroll
        for (int i = 0; i < 16; ++i) mx = fmaxf(mx, s1[i]);
        mx = fmaxf(mx, __shfl_xor(mx, 32));
        const float mnew = fmaxf(mrun, mx), alpha = __builtin_amdgcn_exp2f((mrun - mnew) * sl2), nm = mnew * sl2;
        float sum = 0.f;
#pragma unroll
        for (int i = 0; i < 16; ++i) { s0[i] = __builtin_amdgcn_exp2f(s0[i] * sl2 - nm); s1[i] = __builtin_amdgcn_exp2f(s1[i] * sl2 - nm); sum += s0[i] + s1[i]; }
        lrun = lrun * alpha + sum; mrun = mnew;
#pragma unroll
        for (int i = 0; i < 16; ++i) { o0[i] *= alpha; o1[i] *= alpha; }
#pragma unroll
        for (int sub = 0; sub < 2; ++sub) {
#pragma unroll
            for (int s2 = 0; s2 < 2; ++s2) {
                const v4u pw = (sub == 0) ? (v4u){cvtpk(s0[8 * s2], s0[8 * s2 + 1]), cvtpk(s0[8 * s2 + 2], s0[8 * s2 + 3]), cvtpk(s0[8 * s2 + 4], s0[8 * s2 + 5]), cvtpk(s0[8 * s2 + 6], s0[8 * s2 + 7])}
                                          : (v4u){cvtpk(s1[8 * s2], s1[8 * s2 + 1]), cvtpk(s1[8 * s2 + 2], s1[8 * s2 + 3]), cvtpk(s1[8 * s2 + 4], s1[8 * s2 + 5]), cvtpk(s1[8 * s2 + 6], s1[8 * s2 + 7])};
                const bf16x8 pb = __builtin_bit_cast(bf16x8, pw);
                const int kofs = (32 * sub + 16 * s2 + 8 * h) * 2;
#pragma unroll
                for (int slab = 0; slab < 2; ++slab) {
                    const bf16x8 va = *(const LAS bf16x8*)(vb + (32 * slab + r) * 144 + kofs);
                    if (slab == 0) o0 = __builtin_amdgcn_mfma_f32_32x32x16_bf16(va, pb, o0, 0, 0, 0); else o1 = __builtin_amdgcn_mfma_f32_32x32x16_bf16(va, pb, o1, 0, 0, 0); } } }
        if (kt + 1 < ntile) ATT_WRITE(buf ^ 1);
        __syncthreads();
    }
#undef ATT_LOAD
#undef ATT_WRITE
    const float ltot = lrun + __shfl_xor(lrun, 32), inv = 1.f / ltot;
    bf16* orow = Op + (size_t)(wave * 32 + r) * opitch;
#pragma unroll
    for (int g4 = 0; g4 < 4; ++g4) {
        *(GAS v2u*)(orow + 8 * g4 + 4 * h) = (v2u){pk2(o0[4 * g4] * inv, o0[4 * g4 + 1] * inv), pk2(o0[4 * g4 + 2] * inv, o0[4 * g4 + 3] * inv)};
        *(GAS v2u*)(orow + 32 + 8 * g4 + 4 * h) = (v2u){pk2(o1[4 * g4] * inv, o1[4 * g4 + 1] * inv), pk2(o1[4 * g4 + 2] * inv, o1[4 * g4 + 3] * inv)}; }
}

template <bool LAT>
__device__ __forceinline__ void hyena_unit(const Args& a, int l, int c, LAS unsigned char* lds, int tid) {
    constexpr int L = LAT ? 2048 : 256, NB = LAT ? 4 : 16, NE = L / 16, NCH = L / 4, NW = LAT ? 8 : 4, ASH = LAT ? 2 : 4, MG = LAT ? 224 : 32  , UP = L + 2 * MG + 8  , GS = 514  ;
    asm volatile("" : "+v"(tid));
    const int lane = tid & 63, wave = tid >> 6, r = lane & 31, h = lane >> 5;
    const bf16* UT = (const bf16*)(a.ws + WS_UT) + (LAT ? UT_LAT : 0);
    GAS bf16* OC = (GAS bf16*)(a.ws + WS_OC);
    const float* HID = (const float*)(a.ws + WS_HID) + ((size_t)l * 2304 + (LAT ? 256 : 0)) * 64;
    LAS bf16* U = (LAS bf16*)lds; LAS bf16* X = (LAS bf16*)(lds + 20096); LAS float* FT = (LAS float*)(lds + 36480); LAS unsigned char* GC = lds + 69248;
    LAS float* W3 = (LAS float*)(lds + 135040); LAS float* RED = (LAS float*)(lds + 136064);
    for (int q = tid; q < NB * L / 8; q += 512) { const int b = q / (L / 8), off = (q % (L / 8)) * 8;
        *(LAS v4u*)(U + b * UP + MG + off) = *(const GAS v4u*)(UT + ((size_t)b * 1536 + c) * L + off);
        *(LAS v4u*)(X + b * L + off) = *(const GAS v4u*)(UT + ((size_t)b * 1536 + 512 + c) * L + off); }
    for (int q = tid; q < NB * 2 * MG / 8; q += 512) { const int b = q / (2 * MG / 8), o = q % (2 * MG / 8); const int off = (o < MG / 8) ? 8 * o : MG + L + 8 * (o - MG / 8);
        *(LAS v4u*)(U + b * UP + off) = (v4u){0u, 0u, 0u, 0u}; }
    if (tid < 256) { const int j = tid >> 2, k = tid & 3; W3[k * 64 + j] = a.in[25][((size_t)l * 64 + j) * 2048 + (k >> 1) * 1024 + (k & 1) * 512 + c]; }
    __syncthreads();
#if defined(PROBE_HY) && PROBE_HY == 1
    for (int rep = 0; rep < 2; ++rep)
#endif
    { const float dmin = -15.350567286626973f, dmax = -3.0701134573253945f;
      const float delta = fabsf(dmin + (float)c * ((dmax - dmin) / 511.f));
      float p0 = 0.f, p1 = 0.f;
      for (int t = tid; t < L; t += 512) {
          float s[4] = {0.f, 0.f, 0.f, 0.f};
#pragma unroll 4
          for (int j4 = 0; j4 < 16; ++j4) { const f32x4 hv = *(const GAS f32x4*)(HID + (size_t)t * 64 + 4 * j4);
#pragma unroll
              for (int k = 0; k < 4; ++k) s[k] += hv.x * W3[k * 64 + 4 * j4] + hv.y * W3[k * 64 + 4 * j4 + 1] + hv.z * W3[k * 64 + 4 * j4 + 2] + hv.w * W3[k * 64 + 4 * j4 + 3]; }
          const float win = __expf(-((float)t / (float)(L - 1)) * delta);
#pragma unroll
          for (int k = 0; k < 4; ++k) { s[k] *= win; FT[k * L + t] = s[k]; }
          p0 += fabsf(s[0]) + (t >= 1 ? fabsf(s[2]) : 0.f); p1 += fabsf(s[1]) + (t >= 1 ? fabsf(s[3]) : 0.f); }
      p0 = wave_sum(p0); p1 = wave_sum(p1);
      if (lane == 0) { RED[2 * wave] = p0; RED[2 * wave + 1] = p1; } }
    __syncthreads();
    const int col = 32 * wave + r, ca = col >> ASH, cbat = col & (NB - 1);
    const int a_lo = (32 * wave) >> ASH, a_hi = (32 * wave + 31) >> ASH;
    const int rowbase = LAT ? TCTX + cbat * 2048 : cbat * 256;
#pragma unroll 1
    for (int n = 0; n < 2; ++n) {
        float l1s = 0.f;
#pragma unroll
        for (int w = 0; w < 8; ++w) l1s += RED[2 * w + n];
        const float invl1 = 1.f / (l1s + EPSN);
#if defined(PROBE_HY) && PROBE_HY == 4
        for (int rep = 0; rep < 2; ++rep)
#endif
        for (int q = tid; q < 8 * NCH; q += 512) { const int k = q & 7, y = q >> 3, m0 = L - (8 * y + k);
            float v[8];
#pragma unroll
            for (int j = 0; j < 8; ++j) { const int m = m0 - j; float t = 0.f; if (m >= 0 && m < L) t = FT[n * L + m]; else if (m < 0 && m > -L) t = FT[(2 + n) * L - m]; v[j] = t * invl1; }
            *(LAS v4u*)(GC + (k * GS + y) * 16) = (v4u){cvtpk(v[0], v[1]), cvtpk(v[2], v[3]), cvtpk(v[4], v[5]), cvtpk(v[6], v[7])}; }
        __syncthreads();
        f32x16 acc, acc1;
#if defined(PROBE_HY) && PROBE_HY == 3
        for (int rep = 0; rep < 2; ++rep) {
#endif
#pragma unroll
        for (int i = 0; i < 16; ++i) { acc[i] = 0.f; acc1[i] = 0.f; }
        if (wave < NW) {
            const int lam_lo = 2 * a_lo - (NE - 1), lam_hi = 2 * a_hi;
            const int xs0 = 8 * h - r + L;
            const LAS unsigned char* ap = GC + ((xs0 & 7) * GS + (xs0 >> 3) - 2 * lam_lo) * 16;
            const LAS unsigned char* bp = (const LAS unsigned char*)(U + cbat * UP + MG + 8 * h) + 32 * (2 * ca - lam_lo);
            bf16x8 a0 = *(const LAS bf16x8*)ap, b0 = *(const LAS bf16x8*)bp, a1 = *(const LAS bf16x8*)(ap - 32), b1 = *(const LAS bf16x8*)(bp - 32);
            for (int lam = lam_lo; lam <= lam_hi; lam += 2) {
                const bool more = lam + 2 <= lam_hi;
                if (more) { ap -= 64; bp -= 64; }
                const bf16x8 na0 = *(const LAS bf16x8*)ap, na1 = *(const LAS bf16x8*)(ap - 32), nb0 = *(const LAS bf16x8*)bp, nb1 = *(const LAS bf16x8*)(bp - 32);
                acc = __builtin_amdgcn_mfma_f32_32x32x16_bf16(a0, b0, acc, 0, 0, 0);
                acc1 = __builtin_amdgcn_mfma_f32_32x32x16_bf16(a1, b1, acc1, 0, 0, 0);
                a0 = na0; a1 = na1; b0 = nb0; b1 = nb1;
            }
#pragma unroll
            for (int i = 0; i < 16; ++i) acc[i] += acc1[i];
        }
#if defined(PROBE_HY) && PROBE_HY == 3
        asm volatile("" :: "v"(acc[0]), "v"(acc[5]));
        }
#endif
        const float bias = a.in[27][((size_t)l * 2 + n) * 512 + c];
        float z[16];
        if (wave < NW) {
#pragma unroll
            for (int g4 = 0; g4 < 4; ++g4) { const int t0 = 32 * ca + 8 * g4 + 4 * h;
                const v2u uw = *(const LAS v2u*)(U + cbat * UP + MG + t0), xw = *(const LAS v2u*)(X + cbat * L + t0);
                const float uv[4] = {bflo(uw.x), bfhi(uw.x), bflo(uw.y), bfhi(uw.y)}, xv[4] = {bflo(xw.x), bfhi(xw.x), bflo(xw.y), bfhi(xw.y)};
#pragma unroll
                for (int k = 0; k < 4; ++k) z[4 * g4 + k] = xv[k] * (acc[4 * g4 + k] + bias * uv[k]); }
        }
        __syncthreads();
        if (n == 0) {
            if (wave < NW) {
#pragma unroll
                for (int g4 = 0; g4 < 4; ++g4) *(LAS v2u*)(U + cbat * UP + MG + 32 * ca + 8 * g4 + 4 * h) = (v2u){pk2(z[4 * g4], z[4 * g4 + 1]), pk2(z[4 * g4 + 2], z[4 * g4 + 3])}; }
            for (int q = tid; q < NB * L / 8; q += 512) { const int b = q / (L / 8), off = (q % (L / 8)) * 8;
                *(LAS v4u*)(X + b * L + off) = *(const GAS v4u*)(UT + ((size_t)b * 1536 + 1024 + c) * L + off); }
        } else if (wave < NW) {
#if defined(PROBE_HY) && PROBE_HY == 2
            for (int rep = 0; rep < 2; ++rep)
#endif
#pragma unroll
            for (int g4 = 0; g4 < 4; ++g4)
#pragma unroll
                for (int k = 0; k < 4; ++k) OC[(size_t)(rowbase + 32 * ca + 8 * g4 + 4 * h + k) * 512 + c] = (bf16)f2bf(z[4 * g4 + k]);
        }
    }
    __syncthreads();
}
#ifndef PHMASK
#define PHMASK 0x1fff
#endif
#define PH_ON(k) (((PHMASK) >> (k)) & 1)
#define L1_INV() do { asm volatile("s_waitcnt vmcnt(0)" ::: "memory"); __builtin_amdgcn_fence(__ATOMIC_ACQUIRE, "agent"); asm volatile("s_waitcnt vmcnt(0)" ::: "memory"); __syncthreads(); } while (0)
template <class T> __device__ __forceinline__ T* asglobal(T* p) { return (T*)(GAS T*)p; }
__global__ void __launch_bounds__(512, 2) mega_fwd(Args a) {
    extern __shared__ __attribute__((aligned(16))) unsigned char lds_raw[];
    LAS unsigned char* lds = (LAS unsigned char*)lds_raw;
    cg::grid_group grid = cg::this_grid();
    const int bid = blockIdx.x;
    using pg8::Gemm; using pg8::StaticOrder;
    const int ph_lo = a.ph_lo, ph_hi = a.ph_hi;
    volatile LAS unsigned* MISC = (volatile LAS unsigned*)(lds + LDS_BYTES - 64);
    if (threadIdx.x < 16) MISC[threadIdx.x] = 0u;
    __syncthreads();
    if (ph_hi > NPHASE) { __syncthreads(); grid.sync(); }
    XcdBarrier bar = xcd_barrier_post((unsigned*)(a.ws + WS_BAR + (size_t)a.li * BAR_REGION), MISC);
#pragma unroll 1
    for (int ph = ph_lo; ph < ph_hi; ++ph) {
        int tid = threadIdx.x; asm volatile("" : "+v"(tid));
        int G = gridDim.x; asm volatile("" : "+s"(G)); const int NGW = G * 8, NGT = G * 512;
        unsigned char* ws = a.ws; asm volatile("" : "+s"(ws));
#if defined(__HIP_DEVICE_COMPILE__)
#define ASSUME_GLOBAL(p) __builtin_assume(!__builtin_amdgcn_is_shared((const void*)(p)) && !__builtin_amdgcn_is_private((const void*)(p)))
#else
#define ASSUME_GLOBAL(p) ((void)0)
#endif
        ASSUME_GLOBAL(ws); ASSUME_GLOBAL(a.ws); ASSUME_GLOBAL(a.out);
#pragma unroll
        for (int i = 0; i < 35; ++i) ASSUME_GLOBAL(a.in[i]);
        const int lane = tid & 63, wave = __builtin_amdgcn_readfirstlane(tid >> 6), gw = bid * 8 + wave, gt = bid * 512 + tid;
        const int l = (ph >= 1 && ph < 23) ? (ph - 1) / 11 : 0, sub = (ph >= 1 && ph < 23) ? (ph - 1) % 11 : -1;
        float* mod = (float*)(ws + WS_MOD) + (size_t)l * 5 * 6144;
        if (PH_ON(11) && ph == 0) { p0_mod_hid(a, lds, bid, G, tid, gw, NGW, lane); wconv_phase(a, 0, lds, gw, NGW, gt, NGT, wave, lane); }
        else if (PH_ON(12) && ph == 23) { norm_phase(a, 0, 2, false, gw, NGW, lane); }
        else if (PH_ON(0) && sub == 0) { if (l == 1) wconv_phase(a, 1, lds, gw, NGW, gt, NGT, wave, lane); norm_phase(a, l, 0, l == 0, gw, NGW, lane); }
        else if (PH_ON(1) && sub == 1) {
            Gemm g{(const bf16*)(ws + WS_HBF), (const bf16*)(ws + WS_WIN), TT, 3072, 1024, 1024, 1024}; StaticOrder S; S.init(TT, 3072, G, bid);
            pg8::EpiSeg E{(bf16*)(ws + WS_QA), (bf16*)(ws + WS_KVR), (bf16*)(ws + WS_CQ), (bf16*)(ws + WS_CKVR), (bf16*)(ws + WS_HYR)};
            pg8::gemm_phase<pg8::EpiSeg, StaticOrder, true, true>(lds, g, S, E);
        }
        else if (PH_ON(2) && sub == 2) { post_phase(a, l, lds, bid, G, tid, gw, NGW, gt, NGT, lane); }
        else if (PH_ON(3) && sub == 3) {
#pragma unroll 1
            for (int q = 0; q < 3; ++q) {
                Gemm g; StaticOrder S; pg8::EpiStore<0> E;
                if (q == 0) { g = Gemm{(const bf16*)(ws + WS_CQ), (const bf16*)(ws + WS_WUQ), TT, 768, 384, 512, 384}; S.init(TT, 768, G, bid); E = pg8::EpiStore<0>{(bf16*)(ws + WS_QB), 768}; }
                else if (q == 1) { g = Gemm{(const bf16*)(ws + WS_CKVALL), (const bf16*)(ws + WS_WKN), NKEYROWS, 512, 256, 256, 256}; S.init(NKEYROWS, 512, G, (bid + G - 144 % G) % G); E = pg8::EpiStore<0>{(bf16*)(ws + WS_KNB), 512}; }
                else { g = Gemm{(const bf16*)(ws + WS_WVV), (const bf16*)(ws + WS_CKVALL), 512, NKEYROWS, 256, 256, 256}; S.init(512, NKEYROWS, G, (bid + G - 248 % G) % G); E = pg8::EpiStore<0>{(bf16*)(ws + WS_VTB), NKEYROWS}; }
                pg8::gemm_phase<pg8::EpiStore<0>, StaticOrder, true, true>(lds, g, S, E);
            }
        }
        else if (PH_ON(4) && sub == 4) {
            const bf16 *QA = (const bf16*)(ws + WS_QA), *QB = (const bf16*)(ws + WS_QB), *KA = (const bf16*)(ws + WS_KA), *VTA = (const bf16*)(ws + WS_VTA);
            const bf16 *KNB = (const bf16*)(ws + WS_KNB), *VTB = (const bf16*)(ws + WS_VTB), *KPE = (const bf16*)(ws + WS_KPEALL);
            bf16 *OA = (bf16*)(ws + WS_OA), *OB = (bf16*)(ws + WS_OB);
            const float slA = 0.125f * 1.4426950408889634f, slB = 0.10206207261596575f * 1.4426950408889634f;
            const int sel = a.pad;
            for (int it = bid; it < 1792; it += G) {
                { const bool is_hy = (it >= 512 && it < 1024) || it >= 1280; if ((sel == 1 && is_hy) || (sel == 2 && !is_hy)) continue; }
                if (it < 256 || (it >= 1024 && it < 1152)) {
                    const bool lat = it < 256; const int u = lat ? (G == 256 ? ((bid & 7) * 4 + (bid >> 6)) * 8 + ((bid >> 3) & 7) : it) : it - 1024;
                    const int b = lat ? u >> 6 : u >> 3, hh = lat ? (u >> 3) & 7 : u & 7, qb = lat ? u & 7 : 0;
                    const int row0 = lat ? TCTX + b * 2048 + qb * 256 : b * 256, key0 = lat ? TCTX + b * 2304 : b * 256;
                    attn_unit<96>(lds, tid, QB + (size_t)row0 * 768 + hh * 96, 768, KNB + (size_t)key0 * 512 + hh * 64, 512, KPE + (size_t)key0 * 32, VTB + (size_t)(hh * 64) * NKEYROWS + key0, NKEYROWS,
                                  lat ? 2304 : 256, OB + (size_t)row0 * 512 + hh * 64, 512, slB, lat, qb * 256);
                } else if (it < 512 || (it >= 1152 && it < 1280)) {
                    const bool lat = it < 512; const int u = lat ? (G == 256 ? ((bid & 7) * 4 + (bid >> 6)) * 8 + ((bid >> 3) & 7) : it - 256) : it - 1152;
                    const int b = lat ? u >> 6 : u >> 3, hh = lat ? (u >> 3) & 7 : u & 7, qb = lat ? u & 7 : 0, kvh = hh >> 2;
                    const int row0 = lat ? TCTX + b * 2048 + qb * 256 : b * 256, nk = lat ? 2304 : 256;
                    const size_t kbase = lat ? (size_t)KA_LAT + (size_t)(b * 2 + kvh) * 2304 * 64 : (size_t)(b * 2 + kvh) * 256 * 64;
                    attn_unit<64>(lds, tid, QA + (size_t)row0 * 512 + hh * 64, 512, KA + kbase, 64, nullptr, VTA + kbase, nk, nk, OA + (size_t)row0 * 512 + hh * 64, 512, slA, false, 0);
                } else if (it < 1024) { hyena_unit<true>(a, l, it - 512, lds, tid); }
                else { hyena_unit<false>(a, l, it - 1280, lds, tid); }
            }
        }
        else if (PH_ON(5) && sub == 5) {
            static_assert(WS_S1 == WS_S0 + 72 * MiB && WS_S2 == WS_S0 + 96 * MiB, "gate buffer arithmetic");
            bf16 *S0 = (bf16*)(ws + WS_S0), *MBF = (bf16*)(ws + WS_MBF);
            { Gemm g{(const bf16*)(ws + WS_HBF), (const bf16*)(ws + WS_WG), TT, 3072, 1024, 1024, 1024}; StaticOrder S; S.init(TT, 3072, G, bid);
              pg8::EpiGate E{S0}; pg8::gemm_phase<pg8::EpiGate, StaticOrder, true, true>(lds, g, S, E); }
            xcd_barrier(bar);
#pragma unroll 1
            for (int n = 0; n < 3; ++n) {
                Gemm g{(const bf16*)(ws + WS_OA) + (size_t)n * TT * 512, (const bf16*)(ws + WS_WB) + (size_t)n * 1024 * 512, TT, 1024, 512, 512, 512}; StaticOrder S; S.init(TT, 1024, G, bid);
                pg8::EpiMerge E{(const bf16*)(ws + WS_S0 + (size_t)n * (72u << 20) - (size_t)(n >> 1) * (48u << 20)), MBF, n}; pg8::gemm_phase<pg8::EpiMerge, StaticOrder, true, true>(lds, g, S, E);
            }
        }
        else if (PH_ON(6) && sub == 6) {
            Gemm g{(const bf16*)(ws + WS_MBF), (const bf16*)(ws + WS_WO), TT, 1024, 1024, 1024, 1024}; StaticOrder S; S.init(TT, 1024, G, bid);
            pg8::EpiResid E{a.out, mod + 2048}; pg8::gemm_phase<pg8::EpiResid, StaticOrder, true, true>(lds, g, S, E);
        }
        else if (PH_ON(7) && sub == 7) { norm_phase(a, l, 1, false, gw, NGW, lane); }
        else if (PH_ON(8) && sub == 8) {
            Gemm g{(const bf16*)(ws + WS_HBF), (const bf16*)(ws + WS_WUP), TT, 5632, 1024, 1024, 1024}; StaticOrder S; S.init(TT, 5632, G, bid);
            pg8::EpiStore<0> E{(bf16*)(ws + WS_U), 5632}; pg8::gemm_phase<pg8::EpiStore<0>, StaticOrder, true, true>(lds, g, S, E);
        }
        else if (PH_ON(9) && sub == 9) { ffnconv_phase(a, l, gt, NGT); }
        else if (PH_ON(10) && sub == 10) {
            Gemm g{(const bf16*)(ws + WS_ACT), (const bf16*)(ws + WS_WDN), TT, 1024, 2816, 2816, 2816}; StaticOrder S; S.init(TT, 1024, G, bid);
            pg8::EpiResid E{a.out, mod + 5120}; pg8::gemm_phase<pg8::EpiResid, StaticOrder, true, true>(lds, g, S, E);
        }
#ifdef EXTRA_SYNCS
        for (int q = 0; q < EXTRA_SYNCS; ++q) { __syncthreads(); grid.sync(); }
#endif
        if (ph + 1 < ph_hi) xcd_barrier(bar);
    }
}

extern "C" void kernel_launch(void* const* d_in, const int* in_sizes, int n_in, void* d_out, int out_size, void* d_ws, size_t ws_size, hipStream_t stream) {
    static int grid = 0;
    if (grid == 0) {
        if (n_in != 35 || ws_size < WS_END) { fprintf(stderr, "kernel_launch: unexpected n_in %d / ws %zu\n", n_in, ws_size); grid = -1; return; }
        int dev = 0, cus = 0, per_cu = 0;
        if (hipGetDevice(&dev) != hipSuccess || hipDeviceGetAttribute(&cus, hipDeviceAttributeMultiprocessorCount, dev) != hipSuccess) { grid = -1; return; }
        if (hipFuncSetAttribute((const void*)mega_fwd, hipFuncAttributeMaxDynamicSharedMemorySize, LDS_BYTES) != hipSuccess) { fprintf(stderr, "kernel_launch: hipFuncSetAttribute failed\n"); grid = -1; return; }
        if (hipOccupancyMaxActiveBlocksPerMultiprocessor(&per_cu, (const void*)mega_fwd, 512, LDS_BYTES) != hipSuccess || per_cu < 1) { fprintf(stderr, "kernel_launch: occupancy query says %d\n", per_cu); per_cu = 1; }
        (void)hipGetLastError();
        grid = cus;
    }
    if (grid < 0) return;
    if (hipMemsetAsync((char*)d_ws + WS_MOD, 0, ZERO_BYTES, stream) != hipSuccess) { fprintf(stderr, "kernel_launch: memset failed\n"); return; }
    Args a{};
    for (int i = 0; i < 35; ++i) a.in[i] = (const float*)d_in[i];
    a.out = (float*)d_out; a.ws = (unsigned char*)d_ws;
#if defined(MK_PER_PHASE)
    for (int p = 0; p < NPHASE; ++p) { a.ph_lo = p; a.ph_hi = p + 1; a.li = 0; void* args[] = {&a};
        hipError_t e = hipLaunchCooperativeKernel((const void*)mega_fwd, dim3(grid), dim3(512), args, LDS_BYTES, stream);
        if (e != hipSuccess) { fprintf(stderr, "launch %d failed: %s\n", p, hipGetErrorString(e)); break; } }
#else
#if defined(PROBE_SUB)
#ifndef PROBE_SEL
#define PROBE_SEL 0
#endif
    { const int k0 = 1 + PROBE_SUB, k1 = 12 + PROBE_SUB; const int cuts[6][2] = {{0, k0 + 1}, {k0, k0 + 1}, {k0 + 1, k1 + 1}, {k1, k1 + 1}, {k1 + 1, NPHASE}, {0, 0}};
      for (int c = 0; c < 5; ++c) { a.ph_lo = cuts[c][0]; a.ph_hi = cuts[c][1]; a.li = c; a.pad = (c == 1 || c == 3) ? PROBE_SEL : 0; if (a.ph_lo >= a.ph_hi) continue; void* args[] = {&a};
          hipError_t e = hipLaunchCooperativeKernel((const void*)mega_fwd, dim3(grid), dim3(512), args, LDS_BYTES, stream);
          if (e != hipSuccess) { fprintf(stderr, "cooperative launch failed: %s\n", hipGetErrorString(e)); break; } } }
#elif defined(PROBE_CUTS)
    { const int k0 = 1 + PROBE_CUTS, k1 = 12 + PROBE_CUTS; const int cuts[4][2] = {{0, k0 + 1}, {k0 + 1, k1 + 1}, {k1 + 1, NPHASE}, {0, 0}};
      for (int c = 0; c < 3; ++c) { a.ph_lo = cuts[c][0]; a.ph_hi = cuts[c][1]; a.li = c; if (a.ph_lo >= a.ph_hi) continue; void* args[] = {&a};
          hipError_t e = hipLaunchCooperativeKernel((const void*)mega_fwd, dim3(grid), dim3(512), args, LDS_BYTES, stream);
          if (e != hipSuccess) { fprintf(stderr, "cooperative launch failed: %s\n", hipGetErrorString(e)); break; } } }
#else
    a.ph_lo = 0; a.ph_hi = NPHASE; void* args[] = {&a};
    hipError_t e = hipLaunchCooperativeKernel((const void*)mega_fwd, dim3(grid), dim3(512), args, LDS_BYTES, stream);
    if (e != hipSuccess) fprintf(stderr, "cooperative launch failed: %s (grid %d)\n", hipGetErrorString(e), grid);
#endif
#endif
}
```

```cpp
#include <hip/hip_runtime.h>
#include <hip/hip_cooperative_groups.h>
#include <cstdio>
#include <cstdint>
namespace cg = cooperative_groups;
namespace pg8 {
#define PG8_LAS __attribute__((address_space(3)))
typedef unsigned short bf16_t;
typedef short bf16x8 __attribute__((ext_vector_type(8)));
typedef float f32x4 __attribute__((ext_vector_type(4)));
typedef unsigned u32x4 __attribute__((ext_vector_type(4)));
constexpr int BM = 256, BK = 64, HALF = 128, HTB = HALF * BK * 2  , STAGE_BYTES = 8 * HTB, NXCD = 8, WGM = 8;

__host__ __device__ __forceinline__ int lds_byte(int r, int c) { const int st = (r >> 4) * 2 + (c >> 5), rr = r & 15, cc = c & 31, ob = rr * 64 + cc * 2; return st * 1024 + (ob ^ (((ob >> 9) & 1) << 5)); }
__host__ __device__ __forceinline__ void stage_rc(int b, int& R, int& C) { const int st = b / 1024, sb = b % 1024, swz = sb ^ (((sb >> 9) & 1) << 5); R = (st >> 1) * 16 + swz / 64; C = (st & 1) * 32 + (swz % 64) / 2; }
__host__ __device__ __forceinline__ int perm32(int rho) { const int n = rho >> 4, i = rho & 15; return 8 * (i >> 2) + 4 * n + (i & 3); }

struct Unit { int pm, pn, gi; };
struct Gemm { const bf16_t* A; const bf16_t* Bt; int M, N, K, lda, ldb; size_t gsA, gsB; };

struct StaticOrder {
    int nM, nN, nwg, G, c;
    __host__ __device__ void init(int M, int N, int G_, int c_) { nM = M / BM; nN = N / BM; nwg = nM * nN; G = G_; c = c_; }
    __host__ __device__ bool next(int i, Unit& u) const {
        const long L = (long)i * G + c; if (L >= nwg) return false;
        int wgid = (int)L; { const int q = nwg / NXCD, r = nwg % NXCD, xcd = wgid % NXCD, off = wgid / NXCD; wgid = (xcd < r ? xcd * (q + 1) : r * (q + 1) + (xcd - r) * q) + off; }
        const int nig = WGM * nN, gid = wgid / nig, fm = gid * WGM, gsz = (nM - fm) < WGM ? (nM - fm) : WGM;
        u.pm = fm + ((wgid % nig) % gsz); u.pn = (wgid % nig) / gsz; u.gi = 0; return true;
    }
    __device__ __forceinline__ void a_ready(const Unit&) const {}
    __device__ __forceinline__ void done(const Unit&) const {}
};
template <int NB> struct BatchOrder : StaticOrder {
    __host__ __device__ bool next(int i, Unit& u) const { if (i >= NB) return false; if (!StaticOrder::next(0, u)) return false; u.gi = i; return true; }
};


#ifndef GAS
#define GAS __attribute__((address_space(1)))
#endif
typedef float f32x2v __attribute__((ext_vector_type(2)));
typedef __bf16 bf16x2v __attribute__((ext_vector_type(2)));
__device__ __forceinline__ unsigned cvt_pk_bf16(float lo, float hi) { const f32x2v v = {lo, hi}; const bf16x2v b = __builtin_convertvector(v, bf16x2v); return __builtin_bit_cast(unsigned, b); }
__device__ __forceinline__ float sigm(float x) { return __builtin_amdgcn_rcpf(1.f + __expf(-x)); }
#define EPI_FOR _Pragma("unroll") for (int ai = 0; ai < 2; ++ai) _Pragma("unroll") for (int m = 0; m < 4; ++m) _Pragma("unroll") for (int bj = 0; bj < 2; ++bj)

template <int ACT  > struct EpiStore {
    static constexpr bool PERM = true, AFTER_DRAIN = false;
    bf16_t* O; int ld;
    __device__ __forceinline__ void operator()(const f32x4 (&acc)[2][2][4][2], const Unit& u, int wr, int wc, int fr, int fq) const {
        const int row0 = u.pm * BM + wr * 64 + fr, col0 = u.pn * BM + wc * 32 + 8 * fq;
        EPI_FOR { f32x4 v0 = acc[ai][bj][m][0], v1 = acc[ai][bj][m][1];
            if (ACT == 1) { v0 = (f32x4){sigm(v0[0]), sigm(v0[1]), sigm(v0[2]), sigm(v0[3])}; v1 = (f32x4){sigm(v1[0]), sigm(v1[1]), sigm(v1[2]), sigm(v1[3])}; }
            u32x4 w; w.x = cvt_pk_bf16(v0[0], v0[1]); w.y = cvt_pk_bf16(v0[2], v0[3]); w.z = cvt_pk_bf16(v1[0], v1[1]); w.w = cvt_pk_bf16(v1[2], v1[3]);
            *(GAS u32x4*)(O + (size_t)(row0 + ai * HALF + m * 16) * ld + col0 + bj * HALF) = w; }
    }
};
struct EpiSeg {
    static constexpr bool PERM = true, AFTER_DRAIN = false;
    bf16_t *QA, *KV, *CQ, *CKV, *HY;
    __device__ __forceinline__ void operator()(const f32x4 (&acc)[2][2][4][2], const Unit& u, int wr, int wc, int fr, int fq) const {
        bf16_t* base; int ld, coff; const int pn = u.pn;
        if (pn < 2) { base = QA; ld = 512; coff = 256 * pn; } else if (pn == 2) { base = KV; ld = 256; coff = 0; } else if (pn < 5) { base = CQ; ld = 512; coff = 256 * (pn - 3); }
        else if (pn == 5) { base = CKV; ld = 256; coff = 0; } else { base = HY; ld = 1536; coff = 256 * (pn - 6); }
        const int row0 = u.pm * BM + wr * 64 + fr, col0 = coff + wc * 32 + 8 * fq;
        EPI_FOR { const f32x4 v0 = acc[ai][bj][m][0], v1 = acc[ai][bj][m][1];
            u32x4 w; w.x = cvt_pk_bf16(v0[0], v0[1]); w.y = cvt_pk_bf16(v0[2], v0[3]); w.z = cvt_pk_bf16(v1[0], v1[1]); w.w = cvt_pk_bf16(v1[2], v1[3]);
            *(GAS u32x4*)(base + (size_t)(row0 + ai * HALF + m * 16) * ld + col0 + bj * HALF) = w; }
    }
};
struct EpiGate {
    static constexpr bool PERM = true, AFTER_DRAIN = false;
    bf16_t* S0;
    __device__ __forceinline__ void operator()(const f32x4 (&acc)[2][2][4][2], const Unit& u, int wr, int wc, int fr, int fq) const {
        const int n = u.pn >> 2; bf16_t* base = (bf16_t*)((unsigned char*)S0 + (size_t)n * (72u << 20) - (size_t)(n >> 1) * (48u << 20));
        const int row0 = u.pm * BM + wr * 64 + fr, col0 = (u.pn & 3) * BM + wc * 32 + 8 * fq;
        EPI_FOR { f32x4 v0 = acc[ai][bj][m][0], v1 = acc[ai][bj][m][1];
            v0 = (f32x4){sigm(v0[0]), sigm(v0[1]), sigm(v0[2]), sigm(v0[3])}; v1 = (f32x4){sigm(v1[0]), sigm(v1[1]), sigm(v1[2]), sigm(v1[3])};
            u32x4 w; w.x = cvt_pk_bf16(v0[0], v0[1]); w.y = cvt_pk_bf16(v0[2], v0[3]); w.z = cvt_pk_bf16(v1[0], v1[1]); w.w = cvt_pk_bf16(v1[2], v1[3]);
            *(GAS u32x4*)(base + (size_t)(row0 + ai * HALF + m * 16) * 1024 + col0 + bj * HALF) = w; }
    }
};
struct EpiMerge {
    static constexpr bool PERM = true, AFTER_DRAIN = false;
    const bf16_t* S0; bf16_t* M;
    __device__ __forceinline__ void operator()(const f32x4 (&acc)[2][2][4][2], const Unit& u, int wr, int wc, int fr, int fq) const {
        const int row0 = u.pm * BM + wr * 64 + fr, col0 = u.pn * BM + wc * 32 + 8 * fq;
        const int MODE = u.gi; const bf16_t* S = (const bf16_t*)((const unsigned char*)S0 + (size_t)u.gi * (72u << 20) - (size_t)(u.gi >> 1) * (48u << 20));
        EPI_FOR { const size_t off = (size_t)(row0 + ai * HALF + m * 16) * 1024 + col0 + bj * HALF;
            const u32x4 sw = *(const GAS u32x4*)(S + off);
            f32x4 s0 = (f32x4){__uint_as_float(sw.x << 16), __uint_as_float(sw.x & 0xffff0000u), __uint_as_float(sw.y << 16), __uint_as_float(sw.y & 0xffff0000u)};
            f32x4 s1 = (f32x4){__uint_as_float(sw.z << 16), __uint_as_float(sw.z & 0xffff0000u), __uint_as_float(sw.w << 16), __uint_as_float(sw.w & 0xffff0000u)};
            f32x4 v0 = acc[ai][bj][m][0] * s0, v1 = acc[ai][bj][m][1] * s1;
            if (MODE >= 1) { const u32x4 mw = *(const GAS u32x4*)(M + off);
                v0 = v0 + (f32x4){__uint_as_float(mw.x << 16), __uint_as_float(mw.x & 0xffff0000u), __uint_as_float(mw.y << 16), __uint_as_float(mw.y & 0xffff0000u)};
                v1 = v1 + (f32x4){__uint_as_float(mw.z << 16), __uint_as_float(mw.z & 0xffff0000u), __uint_as_float(mw.w << 16), __uint_as_float(mw.w & 0xffff0000u)}; }
            u32x4 w; w.x = cvt_pk_bf16(v0[0], v0[1]); w.y = cvt_pk_bf16(v0[2], v0[3]); w.z = cvt_pk_bf16(v1[0], v1[1]); w.w = cvt_pk_bf16(v1[2], v1[3]); *(GAS u32x4*)(M + off) = w; }
    }
};
struct EpiResid {
    static constexpr bool PERM = true, AFTER_DRAIN = false;
    float* X; const float* gate;
    __device__ __forceinline__ void operator()(const f32x4 (&acc)[2][2][4][2], const Unit& u, int wr, int wc, int fr, int fq) const {
        const int row0 = u.pm * BM + wr * 64 + fr, col0 = u.pn * BM + wc * 32 + 8 * fq;
        const int mrow = (u.pm < 16) ? 0 : 1 + ((u.pm - 16) >> 3);
        const float* gp = gate + (size_t)mrow * 6144 + col0;
        f32x4 g[2][2];
#pragma unroll
        for (int bj = 0; bj < 2; ++bj) { g[bj][0] = *(const GAS f32x4*)(gp + bj * HALF); g[bj][1] = *(const GAS f32x4*)(gp + bj * HALF + 4); }
        EPI_FOR { float* xp = X + (size_t)(row0 + ai * HALF + m * 16) * 1024 + col0 + bj * HALF;
            const f32x4 x0 = *(const GAS f32x4*)xp, x1 = *(const GAS f32x4*)(xp + 4);
            *(GAS f32x4*)xp = x0 + g[bj][0] * acc[ai][bj][m][0]; *(GAS f32x4*)(xp + 4) = x1 + g[bj][1] * acc[ai][bj][m][1]; }
    }
};

template <class Epi, class Sched, bool ALIGN_EPI = false, bool SP2 = false>
__device__ __forceinline__ void gemm_phase(PG8_LAS unsigned char* lds, const Gemm g, const Sched& S, const Epi& E) {
    int tid_l = threadIdx.x; asm volatile("" : "+v"(tid_l));
    const int tid = tid_l, wid = __builtin_amdgcn_readfirstlane(tid >> 6), lane = tid & 63, wr = wid >> 2, wc = wid & 3, fr = lane & 15, fq = lane >> 4;
    const int K = g.K, nt = K / BK;
    unsigned voffA[2], voffB[2];
#pragma unroll
    for (int i = 0; i < 2; ++i) { int R, C; stage_rc(tid * 16 + i * 8192, R, C); const int Rb = Epi::PERM ? ((R & ~31) + perm32(R & 31)) : R;
        voffA[i] = (unsigned)(R * g.lda + C) * 2u; voffB[i] = (unsigned)(Rb * g.ldb + C) * 2u; }
    const size_t kstep = (size_t)(BK * 2);
    const size_t hstepA = (size_t)HALF * g.lda * 2, hstepB = (size_t)HALF * g.ldb * 2;
    const size_t tstepA = 2 * hstepA, tstepB = 2 * hstepB;
    const unsigned ldsw = (unsigned)wid * 1024u;
    const int aoff = lds_byte(wr * 64 + fr, fq * 8), boff = lds_byte(wc * 32 + fr, fq * 8);
#define PG8_SA(b, h) (((b) * 2 + (h)) * HTB)
#define PG8_SB(b, h) ((4 + (b) * 2 + (h)) * HTB)
#define PG8_STAGE(bufoff, gbase, voff) do { _Pragma("unroll") for (int _i = 0; _i < 2; ++_i) \
        __builtin_amdgcn_global_load_lds((const unsigned*)((const char*)(gbase) + (voff)[_i]), (PG8_LAS unsigned*)(lds + (bufoff) + ldsw + _i * 8192), 16, 0, 0); } while (0)
#define PG8_LDA(dst, b, h) do { _Pragma("unroll") for (int m = 0; m < 4; ++m) _Pragma("unroll") for (int k = 0; k < 2; ++k) dst[m][k] = *(const PG8_LAS bf16x8*)(lds + PG8_SA(b, h) + aoff + m * 2048 + k * 1024); } while (0)
#define PG8_LDB(dst, b, h) do { _Pragma("unroll") for (int n = 0; n < 2; ++n) _Pragma("unroll") for (int k = 0; k < 2; ++k) dst[n][k] = *(const PG8_LAS bf16x8*)(lds + PG8_SB(b, h) + boff + n * 2048 + k * 1024); } while (0)
#define PG8_MMA(ai, bj, At, Bt) do { __builtin_amdgcn_s_setprio(1); _Pragma("unroll") for (int m = 0; m < 4; ++m) _Pragma("unroll") for (int n = 0; n < 2; ++n) _Pragma("unroll") for (int k = 0; k < 2; ++k) \
        acc[ai][bj][m][n] = __builtin_amdgcn_mfma_f32_16x16x32_bf16(Bt[n][k], At[m][k], acc[ai][bj][m][n], 0, 0, 0); __builtin_amdgcn_s_setprio(0); } while (0)
#define PG8_WAIT_V(n) asm volatile("s_waitcnt vmcnt(" #n ")" ::: "memory")
#define PG8_WAIT_L(n) asm volatile("s_waitcnt lgkmcnt(" #n ")" ::: "memory")
#define PG8_BAR __builtin_amdgcn_s_barrier()
#define PG8_SCHED __builtin_amdgcn_sched_barrier(0)
    Unit cur, nxt; int ui = 0;
    if (!S.next(0, cur)) return;
    f32x4 acc[2][2][4][2];
#pragma unroll
    for (int a = 0; a < 2; ++a)
#pragma unroll
        for (int b = 0; b < 2; ++b)
#pragma unroll
            for (int m = 0; m < 4; ++m)
#pragma unroll
                for (int n = 0; n < 2; ++n) acc[a][b][m][n] = (f32x4){0.f, 0.f, 0.f, 0.f};
    bf16x8 At[4][2], B0[2][2], B1[2][2];
    const char* cA = (const char*)g.A + (size_t)cur.gi * g.gsA + (size_t)cur.pm * tstepA; const char* cB = (const char*)g.Bt + (size_t)cur.gi * g.gsB + (size_t)cur.pn * tstepB;
    S.a_ready(cur);
    if constexpr (SP2) {
        PG8_STAGE(PG8_SB(0, 0), cB, voffB); PG8_STAGE(PG8_SB(0, 1), cB + hstepB, voffB); PG8_STAGE(PG8_SA(0, 0), cA, voffA); PG8_STAGE(PG8_SA(0, 1), cA + hstepA, voffA);
        if (wr == 1) PG8_BAR;
        PG8_WAIT_V(2); PG8_BAR;
        PG8_STAGE(PG8_SB(1, 0), cB + kstep, voffB); PG8_STAGE(PG8_SA(1, 0), cA + kstep, voffA); PG8_STAGE(PG8_SB(1, 1), cB + hstepB + kstep, voffB);
        PG8_WAIT_V(6); PG8_BAR;
    } else {
        PG8_STAGE(PG8_SB(0, 0), cB, voffB); PG8_STAGE(PG8_SA(0, 0), cA, voffA); PG8_STAGE(PG8_SB(0, 1), cB + hstepB, voffB); PG8_STAGE(PG8_SA(0, 1), cA + hstepA, voffA);
        if (wr == 1) PG8_BAR;
        PG8_WAIT_V(4); PG8_BAR;
        PG8_STAGE(PG8_SB(1, 0), cB + kstep, voffB); PG8_STAGE(PG8_SA(1, 0), cA + kstep, voffA); PG8_STAGE(PG8_SB(1, 1), cB + hstepB + kstep, voffB);
        PG8_WAIT_V(6); PG8_BAR;
    }
    for (;;) {
        const bool has_next = S.next(ui + 1, nxt);
        const char* nA = has_next ? (const char*)g.A + (size_t)nxt.gi * g.gsA + (size_t)nxt.pm * tstepA : cA; const char* nB = has_next ? (const char*)g.Bt + (size_t)nxt.gi * g.gsB + (size_t)nxt.pn * tstepB : cB;
        for (int t = 0; t < nt; t += 2) {
            const bool last = (t == nt - 2);
            const char* a1 = cA + (size_t)(t + 1) * kstep;
            const char* a2 = last ? nA : cA + (size_t)(t + 2) * kstep; const char* b2 = last ? nB : cB + (size_t)(t + 2) * kstep;
            const char* a3 = a2 + kstep; const char* b3 = b2 + kstep;
            if (last && has_next) S.a_ready(nxt);
            if constexpr (SP2) {
            PG8_LDB(B0, 0, 0); PG8_LDB(B1, 0, 1); PG8_SCHED; PG8_LDA(At, 0, 0); PG8_STAGE(PG8_SA(1, 1), a1 + hstepA, voffA);
            PG8_WAIT_V(8); PG8_WAIT_L(0); PG8_BAR; PG8_MMA(0, 0, At, B0); PG8_MMA(0, 1, At, B1); PG8_BAR; PG8_SCHED;
            PG8_LDA(At, 0, 1); PG8_STAGE(PG8_SB(0, 0), b2, voffB); PG8_STAGE(PG8_SB(0, 1), b2 + hstepB, voffB); PG8_STAGE(PG8_SA(0, 0), a2, voffA);
            PG8_WAIT_V(8); PG8_WAIT_L(0); PG8_BAR; PG8_MMA(1, 0, At, B0); PG8_MMA(1, 1, At, B1); PG8_BAR; PG8_SCHED;
            PG8_LDB(B0, 1, 0); PG8_LDB(B1, 1, 1); PG8_SCHED; PG8_LDA(At, 1, 0); PG8_STAGE(PG8_SA(0, 1), a2 + hstepA, voffA);
            PG8_WAIT_V(8); PG8_WAIT_L(0); PG8_BAR; PG8_MMA(0, 0, At, B0); PG8_MMA(0, 1, At, B1); PG8_BAR; PG8_SCHED;
            PG8_LDA(At, 1, 1); PG8_STAGE(PG8_SB(1, 0), b3, voffB); PG8_STAGE(PG8_SB(1, 1), b3 + hstepB, voffB); PG8_STAGE(PG8_SA(1, 0), a3, voffA);
            PG8_WAIT_V(8); PG8_WAIT_L(0); PG8_BAR; PG8_MMA(1, 0, At, B0); PG8_MMA(1, 1, At, B1); PG8_BAR; PG8_SCHED;
            } else {
            PG8_LDB(B0, 0, 0); PG8_SCHED; PG8_LDA(At, 0, 0); PG8_STAGE(PG8_SA(1, 1), a1 + hstepA, voffA);
            PG8_WAIT_L(8); PG8_BAR; PG8_WAIT_L(0); PG8_MMA(0, 0, At, B0); PG8_BAR; PG8_SCHED;
            PG8_LDB(B1, 0, 1); PG8_STAGE(PG8_SB(0, 0), b2, voffB);
            PG8_BAR; PG8_WAIT_L(0); PG8_MMA(0, 1, At, B1); PG8_BAR;
            PG8_LDA(At, 0, 1); PG8_STAGE(PG8_SA(0, 0), a2, voffA);
            PG8_BAR; PG8_WAIT_L(0); PG8_MMA(1, 0, At, B0); PG8_BAR; PG8_SCHED;
            PG8_STAGE(PG8_SB(0, 1), b2 + hstepB, voffB);
            PG8_WAIT_V(6); PG8_BAR; PG8_MMA(1, 1, At, B1); PG8_BAR;
            PG8_LDB(B0, 1, 0); PG8_SCHED; PG8_LDA(At, 1, 0); PG8_STAGE(PG8_SA(0, 1), a2 + hstepA, voffA);
            PG8_WAIT_L(8); PG8_BAR; PG8_WAIT_L(0); PG8_MMA(0, 0, At, B0); PG8_BAR; PG8_SCHED;
            PG8_LDB(B1, 1, 1); PG8_STAGE(PG8_SB(1, 0), b3, voffB);
            PG8_BAR; PG8_WAIT_L(0); PG8_MMA(0, 1, At, B1); PG8_BAR;
            PG8_LDA(At, 1, 1); PG8_STAGE(PG8_SA(1, 0), a3, voffA);
            PG8_BAR; PG8_WAIT_L(0); PG8_MMA(1, 0, At, B0); PG8_BAR; PG8_SCHED;
            PG8_STAGE(PG8_SB(1, 1), b3 + hstepB, voffB);
            PG8_WAIT_V(6); PG8_BAR; PG8_MMA(1, 1, At, B1); PG8_BAR;
            }
        }
        if constexpr (ALIGN_EPI) { if (wr == 0) PG8_BAR; }
        if constexpr (!Epi::AFTER_DRAIN) { E(acc, cur, wr, wc, fr, fq); S.done(cur); }
        if (!has_next) break;
#pragma unroll
        for (int a = 0; a < 2; ++a)
#pragma unroll
            for (int b = 0; b < 2; ++b)
#pragma unroll
                for (int m = 0; m < 4; ++m)
#pragma unroll
                    for (int n = 0; n < 2; ++n) acc[a][b][m][n] = (f32x4){0.f, 0.f, 0.f, 0.f};
        cur = nxt; cA = nA; cB = nB; ++ui;
        if constexpr (ALIGN_EPI) { if (wr == 1) PG8_BAR; }
    }
    PG8_WAIT_V(0);
    if constexpr (!ALIGN_EPI) { if (wr == 0) PG8_BAR; }
    PG8_BAR;
    if constexpr (Epi::AFTER_DRAIN) { E.fused(acc, cur, wr, wc, fr, fq, lds, wid, lane); S.done(cur); }
#undef PG8_SA
#undef PG8_SB
#undef PG8_STAGE
#undef PG8_LDA
#undef PG8_LDB
#undef PG8_MMA
#undef PG8_WAIT_V
#undef PG8_WAIT_L
#undef PG8_BAR
#undef PG8_SCHED
}
}

constexpr int TCTX = 4096, TLAT = 8192, TT = 12288, DM = 1024, NKEYROWS = 13312;
constexpr float EPSN = 1e-6f;
constexpr size_t MiB = 1u << 20;
constexpr size_t WS_MOD = 0, MOD_BYTES = 2 * 5 * 6144 * 4, WS_BAR = 262144, BAR_REGION = 16384, ZERO_BYTES = WS_BAR + 5 * BAR_REGION;
constexpr size_t WS_HID = 1 * MiB;
constexpr size_t WS_WIN = 3 * MiB, WS_WG = 9 * MiB, WS_WUQ = 15 * MiB, WS_WKN = 16 * MiB, WS_WVV = 16 * MiB + 262144, WS_WB = 17 * MiB, WS_WO = 20 * MiB, WS_WUP = 22 * MiB, WS_WDN = 33 * MiB;
constexpr size_t WS_U = 39 * MiB, WS_ACT = 171 * MiB, WS_HBF = 171 * MiB;
constexpr size_t WS_QA = 39 * MiB, WS_KVR = 51 * MiB, WS_CQ = 57 * MiB, WS_CKVR = 69 * MiB, WS_HYR = 75 * MiB, WS_OA = 75 * MiB, WS_OB = 87 * MiB, WS_OC = 99 * MiB;
constexpr size_t WS_UT = 111 * MiB, WS_QB = 147 * MiB, WS_CKVALL = 195 * MiB, WS_KPEALL = 202 * MiB, WS_KNB = 203 * MiB, WS_VTB = 216 * MiB, WS_KA = 229 * MiB, WS_VTA = 233 * MiB;
constexpr size_t WS_S0 = 39 * MiB, WS_S1 = 111 * MiB, WS_S2 = 135 * MiB, WS_MBF = 195 * MiB, WS_END = 256 * MiB;
constexpr int KA_LAT = 16 * 2 * 256 * 64;
constexpr int UT_LAT = 16 * 1536 * 256;
constexpr int OUT_K = 12582912, OUT_V = 13631488, OUT_CKV = 14680064, OUT_KPE = 16777216;
constexpr int LDS_BYTES = 147456;
constexpr int NPHASE = 24;

#ifndef GAS
#define GAS __attribute__((address_space(1)))
#endif
#define LAS __attribute__((address_space(3)))
typedef unsigned short bf16;
typedef unsigned v4u __attribute__((ext_vector_type(4)));
typedef unsigned v2u __attribute__((ext_vector_type(2)));
typedef float f32x4 __attribute__((ext_vector_type(4)));
typedef float f32x16 __attribute__((ext_vector_type(16)));
typedef short bf16x8 __attribute__((ext_vector_type(8)));
typedef short bf16x4 __attribute__((ext_vector_type(4)));
#define LDS_WAIT() asm volatile("s_waitcnt lgkmcnt(0)" ::: "memory")
__device__ __forceinline__ unsigned f2bf(float f) { unsigned u = __builtin_bit_cast(unsigned, f); return (u + 0x7fffu + ((u >> 16) & 1u)) >> 16; }
__device__ __forceinline__ unsigned pk2(float lo, float hi) { return f2bf(lo) | (f2bf(hi) << 16); }
__device__ __forceinline__ float bflo(unsigned w) { return __uint_as_float(w << 16); }
__device__ __forceinline__ float bfhi(unsigned w) { return __uint_as_float(w & 0xffff0000u); }
__device__ __forceinline__ float bf1(bf16 b) { return __uint_as_float(((unsigned)b) << 16); }
__device__ __forceinline__ void fsincos(float x, float& s, float& c) { float rev = x * 0.15915494309189535f; rev = rev - rintf(rev); s = __builtin_amdgcn_sinf(rev); c = __builtin_amdgcn_cosf(rev); }
__device__ __forceinline__ float fsin(float x) { float rev = x * 0.15915494309189535f; rev = rev - rintf(rev); return __builtin_amdgcn_sinf(rev); }
__device__ __forceinline__ float wave_sum(float v) {
#pragma unroll
    for (int o = 1; o < 64; o <<= 1) v += __shfl_xor(v, o);
    return v;
}
__device__ __forceinline__ void rope2(float& x0, float& x1, float ang) { float s, c; fsincos(ang, s, c); const float a = x0 * c - x1 * s, b = x0 * s + x1 * c; x0 = a; x1 = b; }
#define L2_10000 13.287712379549449f

__device__ __forceinline__ void transpose_item(const float* W, size_t ldw, int k0, int n0, bf16* WT, size_t ldt, int drow0, LAS float* scr, int lane) {
    float wv[32];
#pragma unroll
    for (int i = 0; i < 32; ++i) wv[i] = ((const GAS float*)W)[(size_t)(k0 + 2 * i + (lane >> 5)) * ldw + n0 + (lane & 31)];
#pragma unroll
    for (int i = 0; i < 32; ++i) scr[(2 * i + (lane >> 5)) * 33 + (lane & 31)] = wv[i];
    LDS_WAIT(); asm volatile("" ::: "memory");
    const int c = lane & 7;
#pragma unroll
    for (int j = 0; j < 4; ++j) { const int n = (lane >> 3) + 8 * j; const LAS float* s = scr + (8 * c) * 33 + n;
        v4u o; o.x = pk2(s[0 * 33], s[1 * 33]); o.y = pk2(s[2 * 33], s[3 * 33]); o.z = pk2(s[4 * 33], s[5 * 33]); o.w = pk2(s[6 * 33], s[7 * 33]);
        *(GAS v4u*)(WT + (size_t)(drow0 + n) * ldt + k0 + 8 * c) = o; }
    LDS_WAIT(); asm volatile("" ::: "memory");
}

#define XB_TMO      128
#define XB_XCNT(j)  (256  + 64 * (j))
#define XB_XSUB(j)  (1280 + 64 * (j))
#define XB_XGEN(j)  (2304 + 64 * (j))
#define XB_TOP      3328
#define XB_TOPGEN   3392
#define XCD_BAR_WORDS 3456
#define XB_SPIN_CAP (1u << 18)

__device__ __forceinline__ unsigned xb_ld(unsigned* p)              { return __hip_atomic_load(p, __ATOMIC_RELAXED, __HIP_MEMORY_SCOPE_AGENT); }
__device__ __forceinline__ unsigned xb_add(unsigned* p, unsigned v) { return __hip_atomic_fetch_add(p, v, __ATOMIC_RELAXED, __HIP_MEMORY_SCOPE_AGENT); }
__device__ __forceinline__ unsigned xb_xcc_id() { return (unsigned)__builtin_amdgcn_s_getreg((3 << 11) | 20) & 0xFu; }
#define XB_SPIN(cond, bar) do { unsigned _sp = 0; while (cond) { __builtin_amdgcn_s_sleep(1); \
    if ((++_sp & 255u) == 0u) { if (xb_ld(&(bar)[XB_TMO])) break; if (_sp > XB_SPIN_CAP) { atomicAdd(&(bar)[XB_TMO], 1u); break; } } } } while (0)

struct XcdBarrier {
    unsigned* bar; unsigned x;
    volatile LAS unsigned* st;
};

__device__ __forceinline__ XcdBarrier xcd_barrier_post(unsigned* bar, volatile LAS unsigned* st) {
    XcdBarrier b; b.bar = bar; b.x = xb_xcc_id(); b.st = st;
    if (threadIdx.x == 0) (void)xb_add(&bar[XB_XCNT(b.x)], 1u);
    return b;
}
__device__ __forceinline__ void xcd_barrier_complete(unsigned* bar, unsigned x, unsigned& nloc, unsigned& nx) {
    const unsigned G = gridDim.x * gridDim.y * gridDim.z;
    unsigned sum, cnt, mine, sp = 0u;
    for (;;) {
        sum = 0u; cnt = 0u; mine = 0u;
#pragma unroll
        for (unsigned j = 0; j < 16; ++j) { const unsigned c = xb_ld(&bar[XB_XCNT(j)]); sum += c; cnt += (c > 0u) ? 1u : 0u; mine = (j == x) ? c : mine; }
        if (sum == G) break;
        __builtin_amdgcn_s_sleep(1);
        if ((++sp & 255u) == 0u) { if (xb_ld(&bar[XB_TMO])) break; if (sp > XB_SPIN_CAP) { atomicAdd(&bar[XB_TMO], 1u); break; } }
    }
    nloc = mine > 0u ? mine : 1u; nx = cnt > 0u ? cnt : 1u;
}

__device__ __forceinline__ void xcd_barrier(const XcdBarrier& b) {
    asm volatile("s_waitcnt vmcnt(0)" ::: "memory");
    __syncthreads();
    if (threadIdx.x == 0) {
        unsigned* bar = b.bar;
        __builtin_amdgcn_s_waitcnt(0);
        unsigned nloc = b.st[0], nx = b.st[1];
        if (nloc == 0u) { xcd_barrier_complete(bar, b.x, nloc, nx); b.st[0] = nloc; b.st[1] = nx; }
        const unsigned old = xb_add(&bar[XB_XSUB(b.x)], 1u);
        const unsigned gen = old / nloc;
        if (old + 1u == (gen + 1u) * nloc) {
            __builtin_amdgcn_fence(__ATOMIC_RELEASE, "agent");
            asm volatile("s_waitcnt vmcnt(0)" ::: "memory");
            const unsigned og = xb_add(&bar[XB_TOP], 1u);
            const unsigned tg = og / nx;
            if (og + 1u == (tg + 1u) * nx) xb_add(&bar[XB_TOPGEN], 1u);
            else XB_SPIN(xb_ld(&bar[XB_TOPGEN]) == tg, bar);
            __builtin_amdgcn_fence(__ATOMIC_ACQUIRE, "agent");
            xb_add(&bar[XB_XGEN(b.x)], 1u);
            asm volatile("s_waitcnt vmcnt(0)" ::: "memory");
        } else {
            XB_SPIN(xb_ld(&bar[XB_XGEN(b.x)]) == gen, bar);
            __builtin_amdgcn_fence(__ATOMIC_ACQUIRE, "agent");
            asm volatile("s_waitcnt vmcnt(0)" ::: "memory");
        }
    }
    __syncthreads();
}


struct Args { const float* in[35]; float* out; unsigned char* ws; int ph_lo, ph_hi, li, pad; };

__device__ __forceinline__ void wconv_phase(const Args& a, int l, LAS unsigned char* lds, int gw, int NGW, int gt, int NGT, int wave, int lane) {
    LAS float* scr = (LAS float*)(lds + wave * 16384);
    unsigned char* ws = a.ws;
    bf16 *WIN = (bf16*)(ws + WS_WIN), *WG = (bf16*)(ws + WS_WG), *WUQ = (bf16*)(ws + WS_WUQ), *WKN = (bf16*)(ws + WS_WKN), *WVV = (bf16*)(ws + WS_WVV), *WB = (bf16*)(ws + WS_WB), *WO = (bf16*)(ws + WS_WO), *WUP = (bf16*)(ws + WS_WUP), *WDN = (bf16*)(ws + WS_WDN);
    constexpr int I1 = 16 * 189, I2 = 6 * 24, I3 = 4 * 32, I4 = 3 * 8 * 32, I5 = 16 * 32, I6 = 16 * 176, I7 = 44 * 32, NIT = I1 + I2 + I3 + I4 + I5 + I6 + I7;
    for (int it = gw; it < NIT; it += NGW) {
        int r = it;
        if (r < I1) { const int kb = r / 189, n0 = 32 * (r % 189); bf16* dst = WIN; int drow;
            if (n0 < 1152) drow = n0; else if (n0 < 1408) drow = n0 + 128; else if (n0 < 1440) drow = 1152 + (n0 - 1408); else if (n0 < 2976) drow = 1536 + (n0 - 1440); else { dst = WG; drow = n0 - 2976; }
            transpose_item(a.in[12] + (size_t)l * 1024 * 6048, 6048, 64 * kb, n0, dst, 1024, drow, scr, lane); continue; } r -= I1;
        if (r < I2) { const int kb = r / 24, n0 = 32 * (r % 24); transpose_item(a.in[17] + (size_t)l * 384 * 768, 768, 64 * kb, n0, WUQ, 384, n0, scr, lane); continue; } r -= I2;
        if (r < I3) { const int kb = r / 32, n0 = 32 * (r % 32); const int h = n0 >> 7, c0 = n0 & 127;
            transpose_item(a.in[18] + (size_t)l * 256 * 1024, 1024, 64 * kb, n0, (c0 < 64) ? WKN : WVV, 256, h * 64 + (c0 & 63), scr, lane); continue; } r -= I3;
        if (r < I4) { const int n = r / 256, q = r % 256, kb = q / 32, n0 = 32 * (q % 32);
            transpose_item(a.in[28] + ((size_t)l * 3 + n) * 512 * 1024, 1024, 64 * kb, n0, WB + (size_t)n * 1024 * 512, 512, n0, scr, lane); continue; } r -= I4;
        if (r < I5) { const int kb = r / 32, n0 = 32 * (r % 32); transpose_item(a.in[29] + (size_t)l * 1024 * 1024, 1024, 64 * kb, n0, WO, 1024, n0, scr, lane); continue; } r -= I5;
        if (r < I6) { const int kb = r / 176, n0 = 32 * (r % 176); transpose_item(a.in[30] + (size_t)l * 1024 * 5632, 5632, 64 * kb, n0, WUP, 1024, n0, scr, lane); continue; } r -= I6;
        { const int kb = r / 32, n0 = 32 * (r % 32); transpose_item(a.in[33] + (size_t)l * 2816 * 1024, 1024, 64 * kb, n0, WDN, 2816, n0, scr, lane); }
    }
    for (int i = gt; i < 96 * 1024 / 8; i += NGT) *(GAS v4u*)(WIN + (size_t)1184 * 1024 + (size_t)i * 8) = (v4u){0u, 0u, 0u, 0u};
}

__device__ __forceinline__ void norm_phase(const Args& a, int l, int which, bool first, int gw, int NGW, int lane) {
    const GAS float* mod = (const GAS float*)(a.ws + WS_MOD) + (size_t)l * 5 * 6144;
    GAS bf16* HBF = (GAS bf16*)(a.ws + WS_HBF);
    const GAS float* gv = (const GAS float*)((which == 0) ? a.in[10] + l * 1024 : (which == 1) ? a.in[11] + l * 1024 : a.in[34]);
    GAS float* outp = (GAS float*)a.out;
    const int shoff = (which == 0) ? 0 : 3072, scoff = shoff + 1024;
    #pragma unroll 1
    for (int row0 = gw; row0 < TT; row0 += 4 * NGW) {
        f32x4 v[4][4];
#pragma unroll
        for (int q = 0; q < 4; ++q) { const int row = row0 + q * NGW; const int rr = row < TT ? row : row0;
            const GAS float* src = first ? (const GAS float*)(rr < TCTX ? a.in[0] + (size_t)rr * DM : a.in[1] + (size_t)(rr - TCTX) * DM) : (const GAS float*)(outp + (size_t)rr * DM);
#pragma unroll
            for (int j = 0; j < 4; ++j) v[q][j] = *(const GAS f32x4*)(src + 4 * lane + 256 * j); }
#pragma unroll
        for (int q = 0; q < 4; ++q) { const int row = row0 + q * NGW; if (row >= TT) continue;
            float ss = 0.f;
#pragma unroll
            for (int j = 0; j < 4; ++j) ss += (v[q][j].x * v[q][j].x + v[q][j].y * v[q][j].y) + (v[q][j].z * v[q][j].z + v[q][j].w * v[q][j].w);
            if (first) {
#pragma unroll
                for (int j = 0; j < 4; ++j) *(GAS f32x4*)(outp + (size_t)row * DM + 4 * lane + 256 * j) = v[q][j]; }
            const float rs = rsqrtf(wave_sum(ss) * (1.f / DM) + EPSN);
            const int mrow = row < TCTX ? 0 : 1 + ((row - TCTX) >> 11);
            const GAS float* mp = mod + (size_t)mrow * 6144;
#pragma unroll
            for (int j = 0; j < 4; ++j) { const int col = 4 * lane + 256 * j; const f32x4 g = *(const GAS f32x4*)(gv + col);
                if (which == 2) { *(GAS f32x4*)(outp + (size_t)row * DM + col) = v[q][j] * rs * g; }
                else { const f32x4 sc = *(const GAS f32x4*)(mp + scoff + col), sh = *(const GAS f32x4*)(mp + shoff + col);
                    const f32x4 y = v[q][j] * rs * g * (sc + 1.f) + sh;
                    *(GAS v2u*)(HBF + (size_t)row * DM + col) = (v2u){pk2(y.x, y.y), pk2(y.z, y.w)}; } } }
    }
}
__device__ __forceinline__ void p0_mod_hid(const Args& a, LAS unsigned char* lds, int bid, int G, int tid, int gw, int NGW, int lane) {
    float* mod = (float*)(a.ws + WS_MOD);
    LAS float* sc = (LAS float*)lds;
    for (int it = bid; it < 384; it += G) {
        const int l = it / 192, rem = it % 192, kc = rem / 12, jb = rem % 12;
        if (tid < 320) { const int r = tid >> 6, kk = tid & 63, k = kc * 64 + kk; const float cv = (r == 0) ? a.in[7][k] : a.in[6][(r - 1) * 1024 + k]; sc[tid] = cv / (1.f + __expf(-cv)); }
        __syncthreads();
        const int j = jb * 512 + tid;
        const GAS float* wp = (const GAS float*)(a.in[8] + ((size_t)l * 1024 + kc * 64) * 6144 + j);
        float acc[5] = {0.f, 0.f, 0.f, 0.f, 0.f};
#pragma unroll 8
        for (int kk = 0; kk < 64; ++kk) { const float w = wp[(size_t)kk * 6144];
#pragma unroll
            for (int r = 0; r < 5; ++r) acc[r] += sc[r * 64 + kk] * w; }
        const float bias = (kc == 0) ? a.in[9][l * 6144 + j] : 0.f;
#pragma unroll
        for (int r = 0; r < 5; ++r) atomicAdd(mod + (size_t)(l * 5 + r) * 6144 + j, acc[r] + bias);
        __syncthreads();
    }
    float* HID = (float*)(a.ws + WS_HID);
    for (int it = gw; it < 2 * 2304; it += NGW) {
        const int l = it / 2304, q = it % 2304; const int L = q < 256 ? 256 : 2048, t = q < 256 ? q : q - 256;
        const float tn = (float)t / (float)(L - 1);
        float zi = 0.f;
        if (lane == 0) zi = tn;
        else if (lane <= 16) { const int bi = (lane - 1) & 7; const float band = 1e-4f + (float)bi * ((7.f - 1e-4f) / 7.f); const float ang = (6.283185307179586f / (float)L) * (float)t * band; float s, c; fsincos(ang, s, c); zi = (lane <= 8) ? c : -s; }
        float s1 = a.in[22][l * 64 + lane];
#pragma unroll
        for (int i = 0; i < 17; ++i) s1 += __shfl(zi, i) * a.in[21][(l * 17 + i) * 64 + lane];
        const float h1 = fsin(a.in[26][(l * 2 + 0) * 64 + lane] * s1);
        float s2 = a.in[24][l * 64 + lane];
#pragma unroll 8
        for (int i = 0; i < 64; ++i) s2 += __shfl(h1, i) * a.in[23][(l * 64 + i) * 64 + lane];
        HID[(size_t)it * 64 + lane] = fsin(a.in[26][(l * 2 + 1) * 64 + lane] * s2);
    }
}

__device__ __forceinline__ void post_phase(const Args& a, int l, LAS unsigned char* lds, int bid, int G, int tid, int gw, int NGW, int gt, int NGT, int lane) {
    unsigned char* ws = a.ws;
    GAS bf16 *QA = (GAS bf16*)(ws + WS_QA), *KVR = (GAS bf16*)(ws + WS_KVR), *CQ = (GAS bf16*)(ws + WS_CQ), *CKVR = (GAS bf16*)(ws + WS_CKVR), *HYR = (GAS bf16*)(ws + WS_HYR);
    GAS bf16 *UT = (GAS bf16*)(ws + WS_UT), *CKVALL = (GAS bf16*)(ws + WS_CKVALL), *KPEALL = (GAS bf16*)(ws + WS_KPEALL), *KA = (GAS bf16*)(ws + WS_KA), *VTA = (GAS bf16*)(ws + WS_VTA);
    GAS float* outp = (GAS float*)a.out;
    for (int i = gt; i < 4 * 256 * 128; i += NGT) { const int b = i >> 15, p = (i >> 7) & 255, kvh = (i >> 6) & 1, d = i & 63;
        const size_t s = ((size_t)(b * 2 + l) * 256 + p) * 128 + kvh * 64 + d;
        KA[KA_LAT + ((b * 2 + kvh) * 2304 + p) * 64 + d] = (bf16)f2bf(a.in[2][s]);
        VTA[KA_LAT + ((b * 2 + kvh) * 64 + d) * 2304 + p] = (bf16)f2bf(a.in[3][s]); }
    for (int i = gt; i < 4 * 256 * 256; i += NGT) { const int b = i >> 16, p = (i >> 8) & 255, j = i & 255;
        CKVALL[(size_t)(TCTX + b * 2304 + p) * 256 + j] = (bf16)f2bf(a.in[4][((size_t)(b * 2 + l) * 256 + p) * 256 + j]); }
    for (int i = gt; i < 4 * 256 * 32; i += NGT) { const int b = i >> 13, p = (i >> 5) & 255, j = i & 31;
        KPEALL[(size_t)(TCTX + b * 2304 + p) * 32 + j] = (bf16)f2bf(a.in[5][((size_t)(b * 2 + l) * 256 + p) * 32 + j]); }
    const GAS float *gq = (const GAS float*)(a.in[13] + l * 64), *gk = (const GAS float*)(a.in[14] + l * 64), *gcq = (const GAS float*)(a.in[15] + l * 384), *gkv = (const GAS float*)(a.in[16] + l * 256);
    for (int row = gw; row < TT; row += NGW) {
        const bool lat = row >= TCTX;
        const int b = lat ? (row - TCTX) >> 11 : row >> 8, t = lat ? (row - TCTX) & 2047 : row & 255;
        const float grow = (float)(t >> 6), gcol = (float)(t & 63);
        const int keyrow = lat ? TCTX + b * 2304 + 256 + t : row;
        { v4u w = *(const GAS v4u*)(QA + (size_t)row * 512 + 8 * lane);
          float x[8] = {bflo(w.x), bfhi(w.x), bflo(w.y), bfhi(w.y), bflo(w.z), bfhi(w.z), bflo(w.w), bfhi(w.w)};
          float ss = 0.f;
#pragma unroll
          for (int j = 0; j < 8; ++j) ss += x[j] * x[j];
          ss += __shfl_xor(ss, 1); ss += __shfl_xor(ss, 2); ss += __shfl_xor(ss, 4);
          const float rs = rsqrtf(ss * (1.f / 64.f) + EPSN); const int d0 = 8 * (lane & 7);
#pragma unroll
          for (int j = 0; j < 8; ++j) x[j] = x[j] * rs * gq[d0 + j];
          if (lat) {
#pragma unroll
              for (int k = 0; k < 4; ++k) { const int i = 4 * (lane & 7) + k; const float inv = __builtin_amdgcn_exp2f(-(float)(i & 15) * (L2_10000 / 16.f)); rope2(x[2 * k], x[2 * k + 1], (i < 16 ? grow : gcol) * inv); } }
          *(GAS v4u*)(QA + (size_t)row * 512 + 8 * lane) = (v4u){pk2(x[0], x[1]), pk2(x[2], x[3]), pk2(x[4], x[5]), pk2(x[6], x[7])}; }
        { const v2u w = *(const GAS v2u*)(KVR + (size_t)row * 256 + 4 * lane);
          float x[4] = {bflo(w.x), bfhi(w.x), bflo(w.y), bfhi(w.y)};
          float ss = (x[0] * x[0] + x[1] * x[1]) + (x[2] * x[2] + x[3] * x[3]);
          ss += __shfl_xor(ss, 1); ss += __shfl_xor(ss, 2); ss += __shfl_xor(ss, 4); ss += __shfl_xor(ss, 8);
          const int kvh = (lane >> 4) & 1, d0 = 4 * (lane & 15);
          if (lane < 32) {
              const float rs = rsqrtf(ss * (1.f / 64.f) + EPSN);
#pragma unroll
              for (int j = 0; j < 4; ++j) x[j] = x[j] * rs * gk[d0 + j];
              if (!lat) { *(GAS f32x4*)(outp + OUT_K + ((size_t)(b * 2 + l) * 256 + t) * 128 + kvh * 64 + d0) = (f32x4){x[0], x[1], x[2], x[3]};
                  *(GAS v2u*)(KA + ((size_t)(b * 2 + kvh) * 256 + t) * 64 + d0) = (v2u){pk2(x[0], x[1]), pk2(x[2], x[3])}; }
              else {
#pragma unroll
                  for (int k = 0; k < 2; ++k) { const int i = 2 * (lane & 15) + k; const float inv = __builtin_amdgcn_exp2f(-(float)(i & 15) * (L2_10000 / 16.f)); rope2(x[2 * k], x[2 * k + 1], (i < 16 ? grow : gcol) * inv); }
                  *(GAS v2u*)(KA + KA_LAT + ((size_t)(b * 2 + kvh) * 2304 + 256 + t) * 64 + d0) = (v2u){pk2(x[0], x[1]), pk2(x[2], x[3])}; }
          } else {
              if (!lat) { *(GAS f32x4*)(outp + OUT_V + ((size_t)(b * 2 + l) * 256 + t) * 128 + kvh * 64 + d0) = (f32x4){x[0], x[1], x[2], x[3]};
#pragma unroll
                  for (int j = 0; j < 4; ++j) VTA[((size_t)(b * 2 + kvh) * 64 + d0 + j) * 256 + t] = (bf16)f2bf(x[j]); }
              else {
#pragma unroll
                  for (int j = 0; j < 4; ++j) VTA[KA_LAT + ((size_t)(b * 2 + kvh) * 64 + d0 + j) * 2304 + 256 + t] = (bf16)f2bf(x[j]); }
          } }
        { GAS unsigned* p = (GAS unsigned*)(CQ + (size_t)row * 512 + 6 * lane);
          const unsigned w0 = p[0], w1 = p[1], w2 = p[2];
          float x[6] = {bflo(w0), bfhi(w0), bflo(w1), bfhi(w1), bflo(w2), bfhi(w2)};
          float ss = 0.f;
#pragma unroll
          for (int j = 0; j < 6; ++j) ss += x[j] * x[j];
          const float rs = rsqrtf(wave_sum(ss) * (1.f / 384.f) + EPSN);
#pragma unroll
          for (int j = 0; j < 6; ++j) x[j] = x[j] * rs * gcq[6 * lane + j];
          p[0] = pk2(x[0], x[1]); p[1] = pk2(x[2], x[3]); p[2] = pk2(x[4], x[5]);
          if (lane < 16) { const unsigned w = *(const GAS unsigned*)(CQ + (size_t)row * 512 + 384 + 2 * lane); float y0 = bflo(w), y1 = bfhi(w);
              if (!lat) { outp[OUT_KPE + ((size_t)(b * 2 + l) * 256 + t) * 32 + 2 * lane] = y0; outp[OUT_KPE + ((size_t)(b * 2 + l) * 256 + t) * 32 + 2 * lane + 1] = y1; }
              else { const float inv = __builtin_amdgcn_exp2f(-(float)(lane & 7) * (L2_10000 / 8.f)); rope2(y0, y1, (lane < 8 ? grow : gcol) * inv); }
              *(GAS unsigned*)(KPEALL + (size_t)keyrow * 32 + 2 * lane) = pk2(y0, y1); } }
        { const v2u w = *(const GAS v2u*)(CKVR + (size_t)row * 256 + 4 * lane);
          float x[4] = {bflo(w.x), bfhi(w.x), bflo(w.y), bfhi(w.y)};
          const float ss = (x[0] * x[0] + x[1] * x[1]) + (x[2] * x[2] + x[3] * x[3]);
          const float rs = rsqrtf(wave_sum(ss) * (1.f / 256.f) + EPSN);
#pragma unroll
          for (int j = 0; j < 4; ++j) x[j] = x[j] * rs * gkv[4 * lane + j];
          if (!lat) *(GAS f32x4*)(outp + OUT_CKV + ((size_t)(b * 2 + l) * 256 + t) * 256 + 4 * lane) = (f32x4){x[0], x[1], x[2], x[3]};
          *(GAS v2u*)(CKVALL + (size_t)keyrow * 256 + 4 * lane) = (v2u){pk2(x[0], x[1]), pk2(x[2], x[3])}; }
    }
    LAS float* tile = (LAS float*)lds;
    const GAS float *sw = (const GAS float*)(a.in[19] + (size_t)l * 3 * 1536), *sb = (const GAS float*)(a.in[20] + (size_t)l * 1536);
    for (int it = bid; it < 96 * 12; it += G) {
        const int tb = it / 12, cb = it % 12, row0 = tb * 128;
        const bool lat = row0 >= TCTX; const int L = lat ? 2048 : 256;
        const int b = lat ? (row0 - TCTX) >> 11 : row0 >> 8, t0 = lat ? (row0 - TCTX) & 2047 : row0 & 255;
        v4u w[4], wh = (v4u){0u, 0u, 0u, 0u};
        { const int rr = tid >> 4, c8 = tid & 15;
#pragma unroll
          for (int q = 0; q < 4; ++q) w[q] = *(const GAS v4u*)(HYR + (size_t)(row0 + rr + 32 * q) * 1536 + cb * 128 + 8 * c8);
          if (tid < 32) { const int which = tid >> 4; const bool ok = which ? (t0 + 128 < L) : (t0 > 0); const int rsrc = which ? row0 + 128 : row0 - 1;
              if (ok) wh = *(const GAS v4u*)(HYR + (size_t)rsrc * 1536 + cb * 128 + 8 * c8); }
#pragma unroll
          for (int q = 0; q < 4; ++q) { LAS float* tp = tile + (rr + 32 * q + 1) * 129 + 8 * c8;
              tp[0] = bflo(w[q].x); tp[1] = bfhi(w[q].x); tp[2] = bflo(w[q].y); tp[3] = bfhi(w[q].y); tp[4] = bflo(w[q].z); tp[5] = bfhi(w[q].z); tp[6] = bflo(w[q].w); tp[7] = bfhi(w[q].w); }
          if (tid < 32) { LAS float* tp = tile + ((tid >> 4) ? 129 : 0) * 129 + 8 * c8;
              tp[0] = bflo(wh.x); tp[1] = bfhi(wh.x); tp[2] = bflo(wh.y); tp[3] = bfhi(wh.y); tp[4] = bflo(wh.z); tp[5] = bfhi(wh.z); tp[6] = bflo(wh.w); tp[7] = bfhi(wh.w); } }
        __syncthreads();
        { const int c = tid >> 2, tc = tid & 3, cg_ = cb * 128 + c; const float w0 = sw[cg_], w1 = sw[1536 + cg_], w2 = sw[3072 + cg_], bb = sb[cg_];
          const size_t base = lat ? (size_t)UT_LAT + ((size_t)b * 1536 + cg_) * 2048 : ((size_t)b * 1536 + cg_) * 256;
#pragma unroll
          for (int q = 0; q < 4; ++q) { float u[8];
#pragma unroll
              for (int k = 0; k < 8; ++k) { const int tr = 32 * tc + 8 * q + k; u[k] = w0 * tile[tr * 129 + c] + w1 * tile[(tr + 1) * 129 + c] + w2 * tile[(tr + 2) * 129 + c] + bb; }
              *(GAS v4u*)(UT + base + t0 + 32 * tc + 8 * q) = (v4u){pk2(u[0], u[1]), pk2(u[2], u[3]), pk2(u[4], u[5]), pk2(u[6], u[7])}; } }
        __syncthreads();
    }
}

__device__ __forceinline__ void ffnconv_phase(const Args& a, int l, int gt, int NGT) {
    const GAS bf16* U = (const GAS bf16*)(a.ws + WS_U); GAS bf16* ACT = (GAS bf16*)(a.ws + WS_ACT);
    const GAS float *cw = (const GAS float*)(a.in[31] + (size_t)l * 3 * 5632), *cb = (const GAS float*)(a.in[32] + (size_t)l * 5632);
#pragma unroll 1
    for (int idx = gt; idx < 1536 * 352; idx += NGT) {
        const int tb = idx / 352, ch = idx % 352, row0 = tb * 8, c0 = ch * 8;
        const bool lat = row0 >= TCTX; const int t0 = lat ? (row0 - TCTX) & 2047 : row0 & 255, L = lat ? 2048 : 256;
        v4u ra[10], rg[10];
#pragma unroll
        for (int i = 0; i < 10; ++i) { const int t = t0 + i - 1; const bool ok = (t >= 0) && (t < L); const size_t rr = (size_t)(row0 + (ok ? i - 1 : 0)) * 5632 + c0;
            ra[i] = *(const GAS v4u*)(U + rr); rg[i] = *(const GAS v4u*)(U + rr + 2816);
            if (!ok) { ra[i] = (v4u){0u, 0u, 0u, 0u}; rg[i] = (v4u){0u, 0u, 0u, 0u}; } }
        float wa[3][8], wg[3][8], ba[8], bg[8];
#pragma unroll
        for (int j = 0; j < 8; ++j) { ba[j] = cb[c0 + j]; bg[j] = cb[2816 + c0 + j];
#pragma unroll
            for (int k = 0; k < 3; ++k) { wa[k][j] = cw[k * 5632 + c0 + j]; wg[k][j] = cw[k * 5632 + 2816 + c0 + j]; } }
#pragma unroll
        for (int i = 0; i < 8; ++i) {
            float o[8];
#pragma unroll
            for (int j2 = 0; j2 < 4; ++j2) {
                const unsigned a0 = ra[i][j2], a1 = ra[i + 1][j2], a2 = ra[i + 2][j2], g0 = rg[i][j2], g1 = rg[i + 1][j2], g2 = rg[i + 2][j2];
                { const int j = 2 * j2; const float av = wa[0][j] * bflo(a0) + wa[1][j] * bflo(a1) + wa[2][j] * bflo(a2) + ba[j], gv = wg[0][j] * bflo(g0) + wg[1][j] * bflo(g1) + wg[2][j] * bflo(g2) + bg[j]; o[j] = gv * __builtin_amdgcn_rcpf(1.f + __expf(-gv)) * av; }
                { const int j = 2 * j2 + 1; const float av = wa[0][j] * bfhi(a0) + wa[1][j] * bfhi(a1) + wa[2][j] * bfhi(a2) + ba[j], gv = wg[0][j] * bfhi(g0) + wg[1][j] * bfhi(g1) + wg[2][j] * bfhi(g2) + bg[j]; o[j] = gv * __builtin_amdgcn_rcpf(1.f + __expf(-gv)) * av; } }
            *(GAS v4u*)(ACT + (size_t)(row0 + i) * 2816 + c0) = (v4u){pk2(o[0], o[1]), pk2(o[2], o[3]), pk2(o[4], o[5]), pk2(o[6], o[7])};
        }
    }
}
typedef float f32x2_t __attribute__((ext_vector_type(2)));
typedef __bf16 bf16x2_t __attribute__((ext_vector_type(2)));
__device__ __forceinline__ unsigned cvtpk(float lo, float hi) { const f32x2_t v = {lo, hi}; const bf16x2_t b = __builtin_convertvector(v, bf16x2_t); return __builtin_bit_cast(unsigned, b); }
template <int DK>
__device__ __forceinline__ void attn_unit(LAS unsigned char* lds, int tid, const bf16* Qp, int qpitch, const bf16* Kp, int kpitch, const bf16* Kpe, const bf16* Vt, size_t vpitch,
                                          int nkeys, bf16* Op, int opitch, float sl2, bool rope, int pos0) {
    constexpr int NS = DK / 16;
    asm volatile("" : "+v"(tid));
    const int lane = tid & 63, wave = tid >> 6, r = lane & 31, h = lane >> 5;
    bf16x8 qf[NS];
    { const bf16* qrow = Qp + (size_t)(wave * 32 + r) * qpitch;
#pragma unroll
      for (int s = 0; s < NS; ++s) qf[s] = *(const GAS bf16x8*)(qrow + 16 * s + 8 * h);
      if (DK == 96 && rope) { const int t = pos0 + wave * 32 + r; const float grow = (float)(t >> 6), gcol = (float)(t & 63);
#pragma unroll
          for (int sp = 0; sp < 2; ++sp) { bf16x8 v = qf[NS - 2 + sp];
#pragma unroll
              for (int k = 0; k < 4; ++k) { float x0 = bf1((bf16)v[2 * k]), x1 = bf1((bf16)v[2 * k + 1]);
                  const float inv = __builtin_amdgcn_exp2f(-(float)(4 * h + k) * (L2_10000 / 8.f)); rope2(x0, x1, (sp == 0 ? grow : gcol) * inv);
                  v[2 * k] = (short)f2bf(x0); v[2 * k + 1] = (short)f2bf(x1); }
              qf[NS - 2 + sp] = v; } } }
    const int kkey = tid >> 3, kch = tid & 7, pkey = tid >> 2, pch = tid & 3;
    f32x16 o0, o1;
#pragma unroll
    for (int i = 0; i < 16; ++i) { o0[i] = 0.f; o1[i] = 0.f; }
    float mrun = -__builtin_inff(), lrun = 0.f;
    v4u rk, rv, rp = (v4u){0u, 0u, 0u, 0u};
    const int ntile = nkeys >> 6;
#define ATT_LOAD(kt) do { const int key0 = (kt) * 64; rk = *(const GAS v4u*)(Kp + (size_t)(key0 + kkey) * kpitch + 8 * kch); rv = *(const GAS v4u*)(Vt + (size_t)kkey * vpitch + key0 + 8 * kch); \
        if (DK == 96 && tid < 256) rp = *(const GAS v4u*)(Kpe + (size_t)(key0 + pkey) * 32 + 8 * pch); } while (0)
#define ATT_WRITE(buf) do { *(LAS v4u*)(lds + (buf) * 13312 + kkey * 208 + kch * 16) = rk; \
        { LAS unsigned char* vw = lds + 26624 + (buf) * 9216 + kkey * 144 + (kch >> 1) * 32 + (kch & 1) * 8; *(LAS v2u*)vw = (v2u){rv.x, rv.y}; *(LAS v2u*)(vw + 16) = (v2u){rv.z, rv.w}; } \
        if (DK == 96 && tid < 256) *(LAS v4u*)(lds + (buf) * 13312 + pkey * 208 + 128 + pch * 16) = rp; } while (0)
    ATT_LOAD(0); ATT_WRITE(0); __syncthreads();
    for (int kt = 0; kt < ntile; ++kt) {
        const int buf = kt & 1;
        if (kt + 1 < ntile) ATT_LOAD(kt + 1);
        const LAS unsigned char* kb = lds + buf * 13312; const LAS unsigned char* vb = lds + 26624 + buf * 9216;
        f32x16 s0, s1;
#pragma unroll
        for (int i = 0; i < 16; ++i) { s0[i] = 0.f; s1[i] = 0.f; }
#pragma unroll
        for (int s = 0; s < NS; ++s) {
            const bf16x8 a0 = *(const LAS bf16x8*)(kb + r * 208 + (16 * s + 8 * h) * 2), a1 = *(const LAS bf16x8*)(kb + (32 + r) * 208 + (16 * s + 8 * h) * 2);
            s0 = __builtin_amdgcn_mfma_f32_32x32x16_bf16(a0, qf[s], s0, 0, 0, 0); s1 = __builtin_amdgcn_mfma_f32_32x32x16_bf16(a1, qf[s], s1, 0, 0, 0); }
        float mx = s0[0];
#pragma unroll
        for (int i = 1; i < 16; ++i) mx = fmaxf(mx, s0[i]);
#pragma unroll
        for (int i = 0; i < 16; ++i) mx = fmaxf(mx, s1[i]);
        mx = fmaxf(mx, __shfl_xor(mx, 32));
        const float mnew = fmaxf(mrun, mx), alpha = __builtin_amdgcn_exp2f((mrun - mnew) * sl2), nm = mnew * sl2;
        float sum = 0.f;
#pragma unroll
        for (int i = 0; i < 16; ++i) { s0[i] = __builtin_amdgcn_exp2f(s0[i] * sl2 - nm); s1[i] = __builtin_amdgcn_exp2f(s1[i] * sl2 - nm); sum += s0[i] + s1[i]; }
        lrun = lrun * alpha + sum; mrun = mnew;
        if (__builtin_amdgcn_ballot_w64(alpha != 1.f)) {
#pragma unroll
            for (int i = 0; i < 16; ++i) { o0[i] *= alpha; o1[i] *= alpha; } }
#pragma unroll
        for (int sub = 0; sub < 2; ++sub) {
#pragma unroll
            for (int s2 = 0; s2 < 2; ++s2) {
                const v4u pw = (sub == 0) ? (v4u){cvtpk(s0[8 * s2], s0[8 * s2 + 1]), cvtpk(s0[8 * s2 + 2], s0[8 * s2 + 3]), cvtpk(s0[8 * s2 + 4], s0[8 * s2 + 5]), cvtpk(s0[8 * s2 + 6], s0[8 * s2 + 7])}
                                          : (v4u){cvtpk(s1[8 * s2], s1[8 * s2 + 1]), cvtpk(s1[8 * s2 + 2], s1[8 * s2 + 3]), cvtpk(s1[8 * s2 + 4], s1[8 * s2 + 5]), cvtpk(s1[8 * s2 + 6], s1[8 * s2 + 7])};
                const bf16x8 pb = __builtin_bit_cast(bf16x8, pw);
                const int kofs = (32 * sub + 16 * s2 + 8 * h) * 2;
#pragma unroll
                for (int slab = 0; slab < 2; ++slab) {
                    const bf16x8 va = *(const LAS bf16x8*)(vb + (32 * slab + r) * 144 + kofs);
                    if (slab == 0) o0 = __builtin_amdgcn_mfma_f32_32x32x16_bf16(va, pb, o0, 0, 0, 0); else o1 = __builtin_amdgcn_mfma_f32_32x32x16_bf16(va, pb, o1, 0, 0, 0); } } }
        if (kt + 1 < ntile) ATT_WRITE(buf ^ 1);
        __syncthreads();
    }
#undef ATT_LOAD
#undef ATT_WRITE
    const float ltot = lrun + __shfl_xor(lrun, 32), inv = 1.f / ltot;
    bf16* orow = Op + (size_t)(wave * 32 + r) * opitch;
#pragma unroll
    for (int g4 = 0; g4 < 4; ++g4) {
        *(GAS v2u*)(orow + 8 * g4 + 4 * h) = (v2u){pk2(o0[4 * g4] * inv, o0[4 * g4 + 1] * inv), pk2(o0[4 * g4 + 2] * inv, o0[4 * g4 + 3] * inv)};
        *(GAS v2u*)(orow + 32 + 8 * g4 + 4 * h) = (v2u){pk2(o1[4 * g4] * inv, o1[4 * g4 + 1] * inv), pk2(o1[4 * g4 + 2] * inv, o1[4 * g4 + 3] * inv)}; }
}

template <bool LAT>
__device__ __forceinline__ void hyena_unit(const Args& a, int l, int c, LAS unsigned char* lds, int tid) {
    constexpr int L = LAT ? 2048 : 256, NB = LAT ? 4 : 16, NE = L / 16, NCH = L / 4, NW = LAT ? 8 : 4, ASH = LAT ? 2 : 4, MG = LAT ? 224 : 32  , UP = L + 2 * MG + 8  , GS = 514  ;
    asm volatile("" : "+v"(tid));
    const int lane = tid & 63, wave = tid >> 6, r = lane & 31, h = lane >> 5;
    const bf16* UT = (const bf16*)(a.ws + WS_UT) + (LAT ? UT_LAT : 0);
    GAS bf16* OC = (GAS bf16*)(a.ws + WS_OC);
    const float* HID = (const float*)(a.ws + WS_HID) + ((size_t)l * 2304 + (LAT ? 256 : 0)) * 64;
    LAS bf16* U = (LAS bf16*)lds; LAS bf16* X = (LAS bf16*)(lds + 20096); LAS float* FT = (LAS float*)(lds + 36480); LAS unsigned char* GC = lds + 69248;
    LAS float* W3 = (LAS float*)(lds + 135040); LAS float* RED = (LAS float*)(lds + 136064);
    constexpr int NQ = NB * L / 8 / 512;
    v4u x2r[NQ];
#pragma unroll
    for (int i = 0; i < NQ; ++i) { const int q = tid + 512 * i, b = q / (L / 8), off = (q % (L / 8)) * 8;
        const v4u uv = *(const GAS v4u*)(UT + ((size_t)b * 1536 + c) * L + off), xv = *(const GAS v4u*)(UT + ((size_t)b * 1536 + 512 + c) * L + off);
        x2r[i] = *(const GAS v4u*)(UT + ((size_t)b * 1536 + 1024 + c) * L + off);
        *(LAS v4u*)(U + b * UP + MG + off) = uv; *(LAS v4u*)(X + b * L + off) = xv; }
    for (int q = tid; q < NB * 2 * MG / 8; q += 512) { const int b = q / (2 * MG / 8), o = q % (2 * MG / 8); const int off = (o < MG / 8) ? 8 * o : MG + L + 8 * (o - MG / 8);
        *(LAS v4u*)(U + b * UP + off) = (v4u){0u, 0u, 0u, 0u}; }
    if (tid < 256) { const int j = tid >> 2, k = tid & 3; W3[k * 64 + j] = a.in[25][((size_t)l * 64 + j) * 2048 + (k >> 1) * 1024 + (k & 1) * 512 + c]; }
    __syncthreads();
#if defined(PROBE_HY) && PROBE_HY == 1
    for (int rep = 0; rep < 2; ++rep)
#endif
    { const float dmin = -15.350567286626973f, dmax = -3.0701134573253945f;
      const float delta = fabsf(dmin + (float)c * ((dmax - dmin) / 511.f));
      float p0 = 0.f, p1 = 0.f;
      for (int t = tid; t < L; t += 512) {
          float s[4] = {0.f, 0.f, 0.f, 0.f};
#pragma unroll 4
          for (int j4 = 0; j4 < 16; ++j4) { const f32x4 hv = *(const GAS f32x4*)(HID + (size_t)t * 64 + 4 * j4);
#pragma unroll
              for (int k = 0; k < 4; ++k) s[k] += hv.x * W3[k * 64 + 4 * j4] + hv.y * W3[k * 64 + 4 * j4 + 1] + hv.z * W3[k * 64 + 4 * j4 + 2] + hv.w * W3[k * 64 + 4 * j4 + 3]; }
          const float win = __expf(-((float)t / (float)(L - 1)) * delta);
#pragma unroll
          for (int k = 0; k < 4; ++k) { s[k] *= win; FT[k * L + t] = s[k]; }
          p0 += fabsf(s[0]) + (t >= 1 ? fabsf(s[2]) : 0.f); p1 += fabsf(s[1]) + (t >= 1 ? fabsf(s[3]) : 0.f); }
      p0 = wave_sum(p0); p1 = wave_sum(p1);
      if (lane == 0) { RED[2 * wave] = p0; RED[2 * wave + 1] = p1; } }
    __syncthreads();
    const int col = 32 * wave + r, ca = col >> ASH, cbat = col & (NB - 1);
    const int a_lo = (32 * wave) >> ASH, a_hi = (32 * wave + 31) >> ASH;
    const int rowbase = LAT ? TCTX + cbat * 2048 : cbat * 256;
#pragma unroll 1
    for (int n = 0; n < 2; ++n) {
        float l1s = 0.f;
#pragma unroll
        for (int w = 0; w < 8; ++w) l1s += RED[2 * w + n];
        const float invl1 = 1.f / (l1s + EPSN);
#if defined(PROBE_HY) && PROBE_HY == 4
        for (int rep = 0; rep < 2; ++rep)
#endif
        for (int q = tid; q < 8 * NCH; q += 512) { const int k = q & 7, y = q >> 3, m0 = L - (8 * y + k);
            float v[8];
#pragma unroll
            for (int j = 0; j < 8; ++j) { const int m = m0 - j; float t = 0.f; if (m >= 0 && m < L) t = FT[n * L + m]; else if (m < 0 && m > -L) t = FT[(2 + n) * L - m]; v[j] = t * invl1; }
            *(LAS v4u*)(GC + (k * GS + y) * 16) = (v4u){cvtpk(v[0], v[1]), cvtpk(v[2], v[3]), cvtpk(v[4], v[5]), cvtpk(v[6], v[7])}; }
        __syncthreads();
        f32x16 acc, acc1;
#if defined(PROBE_HY) && PROBE_HY == 3
        for (int rep = 0; rep < 2; ++rep) {
#endif
#pragma unroll
        for (int i = 0; i < 16; ++i) { acc[i] = 0.f; acc1[i] = 0.f; }
        if (wave < NW) {
            const int lam_lo = 2 * a_lo - (NE - 1), lam_hi = 2 * a_hi;
            const int xs0 = 8 * h - r + L;
            const LAS unsigned char* ap = GC + ((xs0 & 7) * GS + (xs0 >> 3) - 2 * lam_lo) * 16;
            const LAS unsigned char* bp = (const LAS unsigned char*)(U + cbat * UP + MG + 8 * h) + 32 * (2 * ca - lam_lo);
            bf16x8 a0 = *(const LAS bf16x8*)ap, b0 = *(const LAS bf16x8*)bp, a1 = *(const LAS bf16x8*)(ap - 32), b1 = *(const LAS bf16x8*)(bp - 32);
            for (int lam = lam_lo; lam <= lam_hi; lam += 2) {
                const bool more = lam + 2 <= lam_hi;
                if (more) { ap -= 64; bp -= 64; }
                const bf16x8 na0 = *(const LAS bf16x8*)ap, na1 = *(const LAS bf16x8*)(ap - 32), nb0 = *(const LAS bf16x8*)bp, nb1 = *(const LAS bf16x8*)(bp - 32);
                acc = __builtin_amdgcn_mfma_f32_32x32x16_bf16(a0, b0, acc, 0, 0, 0);
                acc1 = __builtin_amdgcn_mfma_f32_32x32x16_bf16(a1, b1, acc1, 0, 0, 0);
                a0 = na0; a1 = na1; b0 = nb0; b1 = nb1;
            }
#pragma unroll
            for (int i = 0; i < 16; ++i) acc[i] += acc1[i];
        }
#if defined(PROBE_HY) && PROBE_HY == 3
        asm volatile("" :: "v"(acc[0]), "v"(acc[5]));
        }
#endif
        const float bias = a.in[27][((size_t)l * 2 + n) * 512 + c];
        float z[16];
        if (wave < NW) {
#pragma unroll
            for (int g4 = 0; g4 < 4; ++g4) { const int t0 = 32 * ca + 8 * g4 + 4 * h;
                const v2u uw = *(const LAS v2u*)(U + cbat * UP + MG + t0), xw = *(const LAS v2u*)(X + cbat * L + t0);
                const float uv[4] = {bflo(uw.x), bfhi(uw.x), bflo(uw.y), bfhi(uw.y)}, xv[4] = {bflo(xw.x), bfhi(xw.x), bflo(xw.y), bfhi(xw.y)};
#pragma unroll
                for (int k = 0; k < 4; ++k) z[4 * g4 + k] = xv[k] * (acc[4 * g4 + k] + bias * uv[k]); }
        }
        __syncthreads();
        if (n == 0) {
            if (wave < NW) {
#pragma unroll
                for (int g4 = 0; g4 < 4; ++g4) *(LAS v2u*)(U + cbat * UP + MG + 32 * ca + 8 * g4 + 4 * h) = (v2u){pk2(z[4 * g4], z[4 * g4 + 1]), pk2(z[4 * g4 + 2], z[4 * g4 + 3])}; }
#pragma unroll
            for (int i = 0; i < NQ; ++i) { const int q = tid + 512 * i, b = q / (L / 8), off = (q % (L / 8)) * 8; *(LAS v4u*)(X + b * L + off) = x2r[i]; }
        } else if (wave < NW) {
#if defined(PROBE_HY) && PROBE_HY == 2
            for (int rep = 0; rep < 2; ++rep)
#endif
#pragma unroll
            for (int g4 = 0; g4 < 4; ++g4)
#pragma unroll
                for (int k = 0; k < 4; ++k) OC[(size_t)(rowbase + 32 * ca + 8 * g4 + 4 * h + k) * 512 + c] = (bf16)f2bf(z[4 * g4 + k]);
        }
    }
    __syncthreads();
}
#ifndef PHMASK
#define PHMASK 0x1fff
#endif
#define PH_ON(k) (((PHMASK) >> (k)) & 1)
#define L1_INV() do { asm volatile("s_waitcnt vmcnt(0)" ::: "memory"); __builtin_amdgcn_fence(__ATOMIC_ACQUIRE, "agent"); asm volatile("s_waitcnt vmcnt(0)" ::: "memory"); __syncthreads(); } while (0)
template <class T> __device__ __forceinline__ T* asglobal(T* p) { return (T*)(GAS T*)p; }
__global__ void __launch_bounds__(512, 2) mega_fwd(Args a) {
    extern __shared__ __attribute__((aligned(16))) unsigned char lds_raw[];
    LAS unsigned char* lds = (LAS unsigned char*)lds_raw;
    cg::grid_group grid = cg::this_grid();
    const int bid = blockIdx.x;
    using pg8::Gemm; using pg8::StaticOrder;
    const int ph_lo = a.ph_lo, ph_hi = a.ph_hi;
    volatile LAS unsigned* MISC = (volatile LAS unsigned*)(lds + LDS_BYTES - 64);
    if (threadIdx.x < 16) MISC[threadIdx.x] = 0u;
    __syncthreads();
    if (ph_hi > NPHASE) { __syncthreads(); grid.sync(); }
    XcdBarrier bar = xcd_barrier_post((unsigned*)(a.ws + WS_BAR + (size_t)a.li * BAR_REGION), MISC);
#pragma unroll 1
    for (int ph = ph_lo; ph < ph_hi; ++ph) {
        int tid = threadIdx.x; asm volatile("" : "+v"(tid));
        int G = gridDim.x; asm volatile("" : "+s"(G)); const int NGW = G * 8, NGT = G * 512;
        unsigned char* ws = a.ws; asm volatile("" : "+s"(ws));
#if defined(__HIP_DEVICE_COMPILE__)
#define ASSUME_GLOBAL(p) __builtin_assume(!__builtin_amdgcn_is_shared((const void*)(p)) && !__builtin_amdgcn_is_private((const void*)(p)))
#else
#define ASSUME_GLOBAL(p) ((void)0)
#endif
        ASSUME_GLOBAL(ws); ASSUME_GLOBAL(a.ws); ASSUME_GLOBAL(a.out);
#pragma unroll
        for (int i = 0; i < 35; ++i) ASSUME_GLOBAL(a.in[i]);
        const int lane = tid & 63, wave = __builtin_amdgcn_readfirstlane(tid >> 6), gw = bid * 8 + wave, gt = bid * 512 + tid;
        const int l = (ph >= 1 && ph < 23) ? (ph - 1) / 11 : 0, sub = (ph >= 1 && ph < 23) ? (ph - 1) % 11 : -1;
        float* mod = (float*)(ws + WS_MOD) + (size_t)l * 5 * 6144;
        if (PH_ON(11) && ph == 0) { p0_mod_hid(a, lds, bid, G, tid, gw, NGW, lane); wconv_phase(a, 0, lds, gw, NGW, gt, NGT, wave, lane); }
        else if (PH_ON(12) && ph == 23) { norm_phase(a, 0, 2, false, gw, NGW, lane); }
        else if (PH_ON(0) && sub == 0) { if (l == 1) wconv_phase(a, 1, lds, gw, NGW, gt, NGT, wave, lane); norm_phase(a, l, 0, l == 0, gw, NGW, lane); }
        else if (PH_ON(1) && sub == 1) {
            Gemm g{(const bf16*)(ws + WS_HBF), (const bf16*)(ws + WS_WIN), TT, 3072, 1024, 1024, 1024}; StaticOrder S; S.init(TT, 3072, G, bid);
            pg8::EpiSeg E{(bf16*)(ws + WS_QA), (bf16*)(ws + WS_KVR), (bf16*)(ws + WS_CQ), (bf16*)(ws + WS_CKVR), (bf16*)(ws + WS_HYR)};
            pg8::gemm_phase<pg8::EpiSeg, StaticOrder, true, true>(lds, g, S, E);
        }
        else if (PH_ON(2) && sub == 2) { post_phase(a, l, lds, bid, G, tid, gw, NGW, gt, NGT, lane); }
        else if (PH_ON(3) && sub == 3) {
#pragma unroll 1
            for (int q = 0; q < 3; ++q) {
                Gemm g; StaticOrder S; pg8::EpiStore<0> E;
                if (q == 0) { g = Gemm{(const bf16*)(ws + WS_CQ), (const bf16*)(ws + WS_WUQ), TT, 768, 384, 512, 384}; S.init(TT, 768, G, bid); E = pg8::EpiStore<0>{(bf16*)(ws + WS_QB), 768}; }
                else if (q == 1) { g = Gemm{(const bf16*)(ws + WS_CKVALL), (const bf16*)(ws + WS_WKN), NKEYROWS, 512, 256, 256, 256}; S.init(NKEYROWS, 512, G, (bid + G - 144 % G) % G); E = pg8::EpiStore<0>{(bf16*)(ws + WS_KNB), 512}; }
                else { g = Gemm{(const bf16*)(ws + WS_WVV), (const bf16*)(ws + WS_CKVALL), 512, NKEYROWS, 256, 256, 256}; S.init(512, NKEYROWS, G, (bid + G - 248 % G) % G); E = pg8::EpiStore<0>{(bf16*)(ws + WS_VTB), NKEYROWS}; }
                pg8::gemm_phase<pg8::EpiStore<0>, StaticOrder, true, true>(lds, g, S, E);
            }
        }
        else if (PH_ON(4) && sub == 4) {
            const bf16 *QA = (const bf16*)(ws + WS_QA), *QB = (const bf16*)(ws + WS_QB), *KA = (const bf16*)(ws + WS_KA), *VTA = (const bf16*)(ws + WS_VTA);
            const bf16 *KNB = (const bf16*)(ws + WS_KNB), *VTB = (const bf16*)(ws + WS_VTB), *KPE = (const bf16*)(ws + WS_KPEALL);
            bf16 *OA = (bf16*)(ws + WS_OA), *OB = (bf16*)(ws + WS_OB);
            const float slA = 0.125f * 1.4426950408889634f, slB = 0.10206207261596575f * 1.4426950408889634f;
            const int sel = a.pad;
            for (int it = bid; it < 1792; it += G) {
                { const bool is_hy = (it >= 512 && it < 1024) || it >= 1280; if ((sel == 1 && is_hy) || (sel == 2 && !is_hy)) continue; }
                if (it < 256 || (it >= 1024 && it < 1152)) {
                    const bool lat = it < 256; const int u = lat ? (G == 256 ? ((bid & 7) * 4 + (bid >> 6)) * 8 + ((bid >> 3) & 7) : it) : it - 1024;
                    const int b = lat ? u >> 6 : u >> 3, hh = lat ? (u >> 3) & 7 : u & 7, qb = lat ? u & 7 : 0;
                    const int row0 = lat ? TCTX + b * 2048 + qb * 256 : b * 256, key0 = lat ? TCTX + b * 2304 : b * 256;
                    attn_unit<96>(lds, tid, QB + (size_t)row0 * 768 + hh * 96, 768, KNB + (size_t)key0 * 512 + hh * 64, 512, KPE + (size_t)key0 * 32, VTB + (size_t)(hh * 64) * NKEYROWS + key0, NKEYROWS,
                                  lat ? 2304 : 256, OB + (size_t)row0 * 512 + hh * 64, 512, slB, lat, qb * 256);
                } else if (it < 512 || (it >= 1152 && it < 1280)) {
                    const bool lat = it < 512; const int u = lat ? (G == 256 ? ((bid & 7) * 4 + (bid >> 6)) * 8 + ((bid >> 3) & 7) : it - 256) : it - 1152;
                    const int b = lat ? u >> 6 : u >> 3, hh = lat ? (u >> 3) & 7 : u & 7, qb = lat ? u & 7 : 0, kvh = hh >> 2;
                    const int row0 = lat ? TCTX + b * 2048 + qb * 256 : b * 256, nk = lat ? 2304 : 256;
                    const size_t kbase = lat ? (size_t)KA_LAT + (size_t)(b * 2 + kvh) * 2304 * 64 : (size_t)(b * 2 + kvh) * 256 * 64;
                    attn_unit<64>(lds, tid, QA + (size_t)row0 * 512 + hh * 64, 512, KA + kbase, 64, nullptr, VTA + kbase, nk, nk, OA + (size_t)row0 * 512 + hh * 64, 512, slA, false, 0);
                } else if (it < 1024) { hyena_unit<true>(a, l, it - 512, lds, tid); }
                else { hyena_unit<false>(a, l, it - 1280, lds, tid); }
            }
        }
        else if (PH_ON(5) && sub == 5) {
            static_assert(WS_S1 == WS_S0 + 72 * MiB && WS_S2 == WS_S0 + 96 * MiB, "gate buffer arithmetic");
            bf16 *S0 = (bf16*)(ws + WS_S0), *MBF = (bf16*)(ws + WS_MBF);
            { Gemm g{(const bf16*)(ws + WS_HBF), (const bf16*)(ws + WS_WG), TT, 3072, 1024, 1024, 1024}; StaticOrder S; S.init(TT, 3072, G, bid);
              pg8::EpiGate E{S0}; pg8::gemm_phase<pg8::EpiGate, StaticOrder, true, true>(lds, g, S, E); }
            xcd_barrier(bar);
            { Gemm g{(const bf16*)(ws + WS_OA), (const bf16*)(ws + WS_WB), TT, 1024, 512, 512, 512, (size_t)TT * 512 * 2, (size_t)1024 * 512 * 2};
              pg8::BatchOrder<3> S; S.init(TT, 1024, G, bid);
              pg8::EpiMerge E{S0, MBF}; pg8::gemm_phase<pg8::EpiMerge, pg8::BatchOrder<3>, true, true>(lds, g, S, E); }
        }
        else if (PH_ON(6) && sub == 6) {
            Gemm g{(const bf16*)(ws + WS_MBF), (const bf16*)(ws + WS_WO), TT, 1024, 1024, 1024, 1024}; StaticOrder S; S.init(TT, 1024, G, bid);
            pg8::EpiResid E{a.out, mod + 2048}; pg8::gemm_phase<pg8::EpiResid, StaticOrder, true, true>(lds, g, S, E);
        }
        else if (PH_ON(7) && sub == 7) { norm_phase(a, l, 1, false, gw, NGW, lane); }
        else if (PH_ON(8) && sub == 8) {
            Gemm g{(const bf16*)(ws + WS_HBF), (const bf16*)(ws + WS_WUP), TT, 5632, 1024, 1024, 1024}; StaticOrder S; S.init(TT, 5632, G, bid);
            pg8::EpiStore<0> E{(bf16*)(ws + WS_U), 5632}; pg8::gemm_phase<pg8::EpiStore<0>, StaticOrder, true, true>(lds, g, S, E);
        }
        else if (PH_ON(9) && sub == 9) { ffnconv_phase(a, l, gt, NGT); }
        else if (PH_ON(10) && sub == 10) {
            Gemm g{(const bf16*)(ws + WS_ACT), (const bf16*)(ws + WS_WDN), TT, 1024, 2816, 2816, 2816}; StaticOrder S; S.init(TT, 1024, G, bid);
            pg8::EpiResid E{a.out, mod + 5120}; pg8::gemm_phase<pg8::EpiResid, StaticOrder, true, true>(lds, g, S, E);
        }
#ifdef EXTRA_SYNCS
        for (int q = 0; q < EXTRA_SYNCS; ++q) { __syncthreads(); grid.sync(); }
#endif
        if (ph + 1 < ph_hi) xcd_barrier(bar);
    }
}

extern "C" void kernel_launch(void* const* d_in, const int* in_sizes, int n_in, void* d_out, int out_size, void* d_ws, size_t ws_size, hipStream_t stream) {
    static int grid = 0;
    if (grid == 0) {
        if (n_in != 35 || ws_size < WS_END) { fprintf(stderr, "kernel_launch: unexpected n_in %d / ws %zu\n", n_in, ws_size); grid = -1; return; }
        int dev = 0, cus = 0, per_cu = 0;
        if (hipGetDevice(&dev) != hipSuccess || hipDeviceGetAttribute(&cus, hipDeviceAttributeMultiprocessorCount, dev) != hipSuccess) { grid = -1; return; }
        if (hipFuncSetAttribute((const void*)mega_fwd, hipFuncAttributeMaxDynamicSharedMemorySize, LDS_BYTES) != hipSuccess) { fprintf(stderr, "kernel_launch: hipFuncSetAttribute failed\n"); grid = -1; return; }
        if (hipOccupancyMaxActiveBlocksPerMultiprocessor(&per_cu, (const void*)mega_fwd, 512, LDS_BYTES) != hipSuccess || per_cu < 1) { fprintf(stderr, "kernel_launch: occupancy query says %d\n", per_cu); per_cu = 1; }
        (void)hipGetLastError();
        grid = cus;
    }
    if (grid < 0) return;
    if (hipMemsetAsync((char*)d_ws + WS_MOD, 0, ZERO_BYTES, stream) != hipSuccess) { fprintf(stderr, "kernel_launch: memset failed\n"); return; }
    Args a{};
    for (int i = 0; i < 35; ++i) a.in[i] = (const float*)d_in[i];
    a.out = (float*)d_out; a.ws = (unsigned char*)d_ws;
#if defined(MK_PER_PHASE)
    for (int p = 0; p < NPHASE; ++p) { a.ph_lo = p; a.ph_hi = p + 1; a.li = 0; void* args[] = {&a};
        hipError_t e = hipLaunchCooperativeKernel((const void*)mega_fwd, dim3(grid), dim3(512), args, LDS_BYTES, stream);
        if (e != hipSuccess) { fprintf(stderr, "launch %d failed: %s\n", p, hipGetErrorString(e)); break; } }
#else
#if defined(PROBE_SUB)
#ifndef PROBE_SEL
#define PROBE_SEL 0
#endif
    { const int k0 = 1 + PROBE_SUB, k1 = 12 + PROBE_SUB; const int cuts[6][2] = {{0, k0 + 1}, {k0, k0 + 1}, {k0 + 1, k1 + 1}, {k1, k1 + 1}, {k1 + 1, NPHASE}, {0, 0}};
      for (int c = 0; c < 5; ++c) { a.ph_lo = cuts[c][0]; a.ph_hi = cuts[c][1]; a.li = c; a.pad = (c == 1 || c == 3) ? PROBE_SEL : 0; if (a.ph_lo >= a.ph_hi) continue; void* args[] = {&a};
          hipError_t e = hipLaunchCooperativeKernel((const void*)mega_fwd, dim3(grid), dim3(512), args, LDS_BYTES, stream);
          if (e != hipSuccess) { fprintf(stderr, "cooperative launch failed: %s\n", hipGetErrorString(e)); break; } } }
#elif defined(PROBE_CUTS)
    { const int k0 = 1 + PROBE_CUTS, k1 = 12 + PROBE_CUTS; const int cuts[4][2] = {{0, k0 + 1}, {k0 + 1, k1 + 1}, {k1 + 1, NPHASE}, {0, 0}};
      for (int c = 0; c < 3; ++c) { a.ph_lo = cuts[c][0]; a.ph_hi = cuts[c][1]; a.li = c; if (a.ph_lo >= a.ph_hi) continue; void* args[] = {&a};
          hipError_t e = hipLaunchCooperativeKernel((const void*)mega_fwd, dim3(grid), dim3(512), args, LDS_BYTES, stream);
          if (e != hipSuccess) { fprintf(stderr, "cooperative launch failed: %s\n", hipGetErrorString(e)); break; } } }
#else
    a.ph_lo = 0; a.ph_hi = NPHASE; void* args[] = {&a};
    hipError_t e = hipLaunchCooperativeKernel((const void*)mega_fwd, dim3(grid), dim3(512), args, LDS_BYTES, stream);
    if (e != hipSuccess) fprintf(stderr, "cooperative launch failed: %s (grid %d)\n", hipGetErrorString(e), grid);
#endif
#endif
}
```

```cpp
#include <hip/hip_runtime.h>
#include <hip/hip_cooperative_groups.h>
#include <cstdio>
#include <cstdint>
namespace cg = cooperative_groups;
namespace pg8 {
#define PG8_LAS __attribute__((address_space(3)))
typedef unsigned short bf16_t;
typedef short bf16x8 __attribute__((ext_vector_type(8)));
typedef float f32x4 __attribute__((ext_vector_type(4)));
typedef unsigned u32x4 __attribute__((ext_vector_type(4)));
constexpr int BM = 256, BK = 64, HALF = 128, HTB = HALF * BK * 2  , STAGE_BYTES = 8 * HTB, NXCD = 8, WGM = 8;

__host__ __device__ __forceinline__ int lds_byte(int r, int c) { const int st = (r >> 4) * 2 + (c >> 5), rr = r & 15, cc = c & 31, ob = rr * 64 + cc * 2; return st * 1024 + (ob ^ (((ob >> 9) & 1) << 5)); }
__host__ __device__ __forceinline__ void stage_rc(int b, int& R, int& C) { const int st = b / 1024, sb = b % 1024, swz = sb ^ (((sb >> 9) & 1) << 5); R = (st >> 1) * 16 + swz / 64; C = (st & 1) * 32 + (swz % 64) / 2; }
__host__ __device__ __forceinline__ int perm32(int rho) { const int n = rho >> 4, i = rho & 15; return 8 * (i >> 2) + 4 * n + (i & 3); }

struct Unit { int pm, pn, gi; };
struct Gemm { const bf16_t* A; const bf16_t* Bt; int M, N, K, lda, ldb; size_t gsA, gsB; };

struct StaticOrder {
    int nM, nN, nwg, G, c;
    __host__ __device__ void init(int M, int N, int G_, int c_) { nM = M / BM; nN = N / BM; nwg = nM * nN; G = G_; c = c_; }
    __host__ __device__ bool next(int i, Unit& u) const {
        const long L = (long)i * G + c; if (L >= nwg) return false;
        int wgid = (int)L; { const int q = nwg / NXCD, r = nwg % NXCD, xcd = wgid % NXCD, off = wgid / NXCD; wgid = (xcd < r ? xcd * (q + 1) : r * (q + 1) + (xcd - r) * q) + off; }
        const int nig = WGM * nN, gid = wgid / nig, fm = gid * WGM, gsz = (nM - fm) < WGM ? (nM - fm) : WGM;
        u.pm = fm + ((wgid % nig) % gsz); u.pn = (wgid % nig) / gsz; u.gi = 0; return true;
    }
    __device__ __forceinline__ void a_ready(const Unit&) const {}
    __device__ __forceinline__ void done(const Unit&) const {}
};
template <int N0, int N1, int NN0, int NN1> struct PairOrder {
    int G, c;
    __host__ __device__ bool next(int i, Unit& u) const { const int L = i * G + c; if (L >= N0 + N1) return false;
        if (L < N0) { u.pm = L / NN0; u.pn = L % NN0; u.gi = 0; } else { const int q = L - N0; u.pm = q / NN1; u.pn = q % NN1; u.gi = 1; } return true; }
    __device__ __forceinline__ void a_ready(const Unit&) const {}
    __device__ __forceinline__ void done(const Unit&) const {}
};
template <int NB> struct BatchOrder : StaticOrder {
    __host__ __device__ bool next(int i, Unit& u) const { if (i >= NB) return false; if (!StaticOrder::next(0, u)) return false; u.gi = i; return true; }
};


#ifndef GAS
#define GAS __attribute__((address_space(1)))
#endif
typedef float f32x2v __attribute__((ext_vector_type(2)));
typedef __bf16 bf16x2v __attribute__((ext_vector_type(2)));
__device__ __forceinline__ unsigned cvt_pk_bf16(float lo, float hi) { const f32x2v v = {lo, hi}; const bf16x2v b = __builtin_convertvector(v, bf16x2v); return __builtin_bit_cast(unsigned, b); }
__device__ __forceinline__ float sigm(float x) { return __builtin_amdgcn_rcpf(1.f + __expf(-x)); }
#define EPI_FOR _Pragma("unroll") for (int ai = 0; ai < 2; ++ai) _Pragma("unroll") for (int m = 0; m < 4; ++m) _Pragma("unroll") for (int bj = 0; bj < 2; ++bj)

template <int ACT  > struct EpiStore {
    static constexpr bool PERM = true, AFTER_DRAIN = false;
    bf16_t* O; int ld;
    __device__ __forceinline__ void operator()(const f32x4 (&acc)[2][2][4][2], const Unit& u, int wr, int wc, int fr, int fq) const {
        const int row0 = u.pm * BM + wr * 64 + fr, col0 = u.pn * BM + wc * 32 + 8 * fq;
        EPI_FOR { f32x4 v0 = acc[ai][bj][m][0], v1 = acc[ai][bj][m][1];
            if (ACT == 1) { v0 = (f32x4){sigm(v0[0]), sigm(v0[1]), sigm(v0[2]), sigm(v0[3])}; v1 = (f32x4){sigm(v1[0]), sigm(v1[1]), sigm(v1[2]), sigm(v1[3])}; }
            u32x4 w; w.x = cvt_pk_bf16(v0[0], v0[1]); w.y = cvt_pk_bf16(v0[2], v0[3]); w.z = cvt_pk_bf16(v1[0], v1[1]); w.w = cvt_pk_bf16(v1[2], v1[3]);
            *(GAS u32x4*)(O + (size_t)(row0 + ai * HALF + m * 16) * ld + col0 + bj * HALF) = w; }
    }
};
struct EpiPair {
    static constexpr bool PERM = true, AFTER_DRAIN = false;
    bf16_t *O0, *O1; int ld0, ld1;
    __device__ __forceinline__ void operator()(const f32x4 (&acc)[2][2][4][2], const Unit& u, int wr, int wc, int fr, int fq) const {
        bf16_t* O = u.gi ? O1 : O0; const int ld = u.gi ? ld1 : ld0;
        const int row0 = u.pm * BM + wr * 64 + fr, col0 = u.pn * BM + wc * 32 + 8 * fq;
        EPI_FOR { const f32x4 v0 = acc[ai][bj][m][0], v1 = acc[ai][bj][m][1];
            u32x4 w; w.x = cvt_pk_bf16(v0[0], v0[1]); w.y = cvt_pk_bf16(v0[2], v0[3]); w.z = cvt_pk_bf16(v1[0], v1[1]); w.w = cvt_pk_bf16(v1[2], v1[3]);
            *(GAS u32x4*)(O + (size_t)(row0 + ai * HALF + m * 16) * ld + col0 + bj * HALF) = w; }
    }
};
struct EpiSeg {
    static constexpr bool PERM = true, AFTER_DRAIN = false;
    bf16_t *QA, *KV, *CQ, *CKV, *HY, *S0;
    __device__ __forceinline__ void operator()(const f32x4 (&acc)[2][2][4][2], const Unit& u, int wr, int wc, int fr, int fq) const {
        bf16_t* base; int ld, coff; const int pn = u.pn;
        if (pn < 2) { base = QA; ld = 512; coff = 256 * pn; } else if (pn == 2) { base = KV; ld = 256; coff = 0; } else if (pn < 5) { base = CQ; ld = 512; coff = 256 * (pn - 3); }
        else if (pn == 5) { base = CKV; ld = 256; coff = 0; } else if (pn < 12) { base = HY; ld = 1536; coff = 256 * (pn - 6); } else { base = S0; ld = 1024; coff = 256 * (pn - 12); }
        const bool gate = pn >= 12;
        const int row0 = u.pm * BM + wr * 64 + fr, col0 = coff + wc * 32 + 8 * fq;
        EPI_FOR { f32x4 v0 = acc[ai][bj][m][0], v1 = acc[ai][bj][m][1];
            if (gate) { v0 = (f32x4){sigm(v0[0]), sigm(v0[1]), sigm(v0[2]), sigm(v0[3])}; v1 = (f32x4){sigm(v1[0]), sigm(v1[1]), sigm(v1[2]), sigm(v1[3])}; }
            u32x4 w; w.x = cvt_pk_bf16(v0[0], v0[1]); w.y = cvt_pk_bf16(v0[2], v0[3]); w.z = cvt_pk_bf16(v1[0], v1[1]); w.w = cvt_pk_bf16(v1[2], v1[3]);
            *(GAS u32x4*)(base + (size_t)(row0 + ai * HALF + m * 16) * ld + col0 + bj * HALF) = w; }
    }
};
struct EpiGate {
    static constexpr bool PERM = true, AFTER_DRAIN = false;
    bf16_t* S0;
    __device__ __forceinline__ void operator()(const f32x4 (&acc)[2][2][4][2], const Unit& u, int wr, int wc, int fr, int fq) const {
        const int n = 1 + (u.pn >> 2); bf16_t* base = (bf16_t*)((unsigned char*)S0 - (size_t)((n + 1) >> 1) * (121u << 20) + (size_t)(n >> 1) * (24u << 20));
        const int row0 = u.pm * BM + wr * 64 + fr, col0 = (u.pn & 3) * BM + wc * 32 + 8 * fq;
        EPI_FOR { f32x4 v0 = acc[ai][bj][m][0], v1 = acc[ai][bj][m][1];
            v0 = (f32x4){sigm(v0[0]), sigm(v0[1]), sigm(v0[2]), sigm(v0[3])}; v1 = (f32x4){sigm(v1[0]), sigm(v1[1]), sigm(v1[2]), sigm(v1[3])};
            u32x4 w; w.x = cvt_pk_bf16(v0[0], v0[1]); w.y = cvt_pk_bf16(v0[2], v0[3]); w.z = cvt_pk_bf16(v1[0], v1[1]); w.w = cvt_pk_bf16(v1[2], v1[3]);
            *(GAS u32x4*)(base + (size_t)(row0 + ai * HALF + m * 16) * 1024 + col0 + bj * HALF) = w; }
    }
};
struct EpiMerge {
    static constexpr bool PERM = true, AFTER_DRAIN = false;
    const bf16_t* S0; bf16_t* M;
    __device__ __forceinline__ void operator()(const f32x4 (&acc)[2][2][4][2], const Unit& u, int wr, int wc, int fr, int fq) const {
        const int row0 = u.pm * BM + wr * 64 + fr, col0 = u.pn * BM + wc * 32 + 8 * fq;
        const int MODE = u.gi; const bf16_t* S = (const bf16_t*)((const unsigned char*)S0 - (size_t)((u.gi + 1) >> 1) * (121u << 20) + (size_t)(u.gi >> 1) * (24u << 20));
        EPI_FOR { const size_t off = (size_t)(row0 + ai * HALF + m * 16) * 1024 + col0 + bj * HALF;
            const u32x4 sw = *(const GAS u32x4*)(S + off);
            f32x4 s0 = (f32x4){__uint_as_float(sw.x << 16), __uint_as_float(sw.x & 0xffff0000u), __uint_as_float(sw.y << 16), __uint_as_float(sw.y & 0xffff0000u)};
            f32x4 s1 = (f32x4){__uint_as_float(sw.z << 16), __uint_as_float(sw.z & 0xffff0000u), __uint_as_float(sw.w << 16), __uint_as_float(sw.w & 0xffff0000u)};
            f32x4 v0 = acc[ai][bj][m][0] * s0, v1 = acc[ai][bj][m][1] * s1;
            if (MODE >= 1) { const u32x4 mw = *(const GAS u32x4*)(M + off);
                v0 = v0 + (f32x4){__uint_as_float(mw.x << 16), __uint_as_float(mw.x & 0xffff0000u), __uint_as_float(mw.y << 16), __uint_as_float(mw.y & 0xffff0000u)};
                v1 = v1 + (f32x4){__uint_as_float(mw.z << 16), __uint_as_float(mw.z & 0xffff0000u), __uint_as_float(mw.w << 16), __uint_as_float(mw.w & 0xffff0000u)}; }
            u32x4 w; w.x = cvt_pk_bf16(v0[0], v0[1]); w.y = cvt_pk_bf16(v0[2], v0[3]); w.z = cvt_pk_bf16(v1[0], v1[1]); w.w = cvt_pk_bf16(v1[2], v1[3]); *(GAS u32x4*)(M + off) = w; }
    }
};
struct EpiResid {
    static constexpr bool PERM = true, AFTER_DRAIN = false;
    float* X; const float* gate;
    __device__ __forceinline__ void operator()(const f32x4 (&acc)[2][2][4][2], const Unit& u, int wr, int wc, int fr, int fq) const {
        const int row0 = u.pm * BM + wr * 64 + fr, col0 = u.pn * BM + wc * 32 + 8 * fq;
        const int mrow = (u.pm < 16) ? 0 : 1 + ((u.pm - 16) >> 3);
        const float* gp = gate + (size_t)mrow * 6144 + col0;
        f32x4 g[2][2];
#pragma unroll
        for (int bj = 0; bj < 2; ++bj) { g[bj][0] = *(const GAS f32x4*)(gp + bj * HALF); g[bj][1] = *(const GAS f32x4*)(gp + bj * HALF + 4); }
        EPI_FOR { float* xp = X + (size_t)(row0 + ai * HALF + m * 16) * 1024 + col0 + bj * HALF;
            const f32x4 x0 = *(const GAS f32x4*)xp, x1 = *(const GAS f32x4*)(xp + 4);
            *(GAS f32x4*)xp = x0 + g[bj][0] * acc[ai][bj][m][0]; *(GAS f32x4*)(xp + 4) = x1 + g[bj][1] * acc[ai][bj][m][1]; }
    }
};

template <class Epi, class Sched, bool ALIGN_EPI = false, bool SP2 = false>
__device__ __forceinline__ void gemm_phase(PG8_LAS unsigned char* lds, const Gemm g, const Sched& S, const Epi& E) {
    int tid_l = threadIdx.x; asm volatile("" : "+v"(tid_l));
    const int tid = tid_l, wid = __builtin_amdgcn_readfirstlane(tid >> 6), lane = tid & 63, wr = wid >> 2, wc = wid & 3, fr = lane & 15, fq = lane >> 4;
    const int K = g.K, nt = K / BK;
    unsigned voffA[2], voffB[2];
#pragma unroll
    for (int i = 0; i < 2; ++i) { int R, C; stage_rc(tid * 16 + i * 8192, R, C); const int Rb = Epi::PERM ? ((R & ~31) + perm32(R & 31)) : R;
        voffA[i] = (unsigned)(R * g.lda + C) * 2u; voffB[i] = (unsigned)(Rb * g.ldb + C) * 2u; }
    const size_t kstep = (size_t)(BK * 2);
    const size_t hstepA = (size_t)HALF * g.lda * 2, hstepB = (size_t)HALF * g.ldb * 2;
    const size_t tstepA = 2 * hstepA, tstepB = 2 * hstepB;
    const unsigned ldsw = (unsigned)wid * 1024u;
    const int aoff = lds_byte(wr * 64 + fr, fq * 8), boff = lds_byte(wc * 32 + fr, fq * 8);
#define PG8_SA(b, h) (((b) * 2 + (h)) * HTB)
#define PG8_SB(b, h) ((4 + (b) * 2 + (h)) * HTB)
#define PG8_STAGE(bufoff, gbase, voff) do { _Pragma("unroll") for (int _i = 0; _i < 2; ++_i) \
        __builtin_amdgcn_global_load_lds((const unsigned*)((const char*)(gbase) + (voff)[_i]), (PG8_LAS unsigned*)(lds + (bufoff) + ldsw + _i * 8192), 16, 0, 0); } while (0)
#define PG8_LDA(dst, b, h) do { _Pragma("unroll") for (int m = 0; m < 4; ++m) _Pragma("unroll") for (int k = 0; k < 2; ++k) dst[m][k] = *(const PG8_LAS bf16x8*)(lds + PG8_SA(b, h) + aoff + m * 2048 + k * 1024); } while (0)
#define PG8_LDB(dst, b, h) do { _Pragma("unroll") for (int n = 0; n < 2; ++n) _Pragma("unroll") for (int k = 0; k < 2; ++k) dst[n][k] = *(const PG8_LAS bf16x8*)(lds + PG8_SB(b, h) + boff + n * 2048 + k * 1024); } while (0)
#define PG8_MMA(ai, bj, At, Bt) do { __builtin_amdgcn_s_setprio(1); _Pragma("unroll") for (int m = 0; m < 4; ++m) _Pragma("unroll") for (int n = 0; n < 2; ++n) _Pragma("unroll") for (int k = 0; k < 2; ++k) \
        acc[ai][bj][m][n] = __builtin_amdgcn_mfma_f32_16x16x32_bf16(Bt[n][k], At[m][k], acc[ai][bj][m][n], 0, 0, 0); __builtin_amdgcn_s_setprio(0); } while (0)
#define PG8_WAIT_V(n) asm volatile("s_waitcnt vmcnt(" #n ")" ::: "memory")
#define PG8_WAIT_L(n) asm volatile("s_waitcnt lgkmcnt(" #n ")" ::: "memory")
#define PG8_BAR __builtin_amdgcn_s_barrier()
#define PG8_SCHED __builtin_amdgcn_sched_barrier(0)
    Unit cur, nxt; int ui = 0;
    if (!S.next(0, cur)) return;
    f32x4 acc[2][2][4][2];
#pragma unroll
    for (int a = 0; a < 2; ++a)
#pragma unroll
        for (int b = 0; b < 2; ++b)
#pragma unroll
            for (int m = 0; m < 4; ++m)
#pragma unroll
                for (int n = 0; n < 2; ++n) acc[a][b][m][n] = (f32x4){0.f, 0.f, 0.f, 0.f};
    bf16x8 At[4][2], B0[2][2], B1[2][2];
    const char* cA = (const char*)g.A + (size_t)cur.gi * g.gsA + (size_t)cur.pm * tstepA; const char* cB = (const char*)g.Bt + (size_t)cur.gi * g.gsB + (size_t)cur.pn * tstepB;
    S.a_ready(cur);
    if constexpr (SP2) {
        PG8_STAGE(PG8_SB(0, 0), cB, voffB); PG8_STAGE(PG8_SB(0, 1), cB + hstepB, voffB); PG8_STAGE(PG8_SA(0, 0), cA, voffA); PG8_STAGE(PG8_SA(0, 1), cA + hstepA, voffA);
        if (wr == 1) PG8_BAR;
        PG8_WAIT_V(2); PG8_BAR;
        PG8_STAGE(PG8_SB(1, 0), cB + kstep, voffB); PG8_STAGE(PG8_SA(1, 0), cA + kstep, voffA); PG8_STAGE(PG8_SB(1, 1), cB + hstepB + kstep, voffB);
        PG8_WAIT_V(6); PG8_BAR;
    } else {
        PG8_STAGE(PG8_SB(0, 0), cB, voffB); PG8_STAGE(PG8_SA(0, 0), cA, voffA); PG8_STAGE(PG8_SB(0, 1), cB + hstepB, voffB); PG8_STAGE(PG8_SA(0, 1), cA + hstepA, voffA);
        if (wr == 1) PG8_BAR;
        PG8_WAIT_V(4); PG8_BAR;
        PG8_STAGE(PG8_SB(1, 0), cB + kstep, voffB); PG8_STAGE(PG8_SA(1, 0), cA + kstep, voffA); PG8_STAGE(PG8_SB(1, 1), cB + hstepB + kstep, voffB);
        PG8_WAIT_V(6); PG8_BAR;
    }
    for (;;) {
        const bool has_next = S.next(ui + 1, nxt);
        const char* nA = has_next ? (const char*)g.A + (size_t)nxt.gi * g.gsA + (size_t)nxt.pm * tstepA : cA; const char* nB = has_next ? (const char*)g.Bt + (size_t)nxt.gi * g.gsB + (size_t)nxt.pn * tstepB : cB;
        for (int t = 0; t < nt; t += 2) {
            const bool last = (t == nt - 2);
            const char* a1 = cA + (size_t)(t + 1) * kstep;
            const char* a2 = last ? nA : cA + (size_t)(t + 2) * kstep; const char* b2 = last ? nB : cB + (size_t)(t + 2) * kstep;
            const char* a3 = a2 + kstep; const char* b3 = b2 + kstep;
            if (last && has_next) S.a_ready(nxt);
            if constexpr (SP2) {
            PG8_LDB(B0, 0, 0); PG8_LDB(B1, 0, 1); PG8_SCHED; PG8_LDA(At, 0, 0); PG8_STAGE(PG8_SA(1, 1), a1 + hstepA, voffA);
            PG8_WAIT_V(8); PG8_WAIT_L(0); PG8_BAR; PG8_MMA(0, 0, At, B0); PG8_MMA(0, 1, At, B1); PG8_BAR; PG8_SCHED;
            PG8_LDA(At, 0, 1); PG8_STAGE(PG8_SB(0, 0), b2, voffB); PG8_STAGE(PG8_SB(0, 1), b2 + hstepB, voffB); PG8_STAGE(PG8_SA(0, 0), a2, voffA);
            PG8_WAIT_V(8); PG8_WAIT_L(0); PG8_BAR; PG8_MMA(1, 0, At, B0); PG8_MMA(1, 1, At, B1); PG8_BAR; PG8_SCHED;
            PG8_LDB(B0, 1, 0); PG8_LDB(B1, 1, 1); PG8_SCHED; PG8_LDA(At, 1, 0); PG8_STAGE(PG8_SA(0, 1), a2 + hstepA, voffA);
            PG8_WAIT_V(8); PG8_WAIT_L(0); PG8_BAR; PG8_MMA(0, 0, At, B0); PG8_MMA(0, 1, At, B1); PG8_BAR; PG8_SCHED;
            PG8_LDA(At, 1, 1); PG8_STAGE(PG8_SB(1, 0), b3, voffB); PG8_STAGE(PG8_SB(1, 1), b3 + hstepB, voffB); PG8_STAGE(PG8_SA(1, 0), a3, voffA);
            PG8_WAIT_V(8); PG8_WAIT_L(0); PG8_BAR; PG8_MMA(1, 0, At, B0); PG8_MMA(1, 1, At, B1); PG8_BAR; PG8_SCHED;
            } else {
            PG8_LDB(B0, 0, 0); PG8_SCHED; PG8_LDA(At, 0, 0); PG8_STAGE(PG8_SA(1, 1), a1 + hstepA, voffA);
            PG8_WAIT_L(8); PG8_BAR; PG8_WAIT_L(0); PG8_MMA(0, 0, At, B0); PG8_BAR; PG8_SCHED;
            PG8_LDB(B1, 0, 1); PG8_STAGE(PG8_SB(0, 0), b2, voffB);
            PG8_BAR; PG8_WAIT_L(0); PG8_MMA(0, 1, At, B1); PG8_BAR;
            PG8_LDA(At, 0, 1); PG8_STAGE(PG8_SA(0, 0), a2, voffA);
            PG8_BAR; PG8_WAIT_L(0); PG8_MMA(1, 0, At, B0); PG8_BAR; PG8_SCHED;
            PG8_STAGE(PG8_SB(0, 1), b2 + hstepB, voffB);
            PG8_WAIT_V(6); PG8_BAR; PG8_MMA(1, 1, At, B1); PG8_BAR;
            PG8_LDB(B0, 1, 0); PG8_SCHED; PG8_LDA(At, 1, 0); PG8_STAGE(PG8_SA(0, 1), a2 + hstepA, voffA);
            PG8_WAIT_L(8); PG8_BAR; PG8_WAIT_L(0); PG8_MMA(0, 0, At, B0); PG8_BAR; PG8_SCHED;
            PG8_LDB(B1, 1, 1); PG8_STAGE(PG8_SB(1, 0), b3, voffB);
            PG8_BAR; PG8_WAIT_L(0); PG8_MMA(0, 1, At, B1); PG8_BAR;
            PG8_LDA(At, 1, 1); PG8_STAGE(PG8_SA(1, 0), a3, voffA);
            PG8_BAR; PG8_WAIT_L(0); PG8_MMA(1, 0, At, B0); PG8_BAR; PG8_SCHED;
            PG8_STAGE(PG8_SB(1, 1), b3 + hstepB, voffB);
            PG8_WAIT_V(6); PG8_BAR; PG8_MMA(1, 1, At, B1); PG8_BAR;
            }
        }
        if constexpr (ALIGN_EPI) { if (wr == 0) PG8_BAR; }
        if constexpr (!Epi::AFTER_DRAIN) { E(acc, cur, wr, wc, fr, fq); S.done(cur); }
        if (!has_next) break;
#pragma unroll
        for (int a = 0; a < 2; ++a)
#pragma unroll
            for (int b = 0; b < 2; ++b)
#pragma unroll
                for (int m = 0; m < 4; ++m)
#pragma unroll
                    for (int n = 0; n < 2; ++n) acc[a][b][m][n] = (f32x4){0.f, 0.f, 0.f, 0.f};
        cur = nxt; cA = nA; cB = nB; ++ui;
        if constexpr (ALIGN_EPI) { if (wr == 1) PG8_BAR; }
    }
    PG8_WAIT_V(0);
    if constexpr (!ALIGN_EPI) { if (wr == 0) PG8_BAR; }
    PG8_BAR;
    if constexpr (Epi::AFTER_DRAIN) { E.fused(acc, cur, wr, wc, fr, fq, lds, wid, lane); S.done(cur); }
#undef PG8_SA
#undef PG8_SB
#undef PG8_STAGE
#undef PG8_LDA
#undef PG8_LDB
#undef PG8_MMA
#undef PG8_WAIT_V
#undef PG8_WAIT_L
#undef PG8_BAR
#undef PG8_SCHED
}
}

constexpr int TCTX = 4096, TLAT = 8192, TT = 12288, DM = 1024, NKEYROWS = 13312;
constexpr float EPSN = 1e-6f;
constexpr size_t MiB = 1u << 20;
constexpr size_t WS_MOD = 0, MOD_BYTES = 2 * 5 * 6144 * 4, WS_BAR = 262144, BAR_REGION = 16384, ZERO_BYTES = WS_BAR + 5 * BAR_REGION;
constexpr size_t WS_HID = 1 * MiB;
constexpr size_t WS_WIN = 3 * MiB  , WS_WG = 11 * MiB  , WS_WUQ = 15 * MiB, WS_WKN = 16 * MiB, WS_WVV = 16 * MiB + 262144, WS_WB = 17 * MiB, WS_WO = 20 * MiB, WS_WUP = 22 * MiB, WS_WDN = 33 * MiB;
constexpr size_t WS_U = 39 * MiB, WS_ACT = 171 * MiB, WS_HBF = 171 * MiB  , WS_HBF1 = 165 * MiB  ;
constexpr size_t WS_QA = 39 * MiB, WS_KVR = 51 * MiB, WS_CQ = 57 * MiB, WS_CKVR = 69 * MiB, WS_HYR = 75 * MiB, WS_OA = 75 * MiB, WS_OB = 87 * MiB, WS_OC = 99 * MiB;
constexpr size_t WS_UT = 111 * MiB, WS_QB = 147 * MiB, WS_CKVALL = 189 * MiB, WS_KPEALL = 196 * MiB, WS_KNB = 197 * MiB, WS_VTB = 210 * MiB, WS_KA = 223 * MiB, WS_VTA = 227 * MiB;
constexpr size_t WS_S0 = 232 * MiB  , WS_S1 = 111 * MiB, WS_S2 = 135 * MiB, WS_MBF = 195 * MiB, WS_END = 256 * MiB;
constexpr int KA_LAT = 16 * 2 * 256 * 64;
constexpr int UT_LAT = 16 * 1536 * 256;
constexpr int OUT_K = 12582912, OUT_V = 13631488, OUT_CKV = 14680064, OUT_KPE = 16777216;
constexpr int LDS_BYTES = 147456;
constexpr int NPHASE = 24;

#ifndef GAS
#define GAS __attribute__((address_space(1)))
#endif
#define LAS __attribute__((address_space(3)))
typedef unsigned short bf16;
typedef unsigned v4u __attribute__((ext_vector_type(4)));
typedef unsigned v2u __attribute__((ext_vector_type(2)));
typedef float f32x4 __attribute__((ext_vector_type(4)));
typedef float f32x16 __attribute__((ext_vector_type(16)));
typedef short bf16x8 __attribute__((ext_vector_type(8)));
typedef short bf16x4 __attribute__((ext_vector_type(4)));
#define LDS_WAIT() asm volatile("s_waitcnt lgkmcnt(0)" ::: "memory")
__device__ __forceinline__ unsigned f2bf(float f) { unsigned u = __builtin_bit_cast(unsigned, f); return (u + 0x7fffu + ((u >> 16) & 1u)) >> 16; }
__device__ __forceinline__ unsigned pk2(float lo, float hi) { return f2bf(lo) | (f2bf(hi) << 16); }
__device__ __forceinline__ float bflo(unsigned w) { return __uint_as_float(w << 16); }
__device__ __forceinline__ float bfhi(unsigned w) { return __uint_as_float(w & 0xffff0000u); }
__device__ __forceinline__ float bf1(bf16 b) { return __uint_as_float(((unsigned)b) << 16); }
__device__ __forceinline__ void fsincos(float x, float& s, float& c) { float rev = x * 0.15915494309189535f; rev = rev - rintf(rev); s = __builtin_amdgcn_sinf(rev); c = __builtin_amdgcn_cosf(rev); }
__device__ __forceinline__ float fsin(float x) { float rev = x * 0.15915494309189535f; rev = rev - rintf(rev); return __builtin_amdgcn_sinf(rev); }
__device__ __forceinline__ float wave_sum(float v) {
#pragma unroll
    for (int o = 1; o < 64; o <<= 1) v += __shfl_xor(v, o);
    return v;
}
__device__ __forceinline__ void rope2(float& x0, float& x1, float ang) { float s, c; fsincos(ang, s, c); const float a = x0 * c - x1 * s, b = x0 * s + x1 * c; x0 = a; x1 = b; }
#define L2_10000 13.287712379549449f

__device__ __forceinline__ void transpose_item(const float* W, size_t ldw, int k0, int n0, bf16* WT, size_t ldt, int drow0, LAS float* scr, int lane) {
    float wv[32];
#pragma unroll
    for (int i = 0; i < 32; ++i) wv[i] = ((const GAS float*)W)[(size_t)(k0 + 2 * i + (lane >> 5)) * ldw + n0 + (lane & 31)];
#pragma unroll
    for (int i = 0; i < 32; ++i) scr[(2 * i + (lane >> 5)) * 33 + (lane & 31)] = wv[i];
    LDS_WAIT(); asm volatile("" ::: "memory");
    const int c = lane & 7;
#pragma unroll
    for (int j = 0; j < 4; ++j) { const int n = (lane >> 3) + 8 * j; const LAS float* s = scr + (8 * c) * 33 + n;
        v4u o; o.x = pk2(s[0 * 33], s[1 * 33]); o.y = pk2(s[2 * 33], s[3 * 33]); o.z = pk2(s[4 * 33], s[5 * 33]); o.w = pk2(s[6 * 33], s[7 * 33]);
        *(GAS v4u*)(WT + (size_t)(drow0 + n) * ldt + k0 + 8 * c) = o; }
    LDS_WAIT(); asm volatile("" ::: "memory");
}

#define XB_TMO      128
#define XB_XCNT(j)  (256  + 64 * (j))
#define XB_XSUB(j)  (1280 + 64 * (j))
#define XB_XGEN(j)  (2304 + 64 * (j))
#define XB_TOP      3328
#define XB_TOPGEN   3392
#define XCD_BAR_WORDS 3456
#define XB_SPIN_CAP (1u << 18)

__device__ __forceinline__ unsigned xb_ld(unsigned* p)              { return __hip_atomic_load(p, __ATOMIC_RELAXED, __HIP_MEMORY_SCOPE_AGENT); }
__device__ __forceinline__ unsigned xb_add(unsigned* p, unsigned v) { return __hip_atomic_fetch_add(p, v, __ATOMIC_RELAXED, __HIP_MEMORY_SCOPE_AGENT); }
__device__ __forceinline__ unsigned xb_xcc_id() { return (unsigned)__builtin_amdgcn_s_getreg((3 << 11) | 20) & 0xFu; }
#define XB_SPIN(cond, bar) do { unsigned _sp = 0; while (cond) { __builtin_amdgcn_s_sleep(1); \
    if ((++_sp & 255u) == 0u) { if (xb_ld(&(bar)[XB_TMO])) break; if (_sp > XB_SPIN_CAP) { atomicAdd(&(bar)[XB_TMO], 1u); break; } } } } while (0)

struct XcdBarrier {
    unsigned* bar; unsigned x;
    volatile LAS unsigned* st;
};

__device__ __forceinline__ XcdBarrier xcd_barrier_post(unsigned* bar, volatile LAS unsigned* st) {
    XcdBarrier b; b.bar = bar; b.x = xb_xcc_id(); b.st = st;
    if (threadIdx.x == 0) (void)xb_add(&bar[XB_XCNT(b.x)], 1u);
    return b;
}
__device__ __forceinline__ void xcd_barrier_complete(unsigned* bar, unsigned x, unsigned& nloc, unsigned& nx) {
    const unsigned G = gridDim.x * gridDim.y * gridDim.z;
    unsigned sum, cnt, mine, sp = 0u;
    for (;;) {
        sum = 0u; cnt = 0u; mine = 0u;
#pragma unroll
        for (unsigned j = 0; j < 16; ++j) { const unsigned c = xb_ld(&bar[XB_XCNT(j)]); sum += c; cnt += (c > 0u) ? 1u : 0u; mine = (j == x) ? c : mine; }
        if (sum == G) break;
        __builtin_amdgcn_s_sleep(1);
        if ((++sp & 255u) == 0u) { if (xb_ld(&bar[XB_TMO])) break; if (sp > XB_SPIN_CAP) { atomicAdd(&bar[XB_TMO], 1u); break; } }
    }
    nloc = mine > 0u ? mine : 1u; nx = cnt > 0u ? cnt : 1u;
}

__device__ __forceinline__ void xcd_barrier(const XcdBarrier& b) {
    asm volatile("s_waitcnt vmcnt(0)" ::: "memory");
    __syncthreads();
    if (threadIdx.x == 0) {
        unsigned* bar = b.bar;
        __builtin_amdgcn_s_waitcnt(0);
        unsigned nloc = b.st[0], nx = b.st[1];
        if (nloc == 0u) { xcd_barrier_complete(bar, b.x, nloc, nx); b.st[0] = nloc; b.st[1] = nx; }
        const unsigned old = xb_add(&bar[XB_XSUB(b.x)], 1u);
        const unsigned gen = old / nloc;
        if (old + 1u == (gen + 1u) * nloc) {
            __builtin_amdgcn_fence(__ATOMIC_RELEASE, "agent");
            asm volatile("s_waitcnt vmcnt(0)" ::: "memory");
            const unsigned og = xb_add(&bar[XB_TOP], 1u);
            const unsigned tg = og / nx;
            if (og + 1u == (tg + 1u) * nx) xb_add(&bar[XB_TOPGEN], 1u);
            else XB_SPIN(xb_ld(&bar[XB_TOPGEN]) == tg, bar);
            __builtin_amdgcn_fence(__ATOMIC_ACQUIRE, "agent");
            xb_add(&bar[XB_XGEN(b.x)], 1u);
            asm volatile("s_waitcnt vmcnt(0)" ::: "memory");
        } else {
            XB_SPIN(xb_ld(&bar[XB_XGEN(b.x)]) == gen, bar);
            __builtin_amdgcn_fence(__ATOMIC_ACQUIRE, "agent");
            asm volatile("s_waitcnt vmcnt(0)" ::: "memory");
        }
    }
    __syncthreads();
}


struct Args { const float* in[35]; float* out; unsigned char* ws; int ph_lo, ph_hi, li, pad; };

__device__ __forceinline__ void wconv_phase(const Args& a, int l, LAS unsigned char* lds, int gw, int NGW, int gt, int NGT, int wave, int lane) {
    LAS float* scr = (LAS float*)(lds + wave * 16384);
    unsigned char* ws = a.ws;
    bf16 *WIN = (bf16*)(ws + WS_WIN), *WG = (bf16*)(ws + WS_WG), *WUQ = (bf16*)(ws + WS_WUQ), *WKN = (bf16*)(ws + WS_WKN), *WVV = (bf16*)(ws + WS_WVV), *WB = (bf16*)(ws + WS_WB), *WO = (bf16*)(ws + WS_WO), *WUP = (bf16*)(ws + WS_WUP), *WDN = (bf16*)(ws + WS_WDN);
    constexpr int I1 = 16 * 189, I2 = 6 * 24, I3 = 4 * 32, I4 = 3 * 8 * 32, I5 = 16 * 32, I6 = 16 * 176, I7 = 44 * 32, NIT = I1 + I2 + I3 + I4 + I5 + I6 + I7;
    for (int it = gw; it < NIT; it += NGW) {
        int r = it;
        if (r < I1) { const int kb = r / 189, n0 = 32 * (r % 189); bf16* dst = WIN; int drow;
            if (n0 < 1152) drow = n0; else if (n0 < 1408) drow = n0 + 128; else if (n0 < 1440) drow = 1152 + (n0 - 1408); else if (n0 < 2976) drow = 1536 + (n0 - 1440); else if (n0 < 4000) drow = 3072 + (n0 - 2976); else { dst = WG; drow = n0 - 4000; }
            transpose_item(a.in[12] + (size_t)l * 1024 * 6048, 6048, 64 * kb, n0, dst, 1024, drow, scr, lane); continue; } r -= I1;
        if (r < I2) { const int kb = r / 24, n0 = 32 * (r % 24); transpose_item(a.in[17] + (size_t)l * 384 * 768, 768, 64 * kb, n0, WUQ, 384, n0, scr, lane); continue; } r -= I2;
        if (r < I3) { const int kb = r / 32, n0 = 32 * (r % 32); const int h = n0 >> 7, c0 = n0 & 127;
            transpose_item(a.in[18] + (size_t)l * 256 * 1024, 1024, 64 * kb, n0, (c0 < 64) ? WKN : WVV, 256, h * 64 + (c0 & 63), scr, lane); continue; } r -= I3;
        if (r < I4) { const int n = r / 256, q = r % 256, kb = q / 32, n0 = 32 * (q % 32);
            transpose_item(a.in[28] + ((size_t)l * 3 + n) * 512 * 1024, 1024, 64 * kb, n0, WB + (size_t)n * 1024 * 512, 512, n0, scr, lane); continue; } r -= I4;
        if (r < I5) { const int kb = r / 32, n0 = 32 * (r % 32); transpose_item(a.in[29] + (size_t)l * 1024 * 1024, 1024, 64 * kb, n0, WO, 1024, n0, scr, lane); continue; } r -= I5;
        if (r < I6) { const int kb = r / 176, n0 = 32 * (r % 176); transpose_item(a.in[30] + (size_t)l * 1024 * 5632, 5632, 64 * kb, n0, WUP, 1024, n0, scr, lane); continue; } r -= I6;
        { const int kb = r / 32, n0 = 32 * (r % 32); transpose_item(a.in[33] + (size_t)l * 2816 * 1024, 1024, 64 * kb, n0, WDN, 2816, n0, scr, lane); }
    }
    for (int i = gt; i < 96 * 1024 / 8; i += NGT) *(GAS v4u*)(WIN + (size_t)1184 * 1024 + (size_t)i * 8) = (v4u){0u, 0u, 0u, 0u};
}

__device__ __forceinline__ void norm_phase(const Args& a, int l, int which, bool first, int gw, int NGW, int lane) {
    const GAS float* mod = (const GAS float*)(a.ws + WS_MOD) + (size_t)l * 5 * 6144;
    GAS bf16* HBF = (GAS bf16*)(a.ws + (which == 0 ? WS_HBF1 : WS_HBF));
    const GAS float* gv = (const GAS float*)((which == 0) ? a.in[10] + l * 1024 : (which == 1) ? a.in[11] + l * 1024 : a.in[34]);
    GAS float* outp = (GAS float*)a.out;
    const int shoff = (which == 0) ? 0 : 3072, scoff = shoff + 1024;
    #pragma unroll 1
    for (int row0 = gw; row0 < TT; row0 += 4 * NGW) {
        f32x4 v[4][4];
#pragma unroll
        for (int q = 0; q < 4; ++q) { const int row = row0 + q * NGW; const int rr = row < TT ? row : row0;
            const GAS float* src = first ? (const GAS float*)(rr < TCTX ? a.in[0] + (size_t)rr * DM : a.in[1] + (size_t)(rr - TCTX) * DM) : (const GAS float*)(outp + (size_t)rr * DM);
#pragma unroll
            for (int j = 0; j < 4; ++j) v[q][j] = *(const GAS f32x4*)(src + 4 * lane + 256 * j); }
#pragma unroll
        for (int q = 0; q < 4; ++q) { const int row = row0 + q * NGW; if (row >= TT) continue;
            float ss = 0.f;
#pragma unroll
            for (int j = 0; j < 4; ++j) ss += (v[q][j].x * v[q][j].x + v[q][j].y * v[q][j].y) + (v[q][j].z * v[q][j].z + v[q][j].w * v[q][j].w);
            if (first) {
#pragma unroll
                for (int j = 0; j < 4; ++j) *(GAS f32x4*)(outp + (size_t)row * DM + 4 * lane + 256 * j) = v[q][j]; }
            const float rs = rsqrtf(wave_sum(ss) * (1.f / DM) + EPSN);
            const int mrow = row < TCTX ? 0 : 1 + ((row - TCTX) >> 11);
            const GAS float* mp = mod + (size_t)mrow * 6144;
#pragma unroll
            for (int j = 0; j < 4; ++j) { const int col = 4 * lane + 256 * j; const f32x4 g = *(const GAS f32x4*)(gv + col);
                if (which == 2) { *(GAS f32x4*)(outp + (size_t)row * DM + col) = v[q][j] * rs * g; }
                else { const f32x4 sc = *(const GAS f32x4*)(mp + scoff + col), sh = *(const GAS f32x4*)(mp + shoff + col);
                    const f32x4 y = v[q][j] * rs * g * (sc + 1.f) + sh;
                    *(GAS v2u*)(HBF + (size_t)row * DM + col) = (v2u){pk2(y.x, y.y), pk2(y.z, y.w)}; } } }
    }
}
__device__ __forceinline__ void p0_mod_hid(const Args& a, LAS unsigned char* lds, int bid, int G, int tid, int gw, int NGW, int lane) {
    float* mod = (float*)(a.ws + WS_MOD);
    LAS float* sc = (LAS float*)lds;
    for (int it = bid; it < 384; it += G) {
        const int l = it / 192, rem = it % 192, kc = rem / 12, jb = rem % 12;
        if (tid < 320) { const int r = tid >> 6, kk = tid & 63, k = kc * 64 + kk; const float cv = (r == 0) ? a.in[7][k] : a.in[6][(r - 1) * 1024 + k]; sc[tid] = cv / (1.f + __expf(-cv)); }
        __syncthreads();
        const int j = jb * 512 + tid;
        const GAS float* wp = (const GAS float*)(a.in[8] + ((size_t)l * 1024 + kc * 64) * 6144 + j);
        float acc[5] = {0.f, 0.f, 0.f, 0.f, 0.f};
#pragma unroll 8
        for (int kk = 0; kk < 64; ++kk) { const float w = wp[(size_t)kk * 6144];
#pragma unroll
            for (int r = 0; r < 5; ++r) acc[r] += sc[r * 64 + kk] * w; }
        const float bias = (kc == 0) ? a.in[9][l * 6144 + j] : 0.f;
#pragma unroll
        for (int r = 0; r < 5; ++r) atomicAdd(mod + (size_t)(l * 5 + r) * 6144 + j, acc[r] + bias);
        __syncthreads();
    }
    float* HID = (float*)(a.ws + WS_HID);
    for (int it = gw; it < 2 * 2304; it += NGW) {
        const int l = it / 2304, q = it % 2304; const int L = q < 256 ? 256 : 2048, t = q < 256 ? q : q - 256;
        const float tn = (float)t / (float)(L - 1);
        float zi = 0.f;
        if (lane == 0) zi = tn;
        else if (lane <= 16) { const int bi = (lane - 1) & 7; const float band = 1e-4f + (float)bi * ((7.f - 1e-4f) / 7.f); const float ang = (6.283185307179586f / (float)L) * (float)t * band; float s, c; fsincos(ang, s, c); zi = (lane <= 8) ? c : -s; }
        float s1 = a.in[22][l * 64 + lane];
#pragma unroll
        for (int i = 0; i < 17; ++i) s1 += __shfl(zi, i) * a.in[21][(l * 17 + i) * 64 + lane];
        const float h1 = fsin(a.in[26][(l * 2 + 0) * 64 + lane] * s1);
        float s2 = a.in[24][l * 64 + lane];
#pragma unroll 8
        for (int i = 0; i < 64; ++i) s2 += __shfl(h1, i) * a.in[23][(l * 64 + i) * 64 + lane];
        HID[(size_t)it * 64 + lane] = fsin(a.in[26][(l * 2 + 1) * 64 + lane] * s2);
    }
}

__device__ __forceinline__ void post_phase(const Args& a, int l, LAS unsigned char* lds, int bid, int G, int tid, int gw, int NGW, int gt, int NGT, int lane) {
    unsigned char* ws = a.ws;
    GAS bf16 *QA = (GAS bf16*)(ws + WS_QA), *KVR = (GAS bf16*)(ws + WS_KVR), *CQ = (GAS bf16*)(ws + WS_CQ), *CKVR = (GAS bf16*)(ws + WS_CKVR), *HYR = (GAS bf16*)(ws + WS_HYR);
    GAS bf16 *UT = (GAS bf16*)(ws + WS_UT), *CKVALL = (GAS bf16*)(ws + WS_CKVALL), *KPEALL = (GAS bf16*)(ws + WS_KPEALL), *KA = (GAS bf16*)(ws + WS_KA), *VTA = (GAS bf16*)(ws + WS_VTA);
    GAS float* outp = (GAS float*)a.out;
    for (int i = gt; i < 4 * 256 * 128; i += NGT) { const int b = i >> 15, p = (i >> 7) & 255, kvh = (i >> 6) & 1, d = i & 63;
        const size_t s = ((size_t)(b * 2 + l) * 256 + p) * 128 + kvh * 64 + d;
        KA[KA_LAT + ((b * 2 + kvh) * 2304 + p) * 64 + d] = (bf16)f2bf(a.in[2][s]);
        VTA[KA_LAT + ((b * 2 + kvh) * 64 + d) * 2304 + p] = (bf16)f2bf(a.in[3][s]); }
    for (int i = gt; i < 4 * 256 * 256; i += NGT) { const int b = i >> 16, p = (i >> 8) & 255, j = i & 255;
        CKVALL[(size_t)(TCTX + b * 2304 + p) * 256 + j] = (bf16)f2bf(a.in[4][((size_t)(b * 2 + l) * 256 + p) * 256 + j]); }
    for (int i = gt; i < 4 * 256 * 32; i += NGT) { const int b = i >> 13, p = (i >> 5) & 255, j = i & 31;
        KPEALL[(size_t)(TCTX + b * 2304 + p) * 32 + j] = (bf16)f2bf(a.in[5][((size_t)(b * 2 + l) * 256 + p) * 32 + j]); }
    const GAS float *gq = (const GAS float*)(a.in[13] + l * 64), *gk = (const GAS float*)(a.in[14] + l * 64), *gcq = (const GAS float*)(a.in[15] + l * 384), *gkv = (const GAS float*)(a.in[16] + l * 256);
    for (int row = gw; row < TT; row += NGW) {
        const bool lat = row >= TCTX;
        const int b = lat ? (row - TCTX) >> 11 : row >> 8, t = lat ? (row - TCTX) & 2047 : row & 255;
        const float grow = (float)(t >> 6), gcol = (float)(t & 63);
        const int keyrow = lat ? TCTX + b * 2304 + 256 + t : row;
        { v4u w = *(const GAS v4u*)(QA + (size_t)row * 512 + 8 * lane);
          float x[8] = {bflo(w.x), bfhi(w.x), bflo(w.y), bfhi(w.y), bflo(w.z), bfhi(w.z), bflo(w.w), bfhi(w.w)};
          float ss = 0.f;
#pragma unroll
          for (int j = 0; j < 8; ++j) ss += x[j] * x[j];
          ss += __shfl_xor(ss, 1); ss += __shfl_xor(ss, 2); ss += __shfl_xor(ss, 4);
          const float rs = rsqrtf(ss * (1.f / 64.f) + EPSN); const int d0 = 8 * (lane & 7);
#pragma unroll
          for (int j = 0; j < 8; ++j) x[j] = x[j] * rs * gq[d0 + j];
          if (lat) {
#pragma unroll
              for (int k = 0; k < 4; ++k) { const int i = 4 * (lane & 7) + k; const float inv = __builtin_amdgcn_exp2f(-(float)(i & 15) * (L2_10000 / 16.f)); rope2(x[2 * k], x[2 * k + 1], (i < 16 ? grow : gcol) * inv); } }
          *(GAS v4u*)(QA + (size_t)row * 512 + 8 * lane) = (v4u){pk2(x[0], x[1]), pk2(x[2], x[3]), pk2(x[4], x[5]), pk2(x[6], x[7])}; }
        { const v2u w = *(const GAS v2u*)(KVR + (size_t)row * 256 + 4 * lane);
          float x[4] = {bflo(w.x), bfhi(w.x), bflo(w.y), bfhi(w.y)};
          float ss = (x[0] * x[0] + x[1] * x[1]) + (x[2] * x[2] + x[3] * x[3]);
          ss += __shfl_xor(ss, 1); ss += __shfl_xor(ss, 2); ss += __shfl_xor(ss, 4); ss += __shfl_xor(ss, 8);
          const int kvh = (lane >> 4) & 1, d0 = 4 * (lane & 15);
          if (lane < 32) {
              const float rs = rsqrtf(ss * (1.f / 64.f) + EPSN);
#pragma unroll
              for (int j = 0; j < 4; ++j) x[j] = x[j] * rs * gk[d0 + j];
              if (!lat) { *(GAS f32x4*)(outp + OUT_K + ((size_t)(b * 2 + l) * 256 + t) * 128 + kvh * 64 + d0) = (f32x4){x[0], x[1], x[2], x[3]};
                  *(GAS v2u*)(KA + ((size_t)(b * 2 + kvh) * 256 + t) * 64 + d0) = (v2u){pk2(x[0], x[1]), pk2(x[2], x[3])}; }
              else {
#pragma unroll
                  for (int k = 0; k < 2; ++k) { const int i = 2 * (lane & 15) + k; const float inv = __builtin_amdgcn_exp2f(-(float)(i & 15) * (L2_10000 / 16.f)); rope2(x[2 * k], x[2 * k + 1], (i < 16 ? grow : gcol) * inv); }
                  *(GAS v2u*)(KA + KA_LAT + ((size_t)(b * 2 + kvh) * 2304 + 256 + t) * 64 + d0) = (v2u){pk2(x[0], x[1]), pk2(x[2], x[3])}; }
          } else {
              if (!lat) { *(GAS f32x4*)(outp + OUT_V + ((size_t)(b * 2 + l) * 256 + t) * 128 + kvh * 64 + d0) = (f32x4){x[0], x[1], x[2], x[3]};
#pragma unroll
                  for (int j = 0; j < 4; ++j) VTA[((size_t)(b * 2 + kvh) * 64 + d0 + j) * 256 + t] = (bf16)f2bf(x[j]); }
              else {
#pragma unroll
                  for (int j = 0; j < 4; ++j) VTA[KA_LAT + ((size_t)(b * 2 + kvh) * 64 + d0 + j) * 2304 + 256 + t] = (bf16)f2bf(x[j]); }
          } }
        { GAS unsigned* p = (GAS unsigned*)(CQ + (size_t)row * 512 + 6 * lane);
          const unsigned w0 = p[0], w1 = p[1], w2 = p[2];
          float x[6] = {bflo(w0), bfhi(w0), bflo(w1), bfhi(w1), bflo(w2), bfhi(w2)};
          float ss = 0.f;
#pragma unroll
          for (int j = 0; j < 6; ++j) ss += x[j] * x[j];
          const float rs = rsqrtf(wave_sum(ss) * (1.f / 384.f) + EPSN);
#pragma unroll
          for (int j = 0; j < 6; ++j) x[j] = x[j] * rs * gcq[6 * lane + j];
          p[0] = pk2(x[0], x[1]); p[1] = pk2(x[2], x[3]); p[2] = pk2(x[4], x[5]);
          if (lane < 16) { const unsigned w = *(const GAS unsigned*)(CQ + (size_t)row * 512 + 384 + 2 * lane); float y0 = bflo(w), y1 = bfhi(w);
              if (!lat) { outp[OUT_KPE + ((size_t)(b * 2 + l) * 256 + t) * 32 + 2 * lane] = y0; outp[OUT_KPE + ((size_t)(b * 2 + l) * 256 + t) * 32 + 2 * lane + 1] = y1; }
              else { const float inv = __builtin_amdgcn_exp2f(-(float)(lane & 7) * (L2_10000 / 8.f)); rope2(y0, y1, (lane < 8 ? grow : gcol) * inv); }
              *(GAS unsigned*)(KPEALL + (size_t)keyrow * 32 + 2 * lane) = pk2(y0, y1); } }
        { const v2u w = *(const GAS v2u*)(CKVR + (size_t)row * 256 + 4 * lane);
          float x[4] = {bflo(w.x), bfhi(w.x), bflo(w.y), bfhi(w.y)};
          const float ss = (x[0] * x[0] + x[1] * x[1]) + (x[2] * x[2] + x[3] * x[3]);
          const float rs = rsqrtf(wave_sum(ss) * (1.f / 256.f) + EPSN);
#pragma unroll
          for (int j = 0; j < 4; ++j) x[j] = x[j] * rs * gkv[4 * lane + j];
          if (!lat) *(GAS f32x4*)(outp + OUT_CKV + ((size_t)(b * 2 + l) * 256 + t) * 256 + 4 * lane) = (f32x4){x[0], x[1], x[2], x[3]};
          *(GAS v2u*)(CKVALL + (size_t)keyrow * 256 + 4 * lane) = (v2u){pk2(x[0], x[1]), pk2(x[2], x[3])}; }
    }
    LAS float* tile = (LAS float*)lds;
    const GAS float *sw = (const GAS float*)(a.in[19] + (size_t)l * 3 * 1536), *sb = (const GAS float*)(a.in[20] + (size_t)l * 1536);
    for (int it = bid; it < 96 * 12; it += G) {
        const int tb = it / 12, cb = it % 12, row0 = tb * 128;
        const bool lat = row0 >= TCTX; const int L = lat ? 2048 : 256;
        const int b = lat ? (row0 - TCTX) >> 11 : row0 >> 8, t0 = lat ? (row0 - TCTX) & 2047 : row0 & 255;
        v4u w[4], wh = (v4u){0u, 0u, 0u, 0u};
        { const int rr = tid >> 4, c8 = tid & 15;
#pragma unroll
          for (int q = 0; q < 4; ++q) w[q] = *(const GAS v4u*)(HYR + (size_t)(row0 + rr + 32 * q) * 1536 + cb * 128 + 8 * c8);
          if (tid < 32) { const int which = tid >> 4; const bool ok = which ? (t0 + 128 < L) : (t0 > 0); const int rsrc = which ? row0 + 128 : row0 - 1;
              if (ok) wh = *(const GAS v4u*)(HYR + (size_t)rsrc * 1536 + cb * 128 + 8 * c8); }
#pragma unroll
          for (int q = 0; q < 4; ++q) { LAS float* tp = tile + (rr + 32 * q + 1) * 129 + 8 * c8;
              tp[0] = bflo(w[q].x); tp[1] = bfhi(w[q].x); tp[2] = bflo(w[q].y); tp[3] = bfhi(w[q].y); tp[4] = bflo(w[q].z); tp[5] = bfhi(w[q].z); tp[6] = bflo(w[q].w); tp[7] = bfhi(w[q].w); }
          if (tid < 32) { LAS float* tp = tile + ((tid >> 4) ? 129 : 0) * 129 + 8 * c8;
              tp[0] = bflo(wh.x); tp[1] = bfhi(wh.x); tp[2] = bflo(wh.y); tp[3] = bfhi(wh.y); tp[4] = bflo(wh.z); tp[5] = bfhi(wh.z); tp[6] = bflo(wh.w); tp[7] = bfhi(wh.w); } }
        __syncthreads();
        { const int c = tid >> 2, tc = tid & 3, cg_ = cb * 128 + c; const float w0 = sw[cg_], w1 = sw[1536 + cg_], w2 = sw[3072 + cg_], bb = sb[cg_];
          const size_t base = lat ? (size_t)UT_LAT + ((size_t)b * 1536 + cg_) * 2048 : ((size_t)b * 1536 + cg_) * 256;
#pragma unroll
          for (int q = 0; q < 4; ++q) { float u[8];
#pragma unroll
              for (int k = 0; k < 8; ++k) { const int tr = 32 * tc + 8 * q + k; u[k] = w0 * tile[tr * 129 + c] + w1 * tile[(tr + 1) * 129 + c] + w2 * tile[(tr + 2) * 129 + c] + bb; }
              *(GAS v4u*)(UT + base + t0 + 32 * tc + 8 * q) = (v4u){pk2(u[0], u[1]), pk2(u[2], u[3]), pk2(u[4], u[5]), pk2(u[6], u[7])}; } }
        __syncthreads();
    }
}

__device__ __forceinline__ void ffnconv_phase(const Args& a, int l, int gt, int NGT) {
    const GAS bf16* U = (const GAS bf16*)(a.ws + WS_U); GAS bf16* ACT = (GAS bf16*)(a.ws + WS_ACT);
    const GAS float *cw = (const GAS float*)(a.in[31] + (size_t)l * 3 * 5632), *cb = (const GAS float*)(a.in[32] + (size_t)l * 5632);
#pragma unroll 1
    for (int idx = gt; idx < 1536 * 352; idx += NGT) {
        const int tb = idx / 352, ch = idx % 352, row0 = tb * 8, c0 = ch * 8;
        const bool lat = row0 >= TCTX; const int t0 = lat ? (row0 - TCTX) & 2047 : row0 & 255, L = lat ? 2048 : 256;
        v4u ra[10], rg[10];
#pragma unroll
        for (int i = 0; i < 10; ++i) { const int t = t0 + i - 1; const bool ok = (t >= 0) && (t < L); const size_t rr = (size_t)(row0 + (ok ? i - 1 : 0)) * 5632 + c0;
            ra[i] = *(const GAS v4u*)(U + rr); rg[i] = *(const GAS v4u*)(U + rr + 2816);
            if (!ok) { ra[i] = (v4u){0u, 0u, 0u, 0u}; rg[i] = (v4u){0u, 0u, 0u, 0u}; } }
        float wa[3][8], wg[3][8], ba[8], bg[8];
#pragma unroll
        for (int j = 0; j < 8; ++j) { ba[j] = cb[c0 + j]; bg[j] = cb[2816 + c0 + j];
#pragma unroll
            for (int k = 0; k < 3; ++k) { wa[k][j] = cw[k * 5632 + c0 + j]; wg[k][j] = cw[k * 5632 + 2816 + c0 + j]; } }
#pragma unroll
        for (int i = 0; i < 8; ++i) {
            float o[8];
#pragma unroll
            for (int j2 = 0; j2 < 4; ++j2) {
                const unsigned a0 = ra[i][j2], a1 = ra[i + 1][j2], a2 = ra[i + 2][j2], g0 = rg[i][j2], g1 = rg[i + 1][j2], g2 = rg[i + 2][j2];
                { const int j = 2 * j2; const float av = wa[0][j] * bflo(a0) + wa[1][j] * bflo(a1) + wa[2][j] * bflo(a2) + ba[j], gv = wg[0][j] * bflo(g0) + wg[1][j] * bflo(g1) + wg[2][j] * bflo(g2) + bg[j]; o[j] = gv * __builtin_amdgcn_rcpf(1.f + __expf(-gv)) * av; }
                { const int j = 2 * j2 + 1; const float av = wa[0][j] * bfhi(a0) + wa[1][j] * bfhi(a1) + wa[2][j] * bfhi(a2) + ba[j], gv = wg[0][j] * bfhi(g0) + wg[1][j] * bfhi(g1) + wg[2][j] * bfhi(g2) + bg[j]; o[j] = gv * __builtin_amdgcn_rcpf(1.f + __expf(-gv)) * av; } }
            *(GAS v4u*)(ACT + (size_t)(row0 + i) * 2816 + c0) = (v4u){pk2(o[0], o[1]), pk2(o[2], o[3]), pk2(o[4], o[5]), pk2(o[6], o[7])};
        }
    }
}
typedef float f32x2_t __attribute__((ext_vector_type(2)));
typedef __bf16 bf16x2_t __attribute__((ext_vector_type(2)));
__device__ __forceinline__ unsigned cvtpk(float lo, float hi) { const f32x2_t v = {lo, hi}; const bf16x2_t b = __builtin_convertvector(v, bf16x2_t); return __builtin_bit_cast(unsigned, b); }
template <int DK>
__device__ __forceinline__ void attn_unit(LAS unsigned char* lds, int tid, const bf16* Qp, int qpitch, const bf16* Kp, int kpitch, const bf16* Kpe, const bf16* Vt, size_t vpitch,
                                          int nkeys, bf16* Op, int opitch, float sl2, bool rope, int pos0) {
    constexpr int NS = DK / 16;
    asm volatile("" : "+v"(tid));
    const int lane = tid & 63, wave = tid >> 6, r = lane & 31, h = lane >> 5;
    bf16x8 qf[NS];
    { const bf16* qrow = Qp + (size_t)(wave * 32 + r) * qpitch;
#pragma unroll
      for (int s = 0; s < NS; ++s) qf[s] = *(const GAS bf16x8*)(qrow + 16 * s + 8 * h);
      if (DK == 96 && rope) { const int t = pos0 + wave * 32 + r; const float grow = (float)(t >> 6), gcol = (float)(t & 63);
#pragma unroll
          for (int sp = 0; sp < 2; ++sp) { bf16x8 v = qf[NS - 2 + sp];
#pragma unroll
              for (int k = 0; k < 4; ++k) { float x0 = bf1((bf16)v[2 * k]), x1 = bf1((bf16)v[2 * k + 1]);
                  const float inv = __builtin_amdgcn_exp2f(-(float)(4 * h + k) * (L2_10000 / 8.f)); rope2(x0, x1, (sp == 0 ? grow : gcol) * inv);
                  v[2 * k] = (short)f2bf(x0); v[2 * k + 1] = (short)f2bf(x1); }
              qf[NS - 2 + sp] = v; } } }
    const int kkey = tid >> 3, kch = tid & 7, pkey = tid >> 2, pch = tid & 3;
    f32x16 o0, o1;
#pragma unroll
    for (int i = 0; i < 16; ++i) { o0[i] = 0.f; o1[i] = 0.f; }
    float mrun = -__builtin_inff(), lrun = 0.f;
    v4u rk, rv, rp = (v4u){0u, 0u, 0u, 0u};
    const int ntile = nkeys >> 6;
#define ATT_LOAD(kt) do { const int key0 = (kt) * 64; rk = *(const GAS v4u*)(Kp + (size_t)(key0 + kkey) * kpitch + 8 * kch); rv = *(const GAS v4u*)(Vt + (size_t)kkey * vpitch + key0 + 8 * kch); \
        if (DK == 96 && tid < 256) rp = *(const GAS v4u*)(Kpe + (size_t)(key0 + pkey) * 32 + 8 * pch); } while (0)
#define ATT_WRITE(buf) do { *(LAS v4u*)(lds + (buf) * 13312 + kkey * 208 + kch * 16) = rk; \
        { LAS unsigned char* vw = lds + 26624 + (buf) * 9216 + kkey * 144 + (kch >> 1) * 32 + (kch & 1) * 8; *(LAS v2u*)vw = (v2u){rv.x, rv.y}; *(LAS v2u*)(vw + 16) = (v2u){rv.z, rv.w}; } \
        if (DK == 96 && tid < 256) *(LAS v4u*)(lds + (buf) * 13312 + pkey * 208 + 128 + pch * 16) = rp; } while (0)
    ATT_LOAD(0); ATT_WRITE(0); __syncthreads();
    for (int kt = 0; kt < ntile; ++kt) {
        const int buf = kt & 1;
        if (kt + 1 < ntile) ATT_LOAD(kt + 1);
        const LAS unsigned char* kb = lds + buf * 13312; const LAS unsigned char* vb = lds + 26624 + buf * 9216;
        f32x16 s0, s1;
#pragma unroll
        for (int i = 0; i < 16; ++i) { s0[i] = 0.f; s1[i] = 0.f; }
#pragma unroll
        for (int s = 0; s < NS; ++s) {
            const bf16x8 a0 = *(const LAS bf16x8*)(kb + r * 208 + (16 * s + 8 * h) * 2), a1 = *(const LAS bf16x8*)(kb + (32 + r) * 208 + (16 * s + 8 * h) * 2);
            s0 = __builtin_amdgcn_mfma_f32_32x32x16_bf16(a0, qf[s], s0, 0, 0, 0); s1 = __builtin_amdgcn_mfma_f32_32x32x16_bf16(a1, qf[s], s1, 0, 0, 0); }
        float mx = s0[0];
#pragma unroll
        for (int i = 1; i < 16; ++i) mx = fmaxf(mx, s0[i]);
#pragma unroll
        for (int i = 0; i < 16; ++i) mx = fmaxf(mx, s1[i]);
        mx = fmaxf(mx, __shfl_xor(mx, 32));
        const float mnew = fmaxf(mrun, mx), alpha = __builtin_amdgcn_exp2f((mrun - mnew) * sl2), nm = mnew * sl2;
        float sum = 0.f;
#pragma unroll
        for (int i = 0; i < 16; ++i) { s0[i] = __builtin_amdgcn_exp2f(s0[i] * sl2 - nm); s1[i] = __builtin_amdgcn_exp2f(s1[i] * sl2 - nm); sum += s0[i] + s1[i]; }
        lrun = lrun * alpha + sum; mrun = mnew;
        if (__builtin_amdgcn_ballot_w64(alpha != 1.f)) {
#pragma unroll
            for (int i = 0; i < 16; ++i) { o0[i] *= alpha; o1[i] *= alpha; } }
#pragma unroll
        for (int sub = 0; sub < 2; ++sub) {
#pragma unroll
            for (int s2 = 0; s2 < 2; ++s2) {
                const v4u pw = (sub == 0) ? (v4u){cvtpk(s0[8 * s2], s0[8 * s2 + 1]), cvtpk(s0[8 * s2 + 2], s0[8 * s2 + 3]), cvtpk(s0[8 * s2 + 4], s0[8 * s2 + 5]), cvtpk(s0[8 * s2 + 6], s0[8 * s2 + 7])}
                                          : (v4u){cvtpk(s1[8 * s2], s1[8 * s2 + 1]), cvtpk(s1[8 * s2 + 2], s1[8 * s2 + 3]), cvtpk(s1[8 * s2 + 4], s1[8 * s2 + 5]), cvtpk(s1[8 * s2 + 6], s1[8 * s2 + 7])};
                const bf16x8 pb = __builtin_bit_cast(bf16x8, pw);
                const int kofs = (32 * sub + 16 * s2 + 8 * h) * 2;
#pragma unroll
                for (int slab = 0; slab < 2; ++slab) {
                    const bf16x8 va = *(const LAS bf16x8*)(vb + (32 * slab + r) * 144 + kofs);
                    if (slab == 0) o0 = __builtin_amdgcn_mfma_f32_32x32x16_bf16(va, pb, o0, 0, 0, 0); else o1 = __builtin_amdgcn_mfma_f32_32x32x16_bf16(va, pb, o1, 0, 0, 0); } } }
        if (kt + 1 < ntile) ATT_WRITE(buf ^ 1);
        __syncthreads();
    }
#undef ATT_LOAD
#undef ATT_WRITE
    const float ltot = lrun + __shfl_xor(lrun, 32), inv = 1.f / ltot;
    bf16* orow = Op + (size_t)(wave * 32 + r) * opitch;
#pragma unroll
    for (int g4 = 0; g4 < 4; ++g4) {
        *(GAS v2u*)(orow + 8 * g4 + 4 * h) = (v2u){pk2(o0[4 * g4] * inv, o0[4 * g4 + 1] * inv), pk2(o0[4 * g4 + 2] * inv, o0[4 * g4 + 3] * inv)};
        *(GAS v2u*)(orow + 32 + 8 * g4 + 4 * h) = (v2u){pk2(o1[4 * g4] * inv, o1[4 * g4 + 1] * inv), pk2(o1[4 * g4 + 2] * inv, o1[4 * g4 + 3] * inv)}; }
}

template <bool LAT>
__device__ __forceinline__ void hyena_unit(const Args& a, int l, int c, LAS unsigned char* lds, int tid) {
    constexpr int L = LAT ? 2048 : 256, NB = LAT ? 4 : 16, NE = L / 16, NCH = L / 4, NW = LAT ? 8 : 4, ASH = LAT ? 2 : 4, MG = LAT ? 224 : 32  , UP = L + 2 * MG + 8  , GS = 514  ;
    asm volatile("" : "+v"(tid));
    const int lane = tid & 63, wave = tid >> 6, r = lane & 31, h = lane >> 5;
    const bf16* UT = (const bf16*)(a.ws + WS_UT) + (LAT ? UT_LAT : 0);
    GAS bf16* OC = (GAS bf16*)(a.ws + WS_OC);
    const float* HID = (const float*)(a.ws + WS_HID) + ((size_t)l * 2304 + (LAT ? 256 : 0)) * 64;
    LAS bf16* U = (LAS bf16*)lds; LAS bf16* X = (LAS bf16*)(lds + 20096); LAS float* FT = (LAS float*)(lds + 36480); LAS unsigned char* GC = lds + 69248;
    LAS float* W3 = (LAS float*)(lds + 135040); LAS float* RED = (LAS float*)(lds + 136064);
    constexpr int NQ = NB * L / 8 / 512;
    v4u x2r[NQ];
#pragma unroll
    for (int i = 0; i < NQ; ++i) { const int q = tid + 512 * i, b = q / (L / 8), off = (q % (L / 8)) * 8;
        const v4u uv = *(const GAS v4u*)(UT + ((size_t)b * 1536 + c) * L + off), xv = *(const GAS v4u*)(UT + ((size_t)b * 1536 + 512 + c) * L + off);
        x2r[i] = *(const GAS v4u*)(UT + ((size_t)b * 1536 + 1024 + c) * L + off);
        *(LAS v4u*)(U + b * UP + MG + off) = uv; *(LAS v4u*)(X + b * L + off) = xv; }
    for (int q = tid; q < NB * 2 * MG / 8; q += 512) { const int b = q / (2 * MG / 8), o = q % (2 * MG / 8); const int off = (o < MG / 8) ? 8 * o : MG + L + 8 * (o - MG / 8);
        *(LAS v4u*)(U + b * UP + off) = (v4u){0u, 0u, 0u, 0u}; }
    if (tid < 256) { const int j = tid >> 2, k = tid & 3; W3[k * 64 + j] = a.in[25][((size_t)l * 64 + j) * 2048 + (k >> 1) * 1024 + (k & 1) * 512 + c]; }
    __syncthreads();
#if defined(PROBE_HY) && PROBE_HY == 1
    for (int rep = 0; rep < 2; ++rep)
#endif
    { const float dmin = -15.350567286626973f, dmax = -3.0701134573253945f;
      const float delta = fabsf(dmin + (float)c * ((dmax - dmin) / 511.f));
      float p0 = 0.f, p1 = 0.f;
      for (int t = tid; t < L; t += 512) {
          float s[4] = {0.f, 0.f, 0.f, 0.f};
#pragma unroll 4
          for (int j4 = 0; j4 < 16; ++j4) { const f32x4 hv = *(const GAS f32x4*)(HID + (size_t)t * 64 + 4 * j4);
#pragma unroll
              for (int k = 0; k < 4; ++k) s[k] += hv.x * W3[k * 64 + 4 * j4] + hv.y * W3[k * 64 + 4 * j4 + 1] + hv.z * W3[k * 64 + 4 * j4 + 2] + hv.w * W3[k * 64 + 4 * j4 + 3]; }
          const float win = __expf(-((float)t / (float)(L - 1)) * delta);
#pragma unroll
          for (int k = 0; k < 4; ++k) { s[k] *= win; FT[k * L + t] = s[k]; }
          p0 += fabsf(s[0]) + (t >= 1 ? fabsf(s[2]) : 0.f); p1 += fabsf(s[1]) + (t >= 1 ? fabsf(s[3]) : 0.f); }
      p0 = wave_sum(p0); p1 = wave_sum(p1);
      if (lane == 0) { RED[2 * wave] = p0; RED[2 * wave + 1] = p1; } }
    __syncthreads();
    const int col = 32 * wave + r, ca = col >> ASH, cbat = col & (NB - 1);
    const int a_lo = (32 * wave) >> ASH, a_hi = (32 * wave + 31) >> ASH;
    const int rowbase = LAT ? TCTX + cbat * 2048 : cbat * 256;
#pragma unroll 1
    for (int n = 0; n < 2; ++n) {
        float l1s = 0.f;
#pragma unroll
        for (int w = 0; w < 8; ++w) l1s += RED[2 * w + n];
        const float invl1 = 1.f / (l1s + EPSN);
#if defined(PROBE_HY) && PROBE_HY == 4
        for (int rep = 0; rep < 2; ++rep)
#endif
        for (int q = tid; q < 8 * NCH; q += 512) { const int k = q & 7, y = q >> 3, m0 = L - (8 * y + k);
            float v[8];
#pragma unroll
            for (int j = 0; j < 8; ++j) { const int m = m0 - j; float t = 0.f; if (m >= 0 && m < L) t = FT[n * L + m]; else if (m < 0 && m > -L) t = FT[(2 + n) * L - m]; v[j] = t * invl1; }
            *(LAS v4u*)(GC + (k * GS + y) * 16) = (v4u){cvtpk(v[0], v[1]), cvtpk(v[2], v[3]), cvtpk(v[4], v[5]), cvtpk(v[6], v[7])}; }
        __syncthreads();
        f32x16 acc, acc1;
#if defined(PROBE_HY) && PROBE_HY == 3
        for (int rep = 0; rep < 2; ++rep) {
#endif
#pragma unroll
        for (int i = 0; i < 16; ++i) { acc[i] = 0.f; acc1[i] = 0.f; }
        if (wave < NW) {
            const int lam_lo = 2 * a_lo - (NE - 1), lam_hi = 2 * a_hi;
            const int xs0 = 8 * h - r + L;
            const LAS unsigned char* ap = GC + ((xs0 & 7) * GS + (xs0 >> 3) - 2 * lam_lo) * 16;
            const LAS unsigned char* bp = (const LAS unsigned char*)(U + cbat * UP + MG + 8 * h) + 32 * (2 * ca - lam_lo);
            bf16x8 a0 = *(const LAS bf16x8*)ap, b0 = *(const LAS bf16x8*)bp, a1 = *(const LAS bf16x8*)(ap - 32), b1 = *(const LAS bf16x8*)(bp - 32);
            for (int lam = lam_lo; lam <= lam_hi; lam += 2) {
                const bool more = lam + 2 <= lam_hi;
                if (more) { ap -= 64; bp -= 64; }
                const bf16x8 na0 = *(const LAS bf16x8*)ap, na1 = *(const LAS bf16x8*)(ap - 32), nb0 = *(const LAS bf16x8*)bp, nb1 = *(const LAS bf16x8*)(bp - 32);
                acc = __builtin_amdgcn_mfma_f32_32x32x16_bf16(a0, b0, acc, 0, 0, 0);
                acc1 = __builtin_amdgcn_mfma_f32_32x32x16_bf16(a1, b1, acc1, 0, 0, 0);
                a0 = na0; a1 = na1; b0 = nb0; b1 = nb1;
            }
#pragma unroll
            for (int i = 0; i < 16; ++i) acc[i] += acc1[i];
        }
#if defined(PROBE_HY) && PROBE_HY == 3
        asm volatile("" :: "v"(acc[0]), "v"(acc[5]));
        }
#endif
        const float bias = a.in[27][((size_t)l * 2 + n) * 512 + c];
        float z[16];
        if (wave < NW) {
#pragma unroll
            for (int g4 = 0; g4 < 4; ++g4) { const int t0 = 32 * ca + 8 * g4 + 4 * h;
                const v2u uw = *(const LAS v2u*)(U + cbat * UP + MG + t0), xw = *(const LAS v2u*)(X + cbat * L + t0);
                const float uv[4] = {bflo(uw.x), bfhi(uw.x), bflo(uw.y), bfhi(uw.y)}, xv[4] = {bflo(xw.x), bfhi(xw.x), bflo(xw.y), bfhi(xw.y)};
#pragma unroll
                for (int k = 0; k < 4; ++k) z[4 * g4 + k] = xv[k] * (acc[4 * g4 + k] + bias * uv[k]); }
        }
        __syncthreads();
        if (n == 0) {
            if (wave < NW) {
#pragma unroll
                for (int g4 = 0; g4 < 4; ++g4) *(LAS v2u*)(U + cbat * UP + MG + 32 * ca + 8 * g4 + 4 * h) = (v2u){pk2(z[4 * g4], z[4 * g4 + 1]), pk2(z[4 * g4 + 2], z[4 * g4 + 3])}; }
#pragma unroll
            for (int i = 0; i < NQ; ++i) { const int q = tid + 512 * i, b = q / (L / 8), off = (q % (L / 8)) * 8; *(LAS v4u*)(X + b * L + off) = x2r[i]; }
        } else if (wave < NW) {
#if defined(PROBE_HY) && PROBE_HY == 2
            for (int rep = 0; rep < 2; ++rep)
#endif
#pragma unroll
            for (int g4 = 0; g4 < 4; ++g4)
#pragma unroll
                for (int k = 0; k < 4; ++k) OC[(size_t)(rowbase + 32 * ca + 8 * g4 + 4 * h + k) * 512 + c] = (bf16)f2bf(z[4 * g4 + k]);
        }
    }
    __syncthreads();
}
#ifndef PHMASK
#define PHMASK 0x1fff
#endif
#define PH_ON(k) (((PHMASK) >> (k)) & 1)
#define L1_INV() do { asm volatile("s_waitcnt vmcnt(0)" ::: "memory"); __builtin_amdgcn_fence(__ATOMIC_ACQUIRE, "agent"); asm volatile("s_waitcnt vmcnt(0)" ::: "memory"); __syncthreads(); } while (0)
template <class T> __device__ __forceinline__ T* asglobal(T* p) { return (T*)(GAS T*)p; }
__global__ void __launch_bounds__(512, 2) mega_fwd(Args a) {
    extern __shared__ __attribute__((aligned(16))) unsigned char lds_raw[];
    LAS unsigned char* lds = (LAS unsigned char*)lds_raw;
    cg::grid_group grid = cg::this_grid();
    const int bid = blockIdx.x;
    using pg8::Gemm; using pg8::StaticOrder;
    const int ph_lo = a.ph_lo, ph_hi = a.ph_hi;
    volatile LAS unsigned* MISC = (volatile LAS unsigned*)(lds + LDS_BYTES - 64);
    if (threadIdx.x < 16) MISC[threadIdx.x] = 0u;
    __syncthreads();
    if (ph_hi > NPHASE) { __syncthreads(); grid.sync(); }
    XcdBarrier bar = xcd_barrier_post((unsigned*)(a.ws + WS_BAR + (size_t)a.li * BAR_REGION), MISC);
#pragma unroll 1
    for (int ph = ph_lo; ph < ph_hi; ++ph) {
        int tid = threadIdx.x; asm volatile("" : "+v"(tid));
        int G = gridDim.x; asm volatile("" : "+s"(G)); const int NGW = G * 8, NGT = G * 512;
        unsigned char* ws = a.ws; asm volatile("" : "+s"(ws));
#if defined(__HIP_DEVICE_COMPILE__)
#define ASSUME_GLOBAL(p) __builtin_assume(!__builtin_amdgcn_is_shared((const void*)(p)) && !__builtin_amdgcn_is_private((const void*)(p)))
#else
#define ASSUME_GLOBAL(p) ((void)0)
#endif
        ASSUME_GLOBAL(ws); ASSUME_GLOBAL(a.ws); ASSUME_GLOBAL(a.out);
#pragma unroll
        for (int i = 0; i < 35; ++i) ASSUME_GLOBAL(a.in[i]);
        const int lane = tid & 63, wave = __builtin_amdgcn_readfirstlane(tid >> 6), gw = bid * 8 + wave, gt = bid * 512 + tid;
        const int l = (ph >= 1 && ph < 23) ? (ph - 1) / 11 : 0, sub = (ph >= 1 && ph < 23) ? (ph - 1) % 11 : -1;
        float* mod = (float*)(ws + WS_MOD) + (size_t)l * 5 * 6144;
        if (PH_ON(11) && ph == 0) { p0_mod_hid(a, lds, bid, G, tid, gw, NGW, lane); wconv_phase(a, 0, lds, gw, NGW, gt, NGT, wave, lane); }
        else if (PH_ON(12) && ph == 23) { norm_phase(a, 0, 2, false, gw, NGW, lane); }
        else if (PH_ON(0) && sub == 0) { if (l == 1) wconv_phase(a, 1, lds, gw, NGW, gt, NGT, wave, lane); norm_phase(a, l, 0, l == 0, gw, NGW, lane); }
        else if (PH_ON(1) && sub == 1) {
            Gemm g{(const bf16*)(ws + WS_HBF1), (const bf16*)(ws + WS_WIN), TT, 4096, 1024, 1024, 1024}; StaticOrder S; S.init(TT, 4096, G, bid);
            pg8::EpiSeg E{(bf16*)(ws + WS_QA), (bf16*)(ws + WS_KVR), (bf16*)(ws + WS_CQ), (bf16*)(ws + WS_CKVR), (bf16*)(ws + WS_HYR), (bf16*)(ws + WS_S0)};
            pg8::gemm_phase<pg8::EpiSeg, StaticOrder, true, true>(lds, g, S, E);
        }
        else if (PH_ON(2) && sub == 2) { post_phase(a, l, lds, bid, G, tid, gw, NGW, gt, NGT, lane); }
        else if (PH_ON(3) && sub == 3) {
#pragma unroll 1
            for (int q = 0; q < 3; ++q) {
                Gemm g; StaticOrder S; pg8::EpiStore<0> E;
                if (q == 0) { g = Gemm{(const bf16*)(ws + WS_CQ), (const bf16*)(ws + WS_WUQ), TT, 768, 384, 512, 384}; S.init(TT, 768, G, bid); E = pg8::EpiStore<0>{(bf16*)(ws + WS_QB), 768}; }
                else if (q == 1) { g = Gemm{(const bf16*)(ws + WS_CKVALL), (const bf16*)(ws + WS_WKN), NKEYROWS, 512, 256, 256, 256}; S.init(NKEYROWS, 512, G, (bid + G - 144 % G) % G); E = pg8::EpiStore<0>{(bf16*)(ws + WS_KNB), 512}; }
                else { g = Gemm{(const bf16*)(ws + WS_WVV), (const bf16*)(ws + WS_CKVALL), 512, NKEYROWS, 256, 256, 256}; S.init(512, NKEYROWS, G, (bid + G - 248 % G) % G); E = pg8::EpiStore<0>{(bf16*)(ws + WS_VTB), NKEYROWS}; }
                pg8::gemm_phase<pg8::EpiStore<0>, StaticOrder, true, true>(lds, g, S, E);
            }
        }
        else if (PH_ON(4) && sub == 4) {
            const bf16 *QA = (const bf16*)(ws + WS_QA), *QB = (const bf16*)(ws + WS_QB), *KA = (const bf16*)(ws + WS_KA), *VTA = (const bf16*)(ws + WS_VTA);
            const bf16 *KNB = (const bf16*)(ws + WS_KNB), *VTB = (const bf16*)(ws + WS_VTB), *KPE = (const bf16*)(ws + WS_KPEALL);
            bf16 *OA = (bf16*)(ws + WS_OA), *OB = (bf16*)(ws + WS_OB);
            const float slA = 0.125f * 1.4426950408889634f, slB = 0.10206207261596575f * 1.4426950408889634f;
            const int sel = a.pad;
            for (int it = bid; it < 1792; it += G) {
                { const bool is_hy = (it >= 512 && it < 1024) || it >= 1280; if ((sel == 1 && is_hy) || (sel == 2 && !is_hy)) continue; }
                if (it < 256 || (it >= 1024 && it < 1152)) {
                    const bool lat = it < 256; const int u = lat ? (G == 256 ? ((bid & 7) * 4 + (bid >> 6)) * 8 + ((bid >> 3) & 7) : it) : it - 1024;
                    const int b = lat ? u >> 6 : u >> 3, hh = lat ? (u >> 3) & 7 : u & 7, qb = lat ? u & 7 : 0;
                    const int row0 = lat ? TCTX + b * 2048 + qb * 256 : b * 256, key0 = lat ? TCTX + b * 2304 : b * 256;
                    attn_unit<96>(lds, tid, QB + (size_t)row0 * 768 + hh * 96, 768, KNB + (size_t)key0 * 512 + hh * 64, 512, KPE + (size_t)key0 * 32, VTB + (size_t)(hh * 64) * NKEYROWS + key0, NKEYROWS,
                                  lat ? 2304 : 256, OB + (size_t)row0 * 512 + hh * 64, 512, slB, lat, qb * 256);
                } else if (it < 512 || (it >= 1152 && it < 1280)) {
                    const bool lat = it < 512; const int u = lat ? (G == 256 ? ((bid & 7) * 4 + (bid >> 6)) * 8 + ((bid >> 3) & 7) : it - 256) : it - 1152;
                    const int b = lat ? u >> 6 : u >> 3, hh = lat ? (u >> 3) & 7 : u & 7, qb = lat ? u & 7 : 0, kvh = hh >> 2;
                    const int row0 = lat ? TCTX + b * 2048 + qb * 256 : b * 256, nk = lat ? 2304 : 256;
                    const size_t kbase = lat ? (size_t)KA_LAT + (size_t)(b * 2 + kvh) * 2304 * 64 : (size_t)(b * 2 + kvh) * 256 * 64;
                    attn_unit<64>(lds, tid, QA + (size_t)row0 * 512 + hh * 64, 512, KA + kbase, 64, nullptr, VTA + kbase, nk, nk, OA + (size_t)row0 * 512 + hh * 64, 512, slA, false, 0);
                } else if (it < 1024) { hyena_unit<true>(a, l, it - 512, lds, tid); }
                else { hyena_unit<false>(a, l, it - 1280, lds, tid); }
            }
        }
        else if (PH_ON(5) && sub == 5) {
            static_assert(WS_S1 + 121 * MiB == WS_S0 && WS_S2 + 97 * MiB == WS_S0, "gate buffer arithmetic");
            bf16 *S0 = (bf16*)(ws + WS_S0), *MBF = (bf16*)(ws + WS_MBF);
            { Gemm g{(const bf16*)(ws + WS_HBF1), (const bf16*)(ws + WS_WG), TT, 2048, 1024, 1024, 1024}; StaticOrder S; S.init(TT, 2048, G, bid);
              pg8::EpiGate E{S0}; pg8::gemm_phase<pg8::EpiGate, StaticOrder, true, true>(lds, g, S, E); }
            xcd_barrier(bar);
            { Gemm g{(const bf16*)(ws + WS_OA), (const bf16*)(ws + WS_WB), TT, 1024, 512, 512, 512, (size_t)TT * 512 * 2, (size_t)1024 * 512 * 2};
              pg8::BatchOrder<3> S; S.init(TT, 1024, G, bid);
              pg8::EpiMerge E{S0, MBF}; pg8::gemm_phase<pg8::EpiMerge, pg8::BatchOrder<3>, true, true>(lds, g, S, E); }
        }
        else if (PH_ON(6) && sub == 6) {
            Gemm g{(const bf16*)(ws + WS_MBF), (const bf16*)(ws + WS_WO), TT, 1024, 1024, 1024, 1024}; StaticOrder S; S.init(TT, 1024, G, bid);
            pg8::EpiResid E{a.out, mod + 2048}; pg8::gemm_phase<pg8::EpiResid, StaticOrder, true, true>(lds, g, S, E);
        }
        else if (PH_ON(7) && sub == 7) { norm_phase(a, l, 1, false, gw, NGW, lane); }
        else if (PH_ON(8) && sub == 8) {
            Gemm g{(const bf16*)(ws + WS_HBF), (const bf16*)(ws + WS_WUP), TT, 5632, 1024, 1024, 1024}; StaticOrder S; S.init(TT, 5632, G, bid);
            pg8::EpiStore<0> E{(bf16*)(ws + WS_U), 5632}; pg8::gemm_phase<pg8::EpiStore<0>, StaticOrder, true, true>(lds, g, S, E);
        }
        else if (PH_ON(9) && sub == 9) { ffnconv_phase(a, l, gt, NGT); }
        else if (PH_ON(10) && sub == 10) {
            Gemm g{(const bf16*)(ws + WS_ACT), (const bf16*)(ws + WS_WDN), TT, 1024, 2816, 2816, 2816}; StaticOrder S; S.init(TT, 1024, G, bid);
            pg8::EpiResid E{a.out, mod + 5120}; pg8::gemm_phase<pg8::EpiResid, StaticOrder, true, true>(lds, g, S, E);
        }
#ifdef EXTRA_SYNCS
        for (int q = 0; q < EXTRA_SYNCS; ++q) { __syncthreads(); grid.sync(); }
#endif
        if (ph + 1 < ph_hi) xcd_barrier(bar);
    }
}

extern "C" void kernel_launch(void* const* d_in, const int* in_sizes, int n_in, void* d_out, int out_size, void* d_ws, size_t ws_size, hipStream_t stream) {
    static int grid = 0;
    if (grid == 0) {
        if (n_in != 35 || ws_size < WS_END) { fprintf(stderr, "kernel_launch: unexpected n_in %d / ws %zu\n", n_in, ws_size); grid = -1; return; }
        int dev = 0, cus = 0, per_cu = 0;
        if (hipGetDevice(&dev) != hipSuccess || hipDeviceGetAttribute(&cus, hipDeviceAttributeMultiprocessorCount, dev) != hipSuccess) { grid = -1; return; }
        if (hipFuncSetAttribute((const void*)mega_fwd, hipFuncAttributeMaxDynamicSharedMemorySize, LDS_BYTES) != hipSuccess) { fprintf(stderr, "kernel_launch: hipFuncSetAttribute failed\n"); grid = -1; return; }
        if (hipOccupancyMaxActiveBlocksPerMultiprocessor(&per_cu, (const void*)mega_fwd, 512, LDS_BYTES) != hipSuccess || per_cu < 1) { fprintf(stderr, "kernel_launch: occupancy query says %d\n", per_cu); per_cu = 1; }
        (void)hipGetLastError();
        grid = cus;
    }
    if (grid < 0) return;
    if (hipMemsetAsync((char*)d_ws + WS_MOD, 0, ZERO_BYTES, stream) != hipSuccess) { fprintf(stderr, "kernel_launch: memset failed\n"); return; }
    Args a{};
    for (int i = 0; i < 35; ++i) a.in[i] = (const float*)d_in[i];
    a.out = (float*)d_out; a.ws = (unsigned char*)d_ws;
#if defined(MK_PER_PHASE)
    for (int p = 0; p < NPHASE; ++p) { a.ph_lo = p; a.ph_hi = p + 1; a.li = 0; void* args[] = {&a};
        hipError_t e = hipLaunchCooperativeKernel((const void*)mega_fwd, dim3(grid), dim3(512), args, LDS_BYTES, stream);
        if (e != hipSuccess) { fprintf(stderr, "launch %d failed: %s\n", p, hipGetErrorString(e)); break; } }
#else
#if defined(PROBE_SUB)
#ifndef PROBE_SEL
#define PROBE_SEL 0
#endif
    { const int k0 = 1 + PROBE_SUB, k1 = 12 + PROBE_SUB; const int cuts[6][2] = {{0, k0 + 1}, {k0, k0 + 1}, {k0 + 1, k1 + 1}, {k1, k1 + 1}, {k1 + 1, NPHASE}, {0, 0}};
      for (int c = 0; c < 5; ++c) { a.ph_lo = cuts[c][0]; a.ph_hi = cuts[c][1]; a.li = c; a.pad = (c == 1 || c == 3) ? PROBE_SEL : 0; if (a.ph_lo >= a.ph_hi) continue; void* args[] = {&a};
          hipError_t e = hipLaunchCooperativeKernel((const void*)mega_fwd, dim3(grid), dim3(512), args, LDS_BYTES, stream);
          if (e != hipSuccess) { fprintf(stderr, "cooperative launch failed: %s\n", hipGetErrorString(e)); break; } } }
#elif defined(PROBE_CUTS)
    { const int k0 = 1 + PROBE_CUTS, k1 = 12 + PROBE_CUTS; const int cuts[4][2] = {{0, k0 + 1}, {k0 + 1, k1 + 1}, {k1 + 1, NPHASE}, {0, 0}};
      for (int c = 0; c < 3; ++c) { a.ph_lo = cuts[c][0]; a.ph_hi = cuts[c][1]; a.li = c; if (a.ph_lo >= a.ph_hi) continue; void* args[] = {&a};
          hipError_t e = hipLaunchCooperativeKernel((const void*)mega_fwd, dim3(grid), dim3(512), args, LDS_BYTES, stream);
          if (e != hipSuccess) { fprintf(stderr, "cooperative launch failed: %s\n", hipGetErrorString(e)); break; } } }
#else
    a.ph_lo = 0; a.ph_hi = NPHASE; void* args[] = {&a};
    hipError_t e = hipLaunchCooperativeKernel((const void*)mega_fwd, dim3(grid), dim3(512), args, LDS_BYTES, stream);
    if (e != hipSuccess) fprintf(stderr, "cooperative launch failed: %s (grid %d)\n", hipGetErrorString(e), grid);
#endif
#endif
}
```

```cpp
#include <hip/hip_runtime.h>
#include <hip/hip_cooperative_groups.h>
#include <cstdio>
#include <cstdint>
namespace cg = cooperative_groups;
namespace pg8 {
#define PG8_LAS __attribute__((address_space(3)))
typedef unsigned short bf16_t;
typedef short bf16x8 __attribute__((ext_vector_type(8)));
typedef float f32x4 __attribute__((ext_vector_type(4)));
typedef unsigned u32x4 __attribute__((ext_vector_type(4)));
constexpr int BM = 256, BK = 64, HALF = 128, HTB = HALF * BK * 2  , STAGE_BYTES = 8 * HTB, NXCD = 8, WGM = 8;

__host__ __device__ __forceinline__ int lds_byte(int r, int c) { const int st = (r >> 4) * 2 + (c >> 5), rr = r & 15, cc = c & 31, ob = rr * 64 + cc * 2; return st * 1024 + (ob ^ (((ob >> 9) & 1) << 5)); }
__host__ __device__ __forceinline__ void stage_rc(int b, int& R, int& C) { const int st = b / 1024, sb = b % 1024, swz = sb ^ (((sb >> 9) & 1) << 5); R = (st >> 1) * 16 + swz / 64; C = (st & 1) * 32 + (swz % 64) / 2; }
__host__ __device__ __forceinline__ int perm32(int rho) { const int n = rho >> 4, i = rho & 15; return 8 * (i >> 2) + 4 * n + (i & 3); }

struct Unit { int pm, pn, gi; };
struct Gemm { const bf16_t* A; const bf16_t* Bt; int M, N, K, lda, ldb; size_t gsA, gsB; };

struct StaticOrder {
    int nM, nN, nwg, G, c;
    __host__ __device__ void init(int M, int N, int G_, int c_) { nM = M / BM; nN = N / BM; nwg = nM * nN; G = G_; c = c_; }
    __host__ __device__ bool next(int i, Unit& u) const {
        const long L = (long)i * G + c; if (L >= nwg) return false;
        int wgid = (int)L; { const int q = nwg / NXCD, r = nwg % NXCD, xcd = wgid % NXCD, off = wgid / NXCD; wgid = (xcd < r ? xcd * (q + 1) : r * (q + 1) + (xcd - r) * q) + off; }
        const int nig = WGM * nN, gid = wgid / nig, fm = gid * WGM, gsz = (nM - fm) < WGM ? (nM - fm) : WGM;
        u.pm = fm + ((wgid % nig) % gsz); u.pn = (wgid % nig) / gsz; u.gi = 0; return true;
    }
    __device__ __forceinline__ void a_ready(const Unit&) const {}
    __device__ __forceinline__ void done(const Unit&) const {}
};
template <int N0, int N1, int NN0, int NN1> struct PairOrder {
    int G, c;
    __host__ __device__ bool next(int i, Unit& u) const { const int L = i * G + c; if (L >= N0 + N1) return false;
        if (L < N0) { u.pm = L / NN0; u.pn = L % NN0; u.gi = 0; } else { const int q = L - N0; u.pm = q / NN1; u.pn = q % NN1; u.gi = 1; } return true; }
    __device__ __forceinline__ void a_ready(const Unit&) const {}
    __device__ __forceinline__ void done(const Unit&) const {}
};
template <int NB> struct BatchOrder : StaticOrder {
    __host__ __device__ bool next(int i, Unit& u) const { if (i >= NB) return false; if (!StaticOrder::next(0, u)) return false; u.gi = i; return true; }
};


#ifndef GAS
#define GAS __attribute__((address_space(1)))
#endif
typedef float f32x2v __attribute__((ext_vector_type(2)));
typedef __bf16 bf16x2v __attribute__((ext_vector_type(2)));
__device__ __forceinline__ unsigned cvt_pk_bf16(float lo, float hi) { const f32x2v v = {lo, hi}; const bf16x2v b = __builtin_convertvector(v, bf16x2v); return __builtin_bit_cast(unsigned, b); }
__device__ __forceinline__ float sigm(float x) { return __builtin_amdgcn_rcpf(1.f + __expf(-x)); }
#define EPI_FOR _Pragma("unroll") for (int ai = 0; ai < 2; ++ai) _Pragma("unroll") for (int m = 0; m < 4; ++m) _Pragma("unroll") for (int bj = 0; bj < 2; ++bj)

template <int ACT  > struct EpiStore {
    static constexpr bool PERM = true, AFTER_DRAIN = false;
    bf16_t* O; int ld;
    __device__ __forceinline__ void operator()(const f32x4 (&acc)[2][2][4][2], const Unit& u, int wr, int wc, int fr, int fq) const {
        const int row0 = u.pm * BM + wr * 64 + fr, col0 = u.pn * BM + wc * 32 + 8 * fq;
        EPI_FOR { f32x4 v0 = acc[ai][bj][m][0], v1 = acc[ai][bj][m][1];
            if (ACT == 1) { v0 = (f32x4){sigm(v0[0]), sigm(v0[1]), sigm(v0[2]), sigm(v0[3])}; v1 = (f32x4){sigm(v1[0]), sigm(v1[1]), sigm(v1[2]), sigm(v1[3])}; }
            u32x4 w; w.x = cvt_pk_bf16(v0[0], v0[1]); w.y = cvt_pk_bf16(v0[2], v0[3]); w.z = cvt_pk_bf16(v1[0], v1[1]); w.w = cvt_pk_bf16(v1[2], v1[3]);
            *(GAS u32x4*)(O + (size_t)(row0 + ai * HALF + m * 16) * ld + col0 + bj * HALF) = w; }
    }
};
struct EpiPair {
    static constexpr bool PERM = true, AFTER_DRAIN = false;
    bf16_t *O0, *O1; int ld0, ld1;
    __device__ __forceinline__ void operator()(const f32x4 (&acc)[2][2][4][2], const Unit& u, int wr, int wc, int fr, int fq) const {
        bf16_t* O = u.gi ? O1 : O0; const int ld = u.gi ? ld1 : ld0;
        const int row0 = u.pm * BM + wr * 64 + fr, col0 = u.pn * BM + wc * 32 + 8 * fq;
        EPI_FOR { const f32x4 v0 = acc[ai][bj][m][0], v1 = acc[ai][bj][m][1];
            u32x4 w; w.x = cvt_pk_bf16(v0[0], v0[1]); w.y = cvt_pk_bf16(v0[2], v0[3]); w.z = cvt_pk_bf16(v1[0], v1[1]); w.w = cvt_pk_bf16(v1[2], v1[3]);
            *(GAS u32x4*)(O + (size_t)(row0 + ai * HALF + m * 16) * ld + col0 + bj * HALF) = w; }
    }
};
struct EpiSeg {
    static constexpr bool PERM = true, AFTER_DRAIN = false;
    bf16_t *QA, *KV, *CQ, *CKV, *HY, *S0;
    __device__ __forceinline__ void operator()(const f32x4 (&acc)[2][2][4][2], const Unit& u, int wr, int wc, int fr, int fq) const {
        bf16_t* base; int ld, coff; const int pn = u.pn;
        if (pn < 2) { base = QA; ld = 512; coff = 256 * pn; } else if (pn == 2) { base = KV; ld = 256; coff = 0; } else if (pn < 5) { base = CQ; ld = 512; coff = 256 * (pn - 3); }
        else if (pn == 5) { base = CKV; ld = 256; coff = 0; } else if (pn < 12) { base = HY; ld = 1536; coff = 256 * (pn - 6); } else { base = S0; ld = 1024; coff = 256 * (pn - 12); }
        const bool gate = pn >= 12;
        const int row0 = u.pm * BM + wr * 64 + fr, col0 = coff + wc * 32 + 8 * fq;
        EPI_FOR { f32x4 v0 = acc[ai][bj][m][0], v1 = acc[ai][bj][m][1];
            if (gate) { v0 = (f32x4){sigm(v0[0]), sigm(v0[1]), sigm(v0[2]), sigm(v0[3])}; v1 = (f32x4){sigm(v1[0]), sigm(v1[1]), sigm(v1[2]), sigm(v1[3])}; }
            u32x4 w; w.x = cvt_pk_bf16(v0[0], v0[1]); w.y = cvt_pk_bf16(v0[2], v0[3]); w.z = cvt_pk_bf16(v1[0], v1[1]); w.w = cvt_pk_bf16(v1[2], v1[3]);
            *(GAS u32x4*)(base + (size_t)(row0 + ai * HALF + m * 16) * ld + col0 + bj * HALF) = w; }
    }
};
struct EpiGate {
    static constexpr bool PERM = true, AFTER_DRAIN = false;
    bf16_t* S0;
    __device__ __forceinline__ void operator()(const f32x4 (&acc)[2][2][4][2], const Unit& u, int wr, int wc, int fr, int fq) const {
        const int n = 1 + (u.pn >> 2); bf16_t* base = (bf16_t*)((unsigned char*)S0 - (size_t)((n + 1) >> 1) * (121u << 20) + (size_t)(n >> 1) * (24u << 20));
        const int row0 = u.pm * BM + wr * 64 + fr, col0 = (u.pn & 3) * BM + wc * 32 + 8 * fq;
        EPI_FOR { f32x4 v0 = acc[ai][bj][m][0], v1 = acc[ai][bj][m][1];
            v0 = (f32x4){sigm(v0[0]), sigm(v0[1]), sigm(v0[2]), sigm(v0[3])}; v1 = (f32x4){sigm(v1[0]), sigm(v1[1]), sigm(v1[2]), sigm(v1[3])};
            u32x4 w; w.x = cvt_pk_bf16(v0[0], v0[1]); w.y = cvt_pk_bf16(v0[2], v0[3]); w.z = cvt_pk_bf16(v1[0], v1[1]); w.w = cvt_pk_bf16(v1[2], v1[3]);
            *(GAS u32x4*)(base + (size_t)(row0 + ai * HALF + m * 16) * 1024 + col0 + bj * HALF) = w; }
    }
};
struct EpiMerge {
    static constexpr bool PERM = true, AFTER_DRAIN = false;
    const bf16_t* S0; bf16_t* M;
    __device__ __forceinline__ void operator()(const f32x4 (&acc)[2][2][4][2], const Unit& u, int wr, int wc, int fr, int fq) const {
        const int row0 = u.pm * BM + wr * 64 + fr, col0 = u.pn * BM + wc * 32 + 8 * fq;
        const int MODE = u.gi; const bf16_t* S = (const bf16_t*)((const unsigned char*)S0 - (size_t)((u.gi + 1) >> 1) * (121u << 20) + (size_t)(u.gi >> 1) * (24u << 20));
        EPI_FOR { const size_t off = (size_t)(row0 + ai * HALF + m * 16) * 1024 + col0 + bj * HALF;
            const u32x4 sw = *(const GAS u32x4*)(S + off);
            f32x4 s0 = (f32x4){__uint_as_float(sw.x << 16), __uint_as_float(sw.x & 0xffff0000u), __uint_as_float(sw.y << 16), __uint_as_float(sw.y & 0xffff0000u)};
            f32x4 s1 = (f32x4){__uint_as_float(sw.z << 16), __uint_as_float(sw.z & 0xffff0000u), __uint_as_float(sw.w << 16), __uint_as_float(sw.w & 0xffff0000u)};
            f32x4 v0 = acc[ai][bj][m][0] * s0, v1 = acc[ai][bj][m][1] * s1;
            if (MODE >= 1) { const u32x4 mw = *(const GAS u32x4*)(M + off);
                v0 = v0 + (f32x4){__uint_as_float(mw.x << 16), __uint_as_float(mw.x & 0xffff0000u), __uint_as_float(mw.y << 16), __uint_as_float(mw.y & 0xffff0000u)};
                v1 = v1 + (f32x4){__uint_as_float(mw.z << 16), __uint_as_float(mw.z & 0xffff0000u), __uint_as_float(mw.w << 16), __uint_as_float(mw.w & 0xffff0000u)}; }
            u32x4 w; w.x = cvt_pk_bf16(v0[0], v0[1]); w.y = cvt_pk_bf16(v0[2], v0[3]); w.z = cvt_pk_bf16(v1[0], v1[1]); w.w = cvt_pk_bf16(v1[2], v1[3]); *(GAS u32x4*)(M + off) = w; }
    }
};
struct EpiResid {
    static constexpr bool PERM = true, AFTER_DRAIN = false;
    float* X; const float* gate;
    __device__ __forceinline__ void operator()(const f32x4 (&acc)[2][2][4][2], const Unit& u, int wr, int wc, int fr, int fq) const {
        const int row0 = u.pm * BM + wr * 64 + fr, col0 = u.pn * BM + wc * 32 + 8 * fq;
        const int mrow = (u.pm < 16) ? 0 : 1 + ((u.pm - 16) >> 3);
        const float* gp = gate + (size_t)mrow * 6144 + col0;
        f32x4 g[2][2];
#pragma unroll
        for (int bj = 0; bj < 2; ++bj) { g[bj][0] = *(const GAS f32x4*)(gp + bj * HALF); g[bj][1] = *(const GAS f32x4*)(gp + bj * HALF + 4); }
        EPI_FOR { float* xp = X + (size_t)(row0 + ai * HALF + m * 16) * 1024 + col0 + bj * HALF;
            const f32x4 x0 = *(const GAS f32x4*)xp, x1 = *(const GAS f32x4*)(xp + 4);
            *(GAS f32x4*)xp = x0 + g[bj][0] * acc[ai][bj][m][0]; *(GAS f32x4*)(xp + 4) = x1 + g[bj][1] * acc[ai][bj][m][1]; }
    }
};

template <class Epi, class Sched, bool ALIGN_EPI = false, bool SP2 = false>
__device__ __forceinline__ void gemm_phase(PG8_LAS unsigned char* lds, const Gemm g, const Sched& S, const Epi& E) {
    int tid_l = threadIdx.x; asm volatile("" : "+v"(tid_l));
    const int tid = tid_l, wid = __builtin_amdgcn_readfirstlane(tid >> 6), lane = tid & 63, wr = wid >> 2, wc = wid & 3, fr = lane & 15, fq = lane >> 4;
    const int K = g.K, nt = K / BK;
    unsigned voffA[2], voffB[2];
#pragma unroll
    for (int i = 0; i < 2; ++i) { int R, C; stage_rc(tid * 16 + i * 8192, R, C); const int Rb = Epi::PERM ? ((R & ~31) + perm32(R & 31)) : R;
        voffA[i] = (unsigned)(R * g.lda + C) * 2u; voffB[i] = (unsigned)(Rb * g.ldb + C) * 2u; }
    const size_t kstep = (size_t)(BK * 2);
    const size_t hstepA = (size_t)HALF * g.lda * 2, hstepB = (size_t)HALF * g.ldb * 2;
    const size_t tstepA = 2 * hstepA, tstepB = 2 * hstepB;
    const unsigned ldsw = (unsigned)wid * 1024u;
    const int aoff = lds_byte(wr * 64 + fr, fq * 8), boff = lds_byte(wc * 32 + fr, fq * 8);
#define PG8_SA(b, h) (((b) * 2 + (h)) * HTB)
#define PG8_SB(b, h) ((4 + (b) * 2 + (h)) * HTB)
#define PG8_STAGE(bufoff, gbase, voff) do { _Pragma("unroll") for (int _i = 0; _i < 2; ++_i) \
        __builtin_amdgcn_global_load_lds((const unsigned*)((const char*)(gbase) + (voff)[_i]), (PG8_LAS unsigned*)(lds + (bufoff) + ldsw + _i * 8192), 16, 0, 0); } while (0)
#define PG8_LDA(dst, b, h) do { _Pragma("unroll") for (int m = 0; m < 4; ++m) _Pragma("unroll") for (int k = 0; k < 2; ++k) dst[m][k] = *(const PG8_LAS bf16x8*)(lds + PG8_SA(b, h) + aoff + m * 2048 + k * 1024); } while (0)
#define PG8_LDB(dst, b, h) do { _Pragma("unroll") for (int n = 0; n < 2; ++n) _Pragma("unroll") for (int k = 0; k < 2; ++k) dst[n][k] = *(const PG8_LAS bf16x8*)(lds + PG8_SB(b, h) + boff + n * 2048 + k * 1024); } while (0)
#define PG8_MMA(ai, bj, At, Bt) do { __builtin_amdgcn_s_setprio(1); _Pragma("unroll") for (int m = 0; m < 4; ++m) _Pragma("unroll") for (int n = 0; n < 2; ++n) _Pragma("unroll") for (int k = 0; k < 2; ++k) \
        acc[ai][bj][m][n] = __builtin_amdgcn_mfma_f32_16x16x32_bf16(Bt[n][k], At[m][k], acc[ai][bj][m][n], 0, 0, 0); __builtin_amdgcn_s_setprio(0); } while (0)
#define PG8_WAIT_V(n) asm volatile("s_waitcnt vmcnt(" #n ")" ::: "memory")
#define PG8_WAIT_L(n) asm volatile("s_waitcnt lgkmcnt(" #n ")" ::: "memory")
#define PG8_BAR __builtin_amdgcn_s_barrier()
#define PG8_SCHED __builtin_amdgcn_sched_barrier(0)
    Unit cur, nxt; int ui = 0;
    if (!S.next(0, cur)) return;
    f32x4 acc[2][2][4][2];
#pragma unroll
    for (int a = 0; a < 2; ++a)
#pragma unroll
        for (int b = 0; b < 2; ++b)
#pragma unroll
            for (int m = 0; m < 4; ++m)
#pragma unroll
                for (int n = 0; n < 2; ++n) acc[a][b][m][n] = (f32x4){0.f, 0.f, 0.f, 0.f};
    bf16x8 At[4][2], B0[2][2], B1[2][2];
    const char* cA = (const char*)g.A + (size_t)cur.gi * g.gsA + (size_t)cur.pm * tstepA; const char* cB = (const char*)g.Bt + (size_t)cur.gi * g.gsB + (size_t)cur.pn * tstepB;
    S.a_ready(cur);
    if constexpr (SP2) {
        PG8_STAGE(PG8_SB(0, 0), cB, voffB); PG8_STAGE(PG8_SB(0, 1), cB + hstepB, voffB); PG8_STAGE(PG8_SA(0, 0), cA, voffA); PG8_STAGE(PG8_SA(0, 1), cA + hstepA, voffA);
        if (wr == 1) PG8_BAR;
        PG8_WAIT_V(2); PG8_BAR;
        PG8_STAGE(PG8_SB(1, 0), cB + kstep, voffB); PG8_STAGE(PG8_SA(1, 0), cA + kstep, voffA); PG8_STAGE(PG8_SB(1, 1), cB + hstepB + kstep, voffB);
        PG8_WAIT_V(6); PG8_BAR;
    } else {
        PG8_STAGE(PG8_SB(0, 0), cB, voffB); PG8_STAGE(PG8_SA(0, 0), cA, voffA); PG8_STAGE(PG8_SB(0, 1), cB + hstepB, voffB); PG8_STAGE(PG8_SA(0, 1), cA + hstepA, voffA);
        if (wr == 1) PG8_BAR;
        PG8_WAIT_V(4); PG8_BAR;
        PG8_STAGE(PG8_SB(1, 0), cB + kstep, voffB); PG8_STAGE(PG8_SA(1, 0), cA + kstep, voffA); PG8_STAGE(PG8_SB(1, 1), cB + hstepB + kstep, voffB);
        PG8_WAIT_V(6); PG8_BAR;
    }
    for (;;) {
        const bool has_next = S.next(ui + 1, nxt);
        const char* nA = has_next ? (const char*)g.A + (size_t)nxt.gi * g.gsA + (size_t)nxt.pm * tstepA : cA; const char* nB = has_next ? (const char*)g.Bt + (size_t)nxt.gi * g.gsB + (size_t)nxt.pn * tstepB : cB;
        for (int t = 0; t < nt; t += 2) {
            const bool last = (t == nt - 2);
            const char* a1 = cA + (size_t)(t + 1) * kstep;
            const char* a2 = last ? nA : cA + (size_t)(t + 2) * kstep; const char* b2 = last ? nB : cB + (size_t)(t + 2) * kstep;
            const char* a3 = a2 + kstep; const char* b3 = b2 + kstep;
            if (last && has_next) S.a_ready(nxt);
            if constexpr (SP2) {
            PG8_LDB(B0, 0, 0); PG8_LDB(B1, 0, 1); PG8_SCHED; PG8_LDA(At, 0, 0); PG8_STAGE(PG8_SA(1, 1), a1 + hstepA, voffA);
            PG8_WAIT_V(8); PG8_WAIT_L(0); PG8_BAR; PG8_MMA(0, 0, At, B0); PG8_MMA(0, 1, At, B1); PG8_BAR; PG8_SCHED;
            PG8_LDA(At, 0, 1); PG8_STAGE(PG8_SB(0, 0), b2, voffB); PG8_STAGE(PG8_SB(0, 1), b2 + hstepB, voffB); PG8_STAGE(PG8_SA(0, 0), a2, voffA);
            PG8_WAIT_V(8); PG8_WAIT_L(0); PG8_BAR; PG8_MMA(1, 0, At, B0); PG8_MMA(1, 1, At, B1); PG8_BAR; PG8_SCHED;
            PG8_LDB(B0, 1, 0); PG8_LDB(B1, 1, 1); PG8_SCHED; PG8_LDA(At, 1, 0); PG8_STAGE(PG8_SA(0, 1), a2 + hstepA, voffA);
            PG8_WAIT_V(8); PG8_WAIT_L(0); PG8_BAR; PG8_MMA(0, 0, At, B0); PG8_MMA(0, 1, At, B1); PG8_BAR; PG8_SCHED;
            PG8_LDA(At, 1, 1); PG8_STAGE(PG8_SB(1, 0), b3, voffB); PG8_STAGE(PG8_SB(1, 1), b3 + hstepB, voffB); PG8_STAGE(PG8_SA(1, 0), a3, voffA);
            PG8_WAIT_V(8); PG8_WAIT_L(0); PG8_BAR; PG8_MMA(1, 0, At, B0); PG8_MMA(1, 1, At, B1); PG8_BAR; PG8_SCHED;
            } else {
            PG8_LDB(B0, 0, 0); PG8_SCHED; PG8_LDA(At, 0, 0); PG8_STAGE(PG8_SA(1, 1), a1 + hstepA, voffA);
            PG8_WAIT_L(8); PG8_BAR; PG8_WAIT_L(0); PG8_MMA(0, 0, At, B0); PG8_BAR; PG8_SCHED;
            PG8_LDB(B1, 0, 1); PG8_STAGE(PG8_SB(0, 0), b2, voffB);
            PG8_BAR; PG8_WAIT_L(0); PG8_MMA(0, 1, At, B1); PG8_BAR;
            PG8_LDA(At, 0, 1); PG8_STAGE(PG8_SA(0, 0), a2, voffA);
            PG8_BAR; PG8_WAIT_L(0); PG8_MMA(1, 0, At, B0); PG8_BAR; PG8_SCHED;
            PG8_STAGE(PG8_SB(0, 1), b2 + hstepB, voffB);
            PG8_WAIT_V(6); PG8_BAR; PG8_MMA(1, 1, At, B1); PG8_BAR;
            PG8_LDB(B0, 1, 0); PG8_SCHED; PG8_LDA(At, 1, 0); PG8_STAGE(PG8_SA(0, 1), a2 + hstepA, voffA);
            PG8_WAIT_L(8); PG8_BAR; PG8_WAIT_L(0); PG8_MMA(0, 0, At, B0); PG8_BAR; PG8_SCHED;
            PG8_LDB(B1, 1, 1); PG8_STAGE(PG8_SB(1, 0), b3, voffB);
            PG8_BAR; PG8_WAIT_L(0); PG8_MMA(0, 1, At, B1); PG8_BAR;
            PG8_LDA(At, 1, 1); PG8_STAGE(PG8_SA(1, 0), a3, voffA);
            PG8_BAR; PG8_WAIT_L(0); PG8_MMA(1, 0, At, B0); PG8_BAR; PG8_SCHED;
            PG8_STAGE(PG8_SB(1, 1), b3 + hstepB, voffB);
            PG8_WAIT_V(6); PG8_BAR; PG8_MMA(1, 1, At, B1); PG8_BAR;
            }
        }
        if constexpr (ALIGN_EPI) { if (wr == 0) PG8_BAR; }
        if constexpr (!Epi::AFTER_DRAIN) { E(acc, cur, wr, wc, fr, fq); S.done(cur); }
        if (!has_next) break;
#pragma unroll
        for (int a = 0; a < 2; ++a)
#pragma unroll
            for (int b = 0; b < 2; ++b)
#pragma unroll
                for (int m = 0; m < 4; ++m)
#pragma unroll
                    for (int n = 0; n < 2; ++n) acc[a][b][m][n] = (f32x4){0.f, 0.f, 0.f, 0.f};
        cur = nxt; cA = nA; cB = nB; ++ui;
        if constexpr (ALIGN_EPI) { if (wr == 1) PG8_BAR; }
    }
    PG8_WAIT_V(0);
    if constexpr (!ALIGN_EPI) { if (wr == 0) PG8_BAR; }
    PG8_BAR;
    if constexpr (Epi::AFTER_DRAIN) { E.fused(acc, cur, wr, wc, fr, fq, lds, wid, lane); S.done(cur); }
#undef PG8_SA
#undef PG8_SB
#undef PG8_STAGE
#undef PG8_LDA
#undef PG8_LDB
#undef PG8_MMA
#undef PG8_WAIT_V
#undef PG8_WAIT_L
#undef PG8_BAR
#undef PG8_SCHED
}
}

constexpr int TCTX = 4096, TLAT = 8192, TT = 12288, DM = 1024, NKEYROWS = 13312;
constexpr float EPSN = 1e-6f;
constexpr size_t MiB = 1u << 20;
constexpr size_t WS_MOD = 0, MOD_BYTES = 2 * 5 * 6144 * 4, WS_BAR = 262144, BAR_REGION = 16384, ZERO_BYTES = WS_BAR + 5 * BAR_REGION;
constexpr size_t WS_HID = 1 * MiB;
constexpr size_t WS_WIN = 3 * MiB  , WS_WG = 11 * MiB  , WS_WUQ = 15 * MiB, WS_WKN = 16 * MiB, WS_WVV = 16 * MiB + 262144, WS_WB = 17 * MiB, WS_WO = 20 * MiB, WS_WUP = 22 * MiB, WS_WDN = 33 * MiB;
constexpr size_t WS_U = 39 * MiB, WS_ACT = 171 * MiB, WS_HBF = 171 * MiB  , WS_HBF1 = 165 * MiB  ;
constexpr size_t WS_QA = 39 * MiB, WS_KVR = 51 * MiB, WS_CQ = 57 * MiB, WS_CKVR = 69 * MiB, WS_HYR = 75 * MiB, WS_OA = 75 * MiB, WS_OB = 87 * MiB, WS_OC = 99 * MiB;
constexpr size_t WS_UT = 111 * MiB, WS_QB = 147 * MiB, WS_CKVALL = 189 * MiB, WS_KPEALL = 196 * MiB, WS_KNB = 197 * MiB, WS_VTB = 210 * MiB, WS_KA = 223 * MiB, WS_VTA = 227 * MiB;
constexpr size_t WS_S0 = 232 * MiB  , WS_S1 = 111 * MiB, WS_S2 = 135 * MiB, WS_MBF = 195 * MiB, WS_END = 256 * MiB;
constexpr int KA_LAT = 16 * 2 * 256 * 64;
constexpr int UT_LAT = 16 * 1536 * 256;
constexpr int OUT_K = 12582912, OUT_V = 13631488, OUT_CKV = 14680064, OUT_KPE = 16777216;
constexpr int LDS_BYTES = 147456;
constexpr int NPHASE = 24;

#ifndef GAS
#define GAS __attribute__((address_space(1)))
#endif
#define LAS __attribute__((address_space(3)))
typedef unsigned short bf16;
typedef unsigned v4u __attribute__((ext_vector_type(4)));
typedef unsigned v2u __attribute__((ext_vector_type(2)));
typedef float f32x4 __attribute__((ext_vector_type(4)));
typedef float f32x16 __attribute__((ext_vector_type(16)));
typedef short bf16x8 __attribute__((ext_vector_type(8)));
typedef short bf16x4 __attribute__((ext_vector_type(4)));
#define LDS_WAIT() asm volatile("s_waitcnt lgkmcnt(0)" ::: "memory")
__device__ __forceinline__ unsigned f2bf(float f) { unsigned u = __builtin_bit_cast(unsigned, f); return (u + 0x7fffu + ((u >> 16) & 1u)) >> 16; }
__device__ __forceinline__ unsigned pk2(float lo, float hi) { return f2bf(lo) | (f2bf(hi) << 16); }
__device__ __forceinline__ float bflo(unsigned w) { return __uint_as_float(w << 16); }
__device__ __forceinline__ float bfhi(unsigned w) { return __uint_as_float(w & 0xffff0000u); }
__device__ __forceinline__ float bf1(bf16 b) { return __uint_as_float(((unsigned)b) << 16); }
__device__ __forceinline__ void fsincos(float x, float& s, float& c) { float rev = x * 0.15915494309189535f; rev = rev - rintf(rev); s = __builtin_amdgcn_sinf(rev); c = __builtin_amdgcn_cosf(rev); }
__device__ __forceinline__ float fsin(float x) { float rev = x * 0.15915494309189535f; rev = rev - rintf(rev); return __builtin_amdgcn_sinf(rev); }
__device__ __forceinline__ float wave_sum(float v) {
#pragma unroll
    for (int o = 1; o < 64; o <<= 1) v += __shfl_xor(v, o);
    return v;
}
__device__ __forceinline__ void rope2(float& x0, float& x1, float ang) { float s, c; fsincos(ang, s, c); const float a = x0 * c - x1 * s, b = x0 * s + x1 * c; x0 = a; x1 = b; }
#define L2_10000 13.287712379549449f

__device__ __forceinline__ void transpose_item(const float* W, size_t ldw, int k0, int n0, bf16* WT, size_t ldt, int drow0, LAS float* scr, int lane) {
    float wv[32];
#pragma unroll
    for (int i = 0; i < 32; ++i) wv[i] = ((const GAS float*)W)[(size_t)(k0 + 2 * i + (lane >> 5)) * ldw + n0 + (lane & 31)];
#pragma unroll
    for (int i = 0; i < 32; ++i) scr[(2 * i + (lane >> 5)) * 33 + (lane & 31)] = wv[i];
    LDS_WAIT(); asm volatile("" ::: "memory");
    const int c = lane & 7;
#pragma unroll
    for (int j = 0; j < 4; ++j) { const int n = (lane >> 3) + 8 * j; const LAS float* s = scr + (8 * c) * 33 + n;
        v4u o; o.x = pk2(s[0 * 33], s[1 * 33]); o.y = pk2(s[2 * 33], s[3 * 33]); o.z = pk2(s[4 * 33], s[5 * 33]); o.w = pk2(s[6 * 33], s[7 * 33]);
        *(GAS v4u*)(WT + (size_t)(drow0 + n) * ldt + k0 + 8 * c) = o; }
    LDS_WAIT(); asm volatile("" ::: "memory");
}

#define XB_TMO      128
#define XB_XCNT(j)  (256  + 64 * (j))
#define XB_XSUB(j)  (1280 + 64 * (j))
#define XB_XGEN(j)  (2304 + 64 * (j))
#define XB_TOP      3328
#define XB_TOPGEN   3392
#define XCD_BAR_WORDS 3456
#define XB_SPIN_CAP (1u << 18)

__device__ __forceinline__ unsigned xb_ld(unsigned* p)              { return __hip_atomic_load(p, __ATOMIC_RELAXED, __HIP_MEMORY_SCOPE_AGENT); }
__device__ __forceinline__ unsigned xb_add(unsigned* p, unsigned v) { return __hip_atomic_fetch_add(p, v, __ATOMIC_RELAXED, __HIP_MEMORY_SCOPE_AGENT); }
__device__ __forceinline__ unsigned xb_xcc_id() { return (unsigned)__builtin_amdgcn_s_getreg((3 << 11) | 20) & 0xFu; }
#define XB_SPIN(cond, bar) do { unsigned _sp = 0; while (cond) { __builtin_amdgcn_s_sleep(1); \
    if ((++_sp & 255u) == 0u) { if (xb_ld(&(bar)[XB_TMO])) break; if (_sp > XB_SPIN_CAP) { atomicAdd(&(bar)[XB_TMO], 1u); break; } } } } while (0)

struct XcdBarrier {
    unsigned* bar; unsigned x;
    volatile LAS unsigned* st;
};

__device__ __forceinline__ XcdBarrier xcd_barrier_post(unsigned* bar, volatile LAS unsigned* st) {
    XcdBarrier b; b.bar = bar; b.x = xb_xcc_id(); b.st = st;
    if (threadIdx.x == 0) (void)xb_add(&bar[XB_XCNT(b.x)], 1u);
    return b;
}
__device__ __forceinline__ void xcd_barrier_complete(unsigned* bar, unsigned x, unsigned& nloc, unsigned& nx) {
    const unsigned G = gridDim.x * gridDim.y * gridDim.z;
    unsigned sum, cnt, mine, sp = 0u;
    for (;;) {
        sum = 0u; cnt = 0u; mine = 0u;
#pragma unroll
        for (unsigned j = 0; j < 16; ++j) { const unsigned c = xb_ld(&bar[XB_XCNT(j)]); sum += c; cnt += (c > 0u) ? 1u : 0u; mine = (j == x) ? c : mine; }
        if (sum == G) break;
        __builtin_amdgcn_s_sleep(1);
        if ((++sp & 255u) == 0u) { if (xb_ld(&bar[XB_TMO])) break; if (sp > XB_SPIN_CAP) { atomicAdd(&bar[XB_TMO], 1u); break; } }
    }
    nloc = mine > 0u ? mine : 1u; nx = cnt > 0u ? cnt : 1u;
}

__device__ __forceinline__ void xcd_barrier(const XcdBarrier& b) {
    asm volatile("s_waitcnt vmcnt(0)" ::: "memory");
    __syncthreads();
    if (threadIdx.x == 0) {
        unsigned* bar = b.bar;
        __builtin_amdgcn_s_waitcnt(0);
        unsigned nloc = b.st[0], nx = b.st[1];
        if (nloc == 0u) { xcd_barrier_complete(bar, b.x, nloc, nx); b.st[0] = nloc; b.st[1] = nx; }
        const unsigned old = xb_add(&bar[XB_XSUB(b.x)], 1u);
        const unsigned gen = old / nloc;
        if (old + 1u == (gen + 1u) * nloc) {
            __builtin_amdgcn_fence(__ATOMIC_RELEASE, "agent");
            asm volatile("s_waitcnt vmcnt(0)" ::: "memory");
            const unsigned og = xb_add(&bar[XB_TOP], 1u);
            const unsigned tg = og / nx;
            if (og + 1u == (tg + 1u) * nx) xb_add(&bar[XB_TOPGEN], 1u);
            else XB_SPIN(xb_ld(&bar[XB_TOPGEN]) == tg, bar);
            __builtin_amdgcn_fence(__ATOMIC_ACQUIRE, "agent");
            xb_add(&bar[XB_XGEN(b.x)], 1u);
            asm volatile("s_waitcnt vmcnt(0)" ::: "memory");
        } else {
            XB_SPIN(xb_ld(&bar[XB_XGEN(b.x)]) == gen, bar);
            __builtin_amdgcn_fence(__ATOMIC_ACQUIRE, "agent");
            asm volatile("s_waitcnt vmcnt(0)" ::: "memory");
        }
    }
    __syncthreads();
}


struct Args { const float* in[35]; float* out; unsigned char* ws; int ph_lo, ph_hi, li, pad; };

__device__ __forceinline__ void wconv_phase(const Args& a, int l, int part, LAS unsigned char* lds, int gw, int NGW, int gt, int NGT, int wave, int lane) {
    LAS float* scr = (LAS float*)(lds + wave * 16384);
    unsigned char* ws = a.ws;
    bf16 *WIN = (bf16*)(ws + WS_WIN), *WG = (bf16*)(ws + WS_WG), *WUQ = (bf16*)(ws + WS_WUQ), *WKN = (bf16*)(ws + WS_WKN), *WVV = (bf16*)(ws + WS_WVV), *WB = (bf16*)(ws + WS_WB), *WO = (bf16*)(ws + WS_WO), *WUP = (bf16*)(ws + WS_WUP), *WDN = (bf16*)(ws + WS_WDN);
    constexpr int I1 = 16 * 189, I2 = 6 * 24, I3 = 4 * 32, I4 = 3 * 8 * 32, I5 = 16 * 32, I6 = 16 * 176, I7 = 44 * 32, NIT = I1 + I2 + I3 + I4 + I5 + I6 + I7;
    const int it_lo = (part == 2) ? NIT - I7 : 0, it_hi = (part == 1) ? NIT - I7 : NIT;
    for (int it = it_lo + gw; it < it_hi; it += NGW) {
        int r = it;
        if (r < I1) { const int kb = r / 189, n0 = 32 * (r % 189); bf16* dst = WIN; int drow;
            if (n0 < 1152) drow = n0; else if (n0 < 1408) drow = n0 + 128; else if (n0 < 1440) drow = 1152 + (n0 - 1408); else if (n0 < 2976) drow = 1536 + (n0 - 1440); else if (n0 < 4000) drow = 3072 + (n0 - 2976); else { dst = WG; drow = n0 - 4000; }
            transpose_item(a.in[12] + (size_t)l * 1024 * 6048, 6048, 64 * kb, n0, dst, 1024, drow, scr, lane); continue; } r -= I1;
        if (r < I2) { const int kb = r / 24, n0 = 32 * (r % 24); transpose_item(a.in[17] + (size_t)l * 384 * 768, 768, 64 * kb, n0, WUQ, 384, n0, scr, lane); continue; } r -= I2;
        if (r < I3) { const int kb = r / 32, n0 = 32 * (r % 32); const int h = n0 >> 7, c0 = n0 & 127;
            transpose_item(a.in[18] + (size_t)l * 256 * 1024, 1024, 64 * kb, n0, (c0 < 64) ? WKN : WVV, 256, h * 64 + (c0 & 63), scr, lane); continue; } r -= I3;
        if (r < I4) { const int n = r / 256, q = r % 256, kb = q / 32, n0 = 32 * (q % 32);
            transpose_item(a.in[28] + ((size_t)l * 3 + n) * 512 * 1024, 1024, 64 * kb, n0, WB + (size_t)n * 1024 * 512, 512, n0, scr, lane); continue; } r -= I4;
        if (r < I5) { const int kb = r / 32, n0 = 32 * (r % 32); transpose_item(a.in[29] + (size_t)l * 1024 * 1024, 1024, 64 * kb, n0, WO, 1024, n0, scr, lane); continue; } r -= I5;
        if (r < I6) { const int kb = r / 176, n0 = 32 * (r % 176); transpose_item(a.in[30] + (size_t)l * 1024 * 5632, 5632, 64 * kb, n0, WUP, 1024, n0, scr, lane); continue; } r -= I6;
        { const int kb = r / 32, n0 = 32 * (r % 32); transpose_item(a.in[33] + (size_t)l * 2816 * 1024, 1024, 64 * kb, n0, WDN, 2816, n0, scr, lane); }
    }
    if (part != 2) for (int i = gt; i < 96 * 1024 / 8; i += NGT) *(GAS v4u*)(WIN + (size_t)1184 * 1024 + (size_t)i * 8) = (v4u){0u, 0u, 0u, 0u};
}

__device__ __forceinline__ void norm_phase(const Args& a, int l, int which, bool first, int gw, int NGW, int lane) {
    const GAS float* mod = (const GAS float*)(a.ws + WS_MOD) + (size_t)l * 5 * 6144;
    GAS bf16* HBF = (GAS bf16*)(a.ws + (which == 0 ? WS_HBF1 : WS_HBF));
    const GAS float* gv = (const GAS float*)((which == 0) ? a.in[10] + l * 1024 : (which == 1) ? a.in[11] + l * 1024 : a.in[34]);
    GAS float* outp = (GAS float*)a.out;
    const int shoff = (which == 0) ? 0 : 3072, scoff = shoff + 1024;
    #pragma unroll 1
    for (int row0 = gw; row0 < TT; row0 += 4 * NGW) {
        f32x4 v[4][4];
#pragma unroll
        for (int q = 0; q < 4; ++q) { const int row = row0 + q * NGW; const int rr = row < TT ? row : row0;
            const GAS float* src = first ? (const GAS float*)(rr < TCTX ? a.in[0] + (size_t)rr * DM : a.in[1] + (size_t)(rr - TCTX) * DM) : (const GAS float*)(outp + (size_t)rr * DM);
#pragma unroll
            for (int j = 0; j < 4; ++j) v[q][j] = *(const GAS f32x4*)(src + 4 * lane + 256 * j); }
#pragma unroll
        for (int q = 0; q < 4; ++q) { const int row = row0 + q * NGW; if (row >= TT) continue;
            float ss = 0.f;
#pragma unroll
            for (int j = 0; j < 4; ++j) ss += (v[q][j].x * v[q][j].x + v[q][j].y * v[q][j].y) + (v[q][j].z * v[q][j].z + v[q][j].w * v[q][j].w);
            if (first) {
#pragma unroll
                for (int j = 0; j < 4; ++j) *(GAS f32x4*)(outp + (size_t)row * DM + 4 * lane + 256 * j) = v[q][j]; }
            const float rs = rsqrtf(wave_sum(ss) * (1.f / DM) + EPSN);
            const int mrow = row < TCTX ? 0 : 1 + ((row - TCTX) >> 11);
            const GAS float* mp = mod + (size_t)mrow * 6144;
#pragma unroll
            for (int j = 0; j < 4; ++j) { const int col = 4 * lane + 256 * j; const f32x4 g = *(const GAS f32x4*)(gv + col);
                if (which == 2) { *(GAS f32x4*)(outp + (size_t)row * DM + col) = v[q][j] * rs * g; }
                else { const f32x4 sc = *(const GAS f32x4*)(mp + scoff + col), sh = *(const GAS f32x4*)(mp + shoff + col);
                    const f32x4 y = v[q][j] * rs * g * (sc + 1.f) + sh;
                    *(GAS v2u*)(HBF + (size_t)row * DM + col) = (v2u){pk2(y.x, y.y), pk2(y.z, y.w)}; } } }
    }
}
__device__ __forceinline__ void p0_mod_hid(const Args& a, LAS unsigned char* lds, int bid, int G, int tid, int gw, int NGW, int lane) {
    float* mod = (float*)(a.ws + WS_MOD);
    LAS float* sc = (LAS float*)lds;
    for (int it = bid; it < 384; it += G) {
        const int l = it / 192, rem = it % 192, kc = rem / 12, jb = rem % 12;
        if (tid < 320) { const int r = tid >> 6, kk = tid & 63, k = kc * 64 + kk; const float cv = (r == 0) ? a.in[7][k] : a.in[6][(r - 1) * 1024 + k]; sc[tid] = cv / (1.f + __expf(-cv)); }
        __syncthreads();
        const int j = jb * 512 + tid;
        const GAS float* wp = (const GAS float*)(a.in[8] + ((size_t)l * 1024 + kc * 64) * 6144 + j);
        float acc[5] = {0.f, 0.f, 0.f, 0.f, 0.f};
#pragma unroll 8
        for (int kk = 0; kk < 64; ++kk) { const float w = wp[(size_t)kk * 6144];
#pragma unroll
            for (int r = 0; r < 5; ++r) acc[r] += sc[r * 64 + kk] * w; }
        const float bias = (kc == 0) ? a.in[9][l * 6144 + j] : 0.f;
#pragma unroll
        for (int r = 0; r < 5; ++r) atomicAdd(mod + (size_t)(l * 5 + r) * 6144 + j, acc[r] + bias);
        __syncthreads();
    }
    float* HID = (float*)(a.ws + WS_HID);
    for (int it = gw; it < 2 * 2304; it += NGW) {
        const int l = it / 2304, q = it % 2304; const int L = q < 256 ? 256 : 2048, t = q < 256 ? q : q - 256;
        const float tn = (float)t / (float)(L - 1);
        float zi = 0.f;
        if (lane == 0) zi = tn;
        else if (lane <= 16) { const int bi = (lane - 1) & 7; const float band = 1e-4f + (float)bi * ((7.f - 1e-4f) / 7.f); const float ang = (6.283185307179586f / (float)L) * (float)t * band; float s, c; fsincos(ang, s, c); zi = (lane <= 8) ? c : -s; }
        float s1 = a.in[22][l * 64 + lane];
#pragma unroll
        for (int i = 0; i < 17; ++i) s1 += __shfl(zi, i) * a.in[21][(l * 17 + i) * 64 + lane];
        const float h1 = fsin(a.in[26][(l * 2 + 0) * 64 + lane] * s1);
        float s2 = a.in[24][l * 64 + lane];
#pragma unroll 8
        for (int i = 0; i < 64; ++i) s2 += __shfl(h1, i) * a.in[23][(l * 64 + i) * 64 + lane];
        HID[(size_t)it * 64 + lane] = fsin(a.in[26][(l * 2 + 1) * 64 + lane] * s2);
    }
}

__device__ __forceinline__ void post_phase(const Args& a, int l, LAS unsigned char* lds, int bid, int G, int tid, int gw, int NGW, int gt, int NGT, int lane) {
    unsigned char* ws = a.ws;
    GAS bf16 *QA = (GAS bf16*)(ws + WS_QA), *KVR = (GAS bf16*)(ws + WS_KVR), *CQ = (GAS bf16*)(ws + WS_CQ), *CKVR = (GAS bf16*)(ws + WS_CKVR), *HYR = (GAS bf16*)(ws + WS_HYR);
    GAS bf16 *UT = (GAS bf16*)(ws + WS_UT), *CKVALL = (GAS bf16*)(ws + WS_CKVALL), *KPEALL = (GAS bf16*)(ws + WS_KPEALL), *KA = (GAS bf16*)(ws + WS_KA), *VTA = (GAS bf16*)(ws + WS_VTA);
    GAS float* outp = (GAS float*)a.out;
    for (int i = gt; i < 4 * 256 * 128; i += NGT) { const int b = i >> 15, p = (i >> 7) & 255, kvh = (i >> 6) & 1, d = i & 63;
        const size_t s = ((size_t)(b * 2 + l) * 256 + p) * 128 + kvh * 64 + d;
        KA[KA_LAT + ((b * 2 + kvh) * 2304 + p) * 64 + d] = (bf16)f2bf(a.in[2][s]);
        VTA[KA_LAT + ((b * 2 + kvh) * 64 + d) * 2304 + p] = (bf16)f2bf(a.in[3][s]); }
    for (int i = gt; i < 4 * 256 * 256; i += NGT) { const int b = i >> 16, p = (i >> 8) & 255, j = i & 255;
        CKVALL[(size_t)(TCTX + b * 2304 + p) * 256 + j] = (bf16)f2bf(a.in[4][((size_t)(b * 2 + l) * 256 + p) * 256 + j]); }
    for (int i = gt; i < 4 * 256 * 32; i += NGT) { const int b = i >> 13, p = (i >> 5) & 255, j = i & 31;
        KPEALL[(size_t)(TCTX + b * 2304 + p) * 32 + j] = (bf16)f2bf(a.in[5][((size_t)(b * 2 + l) * 256 + p) * 32 + j]); }
    const GAS float *gq = (const GAS float*)(a.in[13] + l * 64), *gk = (const GAS float*)(a.in[14] + l * 64), *gcq = (const GAS float*)(a.in[15] + l * 384), *gkv = (const GAS float*)(a.in[16] + l * 256);
    for (int row = gw; row < TT; row += NGW) {
        const bool lat = row >= TCTX;
        const int b = lat ? (row - TCTX) >> 11 : row >> 8, t = lat ? (row - TCTX) & 2047 : row & 255;
        const float grow = (float)(t >> 6), gcol = (float)(t & 63);
        const int keyrow = lat ? TCTX + b * 2304 + 256 + t : row;
        { v4u w = *(const GAS v4u*)(QA + (size_t)row * 512 + 8 * lane);
          float x[8] = {bflo(w.x), bfhi(w.x), bflo(w.y), bfhi(w.y), bflo(w.z), bfhi(w.z), bflo(w.w), bfhi(w.w)};
          float ss = 0.f;
#pragma unroll
          for (int j = 0; j < 8; ++j) ss += x[j] * x[j];
          ss += __shfl_xor(ss, 1); ss += __shfl_xor(ss, 2); ss += __shfl_xor(ss, 4);
          const float rs = rsqrtf(ss * (1.f / 64.f) + EPSN); const int d0 = 8 * (lane & 7);
#pragma unroll
          for (int j = 0; j < 8; ++j) x[j] = x[j] * rs * gq[d0 + j];
          if (lat) {
#pragma unroll
              for (int k = 0; k < 4; ++k) { const int i = 4 * (lane & 7) + k; const float inv = __builtin_amdgcn_exp2f(-(float)(i & 15) * (L2_10000 / 16.f)); rope2(x[2 * k], x[2 * k + 1], (i < 16 ? grow : gcol) * inv); } }
          *(GAS v4u*)(QA + (size_t)row * 512 + 8 * lane) = (v4u){pk2(x[0], x[1]), pk2(x[2], x[3]), pk2(x[4], x[5]), pk2(x[6], x[7])}; }
        { const v2u w = *(const GAS v2u*)(KVR + (size_t)row * 256 + 4 * lane);
          float x[4] = {bflo(w.x), bfhi(w.x), bflo(w.y), bfhi(w.y)};
          float ss = (x[0] * x[0] + x[1] * x[1]) + (x[2] * x[2] + x[3] * x[3]);
          ss += __shfl_xor(ss, 1); ss += __shfl_xor(ss, 2); ss += __shfl_xor(ss, 4); ss += __shfl_xor(ss, 8);
          const int kvh = (lane >> 4) & 1, d0 = 4 * (lane & 15);
          if (lane < 32) {
              const float rs = rsqrtf(ss * (1.f / 64.f) + EPSN);
#pragma unroll
              for (int j = 0; j < 4; ++j) x[j] = x[j] * rs * gk[d0 + j];
              if (!lat) { *(GAS f32x4*)(outp + OUT_K + ((size_t)(b * 2 + l) * 256 + t) * 128 + kvh * 64 + d0) = (f32x4){x[0], x[1], x[2], x[3]};
                  *(GAS v2u*)(KA + ((size_t)(b * 2 + kvh) * 256 + t) * 64 + d0) = (v2u){pk2(x[0], x[1]), pk2(x[2], x[3])}; }
              else {
#pragma unroll
                  for (int k = 0; k < 2; ++k) { const int i = 2 * (lane & 15) + k; const float inv = __builtin_amdgcn_exp2f(-(float)(i & 15) * (L2_10000 / 16.f)); rope2(x[2 * k], x[2 * k + 1], (i < 16 ? grow : gcol) * inv); }
                  *(GAS v2u*)(KA + KA_LAT + ((size_t)(b * 2 + kvh) * 2304 + 256 + t) * 64 + d0) = (v2u){pk2(x[0], x[1]), pk2(x[2], x[3])}; }
          } else {
              if (!lat) { *(GAS f32x4*)(outp + OUT_V + ((size_t)(b * 2 + l) * 256 + t) * 128 + kvh * 64 + d0) = (f32x4){x[0], x[1], x[2], x[3]};
#pragma unroll
                  for (int j = 0; j < 4; ++j) VTA[((size_t)(b * 2 + kvh) * 64 + d0 + j) * 256 + t] = (bf16)f2bf(x[j]); }
              else {
#pragma unroll
                  for (int j = 0; j < 4; ++j) VTA[KA_LAT + ((size_t)(b * 2 + kvh) * 64 + d0 + j) * 2304 + 256 + t] = (bf16)f2bf(x[j]); }
          } }
        { GAS unsigned* p = (GAS unsigned*)(CQ + (size_t)row * 512 + 6 * lane);
          const unsigned w0 = p[0], w1 = p[1], w2 = p[2];
          float x[6] = {bflo(w0), bfhi(w0), bflo(w1), bfhi(w1), bflo(w2), bfhi(w2)};
          float ss = 0.f;
#pragma unroll
          for (int j = 0; j < 6; ++j) ss += x[j] * x[j];
          const float rs = rsqrtf(wave_sum(ss) * (1.f / 384.f) + EPSN);
#pragma unroll
          for (int j = 0; j < 6; ++j) x[j] = x[j] * rs * gcq[6 * lane + j];
          p[0] = pk2(x[0], x[1]); p[1] = pk2(x[2], x[3]); p[2] = pk2(x[4], x[5]);
          if (lane < 16) { const unsigned w = *(const GAS unsigned*)(CQ + (size_t)row * 512 + 384 + 2 * lane); float y0 = bflo(w), y1 = bfhi(w);
              if (!lat) { outp[OUT_KPE + ((size_t)(b * 2 + l) * 256 + t) * 32 + 2 * lane] = y0; outp[OUT_KPE + ((size_t)(b * 2 + l) * 256 + t) * 32 + 2 * lane + 1] = y1; }
              else { const float inv = __builtin_amdgcn_exp2f(-(float)(lane & 7) * (L2_10000 / 8.f)); rope2(y0, y1, (lane < 8 ? grow : gcol) * inv); }
              *(GAS unsigned*)(KPEALL + (size_t)keyrow * 32 + 2 * lane) = pk2(y0, y1); } }
        { const v2u w = *(const GAS v2u*)(CKVR + (size_t)row * 256 + 4 * lane);
          float x[4] = {bflo(w.x), bfhi(w.x), bflo(w.y), bfhi(w.y)};
          const float ss = (x[0] * x[0] + x[1] * x[1]) + (x[2] * x[2] + x[3] * x[3]);
          const float rs = rsqrtf(wave_sum(ss) * (1.f / 256.f) + EPSN);
#pragma unroll
          for (int j = 0; j < 4; ++j) x[j] = x[j] * rs * gkv[4 * lane + j];
          if (!lat) *(GAS f32x4*)(outp + OUT_CKV + ((size_t)(b * 2 + l) * 256 + t) * 256 + 4 * lane) = (f32x4){x[0], x[1], x[2], x[3]};
          *(GAS v2u*)(CKVALL + (size_t)keyrow * 256 + 4 * lane) = (v2u){pk2(x[0], x[1]), pk2(x[2], x[3])}; }
    }
    LAS float* tile = (LAS float*)lds;
    const GAS float *sw = (const GAS float*)(a.in[19] + (size_t)l * 3 * 1536), *sb = (const GAS float*)(a.in[20] + (size_t)l * 1536);
    for (int it = bid; it < 96 * 12; it += G) {
        const int tb = it / 12, cb = it % 12, row0 = tb * 128;
        const bool lat = row0 >= TCTX; const int L = lat ? 2048 : 256;
        const int b = lat ? (row0 - TCTX) >> 11 : row0 >> 8, t0 = lat ? (row0 - TCTX) & 2047 : row0 & 255;
        v4u w[4], wh = (v4u){0u, 0u, 0u, 0u};
        { const int rr = tid >> 4, c8 = tid & 15;
#pragma unroll
          for (int q = 0; q < 4; ++q) w[q] = *(const GAS v4u*)(HYR + (size_t)(row0 + rr + 32 * q) * 1536 + cb * 128 + 8 * c8);
          if (tid < 32) { const int which = tid >> 4; const bool ok = which ? (t0 + 128 < L) : (t0 > 0); const int rsrc = which ? row0 + 128 : row0 - 1;
              if (ok) wh = *(const GAS v4u*)(HYR + (size_t)rsrc * 1536 + cb * 128 + 8 * c8); }
#pragma unroll
          for (int q = 0; q < 4; ++q) { LAS float* tp = tile + (rr + 32 * q + 1) * 129 + 8 * c8;
              tp[0] = bflo(w[q].x); tp[1] = bfhi(w[q].x); tp[2] = bflo(w[q].y); tp[3] = bfhi(w[q].y); tp[4] = bflo(w[q].z); tp[5] = bfhi(w[q].z); tp[6] = bflo(w[q].w); tp[7] = bfhi(w[q].w); }
          if (tid < 32) { LAS float* tp = tile + ((tid >> 4) ? 129 : 0) * 129 + 8 * c8;
              tp[0] = bflo(wh.x); tp[1] = bfhi(wh.x); tp[2] = bflo(wh.y); tp[3] = bfhi(wh.y); tp[4] = bflo(wh.z); tp[5] = bfhi(wh.z); tp[6] = bflo(wh.w); tp[7] = bfhi(wh.w); } }
        __syncthreads();
        { const int c = tid >> 2, tc = tid & 3, cg_ = cb * 128 + c; const float w0 = sw[cg_], w1 = sw[1536 + cg_], w2 = sw[3072 + cg_], bb = sb[cg_];
          const size_t base = lat ? (size_t)UT_LAT + ((size_t)b * 1536 + cg_) * 2048 : ((size_t)b * 1536 + cg_) * 256;
#pragma unroll
          for (int q = 0; q < 4; ++q) { float u[8];
#pragma unroll
              for (int k = 0; k < 8; ++k) { const int tr = 32 * tc + 8 * q + k; u[k] = w0 * tile[tr * 129 + c] + w1 * tile[(tr + 1) * 129 + c] + w2 * tile[(tr + 2) * 129 + c] + bb; }
              *(GAS v4u*)(UT + base + t0 + 32 * tc + 8 * q) = (v4u){pk2(u[0], u[1]), pk2(u[2], u[3]), pk2(u[4], u[5]), pk2(u[6], u[7])}; } }
        __syncthreads();
    }
}

__device__ __forceinline__ void ffnconv_phase(const Args& a, int l, int gt, int NGT) {
    const GAS bf16* U = (const GAS bf16*)(a.ws + WS_U); GAS bf16* ACT = (GAS bf16*)(a.ws + WS_ACT);
    const GAS float *cw = (const GAS float*)(a.in[31] + (size_t)l * 3 * 5632), *cb = (const GAS float*)(a.in[32] + (size_t)l * 5632);
#pragma unroll 1
    for (int idx = gt; idx < 1536 * 352; idx += NGT) {
        const int tb = idx / 352, ch = idx % 352, row0 = tb * 8, c0 = ch * 8;
        const bool lat = row0 >= TCTX; const int t0 = lat ? (row0 - TCTX) & 2047 : row0 & 255, L = lat ? 2048 : 256;
        v4u ra[10], rg[10];
#pragma unroll
        for (int i = 0; i < 10; ++i) { const int t = t0 + i - 1; const bool ok = (t >= 0) && (t < L); const size_t rr = (size_t)(row0 + (ok ? i - 1 : 0)) * 5632 + c0;
            ra[i] = *(const GAS v4u*)(U + rr); rg[i] = *(const GAS v4u*)(U + rr + 2816);
            if (!ok) { ra[i] = (v4u){0u, 0u, 0u, 0u}; rg[i] = (v4u){0u, 0u, 0u, 0u}; } }
        float wa[3][8], wg[3][8], ba[8], bg[8];
#pragma unroll
        for (int j = 0; j < 8; ++j) { ba[j] = cb[c0 + j]; bg[j] = cb[2816 + c0 + j];
#pragma unroll
            for (int k = 0; k < 3; ++k) { wa[k][j] = cw[k * 5632 + c0 + j]; wg[k][j] = cw[k * 5632 + 2816 + c0 + j]; } }
#pragma unroll
        for (int i = 0; i < 8; ++i) {
            float o[8];
#pragma unroll
            for (int j2 = 0; j2 < 4; ++j2) {
                const unsigned a0 = ra[i][j2], a1 = ra[i + 1][j2], a2 = ra[i + 2][j2], g0 = rg[i][j2], g1 = rg[i + 1][j2], g2 = rg[i + 2][j2];
                { const int j = 2 * j2; const float av = wa[0][j] * bflo(a0) + wa[1][j] * bflo(a1) + wa[2][j] * bflo(a2) + ba[j], gv = wg[0][j] * bflo(g0) + wg[1][j] * bflo(g1) + wg[2][j] * bflo(g2) + bg[j]; o[j] = gv * __builtin_amdgcn_rcpf(1.f + __expf(-gv)) * av; }
                { const int j = 2 * j2 + 1; const float av = wa[0][j] * bfhi(a0) + wa[1][j] * bfhi(a1) + wa[2][j] * bfhi(a2) + ba[j], gv = wg[0][j] * bfhi(g0) + wg[1][j] * bfhi(g1) + wg[2][j] * bfhi(g2) + bg[j]; o[j] = gv * __builtin_amdgcn_rcpf(1.f + __expf(-gv)) * av; } }
            *(GAS v4u*)(ACT + (size_t)(row0 + i) * 2816 + c0) = (v4u){pk2(o[0], o[1]), pk2(o[2], o[3]), pk2(o[4], o[5]), pk2(o[6], o[7])};
        }
    }
}
typedef float f32x2_t __attribute__((ext_vector_type(2)));
typedef __bf16 bf16x2_t __attribute__((ext_vector_type(2)));
__device__ __forceinline__ unsigned cvtpk(float lo, float hi) { const f32x2_t v = {lo, hi}; const bf16x2_t b = __builtin_convertvector(v, bf16x2_t); return __builtin_bit_cast(unsigned, b); }
template <int DK>
__device__ __forceinline__ void attn_unit(LAS unsigned char* lds, int tid, const bf16* Qp, int qpitch, const bf16* Kp, int kpitch, const bf16* Kpe, const bf16* Vt, size_t vpitch,
                                          int nkeys, bf16* Op, int opitch, float sl2, bool rope, int pos0) {
    constexpr int NS = DK / 16;
    asm volatile("" : "+v"(tid));
    const int lane = tid & 63, wave = tid >> 6, r = lane & 31, h = lane >> 5;
    bf16x8 qf[NS];
    { const bf16* qrow = Qp + (size_t)(wave * 32 + r) * qpitch;
#pragma unroll
      for (int s = 0; s < NS; ++s) qf[s] = *(const GAS bf16x8*)(qrow + 16 * s + 8 * h);
      if (DK == 96 && rope) { const int t = pos0 + wave * 32 + r; const float grow = (float)(t >> 6), gcol = (float)(t & 63);
#pragma unroll
          for (int sp = 0; sp < 2; ++sp) { bf16x8 v = qf[NS - 2 + sp];
#pragma unroll
              for (int k = 0; k < 4; ++k) { float x0 = bf1((bf16)v[2 * k]), x1 = bf1((bf16)v[2 * k + 1]);
                  const float inv = __builtin_amdgcn_exp2f(-(float)(4 * h + k) * (L2_10000 / 8.f)); rope2(x0, x1, (sp == 0 ? grow : gcol) * inv);
                  v[2 * k] = (short)f2bf(x0); v[2 * k + 1] = (short)f2bf(x1); }
              qf[NS - 2 + sp] = v; } } }
    const int kkey = tid >> 3, kch = tid & 7, pkey = tid >> 2, pch = tid & 3;
    f32x16 o0, o1;
#pragma unroll
    for (int i = 0; i < 16; ++i) { o0[i] = 0.f; o1[i] = 0.f; }
    float mrun = -__builtin_inff(), lrun = 0.f;
    v4u rk, rv, rp = (v4u){0u, 0u, 0u, 0u};
    const int ntile = nkeys >> 6;
#define ATT_LOAD(kt) do { const int key0 = (kt) * 64; rk = *(const GAS v4u*)(Kp + (size_t)(key0 + kkey) * kpitch + 8 * kch); rv = *(const GAS v4u*)(Vt + (size_t)kkey * vpitch + key0 + 8 * kch); \
        if (DK == 96 && tid < 256) rp = *(const GAS v4u*)(Kpe + (size_t)(key0 + pkey) * 32 + 8 * pch); } while (0)
#define ATT_WRITE(buf) do { *(LAS v4u*)(lds + (buf) * 13312 + kkey * 208 + kch * 16) = rk; \
        { LAS unsigned char* vw = lds + 26624 + (buf) * 9216 + kkey * 144 + (kch >> 1) * 32 + (kch & 1) * 8; *(LAS v2u*)vw = (v2u){rv.x, rv.y}; *(LAS v2u*)(vw + 16) = (v2u){rv.z, rv.w}; } \
        if (DK == 96 && tid < 256) *(LAS v4u*)(lds + (buf) * 13312 + pkey * 208 + 128 + pch * 16) = rp; } while (0)
    ATT_LOAD(0); ATT_WRITE(0); __syncthreads();
    for (int kt = 0; kt < ntile; ++kt) {
        const int buf = kt & 1;
        if (kt + 1 < ntile) ATT_LOAD(kt + 1);
        const LAS unsigned char* kb = lds + buf * 13312; const LAS unsigned char* vb = lds + 26624 + buf * 9216;
        f32x16 s0, s1;
#pragma unroll
        for (int i = 0; i < 16; ++i) { s0[i] = 0.f; s1[i] = 0.f; }
#pragma unroll
        for (int s = 0; s < NS; ++s) {
            const bf16x8 a0 = *(const LAS bf16x8*)(kb + r * 208 + (16 * s + 8 * h) * 2), a1 = *(const LAS bf16x8*)(kb + (32 + r) * 208 + (16 * s + 8 * h) * 2);
            s0 = __builtin_amdgcn_mfma_f32_32x32x16_bf16(a0, qf[s], s0, 0, 0, 0); s1 = __builtin_amdgcn_mfma_f32_32x32x16_bf16(a1, qf[s], s1, 0, 0, 0); }
        float mx = s0[0];
#pragma unroll
        for (int i = 1; i < 16; ++i) mx = fmaxf(mx, s0[i]);
#pragma unroll
        for (int i = 0; i < 16; ++i) mx = fmaxf(mx, s1[i]);
        mx = fmaxf(mx, __shfl_xor(mx, 32));
        const float mnew = fmaxf(mrun, mx), alpha = __builtin_amdgcn_exp2f((mrun - mnew) * sl2), nm = mnew * sl2;
        float sum = 0.f;
#pragma unroll
        for (int i = 0; i < 16; ++i) { s0[i] = __builtin_amdgcn_exp2f(s0[i] * sl2 - nm); s1[i] = __builtin_amdgcn_exp2f(s1[i] * sl2 - nm); sum += s0[i] + s1[i]; }
        lrun = lrun * alpha + sum; mrun = mnew;
        if (__builtin_amdgcn_ballot_w64(alpha != 1.f)) {
#pragma unroll
            for (int i = 0; i < 16; ++i) { o0[i] *= alpha; o1[i] *= alpha; } }
#pragma unroll
        for (int sub = 0; sub < 2; ++sub) {
#pragma unroll
            for (int s2 = 0; s2 < 2; ++s2) {
                const v4u pw = (sub == 0) ? (v4u){cvtpk(s0[8 * s2], s0[8 * s2 + 1]), cvtpk(s0[8 * s2 + 2], s0[8 * s2 + 3]), cvtpk(s0[8 * s2 + 4], s0[8 * s2 + 5]), cvtpk(s0[8 * s2 + 6], s0[8 * s2 + 7])}
                                          : (v4u){cvtpk(s1[8 * s2], s1[8 * s2 + 1]), cvtpk(s1[8 * s2 + 2], s1[8 * s2 + 3]), cvtpk(s1[8 * s2 + 4], s1[8 * s2 + 5]), cvtpk(s1[8 * s2 + 6], s1[8 * s2 + 7])};
                const bf16x8 pb = __builtin_bit_cast(bf16x8, pw);
                const int kofs = (32 * sub + 16 * s2 + 8 * h) * 2;
#pragma unroll
                for (int slab = 0; slab < 2; ++slab) {
                    const bf16x8 va = *(const LAS bf16x8*)(vb + (32 * slab + r) * 144 + kofs);
                    if (slab == 0) o0 = __builtin_amdgcn_mfma_f32_32x32x16_bf16(va, pb, o0, 0, 0, 0); else o1 = __builtin_amdgcn_mfma_f32_32x32x16_bf16(va, pb, o1, 0, 0, 0); } } }
        if (kt + 1 < ntile) ATT_WRITE(buf ^ 1);
        __syncthreads();
    }
#undef ATT_LOAD
#undef ATT_WRITE
    const float ltot = lrun + __shfl_xor(lrun, 32), inv = 1.f / ltot;
    bf16* orow = Op + (size_t)(wave * 32 + r) * opitch;
#pragma unroll
    for (int g4 = 0; g4 < 4; ++g4) {
        *(GAS v2u*)(orow + 8 * g4 + 4 * h) = (v2u){pk2(o0[4 * g4] * inv, o0[4 * g4 + 1] * inv), pk2(o0[4 * g4 + 2] * inv, o0[4 * g4 + 3] * inv)};
        *(GAS v2u*)(orow + 32 + 8 * g4 + 4 * h) = (v2u){pk2(o1[4 * g4] * inv, o1[4 * g4 + 1] * inv), pk2(o1[4 * g4 + 2] * inv, o1[4 * g4 + 3] * inv)}; }
}

template <bool LAT>
__device__ __forceinline__ void hyena_unit(const Args& a, int l, int c, LAS unsigned char* lds, int tid) {
    constexpr int L = LAT ? 2048 : 256, NB = LAT ? 4 : 16, NE = L / 16, NCH = L / 4, NW = LAT ? 8 : 4, ASH = LAT ? 2 : 4, MG = LAT ? 224 : 32  , UP = L + 2 * MG + 8  , GS = 514  ;
    asm volatile("" : "+v"(tid));
    const int lane = tid & 63, wave = tid >> 6, r = lane & 31, h = lane >> 5;
    const bf16* UT = (const bf16*)(a.ws + WS_UT) + (LAT ? UT_LAT : 0);
    GAS bf16* OC = (GAS bf16*)(a.ws + WS_OC);
    const float* HID = (const float*)(a.ws + WS_HID) + ((size_t)l * 2304 + (LAT ? 256 : 0)) * 64;
    LAS bf16* U = (LAS bf16*)lds; LAS bf16* X = (LAS bf16*)(lds + 20096); LAS float* FT = (LAS float*)(lds + 36480); LAS unsigned char* GC = lds + 69248;
    LAS float* W3 = (LAS float*)(lds + 135040); LAS float* RED = (LAS float*)(lds + 136064);
    constexpr int NQ = NB * L / 8 / 512;
    v4u x2r[NQ];
#pragma unroll
    for (int i = 0; i < NQ; ++i) { const int q = tid + 512 * i, b = q / (L / 8), off = (q % (L / 8)) * 8;
        const v4u uv = *(const GAS v4u*)(UT + ((size_t)b * 1536 + c) * L + off), xv = *(const GAS v4u*)(UT + ((size_t)b * 1536 + 512 + c) * L + off);
        x2r[i] = *(const GAS v4u*)(UT + ((size_t)b * 1536 + 1024 + c) * L + off);
        *(LAS v4u*)(U + b * UP + MG + off) = uv; *(LAS v4u*)(X + b * L + off) = xv; }
    for (int q = tid; q < NB * 2 * MG / 8; q += 512) { const int b = q / (2 * MG / 8), o = q % (2 * MG / 8); const int off = (o < MG / 8) ? 8 * o : MG + L + 8 * (o - MG / 8);
        *(LAS v4u*)(U + b * UP + off) = (v4u){0u, 0u, 0u, 0u}; }
    if (tid < 256) { const int j = tid >> 2, k = tid & 3; W3[k * 64 + j] = a.in[25][((size_t)l * 64 + j) * 2048 + (k >> 1) * 1024 + (k & 1) * 512 + c]; }
    __syncthreads();
#if defined(PROBE_HY) && PROBE_HY == 1
    for (int rep = 0; rep < 2; ++rep)
#endif
    { const float dmin = -15.350567286626973f, dmax = -3.0701134573253945f;
      const float delta = fabsf(dmin + (float)c * ((dmax - dmin) / 511.f));
      float p0 = 0.f, p1 = 0.f;
      for (int t = tid; t < L; t += 512) {
          float s[4] = {0.f, 0.f, 0.f, 0.f};
#pragma unroll 4
          for (int j4 = 0; j4 < 16; ++j4) { const f32x4 hv = *(const GAS f32x4*)(HID + (size_t)t * 64 + 4 * j4);
#pragma unroll
              for (int k = 0; k < 4; ++k) s[k] += hv.x * W3[k * 64 + 4 * j4] + hv.y * W3[k * 64 + 4 * j4 + 1] + hv.z * W3[k * 64 + 4 * j4 + 2] + hv.w * W3[k * 64 + 4 * j4 + 3]; }
          const float win = __expf(-((float)t / (float)(L - 1)) * delta);
#pragma unroll
          for (int k = 0; k < 4; ++k) { s[k] *= win; FT[k * L + t] = s[k]; }
          p0 += fabsf(s[0]) + (t >= 1 ? fabsf(s[2]) : 0.f); p1 += fabsf(s[1]) + (t >= 1 ? fabsf(s[3]) : 0.f); }
      p0 = wave_sum(p0); p1 = wave_sum(p1);
      if (lane == 0) { RED[2 * wave] = p0; RED[2 * wave + 1] = p1; } }
    __syncthreads();
    const int col = 32 * wave + r, ca = col >> ASH, cbat = col & (NB - 1);
    const int a_lo = (32 * wave) >> ASH, a_hi = (32 * wave + 31) >> ASH;
    const int rowbase = LAT ? TCTX + cbat * 2048 : cbat * 256;
#pragma unroll 1
    for (int n = 0; n < 2; ++n) {
        float l1s = 0.f;
#pragma unroll
        for (int w = 0; w < 8; ++w) l1s += RED[2 * w + n];
        const float invl1 = 1.f / (l1s + EPSN);
#if defined(PROBE_HY) && PROBE_HY == 4
        for (int rep = 0; rep < 2; ++rep)
#endif
        for (int q = tid; q < 8 * NCH; q += 512) { const int k = q & 7, y = q >> 3, m0 = L - (8 * y + k);
            float v[8];
#pragma unroll
            for (int j = 0; j < 8; ++j) { const int m = m0 - j; float t = 0.f; if (m >= 0 && m < L) t = FT[n * L + m]; else if (m < 0 && m > -L) t = FT[(2 + n) * L - m]; v[j] = t * invl1; }
            *(LAS v4u*)(GC + (k * GS + y) * 16) = (v4u){cvtpk(v[0], v[1]), cvtpk(v[2], v[3]), cvtpk(v[4], v[5]), cvtpk(v[6], v[7])}; }
        __syncthreads();
        f32x16 acc, acc1;
#if defined(PROBE_HY) && PROBE_HY == 3
        for (int rep = 0; rep < 2; ++rep) {
#endif
#pragma unroll
        for (int i = 0; i < 16; ++i) { acc[i] = 0.f; acc1[i] = 0.f; }
        if (wave < NW) {
            const int lam_lo = 2 * a_lo - (NE - 1), lam_hi = 2 * a_hi;
            const int xs0 = 8 * h - r + L;
            const LAS unsigned char* ap = GC + ((xs0 & 7) * GS + (xs0 >> 3) - 2 * lam_lo) * 16;
            const LAS unsigned char* bp = (const LAS unsigned char*)(U + cbat * UP + MG + 8 * h) + 32 * (2 * ca - lam_lo);
            bf16x8 a0 = *(const LAS bf16x8*)ap, b0 = *(const LAS bf16x8*)bp, a1 = *(const LAS bf16x8*)(ap - 32), b1 = *(const LAS bf16x8*)(bp - 32);
            for (int lam = lam_lo; lam <= lam_hi; lam += 2) {
                const bool more = lam + 2 <= lam_hi;
                if (more) { ap -= 64; bp -= 64; }
                const bf16x8 na0 = *(const LAS bf16x8*)ap, na1 = *(const LAS bf16x8*)(ap - 32), nb0 = *(const LAS bf16x8*)bp, nb1 = *(const LAS bf16x8*)(bp - 32);
                acc = __builtin_amdgcn_mfma_f32_32x32x16_bf16(a0, b0, acc, 0, 0, 0);
                acc1 = __builtin_amdgcn_mfma_f32_32x32x16_bf16(a1, b1, acc1, 0, 0, 0);
                a0 = na0; a1 = na1; b0 = nb0; b1 = nb1;
            }
#pragma unroll
            for (int i = 0; i < 16; ++i) acc[i] += acc1[i];
        }
#if defined(PROBE_HY) && PROBE_HY == 3
        asm volatile("" :: "v"(acc[0]), "v"(acc[5]));
        }
#endif
        const float bias = a.in[27][((size_t)l * 2 + n) * 512 + c];
        float z[16];
        if (wave < NW) {
#pragma unroll
            for (int g4 = 0; g4 < 4; ++g4) { const int t0 = 32 * ca + 8 * g4 + 4 * h;
                const v2u uw = *(const LAS v2u*)(U + cbat * UP + MG + t0), xw = *(const LAS v2u*)(X + cbat * L + t0);
                const float uv[4] = {bflo(uw.x), bfhi(uw.x), bflo(uw.y), bfhi(uw.y)}, xv[4] = {bflo(xw.x), bfhi(xw.x), bflo(xw.y), bfhi(xw.y)};
#pragma unroll
                for (int k = 0; k < 4; ++k) z[4 * g4 + k] = xv[k] * (acc[4 * g4 + k] + bias * uv[k]); }
        }
        __syncthreads();
        if (n == 0) {
            if (wave < NW) {
#pragma unroll
                for (int g4 = 0; g4 < 4; ++g4) *(LAS v2u*)(U + cbat * UP + MG + 32 * ca + 8 * g4 + 4 * h) = (v2u){pk2(z[4 * g4], z[4 * g4 + 1]), pk2(z[4 * g4 + 2], z[4 * g4 + 3])}; }
#pragma unroll
            for (int i = 0; i < NQ; ++i) { const int q = tid + 512 * i, b = q / (L / 8), off = (q % (L / 8)) * 8; *(LAS v4u*)(X + b * L + off) = x2r[i]; }
        } else if (wave < NW) {
#if defined(PROBE_HY) && PROBE_HY == 2
            for (int rep = 0; rep < 2; ++rep)
#endif
#pragma unroll
            for (int g4 = 0; g4 < 4; ++g4)
#pragma unroll
                for (int k = 0; k < 4; ++k) OC[(size_t)(rowbase + 32 * ca + 8 * g4 + 4 * h + k) * 512 + c] = (bf16)f2bf(z[4 * g4 + k]);
        }
    }
    __syncthreads();
}
#ifndef PHMASK
#define PHMASK 0x1fff
#endif
#define PH_ON(k) (((PHMASK) >> (k)) & 1)
#define L1_INV() do { asm volatile("s_waitcnt vmcnt(0)" ::: "memory"); __builtin_amdgcn_fence(__ATOMIC_ACQUIRE, "agent"); asm volatile("s_waitcnt vmcnt(0)" ::: "memory"); __syncthreads(); } while (0)
template <class T> __device__ __forceinline__ T* asglobal(T* p) { return (T*)(GAS T*)p; }
__global__ void __launch_bounds__(512, 2) mega_fwd(Args a) {
    extern __shared__ __attribute__((aligned(16))) unsigned char lds_raw[];
    LAS unsigned char* lds = (LAS unsigned char*)lds_raw;
    cg::grid_group grid = cg::this_grid();
    const int bid = blockIdx.x;
    using pg8::Gemm; using pg8::StaticOrder;
    const int ph_lo = a.ph_lo, ph_hi = a.ph_hi;
    volatile LAS unsigned* MISC = (volatile LAS unsigned*)(lds + LDS_BYTES - 64);
    if (threadIdx.x < 16) MISC[threadIdx.x] = 0u;
    __syncthreads();
    if (ph_hi > NPHASE) { __syncthreads(); grid.sync(); }
    XcdBarrier bar = xcd_barrier_post((unsigned*)(a.ws + WS_BAR + (size_t)a.li * BAR_REGION), MISC);
#pragma unroll 1
    for (int ph = ph_lo; ph < ph_hi; ++ph) {
        int tid = threadIdx.x; asm volatile("" : "+v"(tid));
        int G = gridDim.x; asm volatile("" : "+s"(G)); const int NGW = G * 8, NGT = G * 512;
        unsigned char* ws = a.ws; asm volatile("" : "+s"(ws));
#if defined(__HIP_DEVICE_COMPILE__)
#define ASSUME_GLOBAL(p) __builtin_assume(!__builtin_amdgcn_is_shared((const void*)(p)) && !__builtin_amdgcn_is_private((const void*)(p)))
#else
#define ASSUME_GLOBAL(p) ((void)0)
#endif
        ASSUME_GLOBAL(ws); ASSUME_GLOBAL(a.ws); ASSUME_GLOBAL(a.out);
#pragma unroll
        for (int i = 0; i < 35; ++i) ASSUME_GLOBAL(a.in[i]);
        const int lane = tid & 63, wave = __builtin_amdgcn_readfirstlane(tid >> 6), gw = bid * 8 + wave, gt = bid * 512 + tid;
        const int l = (ph >= 1 && ph < 23) ? (ph - 1) / 11 : 0, sub = (ph >= 1 && ph < 23) ? (ph - 1) % 11 : -1;
        float* mod = (float*)(ws + WS_MOD) + (size_t)l * 5 * 6144;
        if (PH_ON(11) && ph == 0) { p0_mod_hid(a, lds, bid, G, tid, gw, NGW, lane); wconv_phase(a, 0, 0, lds, gw, NGW, gt, NGT, wave, lane); }
        else if (PH_ON(12) && ph == 23) { norm_phase(a, 0, 2, false, gw, NGW, lane); }
        else if (PH_ON(0) && sub == 0) { if (l == 1) wconv_phase(a, 1, (G == 256) ? 2 : 0, lds, gw, NGW, gt, NGT, wave, lane);     norm_phase(a, l, 0, l == 0, gw, NGW, lane); }
        else if (PH_ON(1) && sub == 1) {
            Gemm g{(const bf16*)(ws + WS_HBF1), (const bf16*)(ws + WS_WIN), TT, 4096, 1024, 1024, 1024}; StaticOrder S; S.init(TT, 4096, G, bid);
            pg8::EpiSeg E{(bf16*)(ws + WS_QA), (bf16*)(ws + WS_KVR), (bf16*)(ws + WS_CQ), (bf16*)(ws + WS_CKVR), (bf16*)(ws + WS_HYR), (bf16*)(ws + WS_S0)};
            pg8::gemm_phase<pg8::EpiSeg, StaticOrder, true, true>(lds, g, S, E);
        }
        else if (PH_ON(2) && sub == 2) { post_phase(a, l, lds, bid, G, tid, gw, NGW, gt, NGT, lane); }
        else if (PH_ON(3) && sub == 3) {
#pragma unroll 1
            for (int q = 0; q < 3; ++q) {
                Gemm g; StaticOrder S; pg8::EpiStore<0> E;
                if (q == 0) { g = Gemm{(const bf16*)(ws + WS_CQ), (const bf16*)(ws + WS_WUQ), TT, 768, 384, 512, 384}; S.init(TT, 768, G, bid); E = pg8::EpiStore<0>{(bf16*)(ws + WS_QB), 768}; }
                else if (q == 1) { g = Gemm{(const bf16*)(ws + WS_CKVALL), (const bf16*)(ws + WS_WKN), NKEYROWS, 512, 256, 256, 256}; S.init(NKEYROWS, 512, G, (bid + G - 144 % G) % G); E = pg8::EpiStore<0>{(bf16*)(ws + WS_KNB), 512}; }
                else { g = Gemm{(const bf16*)(ws + WS_WVV), (const bf16*)(ws + WS_CKVALL), 512, NKEYROWS, 256, 256, 256}; S.init(512, NKEYROWS, G, (bid + G - 248 % G) % G); E = pg8::EpiStore<0>{(bf16*)(ws + WS_VTB), NKEYROWS}; }
                pg8::gemm_phase<pg8::EpiStore<0>, StaticOrder, true, true>(lds, g, S, E);
            }
        }
        else if (PH_ON(4) && sub == 4) {
            const bf16 *QA = (const bf16*)(ws + WS_QA), *QB = (const bf16*)(ws + WS_QB), *KA = (const bf16*)(ws + WS_KA), *VTA = (const bf16*)(ws + WS_VTA);
            const bf16 *KNB = (const bf16*)(ws + WS_KNB), *VTB = (const bf16*)(ws + WS_VTB), *KPE = (const bf16*)(ws + WS_KPEALL);
            bf16 *OA = (bf16*)(ws + WS_OA), *OB = (bf16*)(ws + WS_OB);
            const float slA = 0.125f * 1.4426950408889634f, slB = 0.10206207261596575f * 1.4426950408889634f;
            const int sel = a.pad;
            for (int it = bid; it < 1792; it += G) {
                { const bool is_hy = (it >= 512 && it < 1024) || it >= 1280; if ((sel == 1 && is_hy) || (sel == 2 && !is_hy)) continue; }
                if (it < 256 || (it >= 1024 && it < 1152)) {
                    const bool lat = it < 256; const int u = lat ? (G == 256 ? ((bid & 7) * 4 + (bid >> 6)) * 8 + ((bid >> 3) & 7) : it) : it - 1024;
                    const int b = lat ? u >> 6 : u >> 3, hh = lat ? (u >> 3) & 7 : u & 7, qb = lat ? u & 7 : 0;
                    const int row0 = lat ? TCTX + b * 2048 + qb * 256 : b * 256, key0 = lat ? TCTX + b * 2304 : b * 256;
                    attn_unit<96>(lds, tid, QB + (size_t)row0 * 768 + hh * 96, 768, KNB + (size_t)key0 * 512 + hh * 64, 512, KPE + (size_t)key0 * 32, VTB + (size_t)(hh * 64) * NKEYROWS + key0, NKEYROWS,
                                  lat ? 2304 : 256, OB + (size_t)row0 * 512 + hh * 64, 512, slB, lat, qb * 256);
                } else if (it < 512 || (it >= 1152 && it < 1280)) {
                    const bool lat = it < 512; const int u = lat ? (G == 256 ? ((bid & 7) * 4 + (bid >> 6)) * 8 + ((bid >> 3) & 7) : it - 256) : it - 1152;
                    const int b = lat ? u >> 6 : u >> 3, hh = lat ? (u >> 3) & 7 : u & 7, qb = lat ? u & 7 : 0, kvh = hh >> 2;
                    const int row0 = lat ? TCTX + b * 2048 + qb * 256 : b * 256, nk = lat ? 2304 : 256;
                    const size_t kbase = lat ? (size_t)KA_LAT + (size_t)(b * 2 + kvh) * 2304 * 64 : (size_t)(b * 2 + kvh) * 256 * 64;
                    attn_unit<64>(lds, tid, QA + (size_t)row0 * 512 + hh * 64, 512, KA + kbase, 64, nullptr, VTA + kbase, nk, nk, OA + (size_t)row0 * 512 + hh * 64, 512, slA, false, 0);
                } else if (it < 1024) { hyena_unit<true>(a, l, it - 512, lds, tid); }
                else { hyena_unit<false>(a, l, it - 1280, lds, tid); }
            }
        }
        else if (PH_ON(5) && sub == 5) {
            static_assert(WS_S1 + 121 * MiB == WS_S0 && WS_S2 + 97 * MiB == WS_S0, "gate buffer arithmetic");
            bf16 *S0 = (bf16*)(ws + WS_S0), *MBF = (bf16*)(ws + WS_MBF);
            { Gemm g{(const bf16*)(ws + WS_HBF1), (const bf16*)(ws + WS_WG), TT, 2048, 1024, 1024, 1024}; StaticOrder S; S.init(TT, 2048, G, bid);
              pg8::EpiGate E{S0}; pg8::gemm_phase<pg8::EpiGate, StaticOrder, true, true>(lds, g, S, E); }
            xcd_barrier(bar);
            { Gemm g{(const bf16*)(ws + WS_OA), (const bf16*)(ws + WS_WB), TT, 1024, 512, 512, 512, (size_t)TT * 512 * 2, (size_t)1024 * 512 * 2};
              pg8::BatchOrder<3> S; S.init(TT, 1024, G, bid);
              pg8::EpiMerge E{S0, MBF}; pg8::gemm_phase<pg8::EpiMerge, pg8::BatchOrder<3>, true, true>(lds, g, S, E); }
        }
        else if (PH_ON(6) && sub == 6) {
            Gemm g{(const bf16*)(ws + WS_MBF), (const bf16*)(ws + WS_WO), TT, 1024, 1024, 1024, 1024}; StaticOrder S; S.init(TT, 1024, G, bid);
            pg8::EpiResid E{a.out, mod + 2048}; pg8::gemm_phase<pg8::EpiResid, StaticOrder, true, true>(lds, g, S, E);
        }
        else if (PH_ON(7) && sub == 7) { norm_phase(a, l, 1, false, gw, NGW, lane); }
        else if (PH_ON(8) && sub == 8) {
            Gemm g{(const bf16*)(ws + WS_HBF), (const bf16*)(ws + WS_WUP), TT, 5632, 1024, 1024, 1024}; StaticOrder S; S.init(TT, 5632, G, bid);
            pg8::EpiStore<0> E{(bf16*)(ws + WS_U), 5632}; pg8::gemm_phase<pg8::EpiStore<0>, StaticOrder, true, true>(lds, g, S, E);
        }
        else if (PH_ON(9) && sub == 9) { ffnconv_phase(a, l, gt, NGT); }
        else if (PH_ON(10) && sub == 10) {
            Gemm g{(const bf16*)(ws + WS_ACT), (const bf16*)(ws + WS_WDN), TT, 1024, 2816, 2816, 2816}; StaticOrder S; S.init(TT, 1024, G, bid);
            pg8::EpiResid E{a.out, mod + 5120}; pg8::gemm_phase<pg8::EpiResid, StaticOrder, true, true>(lds, g, S, E);
            if (l == 0 && G == 256 && bid >= 192)
                wconv_phase(a, 1, 1, lds, (bid - 192) * 8 + wave, 64 * 8, (bid - 192) * 512 + tid, 64 * 512, wave, lane);
        }
#ifdef EXTRA_SYNCS
        for (int q = 0; q < EXTRA_SYNCS; ++q) { __syncthreads(); grid.sync(); }
#endif
        if (ph + 1 < ph_hi) xcd_barrier(bar);
    }
}

extern "C" void kernel_launch(void* const* d_in, const int* in_sizes, int n_in, void* d_out, int out_size, void* d_ws, size_t ws_size, hipStream_t stream) {
    static int grid = 0;
    if (grid == 0) {
        if (n_in != 35 || ws_size < WS_END) { fprintf(stderr, "kernel_launch: unexpected n_in %d / ws %zu\n", n_in, ws_size); grid = -1; return; }
        int dev = 0, cus = 0, per_cu = 0;
        if (hipGetDevice(&dev) != hipSuccess || hipDeviceGetAttribute(&cus, hipDeviceAttributeMultiprocessorCount, dev) != hipSuccess) { grid = -1; return; }
        if (hipFuncSetAttribute((const void*)mega_fwd, hipFuncAttributeMaxDynamicSharedMemorySize, LDS_BYTES) != hipSuccess) { fprintf(stderr, "kernel_launch: hipFuncSetAttribute failed\n"); grid = -1; return; }
        if (hipOccupancyMaxActiveBlocksPerMultiprocessor(&per_cu, (const void*)mega_fwd, 512, LDS_BYTES) != hipSuccess || per_cu < 1) { fprintf(stderr, "kernel_launch: occupancy query says %d\n", per_cu); per_cu = 1; }
        (void)hipGetLastError();
        grid = cus;
    }
    if (grid < 0) return;
    if (hipMemsetAsync((char*)d_ws + WS_MOD, 0, ZERO_BYTES, stream) != hipSuccess) { fprintf(stderr, "kernel_launch: memset failed\n"); return; }
    Args a{};
    for (int i = 0; i < 35; ++i) a.in[i] = (const float*)d_in[i];
    a.out = (float*)d_out; a.ws = (unsigned char*)d_ws;
#if defined(MK_PER_PHASE)
    for (int p = 0; p < NPHASE; ++p) { a.ph_lo = p; a.ph_hi = p + 1; a.li = 0; void* args[] = {&a};
        hipError_t e = hipLaunchCooperativeKernel((const void*)mega_fwd, dim3(grid), dim3(512), args, LDS_BYTES, stream);
        if (e != hipSuccess) { fprintf(stderr, "launch %d failed: %s\n", p, hipGetErrorString(e)); break; } }
#else
#if defined(PROBE_SUB)
#ifndef PROBE_SEL
#define PROBE_SEL 0
#endif
    { const int k0 = 1 + PROBE_SUB, k1 = 12 + PROBE_SUB; const int cuts[6][2] = {{0, k0 + 1}, {k0, k0 + 1}, {k0 + 1, k1 + 1}, {k1, k1 + 1}, {k1 + 1, NPHASE}, {0, 0}};
      for (int c = 0; c < 5; ++c) { a.ph_lo = cuts[c][0]; a.ph_hi = cuts[c][1]; a.li = c; a.pad = (c == 1 || c == 3) ? PROBE_SEL : 0; if (a.ph_lo >= a.ph_hi) continue; void* args[] = {&a};
          hipError_t e = hipLaunchCooperativeKernel((const void*)mega_fwd, dim3(grid), dim3(512), args, LDS_BYTES, stream);
          if (e != hipSuccess) { fprintf(stderr, "cooperative launch failed: %s\n", hipGetErrorString(e)); break; } } }
#elif defined(PROBE_CUTS)
    { const int k0 = 1 + PROBE_CUTS, k1 = 12 + PROBE_CUTS; const int cuts[4][2] = {{0, k0 + 1}, {k0 + 1, k1 + 1}, {k1 + 1, NPHASE}, {0, 0}};
      for (int c = 0; c < 3; ++c) { a.ph_lo = cuts[c][0]; a.ph_hi = cuts[c][1]; a.li = c; if (a.ph_lo >= a.ph_hi) continue; void* args[] = {&a};
          hipError_t e = hipLaunchCooperativeKernel((const void*)mega_fwd, dim3(grid), dim3(512), args, LDS_BYTES, stream);
          if (e != hipSuccess) { fprintf(stderr, "cooperative launch failed: %s\n", hipGetErrorString(e)); break; } } }
#else
    a.ph_lo = 0; a.ph_hi = NPHASE; void* args[] = {&a};
    hipError_t e = hipLaunchCooperativeKernel((const void*)mega_fwd, dim3(grid), dim3(512), args, LDS_BYTES, stream);
    if (e != hipSuccess) fprintf(stderr, "cooperative launch failed: %s (grid %d)\n", hipGetErrorString(e), grid);
#endif
#endif
}
```

```cpp
#include <hip/hip_runtime.h>
#include <hip/hip_cooperative_groups.h>
#include <cstdio>
#include <cstdint>
namespace cg = cooperative_groups;
namespace pg8 {
#define PG8_LAS __attribute__((address_space(3)))
typedef unsigned short bf16_t;
typedef short bf16x8 __attribute__((ext_vector_type(8)));
typedef float f32x4 __attribute__((ext_vector_type(4)));
typedef unsigned u32x4 __attribute__((ext_vector_type(4)));
constexpr int BM = 256, BK = 64, HALF = 128, HTB = HALF * BK * 2  , STAGE_BYTES = 8 * HTB, NXCD = 8, WGM = 8;

__host__ __device__ __forceinline__ int lds_byte(int r, int c) { const int st = (r >> 4) * 2 + (c >> 5), rr = r & 15, cc = c & 31, ob = rr * 64 + cc * 2; return st * 1024 + (ob ^ (((ob >> 9) & 1) << 5)); }
__host__ __device__ __forceinline__ void stage_rc(int b, int& R, int& C) { const int st = b / 1024, sb = b % 1024, swz = sb ^ (((sb >> 9) & 1) << 5); R = (st >> 1) * 16 + swz / 64; C = (st & 1) * 32 + (swz % 64) / 2; }
__host__ __device__ __forceinline__ int perm32(int rho) { const int n = rho >> 4, i = rho & 15; return 8 * (i >> 2) + 4 * n + (i & 3); }

struct Unit { int pm, pn, gi; };
struct Gemm { const bf16_t* A; const bf16_t* Bt; int M, N, K, lda, ldb; size_t gsA, gsB; };

struct StaticOrder {
    int nM, nN, nwg, G, c;
    __host__ __device__ void init(int M, int N, int G_, int c_) { nM = M / BM; nN = N / BM; nwg = nM * nN; G = G_; c = c_; }
    __host__ __device__ bool next(int i, Unit& u) const {
        const long L = (long)i * G + c; if (L >= nwg) return false;
        int wgid = (int)L; { const int q = nwg / NXCD, r = nwg % NXCD, xcd = wgid % NXCD, off = wgid / NXCD; wgid = (xcd < r ? xcd * (q + 1) : r * (q + 1) + (xcd - r) * q) + off; }
        const int nig = WGM * nN, gid = wgid / nig, fm = gid * WGM, gsz = (nM - fm) < WGM ? (nM - fm) : WGM;
        u.pm = fm + ((wgid % nig) % gsz); u.pn = (wgid % nig) / gsz; u.gi = 0; return true;
    }
    __device__ __forceinline__ void a_ready(const Unit&) const {}
    __device__ __forceinline__ void done(const Unit&) const {}
};
template <int N0, int N1, int NN0, int NN1> struct PairOrder {
    int G, c;
    __host__ __device__ bool next(int i, Unit& u) const { const int L = i * G + c; if (L >= N0 + N1) return false;
        if (L < N0) { u.pm = L / NN0; u.pn = L % NN0; u.gi = 0; } else { const int q = L - N0; u.pm = q / NN1; u.pn = q % NN1; u.gi = 1; } return true; }
    __device__ __forceinline__ void a_ready(const Unit&) const {}
    __device__ __forceinline__ void done(const Unit&) const {}
};
template <int NB> struct BatchOrder : StaticOrder {
    __host__ __device__ bool next(int i, Unit& u) const { if (i >= NB) return false; if (!StaticOrder::next(0, u)) return false; u.gi = i; return true; }
};


#ifndef GAS
#define GAS __attribute__((address_space(1)))
#endif
typedef float f32x2v __attribute__((ext_vector_type(2)));
typedef __bf16 bf16x2v __attribute__((ext_vector_type(2)));
__device__ __forceinline__ unsigned cvt_pk_bf16(float lo, float hi) { const f32x2v v = {lo, hi}; const bf16x2v b = __builtin_convertvector(v, bf16x2v); return __builtin_bit_cast(unsigned, b); }
__device__ __forceinline__ float sigm(float x) { return __builtin_amdgcn_rcpf(1.f + __expf(-x)); }
#define EPI_FOR _Pragma("unroll") for (int ai = 0; ai < 2; ++ai) _Pragma("unroll") for (int m = 0; m < 4; ++m) _Pragma("unroll") for (int bj = 0; bj < 2; ++bj)

template <int ACT  > struct EpiStore {
    static constexpr bool PERM = true, AFTER_DRAIN = false;
    bf16_t* O; int ld;
    __device__ __forceinline__ void operator()(const f32x4 (&acc)[2][2][4][2], const Unit& u, int wr, int wc, int fr, int fq) const {
        const int row0 = u.pm * BM + wr * 64 + fr, col0 = u.pn * BM + wc * 32 + 8 * fq;
        EPI_FOR { f32x4 v0 = acc[ai][bj][m][0], v1 = acc[ai][bj][m][1];
            if (ACT == 1) { v0 = (f32x4){sigm(v0[0]), sigm(v0[1]), sigm(v0[2]), sigm(v0[3])}; v1 = (f32x4){sigm(v1[0]), sigm(v1[1]), sigm(v1[2]), sigm(v1[3])}; }
            u32x4 w; w.x = cvt_pk_bf16(v0[0], v0[1]); w.y = cvt_pk_bf16(v0[2], v0[3]); w.z = cvt_pk_bf16(v1[0], v1[1]); w.w = cvt_pk_bf16(v1[2], v1[3]);
            *(GAS u32x4*)(O + (size_t)(row0 + ai * HALF + m * 16) * ld + col0 + bj * HALF) = w; }
    }
};
struct EpiPair {
    static constexpr bool PERM = true, AFTER_DRAIN = false;
    bf16_t *O0, *O1; int ld0, ld1;
    __device__ __forceinline__ void operator()(const f32x4 (&acc)[2][2][4][2], const Unit& u, int wr, int wc, int fr, int fq) const {
        bf16_t* O = u.gi ? O1 : O0; const int ld = u.gi ? ld1 : ld0;
        const int row0 = u.pm * BM + wr * 64 + fr, col0 = u.pn * BM + wc * 32 + 8 * fq;
        EPI_FOR { const f32x4 v0 = acc[ai][bj][m][0], v1 = acc[ai][bj][m][1];
            u32x4 w; w.x = cvt_pk_bf16(v0[0], v0[1]); w.y = cvt_pk_bf16(v0[2], v0[3]); w.z = cvt_pk_bf16(v1[0], v1[1]); w.w = cvt_pk_bf16(v1[2], v1[3]);
            *(GAS u32x4*)(O + (size_t)(row0 + ai * HALF + m * 16) * ld + col0 + bj * HALF) = w; }
    }
};
struct EpiSeg {
    static constexpr bool PERM = true, AFTER_DRAIN = false;
    bf16_t *QA, *KV, *CQ, *CKV, *HY, *S0;
    __device__ __forceinline__ void operator()(const f32x4 (&acc)[2][2][4][2], const Unit& u, int wr, int wc, int fr, int fq) const {
        bf16_t* base; int ld, coff; const int pn = u.pn;
        if (pn < 2) { base = QA; ld = 512; coff = 256 * pn; } else if (pn == 2) { base = KV; ld = 256; coff = 0; } else if (pn < 5) { base = CQ; ld = 512; coff = 256 * (pn - 3); }
        else if (pn == 5) { base = CKV; ld = 256; coff = 0; } else if (pn < 12) { base = HY; ld = 1536; coff = 256 * (pn - 6); } else { base = S0; ld = 1024; coff = 256 * (pn - 12); }
        const bool gate = pn >= 12;
        const int row0 = u.pm * BM + wr * 64 + fr, col0 = coff + wc * 32 + 8 * fq;
        EPI_FOR { f32x4 v0 = acc[ai][bj][m][0], v1 = acc[ai][bj][m][1];
            if (gate) { v0 = (f32x4){sigm(v0[0]), sigm(v0[1]), sigm(v0[2]), sigm(v0[3])}; v1 = (f32x4){sigm(v1[0]), sigm(v1[1]), sigm(v1[2]), sigm(v1[3])}; }
            u32x4 w; w.x = cvt_pk_bf16(v0[0], v0[1]); w.y = cvt_pk_bf16(v0[2], v0[3]); w.z = cvt_pk_bf16(v1[0], v1[1]); w.w = cvt_pk_bf16(v1[2], v1[3]);
            *(GAS u32x4*)(base + (size_t)(row0 + ai * HALF + m * 16) * ld + col0 + bj * HALF) = w; }
    }
};
struct EpiGate {
    static constexpr bool PERM = true, AFTER_DRAIN = false;
    bf16_t* S0;
    __device__ __forceinline__ void operator()(const f32x4 (&acc)[2][2][4][2], const Unit& u, int wr, int wc, int fr, int fq) const {
        const int n = 1 + (u.pn >> 2); bf16_t* base = (bf16_t*)((unsigned char*)S0 - (size_t)((n + 1) >> 1) * (121u << 20) + (size_t)(n >> 1) * (24u << 20));
        const int row0 = u.pm * BM + wr * 64 + fr, col0 = (u.pn & 3) * BM + wc * 32 + 8 * fq;
        EPI_FOR { f32x4 v0 = acc[ai][bj][m][0], v1 = acc[ai][bj][m][1];
            v0 = (f32x4){sigm(v0[0]), sigm(v0[1]), sigm(v0[2]), sigm(v0[3])}; v1 = (f32x4){sigm(v1[0]), sigm(v1[1]), sigm(v1[2]), sigm(v1[3])};
            u32x4 w; w.x = cvt_pk_bf16(v0[0], v0[1]); w.y = cvt_pk_bf16(v0[2], v0[3]); w.z = cvt_pk_bf16(v1[0], v1[1]); w.w = cvt_pk_bf16(v1[2], v1[3]);
            *(GAS u32x4*)(base + (size_t)(row0 + ai * HALF + m * 16) * 1024 + col0 + bj * HALF) = w; }
    }
};
struct EpiMerge {
    static constexpr bool PERM = true, AFTER_DRAIN = false;
    const bf16_t* S0; bf16_t* M;
    __device__ __forceinline__ void operator()(const f32x4 (&acc)[2][2][4][2], const Unit& u, int wr, int wc, int fr, int fq) const {
        const int row0 = u.pm * BM + wr * 64 + fr, col0 = u.pn * BM + wc * 32 + 8 * fq;
        const int MODE = u.gi; const bf16_t* S = (const bf16_t*)((const unsigned char*)S0 - (size_t)((u.gi + 1) >> 1) * (121u << 20) + (size_t)(u.gi >> 1) * (24u << 20));
        EPI_FOR { const size_t off = (size_t)(row0 + ai * HALF + m * 16) * 1024 + col0 + bj * HALF;
            const u32x4 sw = *(const GAS u32x4*)(S + off);
            f32x4 s0 = (f32x4){__uint_as_float(sw.x << 16), __uint_as_float(sw.x & 0xffff0000u), __uint_as_float(sw.y << 16), __uint_as_float(sw.y & 0xffff0000u)};
            f32x4 s1 = (f32x4){__uint_as_float(sw.z << 16), __uint_as_float(sw.z & 0xffff0000u), __uint_as_float(sw.w << 16), __uint_as_float(sw.w & 0xffff0000u)};
            f32x4 v0 = acc[ai][bj][m][0] * s0, v1 = acc[ai][bj][m][1] * s1;
            if (MODE >= 1) { const u32x4 mw = *(const GAS u32x4*)(M + off);
                v0 = v0 + (f32x4){__uint_as_float(mw.x << 16), __uint_as_float(mw.x & 0xffff0000u), __uint_as_float(mw.y << 16), __uint_as_float(mw.y & 0xffff0000u)};
                v1 = v1 + (f32x4){__uint_as_float(mw.z << 16), __uint_as_float(mw.z & 0xffff0000u), __uint_as_float(mw.w << 16), __uint_as_float(mw.w & 0xffff0000u)}; }
            u32x4 w; w.x = cvt_pk_bf16(v0[0], v0[1]); w.y = cvt_pk_bf16(v0[2], v0[3]); w.z = cvt_pk_bf16(v1[0], v1[1]); w.w = cvt_pk_bf16(v1[2], v1[3]); *(GAS u32x4*)(M + off) = w; }
    }
};
struct EpiResid {
    static constexpr bool PERM = true, AFTER_DRAIN = false;
    float* X; const float* gate;
    __device__ __forceinline__ void operator()(const f32x4 (&acc)[2][2][4][2], const Unit& u, int wr, int wc, int fr, int fq) const {
        const int row0 = u.pm * BM + wr * 64 + fr, col0 = u.pn * BM + wc * 32 + 8 * fq;
        const int mrow = (u.pm < 16) ? 0 : 1 + ((u.pm - 16) >> 3);
        const float* gp = gate + (size_t)mrow * 6144 + col0;
        f32x4 g[2][2];
#pragma unroll
        for (int bj = 0; bj < 2; ++bj) { g[bj][0] = *(const GAS f32x4*)(gp + bj * HALF); g[bj][1] = *(const GAS f32x4*)(gp + bj * HALF + 4); }
        EPI_FOR { float* xp = X + (size_t)(row0 + ai * HALF + m * 16) * 1024 + col0 + bj * HALF;
            const f32x4 x0 = *(const GAS f32x4*)xp, x1 = *(const GAS f32x4*)(xp + 4);
            *(GAS f32x4*)xp = x0 + g[bj][0] * acc[ai][bj][m][0]; *(GAS f32x4*)(xp + 4) = x1 + g[bj][1] * acc[ai][bj][m][1]; }
    }
};

template <class Epi, class Sched, bool ALIGN_EPI = false, bool SP2 = false>
__device__ __forceinline__ void gemm_phase(PG8_LAS unsigned char* lds, const Gemm g, const Sched& S, const Epi& E) {
    int tid_l = threadIdx.x; asm volatile("" : "+v"(tid_l));
    const int tid = tid_l, wid = __builtin_amdgcn_readfirstlane(tid >> 6), lane = tid & 63, wr = wid >> 2, wc = wid & 3, fr = lane & 15, fq = lane >> 4;
    const int K = g.K, nt = K / BK;
    unsigned voffA[2], voffB[2];
#pragma unroll
    for (int i = 0; i < 2; ++i) { int R, C; stage_rc(tid * 16 + i * 8192, R, C); const int Rb = Epi::PERM ? ((R & ~31) + perm32(R & 31)) : R;
        voffA[i] = (unsigned)(R * g.lda + C) * 2u; voffB[i] = (unsigned)(Rb * g.ldb + C) * 2u; }
    const size_t kstep = (size_t)(BK * 2);
    const size_t hstepA = (size_t)HALF * g.lda * 2, hstepB = (size_t)HALF * g.ldb * 2;
    const size_t tstepA = 2 * hstepA, tstepB = 2 * hstepB;
    const unsigned ldsw = (unsigned)wid * 1024u;
    const int aoff = lds_byte(wr * 64 + fr, fq * 8), boff = lds_byte(wc * 32 + fr, fq * 8);
#define PG8_SA(b, h) (((b) * 2 + (h)) * HTB)
#define PG8_SB(b, h) ((4 + (b) * 2 + (h)) * HTB)
#define PG8_STAGE(bufoff, gbase, voff) do { _Pragma("unroll") for (int _i = 0; _i < 2; ++_i) \
        __builtin_amdgcn_global_load_lds((const unsigned*)((const char*)(gbase) + (voff)[_i]), (PG8_LAS unsigned*)(lds + (bufoff) + ldsw + _i * 8192), 16, 0, 0); } while (0)
#define PG8_LDA(dst, b, h) do { _Pragma("unroll") for (int m = 0; m < 4; ++m) _Pragma("unroll") for (int k = 0; k < 2; ++k) dst[m][k] = *(const PG8_LAS bf16x8*)(lds + PG8_SA(b, h) + aoff + m * 2048 + k * 1024); } while (0)
#define PG8_LDB(dst, b, h) do { _Pragma("unroll") for (int n = 0; n < 2; ++n) _Pragma("unroll") for (int k = 0; k < 2; ++k) dst[n][k] = *(const PG8_LAS bf16x8*)(lds + PG8_SB(b, h) + boff + n * 2048 + k * 1024); } while (0)
#define PG8_MMA(ai, bj, At, Bt) do { __builtin_amdgcn_s_setprio(1); _Pragma("unroll") for (int m = 0; m < 4; ++m) _Pragma("unroll") for (int n = 0; n < 2; ++n) _Pragma("unroll") for (int k = 0; k < 2; ++k) \
        acc[ai][bj][m][n] = __builtin_amdgcn_mfma_f32_16x16x32_bf16(Bt[n][k], At[m][k], acc[ai][bj][m][n], 0, 0, 0); __builtin_amdgcn_s_setprio(0); } while (0)
#define PG8_WAIT_V(n) asm volatile("s_waitcnt vmcnt(" #n ")" ::: "memory")
#define PG8_WAIT_L(n) asm volatile("s_waitcnt lgkmcnt(" #n ")" ::: "memory")
#define PG8_BAR __builtin_amdgcn_s_barrier()
#define PG8_SCHED __builtin_amdgcn_sched_barrier(0)
    Unit cur, nxt; int ui = 0;
    if (!S.next(0, cur)) return;
    f32x4 acc[2][2][4][2];
#pragma unroll
    for (int a = 0; a < 2; ++a)
#pragma unroll
        for (int b = 0; b < 2; ++b)
#pragma unroll
            for (int m = 0; m < 4; ++m)
#pragma unroll
                for (int n = 0; n < 2; ++n) acc[a][b][m][n] = (f32x4){0.f, 0.f, 0.f, 0.f};
    bf16x8 At[4][2], B0[2][2], B1[2][2];
    const char* cA = (const char*)g.A + (size_t)cur.gi * g.gsA + (size_t)cur.pm * tstepA; const char* cB = (const char*)g.Bt + (size_t)cur.gi * g.gsB + (size_t)cur.pn * tstepB;
    S.a_ready(cur);
    if constexpr (SP2) {
        PG8_STAGE(PG8_SB(0, 0), cB, voffB); PG8_STAGE(PG8_SB(0, 1), cB + hstepB, voffB); PG8_STAGE(PG8_SA(0, 0), cA, voffA); PG8_STAGE(PG8_SA(0, 1), cA + hstepA, voffA);
        if (wr == 1) PG8_BAR;
        PG8_WAIT_V(2); PG8_BAR;
        PG8_STAGE(PG8_SB(1, 0), cB + kstep, voffB); PG8_STAGE(PG8_SA(1, 0), cA + kstep, voffA); PG8_STAGE(PG8_SB(1, 1), cB + hstepB + kstep, voffB);
        PG8_WAIT_V(6); PG8_BAR;
    } else {
        PG8_STAGE(PG8_SB(0, 0), cB, voffB); PG8_STAGE(PG8_SA(0, 0), cA, voffA); PG8_STAGE(PG8_SB(0, 1), cB + hstepB, voffB); PG8_STAGE(PG8_SA(0, 1), cA + hstepA, voffA);
        if (wr == 1) PG8_BAR;
        PG8_WAIT_V(4); PG8_BAR;
        PG8_STAGE(PG8_SB(1, 0), cB + kstep, voffB); PG8_STAGE(PG8_SA(1, 0), cA + kstep, voffA); PG8_STAGE(PG8_SB(1, 1), cB + hstepB + kstep, voffB);
        PG8_WAIT_V(6); PG8_BAR;
    }
    for (;;) {
        const bool has_next = S.next(ui + 1, nxt);
        const char* nA = has_next ? (const char*)g.A + (size_t)nxt.gi * g.gsA + (size_t)nxt.pm * tstepA : cA; const char* nB = has_next ? (const char*)g.Bt + (size_t)nxt.gi * g.gsB + (size_t)nxt.pn * tstepB : cB;
        for (int t = 0; t < nt; t += 2) {
            const bool last = (t == nt - 2);
            const char* a1 = cA + (size_t)(t + 1) * kstep;
            const char* a2 = last ? nA : cA + (size_t)(t + 2) * kstep; const char* b2 = last ? nB : cB + (size_t)(t + 2) * kstep;
            const char* a3 = a2 + kstep; const char* b3 = b2 + kstep;
            if (last && has_next) S.a_ready(nxt);
            if constexpr (SP2) {
            PG8_LDB(B0, 0, 0); PG8_LDB(B1, 0, 1); PG8_SCHED; PG8_LDA(At, 0, 0); PG8_STAGE(PG8_SA(1, 1), a1 + hstepA, voffA);
            PG8_WAIT_V(8); PG8_WAIT_L(0); PG8_BAR; PG8_MMA(0, 0, At, B0); PG8_MMA(0, 1, At, B1); PG8_BAR; PG8_SCHED;
            PG8_LDA(At, 0, 1); PG8_STAGE(PG8_SB(0, 0), b2, voffB); PG8_STAGE(PG8_SB(0, 1), b2 + hstepB, voffB); PG8_STAGE(PG8_SA(0, 0), a2, voffA);
            PG8_WAIT_V(8); PG8_WAIT_L(0); PG8_BAR; PG8_MMA(1, 0, At, B0); PG8_MMA(1, 1, At, B1); PG8_BAR; PG8_SCHED;
            PG8_LDB(B0, 1, 0); PG8_LDB(B1, 1, 1); PG8_SCHED; PG8_LDA(At, 1, 0); PG8_STAGE(PG8_SA(0, 1), a2 + hstepA, voffA);
            PG8_WAIT_V(8); PG8_WAIT_L(0); PG8_BAR; PG8_MMA(0, 0, At, B0); PG8_MMA(0, 1, At, B1); PG8_BAR; PG8_SCHED;
            PG8_LDA(At, 1, 1); PG8_STAGE(PG8_SB(1, 0), b3, voffB); PG8_STAGE(PG8_SB(1, 1), b3 + hstepB, voffB); PG8_STAGE(PG8_SA(1, 0), a3, voffA);
            PG8_WAIT_V(8); PG8_WAIT_L(0); PG8_BAR; PG8_MMA(1, 0, At, B0); PG8_MMA(1, 1, At, B1); PG8_BAR; PG8_SCHED;
            } else {
            PG8_LDB(B0, 0, 0); PG8_SCHED; PG8_LDA(At, 0, 0); PG8_STAGE(PG8_SA(1, 1), a1 + hstepA, voffA);
            PG8_WAIT_L(8); PG8_BAR; PG8_WAIT_L(0); PG8_MMA(0, 0, At, B0); PG8_BAR; PG8_SCHED;
            PG8_LDB(B1, 0, 1); PG8_STAGE(PG8_SB(0, 0), b2, voffB);
            PG8_BAR; PG8_WAIT_L(0); PG8_MMA(0, 1, At, B1); PG8_BAR;
            PG8_LDA(At, 0, 1); PG8_STAGE(PG8_SA(0, 0), a2, voffA);
            PG8_BAR; PG8_WAIT_L(0); PG8_MMA(1, 0, At, B0); PG8_BAR; PG8_SCHED;
            PG8_STAGE(PG8_SB(0, 1), b2 + hstepB, voffB);
            PG8_WAIT_V(6); PG8_BAR; PG8_MMA(1, 1, At, B1); PG8_BAR;
            PG8_LDB(B0, 1, 0); PG8_SCHED; PG8_LDA(At, 1, 0); PG8_STAGE(PG8_SA(0, 1), a2 + hstepA, voffA);
            PG8_WAIT_L(8); PG8_BAR; PG8_WAIT_L(0); PG8_MMA(0, 0, At, B0); PG8_BAR; PG8_SCHED;
            PG8_LDB(B1, 1, 1); PG8_STAGE(PG8_SB(1, 0), b3, voffB);
            PG8_BAR; PG8_WAIT_L(0); PG8_MMA(0, 1, At, B1); PG8_BAR;
            PG8_LDA(At, 1, 1); PG8_STAGE(PG8_SA(1, 0), a3, voffA);
            PG8_BAR; PG8_WAIT_L(0); PG8_MMA(1, 0, At, B0); PG8_BAR; PG8_SCHED;
            PG8_STAGE(PG8_SB(1, 1), b3 + hstepB, voffB);
            PG8_WAIT_V(6); PG8_BAR; PG8_MMA(1, 1, At, B1); PG8_BAR;
            }
        }
        if constexpr (ALIGN_EPI) { if (wr == 0) PG8_BAR; }
        if constexpr (!Epi::AFTER_DRAIN) { E(acc, cur, wr, wc, fr, fq); S.done(cur); }
        if (!has_next) break;
#pragma unroll
        for (int a = 0; a < 2; ++a)
#pragma unroll
            for (int b = 0; b < 2; ++b)
#pragma unroll
                for (int m = 0; m < 4; ++m)
#pragma unroll
                    for (int n = 0; n < 2; ++n) acc[a][b][m][n] = (f32x4){0.f, 0.f, 0.f, 0.f};
        cur = nxt; cA = nA; cB = nB; ++ui;
        if constexpr (ALIGN_EPI) { if (wr == 1) PG8_BAR; }
    }
    PG8_WAIT_V(0);
    if constexpr (!ALIGN_EPI) { if (wr == 0) PG8_BAR; }
    PG8_BAR;
    if constexpr (Epi::AFTER_DRAIN) { E.fused(acc, cur, wr, wc, fr, fq, lds, wid, lane); S.done(cur); }
#undef PG8_SA
#undef PG8_SB
#undef PG8_STAGE
#undef PG8_LDA
#undef PG8_LDB
#undef PG8_MMA
#undef PG8_WAIT_V
#undef PG8_WAIT_L
#undef PG8_BAR
#undef PG8_SCHED
}
}

constexpr int TCTX = 4096, TLAT = 8192, TT = 12288, DM = 1024, NKEYROWS = 13312;
constexpr float EPSN = 1e-6f;
constexpr size_t MiB = 1u << 20;
constexpr size_t WS_MOD = 0, MOD_BYTES = 2 * 5 * 6144 * 4, WS_BAR = 262144, BAR_REGION = 16384, ZERO_BYTES = WS_BAR + 5 * BAR_REGION;
constexpr size_t WS_HID = 1 * MiB;
constexpr size_t WS_WIN = 3 * MiB  , WS_WG = 11 * MiB  , WS_WUQ = 15 * MiB, WS_WKN = 16 * MiB, WS_WVV = 16 * MiB + 262144, WS_WB = 17 * MiB, WS_WO = 20 * MiB, WS_WUP = 22 * MiB, WS_WDN = 33 * MiB;
constexpr size_t WS_U = 39 * MiB, WS_ACT = 171 * MiB, WS_HBF = 171 * MiB  , WS_HBF1 = 165 * MiB  ;
constexpr size_t WS_QA = 39 * MiB, WS_KVR = 51 * MiB, WS_CQ = 57 * MiB, WS_CKVR = 69 * MiB, WS_HYR = 75 * MiB, WS_OA = 75 * MiB, WS_OB = 87 * MiB, WS_OC = 99 * MiB;
constexpr size_t WS_UT = 111 * MiB, WS_QB = 147 * MiB, WS_CKVALL = 189 * MiB, WS_KPEALL = 196 * MiB, WS_KNB = 197 * MiB, WS_VTB = 210 * MiB, WS_KA = 223 * MiB, WS_VTA = 227 * MiB;
constexpr size_t WS_S0 = 232 * MiB  , WS_S1 = 111 * MiB, WS_S2 = 135 * MiB, WS_MBF = 195 * MiB, WS_END = 256 * MiB;
constexpr int KA_LAT = 16 * 2 * 256 * 64;
constexpr int UT_LAT = 16 * 1536 * 256;
constexpr int OUT_K = 12582912, OUT_V = 13631488, OUT_CKV = 14680064, OUT_KPE = 16777216;
constexpr int LDS_BYTES = 147456;
constexpr int NPHASE = 24;

#ifndef GAS
#define GAS __attribute__((address_space(1)))
#endif
#define LAS __attribute__((address_space(3)))
typedef unsigned short bf16;
typedef unsigned v4u __attribute__((ext_vector_type(4)));
typedef unsigned v2u __attribute__((ext_vector_type(2)));
typedef float f32x4 __attribute__((ext_vector_type(4)));
typedef float f32x16 __attribute__((ext_vector_type(16)));
typedef short bf16x8 __attribute__((ext_vector_type(8)));
typedef short bf16x4 __attribute__((ext_vector_type(4)));
#define LDS_WAIT() asm volatile("s_waitcnt lgkmcnt(0)" ::: "memory")
__device__ __forceinline__ unsigned f2bf(float f) { unsigned u = __builtin_bit_cast(unsigned, f); return (u + 0x7fffu + ((u >> 16) & 1u)) >> 16; }
__device__ __forceinline__ unsigned pk2(float lo, float hi) { return f2bf(lo) | (f2bf(hi) << 16); }
__device__ __forceinline__ float bflo(unsigned w) { return __uint_as_float(w << 16); }
__device__ __forceinline__ float bfhi(unsigned w) { return __uint_as_float(w & 0xffff0000u); }
__device__ __forceinline__ float bf1(bf16 b) { return __uint_as_float(((unsigned)b) << 16); }
__device__ __forceinline__ void fsincos(float x, float& s, float& c) { float rev = x * 0.15915494309189535f; rev = rev - rintf(rev); s = __builtin_amdgcn_sinf(rev); c = __builtin_amdgcn_cosf(rev); }
__device__ __forceinline__ float fsin(float x) { float rev = x * 0.15915494309189535f; rev = rev - rintf(rev); return __builtin_amdgcn_sinf(rev); }
__device__ __forceinline__ float wave_sum(float v) {
#pragma unroll
    for (int o = 1; o < 64; o <<= 1) v += __shfl_xor(v, o);
    return v;
}
__device__ __forceinline__ void rope2(float& x0, float& x1, float ang) { float s, c; fsincos(ang, s, c); const float a = x0 * c - x1 * s, b = x0 * s + x1 * c; x0 = a; x1 = b; }
#define L2_10000 13.287712379549449f

__device__ __forceinline__ void transpose_item(const float* W, size_t ldw, int k0, int n0, bf16* WT, size_t ldt, int drow0, LAS float* scr, int lane) {
    float wv[32];
#pragma unroll
    for (int i = 0; i < 32; ++i) wv[i] = ((const GAS float*)W)[(size_t)(k0 + 2 * i + (lane >> 5)) * ldw + n0 + (lane & 31)];
#pragma unroll
    for (int i = 0; i < 32; ++i) scr[(2 * i + (lane >> 5)) * 33 + (lane & 31)] = wv[i];
    LDS_WAIT(); asm volatile("" ::: "memory");
    const int c = lane & 7;
#pragma unroll
    for (int j = 0; j < 4; ++j) { const int n = (lane >> 3) + 8 * j; const LAS float* s = scr + (8 * c) * 33 + n;
        v4u o; o.x = pk2(s[0 * 33], s[1 * 33]); o.y = pk2(s[2 * 33], s[3 * 33]); o.z = pk2(s[4 * 33], s[5 * 33]); o.w = pk2(s[6 * 33], s[7 * 33]);
        *(GAS v4u*)(WT + (size_t)(drow0 + n) * ldt + k0 + 8 * c) = o; }
    LDS_WAIT(); asm volatile("" ::: "memory");
}

#define XB_TMO      128
#define XB_XCNT(j)  (256  + 64 * (j))
#define XB_XSUB(j)  (1280 + 64 * (j))
#define XB_XGEN(j)  (2304 + 64 * (j))
#define XB_TOP      3328
#define XB_TOPGEN   3392
#define XCD_BAR_WORDS 3456
#define XB_SPIN_CAP (1u << 18)

__device__ __forceinline__ unsigned xb_ld(unsigned* p)              { return __hip_atomic_load(p, __ATOMIC_RELAXED, __HIP_MEMORY_SCOPE_AGENT); }
__device__ __forceinline__ unsigned xb_add(unsigned* p, unsigned v) { return __hip_atomic_fetch_add(p, v, __ATOMIC_RELAXED, __HIP_MEMORY_SCOPE_AGENT); }
__device__ __forceinline__ unsigned xb_xcc_id() { return (unsigned)__builtin_amdgcn_s_getreg((3 << 11) | 20) & 0xFu; }
#define XB_SPIN(cond, bar) do { unsigned _sp = 0; while (cond) { __builtin_amdgcn_s_sleep(1); \
    if ((++_sp & 255u) == 0u) { if (xb_ld(&(bar)[XB_TMO])) break; if (_sp > XB_SPIN_CAP) { atomicAdd(&(bar)[XB_TMO], 1u); break; } } } } while (0)

struct XcdBarrier {
    unsigned* bar; unsigned x;
    volatile LAS unsigned* st;
};

__device__ __forceinline__ XcdBarrier xcd_barrier_post(unsigned* bar, volatile LAS unsigned* st) {
    XcdBarrier b; b.bar = bar; b.x = xb_xcc_id(); b.st = st;
    if (threadIdx.x == 0) (void)xb_add(&bar[XB_XCNT(b.x)], 1u);
    return b;
}
__device__ __forceinline__ void xcd_barrier_complete(unsigned* bar, unsigned x, unsigned& nloc, unsigned& nx) {
    const unsigned G = gridDim.x * gridDim.y * gridDim.z;
    unsigned sum, cnt, mine, sp = 0u;
    for (;;) {
        sum = 0u; cnt = 0u; mine = 0u;
#pragma unroll
        for (unsigned j = 0; j < 16; ++j) { const unsigned c = xb_ld(&bar[XB_XCNT(j)]); sum += c; cnt += (c > 0u) ? 1u : 0u; mine = (j == x) ? c : mine; }
        if (sum == G) break;
        __builtin_amdgcn_s_sleep(1);
        if ((++sp & 255u) == 0u) { if (xb_ld(&bar[XB_TMO])) break; if (sp > XB_SPIN_CAP) { atomicAdd(&bar[XB_TMO], 1u); break; } }
    }
    nloc = mine > 0u ? mine : 1u; nx = cnt > 0u ? cnt : 1u;
}

__device__ __forceinline__ void xcd_barrier(const XcdBarrier& b) {
    asm volatile("s_waitcnt vmcnt(0)" ::: "memory");
    __syncthreads();
    if (threadIdx.x == 0) {
        unsigned* bar = b.bar;
        __builtin_amdgcn_s_waitcnt(0);
        unsigned nloc = b.st[0], nx = b.st[1];
        if (nloc == 0u) { xcd_barrier_complete(bar, b.x, nloc, nx); b.st[0] = nloc; b.st[1] = nx; }
        const unsigned old = xb_add(&bar[XB_XSUB(b.x)], 1u);
        const unsigned gen = old / nloc;
        if (old + 1u == (gen + 1u) * nloc) {
            __builtin_amdgcn_fence(__ATOMIC_RELEASE, "agent");
            asm volatile("s_waitcnt vmcnt(0)" ::: "memory");
            const unsigned og = xb_add(&bar[XB_TOP], 1u);
            const unsigned tg = og / nx;
            if (og + 1u == (tg + 1u) * nx) xb_add(&bar[XB_TOPGEN], 1u);
            else XB_SPIN(xb_ld(&bar[XB_TOPGEN]) == tg, bar);
            __builtin_amdgcn_fence(__ATOMIC_ACQUIRE, "agent");
            xb_add(&bar[XB_XGEN(b.x)], 1u);
            asm volatile("s_waitcnt vmcnt(0)" ::: "memory");
        } else {
            XB_SPIN(xb_ld(&bar[XB_XGEN(b.x)]) == gen, bar);
            __builtin_amdgcn_fence(__ATOMIC_ACQUIRE, "agent");
            asm volatile("s_waitcnt vmcnt(0)" ::: "memory");
        }
    }
    __syncthreads();
}


struct Args { const float* in[35]; float* out; unsigned char* ws; int ph_lo, ph_hi, li, pad; };

__device__ __forceinline__ void wconv_phase(const Args& a, int l, int part, LAS unsigned char* lds, int gw, int NGW, int gt, int NGT, int wave, int lane) {
    LAS float* scr = (LAS float*)(lds + wave * 16384);
    unsigned char* ws = a.ws;
    bf16 *WIN = (bf16*)(ws + WS_WIN), *WG = (bf16*)(ws + WS_WG), *WUQ = (bf16*)(ws + WS_WUQ), *WKN = (bf16*)(ws + WS_WKN), *WVV = (bf16*)(ws + WS_WVV), *WB = (bf16*)(ws + WS_WB), *WO = (bf16*)(ws + WS_WO), *WUP = (bf16*)(ws + WS_WUP), *WDN = (bf16*)(ws + WS_WDN);
    constexpr int I1 = 16 * 189, I2 = 6 * 24, I3 = 4 * 32, I4 = 3 * 8 * 32, I5 = 16 * 32, I6 = 16 * 176, I7 = 44 * 32, NIT = I1 + I2 + I3 + I4 + I5 + I6 + I7;
    const int it_lo = (part == 2) ? NIT - I7 : 0, it_hi = (part == 1) ? NIT - I7 : NIT;
    for (int it = it_lo + gw; it < it_hi; it += NGW) {
        int r = it;
        if (r < I1) { const int kb = r / 189, n0 = 32 * (r % 189); bf16* dst = WIN; int drow;
            if (n0 < 1152) drow = n0; else if (n0 < 1408) drow = n0 + 128; else if (n0 < 1440) drow = 1152 + (n0 - 1408); else if (n0 < 2976) drow = 1536 + (n0 - 1440); else if (n0 < 4000) drow = 3072 + (n0 - 2976); else { dst = WG; drow = n0 - 4000; }
            transpose_item(a.in[12] + (size_t)l * 1024 * 6048, 6048, 64 * kb, n0, dst, 1024, drow, scr, lane); continue; } r -= I1;
        if (r < I2) { const int kb = r / 24, n0 = 32 * (r % 24); transpose_item(a.in[17] + (size_t)l * 384 * 768, 768, 64 * kb, n0, WUQ, 384, n0, scr, lane); continue; } r -= I2;
        if (r < I3) { const int kb = r / 32, n0 = 32 * (r % 32); const int h = n0 >> 7, c0 = n0 & 127;
            transpose_item(a.in[18] + (size_t)l * 256 * 1024, 1024, 64 * kb, n0, (c0 < 64) ? WKN : WVV, 256, h * 64 + (c0 & 63), scr, lane); continue; } r -= I3;
        if (r < I4) { const int n = r / 256, q = r % 256, kb = q / 32, n0 = 32 * (q % 32);
            transpose_item(a.in[28] + ((size_t)l * 3 + n) * 512 * 1024, 1024, 64 * kb, n0, WB + (size_t)n * 1024 * 512, 512, n0, scr, lane); continue; } r -= I4;
        if (r < I5) { const int kb = r / 32, n0 = 32 * (r % 32); transpose_item(a.in[29] + (size_t)l * 1024 * 1024, 1024, 64 * kb, n0, WO, 1024, n0, scr, lane); continue; } r -= I5;
        if (r < I6) { const int kb = r / 176, n0 = 32 * (r % 176); transpose_item(a.in[30] + (size_t)l * 1024 * 5632, 5632, 64 * kb, n0, WUP, 1024, n0, scr, lane); continue; } r -= I6;
        { const int kb = r / 32, n0 = 32 * (r % 32); transpose_item(a.in[33] + (size_t)l * 2816 * 1024, 1024, 64 * kb, n0, WDN, 2816, n0, scr, lane); }
    }
    if (part != 2) for (int i = gt; i < 96 * 1024 / 8; i += NGT) *(GAS v4u*)(WIN + (size_t)1184 * 1024 + (size_t)i * 8) = (v4u){0u, 0u, 0u, 0u};
}

__device__ __forceinline__ void norm_phase(const Args& a, int l, int which, bool first, int gw, int NGW, int lane) {
    const GAS float* mod = (const GAS float*)(a.ws + WS_MOD) + (size_t)l * 5 * 6144;
    GAS bf16* HBF = (GAS bf16*)(a.ws + (which == 0 ? WS_HBF1 : WS_HBF));
    const GAS float* gv = (const GAS float*)((which == 0) ? a.in[10] + l * 1024 : (which == 1) ? a.in[11] + l * 1024 : a.in[34]);
    GAS float* outp = (GAS float*)a.out;
    const int shoff = (which == 0) ? 0 : 3072, scoff = shoff + 1024;
    #pragma unroll 1
    for (int row0 = gw; row0 < TT; row0 += 4 * NGW) {
        f32x4 v[4][4];
#pragma unroll
        for (int q = 0; q < 4; ++q) { const int row = row0 + q * NGW; const int rr = row < TT ? row : row0;
            const GAS float* src = first ? (const GAS float*)(rr < TCTX ? a.in[0] + (size_t)rr * DM : a.in[1] + (size_t)(rr - TCTX) * DM) : (const GAS float*)(outp + (size_t)rr * DM);
#pragma unroll
            for (int j = 0; j < 4; ++j) v[q][j] = *(const GAS f32x4*)(src + 4 * lane + 256 * j); }
#pragma unroll
        for (int q = 0; q < 4; ++q) { const int row = row0 + q * NGW; if (row >= TT) continue;
            float ss = 0.f;
#pragma unroll
            for (int j = 0; j < 4; ++j) ss += (v[q][j].x * v[q][j].x + v[q][j].y * v[q][j].y) + (v[q][j].z * v[q][j].z + v[q][j].w * v[q][j].w);
            if (first) {
#pragma unroll
                for (int j = 0; j < 4; ++j) *(GAS f32x4*)(outp + (size_t)row * DM + 4 * lane + 256 * j) = v[q][j]; }
            const float rs = rsqrtf(wave_sum(ss) * (1.f / DM) + EPSN);
            const int mrow = row < TCTX ? 0 : 1 + ((row - TCTX) >> 11);
            const GAS float* mp = mod + (size_t)mrow * 6144;
#pragma unroll
            for (int j = 0; j < 4; ++j) { const int col = 4 * lane + 256 * j; const f32x4 g = *(const GAS f32x4*)(gv + col);
                if (which == 2) { *(GAS f32x4*)(outp + (size_t)row * DM + col) = v[q][j] * rs * g; }
                else { const f32x4 sc = *(const GAS f32x4*)(mp + scoff + col), sh = *(const GAS f32x4*)(mp + shoff + col);
                    const f32x4 y = v[q][j] * rs * g * (sc + 1.f) + sh;
                    *(GAS v2u*)(HBF + (size_t)row * DM + col) = (v2u){pk2(y.x, y.y), pk2(y.z, y.w)}; } } }
    }
}
__device__ __forceinline__ void p0_mod_hid(const Args& a, LAS unsigned char* lds, int bid, int G, int tid, int gw, int NGW, int lane) {
    float* mod = (float*)(a.ws + WS_MOD);
    LAS float* sc = (LAS float*)lds;
    for (int it = bid; it < 384; it += G) {
        const int l = it / 192, rem = it % 192, kc = rem / 12, jb = rem % 12;
        if (tid < 320) { const int r = tid >> 6, kk = tid & 63, k = kc * 64 + kk; const float cv = (r == 0) ? a.in[7][k] : a.in[6][(r - 1) * 1024 + k]; sc[tid] = cv / (1.f + __expf(-cv)); }
        __syncthreads();
        const int j = jb * 512 + tid;
        const GAS float* wp = (const GAS float*)(a.in[8] + ((size_t)l * 1024 + kc * 64) * 6144 + j);
        float acc[5] = {0.f, 0.f, 0.f, 0.f, 0.f};
#pragma unroll 8
        for (int kk = 0; kk < 64; ++kk) { const float w = wp[(size_t)kk * 6144];
#pragma unroll
            for (int r = 0; r < 5; ++r) acc[r] += sc[r * 64 + kk] * w; }
        const float bias = (kc == 0) ? a.in[9][l * 6144 + j] : 0.f;
#pragma unroll
        for (int r = 0; r < 5; ++r) atomicAdd(mod + (size_t)(l * 5 + r) * 6144 + j, acc[r] + bias);
        __syncthreads();
    }
    float* HID = (float*)(a.ws + WS_HID);
    for (int it = gw; it < 2 * 2304; it += NGW) {
        const int l = it / 2304, q = it % 2304; const int L = q < 256 ? 256 : 2048, t = q < 256 ? q : q - 256;
        const float tn = (float)t / (float)(L - 1);
        float zi = 0.f;
        if (lane == 0) zi = tn;
        else if (lane <= 16) { const int bi = (lane - 1) & 7; const float band = 1e-4f + (float)bi * ((7.f - 1e-4f) / 7.f); const float ang = (6.283185307179586f / (float)L) * (float)t * band; float s, c; fsincos(ang, s, c); zi = (lane <= 8) ? c : -s; }
        float s1 = a.in[22][l * 64 + lane];
#pragma unroll
        for (int i = 0; i < 17; ++i) s1 += __shfl(zi, i) * a.in[21][(l * 17 + i) * 64 + lane];
        const float h1 = fsin(a.in[26][(l * 2 + 0) * 64 + lane] * s1);
        float s2 = a.in[24][l * 64 + lane];
#pragma unroll 8
        for (int i = 0; i < 64; ++i) s2 += __shfl(h1, i) * a.in[23][(l * 64 + i) * 64 + lane];
        HID[(size_t)it * 64 + lane] = fsin(a.in[26][(l * 2 + 1) * 64 + lane] * s2);
    }
}

__device__ __forceinline__ void post_phase(const Args& a, int l, LAS unsigned char* lds, int bid, int G, int tid, int gw, int NGW, int gt, int NGT, int lane) {
    unsigned char* ws = a.ws;
    GAS bf16 *QA = (GAS bf16*)(ws + WS_QA), *KVR = (GAS bf16*)(ws + WS_KVR), *CQ = (GAS bf16*)(ws + WS_CQ), *CKVR = (GAS bf16*)(ws + WS_CKVR), *HYR = (GAS bf16*)(ws + WS_HYR);
    GAS bf16 *UT = (GAS bf16*)(ws + WS_UT), *CKVALL = (GAS bf16*)(ws + WS_CKVALL), *KPEALL = (GAS bf16*)(ws + WS_KPEALL), *KA = (GAS bf16*)(ws + WS_KA), *VTA = (GAS bf16*)(ws + WS_VTA);
    GAS float* outp = (GAS float*)a.out;
    for (int i = gt; i < 4 * 256 * 128; i += NGT) { const int b = i >> 15, p = (i >> 7) & 255, kvh = (i >> 6) & 1, d = i & 63;
        const size_t s = ((size_t)(b * 2 + l) * 256 + p) * 128 + kvh * 64 + d;
        KA[KA_LAT + ((b * 2 + kvh) * 2304 + p) * 64 + d] = (bf16)f2bf(a.in[2][s]);
        VTA[KA_LAT + ((b * 2 + kvh) * 64 + d) * 2304 + p] = (bf16)f2bf(a.in[3][s]); }
    for (int i = gt; i < 4 * 256 * 256; i += NGT) { const int b = i >> 16, p = (i >> 8) & 255, j = i & 255;
        CKVALL[(size_t)(TCTX + b * 2304 + p) * 256 + j] = (bf16)f2bf(a.in[4][((size_t)(b * 2 + l) * 256 + p) * 256 + j]); }
    for (int i = gt; i < 4 * 256 * 32; i += NGT) { const int b = i >> 13, p = (i >> 5) & 255, j = i & 31;
        KPEALL[(size_t)(TCTX + b * 2304 + p) * 32 + j] = (bf16)f2bf(a.in[5][((size_t)(b * 2 + l) * 256 + p) * 32 + j]); }
    const GAS float *gq = (const GAS float*)(a.in[13] + l * 64), *gk = (const GAS float*)(a.in[14] + l * 64), *gcq = (const GAS float*)(a.in[15] + l * 384), *gkv = (const GAS float*)(a.in[16] + l * 256);
    for (int row = gw; row < TT; row += NGW) {
        const bool lat = row >= TCTX;
        const int b = lat ? (row - TCTX) >> 11 : row >> 8, t = lat ? (row - TCTX) & 2047 : row & 255;
        const float grow = (float)(t >> 6), gcol = (float)(t & 63);
        const int keyrow = lat ? TCTX + b * 2304 + 256 + t : row;
        { v4u w = *(const GAS v4u*)(QA + (size_t)row * 512 + 8 * lane);
          float x[8] = {bflo(w.x), bfhi(w.x), bflo(w.y), bfhi(w.y), bflo(w.z), bfhi(w.z), bflo(w.w), bfhi(w.w)};
          float ss = 0.f;
#pragma unroll
          for (int j = 0; j < 8; ++j) ss += x[j] * x[j];
          ss += __shfl_xor(ss, 1); ss += __shfl_xor(ss, 2); ss += __shfl_xor(ss, 4);
          const float rs = rsqrtf(ss * (1.f / 64.f) + EPSN); const int d0 = 8 * (lane & 7);
#pragma unroll
          for (int j = 0; j < 8; ++j) x[j] = x[j] * rs * gq[d0 + j];
          if (lat) {
#pragma unroll
              for (int k = 0; k < 4; ++k) { const int i = 4 * (lane & 7) + k; const float inv = __builtin_amdgcn_exp2f(-(float)(i & 15) * (L2_10000 / 16.f)); rope2(x[2 * k], x[2 * k + 1], (i < 16 ? grow : gcol) * inv); } }
          *(GAS v4u*)(QA + (size_t)row * 512 + 8 * lane) = (v4u){pk2(x[0], x[1]), pk2(x[2], x[3]), pk2(x[4], x[5]), pk2(x[6], x[7])}; }
        { const v2u w = *(const GAS v2u*)(KVR + (size_t)row * 256 + 4 * lane);
          float x[4] = {bflo(w.x), bfhi(w.x), bflo(w.y), bfhi(w.y)};
          float ss = (x[0] * x[0] + x[1] * x[1]) + (x[2] * x[2] + x[3] * x[3]);
          ss += __shfl_xor(ss, 1); ss += __shfl_xor(ss, 2); ss += __shfl_xor(ss, 4); ss += __shfl_xor(ss, 8);
          const int kvh = (lane >> 4) & 1, d0 = 4 * (lane & 15);
          if (lane < 32) {
              const float rs = rsqrtf(ss * (1.f / 64.f) + EPSN);
#pragma unroll
              for (int j = 0; j < 4; ++j) x[j] = x[j] * rs * gk[d0 + j];
              if (!lat) { *(GAS f32x4*)(outp + OUT_K + ((size_t)(b * 2 + l) * 256 + t) * 128 + kvh * 64 + d0) = (f32x4){x[0], x[1], x[2], x[3]};
                  *(GAS v2u*)(KA + ((size_t)(b * 2 + kvh) * 256 + t) * 64 + d0) = (v2u){pk2(x[0], x[1]), pk2(x[2], x[3])}; }
              else {
#pragma unroll
                  for (int k = 0; k < 2; ++k) { const int i = 2 * (lane & 15) + k; const float inv = __builtin_amdgcn_exp2f(-(float)(i & 15) * (L2_10000 / 16.f)); rope2(x[2 * k], x[2 * k + 1], (i < 16 ? grow : gcol) * inv); }
                  *(GAS v2u*)(KA + KA_LAT + ((size_t)(b * 2 + kvh) * 2304 + 256 + t) * 64 + d0) = (v2u){pk2(x[0], x[1]), pk2(x[2], x[3])}; }
          } else {
              if (!lat) { *(GAS f32x4*)(outp + OUT_V + ((size_t)(b * 2 + l) * 256 + t) * 128 + kvh * 64 + d0) = (f32x4){x[0], x[1], x[2], x[3]};
#pragma unroll
                  for (int j = 0; j < 4; ++j) VTA[((size_t)(b * 2 + kvh) * 64 + d0 + j) * 256 + t] = (bf16)f2bf(x[j]); }
              else {
#pragma unroll
                  for (int j = 0; j < 4; ++j) VTA[KA_LAT + ((size_t)(b * 2 + kvh) * 64 + d0 + j) * 2304 + 256 + t] = (bf16)f2bf(x[j]); }
          } }
        { GAS unsigned* p = (GAS unsigned*)(CQ + (size_t)row * 512 + 6 * lane);
          const unsigned w0 = p[0], w1 = p[1], w2 = p[2];
          float x[6] = {bflo(w0), bfhi(w0), bflo(w1), bfhi(w1), bflo(w2), bfhi(w2)};
          float ss = 0.f;
#pragma unroll
          for (int j = 0; j < 6; ++j) ss += x[j] * x[j];
          const float rs = rsqrtf(wave_sum(ss) * (1.f / 384.f) + EPSN);
#pragma unroll
          for (int j = 0; j < 6; ++j) x[j] = x[j] * rs * gcq[6 * lane + j];
          p[0] = pk2(x[0], x[1]); p[1] = pk2(x[2], x[3]); p[2] = pk2(x[4], x[5]);
          if (lane < 16) { const unsigned w = *(const GAS unsigned*)(CQ + (size_t)row * 512 + 384 + 2 * lane); float y0 = bflo(w), y1 = bfhi(w);
              if (!lat) { outp[OUT_KPE + ((size_t)(b * 2 + l) * 256 + t) * 32 + 2 * lane] = y0; outp[OUT_KPE + ((size_t)(b * 2 + l) * 256 + t) * 32 + 2 * lane + 1] = y1; }
              else { const float inv = __builtin_amdgcn_exp2f(-(float)(lane & 7) * (L2_10000 / 8.f)); rope2(y0, y1, (lane < 8 ? grow : gcol) * inv); }
              *(GAS unsigned*)(KPEALL + (size_t)keyrow * 32 + 2 * lane) = pk2(y0, y1); } }
        { const v2u w = *(const GAS v2u*)(CKVR + (size_t)row * 256 + 4 * lane);
          float x[4] = {bflo(w.x), bfhi(w.x), bflo(w.y), bfhi(w.y)};
          const float ss = (x[0] * x[0] + x[1] * x[1]) + (x[2] * x[2] + x[3] * x[3]);
          const float rs = rsqrtf(wave_sum(ss) * (1.f / 256.f) + EPSN);
#pragma unroll
          for (int j = 0; j < 4; ++j) x[j] = x[j] * rs * gkv[4 * lane + j];
          if (!lat) *(GAS f32x4*)(outp + OUT_CKV + ((size_t)(b * 2 + l) * 256 + t) * 256 + 4 * lane) = (f32x4){x[0], x[1], x[2], x[3]};
          *(GAS v2u*)(CKVALL + (size_t)keyrow * 256 + 4 * lane) = (v2u){pk2(x[0], x[1]), pk2(x[2], x[3])}; }
    }
    LAS float* tile = (LAS float*)lds;
    const GAS float *sw = (const GAS float*)(a.in[19] + (size_t)l * 3 * 1536), *sb = (const GAS float*)(a.in[20] + (size_t)l * 1536);
    for (int it = bid; it < 96 * 12; it += G) {
        const int tb = it / 12, cb = it % 12, row0 = tb * 128;
        const bool lat = row0 >= TCTX; const int L = lat ? 2048 : 256;
        const int b = lat ? (row0 - TCTX) >> 11 : row0 >> 8, t0 = lat ? (row0 - TCTX) & 2047 : row0 & 255;
        v4u w[4], wh = (v4u){0u, 0u, 0u, 0u};
        { const int rr = tid >> 4, c8 = tid & 15;
#pragma unroll
          for (int q = 0; q < 4; ++q) w[q] = *(const GAS v4u*)(HYR + (size_t)(row0 + rr + 32 * q) * 1536 + cb * 128 + 8 * c8);
          if (tid < 32) { const int which = tid >> 4; const bool ok = which ? (t0 + 128 < L) : (t0 > 0); const int rsrc = which ? row0 + 128 : row0 - 1;
              if (ok) wh = *(const GAS v4u*)(HYR + (size_t)rsrc * 1536 + cb * 128 + 8 * c8); }
#pragma unroll
          for (int q = 0; q < 4; ++q) { LAS float* tp = tile + (rr + 32 * q + 1) * 129 + 8 * c8;
              tp[0] = bflo(w[q].x); tp[1] = bfhi(w[q].x); tp[2] = bflo(w[q].y); tp[3] = bfhi(w[q].y); tp[4] = bflo(w[q].z); tp[5] = bfhi(w[q].z); tp[6] = bflo(w[q].w); tp[7] = bfhi(w[q].w); }
          if (tid < 32) { LAS float* tp = tile + ((tid >> 4) ? 129 : 0) * 129 + 8 * c8;
              tp[0] = bflo(wh.x); tp[1] = bfhi(wh.x); tp[2] = bflo(wh.y); tp[3] = bfhi(wh.y); tp[4] = bflo(wh.z); tp[5] = bfhi(wh.z); tp[6] = bflo(wh.w); tp[7] = bfhi(wh.w); } }
        __syncthreads();
        { const int c = tid >> 2, tc = tid & 3, cg_ = cb * 128 + c; const float w0 = sw[cg_], w1 = sw[1536 + cg_], w2 = sw[3072 + cg_], bb = sb[cg_];
          const size_t base = lat ? (size_t)UT_LAT + ((size_t)b * 1536 + cg_) * 2048 : ((size_t)b * 1536 + cg_) * 256;
#pragma unroll
          for (int q = 0; q < 4; ++q) { float u[8];
#pragma unroll
              for (int k = 0; k < 8; ++k) { const int tr = 32 * tc + 8 * q + k; u[k] = w0 * tile[tr * 129 + c] + w1 * tile[(tr + 1) * 129 + c] + w2 * tile[(tr + 2) * 129 + c] + bb; }
              *(GAS v4u*)(UT + base + t0 + 32 * tc + 8 * q) = (v4u){pk2(u[0], u[1]), pk2(u[2], u[3]), pk2(u[4], u[5]), pk2(u[6], u[7])}; } }
        __syncthreads();
    }
}

__device__ __forceinline__ void ffnconv_phase(const Args& a, int l, int gt, int NGT) {
    const GAS bf16* U = (const GAS bf16*)(a.ws + WS_U); GAS bf16* ACT = (GAS bf16*)(a.ws + WS_ACT);
    const GAS float *cw = (const GAS float*)(a.in[31] + (size_t)l * 3 * 5632), *cb = (const GAS float*)(a.in[32] + (size_t)l * 5632);
#pragma unroll 1
    for (int idx = gt; idx < 1536 * 352; idx += NGT) {
        const int tb = idx / 352, ch = idx % 352, row0 = tb * 8, c0 = ch * 8;
        const bool lat = row0 >= TCTX; const int t0 = lat ? (row0 - TCTX) & 2047 : row0 & 255, L = lat ? 2048 : 256;
        v4u ra[10], rg[10];
#pragma unroll
        for (int i = 0; i < 10; ++i) { const int t = t0 + i - 1; const bool ok = (t >= 0) && (t < L); const size_t rr = (size_t)(row0 + (ok ? i - 1 : 0)) * 5632 + c0;
            ra[i] = *(const GAS v4u*)(U + rr); rg[i] = *(const GAS v4u*)(U + rr + 2816);
            if (!ok) { ra[i] = (v4u){0u, 0u, 0u, 0u}; rg[i] = (v4u){0u, 0u, 0u, 0u}; } }
        float wa[3][8], wg[3][8], ba[8], bg[8];
#pragma unroll
        for (int j = 0; j < 8; ++j) { ba[j] = cb[c0 + j]; bg[j] = cb[2816 + c0 + j];
#pragma unroll
            for (int k = 0; k < 3; ++k) { wa[k][j] = cw[k * 5632 + c0 + j]; wg[k][j] = cw[k * 5632 + 2816 + c0 + j]; } }
#pragma unroll
        for (int i = 0; i < 8; ++i) {
            float o[8];
#pragma unroll
            for (int j2 = 0; j2 < 4; ++j2) {
                const unsigned a0 = ra[i][j2], a1 = ra[i + 1][j2], a2 = ra[i + 2][j2], g0 = rg[i][j2], g1 = rg[i + 1][j2], g2 = rg[i + 2][j2];
                { const int j = 2 * j2; const float av = wa[0][j] * bflo(a0) + wa[1][j] * bflo(a1) + wa[2][j] * bflo(a2) + ba[j], gv = wg[0][j] * bflo(g0) + wg[1][j] * bflo(g1) + wg[2][j] * bflo(g2) + bg[j]; o[j] = gv * __builtin_amdgcn_rcpf(1.f + __expf(-gv)) * av; }
                { const int j = 2 * j2 + 1; const float av = wa[0][j] * bfhi(a0) + wa[1][j] * bfhi(a1) + wa[2][j] * bfhi(a2) + ba[j], gv = wg[0][j] * bfhi(g0) + wg[1][j] * bfhi(g1) + wg[2][j] * bfhi(g2) + bg[j]; o[j] = gv * __builtin_amdgcn_rcpf(1.f + __expf(-gv)) * av; } }
            *(GAS v4u*)(ACT + (size_t)(row0 + i) * 2816 + c0) = (v4u){pk2(o[0], o[1]), pk2(o[2], o[3]), pk2(o[4], o[5]), pk2(o[6], o[7])};
        }
    }
}
typedef float f32x2_t __attribute__((ext_vector_type(2)));
typedef __bf16 bf16x2_t __attribute__((ext_vector_type(2)));
__device__ __forceinline__ unsigned cvtpk(float lo, float hi) { const f32x2_t v = {lo, hi}; const bf16x2_t b = __builtin_convertvector(v, bf16x2_t); return __builtin_bit_cast(unsigned, b); }
template <int DK>
__device__ __forceinline__ void attn_unit(LAS unsigned char* lds, int tid, const bf16* Qp, int qpitch, const bf16* Kp, int kpitch, const bf16* Kpe, const bf16* Vt, size_t vpitch,
                                          int nkeys, bf16* Op, int opitch, float sl2, bool rope, int pos0) {
    constexpr int NS = DK / 16;
    asm volatile("" : "+v"(tid));
    const int lane = tid & 63, wave = tid >> 6, r = lane & 31, h = lane >> 5;
    bf16x8 qf[NS];
    { const bf16* qrow = Qp + (size_t)(wave * 32 + r) * qpitch;
#pragma unroll
      for (int s = 0; s < NS; ++s) qf[s] = *(const GAS bf16x8*)(qrow + 16 * s + 8 * h);
      if (DK == 96 && rope) { const int t = pos0 + wave * 32 + r; const float grow = (float)(t >> 6), gcol = (float)(t & 63);
#pragma unroll
          for (int sp = 0; sp < 2; ++sp) { bf16x8 v = qf[NS - 2 + sp];
#pragma unroll
              for (int k = 0; k < 4; ++k) { float x0 = bf1((bf16)v[2 * k]), x1 = bf1((bf16)v[2 * k + 1]);
                  const float inv = __builtin_amdgcn_exp2f(-(float)(4 * h + k) * (L2_10000 / 8.f)); rope2(x0, x1, (sp == 0 ? grow : gcol) * inv);
                  v[2 * k] = (short)f2bf(x0); v[2 * k + 1] = (short)f2bf(x1); }
              qf[NS - 2 + sp] = v; } } }
    const int kkey = tid >> 3, kch = tid & 7, pkey = tid >> 2, pch = tid & 3;
    f32x16 o0, o1;
#pragma unroll
    for (int i = 0; i < 16; ++i) { o0[i] = 0.f; o1[i] = 0.f; }
    float mrun = -__builtin_inff(), lrun = 0.f;
    v4u rk, rv, rp = (v4u){0u, 0u, 0u, 0u};
    const int ntile = nkeys >> 6;
#define ATT_LOAD(kt) do { const int key0 = (kt) * 64; rk = *(const GAS v4u*)(Kp + (size_t)(key0 + kkey) * kpitch + 8 * kch); rv = *(const GAS v4u*)(Vt + (size_t)kkey * vpitch + key0 + 8 * kch); \
        if (DK == 96 && tid < 256) rp = *(const GAS v4u*)(Kpe + (size_t)(key0 + pkey) * 32 + 8 * pch); } while (0)
#define ATT_WRITE(buf) do { *(LAS v4u*)(lds + (buf) * 13312 + kkey * 208 + kch * 16) = rk; \
        { LAS unsigned char* vw = lds + 26624 + (buf) * 9216 + kkey * 144 + (kch >> 1) * 32 + (kch & 1) * 8; *(LAS v2u*)vw = (v2u){rv.x, rv.y}; *(LAS v2u*)(vw + 16) = (v2u){rv.z, rv.w}; } \
        if (DK == 96 && tid < 256) *(LAS v4u*)(lds + (buf) * 13312 + pkey * 208 + 128 + pch * 16) = rp; } while (0)
    ATT_LOAD(0); ATT_WRITE(0); __syncthreads();
    for (int kt = 0; kt < ntile; ++kt) {
        const int buf = kt & 1;
        if (kt + 1 < ntile) ATT_LOAD(kt + 1);
        const LAS unsigned char* kb = lds + buf * 13312; const LAS unsigned char* vb = lds + 26624 + buf * 9216;
        f32x16 s0, s1;
#pragma unroll
        for (int i = 0; i < 16; ++i) { s0[i] = 0.f; s1[i] = 0.f; }
#pragma unroll
        for (int s = 0; s < NS; ++s) {
            const bf16x8 a0 = *(const LAS bf16x8*)(kb + r * 208 + (16 * s + 8 * h) * 2), a1 = *(const LAS bf16x8*)(kb + (32 + r) * 208 + (16 * s + 8 * h) * 2);
            s0 = __builtin_amdgcn_mfma_f32_32x32x16_bf16(a0, qf[s], s0, 0, 0, 0); s1 = __builtin_amdgcn_mfma_f32_32x32x16_bf16(a1, qf[s], s1, 0, 0, 0); }
        float mx = s0[0];
#pragma unroll
        for (int i = 1; i < 16; ++i) mx = fmaxf(mx, s0[i]);
#pragma unroll
        for (int i = 0; i < 16; ++i) mx = fmaxf(mx, s1[i]);
        mx = fmaxf(mx, __shfl_xor(mx, 32));
        const float mnew = fmaxf(mrun, mx), alpha = __builtin_amdgcn_exp2f((mrun - mnew) * sl2), nm = mnew * sl2;
        f32x2_t sum2 = {0.f, 0.f};
#pragma unroll
        for (int i = 0; i < 8; ++i) {
            f32x2_t t0 = {s0[2 * i], s0[2 * i + 1]}, t1 = {s1[2 * i], s1[2 * i + 1]};
            t0 = t0 * sl2 - nm; t1 = t1 * sl2 - nm;
            t0.x = __builtin_amdgcn_exp2f(t0.x); t0.y = __builtin_amdgcn_exp2f(t0.y); t1.x = __builtin_amdgcn_exp2f(t1.x); t1.y = __builtin_amdgcn_exp2f(t1.y);
            s0[2 * i] = t0.x; s0[2 * i + 1] = t0.y; s1[2 * i] = t1.x; s1[2 * i + 1] = t1.y;
            sum2 = sum2 + (t0 + t1); }
        lrun = lrun * alpha + (sum2.x + sum2.y); mrun = mnew;
        if (__builtin_amdgcn_ballot_w64(alpha != 1.f)) {
#pragma unroll
            for (int i = 0; i < 16; ++i) { o0[i] *= alpha; o1[i] *= alpha; } }
#pragma unroll
        for (int sub = 0; sub < 2; ++sub) {
#pragma unroll
            for (int s2 = 0; s2 < 2; ++s2) {
                const v4u pw = (sub == 0) ? (v4u){cvtpk(s0[8 * s2], s0[8 * s2 + 1]), cvtpk(s0[8 * s2 + 2], s0[8 * s2 + 3]), cvtpk(s0[8 * s2 + 4], s0[8 * s2 + 5]), cvtpk(s0[8 * s2 + 6], s0[8 * s2 + 7])}
                                          : (v4u){cvtpk(s1[8 * s2], s1[8 * s2 + 1]), cvtpk(s1[8 * s2 + 2], s1[8 * s2 + 3]), cvtpk(s1[8 * s2 + 4], s1[8 * s2 + 5]), cvtpk(s1[8 * s2 + 6], s1[8 * s2 + 7])};
                const bf16x8 pb = __builtin_bit_cast(bf16x8, pw);
                const int kofs = (32 * sub + 16 * s2 + 8 * h) * 2;
#pragma unroll
                for (int slab = 0; slab < 2; ++slab) {
                    const bf16x8 va = *(const LAS bf16x8*)(vb + (32 * slab + r) * 144 + kofs);
                    if (slab == 0) o0 = __builtin_amdgcn_mfma_f32_32x32x16_bf16(va, pb, o0, 0, 0, 0); else o1 = __builtin_amdgcn_mfma_f32_32x32x16_bf16(va, pb, o1, 0, 0, 0); } } }
        if (kt + 1 < ntile) ATT_WRITE(buf ^ 1);
        __syncthreads();
    }
#undef ATT_LOAD
#undef ATT_WRITE
    const float ltot = lrun + __shfl_xor(lrun, 32), inv = 1.f / ltot;
    bf16* orow = Op + (size_t)(wave * 32 + r) * opitch;
#pragma unroll
    for (int g4 = 0; g4 < 4; ++g4) {
        *(GAS v2u*)(orow + 8 * g4 + 4 * h) = (v2u){pk2(o0[4 * g4] * inv, o0[4 * g4 + 1] * inv), pk2(o0[4 * g4 + 2] * inv, o0[4 * g4 + 3] * inv)};
        *(GAS v2u*)(orow + 32 + 8 * g4 + 4 * h) = (v2u){pk2(o1[4 * g4] * inv, o1[4 * g4 + 1] * inv), pk2(o1[4 * g4 + 2] * inv, o1[4 * g4 + 3] * inv)}; }
}

template <bool LAT>
__device__ __forceinline__ void hyena_unit(const Args& a, int l, int c, LAS unsigned char* lds, int tid) {
    constexpr int L = LAT ? 2048 : 256, NB = LAT ? 4 : 16, NE = L / 16, NCH = L / 4, NW = LAT ? 8 : 4, ASH = LAT ? 2 : 4, MG = LAT ? 224 : 32  , UP = L + 2 * MG + 8  , GS = 514  ;
    asm volatile("" : "+v"(tid));
    const int lane = tid & 63, wave = tid >> 6, r = lane & 31, h = lane >> 5;
    const bf16* UT = (const bf16*)(a.ws + WS_UT) + (LAT ? UT_LAT : 0);
    GAS bf16* OC = (GAS bf16*)(a.ws + WS_OC);
    const float* HID = (const float*)(a.ws + WS_HID) + ((size_t)l * 2304 + (LAT ? 256 : 0)) * 64;
    LAS bf16* U = (LAS bf16*)lds; LAS bf16* X = (LAS bf16*)(lds + 20096); LAS float* FT = (LAS float*)(lds + 36480); LAS unsigned char* GC = lds + 69248;
    LAS float* W3 = (LAS float*)(lds + 135040); LAS float* RED = (LAS float*)(lds + 136064);
    constexpr int NQ = NB * L / 8 / 512;
    v4u x2r[NQ];
#pragma unroll
    for (int i = 0; i < NQ; ++i) { const int q = tid + 512 * i, b = q / (L / 8), off = (q % (L / 8)) * 8;
        const v4u uv = *(const GAS v4u*)(UT + ((size_t)b * 1536 + c) * L + off), xv = *(const GAS v4u*)(UT + ((size_t)b * 1536 + 512 + c) * L + off);
        x2r[i] = *(const GAS v4u*)(UT + ((size_t)b * 1536 + 1024 + c) * L + off);
        *(LAS v4u*)(U + b * UP + MG + off) = uv; *(LAS v4u*)(X + b * L + off) = xv; }
    for (int q = tid; q < NB * 2 * MG / 8; q += 512) { const int b = q / (2 * MG / 8), o = q % (2 * MG / 8); const int off = (o < MG / 8) ? 8 * o : MG + L + 8 * (o - MG / 8);
        *(LAS v4u*)(U + b * UP + off) = (v4u){0u, 0u, 0u, 0u}; }
    if (tid < 256) { const int j = tid >> 2, k = tid & 3; W3[k * 64 + j] = a.in[25][((size_t)l * 64 + j) * 2048 + (k >> 1) * 1024 + (k & 1) * 512 + c]; }
    __syncthreads();
#if defined(PROBE_HY) && PROBE_HY == 1
    for (int rep = 0; rep < 2; ++rep)
#endif
    { const float dmin = -15.350567286626973f, dmax = -3.0701134573253945f;
      const float delta = fabsf(dmin + (float)c * ((dmax - dmin) / 511.f));
      float p0 = 0.f, p1 = 0.f;
      for (int t = tid; t < L; t += 512) {
          float s[4] = {0.f, 0.f, 0.f, 0.f};
#pragma unroll 4
          for (int j4 = 0; j4 < 16; ++j4) { const f32x4 hv = *(const GAS f32x4*)(HID + (size_t)t * 64 + 4 * j4);
#pragma unroll
              for (int k = 0; k < 4; ++k) s[k] += hv.x * W3[k * 64 + 4 * j4] + hv.y * W3[k * 64 + 4 * j4 + 1] + hv.z * W3[k * 64 + 4 * j4 + 2] + hv.w * W3[k * 64 + 4 * j4 + 3]; }
          const float win = __expf(-((float)t / (float)(L - 1)) * delta);
#pragma unroll
          for (int k = 0; k < 4; ++k) { s[k] *= win; FT[k * L + t] = s[k]; }
          p0 += fabsf(s[0]) + (t >= 1 ? fabsf(s[2]) : 0.f); p1 += fabsf(s[1]) + (t >= 1 ? fabsf(s[3]) : 0.f); }
      p0 = wave_sum(p0); p1 = wave_sum(p1);
      if (lane == 0) { RED[2 * wave] = p0; RED[2 * wave + 1] = p1; } }
    __syncthreads();
    const int col = 32 * wave + r, ca = col >> ASH, cbat = col & (NB - 1);
    const int a_lo = (32 * wave) >> ASH, a_hi = (32 * wave + 31) >> ASH;
    const int rowbase = LAT ? TCTX + cbat * 2048 : cbat * 256;
#pragma unroll 1
    for (int n = 0; n < 2; ++n) {
        float l1s = 0.f;
#pragma unroll
        for (int w = 0; w < 8; ++w) l1s += RED[2 * w + n];
        const float invl1 = 1.f / (l1s + EPSN);
#if defined(PROBE_HY) && PROBE_HY == 4
        for (int rep = 0; rep < 2; ++rep)
#endif
        for (int q = tid; q < 8 * NCH; q += 512) { const int k = q & 7, y = q >> 3, m0 = L - (8 * y + k);
            float v[8];
#pragma unroll
            for (int j = 0; j < 8; ++j) { const int m = m0 - j; float t = 0.f; if (m >= 0 && m < L) t = FT[n * L + m]; else if (m < 0 && m > -L) t = FT[(2 + n) * L - m]; v[j] = t * invl1; }
            *(LAS v4u*)(GC + (k * GS + y) * 16) = (v4u){cvtpk(v[0], v[1]), cvtpk(v[2], v[3]), cvtpk(v[4], v[5]), cvtpk(v[6], v[7])}; }
        __syncthreads();
        f32x16 acc, acc1;
#if defined(PROBE_HY) && PROBE_HY == 3
        for (int rep = 0; rep < 2; ++rep) {
#endif
#pragma unroll
        for (int i = 0; i < 16; ++i) { acc[i] = 0.f; acc1[i] = 0.f; }
        if (wave < NW) {
            const int lam_lo = 2 * a_lo - (NE - 1), lam_hi = 2 * a_hi;
            const int xs0 = 8 * h - r + L;
            const LAS unsigned char* ap = GC + ((xs0 & 7) * GS + (xs0 >> 3) - 2 * lam_lo) * 16;
            const LAS unsigned char* bp = (const LAS unsigned char*)(U + cbat * UP + MG + 8 * h) + 32 * (2 * ca - lam_lo);
            bf16x8 a0 = *(const LAS bf16x8*)ap, b0 = *(const LAS bf16x8*)bp, a1 = *(const LAS bf16x8*)(ap - 32), b1 = *(const LAS bf16x8*)(bp - 32);
            for (int lam = lam_lo; lam <= lam_hi; lam += 2) {
                const bool more = lam + 2 <= lam_hi;
                if (more) { ap -= 64; bp -= 64; }
                const bf16x8 na0 = *(const LAS bf16x8*)ap, na1 = *(const LAS bf16x8*)(ap - 32), nb0 = *(const LAS bf16x8*)bp, nb1 = *(const LAS bf16x8*)(bp - 32);
                acc = __builtin_amdgcn_mfma_f32_32x32x16_bf16(a0, b0, acc, 0, 0, 0);
                acc1 = __builtin_amdgcn_mfma_f32_32x32x16_bf16(a1, b1, acc1, 0, 0, 0);
                a0 = na0; a1 = na1; b0 = nb0; b1 = nb1;
            }
#pragma unroll
            for (int i = 0; i < 16; ++i) acc[i] += acc1[i];
        }
#if defined(PROBE_HY) && PROBE_HY == 3
        asm volatile("" :: "v"(acc[0]), "v"(acc[5]));
        }
#endif
        const float bias = a.in[27][((size_t)l * 2 + n) * 512 + c];
        float z[16];
        if (wave < NW) {
#pragma unroll
            for (int g4 = 0; g4 < 4; ++g4) { const int t0 = 32 * ca + 8 * g4 + 4 * h;
                const v2u uw = *(const LAS v2u*)(U + cbat * UP + MG + t0), xw = *(const LAS v2u*)(X + cbat * L + t0);
                const float uv[4] = {bflo(uw.x), bfhi(uw.x), bflo(uw.y), bfhi(uw.y)}, xv[4] = {bflo(xw.x), bfhi(xw.x), bflo(xw.y), bfhi(xw.y)};
#pragma unroll
                for (int k = 0; k < 4; ++k) z[4 * g4 + k] = xv[k] * (acc[4 * g4 + k] + bias * uv[k]); }
        }
        __syncthreads();
        if (n == 0) {
            if (wave < NW) {
#pragma unroll
                for (int g4 = 0; g4 < 4; ++g4) *(LAS v2u*)(U + cbat * UP + MG + 32 * ca + 8 * g4 + 4 * h) = (v2u){pk2(z[4 * g4], z[4 * g4 + 1]), pk2(z[4 * g4 + 2], z[4 * g4 + 3])}; }
#pragma unroll
            for (int i = 0; i < NQ; ++i) { const int q = tid + 512 * i, b = q / (L / 8), off = (q % (L / 8)) * 8; *(LAS v4u*)(X + b * L + off) = x2r[i]; }
        } else if (wave < NW) {
#if defined(PROBE_HY) && PROBE_HY == 2
            for (int rep = 0; rep < 2; ++rep)
#endif
#pragma unroll
            for (int g4 = 0; g4 < 4; ++g4)
#pragma unroll
                for (int k = 0; k < 4; ++k) OC[(size_t)(rowbase + 32 * ca + 8 * g4 + 4 * h + k) * 512 + c] = (bf16)f2bf(z[4 * g4 + k]);
        }
    }
    __syncthreads();
}
#ifndef PHMASK
#define PHMASK 0x1fff
#endif
#define PH_ON(k) (((PHMASK) >> (k)) & 1)
#define L1_INV() do { asm volatile("s_waitcnt vmcnt(0)" ::: "memory"); __builtin_amdgcn_fence(__ATOMIC_ACQUIRE, "agent"); asm volatile("s_waitcnt vmcnt(0)" ::: "memory"); __syncthreads(); } while (0)
template <class T> __device__ __forceinline__ T* asglobal(T* p) { return (T*)(GAS T*)p; }
__global__ void __launch_bounds__(512, 2) mega_fwd(Args a) {
    extern __shared__ __attribute__((aligned(16))) unsigned char lds_raw[];
    LAS unsigned char* lds = (LAS unsigned char*)lds_raw;
    cg::grid_group grid = cg::this_grid();
    const int bid = blockIdx.x;
    using pg8::Gemm; using pg8::StaticOrder;
    const int ph_lo = a.ph_lo, ph_hi = a.ph_hi;
    volatile LAS unsigned* MISC = (volatile LAS unsigned*)(lds + LDS_BYTES - 64);
    if (threadIdx.x < 16) MISC[threadIdx.x] = 0u;
    __syncthreads();
    if (ph_hi > NPHASE) { __syncthreads(); grid.sync(); }
    XcdBarrier bar = xcd_barrier_post((unsigned*)(a.ws + WS_BAR + (size_t)a.li * BAR_REGION), MISC);
#pragma unroll 1
    for (int ph = ph_lo; ph < ph_hi; ++ph) {
        int tid = threadIdx.x; asm volatile("" : "+v"(tid));
        int G = gridDim.x; asm volatile("" : "+s"(G)); const int NGW = G * 8, NGT = G * 512;
        unsigned char* ws = a.ws; asm volatile("" : "+s"(ws));
#if defined(__HIP_DEVICE_COMPILE__)
#define ASSUME_GLOBAL(p) __builtin_assume(!__builtin_amdgcn_is_shared((const void*)(p)) && !__builtin_amdgcn_is_private((const void*)(p)))
#else
#define ASSUME_GLOBAL(p) ((void)0)
#endif
        ASSUME_GLOBAL(ws); ASSUME_GLOBAL(a.ws); ASSUME_GLOBAL(a.out);
#pragma unroll
        for (int i = 0; i < 35; ++i) ASSUME_GLOBAL(a.in[i]);
        const int lane = tid & 63, wave = __builtin_amdgcn_readfirstlane(tid >> 6), gw = bid * 8 + wave, gt = bid * 512 + tid;
        const int l = (ph >= 1 && ph < 23) ? (ph - 1) / 11 : 0, sub = (ph >= 1 && ph < 23) ? (ph - 1) % 11 : -1;
        float* mod = (float*)(ws + WS_MOD) + (size_t)l * 5 * 6144;
        if (PH_ON(11) && ph == 0) { p0_mod_hid(a, lds, bid, G, tid, gw, NGW, lane); wconv_phase(a, 0, 0, lds, gw, NGW, gt, NGT, wave, lane); }
        else if (PH_ON(12) && ph == 23) { norm_phase(a, 0, 2, false, gw, NGW, lane); }
        else if (PH_ON(0) && sub == 0) { if (l == 1) wconv_phase(a, 1, (G == 256) ? 2 : 0, lds, gw, NGW, gt, NGT, wave, lane);     norm_phase(a, l, 0, l == 0, gw, NGW, lane); }
        else if (PH_ON(1) && sub == 1) {
            Gemm g{(const bf16*)(ws + WS_HBF1), (const bf16*)(ws + WS_WIN), TT, 4096, 1024, 1024, 1024}; StaticOrder S; S.init(TT, 4096, G, bid);
            pg8::EpiSeg E{(bf16*)(ws + WS_QA), (bf16*)(ws + WS_KVR), (bf16*)(ws + WS_CQ), (bf16*)(ws + WS_CKVR), (bf16*)(ws + WS_HYR), (bf16*)(ws + WS_S0)};
            pg8::gemm_phase<pg8::EpiSeg, StaticOrder, true, true>(lds, g, S, E);
        }
        else if (PH_ON(2) && sub == 2) { post_phase(a, l, lds, bid, G, tid, gw, NGW, gt, NGT, lane); }
        else if (PH_ON(3) && sub == 3) {
#pragma unroll 1
            for (int q = 0; q < 3; ++q) {
                Gemm g; StaticOrder S; pg8::EpiStore<0> E;
                if (q == 0) { g = Gemm{(const bf16*)(ws + WS_CQ), (const bf16*)(ws + WS_WUQ), TT, 768, 384, 512, 384}; S.init(TT, 768, G, bid); E = pg8::EpiStore<0>{(bf16*)(ws + WS_QB), 768}; }
                else if (q == 1) { g = Gemm{(const bf16*)(ws + WS_CKVALL), (const bf16*)(ws + WS_WKN), NKEYROWS, 512, 256, 256, 256}; S.init(NKEYROWS, 512, G, (bid + G - 144 % G) % G); E = pg8::EpiStore<0>{(bf16*)(ws + WS_KNB), 512}; }
                else { g = Gemm{(const bf16*)(ws + WS_WVV), (const bf16*)(ws + WS_CKVALL), 512, NKEYROWS, 256, 256, 256}; S.init(512, NKEYROWS, G, (bid + G - 248 % G) % G); E = pg8::EpiStore<0>{(bf16*)(ws + WS_VTB), NKEYROWS}; }
                pg8::gemm_phase<pg8::EpiStore<0>, StaticOrder, true, true>(lds, g, S, E);
            }
        }
        else if (PH_ON(4) && sub == 4) {
            const bf16 *QA = (const bf16*)(ws + WS_QA), *QB = (const bf16*)(ws + WS_QB), *KA = (const bf16*)(ws + WS_KA), *VTA = (const bf16*)(ws + WS_VTA);
            const bf16 *KNB = (const bf16*)(ws + WS_KNB), *VTB = (const bf16*)(ws + WS_VTB), *KPE = (const bf16*)(ws + WS_KPEALL);
            bf16 *OA = (bf16*)(ws + WS_OA), *OB = (bf16*)(ws + WS_OB);
            const float slA = 0.125f * 1.4426950408889634f, slB = 0.10206207261596575f * 1.4426950408889634f;
            const int sel = a.pad;
            for (int it = bid; it < 1792; it += G) {
                { const bool is_hy = (it >= 512 && it < 1024) || it >= 1280; if ((sel == 1 && is_hy) || (sel == 2 && !is_hy)) continue; }
                if (it < 256 || (it >= 1024 && it < 1152)) {
                    const bool lat = it < 256; const int u = lat ? (G == 256 ? ((bid & 7) * 4 + (bid >> 6)) * 8 + ((bid >> 3) & 7) : it) : it - 1024;
                    const int b = lat ? u >> 6 : u >> 3, hh = lat ? (u >> 3) & 7 : u & 7, qb = lat ? u & 7 : 0;
                    const int row0 = lat ? TCTX + b * 2048 + qb * 256 : b * 256, key0 = lat ? TCTX + b * 2304 : b * 256;
                    attn_unit<96>(lds, tid, QB + (size_t)row0 * 768 + hh * 96, 768, KNB + (size_t)key0 * 512 + hh * 64, 512, KPE + (size_t)key0 * 32, VTB + (size_t)(hh * 64) * NKEYROWS + key0, NKEYROWS,
                                  lat ? 2304 : 256, OB + (size_t)row0 * 512 + hh * 64, 512, slB, lat, qb * 256);
                } else if (it < 512 || (it >= 1152 && it < 1280)) {
                    const bool lat = it < 512; const int u = lat ? (G == 256 ? ((bid & 7) * 4 + (bid >> 6)) * 8 + ((bid >> 3) & 7) : it - 256) : it - 1152;
                    const int b = lat ? u >> 6 : u >> 3, hh = lat ? (u >> 3) & 7 : u & 7, qb = lat ? u & 7 : 0, kvh = hh >> 2;
                    const int row0 = lat ? TCTX + b * 2048 + qb * 256 : b * 256, nk = lat ? 2304 : 256;
                    const size_t kbase = lat ? (size_t)KA_LAT + (size_t)(b * 2 + kvh) * 2304 * 64 : (size_t)(b * 2 + kvh) * 256 * 64;
                    attn_unit<64>(lds, tid, QA + (size_t)row0 * 512 + hh * 64, 512, KA + kbase, 64, nullptr, VTA + kbase, nk, nk, OA + (size_t)row0 * 512 + hh * 64, 512, slA, false, 0);
                } else if (it < 1024) { hyena_unit<true>(a, l, it - 512, lds, tid); }
                else { hyena_unit<false>(a, l, it - 1280, lds, tid); }
            }
        }
        else if (PH_ON(5) && sub == 5) {
            static_assert(WS_S1 + 121 * MiB == WS_S0 && WS_S2 + 97 * MiB == WS_S0, "gate buffer arithmetic");
            bf16 *S0 = (bf16*)(ws + WS_S0), *MBF = (bf16*)(ws + WS_MBF);
            { Gemm g{(const bf16*)(ws + WS_HBF1), (const bf16*)(ws + WS_WG), TT, 2048, 1024, 1024, 1024}; StaticOrder S; S.init(TT, 2048, G, bid);
              pg8::EpiGate E{S0}; pg8::gemm_phase<pg8::EpiGate, StaticOrder, true, true>(lds, g, S, E); }
            xcd_barrier(bar);
            { Gemm g{(const bf16*)(ws + WS_OA), (const bf16*)(ws + WS_WB), TT, 1024, 512, 512, 512, (size_t)TT * 512 * 2, (size_t)1024 * 512 * 2};
              pg8::BatchOrder<3> S; S.init(TT, 1024, G, bid);
              pg8::EpiMerge E{S0, MBF}; pg8::gemm_phase<pg8::EpiMerge, pg8::BatchOrder<3>, true, true>(lds, g, S, E); }
        }
        else if (PH_ON(6) && sub == 6) {
            Gemm g{(const bf16*)(ws + WS_MBF), (const bf16*)(ws + WS_WO), TT, 1024, 1024, 1024, 1024}; StaticOrder S; S.init(TT, 1024, G, bid);
            pg8::EpiResid E{a.out, mod + 2048}; pg8::gemm_phase<pg8::EpiResid, StaticOrder, true, true>(lds, g, S, E);
        }
        else if (PH_ON(7) && sub == 7) { norm_phase(a, l, 1, false, gw, NGW, lane); }
        else if (PH_ON(8) && sub == 8) {
            Gemm g{(const bf16*)(ws + WS_HBF), (const bf16*)(ws + WS_WUP), TT, 5632, 1024, 1024, 1024}; StaticOrder S; S.init(TT, 5632, G, bid);
            pg8::EpiStore<0> E{(bf16*)(ws + WS_U), 5632}; pg8::gemm_phase<pg8::EpiStore<0>, StaticOrder, true, true>(lds, g, S, E);
        }
        else if (PH_ON(9) && sub == 9) { ffnconv_phase(a, l, gt, NGT); }
        else if (PH_ON(10) && sub == 10) {
            Gemm g{(const bf16*)(ws + WS_ACT), (const bf16*)(ws + WS_WDN), TT, 1024, 2816, 2816, 2816}; StaticOrder S; S.init(TT, 1024, G, bid);
            pg8::EpiResid E{a.out, mod + 5120}; pg8::gemm_phase<pg8::EpiResid, StaticOrder, true, true>(lds, g, S, E);
            if (l == 0 && G == 256 && bid >= 192)
                wconv_phase(a, 1, 1, lds, (bid - 192) * 8 + wave, 64 * 8, (bid - 192) * 512 + tid, 64 * 512, wave, lane);
        }
#ifdef EXTRA_SYNCS
        for (int q = 0; q < EXTRA_SYNCS; ++q) { __syncthreads(); grid.sync(); }
#endif
        if (ph + 1 < ph_hi) xcd_barrier(bar);
    }
}

extern "C" void kernel_launch(void* const* d_in, const int* in_sizes, int n_in, void* d_out, int out_size, void* d_ws, size_t ws_size, hipStream_t stream) {
    static int grid = 0;
    if (grid == 0) {
        if (n_in != 35 || ws_size < WS_END) { fprintf(stderr, "kernel_launch: unexpected n_in %d / ws %zu\n", n_in, ws_size); grid = -1; return; }
        int dev = 0, cus = 0, per_cu = 0;
        if (hipGetDevice(&dev) != hipSuccess || hipDeviceGetAttribute(&cus, hipDeviceAttributeMultiprocessorCount, dev) != hipSuccess) { grid = -1; return; }
        if (hipFuncSetAttribute((const void*)mega_fwd, hipFuncAttributeMaxDynamicSharedMemorySize, LDS_BYTES) != hipSuccess) { fprintf(stderr, "kernel_launch: hipFuncSetAttribute failed\n"); grid = -1; return; }
        if (hipOccupancyMaxActiveBlocksPerMultiprocessor(&per_cu, (const void*)mega_fwd, 512, LDS_BYTES) != hipSuccess || per_cu < 1) { fprintf(stderr, "kernel_launch: occupancy query says %d\n", per_cu); per_cu = 1; }
        (void)hipGetLastError();
        grid = cus;
    }
    if (grid < 0) return;
    if (hipMemsetAsync((char*)d_ws + WS_MOD, 0, ZERO_BYTES, stream) != hipSuccess) { fprintf(stderr, "kernel_launch: memset failed\n"); return; }
    Args a{};
    for (int i = 0; i < 35; ++i) a.in[i] = (const float*)d_in[i];
    a.out = (float*)d_out; a.ws = (unsigned char*)d_ws;
#if defined(MK_PER_PHASE)
    for (int p = 0; p < NPHASE; ++p) { a.ph_lo = p; a.ph_hi = p + 1; a.li = 0; void* args[] = {&a};
        hipError_t e = hipLaunchCooperativeKernel((const void*)mega_fwd, dim3(grid), dim3(512), args, LDS_BYTES, stream);
        if (e != hipSuccess) { fprintf(stderr, "launch %d failed: %s\n", p, hipGetErrorString(e)); break; } }
#else
#if defined(PROBE_SUB)
#ifndef PROBE_SEL
#define PROBE_SEL 0
#endif
    { const int k0 = 1 + PROBE_SUB, k1 = 12 + PROBE_SUB; const int cuts[6][2] = {{0, k0 + 1}, {k0, k0 + 1}, {k0 + 1, k1 + 1}, {k1, k1 + 1}, {k1 + 1, NPHASE}, {0, 0}};
      for (int c = 0; c < 5; ++c) { a.ph_lo = cuts[c][0]; a.ph_hi = cuts[c][1]; a.li = c; a.pad = (c == 1 || c == 3) ? PROBE_SEL : 0; if (a.ph_lo >= a.ph_hi) continue; void* args[] = {&a};
          hipError_t e = hipLaunchCooperativeKernel((const void*)mega_fwd, dim3(grid), dim3(512), args, LDS_BYTES, stream);
          if (e != hipSuccess) { fprintf(stderr, "cooperative launch failed: %s\n", hipGetErrorString(e)); break; } } }
#elif defined(PROBE_CUTS)
    { const int k0 = 1 + PROBE_CUTS, k1 = 12 + PROBE_CUTS; const int cuts[4][2] = {{0, k0 + 1}, {k0 + 1, k1 + 1}, {k1 + 1, NPHASE}, {0, 0}};
      for (int c = 0; c < 3; ++c) { a.ph_lo = cuts[c][0]; a.ph_hi = cuts[c][1]; a.li = c; if (a.ph_lo >= a.ph_hi) continue; void* args[] = {&a};
          hipError_t e = hipLaunchCooperativeKernel((const void*)mega_fwd, dim3(grid), dim3(512), args, LDS_BYTES, stream);
          if (e != hipSuccess) { fprintf(stderr, "cooperative launch failed: %s\n", hipGetErrorString(e)); break; } } }
#else
    a.ph_lo = 0; a.ph_hi = NPHASE; void* args[] = {&a};
    hipError_t e = hipLaunchCooperativeKernel((const void*)mega_fwd, dim3(grid), dim3(512), args, LDS_BYTES, stream);
    if (e != hipSuccess) fprintf(stderr, "cooperative launch failed: %s (grid %d)\n", hipGetErrorString(e), grid);
#endif
#endif
}
```

```cpp
#include <hip/hip_runtime.h>
#include <hip/hip_cooperative_groups.h>
#include <cstdio>
#include <cstdint>
namespace cg = cooperative_groups;
namespace pg8 {
#define PG8_LAS __attribute__((address_space(3)))
typedef unsigned short bf16_t;
typedef short bf16x8 __attribute__((ext_vector_type(8)));
typedef float f32x4 __attribute__((ext_vector_type(4)));
typedef unsigned u32x4 __attribute__((ext_vector_type(4)));
constexpr int BM = 256, BK = 64, HALF = 128, HTB = HALF * BK * 2  , STAGE_BYTES = 8 * HTB, NXCD = 8, WGM = 8;

__host__ __device__ __forceinline__ int lds_byte(int r, int c) { const int st = (r >> 4) * 2 + (c >> 5), rr = r & 15, cc = c & 31, ob = rr * 64 + cc * 2; return st * 1024 + (ob ^ (((ob >> 9) & 1) << 5)); }
__host__ __device__ __forceinline__ void stage_rc(int b, int& R, int& C) { const int st = b / 1024, sb = b % 1024, swz = sb ^ (((sb >> 9) & 1) << 5); R = (st >> 1) * 16 + swz / 64; C = (st & 1) * 32 + (swz % 64) / 2; }
__host__ __device__ __forceinline__ int perm32(int rho) { const int n = rho >> 4, i = rho & 15; return 8 * (i >> 2) + 4 * n + (i & 3); }

struct Unit { int pm, pn, gi; };
struct Gemm { const bf16_t* A; const bf16_t* Bt; int M, N, K, lda, ldb; size_t gsA, gsB; };

struct StaticOrder {
    int nM, nN, nwg, G, c;
    __host__ __device__ void init(int M, int N, int G_, int c_) { nM = M / BM; nN = N / BM; nwg = nM * nN; G = G_; c = c_; }
    __host__ __device__ bool next(int i, Unit& u) const {
        const long L = (long)i * G + c; if (L >= nwg) return false;
        int wgid = (int)L; { const int q = nwg / NXCD, r = nwg % NXCD, xcd = wgid % NXCD, off = wgid / NXCD; wgid = (xcd < r ? xcd * (q + 1) : r * (q + 1) + (xcd - r) * q) + off; }
        const int nig = WGM * nN, gid = wgid / nig, fm = gid * WGM, gsz = (nM - fm) < WGM ? (nM - fm) : WGM;
        u.pm = fm + ((wgid % nig) % gsz); u.pn = (wgid % nig) / gsz; u.gi = 0; return true;
    }
    __device__ __forceinline__ void a_ready(const Unit&) const {}
    __device__ __forceinline__ void done(const Unit&) const {}
};
template <int N0, int N1, int NN0, int NN1> struct PairOrder {
    int G, c;
    __host__ __device__ bool next(int i, Unit& u) const { const int L = i * G + c; if (L >= N0 + N1) return false;
        if (L < N0) { u.pm = L / NN0; u.pn = L % NN0; u.gi = 0; } else { const int q = L - N0; u.pm = q / NN1; u.pn = q % NN1; u.gi = 1; } return true; }
    __device__ __forceinline__ void a_ready(const Unit&) const {}
    __device__ __forceinline__ void done(const Unit&) const {}
};
template <int NB> struct BatchOrder : StaticOrder {
    __host__ __device__ bool next(int i, Unit& u) const { if (i >= NB) return false; if (!StaticOrder::next(0, u)) return false; u.gi = i; return true; }
};


#ifndef GAS
#define GAS __attribute__((address_space(1)))
#endif
typedef float f32x2v __attribute__((ext_vector_type(2)));
typedef __bf16 bf16x2v __attribute__((ext_vector_type(2)));
__device__ __forceinline__ unsigned cvt_pk_bf16(float lo, float hi) { const f32x2v v = {lo, hi}; const bf16x2v b = __builtin_convertvector(v, bf16x2v); return __builtin_bit_cast(unsigned, b); }
__device__ __forceinline__ float sigm(float x) { return __builtin_amdgcn_rcpf(1.f + __expf(-x)); }
#define EPI_FOR _Pragma("unroll") for (int ai = 0; ai < 2; ++ai) _Pragma("unroll") for (int m = 0; m < 4; ++m) _Pragma("unroll") for (int bj = 0; bj < 2; ++bj)

template <int ACT  > struct EpiStore {
    static constexpr bool PERM = true, AFTER_DRAIN = false;
    bf16_t* O; int ld;
    __device__ __forceinline__ void operator()(const f32x4 (&acc)[2][2][4][2], const Unit& u, int wr, int wc, int fr, int fq) const {
        const int row0 = u.pm * BM + wr * 64 + fr, col0 = u.pn * BM + wc * 32 + 8 * fq;
        EPI_FOR { f32x4 v0 = acc[ai][bj][m][0], v1 = acc[ai][bj][m][1];
            if (ACT == 1) { v0 = (f32x4){sigm(v0[0]), sigm(v0[1]), sigm(v0[2]), sigm(v0[3])}; v1 = (f32x4){sigm(v1[0]), sigm(v1[1]), sigm(v1[2]), sigm(v1[3])}; }
            u32x4 w; w.x = cvt_pk_bf16(v0[0], v0[1]); w.y = cvt_pk_bf16(v0[2], v0[3]); w.z = cvt_pk_bf16(v1[0], v1[1]); w.w = cvt_pk_bf16(v1[2], v1[3]);
            *(GAS u32x4*)(O + (size_t)(row0 + ai * HALF + m * 16) * ld + col0 + bj * HALF) = w; }
    }
};
struct EpiPair {
    static constexpr bool PERM = true, AFTER_DRAIN = false;
    bf16_t *O0, *O1; int ld0, ld1;
    __device__ __forceinline__ void operator()(const f32x4 (&acc)[2][2][4][2], const Unit& u, int wr, int wc, int fr, int fq) const {
        bf16_t* O = u.gi ? O1 : O0; const int ld = u.gi ? ld1 : ld0;
        const int row0 = u.pm * BM + wr * 64 + fr, col0 = u.pn * BM + wc * 32 + 8 * fq;
        EPI_FOR { const f32x4 v0 = acc[ai][bj][m][0], v1 = acc[ai][bj][m][1];
            u32x4 w; w.x = cvt_pk_bf16(v0[0], v0[1]); w.y = cvt_pk_bf16(v0[2], v0[3]); w.z = cvt_pk_bf16(v1[0], v1[1]); w.w = cvt_pk_bf16(v1[2], v1[3]);
            *(GAS u32x4*)(O + (size_t)(row0 + ai * HALF + m * 16) * ld + col0 + bj * HALF) = w; }
    }
};
struct EpiSeg {
    static constexpr bool PERM = true, AFTER_DRAIN = false;
    bf16_t *QA, *KV, *CQ, *CKV, *HY, *S0;
    __device__ __forceinline__ void operator()(const f32x4 (&acc)[2][2][4][2], const Unit& u, int wr, int wc, int fr, int fq) const {
        bf16_t* base; int ld, coff; const int pn = u.pn;
        if (pn < 2) { base = QA; ld = 512; coff = 256 * pn; } else if (pn == 2) { base = KV; ld = 256; coff = 0; } else if (pn < 5) { base = CQ; ld = 512; coff = 256 * (pn - 3); }
        else if (pn == 5) { base = CKV; ld = 256; coff = 0; } else if (pn < 12) { base = HY; ld = 1536; coff = 256 * (pn - 6); } else { base = S0; ld = 1024; coff = 256 * (pn - 12); }
        const bool gate = pn >= 12;
        const int row0 = u.pm * BM + wr * 64 + fr, col0 = coff + wc * 32 + 8 * fq;
        EPI_FOR { f32x4 v0 = acc[ai][bj][m][0], v1 = acc[ai][bj][m][1];
            if (gate) { v0 = (f32x4){sigm(v0[0]), sigm(v0[1]), sigm(v0[2]), sigm(v0[3])}; v1 = (f32x4){sigm(v1[0]), sigm(v1[1]), sigm(v1[2]), sigm(v1[3])}; }
            u32x4 w; w.x = cvt_pk_bf16(v0[0], v0[1]); w.y = cvt_pk_bf16(v0[2], v0[3]); w.z = cvt_pk_bf16(v1[0], v1[1]); w.w = cvt_pk_bf16(v1[2], v1[3]);
            *(GAS u32x4*)(base + (size_t)(row0 + ai * HALF + m * 16) * ld + col0 + bj * HALF) = w; }
    }
};
struct EpiGate {
    static constexpr bool PERM = true, AFTER_DRAIN = false;
    bf16_t* S0;
    __device__ __forceinline__ void operator()(const f32x4 (&acc)[2][2][4][2], const Unit& u, int wr, int wc, int fr, int fq) const {
        const int n = 1 + (u.pn >> 2); bf16_t* base = (bf16_t*)((unsigned char*)S0 - (size_t)((n + 1) >> 1) * (121u << 20) + (size_t)(n >> 1) * (24u << 20));
        const int row0 = u.pm * BM + wr * 64 + fr, col0 = (u.pn & 3) * BM + wc * 32 + 8 * fq;
        EPI_FOR { f32x4 v0 = acc[ai][bj][m][0], v1 = acc[ai][bj][m][1];
            v0 = (f32x4){sigm(v0[0]), sigm(v0[1]), sigm(v0[2]), sigm(v0[3])}; v1 = (f32x4){sigm(v1[0]), sigm(v1[1]), sigm(v1[2]), sigm(v1[3])};
            u32x4 w; w.x = cvt_pk_bf16(v0[0], v0[1]); w.y = cvt_pk_bf16(v0[2], v0[3]); w.z = cvt_pk_bf16(v1[0], v1[1]); w.w = cvt_pk_bf16(v1[2], v1[3]);
            *(GAS u32x4*)(base + (size_t)(row0 + ai * HALF + m * 16) * 1024 + col0 + bj * HALF) = w; }
    }
};
struct EpiMerge {
    static constexpr bool PERM = true, AFTER_DRAIN = false;
    const bf16_t* S0; bf16_t* M;
    __device__ __forceinline__ void operator()(const f32x4 (&acc)[2][2][4][2], const Unit& u, int wr, int wc, int fr, int fq) const {
        const int row0 = u.pm * BM + wr * 64 + fr, col0 = u.pn * BM + wc * 32 + 8 * fq;
        const int MODE = u.gi; const bf16_t* S = (const bf16_t*)((const unsigned char*)S0 - (size_t)((u.gi + 1) >> 1) * (121u << 20) + (size_t)(u.gi >> 1) * (24u << 20));
        EPI_FOR { const size_t off = (size_t)(row0 + ai * HALF + m * 16) * 1024 + col0 + bj * HALF;
            const u32x4 sw = *(const GAS u32x4*)(S + off);
            f32x4 s0 = (f32x4){__uint_as_float(sw.x << 16), __uint_as_float(sw.x & 0xffff0000u), __uint_as_float(sw.y << 16), __uint_as_float(sw.y & 0xffff0000u)};
            f32x4 s1 = (f32x4){__uint_as_float(sw.z << 16), __uint_as_float(sw.z & 0xffff0000u), __uint_as_float(sw.w << 16), __uint_as_float(sw.w & 0xffff0000u)};
            f32x4 v0 = acc[ai][bj][m][0] * s0, v1 = acc[ai][bj][m][1] * s1;
            if (MODE >= 1) { const u32x4 mw = *(const GAS u32x4*)(M + off);
                v0 = v0 + (f32x4){__uint_as_float(mw.x << 16), __uint_as_float(mw.x & 0xffff0000u), __uint_as_float(mw.y << 16), __uint_as_float(mw.y & 0xffff0000u)};
                v1 = v1 + (f32x4){__uint_as_float(mw.z << 16), __uint_as_float(mw.z & 0xffff0000u), __uint_as_float(mw.w << 16), __uint_as_float(mw.w & 0xffff0000u)}; }
            u32x4 w; w.x = cvt_pk_bf16(v0[0], v0[1]); w.y = cvt_pk_bf16(v0[2], v0[3]); w.z = cvt_pk_bf16(v1[0], v1[1]); w.w = cvt_pk_bf16(v1[2], v1[3]); *(GAS u32x4*)(M + off) = w; }
    }
};
struct EpiResid {
    static constexpr bool PERM = true, AFTER_DRAIN = false;
    float* X; const float* gate;
    __device__ __forceinline__ void operator()(const f32x4 (&acc)[2][2][4][2], const Unit& u, int wr, int wc, int fr, int fq) const {
        const int row0 = u.pm * BM + wr * 64 + fr, col0 = u.pn * BM + wc * 32 + 8 * fq;
        const int mrow = (u.pm < 16) ? 0 : 1 + ((u.pm - 16) >> 3);
        const float* gp = gate + (size_t)mrow * 6144 + col0;
        f32x4 g[2][2];
#pragma unroll
        for (int bj = 0; bj < 2; ++bj) { g[bj][0] = *(const GAS f32x4*)(gp + bj * HALF); g[bj][1] = *(const GAS f32x4*)(gp + bj * HALF + 4); }
        EPI_FOR { float* xp = X + (size_t)(row0 + ai * HALF + m * 16) * 1024 + col0 + bj * HALF;
            const f32x4 x0 = *(const GAS f32x4*)xp, x1 = *(const GAS f32x4*)(xp + 4);
            *(GAS f32x4*)xp = x0 + g[bj][0] * acc[ai][bj][m][0]; *(GAS f32x4*)(xp + 4) = x1 + g[bj][1] * acc[ai][bj][m][1]; }
    }
};

struct EpiResNorm {
    static constexpr bool PERM = true, AFTER_DRAIN = true;
    float* X; const float* gate; const float* nw; const float* modn; int shoff, scoff; bf16_t* H; float* slots; unsigned* cnt; int mode;
    __device__ __forceinline__ void fused(f32x4 (&acc)[2][2][4][2], const Unit& u, int wr, int wc, int fr, int fq, PG8_LAS unsigned char* lds, int wid, int lane) const {
        const int tid = wid * 64 + lane;
        const int row0 = u.pm * BM + wr * 64 + fr, col0 = u.pn * BM + wc * 32 + 8 * fq;
        const int mrow = (u.pm < 16) ? 0 : 1 + ((u.pm - 16) >> 3);
        PG8_LAS float* red = (PG8_LAS float*)lds;
        PG8_LAS float* rsv = (PG8_LAS float*)(lds + 8192);
        { const float* gp = gate + (size_t)mrow * 6144 + col0;
          f32x4 g[2][2];
#pragma unroll
          for (int bj = 0; bj < 2; ++bj) { g[bj][0] = *(const GAS f32x4*)(gp + bj * HALF); g[bj][1] = *(const GAS f32x4*)(gp + bj * HALF + 4); }
#pragma unroll
          for (int ai = 0; ai < 2; ++ai)
#pragma unroll
              for (int m = 0; m < 4; ++m) { float ss = 0.f;
#pragma unroll
                  for (int bj = 0; bj < 2; ++bj) { const float* xp = X + (size_t)(row0 + ai * HALF + m * 16) * 1024 + col0 + bj * HALF;
                      const f32x4 v0 = *(const GAS f32x4*)xp + g[bj][0] * acc[ai][bj][m][0], v1 = *(const GAS f32x4*)(xp + 4) + g[bj][1] * acc[ai][bj][m][1];
                      acc[ai][bj][m][0] = v0; acc[ai][bj][m][1] = v1;
                      ss += (v0[0] * v0[0] + v0[1] * v0[1]) + (v0[2] * v0[2] + v0[3] * v0[3]) + (v1[0] * v1[0] + v1[1] * v1[1]) + (v1[2] * v1[2] + v1[3] * v1[3]); }
                  ss += __shfl_xor(ss, 16); ss += __shfl_xor(ss, 32);
                  if (fq == 0) red[((wr * 4 + wc) * 8 + ai * 4 + m) * 16 + fr] = ss; } }
        __syncthreads();
        float* myslot = slots + (size_t)(u.pm * 4 + u.pn) * 256;
        if (tid < 256) { const int ai = tid >> 7, w2 = (tid >> 6) & 1, m = (tid >> 4) & 3, f = tid & 15;
            float t = 0.f;
#pragma unroll
            for (int c = 0; c < 4; ++c) t += red[((w2 * 4 + c) * 8 + ai * 4 + m) * 16 + f];
            __hip_atomic_store(myslot + tid, t, __ATOMIC_RELAXED, __HIP_MEMORY_SCOPE_AGENT); }
        asm volatile("s_waitcnt vmcnt(0)" ::: "memory");
        __syncthreads();
        unsigned* pc = cnt + (size_t)u.pm * 16;
        if (tid == 0) { __hip_atomic_fetch_add(pc, 1u, __ATOMIC_RELAXED, __HIP_MEMORY_SCOPE_AGENT);
            unsigned sp = 0; while (__hip_atomic_load(pc, __ATOMIC_RELAXED, __HIP_MEMORY_SCOPE_AGENT) < 4u && ++sp < (1u << 22)) __builtin_amdgcn_s_sleep(1); }
        __syncthreads();
        if (tid < 256) { float t = 0.f;
#pragma unroll
            for (int c = 0; c < 4; ++c) t += __hip_atomic_load(slots + (size_t)(u.pm * 4 + c) * 256 + tid, __ATOMIC_RELAXED, __HIP_MEMORY_SCOPE_AGENT);
            rsv[tid] = rsqrtf(t * (1.f / 1024.f) + 1e-6f); }
        __syncthreads();
        const float* wp = nw + col0; const float* mp = modn + (size_t)mrow * 6144 + col0;
#pragma unroll
        for (int ai = 0; ai < 2; ++ai)
#pragma unroll
            for (int m = 0; m < 4; ++m) { const float rs = rsv[ai * 128 + wr * 64 + m * 16 + fr];
#pragma unroll
                for (int bj = 0; bj < 2; ++bj) { const size_t off = (size_t)(row0 + ai * HALF + m * 16) * 1024 + col0 + bj * HALF;
                    const f32x4 v0 = acc[ai][bj][m][0], v1 = acc[ai][bj][m][1];
                    const f32x4 w0 = *(const GAS f32x4*)(wp + bj * HALF), w1 = *(const GAS f32x4*)(wp + bj * HALF + 4);
                    f32x4 y0 = v0 * rs * w0, y1 = v1 * rs * w1;
                    if (mode == 1) { *(GAS f32x4*)(X + off) = y0; *(GAS f32x4*)(X + off + 4) = y1; }
                    else { *(GAS f32x4*)(X + off) = v0; *(GAS f32x4*)(X + off + 4) = v1;
                        const f32x4 c0 = *(const GAS f32x4*)(mp + scoff + bj * HALF), c1 = *(const GAS f32x4*)(mp + scoff + bj * HALF + 4), h0 = *(const GAS f32x4*)(mp + shoff + bj * HALF), h1 = *(const GAS f32x4*)(mp + shoff + bj * HALF + 4);
                        y0 = y0 * (c0 + 1.f) + h0; y1 = y1 * (c1 + 1.f) + h1;
                        u32x4 w; w.x = cvt_pk_bf16(y0[0], y0[1]); w.y = cvt_pk_bf16(y0[2], y0[3]); w.z = cvt_pk_bf16(y1[0], y1[1]); w.w = cvt_pk_bf16(y1[2], y1[3]);
                        *(GAS u32x4*)(H + off) = w; } } }
    }
};

template <class Epi, class Sched, bool ALIGN_EPI = false, bool SP2 = false>
__device__ __forceinline__ void gemm_phase(PG8_LAS unsigned char* lds, const Gemm g, const Sched& S, const Epi& E) {
    int tid_l = threadIdx.x; asm volatile("" : "+v"(tid_l));
    const int tid = tid_l, wid = __builtin_amdgcn_readfirstlane(tid >> 6), lane = tid & 63, wr = wid >> 2, wc = wid & 3, fr = lane & 15, fq = lane >> 4;
    const int K = g.K, nt = K / BK;
    unsigned voffA[2], voffB[2];
#pragma unroll
    for (int i = 0; i < 2; ++i) { int R, C; stage_rc(tid * 16 + i * 8192, R, C); const int Rb = Epi::PERM ? ((R & ~31) + perm32(R & 31)) : R;
        voffA[i] = (unsigned)(R * g.lda + C) * 2u; voffB[i] = (unsigned)(Rb * g.ldb + C) * 2u; }
    const size_t kstep = (size_t)(BK * 2);
    const size_t hstepA = (size_t)HALF * g.lda * 2, hstepB = (size_t)HALF * g.ldb * 2;
    const size_t tstepA = 2 * hstepA, tstepB = 2 * hstepB;
    const unsigned ldsw = (unsigned)wid * 1024u;
    const int aoff = lds_byte(wr * 64 + fr, fq * 8), boff = lds_byte(wc * 32 + fr, fq * 8);
#define PG8_SA(b, h) (((b) * 2 + (h)) * HTB)
#define PG8_SB(b, h) ((4 + (b) * 2 + (h)) * HTB)
#define PG8_STAGE(bufoff, gbase, voff) do { _Pragma("unroll") for (int _i = 0; _i < 2; ++_i) \
        __builtin_amdgcn_global_load_lds((const unsigned*)((const char*)(gbase) + (voff)[_i]), (PG8_LAS unsigned*)(lds + (bufoff) + ldsw + _i * 8192), 16, 0, 0); } while (0)
#define PG8_LDA(dst, b, h) do { _Pragma("unroll") for (int m = 0; m < 4; ++m) _Pragma("unroll") for (int k = 0; k < 2; ++k) dst[m][k] = *(const PG8_LAS bf16x8*)(lds + PG8_SA(b, h) + aoff + m * 2048 + k * 1024); } while (0)
#define PG8_LDB(dst, b, h) do { _Pragma("unroll") for (int n = 0; n < 2; ++n) _Pragma("unroll") for (int k = 0; k < 2; ++k) dst[n][k] = *(const PG8_LAS bf16x8*)(lds + PG8_SB(b, h) + boff + n * 2048 + k * 1024); } while (0)
#define PG8_MMA(ai, bj, At, Bt) do { __builtin_amdgcn_s_setprio(1); _Pragma("unroll") for (int m = 0; m < 4; ++m) _Pragma("unroll") for (int n = 0; n < 2; ++n) _Pragma("unroll") for (int k = 0; k < 2; ++k) \
        acc[ai][bj][m][n] = __builtin_amdgcn_mfma_f32_16x16x32_bf16(Bt[n][k], At[m][k], acc[ai][bj][m][n], 0, 0, 0); __builtin_amdgcn_s_setprio(0); } while (0)
#define PG8_WAIT_V(n) asm volatile("s_waitcnt vmcnt(" #n ")" ::: "memory")
#define PG8_WAIT_L(n) asm volatile("s_waitcnt lgkmcnt(" #n ")" ::: "memory")
#define PG8_BAR __builtin_amdgcn_s_barrier()
#define PG8_SCHED __builtin_amdgcn_sched_barrier(0)
    Unit cur, nxt; int ui = 0;
    if (!S.next(0, cur)) return;
    f32x4 acc[2][2][4][2];
#pragma unroll
    for (int a = 0; a < 2; ++a)
#pragma unroll
        for (int b = 0; b < 2; ++b)
#pragma unroll
            for (int m = 0; m < 4; ++m)
#pragma unroll
                for (int n = 0; n < 2; ++n) acc[a][b][m][n] = (f32x4){0.f, 0.f, 0.f, 0.f};
    bf16x8 At[4][2], B0[2][2], B1[2][2];
    const char* cA = (const char*)g.A + (size_t)cur.gi * g.gsA + (size_t)cur.pm * tstepA; const char* cB = (const char*)g.Bt + (size_t)cur.gi * g.gsB + (size_t)cur.pn * tstepB;
    S.a_ready(cur);
    if constexpr (SP2) {
        PG8_STAGE(PG8_SB(0, 0), cB, voffB); PG8_STAGE(PG8_SB(0, 1), cB + hstepB, voffB); PG8_STAGE(PG8_SA(0, 0), cA, voffA); PG8_STAGE(PG8_SA(0, 1), cA + hstepA, voffA);
        if (wr == 1) PG8_BAR;
        PG8_WAIT_V(2); PG8_BAR;
        PG8_STAGE(PG8_SB(1, 0), cB + kstep, voffB); PG8_STAGE(PG8_SA(1, 0), cA + kstep, voffA); PG8_STAGE(PG8_SB(1, 1), cB + hstepB + kstep, voffB);
        PG8_WAIT_V(6); PG8_BAR;
    } else {
        PG8_STAGE(PG8_SB(0, 0), cB, voffB); PG8_STAGE(PG8_SA(0, 0), cA, voffA); PG8_STAGE(PG8_SB(0, 1), cB + hstepB, voffB); PG8_STAGE(PG8_SA(0, 1), cA + hstepA, voffA);
        if (wr == 1) PG8_BAR;
        PG8_WAIT_V(4); PG8_BAR;
        PG8_STAGE(PG8_SB(1, 0), cB + kstep, voffB); PG8_STAGE(PG8_SA(1, 0), cA + kstep, voffA); PG8_STAGE(PG8_SB(1, 1), cB + hstepB + kstep, voffB);
        PG8_WAIT_V(6); PG8_BAR;
    }
    for (;;) {
        const bool has_next = S.next(ui + 1, nxt);
        const char* nA = has_next ? (const char*)g.A + (size_t)nxt.gi * g.gsA + (size_t)nxt.pm * tstepA : cA; const char* nB = has_next ? (const char*)g.Bt + (size_t)nxt.gi * g.gsB + (size_t)nxt.pn * tstepB : cB;
        for (int t = 0; t < nt; t += 2) {
            const bool last = (t == nt - 2);
            const char* a1 = cA + (size_t)(t + 1) * kstep;
            const char* a2 = last ? nA : cA + (size_t)(t + 2) * kstep; const char* b2 = last ? nB : cB + (size_t)(t + 2) * kstep;
            const char* a3 = a2 + kstep; const char* b3 = b2 + kstep;
            if (last && has_next) S.a_ready(nxt);
            if constexpr (SP2) {
            PG8_LDB(B0, 0, 0); PG8_LDB(B1, 0, 1); PG8_SCHED; PG8_LDA(At, 0, 0); PG8_STAGE(PG8_SA(1, 1), a1 + hstepA, voffA);
            PG8_WAIT_V(8); PG8_WAIT_L(0); PG8_BAR; PG8_MMA(0, 0, At, B0); PG8_MMA(0, 1, At, B1); PG8_BAR; PG8_SCHED;
            PG8_LDA(At, 0, 1); PG8_STAGE(PG8_SB(0, 0), b2, voffB); PG8_STAGE(PG8_SB(0, 1), b2 + hstepB, voffB); PG8_STAGE(PG8_SA(0, 0), a2, voffA);
            PG8_WAIT_V(8); PG8_WAIT_L(0); PG8_BAR; PG8_MMA(1, 0, At, B0); PG8_MMA(1, 1, At, B1); PG8_BAR; PG8_SCHED;
            PG8_LDB(B0, 1, 0); PG8_LDB(B1, 1, 1); PG8_SCHED; PG8_LDA(At, 1, 0); PG8_STAGE(PG8_SA(0, 1), a2 + hstepA, voffA);
            PG8_WAIT_V(8); PG8_WAIT_L(0); PG8_BAR; PG8_MMA(0, 0, At, B0); PG8_MMA(0, 1, At, B1); PG8_BAR; PG8_SCHED;
            PG8_LDA(At, 1, 1); PG8_STAGE(PG8_SB(1, 0), b3, voffB); PG8_STAGE(PG8_SB(1, 1), b3 + hstepB, voffB); PG8_STAGE(PG8_SA(1, 0), a3, voffA);
            PG8_WAIT_V(8); PG8_WAIT_L(0); PG8_BAR; PG8_MMA(1, 0, At, B0); PG8_MMA(1, 1, At, B1); PG8_BAR; PG8_SCHED;
            } else {
            PG8_LDB(B0, 0, 0); PG8_SCHED; PG8_LDA(At, 0, 0); PG8_STAGE(PG8_SA(1, 1), a1 + hstepA, voffA);
            PG8_WAIT_L(8); PG8_BAR; PG8_WAIT_L(0); PG8_MMA(0, 0, At, B0); PG8_BAR; PG8_SCHED;
            PG8_LDB(B1, 0, 1); PG8_STAGE(PG8_SB(0, 0), b2, voffB);
            PG8_BAR; PG8_WAIT_L(0); PG8_MMA(0, 1, At, B1); PG8_BAR;
            PG8_LDA(At, 0, 1); PG8_STAGE(PG8_SA(0, 0), a2, voffA);
            PG8_BAR; PG8_WAIT_L(0); PG8_MMA(1, 0, At, B0); PG8_BAR; PG8_SCHED;
            PG8_STAGE(PG8_SB(0, 1), b2 + hstepB, voffB);
            PG8_WAIT_V(6); PG8_BAR; PG8_MMA(1, 1, At, B1); PG8_BAR;
            PG8_LDB(B0, 1, 0); PG8_SCHED; PG8_LDA(At, 1, 0); PG8_STAGE(PG8_SA(0, 1), a2 + hstepA, voffA);
            PG8_WAIT_L(8); PG8_BAR; PG8_WAIT_L(0); PG8_MMA(0, 0, At, B0); PG8_BAR; PG8_SCHED;
            PG8_LDB(B1, 1, 1); PG8_STAGE(PG8_SB(1, 0), b3, voffB);
            PG8_BAR; PG8_WAIT_L(0); PG8_MMA(0, 1, At, B1); PG8_BAR;
            PG8_LDA(At, 1, 1); PG8_STAGE(PG8_SA(1, 0), a3, voffA);
            PG8_BAR; PG8_WAIT_L(0); PG8_MMA(1, 0, At, B0); PG8_BAR; PG8_SCHED;
            PG8_STAGE(PG8_SB(1, 1), b3 + hstepB, voffB);
            PG8_WAIT_V(6); PG8_BAR; PG8_MMA(1, 1, At, B1); PG8_BAR;
            }
        }
        if constexpr (ALIGN_EPI) { if (wr == 0) PG8_BAR; }
        if constexpr (!Epi::AFTER_DRAIN) { E(acc, cur, wr, wc, fr, fq); S.done(cur); }
        if (!has_next) break;
#pragma unroll
        for (int a = 0; a < 2; ++a)
#pragma unroll
            for (int b = 0; b < 2; ++b)
#pragma unroll
                for (int m = 0; m < 4; ++m)
#pragma unroll
                    for (int n = 0; n < 2; ++n) acc[a][b][m][n] = (f32x4){0.f, 0.f, 0.f, 0.f};
        cur = nxt; cA = nA; cB = nB; ++ui;
        if constexpr (ALIGN_EPI) { if (wr == 1) PG8_BAR; }
    }
    PG8_WAIT_V(0);
    if constexpr (!ALIGN_EPI) { if (wr == 0) PG8_BAR; }
    PG8_BAR;
    if constexpr (Epi::AFTER_DRAIN) { E.fused(acc, cur, wr, wc, fr, fq, lds, wid, lane); S.done(cur); }
#undef PG8_SA
#undef PG8_SB
#undef PG8_STAGE
#undef PG8_LDA
#undef PG8_LDB
#undef PG8_MMA
#undef PG8_WAIT_V
#undef PG8_WAIT_L
#undef PG8_BAR
#undef PG8_SCHED
}
}

constexpr int TCTX = 4096, TLAT = 8192, TT = 12288, DM = 1024, NKEYROWS = 13312;
constexpr float EPSN = 1e-6f;
constexpr size_t MiB = 1u << 20;
constexpr size_t WS_MOD = 0, MOD_BYTES = 2 * 5 * 6144 * 4, WS_BAR = 262144, BAR_REGION = 16384, ZERO_BYTES = WS_BAR + 5 * BAR_REGION;
constexpr size_t WS_CNT = 245760  , WS_SLOT = 2 * MiB + 262144  ;
constexpr size_t WS_HID = 1 * MiB;
constexpr size_t WS_WIN = 3 * MiB  , WS_WG = 11 * MiB  , WS_WUQ = 15 * MiB, WS_WKN = 16 * MiB, WS_WVV = 16 * MiB + 262144, WS_WB = 17 * MiB, WS_WO = 20 * MiB, WS_WUP = 22 * MiB, WS_WDN = 33 * MiB;
constexpr size_t WS_U = 39 * MiB, WS_ACT = 171 * MiB, WS_HBF = 171 * MiB  , WS_HBF1 = 165 * MiB  ;
constexpr size_t WS_QA = 39 * MiB, WS_KVR = 51 * MiB, WS_CQ = 57 * MiB, WS_CKVR = 69 * MiB, WS_HYR = 75 * MiB, WS_OA = 75 * MiB, WS_OB = 87 * MiB, WS_OC = 99 * MiB;
constexpr size_t WS_UT = 111 * MiB, WS_QB = 147 * MiB, WS_CKVALL = 189 * MiB, WS_KPEALL = 196 * MiB, WS_KNB = 197 * MiB, WS_VTB = 210 * MiB, WS_KA = 223 * MiB, WS_VTA = 227 * MiB;
constexpr size_t WS_S0 = 232 * MiB  , WS_S1 = 111 * MiB, WS_S2 = 135 * MiB, WS_MBF = 195 * MiB, WS_END = 256 * MiB;
constexpr int KA_LAT = 16 * 2 * 256 * 64;
constexpr int UT_LAT = 16 * 1536 * 256;
constexpr int OUT_K = 12582912, OUT_V = 13631488, OUT_CKV = 14680064, OUT_KPE = 16777216;
constexpr int LDS_BYTES = 147456;
constexpr int NPHASE = 24;

#ifndef GAS
#define GAS __attribute__((address_space(1)))
#endif
#define LAS __attribute__((address_space(3)))
typedef unsigned short bf16;
typedef unsigned v4u __attribute__((ext_vector_type(4)));
typedef unsigned v2u __attribute__((ext_vector_type(2)));
typedef float f32x4 __attribute__((ext_vector_type(4)));
typedef float f32x16 __attribute__((ext_vector_type(16)));
typedef short bf16x8 __attribute__((ext_vector_type(8)));
typedef short bf16x4 __attribute__((ext_vector_type(4)));
#define LDS_WAIT() asm volatile("s_waitcnt lgkmcnt(0)" ::: "memory")
__device__ __forceinline__ unsigned f2bf(float f) { unsigned u = __builtin_bit_cast(unsigned, f); return (u + 0x7fffu + ((u >> 16) & 1u)) >> 16; }
__device__ __forceinline__ unsigned pk2(float lo, float hi) { return f2bf(lo) | (f2bf(hi) << 16); }
__device__ __forceinline__ float bflo(unsigned w) { return __uint_as_float(w << 16); }
__device__ __forceinline__ float bfhi(unsigned w) { return __uint_as_float(w & 0xffff0000u); }
__device__ __forceinline__ float bf1(bf16 b) { return __uint_as_float(((unsigned)b) << 16); }
__device__ __forceinline__ void fsincos(float x, float& s, float& c) { float rev = x * 0.15915494309189535f; rev = rev - rintf(rev); s = __builtin_amdgcn_sinf(rev); c = __builtin_amdgcn_cosf(rev); }
__device__ __forceinline__ float fsin(float x) { float rev = x * 0.15915494309189535f; rev = rev - rintf(rev); return __builtin_amdgcn_sinf(rev); }
__device__ __forceinline__ float wave_sum(float v) {
#pragma unroll
    for (int o = 1; o < 64; o <<= 1) v += __shfl_xor(v, o);
    return v;
}
__device__ __forceinline__ void rope2(float& x0, float& x1, float ang) { float s, c; fsincos(ang, s, c); const float a = x0 * c - x1 * s, b = x0 * s + x1 * c; x0 = a; x1 = b; }
#define L2_10000 13.287712379549449f

__device__ __forceinline__ void transpose_item(const float* W, size_t ldw, int k0, int n0, bf16* WT, size_t ldt, int drow0, LAS float* scr, int lane) {
    float wv[32];
#pragma unroll
    for (int i = 0; i < 32; ++i) wv[i] = ((const GAS float*)W)[(size_t)(k0 + 2 * i + (lane >> 5)) * ldw + n0 + (lane & 31)];
#pragma unroll
    for (int i = 0; i < 32; ++i) scr[(2 * i + (lane >> 5)) * 33 + (lane & 31)] = wv[i];
    LDS_WAIT(); asm volatile("" ::: "memory");
    const int c = lane & 7;
#pragma unroll
    for (int j = 0; j < 4; ++j) { const int n = (lane >> 3) + 8 * j; const LAS float* s = scr + (8 * c) * 33 + n;
        v4u o; o.x = pk2(s[0 * 33], s[1 * 33]); o.y = pk2(s[2 * 33], s[3 * 33]); o.z = pk2(s[4 * 33], s[5 * 33]); o.w = pk2(s[6 * 33], s[7 * 33]);
        *(GAS v4u*)(WT + (size_t)(drow0 + n) * ldt + k0 + 8 * c) = o; }
    LDS_WAIT(); asm volatile("" ::: "memory");
}

#define XB_TMO      128
#define XB_XCNT(j)  (256  + 64 * (j))
#define XB_XSUB(j)  (1280 + 64 * (j))
#define XB_XGEN(j)  (2304 + 64 * (j))
#define XB_TOP      3328
#define XB_TOPGEN   3392
#define XCD_BAR_WORDS 3456
#define XB_SPIN_CAP (1u << 18)

__device__ __forceinline__ unsigned xb_ld(unsigned* p)              { return __hip_atomic_load(p, __ATOMIC_RELAXED, __HIP_MEMORY_SCOPE_AGENT); }
__device__ __forceinline__ unsigned xb_add(unsigned* p, unsigned v) { return __hip_atomic_fetch_add(p, v, __ATOMIC_RELAXED, __HIP_MEMORY_SCOPE_AGENT); }
__device__ __forceinline__ unsigned xb_xcc_id() { return (unsigned)__builtin_amdgcn_s_getreg((3 << 11) | 20) & 0xFu; }
#define XB_SPIN(cond, bar) do { unsigned _sp = 0; while (cond) { __builtin_amdgcn_s_sleep(1); \
    if ((++_sp & 255u) == 0u) { if (xb_ld(&(bar)[XB_TMO])) break; if (_sp > XB_SPIN_CAP) { atomicAdd(&(bar)[XB_TMO], 1u); break; } } } } while (0)

struct XcdBarrier {
    unsigned* bar; unsigned x;
    volatile LAS unsigned* st;
};

__device__ __forceinline__ XcdBarrier xcd_barrier_post(unsigned* bar, volatile LAS unsigned* st) {
    XcdBarrier b; b.bar = bar; b.x = xb_xcc_id(); b.st = st;
    if (threadIdx.x == 0) (void)xb_add(&bar[XB_XCNT(b.x)], 1u);
    return b;
}
__device__ __forceinline__ void xcd_barrier_complete(unsigned* bar, unsigned x, unsigned& nloc, unsigned& nx) {
    const unsigned G = gridDim.x * gridDim.y * gridDim.z;
    unsigned sum, cnt, mine, sp = 0u;
    for (;;) {
        sum = 0u; cnt = 0u; mine = 0u;
#pragma unroll
        for (unsigned j = 0; j < 16; ++j) { const unsigned c = xb_ld(&bar[XB_XCNT(j)]); sum += c; cnt += (c > 0u) ? 1u : 0u; mine = (j == x) ? c : mine; }
        if (sum == G) break;
        __builtin_amdgcn_s_sleep(1);
        if ((++sp & 255u) == 0u) { if (xb_ld(&bar[XB_TMO])) break; if (sp > XB_SPIN_CAP) { atomicAdd(&bar[XB_TMO], 1u); break; } }
    }
    nloc = mine > 0u ? mine : 1u; nx = cnt > 0u ? cnt : 1u;
}

__device__ __forceinline__ void xcd_barrier(const XcdBarrier& b) {
    asm volatile("s_waitcnt vmcnt(0)" ::: "memory");
    __syncthreads();
    if (threadIdx.x == 0) {
        unsigned* bar = b.bar;
        __builtin_amdgcn_s_waitcnt(0);
        unsigned nloc = b.st[0], nx = b.st[1];
        if (nloc == 0u) { xcd_barrier_complete(bar, b.x, nloc, nx); b.st[0] = nloc; b.st[1] = nx; }
        const unsigned old = xb_add(&bar[XB_XSUB(b.x)], 1u);
        const unsigned gen = old / nloc;
        if (old + 1u == (gen + 1u) * nloc) {
            __builtin_amdgcn_fence(__ATOMIC_RELEASE, "agent");
            asm volatile("s_waitcnt vmcnt(0)" ::: "memory");
            const unsigned og = xb_add(&bar[XB_TOP], 1u);
            const unsigned tg = og / nx;
            if (og + 1u == (tg + 1u) * nx) xb_add(&bar[XB_TOPGEN], 1u);
            else XB_SPIN(xb_ld(&bar[XB_TOPGEN]) == tg, bar);
            __builtin_amdgcn_fence(__ATOMIC_ACQUIRE, "agent");
            xb_add(&bar[XB_XGEN(b.x)], 1u);
            asm volatile("s_waitcnt vmcnt(0)" ::: "memory");
        } else {
            XB_SPIN(xb_ld(&bar[XB_XGEN(b.x)]) == gen, bar);
            __builtin_amdgcn_fence(__ATOMIC_ACQUIRE, "agent");
            asm volatile("s_waitcnt vmcnt(0)" ::: "memory");
        }
    }
    __syncthreads();
}


struct Args { const float* in[35]; float* out; unsigned char* ws; int ph_lo, ph_hi, li, pad; };

__device__ __forceinline__ void wconv_phase(const Args& a, int l, int part, LAS unsigned char* lds, int gw, int NGW, int gt, int NGT, int wave, int lane) {
    LAS float* scr = (LAS float*)(lds + wave * 16384);
    unsigned char* ws = a.ws;
    bf16 *WIN = (bf16*)(ws + WS_WIN), *WG = (bf16*)(ws + WS_WG), *WUQ = (bf16*)(ws + WS_WUQ), *WKN = (bf16*)(ws + WS_WKN), *WVV = (bf16*)(ws + WS_WVV), *WB = (bf16*)(ws + WS_WB), *WO = (bf16*)(ws + WS_WO), *WUP = (bf16*)(ws + WS_WUP), *WDN = (bf16*)(ws + WS_WDN);
    constexpr int I1 = 16 * 189, I2 = 6 * 24, I3 = 4 * 32, I4 = 3 * 8 * 32, I5 = 16 * 32, I6 = 16 * 176, I7 = 44 * 32, NIT = I1 + I2 + I3 + I4 + I5 + I6 + I7;
    const int it_lo = (part == 2) ? NIT - I7 : 0, it_hi = (part == 1) ? NIT - I7 : NIT;
    for (int it = it_lo + gw; it < it_hi; it += NGW) {
        int r = it;
        if (r < I1) { const int kb = r / 189, n0 = 32 * (r % 189); bf16* dst = WIN; int drow;
            if (n0 < 1152) drow = n0; else if (n0 < 1408) drow = n0 + 128; else if (n0 < 1440) drow = 1152 + (n0 - 1408); else if (n0 < 2976) drow = 1536 + (n0 - 1440); else if (n0 < 4000) drow = 3072 + (n0 - 2976); else { dst = WG; drow = n0 - 4000; }
            transpose_item(a.in[12] + (size_t)l * 1024 * 6048, 6048, 64 * kb, n0, dst, 1024, drow, scr, lane); continue; } r -= I1;
        if (r < I2) { const int kb = r / 24, n0 = 32 * (r % 24); transpose_item(a.in[17] + (size_t)l * 384 * 768, 768, 64 * kb, n0, WUQ, 384, n0, scr, lane); continue; } r -= I2;
        if (r < I3) { const int kb = r / 32, n0 = 32 * (r % 32); const int h = n0 >> 7, c0 = n0 & 127;
            transpose_item(a.in[18] + (size_t)l * 256 * 1024, 1024, 64 * kb, n0, (c0 < 64) ? WKN : WVV, 256, h * 64 + (c0 & 63), scr, lane); continue; } r -= I3;
        if (r < I4) { const int n = r / 256, q = r % 256, kb = q / 32, n0 = 32 * (q % 32);
            transpose_item(a.in[28] + ((size_t)l * 3 + n) * 512 * 1024, 1024, 64 * kb, n0, WB + (size_t)n * 1024 * 512, 512, n0, scr, lane); continue; } r -= I4;
        if (r < I5) { const int kb = r / 32, n0 = 32 * (r % 32); transpose_item(a.in[29] + (size_t)l * 1024 * 1024, 1024, 64 * kb, n0, WO, 1024, n0, scr, lane); continue; } r -= I5;
        if (r < I6) { const int kb = r / 176, n0 = 32 * (r % 176); transpose_item(a.in[30] + (size_t)l * 1024 * 5632, 5632, 64 * kb, n0, WUP, 1024, n0, scr, lane); continue; } r -= I6;
        { const int kb = r / 32, n0 = 32 * (r % 32); transpose_item(a.in[33] + (size_t)l * 2816 * 1024, 1024, 64 * kb, n0, WDN, 2816, n0, scr, lane); }
    }
    if (part != 2) for (int i = gt; i < 96 * 1024 / 8; i += NGT) *(GAS v4u*)(WIN + (size_t)1184 * 1024 + (size_t)i * 8) = (v4u){0u, 0u, 0u, 0u};
}

__device__ __forceinline__ void norm_phase(const Args& a, int l, int which, bool first, int gw, int NGW, int lane) {
    const GAS float* mod = (const GAS float*)(a.ws + WS_MOD) + (size_t)l * 5 * 6144;
    GAS bf16* HBF = (GAS bf16*)(a.ws + (which == 0 ? WS_HBF1 : WS_HBF));
    const GAS float* gv = (const GAS float*)((which == 0) ? a.in[10] + l * 1024 : (which == 1) ? a.in[11] + l * 1024 : a.in[34]);
    GAS float* outp = (GAS float*)a.out;
    const int shoff = (which == 0) ? 0 : 3072, scoff = shoff + 1024;
    #pragma unroll 1
    for (int row0 = gw; row0 < TT; row0 += 4 * NGW) {
        f32x4 v[4][4];
#pragma unroll
        for (int q = 0; q < 4; ++q) { const int row = row0 + q * NGW; const int rr = row < TT ? row : row0;
            const GAS float* src = first ? (const GAS float*)(rr < TCTX ? a.in[0] + (size_t)rr * DM : a.in[1] + (size_t)(rr - TCTX) * DM) : (const GAS float*)(outp + (size_t)rr * DM);
#pragma unroll
            for (int j = 0; j < 4; ++j) v[q][j] = *(const GAS f32x4*)(src + 4 * lane + 256 * j); }
#pragma unroll
        for (int q = 0; q < 4; ++q) { const int row = row0 + q * NGW; if (row >= TT) continue;
            float ss = 0.f;
#pragma unroll
            for (int j = 0; j < 4; ++j) ss += (v[q][j].x * v[q][j].x + v[q][j].y * v[q][j].y) + (v[q][j].z * v[q][j].z + v[q][j].w * v[q][j].w);
            if (first) {
#pragma unroll
                for (int j = 0; j < 4; ++j) *(GAS f32x4*)(outp + (size_t)row * DM + 4 * lane + 256 * j) = v[q][j]; }
            const float rs = rsqrtf(wave_sum(ss) * (1.f / DM) + EPSN);
            const int mrow = row < TCTX ? 0 : 1 + ((row - TCTX) >> 11);
            const GAS float* mp = mod + (size_t)mrow * 6144;
#pragma unroll
            for (int j = 0; j < 4; ++j) { const int col = 4 * lane + 256 * j; const f32x4 g = *(const GAS f32x4*)(gv + col);
                if (which == 2) { *(GAS f32x4*)(outp + (size_t)row * DM + col) = v[q][j] * rs * g; }
                else { const f32x4 sc = *(const GAS f32x4*)(mp + scoff + col), sh = *(const GAS f32x4*)(mp + shoff + col);
                    const f32x4 y = v[q][j] * rs * g * (sc + 1.f) + sh;
                    *(GAS v2u*)(HBF + (size_t)row * DM + col) = (v2u){pk2(y.x, y.y), pk2(y.z, y.w)}; } } }
    }
}
__device__ __forceinline__ void p0_mod_hid(const Args& a, LAS unsigned char* lds, int bid, int G, int tid, int gw, int NGW, int lane) {
    float* mod = (float*)(a.ws + WS_MOD);
    LAS float* sc = (LAS float*)lds;
    for (int it = bid; it < 384; it += G) {
        const int l = it / 192, rem = it % 192, kc = rem / 12, jb = rem % 12;
        if (tid < 320) { const int r = tid >> 6, kk = tid & 63, k = kc * 64 + kk; const float cv = (r == 0) ? a.in[7][k] : a.in[6][(r - 1) * 1024 + k]; sc[tid] = cv / (1.f + __expf(-cv)); }
        __syncthreads();
        const int j = jb * 512 + tid;
        const GAS float* wp = (const GAS float*)(a.in[8] + ((size_t)l * 1024 + kc * 64) * 6144 + j);
        float acc[5] = {0.f, 0.f, 0.f, 0.f, 0.f};
#pragma unroll 8
        for (int kk = 0; kk < 64; ++kk) { const float w = wp[(size_t)kk * 6144];
#pragma unroll
            for (int r = 0; r < 5; ++r) acc[r] += sc[r * 64 + kk] * w; }
        const float bias = (kc == 0) ? a.in[9][l * 6144 + j] : 0.f;
#pragma unroll
        for (int r = 0; r < 5; ++r) atomicAdd(mod + (size_t)(l * 5 + r) * 6144 + j, acc[r] + bias);
        __syncthreads();
    }
    float* HID = (float*)(a.ws + WS_HID);
    for (int it = gw; it < 2 * 2304; it += NGW) {
        const int l = it / 2304, q = it % 2304; const int L = q < 256 ? 256 : 2048, t = q < 256 ? q : q - 256;
        const float tn = (float)t / (float)(L - 1);
        float zi = 0.f;
        if (lane == 0) zi = tn;
        else if (lane <= 16) { const int bi = (lane - 1) & 7; const float band = 1e-4f + (float)bi * ((7.f - 1e-4f) / 7.f); const float ang = (6.283185307179586f / (float)L) * (float)t * band; float s, c; fsincos(ang, s, c); zi = (lane <= 8) ? c : -s; }
        float s1 = a.in[22][l * 64 + lane];
#pragma unroll
        for (int i = 0; i < 17; ++i) s1 += __shfl(zi, i) * a.in[21][(l * 17 + i) * 64 + lane];
        const float h1 = fsin(a.in[26][(l * 2 + 0) * 64 + lane] * s1);
        float s2 = a.in[24][l * 64 + lane];
#pragma unroll 8
        for (int i = 0; i < 64; ++i) s2 += __shfl(h1, i) * a.in[23][(l * 64 + i) * 64 + lane];
        HID[(size_t)it * 64 + lane] = fsin(a.in[26][(l * 2 + 1) * 64 + lane] * s2);
    }
}

__device__ __forceinline__ void post_phase(const Args& a, int l, LAS unsigned char* lds, int bid, int G, int tid, int gw, int NGW, int gt, int NGT, int lane) {
    unsigned char* ws = a.ws;
    GAS bf16 *QA = (GAS bf16*)(ws + WS_QA), *KVR = (GAS bf16*)(ws + WS_KVR), *CQ = (GAS bf16*)(ws + WS_CQ), *CKVR = (GAS bf16*)(ws + WS_CKVR), *HYR = (GAS bf16*)(ws + WS_HYR);
    GAS bf16 *UT = (GAS bf16*)(ws + WS_UT), *CKVALL = (GAS bf16*)(ws + WS_CKVALL), *KPEALL = (GAS bf16*)(ws + WS_KPEALL), *KA = (GAS bf16*)(ws + WS_KA), *VTA = (GAS bf16*)(ws + WS_VTA);
    GAS float* outp = (GAS float*)a.out;
    if (l == 1 && G == 256) { wconv_phase(a, 1, 2, lds, gw, NGW, gt, NGT, tid >> 6, lane); __syncthreads(); }
    for (int i = gt; i < 4 * 256 * 128; i += NGT) { const int b = i >> 15, p = (i >> 7) & 255, kvh = (i >> 6) & 1, d = i & 63;
        const size_t s = ((size_t)(b * 2 + l) * 256 + p) * 128 + kvh * 64 + d;
        KA[KA_LAT + ((b * 2 + kvh) * 2304 + p) * 64 + d] = (bf16)f2bf(a.in[2][s]);
        VTA[KA_LAT + ((b * 2 + kvh) * 64 + d) * 2304 + p] = (bf16)f2bf(a.in[3][s]); }
    for (int i = gt; i < 4 * 256 * 256; i += NGT) { const int b = i >> 16, p = (i >> 8) & 255, j = i & 255;
        CKVALL[(size_t)(TCTX + b * 2304 + p) * 256 + j] = (bf16)f2bf(a.in[4][((size_t)(b * 2 + l) * 256 + p) * 256 + j]); }
    for (int i = gt; i < 4 * 256 * 32; i += NGT) { const int b = i >> 13, p = (i >> 5) & 255, j = i & 31;
        KPEALL[(size_t)(TCTX + b * 2304 + p) * 32 + j] = (bf16)f2bf(a.in[5][((size_t)(b * 2 + l) * 256 + p) * 32 + j]); }
    const GAS float *gq = (const GAS float*)(a.in[13] + l * 64), *gk = (const GAS float*)(a.in[14] + l * 64), *gcq = (const GAS float*)(a.in[15] + l * 384), *gkv = (const GAS float*)(a.in[16] + l * 256);
    for (int row = gw; row < TT; row += NGW) {
        const bool lat = row >= TCTX;
        const int b = lat ? (row - TCTX) >> 11 : row >> 8, t = lat ? (row - TCTX) & 2047 : row & 255;
        const float grow = (float)(t >> 6), gcol = (float)(t & 63);
        const int keyrow = lat ? TCTX + b * 2304 + 256 + t : row;
        { v4u w = *(const GAS v4u*)(QA + (size_t)row * 512 + 8 * lane);
          float x[8] = {bflo(w.x), bfhi(w.x), bflo(w.y), bfhi(w.y), bflo(w.z), bfhi(w.z), bflo(w.w), bfhi(w.w)};
          float ss = 0.f;
#pragma unroll
          for (int j = 0; j < 8; ++j) ss += x[j] * x[j];
          ss += __shfl_xor(ss, 1); ss += __shfl_xor(ss, 2); ss += __shfl_xor(ss, 4);
          const float rs = rsqrtf(ss * (1.f / 64.f) + EPSN); const int d0 = 8 * (lane & 7);
#pragma unroll
          for (int j = 0; j < 8; ++j) x[j] = x[j] * rs * gq[d0 + j];
          if (lat) {
#pragma unroll
              for (int k = 0; k < 4; ++k) { const int i = 4 * (lane & 7) + k; const float inv = __builtin_amdgcn_exp2f(-(float)(i & 15) * (L2_10000 / 16.f)); rope2(x[2 * k], x[2 * k + 1], (i < 16 ? grow : gcol) * inv); } }
          *(GAS v4u*)(QA + (size_t)row * 512 + 8 * lane) = (v4u){pk2(x[0], x[1]), pk2(x[2], x[3]), pk2(x[4], x[5]), pk2(x[6], x[7])}; }
        { const v2u w = *(const GAS v2u*)(KVR + (size_t)row * 256 + 4 * lane);
          float x[4] = {bflo(w.x), bfhi(w.x), bflo(w.y), bfhi(w.y)};
          float ss = (x[0] * x[0] + x[1] * x[1]) + (x[2] * x[2] + x[3] * x[3]);
          ss += __shfl_xor(ss, 1); ss += __shfl_xor(ss, 2); ss += __shfl_xor(ss, 4); ss += __shfl_xor(ss, 8);
          const int kvh = (lane >> 4) & 1, d0 = 4 * (lane & 15);
          if (lane < 32) {
              const float rs = rsqrtf(ss * (1.f / 64.f) + EPSN);
#pragma unroll
              for (int j = 0; j < 4; ++j) x[j] = x[j] * rs * gk[d0 + j];
              if (!lat) { *(GAS f32x4*)(outp + OUT_K + ((size_t)(b * 2 + l) * 256 + t) * 128 + kvh * 64 + d0) = (f32x4){x[0], x[1], x[2], x[3]};
                  *(GAS v2u*)(KA + ((size_t)(b * 2 + kvh) * 256 + t) * 64 + d0) = (v2u){pk2(x[0], x[1]), pk2(x[2], x[3])}; }
              else {
#pragma unroll
                  for (int k = 0; k < 2; ++k) { const int i = 2 * (lane & 15) + k; const float inv = __builtin_amdgcn_exp2f(-(float)(i & 15) * (L2_10000 / 16.f)); rope2(x[2 * k], x[2 * k + 1], (i < 16 ? grow : gcol) * inv); }
                  *(GAS v2u*)(KA + KA_LAT + ((size_t)(b * 2 + kvh) * 2304 + 256 + t) * 64 + d0) = (v2u){pk2(x[0], x[1]), pk2(x[2], x[3])}; }
          } else {
              if (!lat) { *(GAS f32x4*)(outp + OUT_V + ((size_t)(b * 2 + l) * 256 + t) * 128 + kvh * 64 + d0) = (f32x4){x[0], x[1], x[2], x[3]};
#pragma unroll
                  for (int j = 0; j < 4; ++j) VTA[((size_t)(b * 2 + kvh) * 64 + d0 + j) * 256 + t] = (bf16)f2bf(x[j]); }
              else {
#pragma unroll
                  for (int j = 0; j < 4; ++j) VTA[KA_LAT + ((size_t)(b * 2 + kvh) * 64 + d0 + j) * 2304 + 256 + t] = (bf16)f2bf(x[j]); }
          } }
        { GAS unsigned* p = (GAS unsigned*)(CQ + (size_t)row * 512 + 6 * lane);
          const unsigned w0 = p[0], w1 = p[1], w2 = p[2];
          float x[6] = {bflo(w0), bfhi(w0), bflo(w1), bfhi(w1), bflo(w2), bfhi(w2)};
          float ss = 0.f;
#pragma unroll
          for (int j = 0; j < 6; ++j) ss += x[j] * x[j];
          const float rs = rsqrtf(wave_sum(ss) * (1.f / 384.f) + EPSN);
#pragma unroll
          for (int j = 0; j < 6; ++j) x[j] = x[j] * rs * gcq[6 * lane + j];
          p[0] = pk2(x[0], x[1]); p[1] = pk2(x[2], x[3]); p[2] = pk2(x[4], x[5]);
          if (lane < 16) { const unsigned w = *(const GAS unsigned*)(CQ + (size_t)row * 512 + 384 + 2 * lane); float y0 = bflo(w), y1 = bfhi(w);
              if (!lat) { outp[OUT_KPE + ((size_t)(b * 2 + l) * 256 + t) * 32 + 2 * lane] = y0; outp[OUT_KPE + ((size_t)(b * 2 + l) * 256 + t) * 32 + 2 * lane + 1] = y1; }
              else { const float inv = __builtin_amdgcn_exp2f(-(float)(lane & 7) * (L2_10000 / 8.f)); rope2(y0, y1, (lane < 8 ? grow : gcol) * inv); }
              *(GAS unsigned*)(KPEALL + (size_t)keyrow * 32 + 2 * lane) = pk2(y0, y1); } }
        { const v2u w = *(const GAS v2u*)(CKVR + (size_t)row * 256 + 4 * lane);
          float x[4] = {bflo(w.x), bfhi(w.x), bflo(w.y), bfhi(w.y)};
          const float ss = (x[0] * x[0] + x[1] * x[1]) + (x[2] * x[2] + x[3] * x[3]);
          const float rs = rsqrtf(wave_sum(ss) * (1.f / 256.f) + EPSN);
#pragma unroll
          for (int j = 0; j < 4; ++j) x[j] = x[j] * rs * gkv[4 * lane + j];
          if (!lat) *(GAS f32x4*)(outp + OUT_CKV + ((size_t)(b * 2 + l) * 256 + t) * 256 + 4 * lane) = (f32x4){x[0], x[1], x[2], x[3]};
          *(GAS v2u*)(CKVALL + (size_t)keyrow * 256 + 4 * lane) = (v2u){pk2(x[0], x[1]), pk2(x[2], x[3])}; }
    }
    LAS float* tile = (LAS float*)lds;
    const GAS float *sw = (const GAS float*)(a.in[19] + (size_t)l * 3 * 1536), *sb = (const GAS float*)(a.in[20] + (size_t)l * 1536);
    for (int it = bid; it < 96 * 12; it += G) {
        const int tb = it / 12, cb = it % 12, row0 = tb * 128;
        const bool lat = row0 >= TCTX; const int L = lat ? 2048 : 256;
        const int b = lat ? (row0 - TCTX) >> 11 : row0 >> 8, t0 = lat ? (row0 - TCTX) & 2047 : row0 & 255;
        v4u w[4], wh = (v4u){0u, 0u, 0u, 0u};
        { const int rr = tid >> 4, c8 = tid & 15;
#pragma unroll
          for (int q = 0; q < 4; ++q) w[q] = *(const GAS v4u*)(HYR + (size_t)(row0 + rr + 32 * q) * 1536 + cb * 128 + 8 * c8);
          if (tid < 32) { const int which = tid >> 4; const bool ok = which ? (t0 + 128 < L) : (t0 > 0); const int rsrc = which ? row0 + 128 : row0 - 1;
              if (ok) wh = *(const GAS v4u*)(HYR + (size_t)rsrc * 1536 + cb * 128 + 8 * c8); }
#pragma unroll
          for (int q = 0; q < 4; ++q) { LAS float* tp = tile + (rr + 32 * q + 1) * 129 + 8 * c8;
              tp[0] = bflo(w[q].x); tp[1] = bfhi(w[q].x); tp[2] = bflo(w[q].y); tp[3] = bfhi(w[q].y); tp[4] = bflo(w[q].z); tp[5] = bfhi(w[q].z); tp[6] = bflo(w[q].w); tp[7] = bfhi(w[q].w); }
          if (tid < 32) { LAS float* tp = tile + ((tid >> 4) ? 129 : 0) * 129 + 8 * c8;
              tp[0] = bflo(wh.x); tp[1] = bfhi(wh.x); tp[2] = bflo(wh.y); tp[3] = bfhi(wh.y); tp[4] = bflo(wh.z); tp[5] = bfhi(wh.z); tp[6] = bflo(wh.w); tp[7] = bfhi(wh.w); } }
        __syncthreads();
        { const int c = tid >> 2, tc = tid & 3, cg_ = cb * 128 + c; const float w0 = sw[cg_], w1 = sw[1536 + cg_], w2 = sw[3072 + cg_], bb = sb[cg_];
          const size_t base = lat ? (size_t)UT_LAT + ((size_t)b * 1536 + cg_) * 2048 : ((size_t)b * 1536 + cg_) * 256;
#pragma unroll
          for (int q = 0; q < 4; ++q) { float u[8];
#pragma unroll
              for (int k = 0; k < 8; ++k) { const int tr = 32 * tc + 8 * q + k; u[k] = w0 * tile[tr * 129 + c] + w1 * tile[(tr + 1) * 129 + c] + w2 * tile[(tr + 2) * 129 + c] + bb; }
              *(GAS v4u*)(UT + base + t0 + 32 * tc + 8 * q) = (v4u){pk2(u[0], u[1]), pk2(u[2], u[3]), pk2(u[4], u[5]), pk2(u[6], u[7])}; } }
        __syncthreads();
    }
}

__device__ __forceinline__ void ffnconv_phase(const Args& a, int l, int gt, int NGT) {
    const GAS bf16* U = (const GAS bf16*)(a.ws + WS_U); GAS bf16* ACT = (GAS bf16*)(a.ws + WS_ACT);
    const GAS float *cw = (const GAS float*)(a.in[31] + (size_t)l * 3 * 5632), *cb = (const GAS float*)(a.in[32] + (size_t)l * 5632);
#pragma unroll 1
    for (int idx = gt; idx < 1536 * 352; idx += NGT) {
        const int tb = idx / 352, ch = idx % 352, row0 = tb * 8, c0 = ch * 8;
        const bool lat = row0 >= TCTX; const int t0 = lat ? (row0 - TCTX) & 2047 : row0 & 255, L = lat ? 2048 : 256;
        v4u ra[10], rg[10];
#pragma unroll
        for (int i = 0; i < 10; ++i) { const int t = t0 + i - 1; const bool ok = (t >= 0) && (t < L); const size_t rr = (size_t)(row0 + (ok ? i - 1 : 0)) * 5632 + c0;
            ra[i] = *(const GAS v4u*)(U + rr); rg[i] = *(const GAS v4u*)(U + rr + 2816);
            if (!ok) { ra[i] = (v4u){0u, 0u, 0u, 0u}; rg[i] = (v4u){0u, 0u, 0u, 0u}; } }
        float wa[3][8], wg[3][8], ba[8], bg[8];
#pragma unroll
        for (int j = 0; j < 8; ++j) { ba[j] = cb[c0 + j]; bg[j] = cb[2816 + c0 + j];
#pragma unroll
            for (int k = 0; k < 3; ++k) { wa[k][j] = cw[k * 5632 + c0 + j]; wg[k][j] = cw[k * 5632 + 2816 + c0 + j]; } }
#pragma unroll
        for (int i = 0; i < 8; ++i) {
            float o[8];
#pragma unroll
            for (int j2 = 0; j2 < 4; ++j2) {
                const unsigned a0 = ra[i][j2], a1 = ra[i + 1][j2], a2 = ra[i + 2][j2], g0 = rg[i][j2], g1 = rg[i + 1][j2], g2 = rg[i + 2][j2];
                { const int j = 2 * j2; const float av = wa[0][j] * bflo(a0) + wa[1][j] * bflo(a1) + wa[2][j] * bflo(a2) + ba[j], gv = wg[0][j] * bflo(g0) + wg[1][j] * bflo(g1) + wg[2][j] * bflo(g2) + bg[j]; o[j] = gv * __builtin_amdgcn_rcpf(1.f + __expf(-gv)) * av; }
                { const int j = 2 * j2 + 1; const float av = wa[0][j] * bfhi(a0) + wa[1][j] * bfhi(a1) + wa[2][j] * bfhi(a2) + ba[j], gv = wg[0][j] * bfhi(g0) + wg[1][j] * bfhi(g1) + wg[2][j] * bfhi(g2) + bg[j]; o[j] = gv * __builtin_amdgcn_rcpf(1.f + __expf(-gv)) * av; } }
            *(GAS v4u*)(ACT + (size_t)(row0 + i) * 2816 + c0) = (v4u){pk2(o[0], o[1]), pk2(o[2], o[3]), pk2(o[4], o[5]), pk2(o[6], o[7])};
        }
    }
}
typedef float f32x2_t __attribute__((ext_vector_type(2)));
typedef __bf16 bf16x2_t __attribute__((ext_vector_type(2)));
__device__ __forceinline__ unsigned cvtpk(float lo, float hi) { const f32x2_t v = {lo, hi}; const bf16x2_t b = __builtin_convertvector(v, bf16x2_t); return __builtin_bit_cast(unsigned, b); }
template <int DK>
__device__ __forceinline__ void attn_unit(LAS unsigned char* lds, int tid, const bf16* Qp, int qpitch, const bf16* Kp, int kpitch, const bf16* Kpe, const bf16* Vt, size_t vpitch,
                                          int nkeys, bf16* Op, int opitch, float sl2, bool rope, int pos0) {
    constexpr int NS = DK / 16;
    asm volatile("" : "+v"(tid));
    const int lane = tid & 63, wave = tid >> 6, r = lane & 31, h = lane >> 5;
    bf16x8 qf[NS];
    { const bf16* qrow = Qp + (size_t)(wave * 32 + r) * qpitch;
#pragma unroll
      for (int s = 0; s < NS; ++s) qf[s] = *(const GAS bf16x8*)(qrow + 16 * s + 8 * h);
      if (DK == 96 && rope) { const int t = pos0 + wave * 32 + r; const float grow = (float)(t >> 6), gcol = (float)(t & 63);
#pragma unroll
          for (int sp = 0; sp < 2; ++sp) { bf16x8 v = qf[NS - 2 + sp];
#pragma unroll
              for (int k = 0; k < 4; ++k) { float x0 = bf1((bf16)v[2 * k]), x1 = bf1((bf16)v[2 * k + 1]);
                  const float inv = __builtin_amdgcn_exp2f(-(float)(4 * h + k) * (L2_10000 / 8.f)); rope2(x0, x1, (sp == 0 ? grow : gcol) * inv);
                  v[2 * k] = (short)f2bf(x0); v[2 * k + 1] = (short)f2bf(x1); }
              qf[NS - 2 + sp] = v; } } }
    const int kkey = tid >> 3, kch = tid & 7, pkey = tid >> 2, pch = tid & 3;
    f32x16 o0, o1;
#pragma unroll
    for (int i = 0; i < 16; ++i) { o0[i] = 0.f; o1[i] = 0.f; }
    float mrun = -__builtin_inff(), lrun = 0.f;
    v4u rk, rv, rp = (v4u){0u, 0u, 0u, 0u};
    const int ntile = nkeys >> 6;
#define ATT_LOAD(kt) do { const int key0 = (kt) * 64; rk = *(const GAS v4u*)(Kp + (size_t)(key0 + kkey) * kpitch + 8 * kch); rv = *(const GAS v4u*)(Vt + (size_t)kkey * vpitch + key0 + 8 * kch); \
        if (DK == 96 && tid < 256) rp = *(const GAS v4u*)(Kpe + (size_t)(key0 + pkey) * 32 + 8 * pch); } while (0)
#define ATT_WRITE(buf) do { *(LAS v4u*)(lds + (buf) * 13312 + kkey * 208 + kch * 16) = rk; \
        { LAS unsigned char* vw = lds + 26624 + (buf) * 9216 + kkey * 144 + (kch >> 1) * 32 + (kch & 1) * 8; *(LAS v2u*)vw = (v2u){rv.x, rv.y}; *(LAS v2u*)(vw + 16) = (v2u){rv.z, rv.w}; } \
        if (DK == 96 && tid < 256) *(LAS v4u*)(lds + (buf) * 13312 + pkey * 208 + 128 + pch * 16) = rp; } while (0)
    ATT_LOAD(0); ATT_WRITE(0); __syncthreads();
    for (int kt = 0; kt < ntile; ++kt) {
        const int buf = kt & 1;
        if (kt + 1 < ntile) ATT_LOAD(kt + 1);
        const LAS unsigned char* kb = lds + buf * 13312; const LAS unsigned char* vb = lds + 26624 + buf * 9216;
        f32x16 s0, s1;
#pragma unroll
        for (int i = 0; i < 16; ++i) { s0[i] = 0.f; s1[i] = 0.f; }
#pragma unroll
        for (int s = 0; s < NS; ++s) {
            const bf16x8 a0 = *(const LAS bf16x8*)(kb + r * 208 + (16 * s + 8 * h) * 2), a1 = *(const LAS bf16x8*)(kb + (32 + r) * 208 + (16 * s + 8 * h) * 2);
            s0 = __builtin_amdgcn_mfma_f32_32x32x16_bf16(a0, qf[s], s0, 0, 0, 0); s1 = __builtin_amdgcn_mfma_f32_32x32x16_bf16(a1, qf[s], s1, 0, 0, 0); }
        float mx = s0[0];
#pragma unroll
        for (int i = 1; i < 16; ++i) mx = fmaxf(mx, s0[i]);
#pragma unroll
        for (int i = 0; i < 16; ++i) mx = fmaxf(mx, s1[i]);
        mx = fmaxf(mx, __shfl_xor(mx, 32));
        const float mnew = fmaxf(mrun, mx), alpha = __builtin_amdgcn_exp2f((mrun - mnew) * sl2), nm = mnew * sl2;
        f32x2_t sum2 = {0.f, 0.f};
#pragma unroll
        for (int i = 0; i < 8; ++i) {
            f32x2_t t0 = {s0[2 * i], s0[2 * i + 1]}, t1 = {s1[2 * i], s1[2 * i + 1]};
            t0 = t0 * sl2 - nm; t1 = t1 * sl2 - nm;
            t0.x = __builtin_amdgcn_exp2f(t0.x); t0.y = __builtin_amdgcn_exp2f(t0.y); t1.x = __builtin_amdgcn_exp2f(t1.x); t1.y = __builtin_amdgcn_exp2f(t1.y);
            s0[2 * i] = t0.x; s0[2 * i + 1] = t0.y; s1[2 * i] = t1.x; s1[2 * i + 1] = t1.y;
            sum2 = sum2 + (t0 + t1); }
        lrun = lrun * alpha + (sum2.x + sum2.y); mrun = mnew;
        if (__builtin_amdgcn_ballot_w64(alpha != 1.f)) {
#pragma unroll
            for (int i = 0; i < 16; ++i) { o0[i] *= alpha; o1[i] *= alpha; } }
#pragma unroll
        for (int sub = 0; sub < 2; ++sub) {
#pragma unroll
            for (int s2 = 0; s2 < 2; ++s2) {
                const v4u pw = (sub == 0) ? (v4u){cvtpk(s0[8 * s2], s0[8 * s2 + 1]), cvtpk(s0[8 * s2 + 2], s0[8 * s2 + 3]), cvtpk(s0[8 * s2 + 4], s0[8 * s2 + 5]), cvtpk(s0[8 * s2 + 6], s0[8 * s2 + 7])}
                                          : (v4u){cvtpk(s1[8 * s2], s1[8 * s2 + 1]), cvtpk(s1[8 * s2 + 2], s1[8 * s2 + 3]), cvtpk(s1[8 * s2 + 4], s1[8 * s2 + 5]), cvtpk(s1[8 * s2 + 6], s1[8 * s2 + 7])};
                const bf16x8 pb = __builtin_bit_cast(bf16x8, pw);
                const int kofs = (32 * sub + 16 * s2 + 8 * h) * 2;
#pragma unroll
                for (int slab = 0; slab < 2; ++slab) {
                    const bf16x8 va = *(const LAS bf16x8*)(vb + (32 * slab + r) * 144 + kofs);
                    if (slab == 0) o0 = __builtin_amdgcn_mfma_f32_32x32x16_bf16(va, pb, o0, 0, 0, 0); else o1 = __builtin_amdgcn_mfma_f32_32x32x16_bf16(va, pb, o1, 0, 0, 0); } } }
        if (kt + 1 < ntile) ATT_WRITE(buf ^ 1);
        __syncthreads();
    }
#undef ATT_LOAD
#undef ATT_WRITE
    const float ltot = lrun + __shfl_xor(lrun, 32), inv = 1.f / ltot;
    bf16* orow = Op + (size_t)(wave * 32 + r) * opitch;
#pragma unroll
    for (int g4 = 0; g4 < 4; ++g4) {
        *(GAS v2u*)(orow + 8 * g4 + 4 * h) = (v2u){pk2(o0[4 * g4] * inv, o0[4 * g4 + 1] * inv), pk2(o0[4 * g4 + 2] * inv, o0[4 * g4 + 3] * inv)};
        *(GAS v2u*)(orow + 32 + 8 * g4 + 4 * h) = (v2u){pk2(o1[4 * g4] * inv, o1[4 * g4 + 1] * inv), pk2(o1[4 * g4 + 2] * inv, o1[4 * g4 + 3] * inv)}; }
}

template <bool LAT>
__device__ __forceinline__ void hyena_unit(const Args& a, int l, int c, LAS unsigned char* lds, int tid) {
    constexpr int L = LAT ? 2048 : 256, NB = LAT ? 4 : 16, NE = L / 16, NCH = L / 4, NW = LAT ? 8 : 4, ASH = LAT ? 2 : 4, MG = LAT ? 224 : 32  , UP = L + 2 * MG + 8  , GS = 514  ;
    asm volatile("" : "+v"(tid));
    const int lane = tid & 63, wave = tid >> 6, r = lane & 31, h = lane >> 5;
    const bf16* UT = (const bf16*)(a.ws + WS_UT) + (LAT ? UT_LAT : 0);
    GAS bf16* OC = (GAS bf16*)(a.ws + WS_OC);
    const float* HID = (const float*)(a.ws + WS_HID) + ((size_t)l * 2304 + (LAT ? 256 : 0)) * 64;
    LAS bf16* U = (LAS bf16*)lds; LAS bf16* X = (LAS bf16*)(lds + 20096); LAS float* FT = (LAS float*)(lds + 36480); LAS unsigned char* GC = lds + 69248;
    LAS float* W3 = (LAS float*)(lds + 135040); LAS float* RED = (LAS float*)(lds + 136064);
    constexpr int NQ = NB * L / 8 / 512;
    v4u x2r[NQ];
#pragma unroll
    for (int i = 0; i < NQ; ++i) { const int q = tid + 512 * i, b = q / (L / 8), off = (q % (L / 8)) * 8;
        const v4u uv = *(const GAS v4u*)(UT + ((size_t)b * 1536 + c) * L + off), xv = *(const GAS v4u*)(UT + ((size_t)b * 1536 + 512 + c) * L + off);
        x2r[i] = *(const GAS v4u*)(UT + ((size_t)b * 1536 + 1024 + c) * L + off);
        *(LAS v4u*)(U + b * UP + MG + off) = uv; *(LAS v4u*)(X + b * L + off) = xv; }
    for (int q = tid; q < NB * 2 * MG / 8; q += 512) { const int b = q / (2 * MG / 8), o = q % (2 * MG / 8); const int off = (o < MG / 8) ? 8 * o : MG + L + 8 * (o - MG / 8);
        *(LAS v4u*)(U + b * UP + off) = (v4u){0u, 0u, 0u, 0u}; }
    if (tid < 256) { const int j = tid >> 2, k = tid & 3; W3[k * 64 + j] = a.in[25][((size_t)l * 64 + j) * 2048 + (k >> 1) * 1024 + (k & 1) * 512 + c]; }
    __syncthreads();
#if defined(PROBE_HY) && PROBE_HY == 1
    for (int rep = 0; rep < 2; ++rep)
#endif
    { const float dmin = -15.350567286626973f, dmax = -3.0701134573253945f;
      const float delta = fabsf(dmin + (float)c * ((dmax - dmin) / 511.f));
      float p0 = 0.f, p1 = 0.f;
      for (int t = tid; t < L; t += 512) {
          float s[4] = {0.f, 0.f, 0.f, 0.f};
#pragma unroll 4
          for (int j4 = 0; j4 < 16; ++j4) { const f32x4 hv = *(const GAS f32x4*)(HID + (size_t)t * 64 + 4 * j4);
#pragma unroll
              for (int k = 0; k < 4; ++k) s[k] += hv.x * W3[k * 64 + 4 * j4] + hv.y * W3[k * 64 + 4 * j4 + 1] + hv.z * W3[k * 64 + 4 * j4 + 2] + hv.w * W3[k * 64 + 4 * j4 + 3]; }
          const float win = __expf(-((float)t / (float)(L - 1)) * delta);
#pragma unroll
          for (int k = 0; k < 4; ++k) { s[k] *= win; FT[k * L + t] = s[k]; }
          p0 += fabsf(s[0]) + (t >= 1 ? fabsf(s[2]) : 0.f); p1 += fabsf(s[1]) + (t >= 1 ? fabsf(s[3]) : 0.f); }
      p0 = wave_sum(p0); p1 = wave_sum(p1);
      if (lane == 0) { RED[2 * wave] = p0; RED[2 * wave + 1] = p1; } }
    __syncthreads();
    const int col = 32 * wave + r, ca = col >> ASH, cbat = col & (NB - 1);
    const int a_lo = (32 * wave) >> ASH, a_hi = (32 * wave + 31) >> ASH;
    const int rowbase = LAT ? TCTX + cbat * 2048 : cbat * 256;
#pragma unroll 1
    for (int n = 0; n < 2; ++n) {
        float l1s = 0.f;
#pragma unroll
        for (int w = 0; w < 8; ++w) l1s += RED[2 * w + n];
        const float invl1 = 1.f / (l1s + EPSN);
#if defined(PROBE_HY) && PROBE_HY == 4
        for (int rep = 0; rep < 2; ++rep)
#endif
        for (int q = tid; q < 8 * NCH; q += 512) { const int k = q & 7, y = q >> 3, m0 = L - (8 * y + k);
            float v[8];
#pragma unroll
            for (int j = 0; j < 8; ++j) { const int m = m0 - j; float t = 0.f; if (m >= 0 && m < L) t = FT[n * L + m]; else if (m < 0 && m > -L) t = FT[(2 + n) * L - m]; v[j] = t * invl1; }
            *(LAS v4u*)(GC + (k * GS + y) * 16) = (v4u){cvtpk(v[0], v[1]), cvtpk(v[2], v[3]), cvtpk(v[4], v[5]), cvtpk(v[6], v[7])}; }
        __syncthreads();
        f32x16 acc, acc1;
#if defined(PROBE_HY) && PROBE_HY == 3
        for (int rep = 0; rep < 2; ++rep) {
#endif
#pragma unroll
        for (int i = 0; i < 16; ++i) { acc[i] = 0.f; acc1[i] = 0.f; }
        if (wave < NW) {
            const int lam_lo = 2 * a_lo - (NE - 1), lam_hi = 2 * a_hi;
            const int xs0 = 8 * h - r + L;
            const LAS unsigned char* ap = GC + ((xs0 & 7) * GS + (xs0 >> 3) - 2 * lam_lo) * 16;
            const LAS unsigned char* bp = (const LAS unsigned char*)(U + cbat * UP + MG + 8 * h) + 32 * (2 * ca - lam_lo);
            bf16x8 a0 = *(const LAS bf16x8*)ap, b0 = *(const LAS bf16x8*)bp, a1 = *(const LAS bf16x8*)(ap - 32), b1 = *(const LAS bf16x8*)(bp - 32);
            for (int lam = lam_lo; lam <= lam_hi; lam += 2) {
                const bool more = lam + 2 <= lam_hi;
                if (more) { ap -= 64; bp -= 64; }
                const bf16x8 na0 = *(const LAS bf16x8*)ap, na1 = *(const LAS bf16x8*)(ap - 32), nb0 = *(const LAS bf16x8*)bp, nb1 = *(const LAS bf16x8*)(bp - 32);
                acc = __builtin_amdgcn_mfma_f32_32x32x16_bf16(a0, b0, acc, 0, 0, 0);
                acc1 = __builtin_amdgcn_mfma_f32_32x32x16_bf16(a1, b1, acc1, 0, 0, 0);
                a0 = na0; a1 = na1; b0 = nb0; b1 = nb1;
            }
#pragma unroll
            for (int i = 0; i < 16; ++i) acc[i] += acc1[i];
        }
#if defined(PROBE_HY) && PROBE_HY == 3
        asm volatile("" :: "v"(acc[0]), "v"(acc[5]));
        }
#endif
        const float bias = a.in[27][((size_t)l * 2 + n) * 512 + c];
        float z[16];
        if (wave < NW) {
#pragma unroll
            for (int g4 = 0; g4 < 4; ++g4) { const int t0 = 32 * ca + 8 * g4 + 4 * h;
                const v2u uw = *(const LAS v2u*)(U + cbat * UP + MG + t0), xw = *(const LAS v2u*)(X + cbat * L + t0);
                const float uv[4] = {bflo(uw.x), bfhi(uw.x), bflo(uw.y), bfhi(uw.y)}, xv[4] = {bflo(xw.x), bfhi(xw.x), bflo(xw.y), bfhi(xw.y)};
#pragma unroll
                for (int k = 0; k < 4; ++k) z[4 * g4 + k] = xv[k] * (acc[4 * g4 + k] + bias * uv[k]); }
        }
        __syncthreads();
        if (n == 0) {
            if (wave < NW) {
#pragma unroll
                for (int g4 = 0; g4 < 4; ++g4) *(LAS v2u*)(U + cbat * UP + MG + 32 * ca + 8 * g4 + 4 * h) = (v2u){pk2(z[4 * g4], z[4 * g4 + 1]), pk2(z[4 * g4 + 2], z[4 * g4 + 3])}; }
#pragma unroll
            for (int i = 0; i < NQ; ++i) { const int q = tid + 512 * i, b = q / (L / 8), off = (q % (L / 8)) * 8; *(LAS v4u*)(X + b * L + off) = x2r[i]; }
        } else if (wave < NW) {
#if defined(PROBE_HY) && PROBE_HY == 2
            for (int rep = 0; rep < 2; ++rep)
#endif
#pragma unroll
            for (int g4 = 0; g4 < 4; ++g4)
#pragma unroll
                for (int k = 0; k < 4; ++k) OC[(size_t)(rowbase + 32 * ca + 8 * g4 + 4 * h + k) * 512 + c] = (bf16)f2bf(z[4 * g4 + k]);
        }
    }
    __syncthreads();
}
#ifndef PHMASK
#define PHMASK 0x1fff
#endif
#define PH_ON(k) (((PHMASK) >> (k)) & 1)
#define L1_INV() do { asm volatile("s_waitcnt vmcnt(0)" ::: "memory"); __builtin_amdgcn_fence(__ATOMIC_ACQUIRE, "agent"); asm volatile("s_waitcnt vmcnt(0)" ::: "memory"); __syncthreads(); } while (0)
template <class T> __device__ __forceinline__ T* asglobal(T* p) { return (T*)(GAS T*)p; }
__global__ void __launch_bounds__(512, 2) mega_fwd(Args a) {
    extern __shared__ __attribute__((aligned(16))) unsigned char lds_raw[];
    LAS unsigned char* lds = (LAS unsigned char*)lds_raw;
    cg::grid_group grid = cg::this_grid();
    const int bid = blockIdx.x;
    using pg8::Gemm; using pg8::StaticOrder;
    const int ph_lo = a.ph_lo, ph_hi = a.ph_hi;
    volatile LAS unsigned* MISC = (volatile LAS unsigned*)(lds + LDS_BYTES - 64);
    if (threadIdx.x < 16) MISC[threadIdx.x] = 0u;
    __syncthreads();
    if (ph_hi > NPHASE) { __syncthreads(); grid.sync(); }
    XcdBarrier bar = xcd_barrier_post((unsigned*)(a.ws + WS_BAR + (size_t)a.li * BAR_REGION), MISC);
#pragma unroll 1
    for (int ph = ph_lo; ph < ph_hi; ++ph) {
        int tid = threadIdx.x; asm volatile("" : "+v"(tid));
        int G = gridDim.x; asm volatile("" : "+s"(G)); const int NGW = G * 8, NGT = G * 512;
        unsigned char* ws = a.ws; asm volatile("" : "+s"(ws));
#if defined(__HIP_DEVICE_COMPILE__)
#define ASSUME_GLOBAL(p) __builtin_assume(!__builtin_amdgcn_is_shared((const void*)(p)) && !__builtin_amdgcn_is_private((const void*)(p)))
#else
#define ASSUME_GLOBAL(p) ((void)0)
#endif
        ASSUME_GLOBAL(ws); ASSUME_GLOBAL(a.ws); ASSUME_GLOBAL(a.out);
#pragma unroll
        for (int i = 0; i < 35; ++i) ASSUME_GLOBAL(a.in[i]);
        const int lane = tid & 63, wave = __builtin_amdgcn_readfirstlane(tid >> 6), gw = bid * 8 + wave, gt = bid * 512 + tid;
        const int l = (ph >= 1 && ph < 23) ? (ph - 1) / 11 : 0, sub = (ph >= 1 && ph < 23) ? (ph - 1) % 11 : -1;
        float* mod = (float*)(ws + WS_MOD) + (size_t)l * 5 * 6144;
        bool did = true;
        if (PH_ON(11) && ph == 0) { p0_mod_hid(a, lds, bid, G, tid, gw, NGW, lane); wconv_phase(a, 0, 0, lds, gw, NGW, gt, NGT, wave, lane); }
        else if (PH_ON(12) && ph == 23 && G == 256) { did = false; }
        else if (PH_ON(12) && ph == 23) { norm_phase(a, 0, 2, false, gw, NGW, lane); }
        else if (PH_ON(0) && sub == 0 && l == 1 && G == 256) { did = false; }
        else if (PH_ON(0) && sub == 0) { if (l == 1) wconv_phase(a, 1, 0, lds, gw, NGW, gt, NGT, wave, lane);     norm_phase(a, l, 0, l == 0, gw, NGW, lane); }
        else if (PH_ON(1) && sub == 1) {
            Gemm g{(const bf16*)(ws + WS_HBF1), (const bf16*)(ws + WS_WIN), TT, 4096, 1024, 1024, 1024}; StaticOrder S; S.init(TT, 4096, G, bid);
            pg8::EpiSeg E{(bf16*)(ws + WS_QA), (bf16*)(ws + WS_KVR), (bf16*)(ws + WS_CQ), (bf16*)(ws + WS_CKVR), (bf16*)(ws + WS_HYR), (bf16*)(ws + WS_S0)};
            pg8::gemm_phase<pg8::EpiSeg, StaticOrder, true, true>(lds, g, S, E);
        }
        else if (PH_ON(2) && sub == 2) { post_phase(a, l, lds, bid, G, tid, gw, NGW, gt, NGT, lane); }
        else if (PH_ON(3) && sub == 3) {
#pragma unroll 1
            for (int q = 0; q < 3; ++q) {
                Gemm g; StaticOrder S; pg8::EpiStore<0> E;
                if (q == 0) { g = Gemm{(const bf16*)(ws + WS_CQ), (const bf16*)(ws + WS_WUQ), TT, 768, 384, 512, 384}; S.init(TT, 768, G, bid); E = pg8::EpiStore<0>{(bf16*)(ws + WS_QB), 768}; }
                else if (q == 1) { g = Gemm{(const bf16*)(ws + WS_CKVALL), (const bf16*)(ws + WS_WKN), NKEYROWS, 512, 256, 256, 256}; S.init(NKEYROWS, 512, G, (bid + G - 144 % G) % G); E = pg8::EpiStore<0>{(bf16*)(ws + WS_KNB), 512}; }
                else { g = Gemm{(const bf16*)(ws + WS_WVV), (const bf16*)(ws + WS_CKVALL), 512, NKEYROWS, 256, 256, 256}; S.init(512, NKEYROWS, G, (bid + G - 248 % G) % G); E = pg8::EpiStore<0>{(bf16*)(ws + WS_VTB), NKEYROWS}; }
                pg8::gemm_phase<pg8::EpiStore<0>, StaticOrder, true, true>(lds, g, S, E);
            }
        }
        else if (PH_ON(4) && sub == 4) {
            const bf16 *QA = (const bf16*)(ws + WS_QA), *QB = (const bf16*)(ws + WS_QB), *KA = (const bf16*)(ws + WS_KA), *VTA = (const bf16*)(ws + WS_VTA);
            const bf16 *KNB = (const bf16*)(ws + WS_KNB), *VTB = (const bf16*)(ws + WS_VTB), *KPE = (const bf16*)(ws + WS_KPEALL);
            bf16 *OA = (bf16*)(ws + WS_OA), *OB = (bf16*)(ws + WS_OB);
            const float slA = 0.125f * 1.4426950408889634f, slB = 0.10206207261596575f * 1.4426950408889634f;
            const int sel = a.pad;
            for (int it = bid; it < 1792; it += G) {
                { const bool is_hy = (it >= 512 && it < 1024) || it >= 1280; if ((sel == 1 && is_hy) || (sel == 2 && !is_hy)) continue; }
                if (it < 256 || (it >= 1024 && it < 1152)) {
                    const bool lat = it < 256; const int u = lat ? (G == 256 ? ((bid & 7) * 4 + (bid >> 6)) * 8 + ((bid >> 3) & 7) : it) : it - 1024;
                    const int b = lat ? u >> 6 : u >> 3, hh = lat ? (u >> 3) & 7 : u & 7, qb = lat ? u & 7 : 0;
                    const int row0 = lat ? TCTX + b * 2048 + qb * 256 : b * 256, key0 = lat ? TCTX + b * 2304 : b * 256;
                    attn_unit<96>(lds, tid, QB + (size_t)row0 * 768 + hh * 96, 768, KNB + (size_t)key0 * 512 + hh * 64, 512, KPE + (size_t)key0 * 32, VTB + (size_t)(hh * 64) * NKEYROWS + key0, NKEYROWS,
                                  lat ? 2304 : 256, OB + (size_t)row0 * 512 + hh * 64, 512, slB, lat, qb * 256);
                } else if (it < 512 || (it >= 1152 && it < 1280)) {
                    const bool lat = it < 512; const int u = lat ? (G == 256 ? ((bid & 7) * 4 + (bid >> 6)) * 8 + ((bid >> 3) & 7) : it - 256) : it - 1152;
                    const int b = lat ? u >> 6 : u >> 3, hh = lat ? (u >> 3) & 7 : u & 7, qb = lat ? u & 7 : 0, kvh = hh >> 2;
                    const int row0 = lat ? TCTX + b * 2048 + qb * 256 : b * 256, nk = lat ? 2304 : 256;
                    const size_t kbase = lat ? (size_t)KA_LAT + (size_t)(b * 2 + kvh) * 2304 * 64 : (size_t)(b * 2 + kvh) * 256 * 64;
                    attn_unit<64>(lds, tid, QA + (size_t)row0 * 512 + hh * 64, 512, KA + kbase, 64, nullptr, VTA + kbase, nk, nk, OA + (size_t)row0 * 512 + hh * 64, 512, slA, false, 0);
                } else if (it < 1024) { hyena_unit<true>(a, l, it - 512, lds, tid); }
                else { hyena_unit<false>(a, l, it - 1280, lds, tid); }
            }
        }
        else if (PH_ON(5) && sub == 5) {
            static_assert(WS_S1 + 121 * MiB == WS_S0 && WS_S2 + 97 * MiB == WS_S0, "gate buffer arithmetic");
            bf16 *S0 = (bf16*)(ws + WS_S0), *MBF = (bf16*)(ws + WS_MBF);
            { Gemm g{(const bf16*)(ws + WS_HBF1), (const bf16*)(ws + WS_WG), TT, 2048, 1024, 1024, 1024}; StaticOrder S; S.init(TT, 2048, G, bid);
              pg8::EpiGate E{S0}; pg8::gemm_phase<pg8::EpiGate, StaticOrder, true, true>(lds, g, S, E); }
            xcd_barrier(bar);
            { Gemm g{(const bf16*)(ws + WS_OA), (const bf16*)(ws + WS_WB), TT, 1024, 512, 512, 512, (size_t)TT * 512 * 2, (size_t)1024 * 512 * 2};
              pg8::BatchOrder<3> S; S.init(TT, 1024, G, bid);
              pg8::EpiMerge E{S0, MBF}; pg8::gemm_phase<pg8::EpiMerge, pg8::BatchOrder<3>, true, true>(lds, g, S, E); }
        }
        else if (PH_ON(6) && sub == 6) {
            Gemm g{(const bf16*)(ws + WS_MBF), (const bf16*)(ws + WS_WO), TT, 1024, 1024, 1024, 1024}; StaticOrder S; S.init(TT, 1024, G, bid);
            if (G == 256) { pg8::EpiResNorm E{a.out, mod + 2048, a.in[11] + l * 1024, mod, 3072, 4096, (bf16*)(ws + WS_HBF), (float*)(ws + WS_SLOT), (unsigned*)(ws + WS_CNT) + (size_t)(l * 2) * 48 * 16, 0};
                pg8::gemm_phase<pg8::EpiResNorm, StaticOrder, true, true>(lds, g, S, E); }
            else { pg8::EpiResid E{a.out, mod + 2048}; pg8::gemm_phase<pg8::EpiResid, StaticOrder, true, true>(lds, g, S, E); }
        }
        else if (PH_ON(7) && sub == 7 && G == 256) { did = false; }
        else if (PH_ON(7) && sub == 7) { norm_phase(a, l, 1, false, gw, NGW, lane); }
        else if (PH_ON(8) && sub == 8) {
            Gemm g{(const bf16*)(ws + WS_HBF), (const bf16*)(ws + WS_WUP), TT, 5632, 1024, 1024, 1024}; StaticOrder S; S.init(TT, 5632, G, bid);
            pg8::EpiStore<0> E{(bf16*)(ws + WS_U), 5632}; pg8::gemm_phase<pg8::EpiStore<0>, StaticOrder, true, true>(lds, g, S, E);
        }
        else if (PH_ON(9) && sub == 9) { ffnconv_phase(a, l, gt, NGT); }
        else if (PH_ON(10) && sub == 10) {
            Gemm g{(const bf16*)(ws + WS_ACT), (const bf16*)(ws + WS_WDN), TT, 1024, 2816, 2816, 2816}; StaticOrder S; S.init(TT, 1024, G, bid);
            if (G == 256) {
                const float* modnext = (const float*)(ws + WS_MOD) + (size_t)5 * 6144;
                pg8::EpiResNorm E{a.out, mod + 5120, (l == 0) ? a.in[10] + 1024 : a.in[34], modnext, 0, 1024, (bf16*)(ws + WS_HBF1), (float*)(ws + WS_SLOT), (unsigned*)(ws + WS_CNT) + (size_t)(l * 2 + 1) * 48 * 16, l};
                pg8::gemm_phase<pg8::EpiResNorm, StaticOrder, true, true>(lds, g, S, E); }
            else { pg8::EpiResid E{a.out, mod + 5120}; pg8::gemm_phase<pg8::EpiResid, StaticOrder, true, true>(lds, g, S, E); }
            if (l == 0 && G == 256 && bid >= 192)
                wconv_phase(a, 1, 1, lds, (bid - 192) * 8 + wave, 64 * 8, (bid - 192) * 512 + tid, 64 * 512, wave, lane);
        }
#ifdef EXTRA_SYNCS
        for (int q = 0; q < EXTRA_SYNCS; ++q) { __syncthreads(); grid.sync(); }
#endif
        if (did && ph + 1 < ph_hi) xcd_barrier(bar);
    }
}

extern "C" void kernel_launch(void* const* d_in, const int* in_sizes, int n_in, void* d_out, int out_size, void* d_ws, size_t ws_size, hipStream_t stream) {
    static int grid = 0;
    if (grid == 0) {
        if (n_in != 35 || ws_size < WS_END) { fprintf(stderr, "kernel_launch: unexpected n_in %d / ws %zu\n", n_in, ws_size); grid = -1; return; }
        int dev = 0, cus = 0, per_cu = 0;
        if (hipGetDevice(&dev) != hipSuccess || hipDeviceGetAttribute(&cus, hipDeviceAttributeMultiprocessorCount, dev) != hipSuccess) { grid = -1; return; }
        if (hipFuncSetAttribute((const void*)mega_fwd, hipFuncAttributeMaxDynamicSharedMemorySize, LDS_BYTES) != hipSuccess) { fprintf(stderr, "kernel_launch: hipFuncSetAttribute failed\n"); grid = -1; return; }
        if (hipOccupancyMaxActiveBlocksPerMultiprocessor(&per_cu, (const void*)mega_fwd, 512, LDS_BYTES) != hipSuccess || per_cu < 1) { fprintf(stderr, "kernel_launch: occupancy query says %d\n", per_cu); per_cu = 1; }
        (void)hipGetLastError();
        grid = cus;
    }
    if (grid < 0) return;
    if (hipMemsetAsync((char*)d_ws + WS_MOD, 0, ZERO_BYTES, stream) != hipSuccess) { fprintf(stderr, "kernel_launch: memset failed\n"); return; }
    Args a{};
    for (int i = 0; i < 35; ++i) a.in[i] = (const float*)d_in[i];
    a.out = (float*)d_out; a.ws = (unsigned char*)d_ws;
#if defined(MK_PER_PHASE)
    for (int p = 0; p < NPHASE; ++p) { a.ph_lo = p; a.ph_hi = p + 1; a.li = 0; void* args[] = {&a};
        hipError_t e = hipLaunchCooperativeKernel((const void*)mega_fwd, dim3(grid), dim3(512), args, LDS_BYTES, stream);
        if (e != hipSuccess) { fprintf(stderr, "launch %d failed: %s\n", p, hipGetErrorString(e)); break; } }
#else
#if defined(PROBE_SUB)
#ifndef PROBE_SEL
#define PROBE_SEL 0
#endif
    { const int k0 = 1 + PROBE_SUB, k1 = 12 + PROBE_SUB; const int cuts[6][2] = {{0, k0 + 1}, {k0, k0 + 1}, {k0 + 1, k1 + 1}, {k1, k1 + 1}, {k1 + 1, NPHASE}, {0, 0}};
      for (int c = 0; c < 5; ++c) { a.ph_lo = cuts[c][0]; a.ph_hi = cuts[c][1]; a.li = c; a.pad = (c == 1 || c == 3) ? PROBE_SEL : 0; if (a.ph_lo >= a.ph_hi) continue; void* args[] = {&a};
          hipError_t e = hipLaunchCooperativeKernel((const void*)mega_fwd, dim3(grid), dim3(512), args, LDS_BYTES, stream);
          if (e != hipSuccess) { fprintf(stderr, "cooperative launch failed: %s\n", hipGetErrorString(e)); break; } } }
#elif defined(PROBE_CUTS)
    { const int k0 = 1 + PROBE_CUTS, k1 = 12 + PROBE_CUTS; const int cuts[4][2] = {{0, k0 + 1}, {k0 + 1, k1 + 1}, {k1 + 1, NPHASE}, {0, 0}};
      for (int c = 0; c < 3; ++c) { a.ph_lo = cuts[c][0]; a.ph_hi = cuts[c][1]; a.li = c; if (a.ph_lo >= a.ph_hi) continue; void* args[] = {&a};
          hipError_t e = hipLaunchCooperativeKernel((const void*)mega_fwd, dim3(grid), dim3(512), args, LDS_BYTES, stream);
          if (e != hipSuccess) { fprintf(stderr, "cooperative launch failed: %s\n", hipGetErrorString(e)); break; } } }
#else
    a.ph_lo = 0; a.ph_hi = NPHASE; void* args[] = {&a};
    hipError_t e = hipLaunchCooperativeKernel((const void*)mega_fwd, dim3(grid), dim3(512), args, LDS_BYTES, stream);
    if (e != hipSuccess) fprintf(stderr, "cooperative launch failed: %s (grid %d)\n", hipGetErrorString(e), grid);
#endif
#endif
}
```

```cpp
#include <hip/hip_runtime.h>
#include <hip/hip_cooperative_groups.h>
#include <cstdio>
#include <cstdint>
namespace cg = cooperative_groups;
namespace pg8 {
#define PG8_LAS __attribute__((address_space(3)))
typedef unsigned short bf16_t;
typedef short bf16x8 __attribute__((ext_vector_type(8)));
typedef float f32x4 __attribute__((ext_vector_type(4)));
typedef unsigned u32x4 __attribute__((ext_vector_type(4)));
constexpr int BM = 256, BK = 64, HALF = 128, HTB = HALF * BK * 2  , STAGE_BYTES = 8 * HTB, NXCD = 8, WGM = 8;

__host__ __device__ __forceinline__ int lds_byte(int r, int c) { const int st = (r >> 4) * 2 + (c >> 5), rr = r & 15, cc = c & 31, ob = rr * 64 + cc * 2; return st * 1024 + (ob ^ (((ob >> 9) & 1) << 5)); }
__host__ __device__ __forceinline__ void stage_rc(int b, int& R, int& C) { const int st = b / 1024, sb = b % 1024, swz = sb ^ (((sb >> 9) & 1) << 5); R = (st >> 1) * 16 + swz / 64; C = (st & 1) * 32 + (swz % 64) / 2; }
__host__ __device__ __forceinline__ int perm32(int rho) { const int n = rho >> 4, i = rho & 15; return 8 * (i >> 2) + 4 * n + (i & 3); }

struct Unit { int pm, pn, gi; };
struct Gemm { const bf16_t* A; const bf16_t* Bt; int M, N, K, lda, ldb; size_t gsA, gsB; };

struct StaticOrder {
    int nM, nN, nwg, G, c;
    __host__ __device__ void init(int M, int N, int G_, int c_) { nM = M / BM; nN = N / BM; nwg = nM * nN; G = G_; c = c_; }
    __host__ __device__ bool next(int i, Unit& u) const {
        const long L = (long)i * G + c; if (L >= nwg) return false;
        int wgid = (int)L; { const int q = nwg / NXCD, r = nwg % NXCD, xcd = wgid % NXCD, off = wgid / NXCD; wgid = (xcd < r ? xcd * (q + 1) : r * (q + 1) + (xcd - r) * q) + off; }
        const int nig = WGM * nN, gid = wgid / nig, fm = gid * WGM, gsz = (nM - fm) < WGM ? (nM - fm) : WGM;
        u.pm = fm + ((wgid % nig) % gsz); u.pn = (wgid % nig) / gsz; u.gi = 0; return true;
    }
    __device__ __forceinline__ void a_ready(const Unit&) const {}
    __device__ __forceinline__ void done(const Unit&) const {}
};
template <int N0, int N1, int NN0, int NN1> struct PairOrder {
    int G, c;
    __host__ __device__ bool next(int i, Unit& u) const { const int L = i * G + c; if (L >= N0 + N1) return false;
        if (L < N0) { u.pm = L / NN0; u.pn = L % NN0; u.gi = 0; } else { const int q = L - N0; u.pm = q / NN1; u.pn = q % NN1; u.gi = 1; } return true; }
    __device__ __forceinline__ void a_ready(const Unit&) const {}
    __device__ __forceinline__ void done(const Unit&) const {}
};
template <int NB> struct BatchOrder : StaticOrder {
    __host__ __device__ bool next(int i, Unit& u) const { if (i >= NB) return false; if (!StaticOrder::next(0, u)) return false; u.gi = i; return true; }
};


#ifndef GAS
#define GAS __attribute__((address_space(1)))
#endif
typedef float f32x2v __attribute__((ext_vector_type(2)));
typedef __bf16 bf16x2v __attribute__((ext_vector_type(2)));
__device__ __forceinline__ unsigned cvt_pk_bf16(float lo, float hi) { const f32x2v v = {lo, hi}; const bf16x2v b = __builtin_convertvector(v, bf16x2v); return __builtin_bit_cast(unsigned, b); }
__device__ __forceinline__ float sigm(float x) { return __builtin_amdgcn_rcpf(1.f + __expf(-x)); }
#define EPI_FOR _Pragma("unroll") for (int ai = 0; ai < 2; ++ai) _Pragma("unroll") for (int m = 0; m < 4; ++m) _Pragma("unroll") for (int bj = 0; bj < 2; ++bj)

template <int ACT  > struct EpiStore {
    static constexpr bool PERM = true, AFTER_DRAIN = false;
    bf16_t* O; int ld;
    __device__ __forceinline__ void operator()(const f32x4 (&acc)[2][2][4][2], const Unit& u, int wr, int wc, int fr, int fq) const {
        const int row0 = u.pm * BM + wr * 64 + fr, col0 = u.pn * BM + wc * 32 + 8 * fq;
        EPI_FOR { f32x4 v0 = acc[ai][bj][m][0], v1 = acc[ai][bj][m][1];
            if (ACT == 1) { v0 = (f32x4){sigm(v0[0]), sigm(v0[1]), sigm(v0[2]), sigm(v0[3])}; v1 = (f32x4){sigm(v1[0]), sigm(v1[1]), sigm(v1[2]), sigm(v1[3])}; }
            u32x4 w; w.x = cvt_pk_bf16(v0[0], v0[1]); w.y = cvt_pk_bf16(v0[2], v0[3]); w.z = cvt_pk_bf16(v1[0], v1[1]); w.w = cvt_pk_bf16(v1[2], v1[3]);
            *(GAS u32x4*)(O + (size_t)(row0 + ai * HALF + m * 16) * ld + col0 + bj * HALF) = w; }
    }
};
struct EpiPair {
    static constexpr bool PERM = true, AFTER_DRAIN = false;
    bf16_t *O0, *O1; int ld0, ld1;
    __device__ __forceinline__ void operator()(const f32x4 (&acc)[2][2][4][2], const Unit& u, int wr, int wc, int fr, int fq) const {
        bf16_t* O = u.gi ? O1 : O0; const int ld = u.gi ? ld1 : ld0;
        const int row0 = u.pm * BM + wr * 64 + fr, col0 = u.pn * BM + wc * 32 + 8 * fq;
        EPI_FOR { const f32x4 v0 = acc[ai][bj][m][0], v1 = acc[ai][bj][m][1];
            u32x4 w; w.x = cvt_pk_bf16(v0[0], v0[1]); w.y = cvt_pk_bf16(v0[2], v0[3]); w.z = cvt_pk_bf16(v1[0], v1[1]); w.w = cvt_pk_bf16(v1[2], v1[3]);
            *(GAS u32x4*)(O + (size_t)(row0 + ai * HALF + m * 16) * ld + col0 + bj * HALF) = w; }
    }
};
struct EpiSeg {
    static constexpr bool PERM = true, AFTER_DRAIN = false;
    bf16_t *QA, *KV, *CQ, *CKV, *HY, *S0;
    __device__ __forceinline__ void operator()(const f32x4 (&acc)[2][2][4][2], const Unit& u, int wr, int wc, int fr, int fq) const {
        bf16_t* base; int ld, coff; const int pn = u.pn;
        if (pn < 2) { base = QA; ld = 512; coff = 256 * pn; } else if (pn == 2) { base = KV; ld = 256; coff = 0; } else if (pn < 5) { base = CQ; ld = 512; coff = 256 * (pn - 3); }
        else if (pn == 5) { base = CKV; ld = 256; coff = 0; } else if (pn < 12) { base = HY; ld = 1536; coff = 256 * (pn - 6); } else { base = S0; ld = 1024; coff = 256 * (pn - 12); }
        const bool gate = pn >= 12;
        const int row0 = u.pm * BM + wr * 64 + fr, col0 = coff + wc * 32 + 8 * fq;
        EPI_FOR { f32x4 v0 = acc[ai][bj][m][0], v1 = acc[ai][bj][m][1];
            if (gate) { v0 = (f32x4){sigm(v0[0]), sigm(v0[1]), sigm(v0[2]), sigm(v0[3])}; v1 = (f32x4){sigm(v1[0]), sigm(v1[1]), sigm(v1[2]), sigm(v1[3])}; }
            u32x4 w; w.x = cvt_pk_bf16(v0[0], v0[1]); w.y = cvt_pk_bf16(v0[2], v0[3]); w.z = cvt_pk_bf16(v1[0], v1[1]); w.w = cvt_pk_bf16(v1[2], v1[3]);
            *(GAS u32x4*)(base + (size_t)(row0 + ai * HALF + m * 16) * ld + col0 + bj * HALF) = w; }
    }
};
struct EpiGate {
    static constexpr bool PERM = true, AFTER_DRAIN = false;
    bf16_t* S0;
    __device__ __forceinline__ void operator()(const f32x4 (&acc)[2][2][4][2], const Unit& u, int wr, int wc, int fr, int fq) const {
        const int n = 1 + (u.pn >> 2); bf16_t* base = (bf16_t*)((unsigned char*)S0 - (size_t)((n + 1) >> 1) * (121u << 20) + (size_t)(n >> 1) * (24u << 20));
        const int row0 = u.pm * BM + wr * 64 + fr, col0 = (u.pn & 3) * BM + wc * 32 + 8 * fq;
        EPI_FOR { f32x4 v0 = acc[ai][bj][m][0], v1 = acc[ai][bj][m][1];
            v0 = (f32x4){sigm(v0[0]), sigm(v0[1]), sigm(v0[2]), sigm(v0[3])}; v1 = (f32x4){sigm(v1[0]), sigm(v1[1]), sigm(v1[2]), sigm(v1[3])};
            u32x4 w; w.x = cvt_pk_bf16(v0[0], v0[1]); w.y = cvt_pk_bf16(v0[2], v0[3]); w.z = cvt_pk_bf16(v1[0], v1[1]); w.w = cvt_pk_bf16(v1[2], v1[3]);
            *(GAS u32x4*)(base + (size_t)(row0 + ai * HALF + m * 16) * 1024 + col0 + bj * HALF) = w; }
    }
};
struct EpiMerge {
    static constexpr bool PERM = true, AFTER_DRAIN = false;
    const bf16_t* S0; bf16_t* M;
    __device__ __forceinline__ void operator()(const f32x4 (&acc)[2][2][4][2], const Unit& u, int wr, int wc, int fr, int fq) const {
        const int row0 = u.pm * BM + wr * 64 + fr, col0 = u.pn * BM + wc * 32 + 8 * fq;
        const int MODE = u.gi; const bf16_t* S = (const bf16_t*)((const unsigned char*)S0 - (size_t)((u.gi + 1) >> 1) * (121u << 20) + (size_t)(u.gi >> 1) * (24u << 20));
        EPI_FOR { const size_t off = (size_t)(row0 + ai * HALF + m * 16) * 1024 + col0 + bj * HALF;
            const u32x4 sw = *(const GAS u32x4*)(S + off);
            f32x4 s0 = (f32x4){__uint_as_float(sw.x << 16), __uint_as_float(sw.x & 0xffff0000u), __uint_as_float(sw.y << 16), __uint_as_float(sw.y & 0xffff0000u)};
            f32x4 s1 = (f32x4){__uint_as_float(sw.z << 16), __uint_as_float(sw.z & 0xffff0000u), __uint_as_float(sw.w << 16), __uint_as_float(sw.w & 0xffff0000u)};
            f32x4 v0 = acc[ai][bj][m][0] * s0, v1 = acc[ai][bj][m][1] * s1;
            if (MODE >= 1) { const u32x4 mw = *(const GAS u32x4*)(M + off);
                v0 = v0 + (f32x4){__uint_as_float(mw.x << 16), __uint_as_float(mw.x & 0xffff0000u), __uint_as_float(mw.y << 16), __uint_as_float(mw.y & 0xffff0000u)};
                v1 = v1 + (f32x4){__uint_as_float(mw.z << 16), __uint_as_float(mw.z & 0xffff0000u), __uint_as_float(mw.w << 16), __uint_as_float(mw.w & 0xffff0000u)}; }
            u32x4 w; w.x = cvt_pk_bf16(v0[0], v0[1]); w.y = cvt_pk_bf16(v0[2], v0[3]); w.z = cvt_pk_bf16(v1[0], v1[1]); w.w = cvt_pk_bf16(v1[2], v1[3]); *(GAS u32x4*)(M + off) = w; }
    }
};
struct EpiResid {
    static constexpr bool PERM = true, AFTER_DRAIN = false;
    float* X; const float* gate;
    __device__ __forceinline__ void operator()(const f32x4 (&acc)[2][2][4][2], const Unit& u, int wr, int wc, int fr, int fq) const {
        const int row0 = u.pm * BM + wr * 64 + fr, col0 = u.pn * BM + wc * 32 + 8 * fq;
        const int mrow = (u.pm < 16) ? 0 : 1 + ((u.pm - 16) >> 3);
        const float* gp = gate + (size_t)mrow * 6144 + col0;
        f32x4 g[2][2];
#pragma unroll
        for (int bj = 0; bj < 2; ++bj) { g[bj][0] = *(const GAS f32x4*)(gp + bj * HALF); g[bj][1] = *(const GAS f32x4*)(gp + bj * HALF + 4); }
        EPI_FOR { float* xp = X + (size_t)(row0 + ai * HALF + m * 16) * 1024 + col0 + bj * HALF;
            const f32x4 x0 = *(const GAS f32x4*)xp, x1 = *(const GAS f32x4*)(xp + 4);
            *(GAS f32x4*)xp = x0 + g[bj][0] * acc[ai][bj][m][0]; *(GAS f32x4*)(xp + 4) = x1 + g[bj][1] * acc[ai][bj][m][1]; }
    }
};

struct EpiResNorm {
    static constexpr bool PERM = true, AFTER_DRAIN = true;
    float* X; const float* Xr0; const float* Xr1;
    const float* gate; const float* nw; const float* modn; int shoff, scoff; bf16_t* H; float* slots; unsigned* cnt; int mode;
    __device__ __forceinline__ void fused(f32x4 (&acc)[2][2][4][2], const Unit& u, int wr, int wc, int fr, int fq, PG8_LAS unsigned char* lds, int wid, int lane) const {
        const int tid = wid * 64 + lane;
        const int row0 = u.pm * BM + wr * 64 + fr, col0 = u.pn * BM + wc * 32 + 8 * fq;
        const int mrow = (u.pm < 16) ? 0 : 1 + ((u.pm - 16) >> 3);
        PG8_LAS float* red = (PG8_LAS float*)lds;
        PG8_LAS float* rsv = (PG8_LAS float*)(lds + 8192);
        const float* xr = (u.pm < 16) ? Xr0 : Xr1;
        { const float* gp = gate + (size_t)mrow * 6144 + col0;
          f32x4 g[2][2];
#pragma unroll
          for (int bj = 0; bj < 2; ++bj) { g[bj][0] = *(const GAS f32x4*)(gp + bj * HALF); g[bj][1] = *(const GAS f32x4*)(gp + bj * HALF + 4); }
#pragma unroll
          for (int ai = 0; ai < 2; ++ai)
#pragma unroll
              for (int m = 0; m < 4; ++m) { float ss = 0.f;
#pragma unroll
                  for (int bj = 0; bj < 2; ++bj) { const float* xp = xr + (size_t)(row0 + ai * HALF + m * 16) * 1024 + col0 + bj * HALF;
                      const f32x4 v0 = *(const GAS f32x4*)xp + g[bj][0] * acc[ai][bj][m][0], v1 = *(const GAS f32x4*)(xp + 4) + g[bj][1] * acc[ai][bj][m][1];
                      acc[ai][bj][m][0] = v0; acc[ai][bj][m][1] = v1;
                      ss += (v0[0] * v0[0] + v0[1] * v0[1]) + (v0[2] * v0[2] + v0[3] * v0[3]) + (v1[0] * v1[0] + v1[1] * v1[1]) + (v1[2] * v1[2] + v1[3] * v1[3]); }
                  ss += __shfl_xor(ss, 16); ss += __shfl_xor(ss, 32);
                  if (fq == 0) red[((wr * 4 + wc) * 8 + ai * 4 + m) * 16 + fr] = ss; } }
        __syncthreads();
        float* myslot = slots + (size_t)(u.pm * 4 + u.pn) * 256;
        if (tid < 256) { const int ai = tid >> 7, w2 = (tid >> 6) & 1, m = (tid >> 4) & 3, f = tid & 15;
            float t = 0.f;
#pragma unroll
            for (int c = 0; c < 4; ++c) t += red[((w2 * 4 + c) * 8 + ai * 4 + m) * 16 + f];
            __hip_atomic_store((GAS float*)myslot + tid, t, __ATOMIC_RELAXED, __HIP_MEMORY_SCOPE_AGENT); }
        asm volatile("s_waitcnt vmcnt(0)" ::: "memory");
        __syncthreads();
        GAS unsigned* pc = (GAS unsigned*)cnt + (size_t)u.pm * 16;
        if (tid == 0) { __hip_atomic_fetch_add(pc, 1u, __ATOMIC_RELAXED, __HIP_MEMORY_SCOPE_AGENT);
            unsigned sp = 0; while (__hip_atomic_load(pc, __ATOMIC_RELAXED, __HIP_MEMORY_SCOPE_AGENT) < 4u && ++sp < (1u << 22)) __builtin_amdgcn_s_sleep(1); }
        __syncthreads();
        if (tid < 256) { float t = 0.f;
#pragma unroll
            for (int c = 0; c < 4; ++c) t += __hip_atomic_load((GAS float*)slots + (size_t)(u.pm * 4 + c) * 256 + tid, __ATOMIC_RELAXED, __HIP_MEMORY_SCOPE_AGENT);
            rsv[tid] = rsqrtf(t * (1.f / 1024.f) + 1e-6f); }
        __syncthreads();
        const float* wp = nw + col0; const float* mp = modn + (size_t)mrow * 6144 + col0;
#pragma unroll
        for (int ai = 0; ai < 2; ++ai)
#pragma unroll
            for (int m = 0; m < 4; ++m) { const float rs = rsv[ai * 128 + wr * 64 + m * 16 + fr];
#pragma unroll
                for (int bj = 0; bj < 2; ++bj) { const size_t off = (size_t)(row0 + ai * HALF + m * 16) * 1024 + col0 + bj * HALF;
                    const f32x4 v0 = acc[ai][bj][m][0], v1 = acc[ai][bj][m][1];
                    const f32x4 w0 = *(const GAS f32x4*)(wp + bj * HALF), w1 = *(const GAS f32x4*)(wp + bj * HALF + 4);
                    f32x4 y0 = v0 * rs * w0, y1 = v1 * rs * w1;
                    if (mode == 1) { *(GAS f32x4*)(X + off) = y0; *(GAS f32x4*)(X + off + 4) = y1; }
                    else { *(GAS f32x4*)(X + off) = v0; *(GAS f32x4*)(X + off + 4) = v1;
                        const f32x4 c0 = *(const GAS f32x4*)(mp + scoff + bj * HALF), c1 = *(const GAS f32x4*)(mp + scoff + bj * HALF + 4), h0 = *(const GAS f32x4*)(mp + shoff + bj * HALF), h1 = *(const GAS f32x4*)(mp + shoff + bj * HALF + 4);
                        y0 = y0 * (c0 + 1.f) + h0; y1 = y1 * (c1 + 1.f) + h1;
                        u32x4 w; w.x = cvt_pk_bf16(y0[0], y0[1]); w.y = cvt_pk_bf16(y0[2], y0[3]); w.z = cvt_pk_bf16(y1[0], y1[1]); w.w = cvt_pk_bf16(y1[2], y1[3]);
                        *(GAS u32x4*)(H + off) = w; } } }
    }
};

template <class Epi, class Sched, bool ALIGN_EPI = false, bool SP2 = false>
__device__ __forceinline__ void gemm_phase(PG8_LAS unsigned char* lds, const Gemm g, const Sched& S, const Epi& E) {
    int tid_l = threadIdx.x; asm volatile("" : "+v"(tid_l));
    const int tid = tid_l, wid = __builtin_amdgcn_readfirstlane(tid >> 6), lane = tid & 63, wr = wid >> 2, wc = wid & 3, fr = lane & 15, fq = lane >> 4;
    const int K = g.K, nt = K / BK;
    unsigned voffA[2], voffB[2];
#pragma unroll
    for (int i = 0; i < 2; ++i) { int R, C; stage_rc(tid * 16 + i * 8192, R, C); const int Rb = Epi::PERM ? ((R & ~31) + perm32(R & 31)) : R;
        voffA[i] = (unsigned)(R * g.lda + C) * 2u; voffB[i] = (unsigned)(Rb * g.ldb + C) * 2u; }
    const size_t kstep = (size_t)(BK * 2);
    const size_t hstepA = (size_t)HALF * g.lda * 2, hstepB = (size_t)HALF * g.ldb * 2;
    const size_t tstepA = 2 * hstepA, tstepB = 2 * hstepB;
    const unsigned ldsw = (unsigned)wid * 1024u;
    const int aoff = lds_byte(wr * 64 + fr, fq * 8), boff = lds_byte(wc * 32 + fr, fq * 8);
#define PG8_SA(b, h) (((b) * 2 + (h)) * HTB)
#define PG8_SB(b, h) ((4 + (b) * 2 + (h)) * HTB)
#define PG8_STAGE(bufoff, gbase, voff) do { _Pragma("unroll") for (int _i = 0; _i < 2; ++_i) \
        __builtin_amdgcn_global_load_lds((const unsigned*)((const char*)(gbase) + (voff)[_i]), (PG8_LAS unsigned*)(lds + (bufoff) + ldsw + _i * 8192), 16, 0, 0); } while (0)
#define PG8_LDA(dst, b, h) do { _Pragma("unroll") for (int m = 0; m < 4; ++m) _Pragma("unroll") for (int k = 0; k < 2; ++k) dst[m][k] = *(const PG8_LAS bf16x8*)(lds + PG8_SA(b, h) + aoff + m * 2048 + k * 1024); } while (0)
#define PG8_LDB(dst, b, h) do { _Pragma("unroll") for (int n = 0; n < 2; ++n) _Pragma("unroll") for (int k = 0; k < 2; ++k) dst[n][k] = *(const PG8_LAS bf16x8*)(lds + PG8_SB(b, h) + boff + n * 2048 + k * 1024); } while (0)
#define PG8_MMA(ai, bj, At, Bt) do { __builtin_amdgcn_s_setprio(1); _Pragma("unroll") for (int m = 0; m < 4; ++m) _Pragma("unroll") for (int n = 0; n < 2; ++n) _Pragma("unroll") for (int k = 0; k < 2; ++k) \
        acc[ai][bj][m][n] = __builtin_amdgcn_mfma_f32_16x16x32_bf16(Bt[n][k], At[m][k], acc[ai][bj][m][n], 0, 0, 0); __builtin_amdgcn_s_setprio(0); } while (0)
#define PG8_WAIT_V(n) asm volatile("s_waitcnt vmcnt(" #n ")" ::: "memory")
#define PG8_WAIT_L(n) asm volatile("s_waitcnt lgkmcnt(" #n ")" ::: "memory")
#define PG8_BAR __builtin_amdgcn_s_barrier()
#define PG8_SCHED __builtin_amdgcn_sched_barrier(0)
    Unit cur, nxt; int ui = 0;
    if (!S.next(0, cur)) return;
    f32x4 acc[2][2][4][2];
#pragma unroll
    for (int a = 0; a < 2; ++a)
#pragma unroll
        for (int b = 0; b < 2; ++b)
#pragma unroll
            for (int m = 0; m < 4; ++m)
#pragma unroll
                for (int n = 0; n < 2; ++n) acc[a][b][m][n] = (f32x4){0.f, 0.f, 0.f, 0.f};
    bf16x8 At[4][2], B0[2][2], B1[2][2];
    const char* cA = (const char*)g.A + (size_t)cur.gi * g.gsA + (size_t)cur.pm * tstepA; const char* cB = (const char*)g.Bt + (size_t)cur.gi * g.gsB + (size_t)cur.pn * tstepB;
    S.a_ready(cur);
    if constexpr (SP2) {
        PG8_STAGE(PG8_SB(0, 0), cB, voffB); PG8_STAGE(PG8_SB(0, 1), cB + hstepB, voffB); PG8_STAGE(PG8_SA(0, 0), cA, voffA); PG8_STAGE(PG8_SA(0, 1), cA + hstepA, voffA);
        if (wr == 1) PG8_BAR;
        PG8_WAIT_V(2); PG8_BAR;
        PG8_STAGE(PG8_SB(1, 0), cB + kstep, voffB); PG8_STAGE(PG8_SA(1, 0), cA + kstep, voffA); PG8_STAGE(PG8_SB(1, 1), cB + hstepB + kstep, voffB);
        PG8_WAIT_V(6); PG8_BAR;
    } else {
        PG8_STAGE(PG8_SB(0, 0), cB, voffB); PG8_STAGE(PG8_SA(0, 0), cA, voffA); PG8_STAGE(PG8_SB(0, 1), cB + hstepB, voffB); PG8_STAGE(PG8_SA(0, 1), cA + hstepA, voffA);
        if (wr == 1) PG8_BAR;
        PG8_WAIT_V(4); PG8_BAR;
        PG8_STAGE(PG8_SB(1, 0), cB + kstep, voffB); PG8_STAGE(PG8_SA(1, 0), cA + kstep, voffA); PG8_STAGE(PG8_SB(1, 1), cB + hstepB + kstep, voffB);
        PG8_WAIT_V(6); PG8_BAR;
    }
    for (;;) {
        const bool has_next = S.next(ui + 1, nxt);
        const char* nA = has_next ? (const char*)g.A + (size_t)nxt.gi * g.gsA + (size_t)nxt.pm * tstepA : cA; const char* nB = has_next ? (const char*)g.Bt + (size_t)nxt.gi * g.gsB + (size_t)nxt.pn * tstepB : cB;
        for (int t = 0; t < nt; t += 2) {
            const bool last = (t == nt - 2);
            const char* a1 = cA + (size_t)(t + 1) * kstep;
            const char* a2 = last ? nA : cA + (size_t)(t + 2) * kstep; const char* b2 = last ? nB : cB + (size_t)(t + 2) * kstep;
            const char* a3 = a2 + kstep; const char* b3 = b2 + kstep;
            if (last && has_next) S.a_ready(nxt);
            if constexpr (SP2) {
            PG8_LDB(B0, 0, 0); PG8_LDB(B1, 0, 1); PG8_SCHED; PG8_LDA(At, 0, 0); PG8_STAGE(PG8_SA(1, 1), a1 + hstepA, voffA);
            PG8_WAIT_V(8); PG8_WAIT_L(0); PG8_BAR; PG8_MMA(0, 0, At, B0); PG8_MMA(0, 1, At, B1); PG8_BAR; PG8_SCHED;
            PG8_LDA(At, 0, 1); PG8_STAGE(PG8_SB(0, 0), b2, voffB); PG8_STAGE(PG8_SB(0, 1), b2 + hstepB, voffB); PG8_STAGE(PG8_SA(0, 0), a2, voffA);
            PG8_WAIT_V(8); PG8_WAIT_L(0); PG8_BAR; PG8_MMA(1, 0, At, B0); PG8_MMA(1, 1, At, B1); PG8_BAR; PG8_SCHED;
            PG8_LDB(B0, 1, 0); PG8_LDB(B1, 1, 1); PG8_SCHED; PG8_LDA(At, 1, 0); PG8_STAGE(PG8_SA(0, 1), a2 + hstepA, voffA);
            PG8_WAIT_V(8); PG8_WAIT_L(0); PG8_BAR; PG8_MMA(0, 0, At, B0); PG8_MMA(0, 1, At, B1); PG8_BAR; PG8_SCHED;
            PG8_LDA(At, 1, 1); PG8_STAGE(PG8_SB(1, 0), b3, voffB); PG8_STAGE(PG8_SB(1, 1), b3 + hstepB, voffB); PG8_STAGE(PG8_SA(1, 0), a3, voffA);
            PG8_WAIT_V(8); PG8_WAIT_L(0); PG8_BAR; PG8_MMA(1, 0, At, B0); PG8_MMA(1, 1, At, B1); PG8_BAR; PG8_SCHED;
            } else {
            PG8_LDB(B0, 0, 0); PG8_SCHED; PG8_LDA(At, 0, 0); PG8_STAGE(PG8_SA(1, 1), a1 + hstepA, voffA);
            PG8_WAIT_L(8); PG8_BAR; PG8_WAIT_L(0); PG8_MMA(0, 0, At, B0); PG8_BAR; PG8_SCHED;
            PG8_LDB(B1, 0, 1); PG8_STAGE(PG8_SB(0, 0), b2, voffB);
            PG8_BAR; PG8_WAIT_L(0); PG8_MMA(0, 1, At, B1); PG8_BAR;
            PG8_LDA(At, 0, 1); PG8_STAGE(PG8_SA(0, 0), a2, voffA);
            PG8_BAR; PG8_WAIT_L(0); PG8_MMA(1, 0, At, B0); PG8_BAR; PG8_SCHED;
            PG8_STAGE(PG8_SB(0, 1), b2 + hstepB, voffB);
            PG8_WAIT_V(6); PG8_BAR; PG8_MMA(1, 1, At, B1); PG8_BAR;
            PG8_LDB(B0, 1, 0); PG8_SCHED; PG8_LDA(At, 1, 0); PG8_STAGE(PG8_SA(0, 1), a2 + hstepA, voffA);
            PG8_WAIT_L(8); PG8_BAR; PG8_WAIT_L(0); PG8_MMA(0, 0, At, B0); PG8_BAR; PG8_SCHED;
            PG8_LDB(B1, 1, 1); PG8_STAGE(PG8_SB(1, 0), b3, voffB);
            PG8_BAR; PG8_WAIT_L(0); PG8_MMA(0, 1, At, B1); PG8_BAR;
            PG8_LDA(At, 1, 1); PG8_STAGE(PG8_SA(1, 0), a3, voffA);
            PG8_BAR; PG8_WAIT_L(0); PG8_MMA(1, 0, At, B0); PG8_BAR; PG8_SCHED;
            PG8_STAGE(PG8_SB(1, 1), b3 + hstepB, voffB);
            PG8_WAIT_V(6); PG8_BAR; PG8_MMA(1, 1, At, B1); PG8_BAR;
            }
        }
        if constexpr (ALIGN_EPI) { if (wr == 0) PG8_BAR; }
        if constexpr (!Epi::AFTER_DRAIN) { E(acc, cur, wr, wc, fr, fq); S.done(cur); }
        if (!has_next) break;
#pragma unroll
        for (int a = 0; a < 2; ++a)
#pragma unroll
            for (int b = 0; b < 2; ++b)
#pragma unroll
                for (int m = 0; m < 4; ++m)
#pragma unroll
                    for (int n = 0; n < 2; ++n) acc[a][b][m][n] = (f32x4){0.f, 0.f, 0.f, 0.f};
        cur = nxt; cA = nA; cB = nB; ++ui;
        if constexpr (ALIGN_EPI) { if (wr == 1) PG8_BAR; }
    }
    PG8_WAIT_V(0);
    if constexpr (!ALIGN_EPI) { if (wr == 0) PG8_BAR; }
    PG8_BAR;
    if constexpr (Epi::AFTER_DRAIN) { E.fused(acc, cur, wr, wc, fr, fq, lds, wid, lane); S.done(cur); }
#undef PG8_SA
#undef PG8_SB
#undef PG8_STAGE
#undef PG8_LDA
#undef PG8_LDB
#undef PG8_MMA
#undef PG8_WAIT_V
#undef PG8_WAIT_L
#undef PG8_BAR
#undef PG8_SCHED
}
}

constexpr int TCTX = 4096, TLAT = 8192, TT = 12288, DM = 1024, NKEYROWS = 13312;
constexpr float EPSN = 1e-6f;
constexpr size_t MiB = 1u << 20;
constexpr size_t WS_MOD = 0, MOD_BYTES = 2 * 5 * 6144 * 4, WS_BAR = 262144, BAR_REGION = 16384, ZERO_BYTES = WS_BAR + 5 * BAR_REGION;
constexpr size_t WS_CNT = 245760  , WS_SLOT = 2 * MiB + 262144  ;
constexpr size_t WS_HID = 1 * MiB;
constexpr size_t WS_WIN = 3 * MiB  , WS_WG = 11 * MiB  , WS_WUQ = 15 * MiB, WS_WKN = 16 * MiB, WS_WVV = 16 * MiB + 262144, WS_WB = 17 * MiB, WS_WO = 20 * MiB, WS_WUP = 22 * MiB, WS_WDN = 33 * MiB;
constexpr size_t WS_U = 39 * MiB, WS_ACT = 171 * MiB, WS_HBF = 171 * MiB  , WS_HBF1 = 165 * MiB  ;
constexpr size_t WS_QA = 39 * MiB, WS_KVR = 51 * MiB, WS_CQ = 57 * MiB, WS_CKVR = 69 * MiB, WS_HYR = 75 * MiB, WS_OA = 75 * MiB, WS_OB = 87 * MiB, WS_OC = 99 * MiB;
constexpr size_t WS_UT = 111 * MiB, WS_QB = 147 * MiB, WS_CKVALL = 189 * MiB, WS_KPEALL = 196 * MiB, WS_KNB = 197 * MiB, WS_VTB = 210 * MiB, WS_KA = 223 * MiB, WS_VTA = 227 * MiB;
constexpr size_t WS_S0 = 232 * MiB  , WS_S1 = 111 * MiB, WS_S2 = 135 * MiB, WS_MBF = 195 * MiB, WS_END = 256 * MiB;
constexpr int KA_LAT = 16 * 2 * 256 * 64;
constexpr int UT_LAT = 16 * 1536 * 256;
constexpr int OUT_K = 12582912, OUT_V = 13631488, OUT_CKV = 14680064, OUT_KPE = 16777216;
constexpr int LDS_BYTES = 147456;
constexpr int NPHASE = 24;

#ifndef GAS
#define GAS __attribute__((address_space(1)))
#endif
#define LAS __attribute__((address_space(3)))
typedef unsigned short bf16;
typedef unsigned v4u __attribute__((ext_vector_type(4)));
typedef unsigned v2u __attribute__((ext_vector_type(2)));
typedef float f32x4 __attribute__((ext_vector_type(4)));
typedef float f32x16 __attribute__((ext_vector_type(16)));
typedef short bf16x8 __attribute__((ext_vector_type(8)));
typedef short bf16x4 __attribute__((ext_vector_type(4)));
#define LDS_WAIT() asm volatile("s_waitcnt lgkmcnt(0)" ::: "memory")
__device__ __forceinline__ unsigned f2bf(float f) { unsigned u = __builtin_bit_cast(unsigned, f); return (u + 0x7fffu + ((u >> 16) & 1u)) >> 16; }
__device__ __forceinline__ unsigned pk2(float lo, float hi) { return f2bf(lo) | (f2bf(hi) << 16); }
__device__ __forceinline__ float bflo(unsigned w) { return __uint_as_float(w << 16); }
__device__ __forceinline__ float bfhi(unsigned w) { return __uint_as_float(w & 0xffff0000u); }
__device__ __forceinline__ float bf1(bf16 b) { return __uint_as_float(((unsigned)b) << 16); }
__device__ __forceinline__ void fsincos(float x, float& s, float& c) { float rev = x * 0.15915494309189535f; rev = rev - rintf(rev); s = __builtin_amdgcn_sinf(rev); c = __builtin_amdgcn_cosf(rev); }
__device__ __forceinline__ float fsin(float x) { float rev = x * 0.15915494309189535f; rev = rev - rintf(rev); return __builtin_amdgcn_sinf(rev); }
__device__ __forceinline__ float wave_sum(float v) {
#pragma unroll
    for (int o = 1; o < 64; o <<= 1) v += __shfl_xor(v, o);
    return v;
}
__device__ __forceinline__ void rope2(float& x0, float& x1, float ang) { float s, c; fsincos(ang, s, c); const float a = x0 * c - x1 * s, b = x0 * s + x1 * c; x0 = a; x1 = b; }
#define L2_10000 13.287712379549449f

__device__ __forceinline__ void transpose_item(const float* W, size_t ldw, int k0, int n0, bf16* WT, size_t ldt, int drow0, LAS float* scr, int lane) {
    float wv[32];
#pragma unroll
    for (int i = 0; i < 32; ++i) wv[i] = ((const GAS float*)W)[(size_t)(k0 + 2 * i + (lane >> 5)) * ldw + n0 + (lane & 31)];
#pragma unroll
    for (int i = 0; i < 32; ++i) scr[(2 * i + (lane >> 5)) * 33 + (lane & 31)] = wv[i];
    LDS_WAIT(); asm volatile("" ::: "memory");
    const int c = lane & 7;
#pragma unroll
    for (int j = 0; j < 4; ++j) { const int n = (lane >> 3) + 8 * j; const LAS float* s = scr + (8 * c) * 33 + n;
        v4u o; o.x = pk2(s[0 * 33], s[1 * 33]); o.y = pk2(s[2 * 33], s[3 * 33]); o.z = pk2(s[4 * 33], s[5 * 33]); o.w = pk2(s[6 * 33], s[7 * 33]);
        *(GAS v4u*)(WT + (size_t)(drow0 + n) * ldt + k0 + 8 * c) = o; }
    LDS_WAIT(); asm volatile("" ::: "memory");
}

#define XB_TMO      128
#define XB_XCNT(j)  (256  + 64 * (j))
#define XB_XSUB(j)  (1280 + 64 * (j))
#define XB_XGEN(j)  (2304 + 64 * (j))
#define XB_TOP      3328
#define XB_TOPGEN   3392
#define XCD_BAR_WORDS 3456
#define XB_SPIN_CAP (1u << 18)

__device__ __forceinline__ unsigned xb_ld(unsigned* p)              { return __hip_atomic_load(p, __ATOMIC_RELAXED, __HIP_MEMORY_SCOPE_AGENT); }
__device__ __forceinline__ unsigned xb_add(unsigned* p, unsigned v) { return __hip_atomic_fetch_add(p, v, __ATOMIC_RELAXED, __HIP_MEMORY_SCOPE_AGENT); }
__device__ __forceinline__ unsigned xb_xcc_id() { return (unsigned)__builtin_amdgcn_s_getreg((3 << 11) | 20) & 0xFu; }
#define XB_SPIN(cond, bar) do { unsigned _sp = 0; while (cond) { __builtin_amdgcn_s_sleep(1); \
    if ((++_sp & 255u) == 0u) { if (xb_ld(&(bar)[XB_TMO])) break; if (_sp > XB_SPIN_CAP) { atomicAdd(&(bar)[XB_TMO], 1u); break; } } } } while (0)

struct XcdBarrier {
    unsigned* bar; unsigned x;
    volatile LAS unsigned* st;
};

__device__ __forceinline__ XcdBarrier xcd_barrier_post(unsigned* bar, volatile LAS unsigned* st) {
    XcdBarrier b; b.bar = bar; b.x = xb_xcc_id(); b.st = st;
    if (threadIdx.x == 0) (void)xb_add(&bar[XB_XCNT(b.x)], 1u);
    return b;
}
__device__ __forceinline__ void xcd_barrier_complete(unsigned* bar, unsigned x, unsigned& nloc, unsigned& nx) {
    const unsigned G = gridDim.x * gridDim.y * gridDim.z;
    unsigned sum, cnt, mine, sp = 0u;
    for (;;) {
        sum = 0u; cnt = 0u; mine = 0u;
#pragma unroll
        for (unsigned j = 0; j < 16; ++j) { const unsigned c = xb_ld(&bar[XB_XCNT(j)]); sum += c; cnt += (c > 0u) ? 1u : 0u; mine = (j == x) ? c : mine; }
        if (sum == G) break;
        __builtin_amdgcn_s_sleep(1);
        if ((++sp & 255u) == 0u) { if (xb_ld(&bar[XB_TMO])) break; if (sp > XB_SPIN_CAP) { atomicAdd(&bar[XB_TMO], 1u); break; } }
    }
    nloc = mine > 0u ? mine : 1u; nx = cnt > 0u ? cnt : 1u;
}

__device__ __forceinline__ void xcd_barrier(const XcdBarrier& b) {
    asm volatile("s_waitcnt vmcnt(0)" ::: "memory");
    __syncthreads();
    if (threadIdx.x == 0) {
        unsigned* bar = b.bar;
        __builtin_amdgcn_s_waitcnt(0);
        unsigned nloc = b.st[0], nx = b.st[1];
        if (nloc == 0u) { xcd_barrier_complete(bar, b.x, nloc, nx); b.st[0] = nloc; b.st[1] = nx; }
        const unsigned old = xb_add(&bar[XB_XSUB(b.x)], 1u);
        const unsigned gen = old / nloc;
        if (old + 1u == (gen + 1u) * nloc) {
            __builtin_amdgcn_fence(__ATOMIC_RELEASE, "agent");
            asm volatile("s_waitcnt vmcnt(0)" ::: "memory");
            const unsigned og = xb_add(&bar[XB_TOP], 1u);
            const unsigned tg = og / nx;
            if (og + 1u == (tg + 1u) * nx) xb_add(&bar[XB_TOPGEN], 1u);
            else XB_SPIN(xb_ld(&bar[XB_TOPGEN]) == tg, bar);
            __builtin_amdgcn_fence(__ATOMIC_ACQUIRE, "agent");
            xb_add(&bar[XB_XGEN(b.x)], 1u);
            asm volatile("s_waitcnt vmcnt(0)" ::: "memory");
        } else {
            XB_SPIN(xb_ld(&bar[XB_XGEN(b.x)]) == gen, bar);
            __builtin_amdgcn_fence(__ATOMIC_ACQUIRE, "agent");
            asm volatile("s_waitcnt vmcnt(0)" ::: "memory");
        }
    }
    __syncthreads();
}


struct Args { const float* in[35]; float* out; unsigned char* ws; int ph_lo, ph_hi, li, pad; };

__device__ __forceinline__ void wconv_phase(const Args& a, int l, int part, LAS unsigned char* lds, int gw, int NGW, int gt, int NGT, int wave, int lane) {
    LAS float* scr = (LAS float*)(lds + wave * 16384);
    unsigned char* ws = a.ws;
    bf16 *WIN = (bf16*)(ws + WS_WIN), *WG = (bf16*)(ws + WS_WG), *WUQ = (bf16*)(ws + WS_WUQ), *WKN = (bf16*)(ws + WS_WKN), *WVV = (bf16*)(ws + WS_WVV), *WB = (bf16*)(ws + WS_WB), *WO = (bf16*)(ws + WS_WO), *WUP = (bf16*)(ws + WS_WUP), *WDN = (bf16*)(ws + WS_WDN);
    constexpr int I1 = 16 * 189, I2 = 6 * 24, I3 = 4 * 32, I4 = 3 * 8 * 32, I5 = 16 * 32, I6 = 16 * 176, I7 = 44 * 32, NIT = I1 + I2 + I3 + I4 + I5 + I6 + I7;
    const int it_lo = (part == 2) ? NIT - I7 : 0, it_hi = (part == 1) ? NIT - I7 : NIT;
    for (int it = it_lo + gw; it < it_hi; it += NGW) {
        int r = it;
        if (r < I1) { const int kb = r / 189, n0 = 32 * (r % 189); bf16* dst = WIN; int drow;
            if (n0 < 1152) drow = n0; else if (n0 < 1408) drow = n0 + 128; else if (n0 < 1440) drow = 1152 + (n0 - 1408); else if (n0 < 2976) drow = 1536 + (n0 - 1440); else if (n0 < 4000) drow = 3072 + (n0 - 2976); else { dst = WG; drow = n0 - 4000; }
            transpose_item(a.in[12] + (size_t)l * 1024 * 6048, 6048, 64 * kb, n0, dst, 1024, drow, scr, lane); continue; } r -= I1;
        if (r < I2) { const int kb = r / 24, n0 = 32 * (r % 24); transpose_item(a.in[17] + (size_t)l * 384 * 768, 768, 64 * kb, n0, WUQ, 384, n0, scr, lane); continue; } r -= I2;
        if (r < I3) { const int kb = r / 32, n0 = 32 * (r % 32); const int h = n0 >> 7, c0 = n0 & 127;
            transpose_item(a.in[18] + (size_t)l * 256 * 1024, 1024, 64 * kb, n0, (c0 < 64) ? WKN : WVV, 256, h * 64 + (c0 & 63), scr, lane); continue; } r -= I3;
        if (r < I4) { const int n = r / 256, q = r % 256, kb = q / 32, n0 = 32 * (q % 32);
            transpose_item(a.in[28] + ((size_t)l * 3 + n) * 512 * 1024, 1024, 64 * kb, n0, WB + (size_t)n * 1024 * 512, 512, n0, scr, lane); continue; } r -= I4;
        if (r < I5) { const int kb = r / 32, n0 = 32 * (r % 32); transpose_item(a.in[29] + (size_t)l * 1024 * 1024, 1024, 64 * kb, n0, WO, 1024, n0, scr, lane); continue; } r -= I5;
        if (r < I6) { const int kb = r / 176, n0 = 32 * (r % 176); transpose_item(a.in[30] + (size_t)l * 1024 * 5632, 5632, 64 * kb, n0, WUP, 1024, n0, scr, lane); continue; } r -= I6;
        { const int kb = r / 32, n0 = 32 * (r % 32); transpose_item(a.in[33] + (size_t)l * 2816 * 1024, 1024, 64 * kb, n0, WDN, 2816, n0, scr, lane); }
    }
    if (part != 2) for (int i = gt; i < 96 * 1024 / 8; i += NGT) *(GAS v4u*)(WIN + (size_t)1184 * 1024 + (size_t)i * 8) = (v4u){0u, 0u, 0u, 0u};
}

__device__ __forceinline__ void norm_phase(const Args& a, int l, int which, bool first, bool copy_x, int gw, int NGW, int lane) {
    const GAS float* mod = (const GAS float*)(a.ws + WS_MOD) + (size_t)l * 5 * 6144;
    GAS bf16* HBF = (GAS bf16*)(a.ws + (which == 0 ? WS_HBF1 : WS_HBF));
    const GAS float* gv = (const GAS float*)((which == 0) ? a.in[10] + l * 1024 : (which == 1) ? a.in[11] + l * 1024 : a.in[34]);
    GAS float* outp = (GAS float*)a.out;
    const int shoff = (which == 0) ? 0 : 3072, scoff = shoff + 1024;
    #pragma unroll 1
    for (int row0 = gw; row0 < TT; row0 += 4 * NGW) {
        f32x4 v[4][4];
#pragma unroll
        for (int q = 0; q < 4; ++q) { const int row = row0 + q * NGW; const int rr = row < TT ? row : row0;
            const GAS float* src = first ? (const GAS float*)(rr < TCTX ? a.in[0] + (size_t)rr * DM : a.in[1] + (size_t)(rr - TCTX) * DM) : (const GAS float*)(outp + (size_t)rr * DM);
#pragma unroll
            for (int j = 0; j < 4; ++j) v[q][j] = *(const GAS f32x4*)(src + 4 * lane + 256 * j); }
#pragma unroll
        for (int q = 0; q < 4; ++q) { const int row = row0 + q * NGW; if (row >= TT) continue;
            float ss = 0.f;
#pragma unroll
            for (int j = 0; j < 4; ++j) ss += (v[q][j].x * v[q][j].x + v[q][j].y * v[q][j].y) + (v[q][j].z * v[q][j].z + v[q][j].w * v[q][j].w);
            if (first && copy_x) {
#pragma unroll
                for (int j = 0; j < 4; ++j) *(GAS f32x4*)(outp + (size_t)row * DM + 4 * lane + 256 * j) = v[q][j]; }
            const float rs = rsqrtf(wave_sum(ss) * (1.f / DM) + EPSN);
            const int mrow = row < TCTX ? 0 : 1 + ((row - TCTX) >> 11);
            const GAS float* mp = mod + (size_t)mrow * 6144;
#pragma unroll
            for (int j = 0; j < 4; ++j) { const int col = 4 * lane + 256 * j; const f32x4 g = *(const GAS f32x4*)(gv + col);
                if (which == 2) { *(GAS f32x4*)(outp + (size_t)row * DM + col) = v[q][j] * rs * g; }
                else { const f32x4 sc = *(const GAS f32x4*)(mp + scoff + col), sh = *(const GAS f32x4*)(mp + shoff + col);
                    const f32x4 y = v[q][j] * rs * g * (sc + 1.f) + sh;
                    *(GAS v2u*)(HBF + (size_t)row * DM + col) = (v2u){pk2(y.x, y.y), pk2(y.z, y.w)}; } } }
    }
}
__device__ __forceinline__ void p0_mod_hid(const Args& a, LAS unsigned char* lds, int bid, int G, int tid, int gw, int NGW, int lane) {
    float* mod = (float*)(a.ws + WS_MOD);
    LAS float* sc = (LAS float*)lds;
    for (int it = bid; it < 384; it += G) {
        const int l = it / 192, rem = it % 192, kc = rem / 12, jb = rem % 12;
        if (tid < 320) { const int r = tid >> 6, kk = tid & 63, k = kc * 64 + kk; const float cv = (r == 0) ? a.in[7][k] : a.in[6][(r - 1) * 1024 + k]; sc[tid] = cv / (1.f + __expf(-cv)); }
        __syncthreads();
        const int j = jb * 512 + tid;
        const GAS float* wp = (const GAS float*)(a.in[8] + ((size_t)l * 1024 + kc * 64) * 6144 + j);
        float acc[5] = {0.f, 0.f, 0.f, 0.f, 0.f};
#pragma unroll 8
        for (int kk = 0; kk < 64; ++kk) { const float w = wp[(size_t)kk * 6144];
#pragma unroll
            for (int r = 0; r < 5; ++r) acc[r] += sc[r * 64 + kk] * w; }
        const float bias = (kc == 0) ? a.in[9][l * 6144 + j] : 0.f;
#pragma unroll
        for (int r = 0; r < 5; ++r) atomicAdd(mod + (size_t)(l * 5 + r) * 6144 + j, acc[r] + bias);
        __syncthreads();
    }
    float* HID = (float*)(a.ws + WS_HID);
    for (int it = gw; it < 2 * 2304; it += NGW) {
        const int l = it / 2304, q = it % 2304; const int L = q < 256 ? 256 : 2048, t = q < 256 ? q : q - 256;
        const float tn = (float)t / (float)(L - 1);
        float zi = 0.f;
        if (lane == 0) zi = tn;
        else if (lane <= 16) { const int bi = (lane - 1) & 7; const float band = 1e-4f + (float)bi * ((7.f - 1e-4f) / 7.f); const float ang = (6.283185307179586f / (float)L) * (float)t * band; float s, c; fsincos(ang, s, c); zi = (lane <= 8) ? c : -s; }
        float s1 = a.in[22][l * 64 + lane];
#pragma unroll
        for (int i = 0; i < 17; ++i) s1 += __shfl(zi, i) * a.in[21][(l * 17 + i) * 64 + lane];
        const float h1 = fsin(a.in[26][(l * 2 + 0) * 64 + lane] * s1);
        float s2 = a.in[24][l * 64 + lane];
#pragma unroll 8
        for (int i = 0; i < 64; ++i) s2 += __shfl(h1, i) * a.in[23][(l * 64 + i) * 64 + lane];
        HID[(size_t)it * 64 + lane] = fsin(a.in[26][(l * 2 + 1) * 64 + lane] * s2);
    }
}

__device__ __forceinline__ void post_phase(const Args& a, int l, LAS unsigned char* lds, int bid, int G, int tid, int gw, int NGW, int gt, int NGT, int lane) {
    unsigned char* ws = a.ws;
    GAS bf16 *QA = (GAS bf16*)(ws + WS_QA), *KVR = (GAS bf16*)(ws + WS_KVR), *CQ = (GAS bf16*)(ws + WS_CQ), *CKVR = (GAS bf16*)(ws + WS_CKVR), *HYR = (GAS bf16*)(ws + WS_HYR);
    GAS bf16 *UT = (GAS bf16*)(ws + WS_UT), *CKVALL = (GAS bf16*)(ws + WS_CKVALL), *KPEALL = (GAS bf16*)(ws + WS_KPEALL), *KA = (GAS bf16*)(ws + WS_KA), *VTA = (GAS bf16*)(ws + WS_VTA);
    GAS float* outp = (GAS float*)a.out;
    if (l == 1 && G == 256) { wconv_phase(a, 1, 2, lds, gw, NGW, gt, NGT, tid >> 6, lane); __syncthreads(); }
    for (int i = gt; i < 4 * 256 * 128; i += NGT) { const int b = i >> 15, p = (i >> 7) & 255, kvh = (i >> 6) & 1, d = i & 63;
        const size_t s = ((size_t)(b * 2 + l) * 256 + p) * 128 + kvh * 64 + d;
        KA[KA_LAT + ((b * 2 + kvh) * 2304 + p) * 64 + d] = (bf16)f2bf(a.in[2][s]);
        VTA[KA_LAT + ((b * 2 + kvh) * 64 + d) * 2304 + p] = (bf16)f2bf(a.in[3][s]); }
    for (int i = gt; i < 4 * 256 * 256; i += NGT) { const int b = i >> 16, p = (i >> 8) & 255, j = i & 255;
        CKVALL[(size_t)(TCTX + b * 2304 + p) * 256 + j] = (bf16)f2bf(a.in[4][((size_t)(b * 2 + l) * 256 + p) * 256 + j]); }
    for (int i = gt; i < 4 * 256 * 32; i += NGT) { const int b = i >> 13, p = (i >> 5) & 255, j = i & 31;
        KPEALL[(size_t)(TCTX + b * 2304 + p) * 32 + j] = (bf16)f2bf(a.in[5][((size_t)(b * 2 + l) * 256 + p) * 32 + j]); }
    const GAS float *gq = (const GAS float*)(a.in[13] + l * 64), *gk = (const GAS float*)(a.in[14] + l * 64), *gcq = (const GAS float*)(a.in[15] + l * 384), *gkv = (const GAS float*)(a.in[16] + l * 256);
    for (int row = gw; row < TT; row += NGW) {
        const bool lat = row >= TCTX;
        const int b = lat ? (row - TCTX) >> 11 : row >> 8, t = lat ? (row - TCTX) & 2047 : row & 255;
        const float grow = (float)(t >> 6), gcol = (float)(t & 63);
        const int keyrow = lat ? TCTX + b * 2304 + 256 + t : row;
        { v4u w = *(const GAS v4u*)(QA + (size_t)row * 512 + 8 * lane);
          float x[8] = {bflo(w.x), bfhi(w.x), bflo(w.y), bfhi(w.y), bflo(w.z), bfhi(w.z), bflo(w.w), bfhi(w.w)};
          float ss = 0.f;
#pragma unroll
          for (int j = 0; j < 8; ++j) ss += x[j] * x[j];
          ss += __shfl_xor(ss, 1); ss += __shfl_xor(ss, 2); ss += __shfl_xor(ss, 4);
          const float rs = rsqrtf(ss * (1.f / 64.f) + EPSN); const int d0 = 8 * (lane & 7);
#pragma unroll
          for (int j = 0; j < 8; ++j) x[j] = x[j] * rs * gq[d0 + j];
          if (lat) {
#pragma unroll
              for (int k = 0; k < 4; ++k) { const int i = 4 * (lane & 7) + k; const float inv = __builtin_amdgcn_exp2f(-(float)(i & 15) * (L2_10000 / 16.f)); rope2(x[2 * k], x[2 * k + 1], (i < 16 ? grow : gcol) * inv); } }
          *(GAS v4u*)(QA + (size_t)row * 512 + 8 * lane) = (v4u){pk2(x[0], x[1]), pk2(x[2], x[3]), pk2(x[4], x[5]), pk2(x[6], x[7])}; }
        { const v2u w = *(const GAS v2u*)(KVR + (size_t)row * 256 + 4 * lane);
          float x[4] = {bflo(w.x), bfhi(w.x), bflo(w.y), bfhi(w.y)};
          float ss = (x[0] * x[0] + x[1] * x[1]) + (x[2] * x[2] + x[3] * x[3]);
          ss += __shfl_xor(ss, 1); ss += __shfl_xor(ss, 2); ss += __shfl_xor(ss, 4); ss += __shfl_xor(ss, 8);
          const int kvh = (lane >> 4) & 1, d0 = 4 * (lane & 15);
          if (lane < 32) {
              const float rs = rsqrtf(ss * (1.f / 64.f) + EPSN);
#pragma unroll
              for (int j = 0; j < 4; ++j) x[j] = x[j] * rs * gk[d0 + j];
              if (!lat) { *(GAS f32x4*)(outp + OUT_K + ((size_t)(b * 2 + l) * 256 + t) * 128 + kvh * 64 + d0) = (f32x4){x[0], x[1], x[2], x[3]};
                  *(GAS v2u*)(KA + ((size_t)(b * 2 + kvh) * 256 + t) * 64 + d0) = (v2u){pk2(x[0], x[1]), pk2(x[2], x[3])}; }
              else {
#pragma unroll
                  for (int k = 0; k < 2; ++k) { const int i = 2 * (lane & 15) + k; const float inv = __builtin_amdgcn_exp2f(-(float)(i & 15) * (L2_10000 / 16.f)); rope2(x[2 * k], x[2 * k + 1], (i < 16 ? grow : gcol) * inv); }
                  *(GAS v2u*)(KA + KA_LAT + ((size_t)(b * 2 + kvh) * 2304 + 256 + t) * 64 + d0) = (v2u){pk2(x[0], x[1]), pk2(x[2], x[3])}; }
          } else {
              if (!lat) { *(GAS f32x4*)(outp + OUT_V + ((size_t)(b * 2 + l) * 256 + t) * 128 + kvh * 64 + d0) = (f32x4){x[0], x[1], x[2], x[3]};
#pragma unroll
                  for (int j = 0; j < 4; ++j) VTA[((size_t)(b * 2 + kvh) * 64 + d0 + j) * 256 + t] = (bf16)f2bf(x[j]); }
              else {
#pragma unroll
                  for (int j = 0; j < 4; ++j) VTA[KA_LAT + ((size_t)(b * 2 + kvh) * 64 + d0 + j) * 2304 + 256 + t] = (bf16)f2bf(x[j]); }
          } }
        { GAS unsigned* p = (GAS unsigned*)(CQ + (size_t)row * 512 + 6 * lane);
          const unsigned w0 = p[0], w1 = p[1], w2 = p[2];
          float x[6] = {bflo(w0), bfhi(w0), bflo(w1), bfhi(w1), bflo(w2), bfhi(w2)};
          float ss = 0.f;
#pragma unroll
          for (int j = 0; j < 6; ++j) ss += x[j] * x[j];
          const float rs = rsqrtf(wave_sum(ss) * (1.f / 384.f) + EPSN);
#pragma unroll
          for (int j = 0; j < 6; ++j) x[j] = x[j] * rs * gcq[6 * lane + j];
          p[0] = pk2(x[0], x[1]); p[1] = pk2(x[2], x[3]); p[2] = pk2(x[4], x[5]);
          if (lane < 16) { const unsigned w = *(const GAS unsigned*)(CQ + (size_t)row * 512 + 384 + 2 * lane); float y0 = bflo(w), y1 = bfhi(w);
              if (!lat) { outp[OUT_KPE + ((size_t)(b * 2 + l) * 256 + t) * 32 + 2 * lane] = y0; outp[OUT_KPE + ((size_t)(b * 2 + l) * 256 + t) * 32 + 2 * lane + 1] = y1; }
              else { const float inv = __builtin_amdgcn_exp2f(-(float)(lane & 7) * (L2_10000 / 8.f)); rope2(y0, y1, (lane < 8 ? grow : gcol) * inv); }
              *(GAS unsigned*)(KPEALL + (size_t)keyrow * 32 + 2 * lane) = pk2(y0, y1); } }
        { const v2u w = *(const GAS v2u*)(CKVR + (size_t)row * 256 + 4 * lane);
          float x[4] = {bflo(w.x), bfhi(w.x), bflo(w.y), bfhi(w.y)};
          const float ss = (x[0] * x[0] + x[1] * x[1]) + (x[2] * x[2] + x[3] * x[3]);
          const float rs = rsqrtf(wave_sum(ss) * (1.f / 256.f) + EPSN);
#pragma unroll
          for (int j = 0; j < 4; ++j) x[j] = x[j] * rs * gkv[4 * lane + j];
          if (!lat) *(GAS f32x4*)(outp + OUT_CKV + ((size_t)(b * 2 + l) * 256 + t) * 256 + 4 * lane) = (f32x4){x[0], x[1], x[2], x[3]};
          *(GAS v2u*)(CKVALL + (size_t)keyrow * 256 + 4 * lane) = (v2u){pk2(x[0], x[1]), pk2(x[2], x[3])}; }
    }
    LAS float* tile = (LAS float*)lds;
    const GAS float *sw = (const GAS float*)(a.in[19] + (size_t)l * 3 * 1536), *sb = (const GAS float*)(a.in[20] + (size_t)l * 1536);
    for (int it = bid; it < 96 * 12; it += G) {
        const int tb = it / 12, cb = it % 12, row0 = tb * 128;
        const bool lat = row0 >= TCTX; const int L = lat ? 2048 : 256;
        const int b = lat ? (row0 - TCTX) >> 11 : row0 >> 8, t0 = lat ? (row0 - TCTX) & 2047 : row0 & 255;
        v4u w[4], wh = (v4u){0u, 0u, 0u, 0u};
        { const int rr = tid >> 4, c8 = tid & 15;
#pragma unroll
          for (int q = 0; q < 4; ++q) w[q] = *(const GAS v4u*)(HYR + (size_t)(row0 + rr + 32 * q) * 1536 + cb * 128 + 8 * c8);
          if (tid < 32) { const int which = tid >> 4; const bool ok = which ? (t0 + 128 < L) : (t0 > 0); const int rsrc = which ? row0 + 128 : row0 - 1;
              if (ok) wh = *(const GAS v4u*)(HYR + (size_t)rsrc * 1536 + cb * 128 + 8 * c8); }
#pragma unroll
          for (int q = 0; q < 4; ++q) { LAS float* tp = tile + (rr + 32 * q + 1) * 129 + 8 * c8;
              tp[0] = bflo(w[q].x); tp[1] = bfhi(w[q].x); tp[2] = bflo(w[q].y); tp[3] = bfhi(w[q].y); tp[4] = bflo(w[q].z); tp[5] = bfhi(w[q].z); tp[6] = bflo(w[q].w); tp[7] = bfhi(w[q].w); }
          if (tid < 32) { LAS float* tp = tile + ((tid >> 4) ? 129 : 0) * 129 + 8 * c8;
              tp[0] = bflo(wh.x); tp[1] = bfhi(wh.x); tp[2] = bflo(wh.y); tp[3] = bfhi(wh.y); tp[4] = bflo(wh.z); tp[5] = bfhi(wh.z); tp[6] = bflo(wh.w); tp[7] = bfhi(wh.w); } }
        __syncthreads();
        { const int c = tid >> 2, tc = tid & 3, cg_ = cb * 128 + c; const float w0 = sw[cg_], w1 = sw[1536 + cg_], w2 = sw[3072 + cg_], bb = sb[cg_];
          const size_t base = lat ? (size_t)UT_LAT + ((size_t)b * 1536 + cg_) * 2048 : ((size_t)b * 1536 + cg_) * 256;
#pragma unroll
          for (int q = 0; q < 4; ++q) { float u[8];
#pragma unroll
              for (int k = 0; k < 8; ++k) { const int tr = 32 * tc + 8 * q + k; u[k] = w0 * tile[tr * 129 + c] + w1 * tile[(tr + 1) * 129 + c] + w2 * tile[(tr + 2) * 129 + c] + bb; }
              *(GAS v4u*)(UT + base + t0 + 32 * tc + 8 * q) = (v4u){pk2(u[0], u[1]), pk2(u[2], u[3]), pk2(u[4], u[5]), pk2(u[6], u[7])}; } }
        __syncthreads();
    }
}

__device__ __forceinline__ void ffnconv_phase(const Args& a, int l, int gt, int NGT) {
    const GAS bf16* U = (const GAS bf16*)(a.ws + WS_U); GAS bf16* ACT = (GAS bf16*)(a.ws + WS_ACT);
    const GAS float *cw = (const GAS float*)(a.in[31] + (size_t)l * 3 * 5632), *cb = (const GAS float*)(a.in[32] + (size_t)l * 5632);
#pragma unroll 1
    for (int idx = gt; idx < 1536 * 352; idx += NGT) {
        const int tb = idx / 352, ch = idx % 352, row0 = tb * 8, c0 = ch * 8;
        const bool lat = row0 >= TCTX; const int t0 = lat ? (row0 - TCTX) & 2047 : row0 & 255, L = lat ? 2048 : 256;
        v4u ra[10], rg[10];
#pragma unroll
        for (int i = 0; i < 10; ++i) { const int t = t0 + i - 1; const bool ok = (t >= 0) && (t < L); const size_t rr = (size_t)(row0 + (ok ? i - 1 : 0)) * 5632 + c0;
            ra[i] = *(const GAS v4u*)(U + rr); rg[i] = *(const GAS v4u*)(U + rr + 2816);
            if (!ok) { ra[i] = (v4u){0u, 0u, 0u, 0u}; rg[i] = (v4u){0u, 0u, 0u, 0u}; } }
        float wa[3][8], wg[3][8], ba[8], bg[8];
#pragma unroll
        for (int j = 0; j < 8; ++j) { ba[j] = cb[c0 + j]; bg[j] = cb[2816 + c0 + j];
#pragma unroll
            for (int k = 0; k < 3; ++k) { wa[k][j] = cw[k * 5632 + c0 + j]; wg[k][j] = cw[k * 5632 + 2816 + c0 + j]; } }
#pragma unroll
        for (int i = 0; i < 8; ++i) {
            float o[8];
#pragma unroll
            for (int j2 = 0; j2 < 4; ++j2) {
                const unsigned a0 = ra[i][j2], a1 = ra[i + 1][j2], a2 = ra[i + 2][j2], g0 = rg[i][j2], g1 = rg[i + 1][j2], g2 = rg[i + 2][j2];
                { const int j = 2 * j2; const float av = wa[0][j] * bflo(a0) + wa[1][j] * bflo(a1) + wa[2][j] * bflo(a2) + ba[j], gv = wg[0][j] * bflo(g0) + wg[1][j] * bflo(g1) + wg[2][j] * bflo(g2) + bg[j]; o[j] = gv * __builtin_amdgcn_rcpf(1.f + __expf(-gv)) * av; }
                { const int j = 2 * j2 + 1; const float av = wa[0][j] * bfhi(a0) + wa[1][j] * bfhi(a1) + wa[2][j] * bfhi(a2) + ba[j], gv = wg[0][j] * bfhi(g0) + wg[1][j] * bfhi(g1) + wg[2][j] * bfhi(g2) + bg[j]; o[j] = gv * __builtin_amdgcn_rcpf(1.f + __expf(-gv)) * av; } }
            *(GAS v4u*)(ACT + (size_t)(row0 + i) * 2816 + c0) = (v4u){pk2(o[0], o[1]), pk2(o[2], o[3]), pk2(o[4], o[5]), pk2(o[6], o[7])};
        }
    }
}
typedef float f32x2_t __attribute__((ext_vector_type(2)));
typedef __bf16 bf16x2_t __attribute__((ext_vector_type(2)));
__device__ __forceinline__ unsigned cvtpk(float lo, float hi) { const f32x2_t v = {lo, hi}; const bf16x2_t b = __builtin_convertvector(v, bf16x2_t); return __builtin_bit_cast(unsigned, b); }
template <int DK>
__device__ __forceinline__ void attn_unit(LAS unsigned char* lds, int tid, const bf16* Qp, int qpitch, const bf16* Kp, int kpitch, const bf16* Kpe, const bf16* Vt, size_t vpitch,
                                          int nkeys, bf16* Op, int opitch, float sl2, bool rope, int pos0) {
    constexpr int NS = DK / 16;
    asm volatile("" : "+v"(tid));
    const int lane = tid & 63, wave = tid >> 6, r = lane & 31, h = lane >> 5;
    bf16x8 qf[NS];
    { const bf16* qrow = Qp + (size_t)(wave * 32 + r) * qpitch;
#pragma unroll
      for (int s = 0; s < NS; ++s) qf[s] = *(const GAS bf16x8*)(qrow + 16 * s + 8 * h);
      if (DK == 96 && rope) { const int t = pos0 + wave * 32 + r; const float grow = (float)(t >> 6), gcol = (float)(t & 63);
#pragma unroll
          for (int sp = 0; sp < 2; ++sp) { bf16x8 v = qf[NS - 2 + sp];
#pragma unroll
              for (int k = 0; k < 4; ++k) { float x0 = bf1((bf16)v[2 * k]), x1 = bf1((bf16)v[2 * k + 1]);
                  const float inv = __builtin_amdgcn_exp2f(-(float)(4 * h + k) * (L2_10000 / 8.f)); rope2(x0, x1, (sp == 0 ? grow : gcol) * inv);
                  v[2 * k] = (short)f2bf(x0); v[2 * k + 1] = (short)f2bf(x1); }
              qf[NS - 2 + sp] = v; } } }
    const int kkey = tid >> 3, kch = tid & 7, pkey = tid >> 2, pch = tid & 3;
    f32x16 o0, o1;
#pragma unroll
    for (int i = 0; i < 16; ++i) { o0[i] = 0.f; o1[i] = 0.f; }
    float mrun = -__builtin_inff(), lrun = 0.f;
    v4u rk, rv, rp = (v4u){0u, 0u, 0u, 0u};
    const int ntile = nkeys >> 6;
#define ATT_LOAD(kt) do { const int key0 = (kt) * 64; rk = *(const GAS v4u*)(Kp + (size_t)(key0 + kkey) * kpitch + 8 * kch); rv = *(const GAS v4u*)(Vt + (size_t)kkey * vpitch + key0 + 8 * kch); \
        if (DK == 96 && tid < 256) rp = *(const GAS v4u*)(Kpe + (size_t)(key0 + pkey) * 32 + 8 * pch); } while (0)
#define ATT_WRITE(buf) do { *(LAS v4u*)(lds + (buf) * 13312 + kkey * 208 + kch * 16) = rk; \
        { LAS unsigned char* vw = lds + 26624 + (buf) * 9216 + kkey * 144 + (kch >> 1) * 32 + (kch & 1) * 8; *(LAS v2u*)vw = (v2u){rv.x, rv.y}; *(LAS v2u*)(vw + 16) = (v2u){rv.z, rv.w}; } \
        if (DK == 96 && tid < 256) *(LAS v4u*)(lds + (buf) * 13312 + pkey * 208 + 128 + pch * 16) = rp; } while (0)
    ATT_LOAD(0); ATT_WRITE(0); __syncthreads();
    for (int kt = 0; kt < ntile; ++kt) {
        const int buf = kt & 1;
        if (kt + 1 < ntile) ATT_LOAD(kt + 1);
        const LAS unsigned char* kb = lds + buf * 13312; const LAS unsigned char* vb = lds + 26624 + buf * 9216;
        f32x16 s0, s1;
#pragma unroll
        for (int i = 0; i < 16; ++i) { s0[i] = 0.f; s1[i] = 0.f; }
#pragma unroll
        for (int s = 0; s < NS; ++s) {
            const bf16x8 a0 = *(const LAS bf16x8*)(kb + r * 208 + (16 * s + 8 * h) * 2), a1 = *(const LAS bf16x8*)(kb + (32 + r) * 208 + (16 * s + 8 * h) * 2);
            s0 = __builtin_amdgcn_mfma_f32_32x32x16_bf16(a0, qf[s], s0, 0, 0, 0); s1 = __builtin_amdgcn_mfma_f32_32x32x16_bf16(a1, qf[s], s1, 0, 0, 0); }
        float mx = s0[0];
#pragma unroll
        for (int i = 1; i < 16; ++i) mx = fmaxf(mx, s0[i]);
#pragma unroll
        for (int i = 0; i < 16; ++i) mx = fmaxf(mx, s1[i]);
        mx = fmaxf(mx, __shfl_xor(mx, 32));
        const float mnew = fmaxf(mrun, mx), alpha = __builtin_amdgcn_exp2f((mrun - mnew) * sl2), nm = mnew * sl2;
        f32x2_t sum2 = {0.f, 0.f};
#pragma unroll
        for (int i = 0; i < 8; ++i) {
            f32x2_t t0 = {s0[2 * i], s0[2 * i + 1]}, t1 = {s1[2 * i], s1[2 * i + 1]};
            t0 = t0 * sl2 - nm; t1 = t1 * sl2 - nm;
            t0.x = __builtin_amdgcn_exp2f(t0.x); t0.y = __builtin_amdgcn_exp2f(t0.y); t1.x = __builtin_amdgcn_exp2f(t1.x); t1.y = __builtin_amdgcn_exp2f(t1.y);
            s0[2 * i] = t0.x; s0[2 * i + 1] = t0.y; s1[2 * i] = t1.x; s1[2 * i + 1] = t1.y;
            sum2 = sum2 + (t0 + t1); }
        lrun = lrun * alpha + (sum2.x + sum2.y); mrun = mnew;
        if (__builtin_amdgcn_ballot_w64(alpha != 1.f)) {
#pragma unroll
            for (int i = 0; i < 16; ++i) { o0[i] *= alpha; o1[i] *= alpha; } }
#pragma unroll
        for (int sub = 0; sub < 2; ++sub) {
#pragma unroll
            for (int s2 = 0; s2 < 2; ++s2) {
                const v4u pw = (sub == 0) ? (v4u){cvtpk(s0[8 * s2], s0[8 * s2 + 1]), cvtpk(s0[8 * s2 + 2], s0[8 * s2 + 3]), cvtpk(s0[8 * s2 + 4], s0[8 * s2 + 5]), cvtpk(s0[8 * s2 + 6], s0[8 * s2 + 7])}
                                          : (v4u){cvtpk(s1[8 * s2], s1[8 * s2 + 1]), cvtpk(s1[8 * s2 + 2], s1[8 * s2 + 3]), cvtpk(s1[8 * s2 + 4], s1[8 * s2 + 5]), cvtpk(s1[8 * s2 + 6], s1[8 * s2 + 7])};
                const bf16x8 pb = __builtin_bit_cast(bf16x8, pw);
                const int kofs = (32 * sub + 16 * s2 + 8 * h) * 2;
#pragma unroll
                for (int slab = 0; slab < 2; ++slab) {
                    const bf16x8 va = *(const LAS bf16x8*)(vb + (32 * slab + r) * 144 + kofs);
                    if (slab == 0) o0 = __builtin_amdgcn_mfma_f32_32x32x16_bf16(va, pb, o0, 0, 0, 0); else o1 = __builtin_amdgcn_mfma_f32_32x32x16_bf16(va, pb, o1, 0, 0, 0); } } }
        if (kt + 1 < ntile) ATT_WRITE(buf ^ 1);
        __syncthreads();
    }
#undef ATT_LOAD
#undef ATT_WRITE
    const float ltot = lrun + __shfl_xor(lrun, 32), inv = 1.f / ltot;
    bf16* orow = Op + (size_t)(wave * 32 + r) * opitch;
#pragma unroll
    for (int g4 = 0; g4 < 4; ++g4) {
        *(GAS v2u*)(orow + 8 * g4 + 4 * h) = (v2u){pk2(o0[4 * g4] * inv, o0[4 * g4 + 1] * inv), pk2(o0[4 * g4 + 2] * inv, o0[4 * g4 + 3] * inv)};
        *(GAS v2u*)(orow + 32 + 8 * g4 + 4 * h) = (v2u){pk2(o1[4 * g4] * inv, o1[4 * g4 + 1] * inv), pk2(o1[4 * g4 + 2] * inv, o1[4 * g4 + 3] * inv)}; }
}

template <bool LAT>
__device__ __forceinline__ void hyena_unit(const Args& a, int l, int c, LAS unsigned char* lds, int tid) {
    constexpr int L = LAT ? 2048 : 256, NB = LAT ? 4 : 16, NE = L / 16, NCH = L / 4, NW = LAT ? 8 : 4, ASH = LAT ? 2 : 4, MG = LAT ? 224 : 32  , UP = L + 2 * MG + 8  , GS = 514  ;
    asm volatile("" : "+v"(tid));
    const int lane = tid & 63, wave = tid >> 6, r = lane & 31, h = lane >> 5;
    const bf16* UT = (const bf16*)(a.ws + WS_UT) + (LAT ? UT_LAT : 0);
    GAS bf16* OC = (GAS bf16*)(a.ws + WS_OC);
    const float* HID = (const float*)(a.ws + WS_HID) + ((size_t)l * 2304 + (LAT ? 256 : 0)) * 64;
    LAS bf16* U = (LAS bf16*)lds; LAS bf16* X = (LAS bf16*)(lds + 20096); LAS float* FT = (LAS float*)(lds + 36480); LAS unsigned char* GC = lds + 69248;
    LAS float* W3 = (LAS float*)(lds + 135040); LAS float* RED = (LAS float*)(lds + 136064);
    constexpr int NQ = NB * L / 8 / 512;
    v4u x2r[NQ];
#pragma unroll
    for (int i = 0; i < NQ; ++i) { const int q = tid + 512 * i, b = q / (L / 8), off = (q % (L / 8)) * 8;
        const v4u uv = *(const GAS v4u*)(UT + ((size_t)b * 1536 + c) * L + off), xv = *(const GAS v4u*)(UT + ((size_t)b * 1536 + 512 + c) * L + off);
        x2r[i] = *(const GAS v4u*)(UT + ((size_t)b * 1536 + 1024 + c) * L + off);
        *(LAS v4u*)(U + b * UP + MG + off) = uv; *(LAS v4u*)(X + b * L + off) = xv; }
    for (int q = tid; q < NB * 2 * MG / 8; q += 512) { const int b = q / (2 * MG / 8), o = q % (2 * MG / 8); const int off = (o < MG / 8) ? 8 * o : MG + L + 8 * (o - MG / 8);
        *(LAS v4u*)(U + b * UP + off) = (v4u){0u, 0u, 0u, 0u}; }
    if (tid < 256) { const int j = tid >> 2, k = tid & 3; W3[k * 64 + j] = a.in[25][((size_t)l * 64 + j) * 2048 + (k >> 1) * 1024 + (k & 1) * 512 + c]; }
    __syncthreads();
#if defined(PROBE_HY) && PROBE_HY == 1
    for (int rep = 0; rep < 2; ++rep)
#endif
    { const float dmin = -15.350567286626973f, dmax = -3.0701134573253945f;
      const float delta = fabsf(dmin + (float)c * ((dmax - dmin) / 511.f));
      float p0 = 0.f, p1 = 0.f;
      for (int t = tid; t < L; t += 512) {
          float s[4] = {0.f, 0.f, 0.f, 0.f};
#pragma unroll 4
          for (int j4 = 0; j4 < 16; ++j4) { const f32x4 hv = *(const GAS f32x4*)(HID + (size_t)t * 64 + 4 * j4);
#pragma unroll
              for (int k = 0; k < 4; ++k) s[k] += hv.x * W3[k * 64 + 4 * j4] + hv.y * W3[k * 64 + 4 * j4 + 1] + hv.z * W3[k * 64 + 4 * j4 + 2] + hv.w * W3[k * 64 + 4 * j4 + 3]; }
          const float win = __expf(-((float)t / (float)(L - 1)) * delta);
#pragma unroll
          for (int k = 0; k < 4; ++k) { s[k] *= win; FT[k * L + t] = s[k]; }
          p0 += fabsf(s[0]) + (t >= 1 ? fabsf(s[2]) : 0.f); p1 += fabsf(s[1]) + (t >= 1 ? fabsf(s[3]) : 0.f); }
      p0 = wave_sum(p0); p1 = wave_sum(p1);
      if (lane == 0) { RED[2 * wave] = p0; RED[2 * wave + 1] = p1; } }
    __syncthreads();
    const int col = 32 * wave + r, ca = col >> ASH, cbat = col & (NB - 1);
    const int a_lo = (32 * wave) >> ASH, a_hi = (32 * wave + 31) >> ASH;
    const int rowbase = LAT ? TCTX + cbat * 2048 : cbat * 256;
#pragma unroll 1
    for (int n = 0; n < 2; ++n) {
        float l1s = 0.f;
#pragma unroll
        for (int w = 0; w < 8; ++w) l1s += RED[2 * w + n];
        const float invl1 = 1.f / (l1s + EPSN);
#if defined(PROBE_HY) && PROBE_HY == 4
        for (int rep = 0; rep < 2; ++rep)
#endif
        for (int q = tid; q < 8 * NCH; q += 512) { const int k = q & 7, y = q >> 3, m0 = L - (8 * y + k);
            float v[8];
#pragma unroll
            for (int j = 0; j < 8; ++j) { const int m = m0 - j; float t = 0.f; if (m >= 0 && m < L) t = FT[n * L + m]; else if (m < 0 && m > -L) t = FT[(2 + n) * L - m]; v[j] = t * invl1; }
            *(LAS v4u*)(GC + (k * GS + y) * 16) = (v4u){cvtpk(v[0], v[1]), cvtpk(v[2], v[3]), cvtpk(v[4], v[5]), cvtpk(v[6], v[7])}; }
        __syncthreads();
        f32x16 acc, acc1;
#if defined(PROBE_HY) && PROBE_HY == 3
        for (int rep = 0; rep < 2; ++rep) {
#endif
#pragma unroll
        for (int i = 0; i < 16; ++i) { acc[i] = 0.f; acc1[i] = 0.f; }
        if (wave < NW) {
            const int lam_lo = 2 * a_lo - (NE - 1), lam_hi = 2 * a_hi;
            const int xs0 = 8 * h - r + L;
            const LAS unsigned char* ap = GC + ((xs0 & 7) * GS + (xs0 >> 3) - 2 * lam_lo) * 16;
            const LAS unsigned char* bp = (const LAS unsigned char*)(U + cbat * UP + MG + 8 * h) + 32 * (2 * ca - lam_lo);
            bf16x8 a0 = *(const LAS bf16x8*)ap, b0 = *(const LAS bf16x8*)bp, a1 = *(const LAS bf16x8*)(ap - 32), b1 = *(const LAS bf16x8*)(bp - 32);
            for (int lam = lam_lo; lam <= lam_hi; lam += 2) {
                const bool more = lam + 2 <= lam_hi;
                if (more) { ap -= 64; bp -= 64; }
                const bf16x8 na0 = *(const LAS bf16x8*)ap, na1 = *(const LAS bf16x8*)(ap - 32), nb0 = *(const LAS bf16x8*)bp, nb1 = *(const LAS bf16x8*)(bp - 32);
                acc = __builtin_amdgcn_mfma_f32_32x32x16_bf16(a0, b0, acc, 0, 0, 0);
                acc1 = __builtin_amdgcn_mfma_f32_32x32x16_bf16(a1, b1, acc1, 0, 0, 0);
                a0 = na0; a1 = na1; b0 = nb0; b1 = nb1;
            }
#pragma unroll
            for (int i = 0; i < 16; ++i) acc[i] += acc1[i];
        }
#if defined(PROBE_HY) && PROBE_HY == 3
        asm volatile("" :: "v"(acc[0]), "v"(acc[5]));
        }
#endif
        const float bias = a.in[27][((size_t)l * 2 + n) * 512 + c];
        float z[16];
        if (wave < NW) {
#pragma unroll
            for (int g4 = 0; g4 < 4; ++g4) { const int t0 = 32 * ca + 8 * g4 + 4 * h;
                const v2u uw = *(const LAS v2u*)(U + cbat * UP + MG + t0), xw = *(const LAS v2u*)(X + cbat * L + t0);
                const float uv[4] = {bflo(uw.x), bfhi(uw.x), bflo(uw.y), bfhi(uw.y)}, xv[4] = {bflo(xw.x), bfhi(xw.x), bflo(xw.y), bfhi(xw.y)};
#pragma unroll
                for (int k = 0; k < 4; ++k) z[4 * g4 + k] = xv[k] * (acc[4 * g4 + k] + bias * uv[k]); }
        }
        __syncthreads();
        if (n == 0) {
            if (wave < NW) {
#pragma unroll
                for (int g4 = 0; g4 < 4; ++g4) *(LAS v2u*)(U + cbat * UP + MG + 32 * ca + 8 * g4 + 4 * h) = (v2u){pk2(z[4 * g4], z[4 * g4 + 1]), pk2(z[4 * g4 + 2], z[4 * g4 + 3])}; }
#pragma unroll
            for (int i = 0; i < NQ; ++i) { const int q = tid + 512 * i, b = q / (L / 8), off = (q % (L / 8)) * 8; *(LAS v4u*)(X + b * L + off) = x2r[i]; }
        } else if (wave < NW) {
#if defined(PROBE_HY) && PROBE_HY == 2
            for (int rep = 0; rep < 2; ++rep)
#endif
#pragma unroll
            for (int g4 = 0; g4 < 4; ++g4)
#pragma unroll
                for (int k = 0; k < 4; ++k) OC[(size_t)(rowbase + 32 * ca + 8 * g4 + 4 * h + k) * 512 + c] = (bf16)f2bf(z[4 * g4 + k]);
        }
    }
    __syncthreads();
}
#ifndef PHMASK
#define PHMASK 0x1fff
#endif
#define PH_ON(k) (((PHMASK) >> (k)) & 1)
#define L1_INV() do { asm volatile("s_waitcnt vmcnt(0)" ::: "memory"); __builtin_amdgcn_fence(__ATOMIC_ACQUIRE, "agent"); asm volatile("s_waitcnt vmcnt(0)" ::: "memory"); __syncthreads(); } while (0)
template <class T> __device__ __forceinline__ T* asglobal(T* p) { return (T*)(GAS T*)p; }
__global__ void __launch_bounds__(512, 2) mega_fwd(Args a) {
    extern __shared__ __attribute__((aligned(16))) unsigned char lds_raw[];
    LAS unsigned char* lds = (LAS unsigned char*)lds_raw;
    cg::grid_group grid = cg::this_grid();
    const int bid = blockIdx.x;
    using pg8::Gemm; using pg8::StaticOrder;
    const int ph_lo = a.ph_lo, ph_hi = a.ph_hi;
    volatile LAS unsigned* MISC = (volatile LAS unsigned*)(lds + LDS_BYTES - 64);
    if (threadIdx.x < 16) MISC[threadIdx.x] = 0u;
    __syncthreads();
    if (ph_hi > NPHASE) { __syncthreads(); grid.sync(); }
    XcdBarrier bar = xcd_barrier_post((unsigned*)(a.ws + WS_BAR + (size_t)a.li * BAR_REGION), MISC);
#pragma unroll 1
    for (int ph = ph_lo; ph < ph_hi; ++ph) {
        int tid = threadIdx.x; asm volatile("" : "+v"(tid));
        int G = gridDim.x; asm volatile("" : "+s"(G)); const int NGW = G * 8, NGT = G * 512;
        unsigned char* ws = a.ws; asm volatile("" : "+s"(ws));
#if defined(__HIP_DEVICE_COMPILE__)
#define ASSUME_GLOBAL(p) __builtin_assume(!__builtin_amdgcn_is_shared((const void*)(p)) && !__builtin_amdgcn_is_private((const void*)(p)))
#else
#define ASSUME_GLOBAL(p) ((void)0)
#endif
        ASSUME_GLOBAL(ws); ASSUME_GLOBAL(a.ws); ASSUME_GLOBAL(a.out);
#pragma unroll
        for (int i = 0; i < 35; ++i) ASSUME_GLOBAL(a.in[i]);
        const int lane = tid & 63, wave = __builtin_amdgcn_readfirstlane(tid >> 6), gw = bid * 8 + wave, gt = bid * 512 + tid;
        const int l = (ph >= 1 && ph < 23) ? (ph - 1) / 11 : 0, sub = (ph >= 1 && ph < 23) ? (ph - 1) % 11 : -1;
        float* mod = (float*)(ws + WS_MOD) + (size_t)l * 5 * 6144;
        bool did = true;
        if (PH_ON(11) && ph == 0) { p0_mod_hid(a, lds, bid, G, tid, gw, NGW, lane); wconv_phase(a, 0, 0, lds, gw, NGW, gt, NGT, wave, lane); }
        else if (PH_ON(12) && ph == 23 && G == 256) { did = false; }
        else if (PH_ON(12) && ph == 23) { norm_phase(a, 0, 2, false, false, gw, NGW, lane); }
        else if (PH_ON(0) && sub == 0 && l == 1 && G == 256) { did = false; }
        else if (PH_ON(0) && sub == 0) { if (l == 1) wconv_phase(a, 1, 0, lds, gw, NGW, gt, NGT, wave, lane);     norm_phase(a, l, 0, l == 0, G != 256, gw, NGW, lane); }
        else if (PH_ON(1) && sub == 1) {
            Gemm g{(const bf16*)(ws + WS_HBF1), (const bf16*)(ws + WS_WIN), TT, 4096, 1024, 1024, 1024}; StaticOrder S; S.init(TT, 4096, G, bid);
            pg8::EpiSeg E{(bf16*)(ws + WS_QA), (bf16*)(ws + WS_KVR), (bf16*)(ws + WS_CQ), (bf16*)(ws + WS_CKVR), (bf16*)(ws + WS_HYR), (bf16*)(ws + WS_S0)};
            pg8::gemm_phase<pg8::EpiSeg, StaticOrder, true, true>(lds, g, S, E);
        }
        else if (PH_ON(2) && sub == 2) { post_phase(a, l, lds, bid, G, tid, gw, NGW, gt, NGT, lane); }
        else if (PH_ON(3) && sub == 3) {
#pragma unroll 1
            for (int q = 0; q < 3; ++q) {
                Gemm g; StaticOrder S; pg8::EpiStore<0> E;
                if (q == 0) { g = Gemm{(const bf16*)(ws + WS_CQ), (const bf16*)(ws + WS_WUQ), TT, 768, 384, 512, 384}; S.init(TT, 768, G, bid); E = pg8::EpiStore<0>{(bf16*)(ws + WS_QB), 768}; }
                else if (q == 1) { g = Gemm{(const bf16*)(ws + WS_CKVALL), (const bf16*)(ws + WS_WKN), NKEYROWS, 512, 256, 256, 256}; S.init(NKEYROWS, 512, G, (bid + G - 144 % G) % G); E = pg8::EpiStore<0>{(bf16*)(ws + WS_KNB), 512}; }
                else { g = Gemm{(const bf16*)(ws + WS_WVV), (const bf16*)(ws + WS_CKVALL), 512, NKEYROWS, 256, 256, 256}; S.init(512, NKEYROWS, G, (bid + G - 248 % G) % G); E = pg8::EpiStore<0>{(bf16*)(ws + WS_VTB), NKEYROWS}; }
                pg8::gemm_phase<pg8::EpiStore<0>, StaticOrder, true, true>(lds, g, S, E);
            }
        }
        else if (PH_ON(4) && sub == 4) {
            const bf16 *QA = (const bf16*)(ws + WS_QA), *QB = (const bf16*)(ws + WS_QB), *KA = (const bf16*)(ws + WS_KA), *VTA = (const bf16*)(ws + WS_VTA);
            const bf16 *KNB = (const bf16*)(ws + WS_KNB), *VTB = (const bf16*)(ws + WS_VTB), *KPE = (const bf16*)(ws + WS_KPEALL);
            bf16 *OA = (bf16*)(ws + WS_OA), *OB = (bf16*)(ws + WS_OB);
            const float slA = 0.125f * 1.4426950408889634f, slB = 0.10206207261596575f * 1.4426950408889634f;
            const int sel = a.pad;
            for (int it = bid; it < 1792; it += G) {
                { const bool is_hy = (it >= 512 && it < 1024) || it >= 1280; if ((sel == 1 && is_hy) || (sel == 2 && !is_hy)) continue; }
                if (it < 256 || (it >= 1024 && it < 1152)) {
                    const bool lat = it < 256; const int u = lat ? (G == 256 ? ((bid & 7) * 4 + (bid >> 6)) * 8 + ((bid >> 3) & 7) : it) : it - 1024;
                    const int b = lat ? u >> 6 : u >> 3, hh = lat ? (u >> 3) & 7 : u & 7, qb = lat ? u & 7 : 0;
                    const int row0 = lat ? TCTX + b * 2048 + qb * 256 : b * 256, key0 = lat ? TCTX + b * 2304 : b * 256;
                    attn_unit<96>(lds, tid, QB + (size_t)row0 * 768 + hh * 96, 768, KNB + (size_t)key0 * 512 + hh * 64, 512, KPE + (size_t)key0 * 32, VTB + (size_t)(hh * 64) * NKEYROWS + key0, NKEYROWS,
                                  lat ? 2304 : 256, OB + (size_t)row0 * 512 + hh * 64, 512, slB, lat, qb * 256);
                } else if (it < 512 || (it >= 1152 && it < 1280)) {
                    const bool lat = it < 512; const int u = lat ? (G == 256 ? ((bid & 7) * 4 + (bid >> 6)) * 8 + ((bid >> 3) & 7) : it - 256) : it - 1152;
                    const int b = lat ? u >> 6 : u >> 3, hh = lat ? (u >> 3) & 7 : u & 7, qb = lat ? u & 7 : 0, kvh = hh >> 2;
                    const int row0 = lat ? TCTX + b * 2048 + qb * 256 : b * 256, nk = lat ? 2304 : 256;
                    const size_t kbase = lat ? (size_t)KA_LAT + (size_t)(b * 2 + kvh) * 2304 * 64 : (size_t)(b * 2 + kvh) * 256 * 64;
                    attn_unit<64>(lds, tid, QA + (size_t)row0 * 512 + hh * 64, 512, KA + kbase, 64, nullptr, VTA + kbase, nk, nk, OA + (size_t)row0 * 512 + hh * 64, 512, slA, false, 0);
                } else if (it < 1024) { hyena_unit<true>(a, l, it - 512, lds, tid); }
                else { hyena_unit<false>(a, l, it - 1280, lds, tid); }
            }
        }
        else if (PH_ON(5) && sub == 5) {
            static_assert(WS_S1 + 121 * MiB == WS_S0 && WS_S2 + 97 * MiB == WS_S0, "gate buffer arithmetic");
            bf16 *S0 = (bf16*)(ws + WS_S0), *MBF = (bf16*)(ws + WS_MBF);
            { Gemm g{(const bf16*)(ws + WS_HBF1), (const bf16*)(ws + WS_WG), TT, 2048, 1024, 1024, 1024}; StaticOrder S; S.init(TT, 2048, G, bid);
              pg8::EpiGate E{S0}; pg8::gemm_phase<pg8::EpiGate, StaticOrder, true, true>(lds, g, S, E); }
            xcd_barrier(bar);
            { Gemm g{(const bf16*)(ws + WS_OA), (const bf16*)(ws + WS_WB), TT, 1024, 512, 512, 512, (size_t)TT * 512 * 2, (size_t)1024 * 512 * 2};
              pg8::BatchOrder<3> S; S.init(TT, 1024, G, bid);
              pg8::EpiMerge E{S0, MBF}; pg8::gemm_phase<pg8::EpiMerge, pg8::BatchOrder<3>, true, true>(lds, g, S, E); }
        }
        else if (PH_ON(6) && sub == 6) {
            Gemm g{(const bf16*)(ws + WS_MBF), (const bf16*)(ws + WS_WO), TT, 1024, 1024, 1024, 1024}; StaticOrder S; S.init(TT, 1024, G, bid);
            if (G == 256) { pg8::EpiResNorm E{a.out, (l == 0) ? a.in[0] : a.out, (l == 0) ? a.in[1] - (size_t)TCTX * DM : a.out, mod + 2048, a.in[11] + l * 1024, mod, 3072, 4096, (bf16*)(ws + WS_HBF), (float*)(ws + WS_SLOT), (unsigned*)(ws + WS_CNT) + (size_t)(l * 2) * 48 * 16, 0};
                pg8::gemm_phase<pg8::EpiResNorm, StaticOrder, true, true>(lds, g, S, E); }
            else { pg8::EpiResid E{a.out, mod + 2048}; pg8::gemm_phase<pg8::EpiResid, StaticOrder, true, true>(lds, g, S, E); }
        }
        else if (PH_ON(7) && sub == 7 && G == 256) { did = false; }
        else if (PH_ON(7) && sub == 7) { norm_phase(a, l, 1, false, false, gw, NGW, lane); }
        else if (PH_ON(8) && sub == 8) {
            Gemm g{(const bf16*)(ws + WS_HBF), (const bf16*)(ws + WS_WUP), TT, 5632, 1024, 1024, 1024}; StaticOrder S; S.init(TT, 5632, G, bid);
            pg8::EpiStore<0> E{(bf16*)(ws + WS_U), 5632}; pg8::gemm_phase<pg8::EpiStore<0>, StaticOrder, true, true>(lds, g, S, E);
        }
        else if (PH_ON(9) && sub == 9) { ffnconv_phase(a, l, gt, NGT); }
        else if (PH_ON(10) && sub == 10) {
            Gemm g{(const bf16*)(ws + WS_ACT), (const bf16*)(ws + WS_WDN), TT, 1024, 2816, 2816, 2816}; StaticOrder S; S.init(TT, 1024, G, bid);
            if (G == 256) {
                const float* modnext = (const float*)(ws + WS_MOD) + (size_t)5 * 6144;
                pg8::EpiResNorm E{a.out, a.out, a.out, mod + 5120, (l == 0) ? a.in[10] + 1024 : a.in[34], modnext, 0, 1024, (bf16*)(ws + WS_HBF1), (float*)(ws + WS_SLOT), (unsigned*)(ws + WS_CNT) + (size_t)(l * 2 + 1) * 48 * 16, l};
                pg8::gemm_phase<pg8::EpiResNorm, StaticOrder, true, true>(lds, g, S, E); }
            else { pg8::EpiResid E{a.out, mod + 5120}; pg8::gemm_phase<pg8::EpiResid, StaticOrder, true, true>(lds, g, S, E); }
            if (l == 0 && G == 256 && bid >= 192)
                wconv_phase(a, 1, 1, lds, (bid - 192) * 8 + wave, 64 * 8, (bid - 192) * 512 + tid, 64 * 512, wave, lane);
        }
#ifdef EXTRA_SYNCS
        for (int q = 0; q < EXTRA_SYNCS; ++q) { __syncthreads(); grid.sync(); }
#endif
        if (did && ph + 1 < ph_hi) xcd_barrier(bar);
    }
}

extern "C" void kernel_launch(void* const* d_in, const int* in_sizes, int n_in, void* d_out, int out_size, void* d_ws, size_t ws_size, hipStream_t stream) {
    static int grid = 0;
    if (grid == 0) {
        if (n_in != 35 || ws_size < WS_END) { fprintf(stderr, "kernel_launch: unexpected n_in %d / ws %zu\n", n_in, ws_size); grid = -1; return; }
        int dev = 0, cus = 0, per_cu = 0;
        if (hipGetDevice(&dev) != hipSuccess || hipDeviceGetAttribute(&cus, hipDeviceAttributeMultiprocessorCount, dev) != hipSuccess) { grid = -1; return; }
        if (hipFuncSetAttribute((const void*)mega_fwd, hipFuncAttributeMaxDynamicSharedMemorySize, LDS_BYTES) != hipSuccess) { fprintf(stderr, "kernel_launch: hipFuncSetAttribute failed\n"); grid = -1; return; }
        if (hipOccupancyMaxActiveBlocksPerMultiprocessor(&per_cu, (const void*)mega_fwd, 512, LDS_BYTES) != hipSuccess || per_cu < 1) { fprintf(stderr, "kernel_launch: occupancy query says %d\n", per_cu); per_cu = 1; }
        (void)hipGetLastError();
        grid = cus;
    }
    if (grid < 0) return;
    if (hipMemsetAsync((char*)d_ws + WS_MOD, 0, ZERO_BYTES, stream) != hipSuccess) { fprintf(stderr, "kernel_launch: memset failed\n"); return; }
    Args a{};
    for (int i = 0; i < 35; ++i) a.in[i] = (const float*)d_in[i];
    a.out = (float*)d_out; a.ws = (unsigned char*)d_ws;
#if defined(MK_PER_PHASE)
    for (int p = 0; p < NPHASE; ++p) { a.ph_lo = p; a.ph_hi = p + 1; a.li = 0; void* args[] = {&a};
        hipError_t e = hipLaunchCooperativeKernel((const void*)mega_fwd, dim3(grid), dim3(512), args, LDS_BYTES, stream);
        if (e != hipSuccess) { fprintf(stderr, "launch %d failed: %s\n", p, hipGetErrorString(e)); break; } }
#else
#if defined(PROBE_SUB)
#ifndef PROBE_SEL
#define PROBE_SEL 0
#endif
    { const int k0 = 1 + PROBE_SUB, k1 = 12 + PROBE_SUB; const int cuts[6][2] = {{0, k0 + 1}, {k0, k0 + 1}, {k0 + 1, k1 + 1}, {k1, k1 + 1}, {k1 + 1, NPHASE}, {0, 0}};
      for (int c = 0; c < 5; ++c) { a.ph_lo = cuts[c][0]; a.ph_hi = cuts[c][1]; a.li = c; a.pad = (c == 1 || c == 3) ? PROBE_SEL : 0; if (a.ph_lo >= a.ph_hi) continue; void* args[] = {&a};
          hipError_t e = hipLaunchCooperativeKernel((const void*)mega_fwd, dim3(grid), dim3(512), args, LDS_BYTES, stream);
          if (e != hipSuccess) { fprintf(stderr, "cooperative launch failed: %s\n", hipGetErrorString(e)); break; } } }
#elif defined(PROBE_CUTS)
    { const int k0 = 1 + PROBE_CUTS, k1 = 12 + PROBE_CUTS; const int cuts[4][2] = {{0, k0 + 1}, {k0 + 1, k1 + 1}, {k1 + 1, NPHASE}, {0, 0}};
      for (int c = 0; c < 3; ++c) { a.ph_lo = cuts[c][0]; a.ph_hi = cuts[c][1]; a.li = c; if (a.ph_lo >= a.ph_hi) continue; void* args[] = {&a};
          hipError_t e = hipLaunchCooperativeKernel((const void*)mega_fwd, dim3(grid), dim3(512), args, LDS_BYTES, stream);
          if (e != hipSuccess) { fprintf(stderr, "cooperative launch failed: %s\n", hipGetErrorString(e)); break; } } }
#else
    a.ph_lo = 0; a.ph_hi = NPHASE; void* args[] = {&a};
    hipError_t e = hipLaunchCooperativeKernel((const void*)mega_fwd, dim3(grid), dim3(512), args, LDS_BYTES, stream);
    if (e != hipSuccess) fprintf(stderr, "cooperative launch failed: %s (grid %d)\n", hipGetErrorString(e), grid);
#endif
#endif
}
```

```cpp
#include <hip/hip_runtime.h>
#include <hip/hip_cooperative_groups.h>
#include <cstdio>
#include <cstdint>
namespace cg = cooperative_groups;
namespace pg8 {
#define PG8_LAS __attribute__((address_space(3)))
typedef unsigned short bf16_t;
typedef short bf16x8 __attribute__((ext_vector_type(8)));
typedef float f32x4 __attribute__((ext_vector_type(4)));
typedef unsigned u32x4 __attribute__((ext_vector_type(4)));
constexpr int BM = 256, BK = 64, HALF = 128, HTB = HALF * BK * 2  , STAGE_BYTES = 8 * HTB, NXCD = 8, WGM = 8;

__host__ __device__ __forceinline__ int lds_byte(int r, int c) { const int st = (r >> 4) * 2 + (c >> 5), rr = r & 15, cc = c & 31, ob = rr * 64 + cc * 2; return st * 1024 + (ob ^ (((ob >> 9) & 1) << 5)); }
__host__ __device__ __forceinline__ void stage_rc(int b, int& R, int& C) { const int st = b / 1024, sb = b % 1024, swz = sb ^ (((sb >> 9) & 1) << 5); R = (st >> 1) * 16 + swz / 64; C = (st & 1) * 32 + (swz % 64) / 2; }
__host__ __device__ __forceinline__ int perm32(int rho) { const int n = rho >> 4, i = rho & 15; return 8 * (i >> 2) + 4 * n + (i & 3); }

struct Unit { int pm, pn, gi; };
struct Gemm { const bf16_t* A; const bf16_t* Bt; int M, N, K, lda, ldb; size_t gsA, gsB; };

struct StaticOrder {
    int nM, nN, nwg, G, c;
    __host__ __device__ void init(int M, int N, int G_, int c_) { nM = M / BM; nN = N / BM; nwg = nM * nN; G = G_; c = c_; }
    __host__ __device__ bool next(int i, Unit& u) const {
        const long L = (long)i * G + c; if (L >= nwg) return false;
        int wgid = (int)L; { const int q = nwg / NXCD, r = nwg % NXCD, xcd = wgid % NXCD, off = wgid / NXCD; wgid = (xcd < r ? xcd * (q + 1) : r * (q + 1) + (xcd - r) * q) + off; }
        const int nig = WGM * nN, gid = wgid / nig, fm = gid * WGM, gsz = (nM - fm) < WGM ? (nM - fm) : WGM;
        u.pm = fm + ((wgid % nig) % gsz); u.pn = (wgid % nig) / gsz; u.gi = 0; return true;
    }
    __device__ __forceinline__ void a_ready(const Unit&) const {}
    __device__ __forceinline__ void done(const Unit&) const {}
};
template <int N0, int N1, int NN0, int NN1> struct PairOrder {
    int G, c;
    __host__ __device__ bool next(int i, Unit& u) const { const int L = i * G + c; if (L >= N0 + N1) return false;
        if (L < N0) { u.pm = L / NN0; u.pn = L % NN0; u.gi = 0; } else { const int q = L - N0; u.pm = q / NN1; u.pn = q % NN1; u.gi = 1; } return true; }
    __device__ __forceinline__ void a_ready(const Unit&) const {}
    __device__ __forceinline__ void done(const Unit&) const {}
};
template <int NB> struct BatchOrder : StaticOrder {
    __host__ __device__ bool next(int i, Unit& u) const { if (i >= NB) return false; if (!StaticOrder::next(0, u)) return false; u.gi = i; return true; }
};


#ifndef GAS
#define GAS __attribute__((address_space(1)))
#endif
typedef float f32x2v __attribute__((ext_vector_type(2)));
typedef __bf16 bf16x2v __attribute__((ext_vector_type(2)));
__device__ __forceinline__ unsigned cvt_pk_bf16(float lo, float hi) { const f32x2v v = {lo, hi}; const bf16x2v b = __builtin_convertvector(v, bf16x2v); return __builtin_bit_cast(unsigned, b); }
__device__ __forceinline__ float sigm(float x) { return __builtin_amdgcn_rcpf(1.f + __expf(-x)); }
#define EPI_FOR _Pragma("unroll") for (int ai = 0; ai < 2; ++ai) _Pragma("unroll") for (int m = 0; m < 4; ++m) _Pragma("unroll") for (int bj = 0; bj < 2; ++bj)

template <int ACT  > struct EpiStore {
    static constexpr bool PERM = true, AFTER_DRAIN = false;
    bf16_t* O; int ld;
    __device__ __forceinline__ void operator()(const f32x4 (&acc)[2][2][4][2], const Unit& u, int wr, int wc, int fr, int fq) const {
        const int row0 = u.pm * BM + wr * 64 + fr, col0 = u.pn * BM + wc * 32 + 8 * fq;
        EPI_FOR { f32x4 v0 = acc[ai][bj][m][0], v1 = acc[ai][bj][m][1];
            if (ACT == 1) { v0 = (f32x4){sigm(v0[0]), sigm(v0[1]), sigm(v0[2]), sigm(v0[3])}; v1 = (f32x4){sigm(v1[0]), sigm(v1[1]), sigm(v1[2]), sigm(v1[3])}; }
            u32x4 w; w.x = cvt_pk_bf16(v0[0], v0[1]); w.y = cvt_pk_bf16(v0[2], v0[3]); w.z = cvt_pk_bf16(v1[0], v1[1]); w.w = cvt_pk_bf16(v1[2], v1[3]);
            *(GAS u32x4*)(O + (size_t)(row0 + ai * HALF + m * 16) * ld + col0 + bj * HALF) = w; }
    }
};
struct EpiPair {
    static constexpr bool PERM = true, AFTER_DRAIN = false;
    bf16_t *O0, *O1; int ld0, ld1;
    __device__ __forceinline__ void operator()(const f32x4 (&acc)[2][2][4][2], const Unit& u, int wr, int wc, int fr, int fq) const {
        bf16_t* O = u.gi ? O1 : O0; const int ld = u.gi ? ld1 : ld0;
        const int row0 = u.pm * BM + wr * 64 + fr, col0 = u.pn * BM + wc * 32 + 8 * fq;
        EPI_FOR { const f32x4 v0 = acc[ai][bj][m][0], v1 = acc[ai][bj][m][1];
            u32x4 w; w.x = cvt_pk_bf16(v0[0], v0[1]); w.y = cvt_pk_bf16(v0[2], v0[3]); w.z = cvt_pk_bf16(v1[0], v1[1]); w.w = cvt_pk_bf16(v1[2], v1[3]);
            *(GAS u32x4*)(O + (size_t)(row0 + ai * HALF + m * 16) * ld + col0 + bj * HALF) = w; }
    }
};
struct EpiSeg {
    static constexpr bool PERM = true, AFTER_DRAIN = false;
    bf16_t *QA, *KV, *CQ, *CKV, *HY, *S0;
    __device__ __forceinline__ void operator()(const f32x4 (&acc)[2][2][4][2], const Unit& u, int wr, int wc, int fr, int fq) const {
        bf16_t* base; int ld, coff; const int pn = u.pn;
        if (pn < 2) { base = QA; ld = 512; coff = 256 * pn; } else if (pn == 2) { base = KV; ld = 256; coff = 0; } else if (pn < 5) { base = CQ; ld = 512; coff = 256 * (pn - 3); }
        else if (pn == 5) { base = CKV; ld = 256; coff = 0; } else if (pn < 12) { base = HY; ld = 1536; coff = 256 * (pn - 6); } else { base = S0; ld = 1024; coff = 256 * (pn - 12); }
        const bool gate = pn >= 12;
        const int row0 = u.pm * BM + wr * 64 + fr, col0 = coff + wc * 32 + 8 * fq;
        EPI_FOR { f32x4 v0 = acc[ai][bj][m][0], v1 = acc[ai][bj][m][1];
            if (gate) { v0 = (f32x4){sigm(v0[0]), sigm(v0[1]), sigm(v0[2]), sigm(v0[3])}; v1 = (f32x4){sigm(v1[0]), sigm(v1[1]), sigm(v1[2]), sigm(v1[3])}; }
            u32x4 w; w.x = cvt_pk_bf16(v0[0], v0[1]); w.y = cvt_pk_bf16(v0[2], v0[3]); w.z = cvt_pk_bf16(v1[0], v1[1]); w.w = cvt_pk_bf16(v1[2], v1[3]);
            *(GAS u32x4*)(base + (size_t)(row0 + ai * HALF + m * 16) * ld + col0 + bj * HALF) = w; }
    }
};
struct EpiGate {
    static constexpr bool PERM = true, AFTER_DRAIN = false;
    bf16_t* S0;
    __device__ __forceinline__ void operator()(const f32x4 (&acc)[2][2][4][2], const Unit& u, int wr, int wc, int fr, int fq) const {
        const int n = 1 + (u.pn >> 2); bf16_t* base = (bf16_t*)((unsigned char*)S0 - (size_t)((n + 1) >> 1) * (121u << 20) + (size_t)(n >> 1) * (24u << 20));
        const int row0 = u.pm * BM + wr * 64 + fr, col0 = (u.pn & 3) * BM + wc * 32 + 8 * fq;
        EPI_FOR { f32x4 v0 = acc[ai][bj][m][0], v1 = acc[ai][bj][m][1];
            v0 = (f32x4){sigm(v0[0]), sigm(v0[1]), sigm(v0[2]), sigm(v0[3])}; v1 = (f32x4){sigm(v1[0]), sigm(v1[1]), sigm(v1[2]), sigm(v1[3])};
            u32x4 w; w.x = cvt_pk_bf16(v0[0], v0[1]); w.y = cvt_pk_bf16(v0[2], v0[3]); w.z = cvt_pk_bf16(v1[0], v1[1]); w.w = cvt_pk_bf16(v1[2], v1[3]);
            *(GAS u32x4*)(base + (size_t)(row0 + ai * HALF + m * 16) * 1024 + col0 + bj * HALF) = w; }
    }
};
struct EpiMerge {
    static constexpr bool PERM = true, AFTER_DRAIN = false;
    const bf16_t* S0; bf16_t* M;
    __device__ __forceinline__ void operator()(const f32x4 (&acc)[2][2][4][2], const Unit& u, int wr, int wc, int fr, int fq) const {
        const int row0 = u.pm * BM + wr * 64 + fr, col0 = u.pn * BM + wc * 32 + 8 * fq;
        const int MODE = u.gi; const bf16_t* S = (const bf16_t*)((const unsigned char*)S0 - (size_t)((u.gi + 1) >> 1) * (121u << 20) + (size_t)(u.gi >> 1) * (24u << 20));
        EPI_FOR { const size_t off = (size_t)(row0 + ai * HALF + m * 16) * 1024 + col0 + bj * HALF;
            const u32x4 sw = *(const GAS u32x4*)(S + off);
            f32x4 s0 = (f32x4){__uint_as_float(sw.x << 16), __uint_as_float(sw.x & 0xffff0000u), __uint_as_float(sw.y << 16), __uint_as_float(sw.y & 0xffff0000u)};
            f32x4 s1 = (f32x4){__uint_as_float(sw.z << 16), __uint_as_float(sw.z & 0xffff0000u), __uint_as_float(sw.w << 16), __uint_as_float(sw.w & 0xffff0000u)};
            f32x4 v0 = acc[ai][bj][m][0] * s0, v1 = acc[ai][bj][m][1] * s1;
            if (MODE >= 1) { const u32x4 mw = *(const GAS u32x4*)(M + off);
                v0 = v0 + (f32x4){__uint_as_float(mw.x << 16), __uint_as_float(mw.x & 0xffff0000u), __uint_as_float(mw.y << 16), __uint_as_float(mw.y & 0xffff0000u)};
                v1 = v1 + (f32x4){__uint_as_float(mw.z << 16), __uint_as_float(mw.z & 0xffff0000u), __uint_as_float(mw.w << 16), __uint_as_float(mw.w & 0xffff0000u)}; }
            u32x4 w; w.x = cvt_pk_bf16(v0[0], v0[1]); w.y = cvt_pk_bf16(v0[2], v0[3]); w.z = cvt_pk_bf16(v1[0], v1[1]); w.w = cvt_pk_bf16(v1[2], v1[3]); *(GAS u32x4*)(M + off) = w; }
    }
};
struct EpiResid {
    static constexpr bool PERM = true, AFTER_DRAIN = false;
    float* X; const float* gate;
    __device__ __forceinline__ void operator()(const f32x4 (&acc)[2][2][4][2], const Unit& u, int wr, int wc, int fr, int fq) const {
        const int row0 = u.pm * BM + wr * 64 + fr, col0 = u.pn * BM + wc * 32 + 8 * fq;
        const int mrow = (u.pm < 16) ? 0 : 1 + ((u.pm - 16) >> 3);
        const float* gp = gate + (size_t)mrow * 6144 + col0;
        f32x4 g[2][2];
#pragma unroll
        for (int bj = 0; bj < 2; ++bj) { g[bj][0] = *(const GAS f32x4*)(gp + bj * HALF); g[bj][1] = *(const GAS f32x4*)(gp + bj * HALF + 4); }
        EPI_FOR { float* xp = X + (size_t)(row0 + ai * HALF + m * 16) * 1024 + col0 + bj * HALF;
            const f32x4 x0 = *(const GAS f32x4*)xp, x1 = *(const GAS f32x4*)(xp + 4);
            *(GAS f32x4*)xp = x0 + g[bj][0] * acc[ai][bj][m][0]; *(GAS f32x4*)(xp + 4) = x1 + g[bj][1] * acc[ai][bj][m][1]; }
    }
};

struct EpiResNorm {
    static constexpr bool PERM = true, AFTER_DRAIN = true;
    float* X; const float* Xr0; const float* Xr1;
    const float* gate; const float* nw; const float* modn; int shoff, scoff; bf16_t* H; float* slots; unsigned* cnt; int mode;
    __device__ __forceinline__ void fused(f32x4 (&acc)[2][2][4][2], const Unit& u, int wr, int wc, int fr, int fq, PG8_LAS unsigned char* lds, int wid, int lane) const {
        const int tid = wid * 64 + lane;
        const int row0 = u.pm * BM + wr * 64 + fr, col0 = u.pn * BM + wc * 32 + 8 * fq;
        const int mrow = (u.pm < 16) ? 0 : 1 + ((u.pm - 16) >> 3);
        PG8_LAS float* red = (PG8_LAS float*)lds;
        PG8_LAS float* rsv = (PG8_LAS float*)(lds + 8192);
        const float* xr = (u.pm < 16) ? Xr0 : Xr1;
        { const float* gp = gate + (size_t)mrow * 6144 + col0;
          f32x4 g[2][2];
#pragma unroll
          for (int bj = 0; bj < 2; ++bj) { g[bj][0] = *(const GAS f32x4*)(gp + bj * HALF); g[bj][1] = *(const GAS f32x4*)(gp + bj * HALF + 4); }
#pragma unroll
          for (int ai = 0; ai < 2; ++ai)
#pragma unroll
              for (int m = 0; m < 4; ++m) { float ss = 0.f;
#pragma unroll
                  for (int bj = 0; bj < 2; ++bj) { const float* xp = xr + (size_t)(row0 + ai * HALF + m * 16) * 1024 + col0 + bj * HALF;
                      const f32x4 v0 = *(const GAS f32x4*)xp + g[bj][0] * acc[ai][bj][m][0], v1 = *(const GAS f32x4*)(xp + 4) + g[bj][1] * acc[ai][bj][m][1];
                      acc[ai][bj][m][0] = v0; acc[ai][bj][m][1] = v1;
                      ss += (v0[0] * v0[0] + v0[1] * v0[1]) + (v0[2] * v0[2] + v0[3] * v0[3]) + (v1[0] * v1[0] + v1[1] * v1[1]) + (v1[2] * v1[2] + v1[3] * v1[3]); }
                  ss += __shfl_xor(ss, 16); ss += __shfl_xor(ss, 32);
                  if (fq == 0) red[((wr * 4 + wc) * 8 + ai * 4 + m) * 16 + fr] = ss; } }
        __syncthreads();
        float* myslot = slots + (size_t)(u.pm * 4 + u.pn) * 256;
        if (tid < 256) { const int ai = tid >> 7, w2 = (tid >> 6) & 1, m = (tid >> 4) & 3, f = tid & 15;
            float t = 0.f;
#pragma unroll
            for (int c = 0; c < 4; ++c) t += red[((w2 * 4 + c) * 8 + ai * 4 + m) * 16 + f];
            __hip_atomic_store((GAS float*)myslot + tid, t, __ATOMIC_RELAXED, __HIP_MEMORY_SCOPE_AGENT); }
        asm volatile("s_waitcnt vmcnt(0)" ::: "memory");
        __syncthreads();
        GAS unsigned* pc = (GAS unsigned*)cnt + (size_t)u.pm * 16;
        if (tid == 0) { __hip_atomic_fetch_add(pc, 1u, __ATOMIC_RELAXED, __HIP_MEMORY_SCOPE_AGENT);
            unsigned sp = 0; while (__hip_atomic_load(pc, __ATOMIC_RELAXED, __HIP_MEMORY_SCOPE_AGENT) < 4u && ++sp < (1u << 22)) __builtin_amdgcn_s_sleep(1); }
        __syncthreads();
        if (tid < 256) { float t = 0.f;
#pragma unroll
            for (int c = 0; c < 4; ++c) t += __hip_atomic_load((GAS float*)slots + (size_t)(u.pm * 4 + c) * 256 + tid, __ATOMIC_RELAXED, __HIP_MEMORY_SCOPE_AGENT);
            rsv[tid] = rsqrtf(t * (1.f / 1024.f) + 1e-6f); }
        __syncthreads();
        const float* wp = nw + col0; const float* mp = modn + (size_t)mrow * 6144 + col0;
#pragma unroll
        for (int ai = 0; ai < 2; ++ai)
#pragma unroll
            for (int m = 0; m < 4; ++m) { const float rs = rsv[ai * 128 + wr * 64 + m * 16 + fr];
#pragma unroll
                for (int bj = 0; bj < 2; ++bj) { const size_t off = (size_t)(row0 + ai * HALF + m * 16) * 1024 + col0 + bj * HALF;
                    const f32x4 v0 = acc[ai][bj][m][0], v1 = acc[ai][bj][m][1];
                    const f32x4 w0 = *(const GAS f32x4*)(wp + bj * HALF), w1 = *(const GAS f32x4*)(wp + bj * HALF + 4);
                    f32x4 y0 = v0 * rs * w0, y1 = v1 * rs * w1;
                    if (mode == 1) { *(GAS f32x4*)(X + off) = y0; *(GAS f32x4*)(X + off + 4) = y1; }
                    else { *(GAS f32x4*)(X + off) = v0; *(GAS f32x4*)(X + off + 4) = v1;
                        const f32x4 c0 = *(const GAS f32x4*)(mp + scoff + bj * HALF), c1 = *(const GAS f32x4*)(mp + scoff + bj * HALF + 4), h0 = *(const GAS f32x4*)(mp + shoff + bj * HALF), h1 = *(const GAS f32x4*)(mp + shoff + bj * HALF + 4);
                        y0 = y0 * (c0 + 1.f) + h0; y1 = y1 * (c1 + 1.f) + h1;
                        u32x4 w; w.x = cvt_pk_bf16(y0[0], y0[1]); w.y = cvt_pk_bf16(y0[2], y0[3]); w.z = cvt_pk_bf16(y1[0], y1[1]); w.w = cvt_pk_bf16(y1[2], y1[3]);
                        *(GAS u32x4*)(H + off) = w; } } }
    }
};

template <class Epi, class Sched, bool ALIGN_EPI = false, bool SP2 = false>
__device__ __forceinline__ void gemm_phase(PG8_LAS unsigned char* lds, const Gemm g, const Sched& S, const Epi& E) {
    int tid_l = threadIdx.x; asm volatile("" : "+v"(tid_l));
    const int tid = tid_l, wid = __builtin_amdgcn_readfirstlane(tid >> 6), lane = tid & 63, wr = wid >> 2, wc = wid & 3, fr = lane & 15, fq = lane >> 4;
    const int K = g.K, nt = K / BK;
    unsigned voffA[2], voffB[2];
#pragma unroll
    for (int i = 0; i < 2; ++i) { int R, C; stage_rc(tid * 16 + i * 8192, R, C); const int Rb = Epi::PERM ? ((R & ~31) + perm32(R & 31)) : R;
        voffA[i] = (unsigned)(R * g.lda + C) * 2u; voffB[i] = (unsigned)(Rb * g.ldb + C) * 2u; }
    const size_t kstep = (size_t)(BK * 2);
    const size_t hstepA = (size_t)HALF * g.lda * 2, hstepB = (size_t)HALF * g.ldb * 2;
    const size_t tstepA = 2 * hstepA, tstepB = 2 * hstepB;
    const unsigned ldsw = (unsigned)wid * 1024u;
    const int aoff = lds_byte(wr * 64 + fr, fq * 8), boff = lds_byte(wc * 32 + fr, fq * 8);
#define PG8_SA(b, h) (((b) * 2 + (h)) * HTB)
#define PG8_SB(b, h) ((4 + (b) * 2 + (h)) * HTB)
#define PG8_STAGE(bufoff, gbase, voff) do { _Pragma("unroll") for (int _i = 0; _i < 2; ++_i) \
        __builtin_amdgcn_global_load_lds((const unsigned*)((const char*)(gbase) + (voff)[_i]), (PG8_LAS unsigned*)(lds + (bufoff) + ldsw + _i * 8192), 16, 0, 0); } while (0)
#define PG8_LDA(dst, b, h) do { _Pragma("unroll") for (int m = 0; m < 4; ++m) _Pragma("unroll") for (int k = 0; k < 2; ++k) dst[m][k] = *(const PG8_LAS bf16x8*)(lds + PG8_SA(b, h) + aoff + m * 2048 + k * 1024); } while (0)
#define PG8_LDB(dst, b, h) do { _Pragma("unroll") for (int n = 0; n < 2; ++n) _Pragma("unroll") for (int k = 0; k < 2; ++k) dst[n][k] = *(const PG8_LAS bf16x8*)(lds + PG8_SB(b, h) + boff + n * 2048 + k * 1024); } while (0)
#define PG8_MMA(ai, bj, At, Bt) do { __builtin_amdgcn_s_setprio(1); _Pragma("unroll") for (int m = 0; m < 4; ++m) _Pragma("unroll") for (int n = 0; n < 2; ++n) _Pragma("unroll") for (int k = 0; k < 2; ++k) \
        acc[ai][bj][m][n] = __builtin_amdgcn_mfma_f32_16x16x32_bf16(Bt[n][k], At[m][k], acc[ai][bj][m][n], 0, 0, 0); __builtin_amdgcn_s_setprio(0); } while (0)
#define PG8_WAIT_V(n) asm volatile("s_waitcnt vmcnt(" #n ")" ::: "memory")
#define PG8_WAIT_L(n) asm volatile("s_waitcnt lgkmcnt(" #n ")" ::: "memory")
#define PG8_BAR __builtin_amdgcn_s_barrier()
#define PG8_SCHED __builtin_amdgcn_sched_barrier(0)
    Unit cur, nxt; int ui = 0;
    if (!S.next(0, cur)) return;
    f32x4 acc[2][2][4][2];
#pragma unroll
    for (int a = 0; a < 2; ++a)
#pragma unroll
        for (int b = 0; b < 2; ++b)
#pragma unroll
            for (int m = 0; m < 4; ++m)
#pragma unroll
                for (int n = 0; n < 2; ++n) acc[a][b][m][n] = (f32x4){0.f, 0.f, 0.f, 0.f};
    bf16x8 At[4][2], B0[2][2], B1[2][2];
    const char* cA = (const char*)g.A + (size_t)cur.gi * g.gsA + (size_t)cur.pm * tstepA; const char* cB = (const char*)g.Bt + (size_t)cur.gi * g.gsB + (size_t)cur.pn * tstepB;
    S.a_ready(cur);
    if constexpr (SP2) {
        PG8_STAGE(PG8_SB(0, 0), cB, voffB); PG8_STAGE(PG8_SB(0, 1), cB + hstepB, voffB); PG8_STAGE(PG8_SA(0, 0), cA, voffA); PG8_STAGE(PG8_SA(0, 1), cA + hstepA, voffA);
        if (wr == 1) PG8_BAR;
        PG8_WAIT_V(2); PG8_BAR;
        PG8_STAGE(PG8_SB(1, 0), cB + kstep, voffB); PG8_STAGE(PG8_SA(1, 0), cA + kstep, voffA); PG8_STAGE(PG8_SB(1, 1), cB + hstepB + kstep, voffB);
        PG8_WAIT_V(6); PG8_BAR;
    } else {
        PG8_STAGE(PG8_SB(0, 0), cB, voffB); PG8_STAGE(PG8_SA(0, 0), cA, voffA); PG8_STAGE(PG8_SB(0, 1), cB + hstepB, voffB); PG8_STAGE(PG8_SA(0, 1), cA + hstepA, voffA);
        if (wr == 1) PG8_BAR;
        PG8_WAIT_V(4); PG8_BAR;
        PG8_STAGE(PG8_SB(1, 0), cB + kstep, voffB); PG8_STAGE(PG8_SA(1, 0), cA + kstep, voffA); PG8_STAGE(PG8_SB(1, 1), cB + hstepB + kstep, voffB);
        PG8_WAIT_V(6); PG8_BAR;
    }
    for (;;) {
        const bool has_next = S.next(ui + 1, nxt);
        const char* nA = has_next ? (const char*)g.A + (size_t)nxt.gi * g.gsA + (size_t)nxt.pm * tstepA : cA; const char* nB = has_next ? (const char*)g.Bt + (size_t)nxt.gi * g.gsB + (size_t)nxt.pn * tstepB : cB;
        for (int t = 0; t < nt; t += 2) {
            const bool last = (t == nt - 2);
            const char* a1 = cA + (size_t)(t + 1) * kstep;
            const char* a2 = last ? nA : cA + (size_t)(t + 2) * kstep; const char* b2 = last ? nB : cB + (size_t)(t + 2) * kstep;
            const char* a3 = a2 + kstep; const char* b3 = b2 + kstep;
            if (last && has_next) S.a_ready(nxt);
            if constexpr (SP2) {
            PG8_LDB(B0, 0, 0); PG8_LDB(B1, 0, 1); PG8_SCHED; PG8_LDA(At, 0, 0); PG8_STAGE(PG8_SA(1, 1), a1 + hstepA, voffA);
            PG8_WAIT_V(8); PG8_WAIT_L(0); PG8_BAR; PG8_MMA(0, 0, At, B0); PG8_MMA(0, 1, At, B1); PG8_BAR; PG8_SCHED;
            PG8_LDA(At, 0, 1); PG8_STAGE(PG8_SB(0, 0), b2, voffB); PG8_STAGE(PG8_SB(0, 1), b2 + hstepB, voffB); PG8_STAGE(PG8_SA(0, 0), a2, voffA);
            PG8_WAIT_V(8); PG8_WAIT_L(0); PG8_BAR; PG8_MMA(1, 0, At, B0); PG8_MMA(1, 1, At, B1); PG8_BAR; PG8_SCHED;
            PG8_LDB(B0, 1, 0); PG8_LDB(B1, 1, 1); PG8_SCHED; PG8_LDA(At, 1, 0); PG8_STAGE(PG8_SA(0, 1), a2 + hstepA, voffA);
            PG8_WAIT_V(8); PG8_WAIT_L(0); PG8_BAR; PG8_MMA(0, 0, At, B0); PG8_MMA(0, 1, At, B1); PG8_BAR; PG8_SCHED;
            PG8_LDA(At, 1, 1); PG8_STAGE(PG8_SB(1, 0), b3, voffB); PG8_STAGE(PG8_SB(1, 1), b3 + hstepB, voffB); PG8_STAGE(PG8_SA(1, 0), a3, voffA);
            PG8_WAIT_V(8); PG8_WAIT_L(0); PG8_BAR; PG8_MMA(1, 0, At, B0); PG8_MMA(1, 1, At, B1); PG8_BAR; PG8_SCHED;
            } else {
            PG8_LDB(B0, 0, 0); PG8_SCHED; PG8_LDA(At, 0, 0); PG8_STAGE(PG8_SA(1, 1), a1 + hstepA, voffA);
            PG8_WAIT_L(8); PG8_BAR; PG8_WAIT_L(0); PG8_MMA(0, 0, At, B0); PG8_BAR; PG8_SCHED;
            PG8_LDB(B1, 0, 1); PG8_STAGE(PG8_SB(0, 0), b2, voffB);
            PG8_BAR; PG8_WAIT_L(0); PG8_MMA(0, 1, At, B1); PG8_BAR;
            PG8_LDA(At, 0, 1); PG8_STAGE(PG8_SA(0, 0), a2, voffA);
            PG8_BAR; PG8_WAIT_L(0); PG8_MMA(1, 0, At, B0); PG8_BAR; PG8_SCHED;
            PG8_STAGE(PG8_SB(0, 1), b2 + hstepB, voffB);
            PG8_WAIT_V(6); PG8_BAR; PG8_MMA(1, 1, At, B1); PG8_BAR;
            PG8_LDB(B0, 1, 0); PG8_SCHED; PG8_LDA(At, 1, 0); PG8_STAGE(PG8_SA(0, 1), a2 + hstepA, voffA);
            PG8_WAIT_L(8); PG8_BAR; PG8_WAIT_L(0); PG8_MMA(0, 0, At, B0); PG8_BAR; PG8_SCHED;
            PG8_LDB(B1, 1, 1); PG8_STAGE(PG8_SB(1, 0), b3, voffB);
            PG8_BAR; PG8_WAIT_L(0); PG8_MMA(0, 1, At, B1); PG8_BAR;
            PG8_LDA(At, 1, 1); PG8_STAGE(PG8_SA(1, 0), a3, voffA);
            PG8_BAR; PG8_WAIT_L(0); PG8_MMA(1, 0, At, B0); PG8_BAR; PG8_SCHED;
            PG8_STAGE(PG8_SB(1, 1), b3 + hstepB, voffB);
            PG8_WAIT_V(6); PG8_BAR; PG8_MMA(1, 1, At, B1); PG8_BAR;
            }
        }
        if constexpr (ALIGN_EPI) { if (wr == 0) PG8_BAR; }
        if constexpr (!Epi::AFTER_DRAIN) { E(acc, cur, wr, wc, fr, fq); S.done(cur); }
        if (!has_next) break;
#pragma unroll
        for (int a = 0; a < 2; ++a)
#pragma unroll
            for (int b = 0; b < 2; ++b)
#pragma unroll
                for (int m = 0; m < 4; ++m)
#pragma unroll
                    for (int n = 0; n < 2; ++n) acc[a][b][m][n] = (f32x4){0.f, 0.f, 0.f, 0.f};
        cur = nxt; cA = nA; cB = nB; ++ui;
        if constexpr (ALIGN_EPI) { if (wr == 1) PG8_BAR; }
    }
    PG8_WAIT_V(0);
    if constexpr (!ALIGN_EPI) { if (wr == 0) PG8_BAR; }
    PG8_BAR;
    if constexpr (Epi::AFTER_DRAIN) { E.fused(acc, cur, wr, wc, fr, fq, lds, wid, lane); S.done(cur); }
#undef PG8_SA
#undef PG8_SB
#undef PG8_STAGE
#undef PG8_LDA
#undef PG8_LDB
#undef PG8_MMA
#undef PG8_WAIT_V
#undef PG8_WAIT_L
#undef PG8_BAR
#undef PG8_SCHED
}
}

constexpr int TCTX = 4096, TLAT = 8192, TT = 12288, DM = 1024, NKEYROWS = 13312;
constexpr float EPSN = 1e-6f;
constexpr size_t MiB = 1u << 20;
constexpr size_t WS_MOD = 0, MOD_BYTES = 2 * 5 * 6144 * 4, WS_BAR = 262144, BAR_REGION = 16384, ZERO_BYTES = WS_BAR + 5 * BAR_REGION;
constexpr size_t WS_CNT = 245760  , WS_SLOT = 2 * MiB + 262144  ;
constexpr size_t WS_HID = 1 * MiB;
constexpr size_t WS_WIN = 3 * MiB  , WS_WG = 11 * MiB  , WS_WUQ = 15 * MiB, WS_WKN = 16 * MiB, WS_WVV = 16 * MiB + 262144, WS_WB = 17 * MiB, WS_WO = 20 * MiB, WS_WUP = 22 * MiB, WS_WDN = 33 * MiB;
constexpr size_t WS_U = 39 * MiB, WS_ACT = 171 * MiB, WS_HBF = 171 * MiB  , WS_HBF1 = 165 * MiB  ;
constexpr size_t WS_QA = 39 * MiB, WS_KVR = 51 * MiB, WS_CQ = 57 * MiB, WS_CKVR = 69 * MiB, WS_HYR = 75 * MiB, WS_OA = 75 * MiB, WS_OB = 87 * MiB, WS_OC = 99 * MiB;
constexpr size_t WS_UT = 111 * MiB, WS_QB = 147 * MiB, WS_CKVALL = 189 * MiB, WS_KPEALL = 196 * MiB, WS_KNB = 197 * MiB, WS_VTB = 210 * MiB, WS_KA = 223 * MiB, WS_VTA = 227 * MiB;
constexpr size_t WS_S0 = 232 * MiB  , WS_S1 = 111 * MiB, WS_S2 = 135 * MiB, WS_MBF = 195 * MiB, WS_END = 256 * MiB;
constexpr int KA_LAT = 16 * 2 * 256 * 64;
constexpr int UT_LAT = 16 * 1536 * 256;
constexpr int OUT_K = 12582912, OUT_V = 13631488, OUT_CKV = 14680064, OUT_KPE = 16777216;
constexpr int LDS_BYTES = 147456;
constexpr int NPHASE = 24;

#ifndef GAS
#define GAS __attribute__((address_space(1)))
#endif
#define LAS __attribute__((address_space(3)))
typedef unsigned short bf16;
typedef unsigned v4u __attribute__((ext_vector_type(4)));
typedef unsigned v2u __attribute__((ext_vector_type(2)));
typedef float f32x4 __attribute__((ext_vector_type(4)));
typedef float f32x16 __attribute__((ext_vector_type(16)));
typedef short bf16x8 __attribute__((ext_vector_type(8)));
typedef short bf16x4 __attribute__((ext_vector_type(4)));
#define LDS_WAIT() asm volatile("s_waitcnt lgkmcnt(0)" ::: "memory")
__device__ __forceinline__ unsigned f2bf(float f) { unsigned u = __builtin_bit_cast(unsigned, f); return (u + 0x7fffu + ((u >> 16) & 1u)) >> 16; }
__device__ __forceinline__ unsigned pk2(float lo, float hi) { return f2bf(lo) | (f2bf(hi) << 16); }
__device__ __forceinline__ float bflo(unsigned w) { return __uint_as_float(w << 16); }
__device__ __forceinline__ float bfhi(unsigned w) { return __uint_as_float(w & 0xffff0000u); }
__device__ __forceinline__ float bf1(bf16 b) { return __uint_as_float(((unsigned)b) << 16); }
__device__ __forceinline__ void fsincos(float x, float& s, float& c) { float rev = x * 0.15915494309189535f; rev = rev - rintf(rev); s = __builtin_amdgcn_sinf(rev); c = __builtin_amdgcn_cosf(rev); }
__device__ __forceinline__ float fsin(float x) { float rev = x * 0.15915494309189535f; rev = rev - rintf(rev); return __builtin_amdgcn_sinf(rev); }
__device__ __forceinline__ float wave_sum(float v) {
#pragma unroll
    for (int o = 1; o < 64; o <<= 1) v += __shfl_xor(v, o);
    return v;
}
__device__ __forceinline__ void rope2(float& x0, float& x1, float ang) { float s, c; fsincos(ang, s, c); const float a = x0 * c - x1 * s, b = x0 * s + x1 * c; x0 = a; x1 = b; }
#define L2_10000 13.287712379549449f

__device__ __forceinline__ void transpose_item(const float* W, size_t ldw, int k0, int n0, bf16* WT, size_t ldt, int drow0, LAS float* scr, int lane) {
    float wv[32];
#pragma unroll
    for (int i = 0; i < 32; ++i) wv[i] = ((const GAS float*)W)[(size_t)(k0 + 2 * i + (lane >> 5)) * ldw + n0 + (lane & 31)];
#pragma unroll
    for (int i = 0; i < 32; ++i) scr[(2 * i + (lane >> 5)) * 33 + (lane & 31)] = wv[i];
    LDS_WAIT(); asm volatile("" ::: "memory");
    const int c = lane & 7;
#pragma unroll
    for (int j = 0; j < 4; ++j) { const int n = (lane >> 3) + 8 * j; const LAS float* s = scr + (8 * c) * 33 + n;
        v4u o; o.x = pk2(s[0 * 33], s[1 * 33]); o.y = pk2(s[2 * 33], s[3 * 33]); o.z = pk2(s[4 * 33], s[5 * 33]); o.w = pk2(s[6 * 33], s[7 * 33]);
        *(GAS v4u*)(WT + (size_t)(drow0 + n) * ldt + k0 + 8 * c) = o; }
    LDS_WAIT(); asm volatile("" ::: "memory");
}

#define XB_TMO      128
#define XB_XCNT(j)  (256  + 64 * (j))
#define XB_XSUB(j)  (1280 + 64 * (j))
#define XB_XGEN(j)  (2304 + 64 * (j))
#define XB_TOP      3328
#define XB_TOPGEN   3392
#define XCD_BAR_WORDS 3456
#define XB_SPIN_CAP (1u << 18)

__device__ __forceinline__ unsigned xb_ld(unsigned* p)              { return __hip_atomic_load(p, __ATOMIC_RELAXED, __HIP_MEMORY_SCOPE_AGENT); }
__device__ __forceinline__ unsigned xb_add(unsigned* p, unsigned v) { return __hip_atomic_fetch_add(p, v, __ATOMIC_RELAXED, __HIP_MEMORY_SCOPE_AGENT); }
__device__ __forceinline__ unsigned xb_xcc_id() { return (unsigned)__builtin_amdgcn_s_getreg((3 << 11) | 20) & 0xFu; }
#define XB_SPIN(cond, bar) do { unsigned _sp = 0; while (cond) { __builtin_amdgcn_s_sleep(1); \
    if ((++_sp & 255u) == 0u) { if (xb_ld(&(bar)[XB_TMO])) break; if (_sp > XB_SPIN_CAP) { atomicAdd(&(bar)[XB_TMO], 1u); break; } } } } while (0)

struct XcdBarrier {
    unsigned* bar; unsigned x;
    volatile LAS unsigned* st;
};

__device__ __forceinline__ XcdBarrier xcd_barrier_post(unsigned* bar, volatile LAS unsigned* st) {
    XcdBarrier b; b.bar = bar; b.x = xb_xcc_id(); b.st = st;
    if (threadIdx.x == 0) (void)xb_add(&bar[XB_XCNT(b.x)], 1u);
    return b;
}
__device__ __forceinline__ void xcd_barrier_complete(unsigned* bar, unsigned x, unsigned& nloc, unsigned& nx) {
    const unsigned G = gridDim.x * gridDim.y * gridDim.z;
    unsigned sum, cnt, mine, sp = 0u;
    for (;;) {
        sum = 0u; cnt = 0u; mine = 0u;
#pragma unroll
        for (unsigned j = 0; j < 16; ++j) { const unsigned c = xb_ld(&bar[XB_XCNT(j)]); sum += c; cnt += (c > 0u) ? 1u : 0u; mine = (j == x) ? c : mine; }
        if (sum == G) break;
        __builtin_amdgcn_s_sleep(1);
        if ((++sp & 255u) == 0u) { if (xb_ld(&bar[XB_TMO])) break; if (sp > XB_SPIN_CAP) { atomicAdd(&bar[XB_TMO], 1u); break; } }
    }
    nloc = mine > 0u ? mine : 1u; nx = cnt > 0u ? cnt : 1u;
}

__device__ __forceinline__ void xcd_barrier(const XcdBarrier& b) {
    asm volatile("s_waitcnt vmcnt(0)" ::: "memory");
    __syncthreads();
    if (threadIdx.x == 0) {
        unsigned* bar = b.bar;
        __builtin_amdgcn_s_waitcnt(0);
        unsigned nloc = b.st[0], nx = b.st[1];
        if (nloc == 0u) { xcd_barrier_complete(bar, b.x, nloc, nx); b.st[0] = nloc; b.st[1] = nx; }
        const unsigned old = xb_add(&bar[XB_XSUB(b.x)], 1u);
        const unsigned gen = old / nloc;
        if (old + 1u == (gen + 1u) * nloc) {
            __builtin_amdgcn_fence(__ATOMIC_RELEASE, "agent");
            asm volatile("s_waitcnt vmcnt(0)" ::: "memory");
            const unsigned og = xb_add(&bar[XB_TOP], 1u);
            const unsigned tg = og / nx;
            if (og + 1u == (tg + 1u) * nx) xb_add(&bar[XB_TOPGEN], 1u);
            else XB_SPIN(xb_ld(&bar[XB_TOPGEN]) == tg, bar);
            __builtin_amdgcn_fence(__ATOMIC_ACQUIRE, "agent");
            xb_add(&bar[XB_XGEN(b.x)], 1u);
            asm volatile("s_waitcnt vmcnt(0)" ::: "memory");
        } else {
            XB_SPIN(xb_ld(&bar[XB_XGEN(b.x)]) == gen, bar);
            __builtin_amdgcn_fence(__ATOMIC_ACQUIRE, "agent");
            asm volatile("s_waitcnt vmcnt(0)" ::: "memory");
        }
    }
    __syncthreads();
}


struct Args { const float* in[35]; float* out; unsigned char* ws; int ph_lo, ph_hi, li, pad; };

__device__ __forceinline__ void wconv_phase(const Args& a, int l, int part, LAS unsigned char* lds, int gw, int NGW, int gt, int NGT, int wave, int lane) {
    LAS float* scr = (LAS float*)(lds + wave * 16384);
    unsigned char* ws = a.ws;
    bf16 *WIN = (bf16*)(ws + WS_WIN), *WG = (bf16*)(ws + WS_WG), *WUQ = (bf16*)(ws + WS_WUQ), *WKN = (bf16*)(ws + WS_WKN), *WVV = (bf16*)(ws + WS_WVV), *WB = (bf16*)(ws + WS_WB), *WO = (bf16*)(ws + WS_WO), *WUP = (bf16*)(ws + WS_WUP), *WDN = (bf16*)(ws + WS_WDN);
    constexpr int I1 = 16 * 189, I2 = 6 * 24, I3 = 4 * 32, I4 = 3 * 8 * 32, I5 = 16 * 32, I6 = 16 * 176, I7 = 44 * 32, NIT = I1 + I2 + I3 + I4 + I5 + I6 + I7;
    const int it_lo = (part == 2) ? NIT - I7 : 0, it_hi = (part == 1) ? NIT - I7 : NIT;
    for (int it = it_lo + gw; it < it_hi; it += NGW) {
        int r = it;
        if (r < I1) { const int kb = r / 189, n0 = 32 * (r % 189); bf16* dst = WIN; int drow;
            if (n0 < 1152) drow = n0; else if (n0 < 1408) drow = n0 + 128; else if (n0 < 1440) drow = 1152 + (n0 - 1408); else if (n0 < 2976) drow = 1536 + (n0 - 1440); else if (n0 < 4000) drow = 3072 + (n0 - 2976); else { dst = WG; drow = n0 - 4000; }
            transpose_item(a.in[12] + (size_t)l * 1024 * 6048, 6048, 64 * kb, n0, dst, 1024, drow, scr, lane); continue; } r -= I1;
        if (r < I2) { const int kb = r / 24, n0 = 32 * (r % 24); transpose_item(a.in[17] + (size_t)l * 384 * 768, 768, 64 * kb, n0, WUQ, 384, n0, scr, lane); continue; } r -= I2;
        if (r < I3) { const int kb = r / 32, n0 = 32 * (r % 32); const int h = n0 >> 7, c0 = n0 & 127;
            transpose_item(a.in[18] + (size_t)l * 256 * 1024, 1024, 64 * kb, n0, (c0 < 64) ? WKN : WVV, 256, h * 64 + (c0 & 63), scr, lane); continue; } r -= I3;
        if (r < I4) { const int n = r / 256, q = r % 256, kb = q / 32, n0 = 32 * (q % 32);
            transpose_item(a.in[28] + ((size_t)l * 3 + n) * 512 * 1024, 1024, 64 * kb, n0, WB + (size_t)n * 1024 * 512, 512, n0, scr, lane); continue; } r -= I4;
        if (r < I5) { const int kb = r / 32, n0 = 32 * (r % 32); transpose_item(a.in[29] + (size_t)l * 1024 * 1024, 1024, 64 * kb, n0, WO, 1024, n0, scr, lane); continue; } r -= I5;
        if (r < I6) { const int kb = r / 176, n0 = 32 * (r % 176); transpose_item(a.in[30] + (size_t)l * 1024 * 5632, 5632, 64 * kb, n0, WUP, 1024, n0, scr, lane); continue; } r -= I6;
        { const int kb = r / 32, n0 = 32 * (r % 32); transpose_item(a.in[33] + (size_t)l * 2816 * 1024, 1024, 64 * kb, n0, WDN, 2816, n0, scr, lane); }
    }
    if (part != 2) for (int i = gt; i < 96 * 1024 / 8; i += NGT) *(GAS v4u*)(WIN + (size_t)1184 * 1024 + (size_t)i * 8) = (v4u){0u, 0u, 0u, 0u};
}

__device__ __forceinline__ void norm_phase(const Args& a, int l, int which, bool first, bool copy_x, int gw, int NGW, int lane) {
    const GAS float* mod = (const GAS float*)(a.ws + WS_MOD) + (size_t)l * 5 * 6144;
    GAS bf16* HBF = (GAS bf16*)(a.ws + (which == 0 ? WS_HBF1 : WS_HBF));
    const GAS float* gv = (const GAS float*)((which == 0) ? a.in[10] + l * 1024 : (which == 1) ? a.in[11] + l * 1024 : a.in[34]);
    GAS float* outp = (GAS float*)a.out;
    const int shoff = (which == 0) ? 0 : 3072, scoff = shoff + 1024;
    #pragma unroll 1
    for (int row0 = gw; row0 < TT; row0 += 4 * NGW) {
        f32x4 v[4][4];
#pragma unroll
        for (int q = 0; q < 4; ++q) { const int row = row0 + q * NGW; const int rr = row < TT ? row : row0;
            const GAS float* src = first ? (const GAS float*)(rr < TCTX ? a.in[0] + (size_t)rr * DM : a.in[1] + (size_t)(rr - TCTX) * DM) : (const GAS float*)(outp + (size_t)rr * DM);
#pragma unroll
            for (int j = 0; j < 4; ++j) v[q][j] = *(const GAS f32x4*)(src + 4 * lane + 256 * j); }
#pragma unroll
        for (int q = 0; q < 4; ++q) { const int row = row0 + q * NGW; if (row >= TT) continue;
            float ss = 0.f;
#pragma unroll
            for (int j = 0; j < 4; ++j) ss += (v[q][j].x * v[q][j].x + v[q][j].y * v[q][j].y) + (v[q][j].z * v[q][j].z + v[q][j].w * v[q][j].w);
            if (first && copy_x) {
#pragma unroll
                for (int j = 0; j < 4; ++j) *(GAS f32x4*)(outp + (size_t)row * DM + 4 * lane + 256 * j) = v[q][j]; }
            const float rs = rsqrtf(wave_sum(ss) * (1.f / DM) + EPSN);
            const int mrow = row < TCTX ? 0 : 1 + ((row - TCTX) >> 11);
            const GAS float* mp = mod + (size_t)mrow * 6144;
#pragma unroll
            for (int j = 0; j < 4; ++j) { const int col = 4 * lane + 256 * j; const f32x4 g = *(const GAS f32x4*)(gv + col);
                if (which == 2) { *(GAS f32x4*)(outp + (size_t)row * DM + col) = v[q][j] * rs * g; }
                else { const f32x4 sc = *(const GAS f32x4*)(mp + scoff + col), sh = *(const GAS f32x4*)(mp + shoff + col);
                    const f32x4 y = v[q][j] * rs * g * (sc + 1.f) + sh;
                    *(GAS v2u*)(HBF + (size_t)row * DM + col) = (v2u){pk2(y.x, y.y), pk2(y.z, y.w)}; } } }
    }
}
__device__ __forceinline__ void p0_mod_hid(const Args& a, LAS unsigned char* lds, int bid, int G, int tid, int gw, int NGW, int lane) {
    float* mod = (float*)(a.ws + WS_MOD);
    LAS float* sc = (LAS float*)lds;
    for (int it = bid; it < 384; it += G) {
        const int l = it / 192, rem = it % 192, kc = rem / 12, jb = rem % 12;
        if (tid < 320) { const int r = tid >> 6, kk = tid & 63, k = kc * 64 + kk; const float cv = (r == 0) ? a.in[7][k] : a.in[6][(r - 1) * 1024 + k]; sc[tid] = cv / (1.f + __expf(-cv)); }
        __syncthreads();
        const int j = jb * 512 + tid;
        const GAS float* wp = (const GAS float*)(a.in[8] + ((size_t)l * 1024 + kc * 64) * 6144 + j);
        float acc[5] = {0.f, 0.f, 0.f, 0.f, 0.f};
#pragma unroll 8
        for (int kk = 0; kk < 64; ++kk) { const float w = wp[(size_t)kk * 6144];
#pragma unroll
            for (int r = 0; r < 5; ++r) acc[r] += sc[r * 64 + kk] * w; }
        const float bias = (kc == 0) ? a.in[9][l * 6144 + j] : 0.f;
#pragma unroll
        for (int r = 0; r < 5; ++r) atomicAdd(mod + (size_t)(l * 5 + r) * 6144 + j, acc[r] + bias);
        __syncthreads();
    }
    float* HID = (float*)(a.ws + WS_HID);
    for (int it = gw; it < 2 * 2304; it += NGW) {
        const int l = it / 2304, q = it % 2304; const int L = q < 256 ? 256 : 2048, t = q < 256 ? q : q - 256;
        const float tn = (float)t / (float)(L - 1);
        float zi = 0.f;
        if (lane == 0) zi = tn;
        else if (lane <= 16) { const int bi = (lane - 1) & 7; const float band = 1e-4f + (float)bi * ((7.f - 1e-4f) / 7.f); const float ang = (6.283185307179586f / (float)L) * (float)t * band; float s, c; fsincos(ang, s, c); zi = (lane <= 8) ? c : -s; }
        float s1 = a.in[22][l * 64 + lane];
#pragma unroll
        for (int i = 0; i < 17; ++i) s1 += __shfl(zi, i) * a.in[21][(l * 17 + i) * 64 + lane];
        const float h1 = fsin(a.in[26][(l * 2 + 0) * 64 + lane] * s1);
        float s2 = a.in[24][l * 64 + lane];
#pragma unroll 8
        for (int i = 0; i < 64; ++i) s2 += __shfl(h1, i) * a.in[23][(l * 64 + i) * 64 + lane];
        HID[(size_t)it * 64 + lane] = fsin(a.in[26][(l * 2 + 1) * 64 + lane] * s2);
    }
}

__device__ __forceinline__ void post_phase(const Args& a, int l, LAS unsigned char* lds, int bid, int G, int tid, int gw, int NGW, int gt, int NGT, int lane) {
    unsigned char* ws = a.ws;
    GAS bf16 *QA = (GAS bf16*)(ws + WS_QA), *KVR = (GAS bf16*)(ws + WS_KVR), *CQ = (GAS bf16*)(ws + WS_CQ), *CKVR = (GAS bf16*)(ws + WS_CKVR), *HYR = (GAS bf16*)(ws + WS_HYR);
    GAS bf16 *UT = (GAS bf16*)(ws + WS_UT), *CKVALL = (GAS bf16*)(ws + WS_CKVALL), *KPEALL = (GAS bf16*)(ws + WS_KPEALL), *KA = (GAS bf16*)(ws + WS_KA), *VTA = (GAS bf16*)(ws + WS_VTA);
    GAS float* outp = (GAS float*)a.out;
    if (l == 1 && G == 256) { wconv_phase(a, 1, 2, lds, gw, NGW, gt, NGT, tid >> 6, lane); __syncthreads(); }
    for (int i = gt; i < 4 * 256 * 128; i += NGT) { const int b = i >> 15, p = (i >> 7) & 255, kvh = (i >> 6) & 1, d = i & 63;
        const size_t s = ((size_t)(b * 2 + l) * 256 + p) * 128 + kvh * 64 + d;
        KA[KA_LAT + ((b * 2 + kvh) * 2304 + p) * 64 + d] = (bf16)f2bf(a.in[2][s]);
        VTA[KA_LAT + ((b * 2 + kvh) * 64 + d) * 2304 + p] = (bf16)f2bf(a.in[3][s]); }
    for (int i = gt; i < 4 * 256 * 256; i += NGT) { const int b = i >> 16, p = (i >> 8) & 255, j = i & 255;
        CKVALL[(size_t)(TCTX + b * 2304 + p) * 256 + j] = (bf16)f2bf(a.in[4][((size_t)(b * 2 + l) * 256 + p) * 256 + j]); }
    for (int i = gt; i < 4 * 256 * 32; i += NGT) { const int b = i >> 13, p = (i >> 5) & 255, j = i & 31;
        KPEALL[(size_t)(TCTX + b * 2304 + p) * 32 + j] = (bf16)f2bf(a.in[5][((size_t)(b * 2 + l) * 256 + p) * 32 + j]); }
    const GAS float *gq = (const GAS float*)(a.in[13] + l * 64), *gk = (const GAS float*)(a.in[14] + l * 64), *gcq = (const GAS float*)(a.in[15] + l * 384), *gkv = (const GAS float*)(a.in[16] + l * 256);
    for (int row = gw; row < TT; row += NGW) {
        const bool lat = row >= TCTX;
        const int b = lat ? (row - TCTX) >> 11 : row >> 8, t = lat ? (row - TCTX) & 2047 : row & 255;
        const float grow = (float)(t >> 6), gcol = (float)(t & 63);
        const int keyrow = lat ? TCTX + b * 2304 + 256 + t : row;
        { v4u w = *(const GAS v4u*)(QA + (size_t)row * 512 + 8 * lane);
          float x[8] = {bflo(w.x), bfhi(w.x), bflo(w.y), bfhi(w.y), bflo(w.z), bfhi(w.z), bflo(w.w), bfhi(w.w)};
          float ss = 0.f;
#pragma unroll
          for (int j = 0; j < 8; ++j) ss += x[j] * x[j];
          ss += __shfl_xor(ss, 1); ss += __shfl_xor(ss, 2); ss += __shfl_xor(ss, 4);
          const float rs = rsqrtf(ss * (1.f / 64.f) + EPSN); const int d0 = 8 * (lane & 7);
#pragma unroll
          for (int j = 0; j < 8; ++j) x[j] = x[j] * rs * gq[d0 + j];
          if (lat) {
#pragma unroll
              for (int k = 0; k < 4; ++k) { const int i = 4 * (lane & 7) + k; const float inv = __builtin_amdgcn_exp2f(-(float)(i & 15) * (L2_10000 / 16.f)); rope2(x[2 * k], x[2 * k + 1], (i < 16 ? grow : gcol) * inv); } }
          *(GAS v4u*)(QA + (size_t)row * 512 + 8 * lane) = (v4u){pk2(x[0], x[1]), pk2(x[2], x[3]), pk2(x[4], x[5]), pk2(x[6], x[7])}; }
        { const v2u w = *(const GAS v2u*)(KVR + (size_t)row * 256 + 4 * lane);
          float x[4] = {bflo(w.x), bfhi(w.x), bflo(w.y), bfhi(w.y)};
          float ss = (x[0] * x[0] + x[1] * x[1]) + (x[2] * x[2] + x[3] * x[3]);
          ss += __shfl_xor(ss, 1); ss += __shfl_xor(ss, 2); ss += __shfl_xor(ss, 4); ss += __shfl_xor(ss, 8);
          const int kvh = (lane >> 4) & 1, d0 = 4 * (lane & 15);
          if (lane < 32) {
              const float rs = rsqrtf(ss * (1.f / 64.f) + EPSN);
#pragma unroll
              for (int j = 0; j < 4; ++j) x[j] = x[j] * rs * gk[d0 + j];
              if (!lat) { *(GAS f32x4*)(outp + OUT_K + ((size_t)(b * 2 + l) * 256 + t) * 128 + kvh * 64 + d0) = (f32x4){x[0], x[1], x[2], x[3]};
                  *(GAS v2u*)(KA + ((size_t)(b * 2 + kvh) * 256 + t) * 64 + d0) = (v2u){pk2(x[0], x[1]), pk2(x[2], x[3])}; }
              else {
#pragma unroll
                  for (int k = 0; k < 2; ++k) { const int i = 2 * (lane & 15) + k; const float inv = __builtin_amdgcn_exp2f(-(float)(i & 15) * (L2_10000 / 16.f)); rope2(x[2 * k], x[2 * k + 1], (i < 16 ? grow : gcol) * inv); }
                  *(GAS v2u*)(KA + KA_LAT + ((size_t)(b * 2 + kvh) * 2304 + 256 + t) * 64 + d0) = (v2u){pk2(x[0], x[1]), pk2(x[2], x[3])}; }
          } else {
              if (!lat) { *(GAS f32x4*)(outp + OUT_V + ((size_t)(b * 2 + l) * 256 + t) * 128 + kvh * 64 + d0) = (f32x4){x[0], x[1], x[2], x[3]};
#pragma unroll
                  for (int j = 0; j < 4; ++j) VTA[((size_t)(b * 2 + kvh) * 64 + d0 + j) * 256 + t] = (bf16)f2bf(x[j]); }
              else {
#pragma unroll
                  for (int j = 0; j < 4; ++j) VTA[KA_LAT + ((size_t)(b * 2 + kvh) * 64 + d0 + j) * 2304 + 256 + t] = (bf16)f2bf(x[j]); }
          } }
        { GAS unsigned* p = (GAS unsigned*)(CQ + (size_t)row * 512 + 6 * lane);
          const unsigned w0 = p[0], w1 = p[1], w2 = p[2];
          float x[6] = {bflo(w0), bfhi(w0), bflo(w1), bfhi(w1), bflo(w2), bfhi(w2)};
          float ss = 0.f;
#pragma unroll
          for (int j = 0; j < 6; ++j) ss += x[j] * x[j];
          const float rs = rsqrtf(wave_sum(ss) * (1.f / 384.f) + EPSN);
#pragma unroll
          for (int j = 0; j < 6; ++j) x[j] = x[j] * rs * gcq[6 * lane + j];
          p[0] = pk2(x[0], x[1]); p[1] = pk2(x[2], x[3]); p[2] = pk2(x[4], x[5]);
          if (lane < 16) { const unsigned w = *(const GAS unsigned*)(CQ + (size_t)row * 512 + 384 + 2 * lane); float y0 = bflo(w), y1 = bfhi(w);
              if (!lat) { outp[OUT_KPE + ((size_t)(b * 2 + l) * 256 + t) * 32 + 2 * lane] = y0; outp[OUT_KPE + ((size_t)(b * 2 + l) * 256 + t) * 32 + 2 * lane + 1] = y1; }
              else { const float inv = __builtin_amdgcn_exp2f(-(float)(lane & 7) * (L2_10000 / 8.f)); rope2(y0, y1, (lane < 8 ? grow : gcol) * inv); }
              *(GAS unsigned*)(KPEALL + (size_t)keyrow * 32 + 2 * lane) = pk2(y0, y1); } }
        { const v2u w = *(const GAS v2u*)(CKVR + (size_t)row * 256 + 4 * lane);
          float x[4] = {bflo(w.x), bfhi(w.x), bflo(w.y), bfhi(w.y)};
          const float ss = (x[0] * x[0] + x[1] * x[1]) + (x[2] * x[2] + x[3] * x[3]);
          const float rs = rsqrtf(wave_sum(ss) * (1.f / 256.f) + EPSN);
#pragma unroll
          for (int j = 0; j < 4; ++j) x[j] = x[j] * rs * gkv[4 * lane + j];
          if (!lat) *(GAS f32x4*)(outp + OUT_CKV + ((size_t)(b * 2 + l) * 256 + t) * 256 + 4 * lane) = (f32x4){x[0], x[1], x[2], x[3]};
          *(GAS v2u*)(CKVALL + (size_t)keyrow * 256 + 4 * lane) = (v2u){pk2(x[0], x[1]), pk2(x[2], x[3])}; }
    }
    LAS float* tile = (LAS float*)lds;
    const GAS float *sw = (const GAS float*)(a.in[19] + (size_t)l * 3 * 1536), *sb = (const GAS float*)(a.in[20] + (size_t)l * 1536);
    for (int it = bid; it < 96 * 12; it += G) {
        const int tb = it / 12, cb = it % 12, row0 = tb * 128;
        const bool lat = row0 >= TCTX; const int L = lat ? 2048 : 256;
        const int b = lat ? (row0 - TCTX) >> 11 : row0 >> 8, t0 = lat ? (row0 - TCTX) & 2047 : row0 & 255;
        v4u w[4], wh = (v4u){0u, 0u, 0u, 0u};
        { const int rr = tid >> 4, c8 = tid & 15;
#pragma unroll
          for (int q = 0; q < 4; ++q) w[q] = *(const GAS v4u*)(HYR + (size_t)(row0 + rr + 32 * q) * 1536 + cb * 128 + 8 * c8);
          if (tid < 32) { const int which = tid >> 4; const bool ok = which ? (t0 + 128 < L) : (t0 > 0); const int rsrc = which ? row0 + 128 : row0 - 1;
              if (ok) wh = *(const GAS v4u*)(HYR + (size_t)rsrc * 1536 + cb * 128 + 8 * c8); }
#pragma unroll
          for (int q = 0; q < 4; ++q) { LAS float* tp = tile + (rr + 32 * q + 1) * 129 + 8 * c8;
              tp[0] = bflo(w[q].x); tp[1] = bfhi(w[q].x); tp[2] = bflo(w[q].y); tp[3] = bfhi(w[q].y); tp[4] = bflo(w[q].z); tp[5] = bfhi(w[q].z); tp[6] = bflo(w[q].w); tp[7] = bfhi(w[q].w); }
          if (tid < 32) { LAS float* tp = tile + ((tid >> 4) ? 129 : 0) * 129 + 8 * c8;
              tp[0] = bflo(wh.x); tp[1] = bfhi(wh.x); tp[2] = bflo(wh.y); tp[3] = bfhi(wh.y); tp[4] = bflo(wh.z); tp[5] = bfhi(wh.z); tp[6] = bflo(wh.w); tp[7] = bfhi(wh.w); } }
        __syncthreads();
        { const int c = tid >> 2, tc = tid & 3, cg_ = cb * 128 + c; const float w0 = sw[cg_], w1 = sw[1536 + cg_], w2 = sw[3072 + cg_], bb = sb[cg_];
          const size_t base = lat ? (size_t)UT_LAT + ((size_t)b * 1536 + cg_) * 2048 : ((size_t)b * 1536 + cg_) * 256;
#pragma unroll
          for (int q = 0; q < 4; ++q) { float u[8];
#pragma unroll
              for (int k = 0; k < 8; ++k) { const int tr = 32 * tc + 8 * q + k; u[k] = w0 * tile[tr * 129 + c] + w1 * tile[(tr + 1) * 129 + c] + w2 * tile[(tr + 2) * 129 + c] + bb; }
              *(GAS v4u*)(UT + base + t0 + 32 * tc + 8 * q) = (v4u){pk2(u[0], u[1]), pk2(u[2], u[3]), pk2(u[4], u[5]), pk2(u[6], u[7])}; } }
        __syncthreads();
    }
}

__device__ __forceinline__ void ffnconv_phase(const Args& a, int l, int gt, int NGT) {
    const GAS bf16* U = (const GAS bf16*)(a.ws + WS_U); GAS bf16* ACT = (GAS bf16*)(a.ws + WS_ACT);
    const GAS float *cw = (const GAS float*)(a.in[31] + (size_t)l * 3 * 5632), *cb = (const GAS float*)(a.in[32] + (size_t)l * 5632);
#pragma unroll 1
    for (int idx = gt; idx < 1536 * 352; idx += NGT) {
        const int tb = idx / 352, ch = idx % 352, row0 = tb * 8, c0 = ch * 8;
        const bool lat = row0 >= TCTX; const int t0 = lat ? (row0 - TCTX) & 2047 : row0 & 255, L = lat ? 2048 : 256;
        v4u ra[10], rg[10];
#pragma unroll
        for (int i = 0; i < 10; ++i) { const int t = t0 + i - 1; const bool ok = (t >= 0) && (t < L); const size_t rr = (size_t)(row0 + (ok ? i - 1 : 0)) * 5632 + c0;
            ra[i] = *(const GAS v4u*)(U + rr); rg[i] = *(const GAS v4u*)(U + rr + 2816);
            if (!ok) { ra[i] = (v4u){0u, 0u, 0u, 0u}; rg[i] = (v4u){0u, 0u, 0u, 0u}; } }
        float wa[3][8], wg[3][8], ba[8], bg[8];
#pragma unroll
        for (int j = 0; j < 8; ++j) { ba[j] = cb[c0 + j]; bg[j] = cb[2816 + c0 + j];
#pragma unroll
            for (int k = 0; k < 3; ++k) { wa[k][j] = cw[k * 5632 + c0 + j]; wg[k][j] = cw[k * 5632 + 2816 + c0 + j]; } }
#pragma unroll
        for (int i = 0; i < 8; ++i) {
            float o[8];
#pragma unroll
            for (int j2 = 0; j2 < 4; ++j2) {
                const unsigned a0 = ra[i][j2], a1 = ra[i + 1][j2], a2 = ra[i + 2][j2], g0 = rg[i][j2], g1 = rg[i + 1][j2], g2 = rg[i + 2][j2];
                { const int j = 2 * j2; const float av = wa[0][j] * bflo(a0) + wa[1][j] * bflo(a1) + wa[2][j] * bflo(a2) + ba[j], gv = wg[0][j] * bflo(g0) + wg[1][j] * bflo(g1) + wg[2][j] * bflo(g2) + bg[j]; o[j] = gv * __builtin_amdgcn_rcpf(1.f + __expf(-gv)) * av; }
                { const int j = 2 * j2 + 1; const float av = wa[0][j] * bfhi(a0) + wa[1][j] * bfhi(a1) + wa[2][j] * bfhi(a2) + ba[j], gv = wg[0][j] * bfhi(g0) + wg[1][j] * bfhi(g1) + wg[2][j] * bfhi(g2) + bg[j]; o[j] = gv * __builtin_amdgcn_rcpf(1.f + __expf(-gv)) * av; } }
            *(GAS v4u*)(ACT + (size_t)(row0 + i) * 2816 + c0) = (v4u){pk2(o[0], o[1]), pk2(o[2], o[3]), pk2(o[4], o[5]), pk2(o[6], o[7])};
        }
    }
}
typedef float f32x2_t __attribute__((ext_vector_type(2)));
typedef __bf16 bf16x2_t __attribute__((ext_vector_type(2)));
__device__ __forceinline__ unsigned cvtpk(float lo, float hi) { const f32x2_t v = {lo, hi}; const bf16x2_t b = __builtin_convertvector(v, bf16x2_t); return __builtin_bit_cast(unsigned, b); }
template <int DK>
__device__ __forceinline__ void attn_unit(LAS unsigned char* lds, int tid, const bf16* Qp, int qpitch, const bf16* Kp, int kpitch, const bf16* Kpe, const bf16* Vt, size_t vpitch,
                                          int nkeys, bf16* Op, int opitch, float sl2, bool rope, int pos0) {
    constexpr int NS = DK / 16;
    asm volatile("" : "+v"(tid));
    const int lane = tid & 63, wave = tid >> 6, r = lane & 31, h = lane >> 5;
    bf16x8 qf[NS];
    { const bf16* qrow = Qp + (size_t)(wave * 32 + r) * qpitch;
#pragma unroll
      for (int s = 0; s < NS; ++s) qf[s] = *(const GAS bf16x8*)(qrow + 16 * s + 8 * h);
      if (DK == 96 && rope) { const int t = pos0 + wave * 32 + r; const float grow = (float)(t >> 6), gcol = (float)(t & 63);
#pragma unroll
          for (int sp = 0; sp < 2; ++sp) { bf16x8 v = qf[NS - 2 + sp];
#pragma unroll
              for (int k = 0; k < 4; ++k) { float x0 = bf1((bf16)v[2 * k]), x1 = bf1((bf16)v[2 * k + 1]);
                  const float inv = __builtin_amdgcn_exp2f(-(float)(4 * h + k) * (L2_10000 / 8.f)); rope2(x0, x1, (sp == 0 ? grow : gcol) * inv);
                  v[2 * k] = (short)f2bf(x0); v[2 * k + 1] = (short)f2bf(x1); }
              qf[NS - 2 + sp] = v; } } }
    const int kkey = tid >> 3, kch = tid & 7, pkey = tid >> 2, pch = tid & 3;
    f32x16 o0, o1;
#pragma unroll
    for (int i = 0; i < 16; ++i) { o0[i] = 0.f; o1[i] = 0.f; }
    float mrun = -__builtin_inff(), lrun = 0.f;
    v4u rk, rv, rp = (v4u){0u, 0u, 0u, 0u};
    const int ntile = nkeys >> 6;
#define ATT_LOAD(kt) do { const int key0 = (kt) * 64; rk = *(const GAS v4u*)(Kp + (size_t)(key0 + kkey) * kpitch + 8 * kch); rv = *(const GAS v4u*)(Vt + (size_t)kkey * vpitch + key0 + 8 * kch); \
        if (DK == 96 && tid < 256) rp = *(const GAS v4u*)(Kpe + (size_t)(key0 + pkey) * 32 + 8 * pch); } while (0)
#define ATT_WRITE(buf) do { *(LAS v4u*)(lds + (buf) * 13312 + kkey * 208 + kch * 16) = rk; \
        { LAS unsigned char* vw = lds + 26624 + (buf) * 9216 + kkey * 144 + (kch >> 1) * 32 + (kch & 1) * 8; *(LAS v2u*)vw = (v2u){rv.x, rv.y}; *(LAS v2u*)(vw + 16) = (v2u){rv.z, rv.w}; } \
        if (DK == 96 && tid < 256) *(LAS v4u*)(lds + (buf) * 13312 + pkey * 208 + 128 + pch * 16) = rp; } while (0)
    ATT_LOAD(0); ATT_WRITE(0); __syncthreads();
    for (int kt = 0; kt < ntile; ++kt) {
        const int buf = kt & 1;
        if (kt + 1 < ntile) ATT_LOAD(kt + 1);
        const LAS unsigned char* kb = lds + buf * 13312; const LAS unsigned char* vb = lds + 26624 + buf * 9216;
        f32x16 s0, s1;
#pragma unroll
        for (int i = 0; i < 16; ++i) { s0[i] = 0.f; s1[i] = 0.f; }
#pragma unroll
        for (int s = 0; s < NS; ++s) {
            const bf16x8 a0 = *(const LAS bf16x8*)(kb + r * 208 + (16 * s + 8 * h) * 2), a1 = *(const LAS bf16x8*)(kb + (32 + r) * 208 + (16 * s + 8 * h) * 2);
            s0 = __builtin_amdgcn_mfma_f32_32x32x16_bf16(a0, qf[s], s0, 0, 0, 0); s1 = __builtin_amdgcn_mfma_f32_32x32x16_bf16(a1, qf[s], s1, 0, 0, 0); }
        float mx = s0[0];
#pragma unroll
        for (int i = 1; i < 16; ++i) mx = fmaxf(mx, s0[i]);
#pragma unroll
        for (int i = 0; i < 16; ++i) mx = fmaxf(mx, s1[i]);
        mx = fmaxf(mx, __shfl_xor(mx, 32));
        const float mcand = fmaxf(mrun, mx);
        const bool resc = __builtin_amdgcn_ballot_w64((mcand - mrun) * sl2 > 8.f) != 0;
        if (resc) { const float alpha = __builtin_amdgcn_exp2f((mrun - mcand) * sl2); lrun *= alpha; mrun = mcand;
#pragma unroll
            for (int i = 0; i < 16; ++i) { o0[i] *= alpha; o1[i] *= alpha; } }
        const float nm = mrun * sl2;
        f32x2_t sum2 = {0.f, 0.f};
#pragma unroll
        for (int i = 0; i < 8; ++i) {
            f32x2_t t0 = {s0[2 * i], s0[2 * i + 1]}, t1 = {s1[2 * i], s1[2 * i + 1]};
            t0 = t0 * sl2 - nm; t1 = t1 * sl2 - nm;
            t0.x = __builtin_amdgcn_exp2f(t0.x); t0.y = __builtin_amdgcn_exp2f(t0.y); t1.x = __builtin_amdgcn_exp2f(t1.x); t1.y = __builtin_amdgcn_exp2f(t1.y);
            s0[2 * i] = t0.x; s0[2 * i + 1] = t0.y; s1[2 * i] = t1.x; s1[2 * i + 1] = t1.y;
            sum2 = sum2 + (t0 + t1); }
        lrun += sum2.x + sum2.y;
#pragma unroll
        for (int sub = 0; sub < 2; ++sub) {
#pragma unroll
            for (int s2 = 0; s2 < 2; ++s2) {
                const v4u pw = (sub == 0) ? (v4u){cvtpk(s0[8 * s2], s0[8 * s2 + 1]), cvtpk(s0[8 * s2 + 2], s0[8 * s2 + 3]), cvtpk(s0[8 * s2 + 4], s0[8 * s2 + 5]), cvtpk(s0[8 * s2 + 6], s0[8 * s2 + 7])}
                                          : (v4u){cvtpk(s1[8 * s2], s1[8 * s2 + 1]), cvtpk(s1[8 * s2 + 2], s1[8 * s2 + 3]), cvtpk(s1[8 * s2 + 4], s1[8 * s2 + 5]), cvtpk(s1[8 * s2 + 6], s1[8 * s2 + 7])};
                const bf16x8 pb = __builtin_bit_cast(bf16x8, pw);
                const int kofs = (32 * sub + 16 * s2 + 8 * h) * 2;
#pragma unroll
                for (int slab = 0; slab < 2; ++slab) {
                    const bf16x8 va = *(const LAS bf16x8*)(vb + (32 * slab + r) * 144 + kofs);
                    if (slab == 0) o0 = __builtin_amdgcn_mfma_f32_32x32x16_bf16(va, pb, o0, 0, 0, 0); else o1 = __builtin_amdgcn_mfma_f32_32x32x16_bf16(va, pb, o1, 0, 0, 0); } } }
        if (kt + 1 < ntile) ATT_WRITE(buf ^ 1);
        __syncthreads();
    }
#undef ATT_LOAD
#undef ATT_WRITE
    const float ltot = lrun + __shfl_xor(lrun, 32), inv = 1.f / ltot;
    bf16* orow = Op + (size_t)(wave * 32 + r) * opitch;
#pragma unroll
    for (int g4 = 0; g4 < 4; ++g4) {
        *(GAS v2u*)(orow + 8 * g4 + 4 * h) = (v2u){pk2(o0[4 * g4] * inv, o0[4 * g4 + 1] * inv), pk2(o0[4 * g4 + 2] * inv, o0[4 * g4 + 3] * inv)};
        *(GAS v2u*)(orow + 32 + 8 * g4 + 4 * h) = (v2u){pk2(o1[4 * g4] * inv, o1[4 * g4 + 1] * inv), pk2(o1[4 * g4 + 2] * inv, o1[4 * g4 + 3] * inv)}; }
}

template <bool LAT>
__device__ __forceinline__ void hyena_unit(const Args& a, int l, int c, LAS unsigned char* lds, int tid) {
    constexpr int L = LAT ? 2048 : 256, NB = LAT ? 4 : 16, NE = L / 16, NCH = L / 4, NW = LAT ? 8 : 4, ASH = LAT ? 2 : 4, MG = LAT ? 224 : 32  , UP = L + 2 * MG + 8  , GS = 514  ;
    asm volatile("" : "+v"(tid));
    const int lane = tid & 63, wave = tid >> 6, r = lane & 31, h = lane >> 5;
    const bf16* UT = (const bf16*)(a.ws + WS_UT) + (LAT ? UT_LAT : 0);
    GAS bf16* OC = (GAS bf16*)(a.ws + WS_OC);
    const float* HID = (const float*)(a.ws + WS_HID) + ((size_t)l * 2304 + (LAT ? 256 : 0)) * 64;
    LAS bf16* U = (LAS bf16*)lds; LAS bf16* X = (LAS bf16*)(lds + 20096); LAS float* FT = (LAS float*)(lds + 36480); LAS unsigned char* GC = lds + 69248;
    LAS float* W3 = (LAS float*)(lds + 135040); LAS float* RED = (LAS float*)(lds + 136064);
    constexpr int NQ = NB * L / 8 / 512;
    v4u x2r[NQ];
#pragma unroll
    for (int i = 0; i < NQ; ++i) { const int q = tid + 512 * i, b = q / (L / 8), off = (q % (L / 8)) * 8;
        const v4u uv = *(const GAS v4u*)(UT + ((size_t)b * 1536 + c) * L + off), xv = *(const GAS v4u*)(UT + ((size_t)b * 1536 + 512 + c) * L + off);
        x2r[i] = *(const GAS v4u*)(UT + ((size_t)b * 1536 + 1024 + c) * L + off);
        *(LAS v4u*)(U + b * UP + MG + off) = uv; *(LAS v4u*)(X + b * L + off) = xv; }
    for (int q = tid; q < NB * 2 * MG / 8; q += 512) { const int b = q / (2 * MG / 8), o = q % (2 * MG / 8); const int off = (o < MG / 8) ? 8 * o : MG + L + 8 * (o - MG / 8);
        *(LAS v4u*)(U + b * UP + off) = (v4u){0u, 0u, 0u, 0u}; }
    if (tid < 256) { const int j = tid >> 2, k = tid & 3; W3[k * 64 + j] = a.in[25][((size_t)l * 64 + j) * 2048 + (k >> 1) * 1024 + (k & 1) * 512 + c]; }
    __syncthreads();
#if defined(PROBE_HY) && PROBE_HY == 1
    for (int rep = 0; rep < 2; ++rep)
#endif
    { const float dmin = -15.350567286626973f, dmax = -3.0701134573253945f;
      const float delta = fabsf(dmin + (float)c * ((dmax - dmin) / 511.f));
      float p0 = 0.f, p1 = 0.f;
      for (int t = tid; t < L; t += 512) {
          float s[4] = {0.f, 0.f, 0.f, 0.f};
#pragma unroll 4
          for (int j4 = 0; j4 < 16; ++j4) { const f32x4 hv = *(const GAS f32x4*)(HID + (size_t)t * 64 + 4 * j4);
#pragma unroll
              for (int k = 0; k < 4; ++k) s[k] += hv.x * W3[k * 64 + 4 * j4] + hv.y * W3[k * 64 + 4 * j4 + 1] + hv.z * W3[k * 64 + 4 * j4 + 2] + hv.w * W3[k * 64 + 4 * j4 + 3]; }
          const float win = __expf(-((float)t / (float)(L - 1)) * delta);
#pragma unroll
          for (int k = 0; k < 4; ++k) { s[k] *= win; FT[k * L + t] = s[k]; }
          p0 += fabsf(s[0]) + (t >= 1 ? fabsf(s[2]) : 0.f); p1 += fabsf(s[1]) + (t >= 1 ? fabsf(s[3]) : 0.f); }
      p0 = wave_sum(p0); p1 = wave_sum(p1);
      if (lane == 0) { RED[2 * wave] = p0; RED[2 * wave + 1] = p1; } }
    __syncthreads();
    const int col = 32 * wave + r, ca = col >> ASH, cbat = col & (NB - 1);
    const int a_lo = (32 * wave) >> ASH, a_hi = (32 * wave + 31) >> ASH;
    const int rowbase = LAT ? TCTX + cbat * 2048 : cbat * 256;
#pragma unroll 1
    for (int n = 0; n < 2; ++n) {
        float l1s = 0.f;
#pragma unroll
        for (int w = 0; w < 8; ++w) l1s += RED[2 * w + n];
        const float invl1 = 1.f / (l1s + EPSN);
#if defined(PROBE_HY) && PROBE_HY == 4
        for (int rep = 0; rep < 2; ++rep)
#endif
        for (int q = tid; q < 8 * NCH; q += 512) { const int k = q & 7, y = q >> 3, m0 = L - (8 * y + k);
            float v[8];
#pragma unroll
            for (int j = 0; j < 8; ++j) { const int m = m0 - j; float t = 0.f; if (m >= 0 && m < L) t = FT[n * L + m]; else if (m < 0 && m > -L) t = FT[(2 + n) * L - m]; v[j] = t * invl1; }
            *(LAS v4u*)(GC + (k * GS + y) * 16) = (v4u){cvtpk(v[0], v[1]), cvtpk(v[2], v[3]), cvtpk(v[4], v[5]), cvtpk(v[6], v[7])}; }
        __syncthreads();
        f32x16 acc, acc1;
#if defined(PROBE_HY) && PROBE_HY == 3
        for (int rep = 0; rep < 2; ++rep) {
#endif
#pragma unroll
        for (int i = 0; i < 16; ++i) { acc[i] = 0.f; acc1[i] = 0.f; }
        if (wave < NW) {
            const int lam_lo = 2 * a_lo - (NE - 1), lam_hi = 2 * a_hi;
            const int xs0 = 8 * h - r + L;
            const LAS unsigned char* ap = GC + ((xs0 & 7) * GS + (xs0 >> 3) - 2 * lam_lo) * 16;
            const LAS unsigned char* bp = (const LAS unsigned char*)(U + cbat * UP + MG + 8 * h) + 32 * (2 * ca - lam_lo);
            bf16x8 a0 = *(const LAS bf16x8*)ap, b0 = *(const LAS bf16x8*)bp, a1 = *(const LAS bf16x8*)(ap - 32), b1 = *(const LAS bf16x8*)(bp - 32);
            for (int lam = lam_lo; lam <= lam_hi; lam += 2) {
                const bool more = lam + 2 <= lam_hi;
                if (more) { ap -= 64; bp -= 64; }
                const bf16x8 na0 = *(const LAS bf16x8*)ap, na1 = *(const LAS bf16x8*)(ap - 32), nb0 = *(const LAS bf16x8*)bp, nb1 = *(const LAS bf16x8*)(bp - 32);
                acc = __builtin_amdgcn_mfma_f32_32x32x16_bf16(a0, b0, acc, 0, 0, 0);
                acc1 = __builtin_amdgcn_mfma_f32_32x32x16_bf16(a1, b1, acc1, 0, 0, 0);
                a0 = na0; a1 = na1; b0 = nb0; b1 = nb1;
            }
#pragma unroll
            for (int i = 0; i < 16; ++i) acc[i] += acc1[i];
        }
#if defined(PROBE_HY) && PROBE_HY == 3
        asm volatile("" :: "v"(acc[0]), "v"(acc[5]));
        }
#endif
        const float bias = a.in[27][((size_t)l * 2 + n) * 512 + c];
        float z[16];
        if (wave < NW) {
#pragma unroll
            for (int g4 = 0; g4 < 4; ++g4) { const int t0 = 32 * ca + 8 * g4 + 4 * h;
                const v2u uw = *(const LAS v2u*)(U + cbat * UP + MG + t0), xw = *(const LAS v2u*)(X + cbat * L + t0);
                const float uv[4] = {bflo(uw.x), bfhi(uw.x), bflo(uw.y), bfhi(uw.y)}, xv[4] = {bflo(xw.x), bfhi(xw.x), bflo(xw.y), bfhi(xw.y)};
#pragma unroll
                for (int k = 0; k < 4; ++k) z[4 * g4 + k] = xv[k] * (acc[4 * g4 + k] + bias * uv[k]); }
        }
        __syncthreads();
        if (n == 0) {
            if (wave < NW) {
#pragma unroll
                for (int g4 = 0; g4 < 4; ++g4) *(LAS v2u*)(U + cbat * UP + MG + 32 * ca + 8 * g4 + 4 * h) = (v2u){pk2(z[4 * g4], z[4 * g4 + 1]), pk2(z[4 * g4 + 2], z[4 * g4 + 3])}; }
#pragma unroll
            for (int i = 0; i < NQ; ++i) { const int q = tid + 512 * i, b = q / (L / 8), off = (q % (L / 8)) * 8; *(LAS v4u*)(X + b * L + off) = x2r[i]; }
        } else if (wave < NW) {
#if defined(PROBE_HY) && PROBE_HY == 2
            for (int rep = 0; rep < 2; ++rep)
#endif
#pragma unroll
            for (int g4 = 0; g4 < 4; ++g4)
#pragma unroll
                for (int k = 0; k < 4; ++k) OC[(size_t)(rowbase + 32 * ca + 8 * g4 + 4 * h + k) * 512 + c] = (bf16)f2bf(z[4 * g4 + k]);
        }
    }
    __syncthreads();
}
#ifndef PHMASK
#define PHMASK 0x1fff
#endif
#define PH_ON(k) (((PHMASK) >> (k)) & 1)
#define L1_INV() do { asm volatile("s_waitcnt vmcnt(0)" ::: "memory"); __builtin_amdgcn_fence(__ATOMIC_ACQUIRE, "agent"); asm volatile("s_waitcnt vmcnt(0)" ::: "memory"); __syncthreads(); } while (0)
template <class T> __device__ __forceinline__ T* asglobal(T* p) { return (T*)(GAS T*)p; }
__global__ void __launch_bounds__(512, 2) mega_fwd(Args a) {
    extern __shared__ __attribute__((aligned(16))) unsigned char lds_raw[];
    LAS unsigned char* lds = (LAS unsigned char*)lds_raw;
    cg::grid_group grid = cg::this_grid();
    const int bid = blockIdx.x;
    using pg8::Gemm; using pg8::StaticOrder;
    const int ph_lo = a.ph_lo, ph_hi = a.ph_hi;
    volatile LAS unsigned* MISC = (volatile LAS unsigned*)(lds + LDS_BYTES - 64);
    if (threadIdx.x < 16) MISC[threadIdx.x] = 0u;
    __syncthreads();
    if (ph_hi > NPHASE) { __syncthreads(); grid.sync(); }
    XcdBarrier bar = xcd_barrier_post((unsigned*)(a.ws + WS_BAR + (size_t)a.li * BAR_REGION), MISC);
#pragma unroll 1
    for (int ph = ph_lo; ph < ph_hi; ++ph) {
        int tid = threadIdx.x; asm volatile("" : "+v"(tid));
        int G = gridDim.x; asm volatile("" : "+s"(G)); const int NGW = G * 8, NGT = G * 512;
        unsigned char* ws = a.ws; asm volatile("" : "+s"(ws));
#if defined(__HIP_DEVICE_COMPILE__)
#define ASSUME_GLOBAL(p) __builtin_assume(!__builtin_amdgcn_is_shared((const void*)(p)) && !__builtin_amdgcn_is_private((const void*)(p)))
#else
#define ASSUME_GLOBAL(p) ((void)0)
#endif
        ASSUME_GLOBAL(ws); ASSUME_GLOBAL(a.ws); ASSUME_GLOBAL(a.out);
#pragma unroll
        for (int i = 0; i < 35; ++i) ASSUME_GLOBAL(a.in[i]);
        const int lane = tid & 63, wave = __builtin_amdgcn_readfirstlane(tid >> 6), gw = bid * 8 + wave, gt = bid * 512 + tid;
        const int l = (ph >= 1 && ph < 23) ? (ph - 1) / 11 : 0, sub = (ph >= 1 && ph < 23) ? (ph - 1) % 11 : -1;
        float* mod = (float*)(ws + WS_MOD) + (size_t)l * 5 * 6144;
        bool did = true;
        if (PH_ON(11) && ph == 0) { p0_mod_hid(a, lds, bid, G, tid, gw, NGW, lane); wconv_phase(a, 0, 0, lds, gw, NGW, gt, NGT, wave, lane); }
        else if (PH_ON(12) && ph == 23 && G == 256) { did = false; }
        else if (PH_ON(12) && ph == 23) { norm_phase(a, 0, 2, false, false, gw, NGW, lane); }
        else if (PH_ON(0) && sub == 0 && l == 1 && G == 256) { did = false; }
        else if (PH_ON(0) && sub == 0) { if (l == 1) wconv_phase(a, 1, 0, lds, gw, NGW, gt, NGT, wave, lane);     norm_phase(a, l, 0, l == 0, G != 256, gw, NGW, lane); }
        else if (PH_ON(1) && sub == 1) {
            Gemm g{(const bf16*)(ws + WS_HBF1), (const bf16*)(ws + WS_WIN), TT, 4096, 1024, 1024, 1024}; StaticOrder S; S.init(TT, 4096, G, bid);
            pg8::EpiSeg E{(bf16*)(ws + WS_QA), (bf16*)(ws + WS_KVR), (bf16*)(ws + WS_CQ), (bf16*)(ws + WS_CKVR), (bf16*)(ws + WS_HYR), (bf16*)(ws + WS_S0)};
            pg8::gemm_phase<pg8::EpiSeg, StaticOrder, true, true>(lds, g, S, E);
        }
        else if (PH_ON(2) && sub == 2) { post_phase(a, l, lds, bid, G, tid, gw, NGW, gt, NGT, lane); }
        else if (PH_ON(3) && sub == 3) {
#pragma unroll 1
            for (int q = 0; q < 3; ++q) {
                Gemm g; StaticOrder S; pg8::EpiStore<0> E;
                if (q == 0) { g = Gemm{(const bf16*)(ws + WS_CQ), (const bf16*)(ws + WS_WUQ), TT, 768, 384, 512, 384}; S.init(TT, 768, G, bid); E = pg8::EpiStore<0>{(bf16*)(ws + WS_QB), 768}; }
                else if (q == 1) { g = Gemm{(const bf16*)(ws + WS_CKVALL), (const bf16*)(ws + WS_WKN), NKEYROWS, 512, 256, 256, 256}; S.init(NKEYROWS, 512, G, (bid + G - 144 % G) % G); E = pg8::EpiStore<0>{(bf16*)(ws + WS_KNB), 512}; }
                else { g = Gemm{(const bf16*)(ws + WS_WVV), (const bf16*)(ws + WS_CKVALL), 512, NKEYROWS, 256, 256, 256}; S.init(512, NKEYROWS, G, (bid + G - 248 % G) % G); E = pg8::EpiStore<0>{(bf16*)(ws + WS_VTB), NKEYROWS}; }
                pg8::gemm_phase<pg8::EpiStore<0>, StaticOrder, true, true>(lds, g, S, E);
            }
        }
        else if (PH_ON(4) && sub == 4) {
            const bf16 *QA = (const bf16*)(ws + WS_QA), *QB = (const bf16*)(ws + WS_QB), *KA = (const bf16*)(ws + WS_KA), *VTA = (const bf16*)(ws + WS_VTA);
            const bf16 *KNB = (const bf16*)(ws + WS_KNB), *VTB = (const bf16*)(ws + WS_VTB), *KPE = (const bf16*)(ws + WS_KPEALL);
            bf16 *OA = (bf16*)(ws + WS_OA), *OB = (bf16*)(ws + WS_OB);
            const float slA = 0.125f * 1.4426950408889634f, slB = 0.10206207261596575f * 1.4426950408889634f;
            const int sel = a.pad;
            for (int it = bid; it < 1792; it += G) {
                { const bool is_hy = (it >= 512 && it < 1024) || it >= 1280; if ((sel == 1 && is_hy) || (sel == 2 && !is_hy)) continue; }
                if (it < 256 || (it >= 1024 && it < 1152)) {
                    const bool lat = it < 256; const int u = lat ? (G == 256 ? ((bid & 7) * 4 + (bid >> 6)) * 8 + ((bid >> 3) & 7) : it) : it - 1024;
                    const int b = lat ? u >> 6 : u >> 3, hh = lat ? (u >> 3) & 7 : u & 7, qb = lat ? u & 7 : 0;
                    const int row0 = lat ? TCTX + b * 2048 + qb * 256 : b * 256, key0 = lat ? TCTX + b * 2304 : b * 256;
                    attn_unit<96>(lds, tid, QB + (size_t)row0 * 768 + hh * 96, 768, KNB + (size_t)key0 * 512 + hh * 64, 512, KPE + (size_t)key0 * 32, VTB + (size_t)(hh * 64) * NKEYROWS + key0, NKEYROWS,
                                  lat ? 2304 : 256, OB + (size_t)row0 * 512 + hh * 64, 512, slB, lat, qb * 256);
                } else if (it < 512 || (it >= 1152 && it < 1280)) {
                    const bool lat = it < 512; const int u = lat ? (G == 256 ? ((bid & 7) * 4 + (bid >> 6)) * 8 + ((bid >> 3) & 7) : it - 256) : it - 1152;
                    const int b = lat ? u >> 6 : u >> 3, hh = lat ? (u >> 3) & 7 : u & 7, qb = lat ? u & 7 : 0, kvh = hh >> 2;
                    const int row0 = lat ? TCTX + b * 2048 + qb * 256 : b * 256, nk = lat ? 2304 : 256;
                    const size_t kbase = lat ? (size_t)KA_LAT + (size_t)(b * 2 + kvh) * 2304 * 64 : (size_t)(b * 2 + kvh) * 256 * 64;
                    attn_unit<64>(lds, tid, QA + (size_t)row0 * 512 + hh * 64, 512, KA + kbase, 64, nullptr, VTA + kbase, nk, nk, OA + (size_t)row0 * 512 + hh * 64, 512, slA, false, 0);
                } else if (it < 1024) { hyena_unit<true>(a, l, it - 512, lds, tid); }
                else { hyena_unit<false>(a, l, it - 1280, lds, tid); }
            }
        }
        else if (PH_ON(5) && sub == 5) {
            static_assert(WS_S1 + 121 * MiB == WS_S0 && WS_S2 + 97 * MiB == WS_S0, "gate buffer arithmetic");
            bf16 *S0 = (bf16*)(ws + WS_S0), *MBF = (bf16*)(ws + WS_MBF);
            { Gemm g{(const bf16*)(ws + WS_HBF1), (const bf16*)(ws + WS_WG), TT, 2048, 1024, 1024, 1024}; StaticOrder S; S.init(TT, 2048, G, bid);
              pg8::EpiGate E{S0}; pg8::gemm_phase<pg8::EpiGate, StaticOrder, true, true>(lds, g, S, E); }
            xcd_barrier(bar);
            { Gemm g{(const bf16*)(ws + WS_OA), (const bf16*)(ws + WS_WB), TT, 1024, 512, 512, 512, (size_t)TT * 512 * 2, (size_t)1024 * 512 * 2};
              pg8::BatchOrder<3> S; S.init(TT, 1024, G, bid);
              pg8::EpiMerge E{S0, MBF}; pg8::gemm_phase<pg8::EpiMerge, pg8::BatchOrder<3>, true, true>(lds, g, S, E); }
        }
        else if (PH_ON(6) && sub == 6) {
            Gemm g{(const bf16*)(ws + WS_MBF), (const bf16*)(ws + WS_WO), TT, 1024, 1024, 1024, 1024}; StaticOrder S; S.init(TT, 1024, G, bid);
            if (G == 256) { pg8::EpiResNorm E{a.out, (l == 0) ? a.in[0] : a.out, (l == 0) ? a.in[1] - (size_t)TCTX * DM : a.out, mod + 2048, a.in[11] + l * 1024, mod, 3072, 4096, (bf16*)(ws + WS_HBF), (float*)(ws + WS_SLOT), (unsigned*)(ws + WS_CNT) + (size_t)(l * 2) * 48 * 16, 0};
                pg8::gemm_phase<pg8::EpiResNorm, StaticOrder, true, true>(lds, g, S, E); }
            else { pg8::EpiResid E{a.out, mod + 2048}; pg8::gemm_phase<pg8::EpiResid, StaticOrder, true, true>(lds, g, S, E); }
        }
        else if (PH_ON(7) && sub == 7 && G == 256) { did = false; }
        else if (PH_ON(7) && sub == 7) { norm_phase(a, l, 1, false, false, gw, NGW, lane); }
        else if (PH_ON(8) && sub == 8) {
            Gemm g{(const bf16*)(ws + WS_HBF), (const bf16*)(ws + WS_WUP), TT, 5632, 1024, 1024, 1024}; StaticOrder S; S.init(TT, 5632, G, bid);
            pg8::EpiStore<0> E{(bf16*)(ws + WS_U), 5632}; pg8::gemm_phase<pg8::EpiStore<0>, StaticOrder, true, true>(lds, g, S, E);
        }
        else if (PH_ON(9) && sub == 9) { ffnconv_phase(a, l, gt, NGT); }
        else if (PH_ON(10) && sub == 10) {
            Gemm g{(const bf16*)(ws + WS_ACT), (const bf16*)(ws + WS_WDN), TT, 1024, 2816, 2816, 2816}; StaticOrder S; S.init(TT, 1024, G, bid);
            if (G == 256) {
                const float* modnext = (const float*)(ws + WS_MOD) + (size_t)5 * 6144;
                pg8::EpiResNorm E{a.out, a.out, a.out, mod + 5120, (l == 0) ? a.in[10] + 1024 : a.in[34], modnext, 0, 1024, (bf16*)(ws + WS_HBF1), (float*)(ws + WS_SLOT), (unsigned*)(ws + WS_CNT) + (size_t)(l * 2 + 1) * 48 * 16, l};
                pg8::gemm_phase<pg8::EpiResNorm, StaticOrder, true, true>(lds, g, S, E); }
            else { pg8::EpiResid E{a.out, mod + 5120}; pg8::gemm_phase<pg8::EpiResid, StaticOrder, true, true>(lds, g, S, E); }
            if (l == 0 && G == 256 && bid >= 192)
                wconv_phase(a, 1, 1, lds, (bid - 192) * 8 + wave, 64 * 8, (bid - 192) * 512 + tid, 64 * 512, wave, lane);
        }
#ifdef EXTRA_SYNCS
        for (int q = 0; q < EXTRA_SYNCS; ++q) { __syncthreads(); grid.sync(); }
#endif
        if (did && ph + 1 < ph_hi) xcd_barrier(bar);
    }
}

extern "C" void kernel_launch(void* const* d_in, const int* in_sizes, int n_in, void* d_out, int out_size, void* d_ws, size_t ws_size, hipStream_t stream) {
    static int grid = 0;
    if (grid == 0) {
        if (n_in != 35 || ws_size < WS_END) { fprintf(stderr, "kernel_launch: unexpected n_in %d / ws %zu\n", n_in, ws_size); grid = -1; return; }
        int dev = 0, cus = 0, per_cu = 0;
        if (hipGetDevice(&dev) != hipSuccess || hipDeviceGetAttribute(&cus, hipDeviceAttributeMultiprocessorCount, dev) != hipSuccess) { grid = -1; return; }
        if (hipFuncSetAttribute((const void*)mega_fwd, hipFuncAttributeMaxDynamicSharedMemorySize, LDS_BYTES) != hipSuccess) { fprintf(stderr, "kernel_launch: hipFuncSetAttribute failed\n"); grid = -1; return; }
        if (hipOccupancyMaxActiveBlocksPerMultiprocessor(&per_cu, (const void*)mega_fwd, 512, LDS_BYTES) != hipSuccess || per_cu < 1) { fprintf(stderr, "kernel_launch: occupancy query says %d\n", per_cu); per_cu = 1; }
        (void)hipGetLastError();
        grid = cus;
    }
    if (grid < 0) return;
    if (hipMemsetAsync((char*)d_ws + WS_MOD, 0, ZERO_BYTES, stream) != hipSuccess) { fprintf(stderr, "kernel_launch: memset failed\n"); return; }
    Args a{};
    for (int i = 0; i < 35; ++i) a.in[i] = (const float*)d_in[i];
    a.out = (float*)d_out; a.ws = (unsigned char*)d_ws;
#if defined(MK_PER_PHASE)
    for (int p = 0; p < NPHASE; ++p) { a.ph_lo = p; a.ph_hi = p + 1; a.li = 0; void* args[] = {&a};
        hipError_t e = hipLaunchCooperativeKernel((const void*)mega_fwd, dim3(grid), dim3(512), args, LDS_BYTES, stream);
        if (e != hipSuccess) { fprintf(stderr, "launch %d failed: %s\n", p, hipGetErrorString(e)); break; } }
#else
#if defined(PROBE_SUB)
#ifndef PROBE_SEL
#define PROBE_SEL 0
#endif
    { const int k0 = 1 + PROBE_SUB, k1 = 12 + PROBE_SUB; const int cuts[6][2] = {{0, k0 + 1}, {k0, k0 + 1}, {k0 + 1, k1 + 1}, {k1, k1 + 1}, {k1 + 1, NPHASE}, {0, 0}};
      for (int c = 0; c < 5; ++c) { a.ph_lo = cuts[c][0]; a.ph_hi = cuts[c][1]; a.li = c; a.pad = (c == 1 || c == 3) ? PROBE_SEL : 0; if (a.ph_lo >= a.ph_hi) continue; void* args[] = {&a};
          hipError_t e = hipLaunchCooperativeKernel((const void*)mega_fwd, dim3(grid), dim3(512), args, LDS_BYTES, stream);
          if (e != hipSuccess) { fprintf(stderr, "cooperative launch failed: %s\n", hipGetErrorString(e)); break; } } }
#elif defined(PROBE_CUTS)
    { const int k0 = 1 + PROBE_CUTS, k1 = 12 + PROBE_CUTS; const int cuts[4][2] = {{0, k0 + 1}, {k0 + 1, k1 + 1}, {k1 + 1, NPHASE}, {0, 0}};
      for (int c = 0; c < 3; ++c) { a.ph_lo = cuts[c][0]; a.ph_hi = cuts[c][1]; a.li = c; if (a.ph_lo >= a.ph_hi) continue; void* args[] = {&a};
          hipError_t e = hipLaunchCooperativeKernel((const void*)mega_fwd, dim3(grid), dim3(512), args, LDS_BYTES, stream);
          if (e != hipSuccess) { fprintf(stderr, "cooperative launch failed: %s\n", hipGetErrorString(e)); break; } } }
#else
    a.ph_lo = 0; a.ph_hi = NPHASE; void* args[] = {&a};
    hipError_t e = hipLaunchCooperativeKernel((const void*)mega_fwd, dim3(grid), dim3(512), args, LDS_BYTES, stream);
    if (e != hipSuccess) fprintf(stderr, "cooperative launch failed: %s (grid %d)\n", hipGetErrorString(e), grid);
#endif
#endif
}
```
